# Optimizing an MI355X kernel written in HIP

```python
import math
import jax, jax.numpy as jnp
from jax import lax
import numpy as np

D_MODEL = 1024
BATCH = 2
SEQ = 16384
DEPTH = 1

PLE_DIM = 256
MOBA_HEADS = 8
MOBA_HEAD_DIM = D_MODEL // 16
MOBA_WIDTH = MOBA_HEADS * MOBA_HEAD_DIM
MOBA_BLOCK = 256
MOBA_TOPK = 3
MOBA_Q_CHUNK = 64
RET_HEADS = 4
RET_HEAD_DIM = D_MODEL // 8
RET_WIDTH = RET_HEADS * RET_HEAD_DIM
RET_CHUNK = 256
MIX_WIDTH = MOBA_WIDTH + RET_WIDTH
IN_PROJ_WIDTH = 3 * MOBA_WIDTH + 4 * RET_WIDTH
SEQ_PAD_MULTIPLE = 256
D_FF = 2816
CONV_WIDTH = 3
RMS_EPS = 1e-6
GN_EPS = 1e-5

kernel_name = "hymba_moba_retnet_convffn_ple"


def rmsnorm(x, g):
    xf = x.astype(jnp.float32)
    ms = jnp.mean(xf * xf, axis=-1, keepdims=True)
    return (xf * lax.rsqrt(ms + RMS_EPS)).astype(x.dtype) * g


def alibi_slopes(n_heads):
    return jnp.exp2(-8.0 * jnp.arange(1, n_heads + 1, dtype=jnp.float32) / n_heads)


def to_heads(t, n_heads, head_dim):
    b, s, _ = t.shape
    return t.reshape(b, s, n_heads, head_dim).transpose(0, 2, 1, 3)


def from_heads(t):
    b, h, s, d = t.shape
    return t.transpose(0, 2, 1, 3).reshape(b, s, h * d)


def moba_attention(q, k, v):
    B, H, S, Dh = q.shape
    nb = S // MOBA_BLOCK
    k_eff = min(MOBA_TOPK, nb)
    n_sel = k_eff * MOBA_BLOCK
    scale = Dh ** -0.5
    slopes = alibi_slopes(H)[:, None, None]
    kb = k.reshape(B, H, nb, MOBA_BLOCK, Dh)
    vb = v.reshape(B, H, nb, MOBA_BLOCK, Dh)
    kmean = jnp.mean(kb.astype(jnp.float32), axis=3).astype(k.dtype)
    kb_flat = kb.reshape(B * H * nb, MOBA_BLOCK, Dh)
    vb_flat = vb.reshape(B * H * nb, MOBA_BLOCK, Dh)
    head_base = (jnp.arange(B * H, dtype=jnp.int32) * nb).reshape(B, H, 1, 1)
    chunks_per_block = MOBA_BLOCK // MOBA_Q_CHUNK
    blk_pos = jnp.arange(MOBA_BLOCK, dtype=jnp.int32)
    blk_ids = jnp.arange(nb, dtype=jnp.int32)

    def one_chunk(c):
        start = c * MOBA_Q_CHUNK
        qc = lax.dynamic_slice_in_dim(q, start, MOBA_Q_CHUNK, axis=2)
        own = c // chunks_per_block
        q_pos = start + jnp.arange(MOBA_Q_CHUNK, dtype=jnp.int32)
        gate = jnp.einsum('bhqd,bhnd->bhqn', qc, kmean).astype(jnp.float32)
        gate = jnp.where(blk_ids < own, gate, -jnp.inf)
        gate_val, sel = lax.top_k(gate, k_eff)
        sel_valid = jnp.isfinite(gate_val)
        flat = head_base + sel
        k_sel = kb_flat[flat].reshape(B, H, MOBA_Q_CHUNK, n_sel, Dh)
        v_sel = vb_flat[flat].reshape(B, H, MOBA_Q_CHUNK, n_sel, Dh)
        s_sel = jnp.einsum('bhqd,bhqkd->bhqk', qc, k_sel).astype(jnp.float32) * scale
        key_pos_sel = (sel[..., None] * MOBA_BLOCK + blk_pos).reshape(B, H, MOBA_Q_CHUNK, n_sel)
        dist_sel = (q_pos[:, None] - key_pos_sel).astype(jnp.float32)
        s_sel = jnp.where(jnp.repeat(sel_valid, MOBA_BLOCK, axis=-1),
                          s_sel - slopes * dist_sel, -jnp.inf)
        k_own = lax.dynamic_index_in_dim(kb, own, axis=2, keepdims=False)
        v_own = lax.dynamic_index_in_dim(vb, own, axis=2, keepdims=False)
        s_own = jnp.einsum('bhqd,bhkd->bhqk', qc, k_own).astype(jnp.float32) * scale
        dist_own = q_pos[:, None] - (own * MOBA_BLOCK + blk_pos)[None, :]
        s_own = jnp.where(dist_own >= 0, s_own - slopes * dist_own.astype(jnp.float32), -jnp.inf)
        probs = jax.nn.softmax(jnp.concatenate([s_sel, s_own], axis=-1), axis=-1).astype(v.dtype)
        out = (jnp.einsum('bhqk,bhqkd->bhqd', probs[..., :n_sel], v_sel)
               + jnp.einsum('bhqk,bhkd->bhqd', probs[..., n_sel:], v_own))
        return out

    outs = lax.map(one_chunk, jnp.arange(S // MOBA_Q_CHUNK, dtype=jnp.int32))
    return jnp.moveaxis(outs, 0, 2).reshape(B, H, S, Dh)


def retention_chunkwise(q, k, v):
    B, H, S, Dh = q.shape
    C = RET_CHUNK
    nc = S // C
    gamma = 1.0 - jnp.exp2(-5.0 - jnp.arange(H, dtype=jnp.float32))
    log_g = jnp.log(gamma)
    idx = jnp.arange(C, dtype=jnp.float32)
    diff = idx[:, None] - idx[None, :]
    decay_intra = jnp.where(diff >= 0, jnp.exp(log_g[:, None, None] * jnp.maximum(diff, 0.0)), 0.0)
    q_decay = jnp.exp(log_g[:, None] * (idx + 1.0))[..., None]
    k_decay = jnp.exp(log_g[:, None] * (C - 1.0 - idx))[..., None]
    chunk_decay = jnp.exp(log_g * C)[:, None, None]
    k = k * (Dh ** -0.5)

    def chunks(t):
        return jnp.moveaxis(t.reshape(B, H, nc, C, Dh), 2, 0)

    def step(state, inp):
        qc, kc, vc = inp
        s = jnp.einsum('bhqd,bhkd->bhqk', qc, kc) * decay_intra
        inner = jnp.einsum('bhqk,bhkd->bhqd', s, vc)
        cross = jnp.einsum('bhqd,bhde->bhqe', qc * q_decay, state)
        new_state = chunk_decay * state + jnp.einsum('bhkd,bhke->bhde', kc * k_decay, vc)
        return new_state, inner + cross

    state0 = jnp.zeros((B, H, Dh, Dh), jnp.float32)
    _, outs = lax.scan(step, state0, (chunks(q), chunks(k), chunks(v)))
    return jnp.moveaxis(outs, 0, 2).reshape(B, H, S, Dh)


def head_groupnorm(o, g):
    mu = jnp.mean(o, axis=-1, keepdims=True)
    var = jnp.mean(jnp.square(o - mu), axis=-1, keepdims=True)
    return from_heads((o - mu) * lax.rsqrt(var + GN_EPS)) * g


def causal_dwconv(u, w, b):
    S = u.shape[1]
    up = jnp.pad(u, ((0, 0), (CONV_WIDTH - 1, 0), (0, 0)))
    out = b
    for j in range(CONV_WIDTH):
        out = out + w[j] * up[:, j:j + S]
    return out


def setup_inputs(seed: int = 0) -> dict:
    key = jax.random.key(seed)
    ks = jax.random.split(key, 17)
    f32 = jnp.float32

    def nrm(k, shape, scale):
        return jax.random.normal(k, shape, f32) * scale

    def gain(k, shape):
        return 1.0 + 0.02 * jax.random.normal(k, shape, f32)

    return {
        "x": nrm(ks[0], (BATCH, SEQ, D_MODEL), 1.0),
        "p": nrm(ks[1], (DEPTH, BATCH, SEQ, PLE_DIM), 1.0),
        "attn_norm": gain(ks[2], (DEPTH, D_MODEL)),
        "w_in": nrm(ks[3], (DEPTH, D_MODEL, IN_PROJ_WIDTH), D_MODEL ** -0.5),
        "ret_norm": gain(ks[4], (DEPTH, RET_WIDTH)),
        "w_out": nrm(ks[5], (DEPTH, MIX_WIDTH, D_MODEL), MIX_WIDTH ** -0.5),
        "ffn_norm": gain(ks[6], (DEPTH, D_MODEL)),
        "w_up": nrm(ks[7], (DEPTH, D_MODEL, D_FF), D_MODEL ** -0.5),
        "w_gate": nrm(ks[8], (DEPTH, D_MODEL, D_FF), D_MODEL ** -0.5),
        "conv_w": nrm(ks[9], (DEPTH, CONV_WIDTH, D_FF), CONV_WIDTH ** -0.5),
        "conv_b": nrm(ks[10], (DEPTH, D_FF), 0.01),
        "w_down": nrm(ks[11], (DEPTH, D_FF, D_MODEL), D_FF ** -0.5),
        "ple_norm": gain(ks[12], (DEPTH, D_MODEL)),
        "w_ple": nrm(ks[13], (DEPTH, PLE_DIM, D_MODEL), PLE_DIM ** -0.5),
        "w_ple_gate": nrm(ks[14], (DEPTH, D_MODEL, D_MODEL), D_MODEL ** -0.5),
        "final_norm": gain(ks[15], (D_MODEL,)),
    }


def reference(x, p, attn_norm, w_in, ret_norm, w_out, ffn_norm, w_up, w_gate, conv_w,
              conv_b, w_down, ple_norm, w_ple, w_ple_gate, final_norm):
    B, S, _ = x.shape
    S_pad = -(-S // SEQ_PAD_MULTIPLE) * SEQ_PAD_MULTIPLE
    split_points = [MOBA_WIDTH, 2 * MOBA_WIDTH, 3 * MOBA_WIDTH,
                    3 * MOBA_WIDTH + RET_WIDTH, 3 * MOBA_WIDTH + 2 * RET_WIDTH,
                    3 * MOBA_WIDTH + 3 * RET_WIDTH]
    for i in range(DEPTH):
        h = rmsnorm(x, attn_norm[i])
        proj = h @ w_in[i]
        proj = jnp.pad(proj, ((0, 0), (0, S_pad - S), (0, 0)))
        mq, mk, mv, rq, rk, rv, rg = jnp.split(proj, split_points, axis=-1)
        moba_out = from_heads(moba_attention(to_heads(mq, MOBA_HEADS, MOBA_HEAD_DIM),
                                             to_heads(mk, MOBA_HEADS, MOBA_HEAD_DIM),
                                             to_heads(mv, MOBA_HEADS, MOBA_HEAD_DIM)))
        ret = retention_chunkwise(to_heads(rq, RET_HEADS, RET_HEAD_DIM),
                                  to_heads(rk, RET_HEADS, RET_HEAD_DIM),
                                  to_heads(rv, RET_HEADS, RET_HEAD_DIM))
        ret_out = (head_groupnorm(ret, ret_norm[i]) * jax.nn.silu(rg)).astype(x.dtype)
        mix = jnp.concatenate([moba_out, ret_out], axis=-1)[:, :S]
        x = x + mix @ w_out[i]
        h = rmsnorm(x, ffn_norm[i])
        u = causal_dwconv(h @ w_up[i], conv_w[i], conv_b[i])
        x = x + (jax.nn.gelu(u) * (h @ w_gate[i])) @ w_down[i]
        g = jax.nn.sigmoid(rmsnorm(x, ple_norm[i]) @ w_ple_gate[i])
        x = x + (p[i] @ w_ple[i]) * g
    return rmsnorm(x, final_norm)
```

```cpp
#include <hip/hip_runtime.h>
#include <stdint.h>
#include <math.h>
#include <cstdio>

typedef unsigned short bf16_t;
typedef unsigned int u32;

constexpr int BATCH = 2, SEQ = 16384, MT = BATCH * SEQ, DM = 1024, NPROJ = 3584, FF = 2816, PLED = 256;
constexpr int MH = 8, MD = 64, RH = 4, RD = 128, NBLK = 64, BLK = 256;
constexpr int C_MQ = 0, C_MK = 512, C_MV = 1024, C_RQ = 1536, C_RK = 2048, C_RV = 2560, C_RG = 3072;
constexpr float RMS_EPS = 1e-6f, GN_EPS = 1e-5f;
constexpr float LOG2E = 1.4426950408889634f;
constexpr float QSCALE = 0.125f * LOG2E;
constexpr float RKSCALE = 0.08838834764831845f;

constexpr size_t MiB = (size_t)1 << 20;
constexpr size_t WS_CTL = 0, WS_WIN = 1 * MiB, WS_WOUT = 8 * MiB, WS_WUG = 10 * MiB, WS_WDOWN = 21 * MiB, WS_WPG = 27 * MiB, WS_WPLE = 29 * MiB;
constexpr size_t WS_RSQ = 30 * MiB;
constexpr size_t WS_PB = 36 * MiB;
constexpr size_t WS_R2 = 52 * MiB;
constexpr size_t WS_R1 = 116 * MiB;
constexpr size_t WS_SEG = 180 * MiB;
constexpr size_t WS_KVT = 212 * MiB;
constexpr size_t WS_STT = 244 * MiB;
constexpr size_t WS_PARTL = 260 * MiB;
constexpr size_t WS_SEL = 264 * MiB;
constexpr size_t WS_CNT = 265 * MiB;
constexpr size_t WS_KMEAN = WS_CNT + 512 * 1024;
constexpr size_t WS_PROJ = 266 * MiB;
constexpr size_t WS_END = 490 * MiB;
constexpr size_t WS_UH = 116 * MiB;

__device__ __forceinline__ float bf2f(bf16_t v) { return __uint_as_float(((u32)v) << 16); }
__device__ __forceinline__ bf16_t f2bf(float f) { u32 u = __float_as_uint(f); return (bf16_t)((u + 0x7fffu + ((u >> 16) & 1u)) >> 16); }
__device__ __forceinline__ float wave_sum(float v) {
#pragma unroll
    for (int o = 1; o < 64; o <<= 1) v += __shfl_xor(v, o);
    return v;
}
__device__ __forceinline__ float rs_from(const float* p) {
    float s = 0.f;
#pragma unroll
    for (int i = 0; i < 16; ++i) s += p[i];
    return rsqrtf(s * (1.0f / DM) + RMS_EPS);
}
__device__ __forceinline__ float gelu_tanh(float x) {
    const float z = 0.7978845608028654f * (x + 0.044715f * x * x * x);
    return x / (1.0f + __expf(-2.0f * z));
}
__device__ __forceinline__ float sigmoidf_(float x) { return 1.0f / (1.0f + __expf(-x)); }

__global__ __launch_bounds__(256) void k_rmsnorm_bf16(const float* __restrict__ x, const float* __restrict__ g, bf16_t* __restrict__ out) {
    const int row = blockIdx.x * 4 + (threadIdx.x >> 6), lane = threadIdx.x & 63;
    const float4* xr = (const float4*)(x + (size_t)row * DM);
    float4 v[4]; float s = 0.f;
#pragma unroll
    for (int j = 0; j < 4; ++j) { v[j] = xr[lane + 64 * j]; s += v[j].x * v[j].x + v[j].y * v[j].y + v[j].z * v[j].z + v[j].w * v[j].w; }
    const float rs = rsqrtf(wave_sum(s) * (1.0f / DM) + RMS_EPS);
#pragma unroll
    for (int j = 0; j < 4; ++j) {
        const float4 gg = ((const float4*)g)[lane + 64 * j];
        ushort4 o; o.x = f2bf(v[j].x * rs * gg.x); o.y = f2bf(v[j].y * rs * gg.y); o.z = f2bf(v[j].z * rs * gg.z); o.w = f2bf(v[j].w * rs * gg.w);
        ((ushort4*)(out + (size_t)row * DM))[lane + 64 * j] = o;
    }
}
__global__ void k_cvt_bf16(const float* __restrict__ in, bf16_t* __restrict__ out, size_t n) {
    for (size_t i = (size_t)blockIdx.x * blockDim.x + threadIdx.x; i < n; i += (size_t)gridDim.x * blockDim.x) out[i] = f2bf(in[i]);
}
__global__ __launch_bounds__(256) void k_rowsq(const float* __restrict__ x, float* __restrict__ rsq) {
    const int row = blockIdx.x * 4 + (threadIdx.x >> 6), lane = threadIdx.x & 63;
    const float4* xr = (const float4*)(x + (size_t)row * DM);
    float s = 0.f;
#pragma unroll
    for (int j = 0; j < 4; ++j) { const float4 v = xr[lane + 64 * j]; s += v.x * v.x + v.y * v.y + v.z * v.z + v.w * v.w; }
    s = wave_sum(s);
    if (lane < 16) rsq[(size_t)row * 16 + lane] = lane == 0 ? s : 0.f;
}
__global__ __launch_bounds__(256) void k_final_norm(float* __restrict__ x, const float* __restrict__ rsq, const float* __restrict__ g) {
    const int row = blockIdx.x * 4 + (threadIdx.x >> 6), lane = threadIdx.x & 63;
    const float rs = rs_from(rsq + (size_t)row * 16);
    float4* xr = (float4*)(x + (size_t)row * DM);
#pragma unroll
    for (int j = 0; j < 4; ++j) { float4 v = xr[lane + 64 * j]; const float4 gg = ((const float4*)g)[lane + 64 * j];
        v.x *= rs * gg.x; v.y *= rs * gg.y; v.z *= rs * gg.z; v.w *= rs * gg.w; xr[lane + 64 * j] = v; }
}

template <class Epi>
__global__ __launch_bounds__(256) void ngemm(const bf16_t* __restrict__ A, const float* __restrict__ Bm, const float* __restrict__ gk, int lda, int ldb, int K, int pad_, Epi e) {
    __shared__ float As[16][65];
    __shared__ float Bs[16][64];
    const int tid = threadIdx.x, tx = tid & 15, ty = tid >> 4;
    const int r0 = blockIdx.y * 64, c0 = blockIdx.x * 64;
    float acc[4][4];
#pragma unroll
    for (int i = 0; i < 4; ++i)
#pragma unroll
        for (int j = 0; j < 4; ++j) acc[i][j] = 0.f;
    for (int k0 = 0; k0 < K; k0 += 16) {
        { const int row = tid >> 2, kq = (tid & 3) * 4; const ushort4 a = *(const ushort4*)(A + (size_t)(r0 + row) * lda + k0 + kq);
          As[kq + 0][row] = bf2f(a.x); As[kq + 1][row] = bf2f(a.y); As[kq + 2][row] = bf2f(a.z); As[kq + 3][row] = bf2f(a.w); }
        { const int k = tid >> 4, n4 = (tid & 15) * 4; float4 b = *(const float4*)(Bm + (size_t)(k0 + k) * ldb + c0 + n4);
          const float gg = gk ? gk[k0 + k] : 1.0f; Bs[k][n4] = b.x * gg; Bs[k][n4 + 1] = b.y * gg; Bs[k][n4 + 2] = b.z * gg; Bs[k][n4 + 3] = b.w * gg; }
        __syncthreads();
#pragma unroll
        for (int kk = 0; kk < 16; ++kk) {
            float a[4], b[4];
#pragma unroll
            for (int i = 0; i < 4; ++i) { a[i] = As[kk][ty * 4 + i]; b[i] = Bs[kk][tx * 4 + i]; }
#pragma unroll
            for (int i = 0; i < 4; ++i)
#pragma unroll
                for (int j = 0; j < 4; ++j) acc[i][j] += a[i] * b[j];
        }
        __syncthreads();
    }
#pragma unroll
    for (int i = 0; i < 4; ++i)
#pragma unroll
        for (int j = 0; j < 4; ++j) e(r0 + ty * 4 + i, c0 + tx * 4 + j, acc[i][j]);
}
struct NEpiProj { bf16_t* O; __device__ void operator()(int r, int c, float v) const {
    const float sc = c < 512 ? QSCALE : ((c >= C_RK && c < C_RV) ? RKSCALE : 1.0f); O[(size_t)r * NPROJ + c] = f2bf(v * sc); } };
struct NEpiRes { const float* base; float* out; bf16_t* xb; __device__ void operator()(int r, int c, float v) const {
    const size_t i = (size_t)r * DM + c; const float y = base[i] + v; out[i] = y; xb[i] = f2bf(y); } };
struct NEpiScaleBf16 { bf16_t* O; const float* rsq; int ldo; int row_off; __device__ void operator()(int r, int c, float v) const {
    const float rs = rsq ? rs_from(rsq + (size_t)(r + row_off) * 16) : 1.0f; O[(size_t)r * ldo + c] = f2bf(v * rs); } };
struct NEpiPle { float* out; const bf16_t* pw; const float* rsq; __device__ void operator()(int r, int c, float v) const {
    const size_t i = (size_t)r * DM + c; const float rs = rs_from(rsq + (size_t)r * 16); out[i] = out[i] + bf2f(pw[i]) * sigmoidf_(v * rs); } };

__global__ void k_kmean(const bf16_t* __restrict__ proj, float* __restrict__ km) {
    const int bhb = blockIdx.x, d = threadIdx.x, blk = bhb & 63, h = (bhb >> 6) & 7, b = bhb >> 9;
    float s = 0.f;
    for (int j = 0; j < 256; ++j) s += bf2f(proj[(size_t)(b * SEQ + blk * 256 + j) * NPROJ + C_MK + h * 64 + d]);
    km[(size_t)bhb * 64 + d] = s;
}

__device__ __forceinline__ void gate_task(int bh, int i, const bf16_t* __restrict__ proj, const float* __restrict__ kmsum, u32* __restrict__ sel,
                                          unsigned short* __restrict__ seg, int* __restrict__ cnt, unsigned char* lds_raw) {
    float* km = (float*)lds_raw; int* cntL = (int*)(lds_raw + 16384);
    const int tid = threadIdx.x, b = bh >> 3, h = bh & 7;
    for (int e = tid; e < i * 64; e += blockDim.x) km[e] = kmsum[(size_t)bh * 4096 + e] * (1.0f / 256.0f);
    if (tid < 64) cntL[tid] = 0;
    __syncthreads();
    if (tid < 256) {
        const int t = i * 256 + tid; const size_t row = (size_t)b * SEQ + t;
        float q[64];
        const uint4* qp = (const uint4*)(proj + row * NPROJ + C_MQ + h * 64);
#pragma unroll
        for (int c = 0; c < 8; ++c) { const uint4 u = qp[c];
            q[c * 8 + 0] = __uint_as_float(u.x << 16); q[c * 8 + 1] = __uint_as_float(u.x & 0xffff0000u);
            q[c * 8 + 2] = __uint_as_float(u.y << 16); q[c * 8 + 3] = __uint_as_float(u.y & 0xffff0000u);
            q[c * 8 + 4] = __uint_as_float(u.z << 16); q[c * 8 + 5] = __uint_as_float(u.z & 0xffff0000u);
            q[c * 8 + 6] = __uint_as_float(u.w << 16); q[c * 8 + 7] = __uint_as_float(u.w & 0xffff0000u); }
        float v0 = -INFINITY, v1 = -INFINITY, v2 = -INFINITY; int i0 = 0, i1 = 0, i2 = 0;
        for (int n = 0; n < i; ++n) {
            const float4* kr = (const float4*)(km + n * 64);
            float d0 = 0.f, d1 = 0.f;
#pragma unroll
            for (int c = 0; c < 16; c += 2) { const float4 a = kr[c], bb = kr[c + 1];
                d0 += q[c * 4] * a.x + q[c * 4 + 1] * a.y + q[c * 4 + 2] * a.z + q[c * 4 + 3] * a.w;
                d1 += q[c * 4 + 4] * bb.x + q[c * 4 + 5] * bb.y + q[c * 4 + 6] * bb.z + q[c * 4 + 7] * bb.w; }
            const float v = d0 + d1;
            if (v > v0) { v2 = v1; i2 = i1; v1 = v0; i1 = i0; v0 = v; i0 = n; }
            else if (v > v1) { v2 = v1; i2 = i1; v1 = v; i1 = n; }
            else if (v > v2) { v2 = v; i2 = n; }
        }
        const int nv = i < 3 ? i : 3;
        sel[row * 8 + h] = (u32)i0 | ((u32)i1 << 8) | ((u32)i2 << 16) | ((u32)nv << 24);
#pragma unroll
        for (int s = 0; s < 3; ++s) if (s < nv) { const int n = s == 0 ? i0 : (s == 1 ? i1 : i2);
            const int pos = atomicAdd(&cntL[n], 1);
            seg[(((size_t)bh * 64 + n) * 64 + i) * 256 + pos] = (unsigned short)((tid << 2) | s); }
    }
    __syncthreads();
    if (tid < i) cnt[((size_t)bh * 64 + tid) * 64 + i] = cntL[tid];
    __syncthreads();
}
__global__ __launch_bounds__(512) void k_gate(const bf16_t* proj, const float* kmsum, u32* sel, unsigned short* seg, int* cnt) {
    __shared__ __attribute__((aligned(16))) unsigned char lds[16384 + 256];
    const int task = blockIdx.x, bh = task / 63, i = 1 + task % 63;
    gate_task(bh, i, proj, kmsum, sel, seg, cnt, lds);
}
__global__ void k_sel_block0(u32* sel) {
    const int g = blockIdx.x * blockDim.x + threadIdx.x;
    const int h = g & 7, t = (g >> 3) & 255, b = g >> 11;
    sel[((size_t)b * SEQ + t) * 8 + h] = 0u;
}

__global__ __launch_bounds__(256) void k_moba_naive(const bf16_t* __restrict__ proj, const u32* __restrict__ sel, bf16_t* __restrict__ mix) {
    const int gid = blockIdx.x * 256 + threadIdx.x; const int t = gid & (SEQ - 1), bh = gid >> 14, b = bh >> 3, h = bh & 7;
    const size_t row = (size_t)b * SEQ + t;
    float q[64], acc[64];
    { const uint4* qp = (const uint4*)(proj + row * NPROJ + C_MQ + h * 64);
#pragma unroll
      for (int c = 0; c < 8; ++c) { const uint4 u = qp[c];
        q[c * 8 + 0] = __uint_as_float(u.x << 16); q[c * 8 + 1] = __uint_as_float(u.x & 0xffff0000u);
        q[c * 8 + 2] = __uint_as_float(u.y << 16); q[c * 8 + 3] = __uint_as_float(u.y & 0xffff0000u);
        q[c * 8 + 4] = __uint_as_float(u.z << 16); q[c * 8 + 5] = __uint_as_float(u.z & 0xffff0000u);
        q[c * 8 + 6] = __uint_as_float(u.w << 16); q[c * 8 + 7] = __uint_as_float(u.w & 0xffff0000u); } }
#pragma unroll
    for (int d = 0; d < 64; ++d) acc[d] = 0.f;
    const u32 sp = sel[row * 8 + h]; const int nv = sp >> 24, own = t >> 8;
    const float slope2 = exp2f(-(float)(h + 1)) * LOG2E;
    float m = -1e30f, l = 0.f;
    for (int s = 0; s <= nv; ++s) {
        const int blk = s < nv ? (int)((sp >> (8 * s)) & 255u) : own;
        const int nk = s < nv ? 256 : (t & 255) + 1;
        for (int j = 0; j < nk; ++j) {
            const int kp = blk * 256 + j;
            const uint4* kr = (const uint4*)(proj + ((size_t)b * SEQ + kp) * NPROJ + C_MK + h * 64);
            float dot = 0.f;
#pragma unroll
            for (int c = 0; c < 8; ++c) { const uint4 u = kr[c];
                dot += q[c * 8 + 0] * __uint_as_float(u.x << 16) + q[c * 8 + 1] * __uint_as_float(u.x & 0xffff0000u)
                     + q[c * 8 + 2] * __uint_as_float(u.y << 16) + q[c * 8 + 3] * __uint_as_float(u.y & 0xffff0000u)
                     + q[c * 8 + 4] * __uint_as_float(u.z << 16) + q[c * 8 + 5] * __uint_as_float(u.z & 0xffff0000u)
                     + q[c * 8 + 6] * __uint_as_float(u.w << 16) + q[c * 8 + 7] * __uint_as_float(u.w & 0xffff0000u); }
            const float sc = dot - slope2 * (float)(t - kp);
            if (sc > m) { const float f = exp2f(m - sc); l *= f;
#pragma unroll
                for (int d = 0; d < 64; ++d) acc[d] *= f;
                m = sc; }
            const float p = exp2f(sc - m); l += p;
            const uint4* vr = (const uint4*)(proj + ((size_t)b * SEQ + kp) * NPROJ + C_MV + h * 64);
#pragma unroll
            for (int c = 0; c < 8; ++c) { const uint4 u = vr[c];
                acc[c * 8 + 0] += p * __uint_as_float(u.x << 16); acc[c * 8 + 1] += p * __uint_as_float(u.x & 0xffff0000u);
                acc[c * 8 + 2] += p * __uint_as_float(u.y << 16); acc[c * 8 + 3] += p * __uint_as_float(u.y & 0xffff0000u);
                acc[c * 8 + 4] += p * __uint_as_float(u.z << 16); acc[c * 8 + 5] += p * __uint_as_float(u.z & 0xffff0000u);
                acc[c * 8 + 6] += p * __uint_as_float(u.w << 16); acc[c * 8 + 7] += p * __uint_as_float(u.w & 0xffff0000u); }
        }
    }
    const float il = 1.0f / l;
#pragma unroll
    for (int d = 0; d < 64; ++d) mix[row * DM + h * 64 + d] = f2bf(acc[d] * il);
}

__global__ __launch_bounds__(256) void k_ret_naive(const bf16_t* __restrict__ proj, float* __restrict__ retraw) {
    const int tl = threadIdx.x & 63, eq = threadIdx.x >> 6, t = blockIdx.x * 64 + tl, bh = blockIdx.y, b = bh >> 2, h = bh & 3;
    const size_t row = (size_t)b * SEQ + t;
    float q[128], acc[32];
    { const uint4* qp = (const uint4*)(proj + row * NPROJ + C_RQ + h * 128);
#pragma unroll
      for (int c = 0; c < 16; ++c) { const uint4 u = qp[c];
        q[c * 8 + 0] = __uint_as_float(u.x << 16); q[c * 8 + 1] = __uint_as_float(u.x & 0xffff0000u);
        q[c * 8 + 2] = __uint_as_float(u.y << 16); q[c * 8 + 3] = __uint_as_float(u.y & 0xffff0000u);
        q[c * 8 + 4] = __uint_as_float(u.z << 16); q[c * 8 + 5] = __uint_as_float(u.z & 0xffff0000u);
        q[c * 8 + 6] = __uint_as_float(u.w << 16); q[c * 8 + 7] = __uint_as_float(u.w & 0xffff0000u); } }
#pragma unroll
    for (int e = 0; e < 32; ++e) acc[e] = 0.f;
    const float log2g = log2f(1.0f - exp2f(-5.0f - (float)h));
    const int smax = blockIdx.x * 64 + 63;
    for (int s = 0; s <= smax; ++s) {
        const uint4* kr = (const uint4*)(proj + ((size_t)b * SEQ + s) * NPROJ + C_RK + h * 128);
        float dot = 0.f;
#pragma unroll
        for (int c = 0; c < 16; ++c) { const uint4 u = kr[c];
            dot += q[c * 8 + 0] * __uint_as_float(u.x << 16) + q[c * 8 + 1] * __uint_as_float(u.x & 0xffff0000u)
                 + q[c * 8 + 2] * __uint_as_float(u.y << 16) + q[c * 8 + 3] * __uint_as_float(u.y & 0xffff0000u)
                 + q[c * 8 + 4] * __uint_as_float(u.z << 16) + q[c * 8 + 5] * __uint_as_float(u.z & 0xffff0000u)
                 + q[c * 8 + 6] * __uint_as_float(u.w << 16) + q[c * 8 + 7] * __uint_as_float(u.w & 0xffff0000u); }
        const float w = s <= t ? dot * exp2f((float)(t - s) * log2g) : 0.f;
        const uint4* vr = (const uint4*)(proj + ((size_t)b * SEQ + s) * NPROJ + C_RV + h * 128 + eq * 32);
#pragma unroll
        for (int c = 0; c < 4; ++c) { const uint4 u = vr[c];
            acc[c * 8 + 0] += w * __uint_as_float(u.x << 16); acc[c * 8 + 1] += w * __uint_as_float(u.x & 0xffff0000u);
            acc[c * 8 + 2] += w * __uint_as_float(u.y << 16); acc[c * 8 + 3] += w * __uint_as_float(u.y & 0xffff0000u);
            acc[c * 8 + 4] += w * __uint_as_float(u.z << 16); acc[c * 8 + 5] += w * __uint_as_float(u.z & 0xffff0000u);
            acc[c * 8 + 6] += w * __uint_as_float(u.w << 16); acc[c * 8 + 7] += w * __uint_as_float(u.w & 0xffff0000u); }
    }
#pragma unroll
    for (int e = 0; e < 32; ++e) retraw[row * 512 + h * 128 + eq * 32 + e] = acc[e];
}
__global__ __launch_bounds__(256) void k_ret_post(const float* __restrict__ retraw, const bf16_t* __restrict__ proj, const float* __restrict__ gain, bf16_t* __restrict__ mix) {
    const int wid = blockIdx.x * 4 + (threadIdx.x >> 6), lane = threadIdx.x & 63; const int h = wid & 3; const size_t row = wid >> 2;
    const float a = retraw[row * 512 + h * 128 + lane], c = retraw[row * 512 + h * 128 + 64 + lane];
    const float mu = wave_sum(a + c) * (1.0f / 128.0f); const float da = a - mu, dc = c - mu;
    const float var = wave_sum(da * da + dc * dc) * (1.0f / 128.0f); const float r = rsqrtf(var + GN_EPS);
    const float g0 = bf2f(proj[row * NPROJ + C_RG + h * 128 + lane]), g1 = bf2f(proj[row * NPROJ + C_RG + h * 128 + 64 + lane]);
    mix[row * DM + 512 + h * 128 + lane] = f2bf(da * r * gain[h * 128 + lane] * (g0 * sigmoidf_(g0)));
    mix[row * DM + 512 + h * 128 + 64 + lane] = f2bf(dc * r * gain[h * 128 + 64 + lane] * (g1 * sigmoidf_(g1)));
}
__global__ void k_conv_act(const bf16_t* __restrict__ U, bf16_t* __restrict__ act, const float* __restrict__ cw, const float* __restrict__ cb) {
    const size_t n = (size_t)SEQ * FF;
    for (size_t i = (size_t)blockIdx.x * blockDim.x + threadIdx.x; i < n; i += (size_t)gridDim.x * blockDim.x) {
        const int t = (int)(i / FF), c = (int)(i % FF);
        const float u0 = bf2f(U[i]), u1 = t >= 1 ? bf2f(U[i - FF]) : 0.f, u2 = t >= 2 ? bf2f(U[i - 2 * FF]) : 0.f;
        const float y = cb[c] + cw[c] * u2 + cw[FF + c] * u1 + cw[2 * FF + c] * u0;
        act[i] = f2bf(gelu_tanh(y) * bf2f(act[i]));
    }
}

extern "C" void kernel_launch(void* const* d_in, const int* in_sizes, int n_in, void* d_out, int out_size, void* d_ws, size_t ws_size, hipStream_t stream) {
    if (n_in != 16 || out_size != MT * DM || ws_size < WS_END) { fprintf(stderr, "kernel_launch: unexpected shapes (n_in %d out %d ws %zu)\n", n_in, out_size, ws_size); return; }
    const float* x = (const float*)d_in[0]; const float* p = (const float*)d_in[1]; const float* attn_norm = (const float*)d_in[2]; const float* w_in = (const float*)d_in[3];
    const float* ret_norm = (const float*)d_in[4]; const float* w_out = (const float*)d_in[5]; const float* ffn_norm = (const float*)d_in[6]; const float* w_up = (const float*)d_in[7];
    const float* w_gate = (const float*)d_in[8]; const float* conv_w = (const float*)d_in[9]; const float* conv_b = (const float*)d_in[10]; const float* w_down = (const float*)d_in[11];
    const float* ple_norm = (const float*)d_in[12]; const float* w_ple = (const float*)d_in[13]; const float* w_ple_gate = (const float*)d_in[14]; const float* final_norm = (const float*)d_in[15];
    unsigned char* ws = (unsigned char*)d_ws; float* out = (float*)d_out;
    bf16_t* XN = (bf16_t*)(ws + WS_R1); bf16_t* MIX = (bf16_t*)(ws + WS_R1); bf16_t* PW = (bf16_t*)(ws + WS_R1);
    bf16_t* XB = (bf16_t*)(ws + WS_R2); float* RETRAW = (float*)(ws + WS_R2);
    bf16_t* PROJ = (bf16_t*)(ws + WS_PROJ); bf16_t* ACT = (bf16_t*)(ws + WS_PROJ); bf16_t* UH = (bf16_t*)(ws + WS_UH);
    bf16_t* PB = (bf16_t*)(ws + WS_PB); float* RSQ = (float*)(ws + WS_RSQ);
    float* KM = (float*)(ws + WS_KMEAN); u32* SEL = (u32*)(ws + WS_SEL); unsigned short* SEG = (unsigned short*)(ws + WS_SEG); int* CNT = (int*)(ws + WS_CNT);

    k_rmsnorm_bf16<<<MT / 4, 256, 0, stream>>>(x, attn_norm, XN);
    k_cvt_bf16<<<2048, 256, 0, stream>>>(p, PB, (size_t)MT * PLED);
    ngemm<NEpiProj><<<dim3(NPROJ / 64, MT / 64), 256, 0, stream>>>(XN, w_in, nullptr, DM, NPROJ, DM, 0, NEpiProj{PROJ});
    k_kmean<<<16 * 64, 64, 0, stream>>>(PROJ, KM);
    k_sel_block0<<<BATCH * 256 * 8 / 256, 256, 0, stream>>>(SEL);
    k_gate<<<16 * 63, 512, 0, stream>>>(PROJ, KM, SEL, SEG, CNT);
    k_moba_naive<<<16 * SEQ / 256, 256, 0, stream>>>(PROJ, SEL, MIX);
    k_ret_naive<<<dim3(SEQ / 64, BATCH * RH), 256, 0, stream>>>(PROJ, RETRAW);
    k_ret_post<<<MT * RH / 4, 256, 0, stream>>>(RETRAW, PROJ, ret_norm, MIX);
    ngemm<NEpiRes><<<dim3(DM / 64, MT / 64), 256, 0, stream>>>(MIX, w_out, nullptr, DM, DM, DM, 0, NEpiRes{x, out, XB});
    k_rowsq<<<MT / 4, 256, 0, stream>>>(out, RSQ);
    for (int hb = 0; hb < 2; ++hb) {
        const bf16_t* Ah = XB + (size_t)hb * SEQ * DM; bf16_t* acth = ACT + (size_t)hb * SEQ * FF;
        ngemm<NEpiScaleBf16><<<dim3(FF / 64, SEQ / 64), 256, 0, stream>>>(Ah, w_up, ffn_norm, DM, FF, DM, 0, NEpiScaleBf16{UH, RSQ, FF, hb * SEQ});
        ngemm<NEpiScaleBf16><<<dim3(FF / 64, SEQ / 64), 256, 0, stream>>>(Ah, w_gate, ffn_norm, DM, FF, DM, 0, NEpiScaleBf16{acth, RSQ, FF, hb * SEQ});
        k_conv_act<<<4096, 256, 0, stream>>>(UH, acth, conv_w, conv_b);
    }
    ngemm<NEpiRes><<<dim3(DM / 64, MT / 64), 256, 0, stream>>>(ACT, w_down, nullptr, FF, DM, FF, 0, NEpiRes{out, out, XB});
    k_rowsq<<<MT / 4, 256, 0, stream>>>(out, RSQ + (size_t)MT * 16);
    ngemm<NEpiScaleBf16><<<dim3(DM / 64, MT / 64), 256, 0, stream>>>(PB, w_ple, nullptr, PLED, DM, PLED, 0, NEpiScaleBf16{PW, nullptr, DM, 0});
    ngemm<NEpiPle><<<dim3(DM / 64, MT / 64), 256, 0, stream>>>(XB, w_ple_gate, ple_norm, DM, DM, DM, 0, NEpiPle{out, PW, RSQ + (size_t)MT * 16});
    k_rowsq<<<MT / 4, 256, 0, stream>>>(out, RSQ + (size_t)2 * MT * 16);
    k_final_norm<<<MT / 4, 256, 0, stream>>>(out, RSQ + (size_t)2 * MT * 16, final_norm);
}
```

```cpp
#include <hip/hip_runtime.h>
#include <stdint.h>
#include <math.h>
#include <cstdio>

typedef unsigned short bf16_t;
typedef unsigned int u32;

constexpr int BATCH = 2, SEQ = 16384, MT = BATCH * SEQ, DM = 1024, NPROJ = 3584, FF = 2816, PLED = 256;
constexpr int MH = 8, MD = 64, RH = 4, RD = 128, NBLK = 64, BLK = 256;
constexpr int C_MQ = 0, C_MK = 512, C_MV = 1024, C_RQ = 1536, C_RK = 2048, C_RV = 2560, C_RG = 3072;
constexpr float RMS_EPS = 1e-6f, GN_EPS = 1e-5f;
constexpr float LOG2E = 1.4426950408889634f;
constexpr float QSCALE = 0.125f * LOG2E;
constexpr float RKSCALE = 0.08838834764831845f;

constexpr size_t MiB = (size_t)1 << 20;
constexpr size_t WS_CTL = 0, WS_WIN = 1 * MiB, WS_WOUT = 8 * MiB, WS_WUG = 10 * MiB, WS_WDOWN = 21 * MiB, WS_WPG = 27 * MiB, WS_WPLE = 29 * MiB;
constexpr size_t WS_RSQ = 30 * MiB;
constexpr size_t WS_PB = 36 * MiB;
constexpr size_t WS_R2 = 52 * MiB;
constexpr size_t WS_R1 = 116 * MiB;
constexpr size_t WS_SEG = 180 * MiB;
constexpr size_t WS_KVT = 212 * MiB;
constexpr size_t WS_STT = 244 * MiB;
constexpr size_t WS_PARTL = 260 * MiB;
constexpr size_t WS_SEL = 264 * MiB;
constexpr size_t WS_CNT = 265 * MiB;
constexpr size_t WS_KMEAN = WS_CNT + 512 * 1024;
constexpr size_t WS_PROJ = 266 * MiB;
constexpr size_t WS_END = 490 * MiB;
constexpr size_t WS_UH = 116 * MiB;

__device__ __forceinline__ float bf2f(bf16_t v) { return __uint_as_float(((u32)v) << 16); }
__device__ __forceinline__ bf16_t f2bf(float f) { u32 u = __float_as_uint(f); return (bf16_t)((u + 0x7fffu + ((u >> 16) & 1u)) >> 16); }
__device__ __forceinline__ float wave_sum(float v) {
#pragma unroll
    for (int o = 1; o < 64; o <<= 1) v += __shfl_xor(v, o);
    return v;
}
__device__ __forceinline__ float rs_from(const float* p) {
    float s = 0.f;
#pragma unroll
    for (int i = 0; i < 16; ++i) s += p[i];
    return rsqrtf(s * (1.0f / DM) + RMS_EPS);
}
__device__ __forceinline__ float gelu_tanh(float x) {
    const float z = 0.7978845608028654f * (x + 0.044715f * x * x * x);
    return x / (1.0f + __expf(-2.0f * z));
}
__device__ __forceinline__ float sigmoidf_(float x) { return 1.0f / (1.0f + __expf(-x)); }

__global__ __launch_bounds__(256) void k_rmsnorm_bf16(const float* __restrict__ x, const float* __restrict__ g, bf16_t* __restrict__ out) {
    const int row = blockIdx.x * 4 + (threadIdx.x >> 6), lane = threadIdx.x & 63;
    const float4* xr = (const float4*)(x + (size_t)row * DM);
    float4 v[4]; float s = 0.f;
#pragma unroll
    for (int j = 0; j < 4; ++j) { v[j] = xr[lane + 64 * j]; s += v[j].x * v[j].x + v[j].y * v[j].y + v[j].z * v[j].z + v[j].w * v[j].w; }
    const float rs = rsqrtf(wave_sum(s) * (1.0f / DM) + RMS_EPS);
#pragma unroll
    for (int j = 0; j < 4; ++j) {
        const float4 gg = ((const float4*)g)[lane + 64 * j];
        ushort4 o; o.x = f2bf(v[j].x * rs * gg.x); o.y = f2bf(v[j].y * rs * gg.y); o.z = f2bf(v[j].z * rs * gg.z); o.w = f2bf(v[j].w * rs * gg.w);
        ((ushort4*)(out + (size_t)row * DM))[lane + 64 * j] = o;
    }
}
__global__ void k_cvt_bf16(const float* __restrict__ in, bf16_t* __restrict__ out, size_t n) {
    for (size_t i = (size_t)blockIdx.x * blockDim.x + threadIdx.x; i < n; i += (size_t)gridDim.x * blockDim.x) out[i] = f2bf(in[i]);
}
__global__ __launch_bounds__(256) void k_rowsq(const float* __restrict__ x, float* __restrict__ rsq) {
    const int row = blockIdx.x * 4 + (threadIdx.x >> 6), lane = threadIdx.x & 63;
    const float4* xr = (const float4*)(x + (size_t)row * DM);
    float s = 0.f;
#pragma unroll
    for (int j = 0; j < 4; ++j) { const float4 v = xr[lane + 64 * j]; s += v.x * v.x + v.y * v.y + v.z * v.z + v.w * v.w; }
    s = wave_sum(s);
    if (lane < 16) rsq[(size_t)row * 16 + lane] = lane == 0 ? s : 0.f;
}
__global__ __launch_bounds__(256) void k_final_norm(float* __restrict__ x, const float* __restrict__ rsq, const float* __restrict__ g) {
    const int row = blockIdx.x * 4 + (threadIdx.x >> 6), lane = threadIdx.x & 63;
    const float rs = rs_from(rsq + (size_t)row * 16);
    float4* xr = (float4*)(x + (size_t)row * DM);
#pragma unroll
    for (int j = 0; j < 4; ++j) { float4 v = xr[lane + 64 * j]; const float4 gg = ((const float4*)g)[lane + 64 * j];
        v.x *= rs * gg.x; v.y *= rs * gg.y; v.z *= rs * gg.z; v.w *= rs * gg.w; xr[lane + 64 * j] = v; }
}

template <class Epi>
__global__ __launch_bounds__(256) void ngemm(const bf16_t* __restrict__ A, const float* __restrict__ Bm, const float* __restrict__ gk, int lda, int ldb, int K, int pad_, Epi e) {
    __shared__ float As[16][65];
    __shared__ float Bs[16][64];
    const int tid = threadIdx.x, tx = tid & 15, ty = tid >> 4;
    const int r0 = blockIdx.y * 64, c0 = blockIdx.x * 64;
    float acc[4][4];
#pragma unroll
    for (int i = 0; i < 4; ++i)
#pragma unroll
        for (int j = 0; j < 4; ++j) acc[i][j] = 0.f;
    for (int k0 = 0; k0 < K; k0 += 16) {
        { const int row = tid >> 2, kq = (tid & 3) * 4; const ushort4 a = *(const ushort4*)(A + (size_t)(r0 + row) * lda + k0 + kq);
          As[kq + 0][row] = bf2f(a.x); As[kq + 1][row] = bf2f(a.y); As[kq + 2][row] = bf2f(a.z); As[kq + 3][row] = bf2f(a.w); }
        { const int k = tid >> 4, n4 = (tid & 15) * 4; float4 b = *(const float4*)(Bm + (size_t)(k0 + k) * ldb + c0 + n4);
          const float gg = gk ? gk[k0 + k] : 1.0f; Bs[k][n4] = b.x * gg; Bs[k][n4 + 1] = b.y * gg; Bs[k][n4 + 2] = b.z * gg; Bs[k][n4 + 3] = b.w * gg; }
        __syncthreads();
#pragma unroll
        for (int kk = 0; kk < 16; ++kk) {
            float a[4], b[4];
#pragma unroll
            for (int i = 0; i < 4; ++i) { a[i] = As[kk][ty * 4 + i]; b[i] = Bs[kk][tx * 4 + i]; }
#pragma unroll
            for (int i = 0; i < 4; ++i)
#pragma unroll
                for (int j = 0; j < 4; ++j) acc[i][j] += a[i] * b[j];
        }
        __syncthreads();
    }
#pragma unroll
    for (int i = 0; i < 4; ++i)
#pragma unroll
        for (int j = 0; j < 4; ++j) e(r0 + ty * 4 + i, c0 + tx * 4 + j, acc[i][j]);
}
struct NEpiProj { bf16_t* O; __device__ void operator()(int r, int c, float v) const {
    const float sc = c < 512 ? QSCALE : ((c >= C_RK && c < C_RV) ? RKSCALE : 1.0f); O[(size_t)r * NPROJ + c] = f2bf(v * sc); } };
struct NEpiRes { const float* base; float* out; bf16_t* xb; __device__ void operator()(int r, int c, float v) const {
    const size_t i = (size_t)r * DM + c; const float y = base[i] + v; out[i] = y; xb[i] = f2bf(y); } };
struct NEpiScaleBf16 { bf16_t* O; const float* rsq; int ldo; int row_off; __device__ void operator()(int r, int c, float v) const {
    const float rs = rsq ? rs_from(rsq + (size_t)(r + row_off) * 16) : 1.0f; O[(size_t)r * ldo + c] = f2bf(v * rs); } };
struct NEpiPle { float* out; const bf16_t* pw; const float* rsq; __device__ void operator()(int r, int c, float v) const {
    const size_t i = (size_t)r * DM + c; const float rs = rs_from(rsq + (size_t)r * 16); out[i] = out[i] + bf2f(pw[i]) * sigmoidf_(v * rs); } };

__global__ void k_kmean(const bf16_t* __restrict__ proj, float* __restrict__ km) {
    const int bhb = blockIdx.x, d = threadIdx.x, blk = bhb & 63, h = (bhb >> 6) & 7, b = bhb >> 9;
    float s = 0.f;
    for (int j = 0; j < 256; ++j) s += bf2f(proj[(size_t)(b * SEQ + blk * 256 + j) * NPROJ + C_MK + h * 64 + d]);
    km[(size_t)bhb * 64 + d] = s;
}

__device__ __forceinline__ void gate_task(int bh, int i, const bf16_t* __restrict__ proj, const float* __restrict__ kmsum, u32* __restrict__ sel,
                                          unsigned short* __restrict__ seg, int* __restrict__ cnt, unsigned char* lds_raw) {
    float* km = (float*)lds_raw; int* cntL = (int*)(lds_raw + 16384);
    const int tid = threadIdx.x, b = bh >> 3, h = bh & 7;
    for (int e = tid; e < i * 64; e += blockDim.x) km[e] = kmsum[(size_t)bh * 4096 + e] * (1.0f / 256.0f);
    if (tid < 64) cntL[tid] = 0;
    __syncthreads();
    if (tid < 256) {
        const int t = i * 256 + tid; const size_t row = (size_t)b * SEQ + t;
        float q[64];
        const uint4* qp = (const uint4*)(proj + row * NPROJ + C_MQ + h * 64);
#pragma unroll
        for (int c = 0; c < 8; ++c) { const uint4 u = qp[c];
            q[c * 8 + 0] = __uint_as_float(u.x << 16); q[c * 8 + 1] = __uint_as_float(u.x & 0xffff0000u);
            q[c * 8 + 2] = __uint_as_float(u.y << 16); q[c * 8 + 3] = __uint_as_float(u.y & 0xffff0000u);
            q[c * 8 + 4] = __uint_as_float(u.z << 16); q[c * 8 + 5] = __uint_as_float(u.z & 0xffff0000u);
            q[c * 8 + 6] = __uint_as_float(u.w << 16); q[c * 8 + 7] = __uint_as_float(u.w & 0xffff0000u); }
        float v0 = -INFINITY, v1 = -INFINITY, v2 = -INFINITY; int i0 = 0, i1 = 0, i2 = 0;
        for (int n = 0; n < i; ++n) {
            const float4* kr = (const float4*)(km + n * 64);
            float d0 = 0.f, d1 = 0.f;
#pragma unroll
            for (int c = 0; c < 16; c += 2) { const float4 a = kr[c], bb = kr[c + 1];
                d0 += q[c * 4] * a.x + q[c * 4 + 1] * a.y + q[c * 4 + 2] * a.z + q[c * 4 + 3] * a.w;
                d1 += q[c * 4 + 4] * bb.x + q[c * 4 + 5] * bb.y + q[c * 4 + 6] * bb.z + q[c * 4 + 7] * bb.w; }
            const float v = d0 + d1;
            if (v > v0) { v2 = v1; i2 = i1; v1 = v0; i1 = i0; v0 = v; i0 = n; }
            else if (v > v1) { v2 = v1; i2 = i1; v1 = v; i1 = n; }
            else if (v > v2) { v2 = v; i2 = n; }
        }
        const int nv = i < 3 ? i : 3;
        sel[row * 8 + h] = (u32)i0 | ((u32)i1 << 8) | ((u32)i2 << 16) | ((u32)nv << 24);
#pragma unroll
        for (int s = 0; s < 3; ++s) if (s < nv) { const int n = s == 0 ? i0 : (s == 1 ? i1 : i2);
            const int pos = atomicAdd(&cntL[n], 1);
            seg[(((size_t)bh * 64 + n) * 64 + i) * 256 + pos] = (unsigned short)((tid << 2) | s); }
    }
    __syncthreads();
    if (tid < i) cnt[((size_t)bh * 64 + tid) * 64 + i] = cntL[tid];
    __syncthreads();
}
__global__ __launch_bounds__(512) void k_gate(const bf16_t* proj, const float* kmsum, u32* sel, unsigned short* seg, int* cnt) {
    __shared__ __attribute__((aligned(16))) unsigned char lds[16384 + 256];
    const int task = blockIdx.x, bh = task / 63, i = 1 + task % 63;
    gate_task(bh, i, proj, kmsum, sel, seg, cnt, lds);
}
__global__ void k_sel_block0(u32* sel) {
    const int g = blockIdx.x * blockDim.x + threadIdx.x;
    const int h = g & 7, t = (g >> 3) & 255, b = g >> 11;
    sel[((size_t)b * SEQ + t) * 8 + h] = 0u;
}

__global__ __launch_bounds__(256) void k_moba_naive(const bf16_t* __restrict__ proj, const u32* __restrict__ sel, bf16_t* __restrict__ mix) {
    const int gid = blockIdx.x * 256 + threadIdx.x; const int t = gid & (SEQ - 1), bh = gid >> 14, b = bh >> 3, h = bh & 7;
    const size_t row = (size_t)b * SEQ + t;
    float q[64], acc[64];
    { const uint4* qp = (const uint4*)(proj + row * NPROJ + C_MQ + h * 64);
#pragma unroll
      for (int c = 0; c < 8; ++c) { const uint4 u = qp[c];
        q[c * 8 + 0] = __uint_as_float(u.x << 16); q[c * 8 + 1] = __uint_as_float(u.x & 0xffff0000u);
        q[c * 8 + 2] = __uint_as_float(u.y << 16); q[c * 8 + 3] = __uint_as_float(u.y & 0xffff0000u);
        q[c * 8 + 4] = __uint_as_float(u.z << 16); q[c * 8 + 5] = __uint_as_float(u.z & 0xffff0000u);
        q[c * 8 + 6] = __uint_as_float(u.w << 16); q[c * 8 + 7] = __uint_as_float(u.w & 0xffff0000u); } }
#pragma unroll
    for (int d = 0; d < 64; ++d) acc[d] = 0.f;
    const u32 sp = sel[row * 8 + h]; const int nv = sp >> 24, own = t >> 8;
    const float slope2 = exp2f(-(float)(h + 1)) * LOG2E;
    float m = -1e30f, l = 0.f;
    for (int s = 0; s <= nv; ++s) {
        const int blk = s < nv ? (int)((sp >> (8 * s)) & 255u) : own;
        const int nk = s < nv ? 256 : (t & 255) + 1;
        for (int j = 0; j < nk; ++j) {
            const int kp = blk * 256 + j;
            const uint4* kr = (const uint4*)(proj + ((size_t)b * SEQ + kp) * NPROJ + C_MK + h * 64);
            float dot = 0.f;
#pragma unroll
            for (int c = 0; c < 8; ++c) { const uint4 u = kr[c];
                dot += q[c * 8 + 0] * __uint_as_float(u.x << 16) + q[c * 8 + 1] * __uint_as_float(u.x & 0xffff0000u)
                     + q[c * 8 + 2] * __uint_as_float(u.y << 16) + q[c * 8 + 3] * __uint_as_float(u.y & 0xffff0000u)
                     + q[c * 8 + 4] * __uint_as_float(u.z << 16) + q[c * 8 + 5] * __uint_as_float(u.z & 0xffff0000u)
                     + q[c * 8 + 6] * __uint_as_float(u.w << 16) + q[c * 8 + 7] * __uint_as_float(u.w & 0xffff0000u); }
            const float sc = dot - slope2 * (float)(t - kp);
            if (sc > m) { const float f = exp2f(m - sc); l *= f;
#pragma unroll
                for (int d = 0; d < 64; ++d) acc[d] *= f;
                m = sc; }
            const float p = exp2f(sc - m); l += p;
            const uint4* vr = (const uint4*)(proj + ((size_t)b * SEQ + kp) * NPROJ + C_MV + h * 64);
#pragma unroll
            for (int c = 0; c < 8; ++c) { const uint4 u = vr[c];
                acc[c * 8 + 0] += p * __uint_as_float(u.x << 16); acc[c * 8 + 1] += p * __uint_as_float(u.x & 0xffff0000u);
                acc[c * 8 + 2] += p * __uint_as_float(u.y << 16); acc[c * 8 + 3] += p * __uint_as_float(u.y & 0xffff0000u);
                acc[c * 8 + 4] += p * __uint_as_float(u.z << 16); acc[c * 8 + 5] += p * __uint_as_float(u.z & 0xffff0000u);
                acc[c * 8 + 6] += p * __uint_as_float(u.w << 16); acc[c * 8 + 7] += p * __uint_as_float(u.w & 0xffff0000u); }
        }
    }
    const float il = 1.0f / l;
#pragma unroll
    for (int d = 0; d < 64; ++d) mix[row * DM + h * 64 + d] = f2bf(acc[d] * il);
}

__global__ __launch_bounds__(256) void k_ret_naive(const bf16_t* __restrict__ proj, float* __restrict__ retraw) {
    const int tl = threadIdx.x & 63, eq = threadIdx.x >> 6, t = blockIdx.x * 64 + tl, bh = blockIdx.y, b = bh >> 2, h = bh & 3;
    const size_t row = (size_t)b * SEQ + t;
    float q[128], acc[32];
    { const uint4* qp = (const uint4*)(proj + row * NPROJ + C_RQ + h * 128);
#pragma unroll
      for (int c = 0; c < 16; ++c) { const uint4 u = qp[c];
        q[c * 8 + 0] = __uint_as_float(u.x << 16); q[c * 8 + 1] = __uint_as_float(u.x & 0xffff0000u);
        q[c * 8 + 2] = __uint_as_float(u.y << 16); q[c * 8 + 3] = __uint_as_float(u.y & 0xffff0000u);
        q[c * 8 + 4] = __uint_as_float(u.z << 16); q[c * 8 + 5] = __uint_as_float(u.z & 0xffff0000u);
        q[c * 8 + 6] = __uint_as_float(u.w << 16); q[c * 8 + 7] = __uint_as_float(u.w & 0xffff0000u); } }
#pragma unroll
    for (int e = 0; e < 32; ++e) acc[e] = 0.f;
    const float log2g = log2f(1.0f - exp2f(-5.0f - (float)h));
    const int smax = blockIdx.x * 64 + 63;
    for (int s = 0; s <= smax; ++s) {
        const uint4* kr = (const uint4*)(proj + ((size_t)b * SEQ + s) * NPROJ + C_RK + h * 128);
        float dot = 0.f;
#pragma unroll
        for (int c = 0; c < 16; ++c) { const uint4 u = kr[c];
            dot += q[c * 8 + 0] * __uint_as_float(u.x << 16) + q[c * 8 + 1] * __uint_as_float(u.x & 0xffff0000u)
                 + q[c * 8 + 2] * __uint_as_float(u.y << 16) + q[c * 8 + 3] * __uint_as_float(u.y & 0xffff0000u)
                 + q[c * 8 + 4] * __uint_as_float(u.z << 16) + q[c * 8 + 5] * __uint_as_float(u.z & 0xffff0000u)
                 + q[c * 8 + 6] * __uint_as_float(u.w << 16) + q[c * 8 + 7] * __uint_as_float(u.w & 0xffff0000u); }
        const float w = s <= t ? dot * exp2f((float)(t - s) * log2g) : 0.f;
        const uint4* vr = (const uint4*)(proj + ((size_t)b * SEQ + s) * NPROJ + C_RV + h * 128 + eq * 32);
#pragma unroll
        for (int c = 0; c < 4; ++c) { const uint4 u = vr[c];
            acc[c * 8 + 0] += w * __uint_as_float(u.x << 16); acc[c * 8 + 1] += w * __uint_as_float(u.x & 0xffff0000u);
            acc[c * 8 + 2] += w * __uint_as_float(u.y << 16); acc[c * 8 + 3] += w * __uint_as_float(u.y & 0xffff0000u);
            acc[c * 8 + 4] += w * __uint_as_float(u.z << 16); acc[c * 8 + 5] += w * __uint_as_float(u.z & 0xffff0000u);
            acc[c * 8 + 6] += w * __uint_as_float(u.w << 16); acc[c * 8 + 7] += w * __uint_as_float(u.w & 0xffff0000u); }
    }
#pragma unroll
    for (int e = 0; e < 32; ++e) retraw[row * 512 + h * 128 + eq * 32 + e] = acc[e];
}
__global__ __launch_bounds__(256) void k_ret_post(const float* __restrict__ retraw, const bf16_t* __restrict__ proj, const float* __restrict__ gain, bf16_t* __restrict__ mix) {
    const int wid = blockIdx.x * 4 + (threadIdx.x >> 6), lane = threadIdx.x & 63; const int h = wid & 3; const size_t row = wid >> 2;
    const float a = retraw[row * 512 + h * 128 + lane], c = retraw[row * 512 + h * 128 + 64 + lane];
    const float mu = wave_sum(a + c) * (1.0f / 128.0f); const float da = a - mu, dc = c - mu;
    const float var = wave_sum(da * da + dc * dc) * (1.0f / 128.0f); const float r = rsqrtf(var + GN_EPS);
    const float g0 = bf2f(proj[row * NPROJ + C_RG + h * 128 + lane]), g1 = bf2f(proj[row * NPROJ + C_RG + h * 128 + 64 + lane]);
    mix[row * DM + 512 + h * 128 + lane] = f2bf(da * r * gain[h * 128 + lane] * (g0 * sigmoidf_(g0)));
    mix[row * DM + 512 + h * 128 + 64 + lane] = f2bf(dc * r * gain[h * 128 + 64 + lane] * (g1 * sigmoidf_(g1)));
}
__global__ void k_conv_act(const bf16_t* __restrict__ U, bf16_t* __restrict__ act, const float* __restrict__ cw, const float* __restrict__ cb) {
    const size_t n = (size_t)SEQ * FF;
    for (size_t i = (size_t)blockIdx.x * blockDim.x + threadIdx.x; i < n; i += (size_t)gridDim.x * blockDim.x) {
        const int t = (int)(i / FF), c = (int)(i % FF);
        const float u0 = bf2f(U[i]), u1 = t >= 1 ? bf2f(U[i - FF]) : 0.f, u2 = t >= 2 ? bf2f(U[i - 2 * FF]) : 0.f;
        const float y = cb[c] + cw[c] * u2 + cw[FF + c] * u1 + cw[2 * FF + c] * u0;
        act[i] = f2bf(gelu_tanh(y) * bf2f(act[i]));
    }
}

namespace pg8 {
#define PG8_LAS __attribute__((address_space(3)))
typedef unsigned short bf16_t;
typedef short bf16x8 __attribute__((ext_vector_type(8)));
typedef float f32x4 __attribute__((ext_vector_type(4)));
typedef unsigned u32x4 __attribute__((ext_vector_type(4)));
constexpr int BM = 256, BK = 64, HALF = 128, HTB = HALF * BK * 2  , STAGE_BYTES = 8 * HTB, NXCD = 8, WGM = 8;

__host__ __device__ __forceinline__ int lds_byte(int r, int c) { const int st = (r >> 4) * 2 + (c >> 5), rr = r & 15, cc = c & 31, ob = rr * 64 + cc * 2; return st * 1024 + (ob ^ (((ob >> 9) & 1) << 5)); }
__host__ __device__ __forceinline__ void stage_rc(int b, int& R, int& C) { const int st = b / 1024, sb = b % 1024, swz = sb ^ (((sb >> 9) & 1) << 5); R = (st >> 1) * 16 + swz / 64; C = (st & 1) * 32 + (swz % 64) / 2; }
__host__ __device__ __forceinline__ int perm32(int rho) { const int n = rho >> 4, i = rho & 15; return 8 * (i >> 2) + 4 * n + (i & 3); }

struct Unit { int pm, pn; };
struct Gemm { const bf16_t* A; const bf16_t* Bt; int M, N, K; };

struct StaticOrder {
    int nM, nN, nwg, G, c;
    __host__ __device__ void init(int M, int N, int G_, int c_) { nM = M / BM; nN = N / BM; nwg = nM * nN; G = G_; c = c_; }
    __host__ __device__ bool next(int i, Unit& u) const {
        const long L = (long)i * G + c; if (L >= nwg) return false;
        int wgid = (int)L; { const int q = nwg / NXCD, r = nwg % NXCD, xcd = wgid % NXCD, off = wgid / NXCD; wgid = (xcd < r ? xcd * (q + 1) : r * (q + 1) + (xcd - r) * q) + off; }
        const int nig = WGM * nN, gid = wgid / nig, fm = gid * WGM, gsz = (nM - fm) < WGM ? (nM - fm) : WGM;
        u.pm = fm + ((wgid % nig) % gsz); u.pn = (wgid % nig) / gsz; return true;
    }
    __device__ __forceinline__ void a_ready(const Unit&) const {}
    __device__ __forceinline__ void done(const Unit&) const {}
};

__device__ __forceinline__ unsigned cvt_pk_bf16(float lo, float hi) { unsigned r; asm volatile("v_cvt_pk_bf16_f32 %0, %1, %2" : "=v"(r) : "v"(lo), "v"(hi)); return r; }
typedef float f32x2 __attribute__((ext_vector_type(2)));
template <class Epi, class Sched, bool ALIGN_EPI = false, bool SP2 = false>
__device__ __forceinline__ void gemm_phase(PG8_LAS unsigned char* lds, const Gemm g, const Sched& S, const Epi& E) {
    const int tid = threadIdx.x, wid = __builtin_amdgcn_readfirstlane(tid >> 6), lane = tid & 63, wr = wid >> 2, wc = wid & 3, fr = lane & 15, fq = lane >> 4;
    const int K = g.K, nt = K / BK;
    unsigned voffA[2], voffB[2];
#pragma unroll
    for (int i = 0; i < 2; ++i) { int R, C; stage_rc(tid * 16 + i * 8192, R, C); const int Rb = Epi::PERM ? ((R & ~31) + perm32(R & 31)) : R;
        voffA[i] = (unsigned)(R * K + C) * 2u; voffB[i] = (unsigned)(Rb * K + C) * 2u; }
    const size_t kstep = (size_t)(BK * 2);
    const size_t hstep = (size_t)HALF * K * 2;
    const size_t tstep = 2 * hstep;
    const unsigned ldsw = (unsigned)wid * 1024u;
    const int aoff = lds_byte(wr * 64 + fr, fq * 8), boff = lds_byte(wc * 32 + fr, fq * 8);
#define PG8_SA(b, h) (((b) * 2 + (h)) * HTB)
#define PG8_SB(b, h) ((4 + (b) * 2 + (h)) * HTB)
#define PG8_STAGE(bufoff, gbase, voff) do { _Pragma("unroll") for (int _i = 0; _i < 2; ++_i) \
        __builtin_amdgcn_global_load_lds((const unsigned*)((const char*)(gbase) + (voff)[_i]), (PG8_LAS unsigned*)(lds + (bufoff) + ldsw + _i * 8192), 16, 0, 0); } while (0)
#define PG8_LDA(dst, b, h) do { _Pragma("unroll") for (int m = 0; m < 4; ++m) _Pragma("unroll") for (int k = 0; k < 2; ++k) dst[m][k] = *(const PG8_LAS bf16x8*)(lds + PG8_SA(b, h) + aoff + m * 2048 + k * 1024); } while (0)
#define PG8_LDB(dst, b, h) do { _Pragma("unroll") for (int n = 0; n < 2; ++n) _Pragma("unroll") for (int k = 0; k < 2; ++k) dst[n][k] = *(const PG8_LAS bf16x8*)(lds + PG8_SB(b, h) + boff + n * 2048 + k * 1024); } while (0)
#define PG8_MMA(ai, bj, At, Bt) do { __builtin_amdgcn_s_setprio(1); _Pragma("unroll") for (int m = 0; m < 4; ++m) _Pragma("unroll") for (int n = 0; n < 2; ++n) _Pragma("unroll") for (int k = 0; k < 2; ++k) \
        acc[ai][bj][m][n] = __builtin_amdgcn_mfma_f32_16x16x32_bf16(Bt[n][k], At[m][k], acc[ai][bj][m][n], 0, 0, 0); __builtin_amdgcn_s_setprio(0); } while (0)
#define PG8_WAIT_V(n) asm volatile("s_waitcnt vmcnt(" #n ")" ::: "memory")
#define PG8_WAIT_L(n) asm volatile("s_waitcnt lgkmcnt(" #n ")" ::: "memory")
#define PG8_BAR __builtin_amdgcn_s_barrier()
#define PG8_SCHED __builtin_amdgcn_sched_barrier(0)
    Unit cur, nxt; int ui = 0;
    if (!S.next(0, cur)) return;
    f32x4 acc[2][2][4][2];
#pragma unroll
    for (int a = 0; a < 2; ++a)
#pragma unroll
        for (int b = 0; b < 2; ++b)
#pragma unroll
            for (int m = 0; m < 4; ++m)
#pragma unroll
                for (int n = 0; n < 2; ++n) acc[a][b][m][n] = (f32x4){0.f, 0.f, 0.f, 0.f};
    bf16x8 At[4][2], B0[2][2], B1[2][2];
    const char* cA = (const char*)g.A + (size_t)cur.pm * tstep; const char* cB = (const char*)g.Bt + (size_t)cur.pn * tstep;
    S.a_ready(cur);
    if constexpr (SP2) {
        PG8_STAGE(PG8_SB(0, 0), cB, voffB); PG8_STAGE(PG8_SB(0, 1), cB + hstep, voffB); PG8_STAGE(PG8_SA(0, 0), cA, voffA); PG8_STAGE(PG8_SA(0, 1), cA + hstep, voffA);
        if (wr == 1) PG8_BAR;
        PG8_WAIT_V(2); PG8_BAR;
        PG8_STAGE(PG8_SB(1, 0), cB + kstep, voffB); PG8_STAGE(PG8_SA(1, 0), cA + kstep, voffA); PG8_STAGE(PG8_SB(1, 1), cB + hstep + kstep, voffB);
        PG8_WAIT_V(6); PG8_BAR;
    } else {
        PG8_STAGE(PG8_SB(0, 0), cB, voffB); PG8_STAGE(PG8_SA(0, 0), cA, voffA); PG8_STAGE(PG8_SB(0, 1), cB + hstep, voffB); PG8_STAGE(PG8_SA(0, 1), cA + hstep, voffA);
        if (wr == 1) PG8_BAR;
        PG8_WAIT_V(4); PG8_BAR;
        PG8_STAGE(PG8_SB(1, 0), cB + kstep, voffB); PG8_STAGE(PG8_SA(1, 0), cA + kstep, voffA); PG8_STAGE(PG8_SB(1, 1), cB + hstep + kstep, voffB);
        PG8_WAIT_V(6); PG8_BAR;
    }
    for (;;) {
        const bool has_next = S.next(ui + 1, nxt);
        const char* nA = has_next ? (const char*)g.A + (size_t)nxt.pm * tstep : cA; const char* nB = has_next ? (const char*)g.Bt + (size_t)nxt.pn * tstep : cB;
        for (int t = 0; t < nt; t += 2) {
            const bool last = (t == nt - 2);
            const char* a1 = cA + (size_t)(t + 1) * kstep;
            const char* a2 = last ? nA : cA + (size_t)(t + 2) * kstep; const char* b2 = last ? nB : cB + (size_t)(t + 2) * kstep;
            const char* a3 = a2 + kstep; const char* b3 = b2 + kstep;
            if (last && has_next) S.a_ready(nxt);
            if constexpr (SP2) {
            PG8_LDB(B0, 0, 0); PG8_LDB(B1, 0, 1); PG8_SCHED; PG8_LDA(At, 0, 0); PG8_STAGE(PG8_SA(1, 1), a1 + hstep, voffA);
            PG8_WAIT_V(8); PG8_WAIT_L(0); PG8_BAR; PG8_MMA(0, 0, At, B0); PG8_MMA(0, 1, At, B1); PG8_BAR; PG8_SCHED;
            PG8_LDA(At, 0, 1); PG8_STAGE(PG8_SB(0, 0), b2, voffB); PG8_STAGE(PG8_SB(0, 1), b2 + hstep, voffB); PG8_STAGE(PG8_SA(0, 0), a2, voffA);
            PG8_WAIT_V(8); PG8_WAIT_L(0); PG8_BAR; PG8_MMA(1, 0, At, B0); PG8_MMA(1, 1, At, B1); PG8_BAR; PG8_SCHED;
            PG8_LDB(B0, 1, 0); PG8_LDB(B1, 1, 1); PG8_SCHED; PG8_LDA(At, 1, 0); PG8_STAGE(PG8_SA(0, 1), a2 + hstep, voffA);
            PG8_WAIT_V(8); PG8_WAIT_L(0); PG8_BAR; PG8_MMA(0, 0, At, B0); PG8_MMA(0, 1, At, B1); PG8_BAR; PG8_SCHED;
            PG8_LDA(At, 1, 1); PG8_STAGE(PG8_SB(1, 0), b3, voffB); PG8_STAGE(PG8_SB(1, 1), b3 + hstep, voffB); PG8_STAGE(PG8_SA(1, 0), a3, voffA);
            PG8_WAIT_V(8); PG8_WAIT_L(0); PG8_BAR; PG8_MMA(1, 0, At, B0); PG8_MMA(1, 1, At, B1); PG8_BAR; PG8_SCHED;
            } else {
            PG8_LDB(B0, 0, 0); PG8_SCHED; PG8_LDA(At, 0, 0); PG8_STAGE(PG8_SA(1, 1), a1 + hstep, voffA);
            PG8_WAIT_L(8); PG8_BAR; PG8_WAIT_L(0); PG8_MMA(0, 0, At, B0); PG8_BAR; PG8_SCHED;
            PG8_LDB(B1, 0, 1); PG8_STAGE(PG8_SB(0, 0), b2, voffB);
            PG8_BAR; PG8_WAIT_L(0); PG8_MMA(0, 1, At, B1); PG8_BAR;
            PG8_LDA(At, 0, 1); PG8_STAGE(PG8_SA(0, 0), a2, voffA);
            PG8_BAR; PG8_WAIT_L(0); PG8_MMA(1, 0, At, B0); PG8_BAR; PG8_SCHED;
            PG8_STAGE(PG8_SB(0, 1), b2 + hstep, voffB);
            PG8_WAIT_V(6); PG8_BAR; PG8_MMA(1, 1, At, B1); PG8_BAR;
            PG8_LDB(B0, 1, 0); PG8_SCHED; PG8_LDA(At, 1, 0); PG8_STAGE(PG8_SA(0, 1), a2 + hstep, voffA);
            PG8_WAIT_L(8); PG8_BAR; PG8_WAIT_L(0); PG8_MMA(0, 0, At, B0); PG8_BAR; PG8_SCHED;
            PG8_LDB(B1, 1, 1); PG8_STAGE(PG8_SB(1, 0), b3, voffB);
            PG8_BAR; PG8_WAIT_L(0); PG8_MMA(0, 1, At, B1); PG8_BAR;
            PG8_LDA(At, 1, 1); PG8_STAGE(PG8_SA(1, 0), a3, voffA);
            PG8_BAR; PG8_WAIT_L(0); PG8_MMA(1, 0, At, B0); PG8_BAR; PG8_SCHED;
            PG8_STAGE(PG8_SB(1, 1), b3 + hstep, voffB);
            PG8_WAIT_V(6); PG8_BAR; PG8_MMA(1, 1, At, B1); PG8_BAR;
            }
        }
        if constexpr (ALIGN_EPI) { if (wr == 0) PG8_BAR; }
        if constexpr (!Epi::AFTER_DRAIN) { E(acc, cur, wr, wc, fr, fq); S.done(cur); }
        if (!has_next) break;
#pragma unroll
        for (int a = 0; a < 2; ++a)
#pragma unroll
            for (int b = 0; b < 2; ++b)
#pragma unroll
                for (int m = 0; m < 4; ++m)
#pragma unroll
                    for (int n = 0; n < 2; ++n) acc[a][b][m][n] = (f32x4){0.f, 0.f, 0.f, 0.f};
        cur = nxt; cA = nA; cB = nB; ++ui;
        if constexpr (ALIGN_EPI) { if (wr == 1) PG8_BAR; }
    }
    PG8_WAIT_V(0);
    if constexpr (!ALIGN_EPI) { if (wr == 0) PG8_BAR; }
    PG8_BAR;
    if constexpr (Epi::AFTER_DRAIN) { E.fused(acc, cur, wr, wc, fr, fq, lds, wid, lane); S.done(cur); }
#undef PG8_SA
#undef PG8_SB
#undef PG8_STAGE
#undef PG8_LDA
#undef PG8_LDB
#undef PG8_MMA
#undef PG8_WAIT_V
#undef PG8_WAIT_L
#undef PG8_BAR
#undef PG8_SCHED
}
}
namespace pg8 {
__device__ __forceinline__ u32x4 pack8(f32x4 v0, f32x4 v1) { u32x4 w; w.x = cvt_pk_bf16(v0[0], v0[1]); w.y = cvt_pk_bf16(v0[2], v0[3]); w.z = cvt_pk_bf16(v1[0], v1[1]); w.w = cvt_pk_bf16(v1[2], v1[3]); return w; }
__device__ __forceinline__ float dot4(f32x4 a) { return (a[0] * a[0] + a[1] * a[1]) + (a[2] * a[2] + a[3] * a[3]); }
__device__ __forceinline__ float rs16(const float* p) { const f32x4 a = *(const f32x4*)p, b = *(const f32x4*)(p + 4), c = *(const f32x4*)(p + 8), d = *(const f32x4*)(p + 12);
    const float s = ((a[0] + a[1]) + (a[2] + a[3])) + ((b[0] + b[1]) + (b[2] + b[3])) + ((c[0] + c[1]) + (c[2] + c[3])) + ((d[0] + d[1]) + (d[2] + d[3])); return rsqrtf(s * (1.0f / DM) + RMS_EPS); }

struct EpiProj {
    static constexpr bool PERM = true, AFTER_DRAIN = false;
    bf16_t* O; float* kmsum;
    __device__ __forceinline__ void operator()(const f32x4 (&acc)[2][2][4][2], const Unit& u, int wr, int wc, int fr, int fq) const {
        const int colt = u.pn * BM;
        const float sc = colt < C_MK ? QSCALE : ((colt >= C_RK && colt < C_RV) ? RKSCALE : 1.0f);
        const int row0 = u.pm * BM + wr * 64 + fr, col0 = colt + wc * 32 + 8 * fq;
#pragma unroll
        for (int ai = 0; ai < 2; ++ai)
#pragma unroll
            for (int m = 0; m < 4; ++m) { bf16_t* rowp = O + (size_t)(row0 + ai * HALF + m * 16) * NPROJ + col0;
#pragma unroll
                for (int bj = 0; bj < 2; ++bj) *(u32x4*)(rowp + bj * HALF) = pack8(acc[ai][bj][m][0] * sc, acc[ai][bj][m][1] * sc); }
        if (colt >= C_MK && colt < C_MV) {
            const int bh0 = (u.pm >> 6) * 8, blk = u.pm & 63;
#pragma unroll
            for (int bj = 0; bj < 2; ++bj)
#pragma unroll
                for (int n = 0; n < 2; ++n)
#pragma unroll
                    for (int j = 0; j < 4; ++j) { float s = 0.f;
#pragma unroll
                        for (int ai = 0; ai < 2; ++ai)
#pragma unroll
                            for (int m = 0; m < 4; ++m) s += acc[ai][bj][m][n][j];
                        s += __shfl_xor(s, 1); s += __shfl_xor(s, 2); s += __shfl_xor(s, 4); s += __shfl_xor(s, 8);
                        if (fr == 0) { const int c = colt - C_MK + bj * HALF + wc * 32 + 8 * fq + 4 * n + j; atomicAdd(kmsum + ((size_t)(bh0 + (c >> 6)) * 64 + blk) * 64 + (c & 63), s); } }
        }
    }
};
struct EpiStore {
    static constexpr bool PERM = true, AFTER_DRAIN = false;
    bf16_t* O;
    __device__ __forceinline__ void operator()(const f32x4 (&acc)[2][2][4][2], const Unit& u, int wr, int wc, int fr, int fq) const {
        const int row0 = u.pm * BM + wr * 64 + fr, col0 = u.pn * BM + wc * 32 + 8 * fq;
#pragma unroll
        for (int ai = 0; ai < 2; ++ai)
#pragma unroll
            for (int m = 0; m < 4; ++m) { bf16_t* rowp = O + (size_t)(row0 + ai * HALF + m * 16) * DM + col0;
#pragma unroll
                for (int bj = 0; bj < 2; ++bj) *(u32x4*)(rowp + bj * HALF) = pack8(acc[ai][bj][m][0], acc[ai][bj][m][1]); }
    }
};
struct EpiRes {
    static constexpr bool PERM = true, AFTER_DRAIN = false;
    const float* base; float* out; bf16_t* xb; float* rsq;
    __device__ __forceinline__ void operator()(const f32x4 (&acc)[2][2][4][2], const Unit& u, int wr, int wc, int fr, int fq) const {
        const int row0 = u.pm * BM + wr * 64 + fr, col0 = u.pn * BM + wc * 32 + 8 * fq;
#pragma unroll
        for (int ai = 0; ai < 2; ++ai)
#pragma unroll
            for (int m = 0; m < 4; ++m) { const int row = row0 + ai * HALF + m * 16; float ss = 0.f;
#pragma unroll
                for (int bj = 0; bj < 2; ++bj) { const size_t off = (size_t)row * DM + col0 + bj * HALF;
                    const f32x4 y0 = *(const f32x4*)(base + off) + acc[ai][bj][m][0], y1 = *(const f32x4*)(base + off + 4) + acc[ai][bj][m][1];
                    *(f32x4*)(out + off) = y0; *(f32x4*)(out + off + 4) = y1; *(u32x4*)(xb + off) = pack8(y0, y1); ss += dot4(y0) + dot4(y1); }
                ss += __shfl_xor(ss, 16); ss += __shfl_xor(ss, 32);
                if (fq == 0) rsq[(size_t)row * 16 + u.pn * 4 + wc] = ss; }
    }
};
struct EpiPle {
    static constexpr bool PERM = true, AFTER_DRAIN = false;
    float* out; const bf16_t* pw; const float* rsq_in; float* rsq_out;
    __device__ __forceinline__ void operator()(const f32x4 (&acc)[2][2][4][2], const Unit& u, int wr, int wc, int fr, int fq) const {
        const int row0 = u.pm * BM + wr * 64 + fr, col0 = u.pn * BM + wc * 32 + 8 * fq;
#pragma unroll
        for (int ai = 0; ai < 2; ++ai)
#pragma unroll
            for (int m = 0; m < 4; ++m) { const int row = row0 + ai * HALF + m * 16; const float rs = rs16(rsq_in + (size_t)row * 16); float ss = 0.f;
#pragma unroll
                for (int bj = 0; bj < 2; ++bj) { const size_t off = (size_t)row * DM + col0 + bj * HALF;
                    const u32x4 pv = *(const u32x4*)(pw + off);
                    const f32x4 p0 = {__uint_as_float(pv.x << 16), __uint_as_float(pv.x & 0xffff0000u), __uint_as_float(pv.y << 16), __uint_as_float(pv.y & 0xffff0000u)};
                    const f32x4 p1 = {__uint_as_float(pv.z << 16), __uint_as_float(pv.z & 0xffff0000u), __uint_as_float(pv.w << 16), __uint_as_float(pv.w & 0xffff0000u)};
                    f32x4 g0 = acc[ai][bj][m][0] * rs, g1 = acc[ai][bj][m][1] * rs;
#pragma unroll
                    for (int j = 0; j < 4; ++j) { g0[j] = 1.0f / (1.0f + __expf(-g0[j])); g1[j] = 1.0f / (1.0f + __expf(-g1[j])); }
                    const f32x4 y0 = *(const f32x4*)(out + off) + p0 * g0, y1 = *(const f32x4*)(out + off + 4) + p1 * g1;
                    *(f32x4*)(out + off) = y0; *(f32x4*)(out + off + 4) = y1; ss += dot4(y0) + dot4(y1); }
                ss += __shfl_xor(ss, 16); ss += __shfl_xor(ss, 32);
                if (fq == 0) rsq_out[(size_t)row * 16 + u.pn * 4 + wc] = ss;
                asm volatile("" ::: "memory"); }
    }
};
struct EpiUG {
    static constexpr bool PERM = true, AFTER_DRAIN = false;
    bf16_t* act; const float* rsq; const float* cw; const float* cb; float* UL; float* UF; float* GF;
    __device__ __forceinline__ void operator()(const f32x4 (&acc)[2][2][4][2], const Unit& u, int wr, int wc, int fr, int fq) const {
        const int lane = fq * 16 + fr;
        const int cu = u.pn * HALF + wc * 32 + 8 * fq;
        float w0[8], w1[8], w2[8], bb[8];
#pragma unroll
        for (int q = 0; q < 2; ++q) { const f32x4 a = *(const f32x4*)(cw + cu + 4 * q), b = *(const f32x4*)(cw + FF + cu + 4 * q), c = *(const f32x4*)(cw + 2 * FF + cu + 4 * q), d = *(const f32x4*)(cb + cu + 4 * q);
#pragma unroll
            for (int j = 0; j < 4; ++j) { w0[4 * q + j] = a[j]; w1[4 * q + j] = b[j]; w2[4 * q + j] = c[j]; bb[4 * q + j] = d[j]; } }
        const int i1 = (lane + 63) & 63, i2 = (lane + 62) & 63, i15 = (lane + 15) & 63, i14 = (lane + 14) & 63;
#pragma unroll
        for (int ai = 0; ai < 2; ++ai) {
            float up[8];
#pragma unroll
            for (int m = 0; m < 4; ++m) {
                const int row = u.pm * BM + ai * HALF + wr * 64 + m * 16 + fr;
                const float rs = rs16(rsq + (size_t)row * 16);
                float uu[8], gg[8], a8[8];
#pragma unroll
                for (int n = 0; n < 2; ++n)
#pragma unroll
                    for (int j = 0; j < 4; ++j) { uu[4 * n + j] = acc[ai][0][m][n][j] * rs; gg[4 * n + j] = acc[ai][1][m][n][j] * rs; }
#pragma unroll
                for (int k = 0; k < 8; ++k) {
                    float u1 = __shfl(uu[k], i1), u2 = __shfl(uu[k], i2);
                    if (m > 0) { const float b1 = __shfl(up[k], i15), b2 = __shfl(up[k], i14); u1 = fr >= 1 ? u1 : b1; u2 = fr >= 2 ? u2 : b2; }
                    const float y = bb[k] + w0[k] * u2 + w1[k] * u1 + w2[k] * uu[k];
                    a8[k] = gelu_tanh(y) * gg[k];
                }
                const bool defer = (m == 0) && (fr < 2);
                if (!defer) { u32x4 w; w.x = cvt_pk_bf16(a8[0], a8[1]); w.y = cvt_pk_bf16(a8[2], a8[3]); w.z = cvt_pk_bf16(a8[4], a8[5]); w.w = cvt_pk_bf16(a8[6], a8[7]);
                    *(u32x4*)(act + (size_t)row * FF + cu) = w; }
                else { const size_t so = ((size_t)(row >> 6) * 2 + fr) * FF + cu;
                    *(f32x4*)(UF + so) = (f32x4){uu[0], uu[1], uu[2], uu[3]}; *(f32x4*)(UF + so + 4) = (f32x4){uu[4], uu[5], uu[6], uu[7]};
                    *(f32x4*)(GF + so) = (f32x4){gg[0], gg[1], gg[2], gg[3]}; *(f32x4*)(GF + so + 4) = (f32x4){gg[4], gg[5], gg[6], gg[7]}; }
                if (m == 3 && fr >= 14) { const size_t so = ((size_t)(row >> 6) * 2 + (fr - 14)) * FF + cu;
                    *(f32x4*)(UL + so) = (f32x4){uu[0], uu[1], uu[2], uu[3]}; *(f32x4*)(UL + so + 4) = (f32x4){uu[4], uu[5], uu[6], uu[7]}; }
#pragma unroll
                for (int k = 0; k < 8; ++k) up[k] = uu[k];
            }
        }
    }
};
}
#define LAS __attribute__((address_space(3)))
namespace mx {
typedef short bf16x8 __attribute__((ext_vector_type(8)));
typedef short s16x4 __attribute__((ext_vector_type(4)));
typedef float f32x16 __attribute__((ext_vector_type(16)));
typedef unsigned u32x4 __attribute__((ext_vector_type(4)));
typedef float f32x4_t __attribute__((ext_vector_type(4)));
typedef LAS const char* lds_cptr;
typedef LAS char* lds_ptr;
__device__ __forceinline__ int crow(int r, int hi) { return (r & 3) + 8 * (r >> 2) + 4 * hi; }
__device__ __forceinline__ s16x4 vtr(lds_cptr p) { return __builtin_bit_cast(s16x4, __builtin_amdgcn_ds_read_tr16_b64_v4i16((LAS s16x4*)p)); }
__device__ __forceinline__ bf16x8 cat8(s16x4 lo, s16x4 hi) { return (bf16x8){lo[0], lo[1], lo[2], lo[3], hi[0], hi[1], hi[2], hi[3]}; }
__device__ __forceinline__ unsigned pk(float lo, float hi) { return pg8::cvt_pk_bf16(lo, hi); }
__device__ __forceinline__ float other_half(float v) { return __shfl_xor(v, 32); }

constexpr int L_K = 0, L_V = 32768;
constexpr int L_WSF = 65536;
constexpr int L_OST = 65536 + 2048;
constexpr int L_ENT = L_OST + 32768;
constexpr int ENT_CAP = 4096;
constexpr int L_PREF = L_ENT + ENT_CAP * 4;
constexpr int L_END = L_PREF + 512;
static_assert(L_END <= 147456, "mixer LDS map");

__device__ __forceinline__ void moba_stage_kv(const bf16_t* __restrict__ proj, int b, int h, int blk, lds_ptr lds, int tid) {
#pragma unroll
    for (int i = 0; i < 4; ++i) { const int pc = tid + 512 * i, key = pc >> 3, ch = pc & 7;
        const bf16_t* src = proj + (size_t)(b * SEQ + blk * 256 + key) * NPROJ + h * 64 + ch * 8;
        const u32x4 kv = *(const u32x4*)(src + C_MK), vv = *(const u32x4*)(src + C_MV);
        *(LAS u32x4*)(lds + L_K + ch * 4096 + key * 16) = kv;
        *(LAS u32x4*)(lds + L_V + (key >> 6) * 8192 + (ch >> 2) * 4096 + ((key & 63) >> 3) * 512 + (key & 7) * 64 + (ch & 3) * 16) = vv; }
}

__device__ __forceinline__ void moba_batch(const bf16_t* qptr, int qpos, int kbase, float slope2, bool diag, int ntiles, lds_ptr lds, int wave, int lane, bf16_t* odst, float* ldst) {
    const int r32 = lane & 31, hi = lane >> 5;
    bf16x8 qr[4];
#pragma unroll
    for (int d0 = 0; d0 < 4; ++d0) qr[d0] = *(const bf16x8*)(qptr + d0 * 16 + hi * 8);
    f32x16 o0, o1;
#pragma unroll
    for (int r = 0; r < 16; ++r) { o0[r] = 0.f; o1[r] = 0.f; }
    float m = -1e30f, l = 0.f;
    const lds_cptr kp = (lds_cptr)lds + L_K + hi * 4096 + r32 * 16;
    const lds_cptr vp = (lds_cptr)lds + L_V + ((lane >> 4) & 1) * 32 + (lane & 3) * 8 + (4 * hi + ((lane & 15) >> 2)) * 64;
    LAS float* wsf = (LAS float*)(lds + L_WSF) + wave * 64;
    for (int kt = 0; kt < ntiles; ++kt) {
        f32x16 p0, p1;
        const float fb0 = (float)(qpos - kbase - 64 * kt - 4 * hi);
#pragma unroll
        for (int r = 0; r < 16; ++r) { const float c = (float)((r & 3) + 8 * (r >> 2)); const float d0f = fb0 - c, d1f = d0f - 32.0f;
            p0[r] = (diag && d0f < 0.f) ? -1e30f : -slope2 * d0f; p1[r] = (diag && d1f < 0.f) ? -1e30f : -slope2 * d1f; }
#pragma unroll
        for (int d0 = 0; d0 < 4; ++d0) {
            const bf16x8 k0 = *(const LAS bf16x8*)(kp + kt * 1024 + d0 * 8192), k1 = *(const LAS bf16x8*)(kp + kt * 1024 + 512 + d0 * 8192);
            p0 = __builtin_amdgcn_mfma_f32_32x32x16_bf16(k0, qr[d0], p0, 0, 0, 0);
            p1 = __builtin_amdgcn_mfma_f32_32x32x16_bf16(k1, qr[d0], p1, 0, 0, 0);
        }
        float mx_ = p0[0];
#pragma unroll
        for (int r = 1; r < 16; ++r) mx_ = fmaxf(mx_, p0[r]);
#pragma unroll
        for (int r = 0; r < 16; ++r) mx_ = fmaxf(mx_, p1[r]);
        mx_ = fmaxf(mx_, other_half(mx_));
        const float mn = fmaxf(m, mx_);
        const float alpha = __builtin_amdgcn_exp2f(m - mn);
        float rs = 0.f;
#pragma unroll
        for (int r = 0; r < 16; ++r) { p0[r] = __builtin_amdgcn_exp2f(p0[r] - mn); p1[r] = __builtin_amdgcn_exp2f(p1[r] - mn); rs += p0[r] + p1[r]; }
        l = l * alpha + rs; m = mn;
        if (!__all(alpha == 1.0f)) {
            if (hi == 0) wsf[r32] = alpha;
#pragma unroll
            for (int r = 0; r < 16; ++r) { const float f = wsf[crow(r, hi)]; o0[r] *= f; o1[r] *= f; }
        }
        u32x4 pw0 = {pk(p0[0], p0[1]), pk(p0[2], p0[3]), pk(p0[4], p0[5]), pk(p0[6], p0[7])};
        u32x4 pw1 = {pk(p0[8], p0[9]), pk(p0[10], p0[11]), pk(p0[12], p0[13]), pk(p0[14], p0[15])};
        u32x4 pw2 = {pk(p1[0], p1[1]), pk(p1[2], p1[3]), pk(p1[4], p1[5]), pk(p1[6], p1[7])};
        u32x4 pw3 = {pk(p1[8], p1[9]), pk(p1[10], p1[11]), pk(p1[12], p1[13]), pk(p1[14], p1[15])};
        const lds_cptr vt = vp + kt * 8192;
#define MX_PV(O, DB, KS, PW) O = __builtin_amdgcn_mfma_f32_32x32x16_bf16(__builtin_bit_cast(bf16x8, PW), cat8(vtr(vt + (DB) * 4096 + (KS) * 1024), vtr(vt + (DB) * 4096 + (KS) * 1024 + 512)), O, 0, 0, 0)
        MX_PV(o0, 0, 0, pw0); MX_PV(o1, 1, 0, pw0); MX_PV(o0, 0, 1, pw1); MX_PV(o1, 1, 1, pw1);
        MX_PV(o0, 0, 2, pw2); MX_PV(o1, 1, 2, pw2); MX_PV(o0, 0, 3, pw3); MX_PV(o1, 1, 3, pw3);
#undef MX_PV
    }
    l += other_half(l);
    if (hi == 0) wsf[32 + r32] = 1.0f / l;
    const float lse = m + __builtin_amdgcn_logf(l);
    LAS bf16_t* ost = (LAS bf16_t*)(lds + L_OST) + wave * 2048;
#pragma unroll
    for (int r = 0; r < 16; ++r) { const int orow = crow(r, hi); const float f = wsf[32 + orow];
        ost[orow * 64 + r32] = f2bf(o0[r] * f); ost[orow * 64 + 32 + r32] = f2bf(o1[r] * f); }
    const unsigned long long dp = (unsigned long long)odst; const unsigned dlo = (unsigned)dp, dhi = (unsigned)(dp >> 32);
#pragma unroll
    for (int i = 0; i < 4; ++i) { const int row = i * 8 + (lane >> 3), ch = lane & 7;
        const u32x4 v = *(const LAS u32x4*)(ost + row * 64 + ch * 8);
        const unsigned long long d = ((unsigned long long)(unsigned)__shfl((int)dhi, row) << 32) | (unsigned)__shfl((int)dlo, row);
        if (d) *(u32x4*)((bf16_t*)d + ch * 8) = v; }
    if (hi == 0 && ldst) *ldst = lse;
}

__device__ __forceinline__ void moba_diag_unit(const bf16_t* __restrict__ proj, int bh, int i, bf16_t* part_o, float* part_l, lds_ptr lds, int tid) {
    const int b = bh >> 3, h = bh & 7, lane = tid & 63, wave = __builtin_amdgcn_readfirstlane(tid >> 6);
    moba_stage_kv(proj, b, h, i, lds, tid);
    __syncthreads();
    const int ql = wave * 32 + (lane & 31), t = i * 256 + ql; const size_t row = (size_t)b * SEQ + t;
    const float slope2 = __builtin_amdgcn_exp2f(-(float)(h + 1)) * LOG2E;
    moba_batch(proj + row * NPROJ + C_MQ + h * 64, t, i * 256, slope2, true, (wave >> 1) + 1, lds, wave, lane,
               part_o + ((row * 8 + h) * 4 + 3) * 64, part_l + (row * 8 + h) * 4 + 3);
    __syncthreads();
}
__device__ __forceinline__ void moba_sel_task(const bf16_t* __restrict__ proj, const unsigned short* __restrict__ seg, const int* __restrict__ cnt, int bh, int n,
                                              bf16_t* part_o, float* part_l, lds_ptr lds, int tid) {
    const int b = bh >> 3, h = bh & 7, lane = tid & 63, wave = __builtin_amdgcn_readfirstlane(tid >> 6);
    LAS int* pref = (LAS int*)(lds + L_PREF); LAS unsigned* ent = (LAS unsigned*)(lds + L_ENT);
    if (tid < 64) pref[tid + 1] = (tid > n) ? cnt[((size_t)bh * 64 + n) * 64 + tid] : 0;
    moba_stage_kv(proj, b, h, n, lds, tid);
    __syncthreads();
    if (tid == 0) { int s = 0; pref[0] = 0; for (int i = 1; i <= 64; ++i) { s += pref[i]; pref[i] = s; } }
    __syncthreads();
    const int T = pref[64];
    const float slope2 = __builtin_amdgcn_exp2f(-(float)(h + 1)) * LOG2E;
    for (int c0 = 0; c0 < T; c0 += ENT_CAP) {
        const int cn = (T - c0) < ENT_CAP ? (T - c0) : ENT_CAP;
        for (int e = tid; e < cn; e += 512) { const int g = c0 + e; int lo = 0, hi = 63;
            while (lo < hi) { const int mid = (lo + hi + 1) >> 1; if (pref[mid] <= g) lo = mid; else hi = mid - 1; }
            ent[e] = ((unsigned)lo << 10) | (unsigned)seg[(((size_t)bh * 64 + n) * 64 + lo) * 256 + (g - pref[lo])]; }
        __syncthreads();
        for (int wb = wave; wb * 32 < cn; wb += 8) {
            const int idx = wb * 32 + (lane & 31); const bool valid = idx < cn;
            const unsigned en = ent[valid ? idx : wb * 32];
            const int isrc = en >> 10, ql = (en >> 2) & 255, slot = en & 3, t = isrc * 256 + ql; const size_t row = (size_t)b * SEQ + t;
            moba_batch(proj + row * NPROJ + C_MQ + h * 64, t, n * 256, slope2, false, 4, lds, wave, lane,
                       valid ? part_o + ((row * 8 + h) * 4 + slot) * 64 : (bf16_t*)nullptr, valid ? part_l + (row * 8 + h) * 4 + slot : (float*)nullptr);
        }
        __syncthreads();
    }
}
__device__ __forceinline__ void moba_combine(const bf16_t* __restrict__ part_o, const float* __restrict__ part_l, const u32* __restrict__ sel, bf16_t* __restrict__ mix, size_t gt, size_t GT) {
    for (size_t i = gt; i < (size_t)MT * 64; i += GT) {
        const int ch = (int)(i & 7), h = (int)((i >> 3) & 7); const size_t row = i >> 6;
        const int nv = sel[row * 8 + h] >> 24;
        const f32x4_t lv = *(const f32x4_t*)(part_l + (row * 8 + h) * 4);
        float w[4]; w[0] = nv > 0 ? lv[0] : -1e30f; w[1] = nv > 1 ? lv[1] : -1e30f; w[2] = nv > 2 ? lv[2] : -1e30f; w[3] = lv[3];
        const float mm = fmaxf(fmaxf(w[0], w[1]), fmaxf(w[2], w[3]));
        float acc[8] = {0.f, 0.f, 0.f, 0.f, 0.f, 0.f, 0.f, 0.f}; float ws = 0.f;
#pragma unroll
        for (int s = 0; s < 4; ++s) { const bool ok = s == 3 || s < nv; const float ww = ok ? __builtin_amdgcn_exp2f(w[s] - mm) : 0.f; ws += ww;
            if (ok) { const u32x4 v = *(const u32x4*)(part_o + ((row * 8 + h) * 4 + s) * 64 + ch * 8);
                acc[0] += ww * __uint_as_float(v.x << 16); acc[1] += ww * __uint_as_float(v.x & 0xffff0000u); acc[2] += ww * __uint_as_float(v.y << 16); acc[3] += ww * __uint_as_float(v.y & 0xffff0000u);
                acc[4] += ww * __uint_as_float(v.z << 16); acc[5] += ww * __uint_as_float(v.z & 0xffff0000u); acc[6] += ww * __uint_as_float(v.w << 16); acc[7] += ww * __uint_as_float(v.w & 0xffff0000u); } }
        const float iw = 1.0f / ws;
        u32x4 o; o.x = pk(acc[0] * iw, acc[1] * iw); o.y = pk(acc[2] * iw, acc[3] * iw); o.z = pk(acc[4] * iw, acc[5] * iw); o.w = pk(acc[6] * iw, acc[7] * iw);
        *(u32x4*)(mix + row * DM + h * 64 + ch * 8) = o;
    }
}

constexpr int R_IMG = 65536;
__device__ __forceinline__ int rimg_off(int t, int c) { return (c >> 5) * 16384 + (t >> 3) * 512 + (t & 7) * 64 + (c & 31) * 2; }
__device__ __forceinline__ void ret_stage(const bf16_t* __restrict__ proj, int b, int t0, int col0, lds_ptr img, int tid, bool kdecay, float log2g) {
#pragma unroll
    for (int i = 0; i < 8; ++i) { const int pc = tid + 512 * i, t = pc >> 4, ch = pc & 15;
        u32x4 v = *(const u32x4*)(proj + (size_t)(b * SEQ + t0 + t) * NPROJ + col0 + ch * 8);
        if (kdecay) { const float f = __builtin_amdgcn_exp2f((float)(255 - t) * log2g);
            v.x = pk(__uint_as_float(v.x << 16) * f, __uint_as_float(v.x & 0xffff0000u) * f); v.y = pk(__uint_as_float(v.y << 16) * f, __uint_as_float(v.y & 0xffff0000u) * f);
            v.z = pk(__uint_as_float(v.z << 16) * f, __uint_as_float(v.z & 0xffff0000u) * f); v.w = pk(__uint_as_float(v.w << 16) * f, __uint_as_float(v.w & 0xffff0000u) * f); }
        *(LAS u32x4*)(img + rimg_off(t, ch * 8)) = v; }
}
__device__ __forceinline__ void ret_kv_task(const bf16_t* __restrict__ proj, int bh, int c, float* __restrict__ kvt, lds_ptr lds, int tid) {
    const int b = bh >> 2, h = bh & 3, lane = tid & 63, wave = __builtin_amdgcn_readfirstlane(tid >> 6), r32 = lane & 31, hi = lane >> 5;
    const float log2g = __builtin_amdgcn_logf(1.0f - __builtin_amdgcn_exp2f(-5.0f - (float)h));
    ret_stage(proj, b, c * 256, C_RV + h * 128, lds, tid, false, 0.f);
    ret_stage(proj, b, c * 256, C_RK + h * 128, lds + R_IMG, tid, true, log2g);
    __syncthreads();
    const int et = wave >> 1, dt0 = (wave & 1) * 2;
    const int lbase = hi * 512 + ((lane & 15) >> 2) * 64 + ((lane >> 4) & 1) * 32 + (lane & 3) * 8;
    const lds_cptr va = (lds_cptr)lds + et * 16384 + lbase, kb0 = (lds_cptr)lds + R_IMG + dt0 * 16384 + lbase, kb1 = kb0 + 16384;
    f32x16 a0, a1;
#pragma unroll
    for (int r = 0; r < 16; ++r) { a0[r] = 0.f; a1[r] = 0.f; }
#pragma unroll 4
    for (int ks = 0; ks < 16; ++ks) {
        const bf16x8 vf = cat8(vtr(va + ks * 1024), vtr(va + ks * 1024 + 256));
        const bf16x8 k0 = cat8(vtr(kb0 + ks * 1024), vtr(kb0 + ks * 1024 + 256)), k1 = cat8(vtr(kb1 + ks * 1024), vtr(kb1 + ks * 1024 + 256));
        a0 = __builtin_amdgcn_mfma_f32_32x32x16_bf16(vf, k0, a0, 0, 0, 0);
        a1 = __builtin_amdgcn_mfma_f32_32x32x16_bf16(vf, k1, a1, 0, 0, 0);
    }
    float* dst = kvt + ((size_t)(bh * 64 + c) * 128) * 128;
#pragma unroll
    for (int r = 0; r < 16; ++r) { const int e = et * 32 + crow(r, hi);
        dst[(size_t)e * 128 + dt0 * 32 + r32] = a0[r]; dst[(size_t)e * 128 + dt0 * 32 + 32 + r32] = a1[r]; }
    __syncthreads();
}
__device__ __forceinline__ void ret_scan(const float* __restrict__ kvt, bf16_t* __restrict__ stt, size_t gt, size_t GT) {
    for (size_t i = gt; i < (size_t)8 * 16384; i += GT) {
        const int bh = (int)(i >> 14), ed = (int)(i & 16383), h = bh & 3;
        const float g256 = __builtin_amdgcn_exp2f(256.0f * __builtin_amdgcn_logf(1.0f - __builtin_amdgcn_exp2f(-5.0f - (float)h)));
        float s = 0.f;
#pragma unroll 8
        for (int c = 0; c < 64; ++c) { const size_t o = ((size_t)(bh * 64 + c) << 14) + ed; stt[o] = f2bf(s); s = s * g256 + kvt[o]; }
    }
}
__device__ __forceinline__ void ret_out_task(const bf16_t* __restrict__ proj, const bf16_t* __restrict__ stt, const float* __restrict__ gain, bf16_t* __restrict__ mix, int bh, int c, lds_ptr lds, int tid) {
    const int b = bh >> 2, h = bh & 3, lane = tid & 63, wave = __builtin_amdgcn_readfirstlane(tid >> 6), r32 = lane & 31, hi = lane >> 5;
    const float log2g = __builtin_amdgcn_logf(1.0f - __builtin_amdgcn_exp2f(-5.0f - (float)h));
    ret_stage(proj, b, c * 256, C_RV + h * 128, lds, tid, false, 0.f);
    __syncthreads();
    const size_t row0 = (size_t)b * SEQ + c * 256;
    bf16x8 qf[8];
    { const bf16_t* qp = proj + (row0 + wave * 32 + r32) * NPROJ + C_RQ + h * 128 + hi * 8;
#pragma unroll
      for (int ks = 0; ks < 8; ++ks) qf[ks] = *(const bf16x8*)(qp + ks * 16); }
    f32x16 o[4];
#pragma unroll
    for (int et = 0; et < 4; ++et)
#pragma unroll
        for (int r = 0; r < 16; ++r) o[et][r] = 0.f;
    { const bf16_t* sp = stt + ((size_t)(bh * 64 + c) << 14) + (size_t)r32 * 128 + hi * 8;
#pragma unroll
      for (int et = 0; et < 4; ++et)
#pragma unroll
          for (int ks = 0; ks < 8; ++ks) { const bf16x8 sf = *(const bf16x8*)(sp + (size_t)et * 32 * 128 + ks * 16);
              o[et] = __builtin_amdgcn_mfma_f32_32x32x16_bf16(qf[ks], sf, o[et], 0, 0, 0); } }
#pragma unroll
    for (int r = 0; r < 16; ++r) { const float f = __builtin_amdgcn_exp2f((float)(wave * 32 + crow(r, hi) + 1) * log2g);
#pragma unroll
        for (int et = 0; et < 4; ++et) o[et][r] *= f; }
    const lds_cptr vp = (lds_cptr)lds + ((lane >> 4) & 1) * 32 + (lane & 3) * 8 + (4 * hi + ((lane & 15) >> 2)) * 64;
    for (int kvt = 0; kvt <= wave; ++kvt) {
        f32x16 p;
#pragma unroll
        for (int r = 0; r < 16; ++r) p[r] = 0.f;
        const bf16_t* kp = proj + (row0 + kvt * 32 + r32) * NPROJ + C_RK + h * 128 + hi * 8;
#pragma unroll
        for (int ks = 0; ks < 8; ++ks) { const bf16x8 kf = *(const bf16x8*)(kp + ks * 16); p = __builtin_amdgcn_mfma_f32_32x32x16_bf16(kf, qf[ks], p, 0, 0, 0); }
        const int dbase = 32 * (wave - kvt) + r32 - 4 * hi;
#pragma unroll
        for (int r = 0; r < 16; ++r) { const int dist = dbase - ((r & 3) + 8 * (r >> 2)); p[r] = dist >= 0 ? p[r] * __builtin_amdgcn_exp2f((float)dist * log2g) : 0.f; }
        const u32x4 pw0 = {pk(p[0], p[1]), pk(p[2], p[3]), pk(p[4], p[5]), pk(p[6], p[7])}, pw1 = {pk(p[8], p[9]), pk(p[10], p[11]), pk(p[12], p[13]), pk(p[14], p[15])};
        const lds_cptr vt = vp + kvt * 2048;
#pragma unroll
        for (int et = 0; et < 4; ++et) {
            o[et] = __builtin_amdgcn_mfma_f32_32x32x16_bf16(__builtin_bit_cast(bf16x8, pw0), cat8(vtr(vt + et * 16384), vtr(vt + et * 16384 + 512)), o[et], 0, 0, 0);
            o[et] = __builtin_amdgcn_mfma_f32_32x32x16_bf16(__builtin_bit_cast(bf16x8, pw1), cat8(vtr(vt + et * 16384 + 1024), vtr(vt + et * 16384 + 1536)), o[et], 0, 0, 0);
        }
    }
#pragma unroll
    for (int r = 0; r < 16; ++r) {
        float s = (o[0][r] + o[1][r]) + (o[2][r] + o[3][r]);
        s += __shfl_xor(s, 1); s += __shfl_xor(s, 2); s += __shfl_xor(s, 4); s += __shfl_xor(s, 8); s += __shfl_xor(s, 16);
        const float mu = s * (1.0f / 128.0f);
        const float d0 = o[0][r] - mu, d1 = o[1][r] - mu, d2 = o[2][r] - mu, d3 = o[3][r] - mu;
        float q = (d0 * d0 + d1 * d1) + (d2 * d2 + d3 * d3);
        q += __shfl_xor(q, 1); q += __shfl_xor(q, 2); q += __shfl_xor(q, 4); q += __shfl_xor(q, 8); q += __shfl_xor(q, 16);
        const float rstd = rsqrtf(q * (1.0f / 128.0f) + GN_EPS);
        const size_t row = row0 + wave * 32 + crow(r, hi);
        const bf16_t* gp = proj + row * NPROJ + C_RG + h * 128 + r32; bf16_t* mp = mix + row * DM + 512 + h * 128 + r32;
        const float dd[4] = {d0, d1, d2, d3};
#pragma unroll
        for (int et = 0; et < 4; ++et) { const float g = bf2f(gp[et * 32]); mp[et * 32] = f2bf(dd[et] * rstd * gain[h * 128 + et * 32 + r32] * (g / (1.0f + __expf(-g)))); }
    }
    __syncthreads();
}
}
#include <hip/hip_cooperative_groups.h>
namespace cg = cooperative_groups;
constexpr int NWAVES = 8, NTHREADS = 512;
constexpr int LDS_BYTES = 147456;
constexpr int NPH = 11;
constexpr size_t WS_STASH = 180 * MiB;
constexpr size_t STASH_ELEMS = (size_t)512 * 2 * FF;

struct Args { const float* in[16]; float* out; unsigned char* ws; int ph_lo, ph_hi, flags, pad; };

__device__ __forceinline__ void p0_transpose_item(const float* __restrict__ W, int K, int N, const float* __restrict__ gk, bf16_t* __restrict__ WT, int k0, int n0, int orow0, LAS float* scr, int lane) {
#pragma unroll 8
    for (int i = 0; i < 32; ++i) { const int kk = 2 * i + (lane >> 5); const float g = gk ? gk[k0 + kk] : 1.0f; scr[kk * 33 + (lane & 31)] = W[(size_t)(k0 + kk) * N + n0 + (lane & 31)] * g; }
    asm volatile("s_waitcnt lgkmcnt(0)" ::: "memory");
    const int c = lane & 7;
#pragma unroll
    for (int j = 0; j < 4; ++j) { const int n = (lane >> 3) + 8 * j; const LAS float* s = scr + (8 * c) * 33 + n;
        uint4 o; o.x = (u32)f2bf(s[0 * 33]) | ((u32)f2bf(s[1 * 33]) << 16); o.y = (u32)f2bf(s[2 * 33]) | ((u32)f2bf(s[3 * 33]) << 16);
        o.z = (u32)f2bf(s[4 * 33]) | ((u32)f2bf(s[5 * 33]) << 16); o.w = (u32)f2bf(s[6 * 33]) | ((u32)f2bf(s[7 * 33]) << 16);
        *(uint4*)(WT + (size_t)(orow0 + n) * K + k0 + 8 * c) = o; }
    asm volatile("s_waitcnt lgkmcnt(0)" ::: "memory");
}

__global__ void __launch_bounds__(NTHREADS, 2) mega(Args a) {
    extern __shared__ __attribute__((aligned(16))) unsigned char lds[];
    cg::grid_group grid = cg::this_grid();
    const int tid = threadIdx.x, lane = tid & 63, wave = __builtin_amdgcn_readfirstlane(tid >> 6);
    const int G = gridDim.x, bx = blockIdx.x;
    const int vcu = (G % 8 == 0) ? (bx % 8) * (G / 8) + bx / 8 : bx;
    const int gw = vcu * NWAVES + wave, NGW = G * NWAVES;
    unsigned char* ws = a.ws;
    const float* x = a.in[0]; const float* p = a.in[1]; const float* attn_norm = a.in[2]; const float* w_in = a.in[3]; const float* ret_norm = a.in[4]; const float* w_out = a.in[5];
    const float* ffn_norm = a.in[6]; const float* w_up = a.in[7]; const float* w_gate = a.in[8]; const float* conv_w = a.in[9]; const float* conv_b = a.in[10]; const float* w_down = a.in[11];
    const float* ple_norm = a.in[12]; const float* w_ple = a.in[13]; const float* w_ple_gate = a.in[14]; const float* final_norm = a.in[15];
    float* out = a.out;
    bf16_t* Win_t = (bf16_t*)(ws + WS_WIN); bf16_t* Wout_t = (bf16_t*)(ws + WS_WOUT); bf16_t* Wug_t = (bf16_t*)(ws + WS_WUG); bf16_t* Wdown_t = (bf16_t*)(ws + WS_WDOWN);
    bf16_t* Wpg_t = (bf16_t*)(ws + WS_WPG); bf16_t* Wple_t = (bf16_t*)(ws + WS_WPLE);
    bf16_t* XN = (bf16_t*)(ws + WS_R1); bf16_t* MIX = (bf16_t*)(ws + WS_R1); bf16_t* PW = (bf16_t*)(ws + WS_R1);
    bf16_t* XB = (bf16_t*)(ws + WS_R2);
    bf16_t* PROJ = (bf16_t*)(ws + WS_PROJ); bf16_t* ACT = (bf16_t*)(ws + WS_PROJ);
    bf16_t* PB = (bf16_t*)(ws + WS_PB); float* RSQ = (float*)(ws + WS_RSQ);
    float* KM = (float*)(ws + WS_KMEAN);
    float* UL = (float*)(ws + WS_STASH); float* UF = UL + STASH_ELEMS; float* GF = UF + STASH_ELEMS;
    float* KVT = (float*)(ws + WS_KVT); bf16_t* STT = (bf16_t*)(ws + WS_STT); float* PART_L = (float*)(ws + WS_PARTL); bf16_t* PART_O = (bf16_t*)out;
    u32* SEL = (u32*)(ws + WS_SEL); unsigned short* SEG = (unsigned short*)(ws + WS_SEG); int* CNT = (int*)(ws + WS_CNT);

    const int lo = a.ph_lo, hi = a.ph_hi;
#define IN(k) (lo <= (k) && (k) < hi)
#define SEAM(k) do { if (IN(k) && IN((k) + 1)) grid.sync(); } while (0)

    if (IN(0)) {
        LAS float* scr = (LAS float*)(lds) + wave * (64 * 33);
        constexpr int I_IN = 16 * (NPROJ / 32), I_OUT = 16 * (DM / 32), I_UP = 16 * (FF / 32), I_DOWN = (FF / 64) * (DM / 32), I_PG = 16 * (DM / 32), I_PLE = (PLED / 64) * (DM / 32);
        constexpr int NITEMS = I_IN + I_OUT + 2 * I_UP + I_DOWN + I_PG + I_PLE;
        for (int it = gw; it < NITEMS; it += NGW) {
            int r = it;
            if (r < I_IN) { const int nb = r % (NPROJ / 32), kb = r / (NPROJ / 32); p0_transpose_item(w_in, DM, NPROJ, nullptr, Win_t, kb * 64, nb * 32, nb * 32, scr, lane); continue; } r -= I_IN;
            if (r < I_OUT) { const int nb = r % (DM / 32), kb = r / (DM / 32); p0_transpose_item(w_out, DM, DM, nullptr, Wout_t, kb * 64, nb * 32, nb * 32, scr, lane); continue; } r -= I_OUT;
            if (r < I_UP) { const int nb = r % (FF / 32), kb = r / (FF / 32), n0 = nb * 32; p0_transpose_item(w_up, DM, FF, ffn_norm, Wug_t, kb * 64, n0, (n0 >> 7) * 256 + (n0 & 127), scr, lane); continue; } r -= I_UP;
            if (r < I_UP) { const int nb = r % (FF / 32), kb = r / (FF / 32), n0 = nb * 32; p0_transpose_item(w_gate, DM, FF, ffn_norm, Wug_t, kb * 64, n0, (n0 >> 7) * 256 + 128 + (n0 & 127), scr, lane); continue; } r -= I_UP;
            if (r < I_DOWN) { const int nb = r % (DM / 32), kb = r / (DM / 32); p0_transpose_item(w_down, FF, DM, nullptr, Wdown_t, kb * 64, nb * 32, nb * 32, scr, lane); continue; } r -= I_DOWN;
            if (r < I_PG) { const int nb = r % (DM / 32), kb = r / (DM / 32); p0_transpose_item(w_ple_gate, DM, DM, ple_norm, Wpg_t, kb * 64, nb * 32, nb * 32, scr, lane); continue; } r -= I_PG;
            { const int nb = r % (DM / 32), kb = r / (DM / 32); p0_transpose_item(w_ple, PLED, DM, nullptr, Wple_t, kb * 64, nb * 32, nb * 32, scr, lane); }
        }
        for (int m = gw; m < MT; m += NGW) {
            const float4* xr = (const float4*)(x + (size_t)m * DM); float4 v[4]; float s = 0.f;
#pragma unroll
            for (int j = 0; j < 4; ++j) { v[j] = xr[lane + 64 * j]; s += v[j].x * v[j].x + v[j].y * v[j].y + v[j].z * v[j].z + v[j].w * v[j].w; }
            const float rs = rsqrtf(wave_sum(s) * (1.0f / DM) + RMS_EPS);
#pragma unroll
            for (int j = 0; j < 4; ++j) { const float4 gg = ((const float4*)attn_norm)[lane + 64 * j];
                ushort4 o; o.x = f2bf(v[j].x * rs * gg.x); o.y = f2bf(v[j].y * rs * gg.y); o.z = f2bf(v[j].z * rs * gg.z); o.w = f2bf(v[j].w * rs * gg.w);
                ((ushort4*)(XN + (size_t)m * DM))[lane + 64 * j] = o; }
        }
        { const size_t n4 = (size_t)MT * PLED / 4; const size_t gt = (size_t)vcu * NTHREADS + tid, GT = (size_t)G * NTHREADS;
          for (size_t i = gt; i < n4; i += GT) { const float4 v = ((const float4*)p)[i]; ushort4 o; o.x = f2bf(v.x); o.y = f2bf(v.y); o.z = f2bf(v.z); o.w = f2bf(v.w); ((ushort4*)PB)[i] = o; }
          for (size_t i = gt; i < 16 * 64 * 64; i += GT) KM[i] = 0.f;
          if (gt < 64) ((int*)(ws + WS_CTL))[gt] = 0; }
    }
    SEAM(0);
    if (IN(1)) {
        pg8::Gemm g{XN, Win_t, MT, NPROJ, DM}; pg8::StaticOrder S; S.init(MT, NPROJ, G, bx);
        pg8::EpiProj E{PROJ, KM};
        pg8::gemm_phase<pg8::EpiProj, pg8::StaticOrder, true, true>((PG8_LAS unsigned char*)lds, g, S, E);
    }
    SEAM(1);
    if (IN(2)) {
        mx::lds_ptr L = (mx::lds_ptr)lds;
        if (!(a.flags & 1)) for (int it = bx; it < 512; it += G) mx::ret_kv_task(PROJ, it >> 6, it & 63, KVT, L, tid);
        if (!(a.flags & 2)) {
            for (int it = bx; it < 16 * 63; it += G) gate_task(it / 63, 1 + it % 63, PROJ, KM, SEL, SEG, CNT, lds);
            { const int gtid = vcu * NTHREADS + tid; if (gtid < BATCH * 256 * 8) { const int h = gtid & 7, t = (gtid >> 3) & 255, b = gtid >> 11; SEL[((size_t)b * SEQ + t) * 8 + h] = 0u; } }
            for (int it = bx; it < 16 * 64; it += G) mx::moba_diag_unit(PROJ, it >> 6, it & 63, PART_O, PART_L, L, tid);
        }
    }
    SEAM(2);
    if (IN(3)) {
        mx::lds_ptr L = (mx::lds_ptr)lds;
        if (!(a.flags & 1)) mx::ret_scan(KVT, STT, (size_t)vcu * NTHREADS + tid, (size_t)G * NTHREADS);
        if (!(a.flags & 2)) {
            LAS int* qslot = (LAS int*)(L + mx::L_PREF + 384);
            for (;;) {
                if (tid == 0) *qslot = atomicAdd((int*)(ws + WS_CTL), 1);
                __syncthreads();
                const int q = *qslot;
                __syncthreads();
                if (q >= 16 * 63) break;
                mx::moba_sel_task(PROJ, SEG, CNT, q & 15, q >> 4, PART_O, PART_L, L, tid);
            }
        }
    }
    SEAM(3);
    if (IN(4)) {
        mx::lds_ptr L = (mx::lds_ptr)lds;
        if (!(a.flags & 1)) for (int it = bx; it < 512; it += G) mx::ret_out_task(PROJ, STT, ret_norm, MIX, it >> 6, it & 63, L, tid);
        if (!(a.flags & 2)) mx::moba_combine(PART_O, PART_L, SEL, MIX, (size_t)vcu * NTHREADS + tid, (size_t)G * NTHREADS);
    }
    SEAM(4);
    if (IN(5)) {
        pg8::Gemm g{MIX, Wout_t, MT, DM, DM}; pg8::StaticOrder S; S.init(MT, DM, G, bx);
        pg8::EpiRes E{x, out, XB, RSQ};
        pg8::gemm_phase<pg8::EpiRes, pg8::StaticOrder, true, true>((PG8_LAS unsigned char*)lds, g, S, E);
    }
    SEAM(5);
    if (IN(6)) {
        pg8::Gemm g{XB, Wug_t, MT, 2 * FF, DM}; pg8::StaticOrder S; S.init(MT, 2 * FF, G, bx);
        pg8::EpiUG E{ACT, RSQ, conv_w, conv_b, UL, UF, GF};
        pg8::gemm_phase<pg8::EpiUG, pg8::StaticOrder, true, true>((PG8_LAS unsigned char*)lds, g, S, E);
    }
    SEAM(6);
    if (IN(7)) {
        const size_t gt = (size_t)vcu * NTHREADS + tid, GT = (size_t)G * NTHREADS;
        for (size_t i = gt; i < (size_t)512 * 2 * FF; i += GT) {
            const int c = (int)(i % FF), r = (int)((i / FF) & 1), g64 = (int)(i / FF / 2);
            float p0 = 0.f, p1 = 0.f;
            if ((g64 & 255) != 0) { p0 = UL[((size_t)(g64 - 1) * 2 + 0) * FF + c]; p1 = UL[((size_t)(g64 - 1) * 2 + 1) * FF + c]; }
            const float f0 = UF[((size_t)g64 * 2 + 0) * FF + c], f1 = UF[((size_t)g64 * 2 + 1) * FF + c];
            const float gg = GF[((size_t)g64 * 2 + r) * FF + c];
            const float u2 = r == 0 ? p0 : p1, u1 = r == 0 ? p1 : f0, u0 = r == 0 ? f0 : f1;
            const float y = conv_b[c] + conv_w[c] * u2 + conv_w[FF + c] * u1 + conv_w[2 * FF + c] * u0;
            ACT[((size_t)g64 * 64 + r) * FF + c] = f2bf(gelu_tanh(y) * gg);
        }
    }
    SEAM(7);
    if (IN(8)) {
        pg8::Gemm g{ACT, Wdown_t, MT, DM, FF}; pg8::StaticOrder S; S.init(MT, DM, G, bx);
        pg8::EpiRes E{out, out, XB, RSQ + (size_t)MT * 16};
        pg8::gemm_phase<pg8::EpiRes, pg8::StaticOrder, true, true>((PG8_LAS unsigned char*)lds, g, S, E);
    }
    SEAM(8);
    if (IN(9)) {
        { int kk = PLED; asm volatile("" : "+s"(kk)); pg8::Gemm g{PB, Wple_t, MT, DM, kk}; pg8::StaticOrder S; S.init(MT, DM, G, bx); pg8::EpiStore E{PW};
          pg8::gemm_phase<pg8::EpiStore, pg8::StaticOrder, true, true>((PG8_LAS unsigned char*)lds, g, S, E); }
        { int kk = DM; const bf16_t* a_ = XB; const bf16_t* b_ = Wpg_t; asm volatile("" : "+s"(kk), "+s"(a_), "+s"(b_) :: "memory"); pg8::Gemm g{a_, b_, MT, DM, kk}; pg8::StaticOrder S; S.init(MT, DM, G, bx); pg8::EpiPle E{out, PW, RSQ + (size_t)MT * 16, RSQ + (size_t)2 * MT * 16};
          pg8::gemm_phase<pg8::EpiPle, pg8::StaticOrder, true, true>((PG8_LAS unsigned char*)lds, g, S, E); }
    }
    SEAM(9);
    if (IN(10)) {
        const float* rsq = RSQ + (size_t)2 * MT * 16;
        for (int m = gw; m < MT; m += NGW) {
            const float rs = pg8::rs16(rsq + (size_t)m * 16); float4* xr = (float4*)(out + (size_t)m * DM);
#pragma unroll
            for (int j = 0; j < 4; ++j) { float4 v = xr[lane + 64 * j]; const float4 gg = ((const float4*)final_norm)[lane + 64 * j];
                v.x *= rs * gg.x; v.y *= rs * gg.y; v.z *= rs * gg.z; v.w *= rs * gg.w; xr[lane + 64 * j] = v; }
        }
    }
#undef IN
#undef SEAM
}

#ifndef BUILD_MODE
#define BUILD_MODE 0
#endif
static int g_grid = 0;
static void launch_mega(Args a, int lo, int hi, hipStream_t stream) {
    a.ph_lo = lo; a.ph_hi = hi; void* args[] = {&a};
    hipError_t e = hipLaunchCooperativeKernel((const void*)mega, dim3(g_grid), dim3(NTHREADS), args, LDS_BYTES, stream);
    if (e != hipSuccess) fprintf(stderr, "cooperative launch [%d,%d) failed: %s (grid %d)\n", lo, hi, hipGetErrorString(e), g_grid);
}
extern "C" void kernel_launch(void* const* d_in, const int* in_sizes, int n_in, void* d_out, int out_size, void* d_ws, size_t ws_size, hipStream_t stream) {
    if (n_in != 16 || out_size != MT * DM || ws_size < WS_END) { fprintf(stderr, "kernel_launch: unexpected shapes (n_in %d out %d ws %zu)\n", n_in, out_size, ws_size); return; }
    if (g_grid == 0) {
        int dev = 0, cus = 0, per_cu = 0;
        hipGetDevice(&dev); hipDeviceGetAttribute(&cus, hipDeviceAttributeMultiprocessorCount, dev);
        hipFuncSetAttribute((const void*)mega, hipFuncAttributeMaxDynamicSharedMemorySize, LDS_BYTES);
        hipOccupancyMaxActiveBlocksPerMultiprocessor(&per_cu, (const void*)mega, NTHREADS, LDS_BYTES);
        if (per_cu < 1) { fprintf(stderr, "occupancy query says %d blocks/CU\n", per_cu); per_cu = 1; }
        g_grid = cus * 1;
        (void)hipGetLastError();
    }
    const float* ret_norm = (const float*)d_in[4];
    unsigned char* ws = (unsigned char*)d_ws;
    bf16_t* MIX = (bf16_t*)(ws + WS_R1); float* RETRAW = (float*)(ws + WS_R2);
    bf16_t* PROJ = (bf16_t*)(ws + WS_PROJ);
    float* KM = (float*)(ws + WS_KMEAN); u32* SEL = (u32*)(ws + WS_SEL); unsigned short* SEG = (unsigned short*)(ws + WS_SEG); int* CNT = (int*)(ws + WS_CNT);
    Args a{}; for (int i = 0; i < 16; ++i) a.in[i] = (const float*)d_in[i]; a.out = (float*)d_out; a.ws = ws;

#if BUILD_MODE == 0
    a.flags = 0; launch_mega(a, 0, NPH, stream);
#elif BUILD_MODE == 1
    a.flags = 1; launch_mega(a, 0, 5, stream);
    k_ret_naive<<<dim3(SEQ / 64, BATCH * RH), 256, 0, stream>>>(PROJ, RETRAW);
    k_ret_post<<<MT * RH / 4, 256, 0, stream>>>(RETRAW, PROJ, ret_norm, MIX);
    launch_mega(a, 5, NPH, stream);
#elif BUILD_MODE == 2
    a.flags = 2; launch_mega(a, 0, 2, stream);
    k_sel_block0<<<BATCH * 256 * 8 / 256, 256, 0, stream>>>(SEL);
    k_gate<<<16 * 63, 512, 0, stream>>>(PROJ, KM, SEL, SEG, CNT);
    k_moba_naive<<<16 * SEQ / 256, 256, 0, stream>>>(PROJ, SEL, MIX);
    launch_mega(a, 2, NPH, stream);
#endif
}
```

```cpp
#include <hip/hip_runtime.h>
#include <stdint.h>
#include <math.h>
#include <cstdio>

typedef unsigned short bf16_t;
typedef unsigned int u32;

constexpr int BATCH = 2, SEQ = 16384, MT = BATCH * SEQ, DM = 1024, NPROJ = 3584, FF = 2816, PLED = 256;
constexpr int MH = 8, MD = 64, RH = 4, RD = 128, NBLK = 64, BLK = 256;
constexpr int C_MQ = 0, C_MK = 512, C_MV = 1024, C_RQ = 1536, C_RK = 2048, C_RV = 2560, C_RG = 3072;
constexpr float RMS_EPS = 1e-6f, GN_EPS = 1e-5f;
constexpr float LOG2E = 1.4426950408889634f;
constexpr float QSCALE = 0.125f * LOG2E;
constexpr float RKSCALE = 0.08838834764831845f;

constexpr size_t MiB = (size_t)1 << 20;
constexpr size_t WS_CTL = 0, WS_WIN = 1 * MiB, WS_WOUT = 8 * MiB, WS_WUG = 10 * MiB, WS_WDOWN = 21 * MiB, WS_WPG = 27 * MiB, WS_WPLE = 29 * MiB;
constexpr size_t WS_RSQ = 30 * MiB;
constexpr size_t WS_PB = 36 * MiB;
constexpr size_t WS_R2 = 52 * MiB;
constexpr size_t WS_R1 = 116 * MiB;
constexpr size_t WS_SEG = 180 * MiB;
constexpr size_t WS_KVT = 212 * MiB;
constexpr size_t WS_STT = 244 * MiB;
constexpr size_t WS_PARTL = 260 * MiB;
constexpr size_t WS_SEL = 264 * MiB;
constexpr size_t WS_CNT = 265 * MiB;
constexpr size_t WS_KMEAN = WS_CNT + 512 * 1024;
constexpr size_t WS_PROJ = 266 * MiB;
constexpr size_t WS_END = 490 * MiB;
constexpr size_t WS_UH = 116 * MiB;

__device__ __forceinline__ float bf2f(bf16_t v) { return __uint_as_float(((u32)v) << 16); }
__device__ __forceinline__ bf16_t f2bf(float f) { u32 u = __float_as_uint(f); return (bf16_t)((u + 0x7fffu + ((u >> 16) & 1u)) >> 16); }
__device__ __forceinline__ float wave_sum(float v) {
#pragma unroll
    for (int o = 1; o < 64; o <<= 1) v += __shfl_xor(v, o);
    return v;
}
__device__ __forceinline__ float rs_from(const float* p) {
    float s = 0.f;
#pragma unroll
    for (int i = 0; i < 16; ++i) s += p[i];
    return rsqrtf(s * (1.0f / DM) + RMS_EPS);
}
__device__ __forceinline__ float gelu_tanh(float x) {
    const float z = 0.7978845608028654f * (x + 0.044715f * x * x * x);
    return x / (1.0f + __expf(-2.0f * z));
}
__device__ __forceinline__ float sigmoidf_(float x) { return 1.0f / (1.0f + __expf(-x)); }

__global__ __launch_bounds__(256) void k_rmsnorm_bf16(const float* __restrict__ x, const float* __restrict__ g, bf16_t* __restrict__ out) {
    const int row = blockIdx.x * 4 + (threadIdx.x >> 6), lane = threadIdx.x & 63;
    const float4* xr = (const float4*)(x + (size_t)row * DM);
    float4 v[4]; float s = 0.f;
#pragma unroll
    for (int j = 0; j < 4; ++j) { v[j] = xr[lane + 64 * j]; s += v[j].x * v[j].x + v[j].y * v[j].y + v[j].z * v[j].z + v[j].w * v[j].w; }
    const float rs = rsqrtf(wave_sum(s) * (1.0f / DM) + RMS_EPS);
#pragma unroll
    for (int j = 0; j < 4; ++j) {
        const float4 gg = ((const float4*)g)[lane + 64 * j];
        ushort4 o; o.x = f2bf(v[j].x * rs * gg.x); o.y = f2bf(v[j].y * rs * gg.y); o.z = f2bf(v[j].z * rs * gg.z); o.w = f2bf(v[j].w * rs * gg.w);
        ((ushort4*)(out + (size_t)row * DM))[lane + 64 * j] = o;
    }
}
__global__ void k_cvt_bf16(const float* __restrict__ in, bf16_t* __restrict__ out, size_t n) {
    for (size_t i = (size_t)blockIdx.x * blockDim.x + threadIdx.x; i < n; i += (size_t)gridDim.x * blockDim.x) out[i] = f2bf(in[i]);
}
__global__ __launch_bounds__(256) void k_rowsq(const float* __restrict__ x, float* __restrict__ rsq) {
    const int row = blockIdx.x * 4 + (threadIdx.x >> 6), lane = threadIdx.x & 63;
    const float4* xr = (const float4*)(x + (size_t)row * DM);
    float s = 0.f;
#pragma unroll
    for (int j = 0; j < 4; ++j) { const float4 v = xr[lane + 64 * j]; s += v.x * v.x + v.y * v.y + v.z * v.z + v.w * v.w; }
    s = wave_sum(s);
    if (lane < 16) rsq[(size_t)row * 16 + lane] = lane == 0 ? s : 0.f;
}
__global__ __launch_bounds__(256) void k_final_norm(float* __restrict__ x, const float* __restrict__ rsq, const float* __restrict__ g) {
    const int row = blockIdx.x * 4 + (threadIdx.x >> 6), lane = threadIdx.x & 63;
    const float rs = rs_from(rsq + (size_t)row * 16);
    float4* xr = (float4*)(x + (size_t)row * DM);
#pragma unroll
    for (int j = 0; j < 4; ++j) { float4 v = xr[lane + 64 * j]; const float4 gg = ((const float4*)g)[lane + 64 * j];
        v.x *= rs * gg.x; v.y *= rs * gg.y; v.z *= rs * gg.z; v.w *= rs * gg.w; xr[lane + 64 * j] = v; }
}

template <class Epi>
__global__ __launch_bounds__(256) void ngemm(const bf16_t* __restrict__ A, const float* __restrict__ Bm, const float* __restrict__ gk, int lda, int ldb, int K, int pad_, Epi e) {
    __shared__ float As[16][65];
    __shared__ float Bs[16][64];
    const int tid = threadIdx.x, tx = tid & 15, ty = tid >> 4;
    const int r0 = blockIdx.y * 64, c0 = blockIdx.x * 64;
    float acc[4][4];
#pragma unroll
    for (int i = 0; i < 4; ++i)
#pragma unroll
        for (int j = 0; j < 4; ++j) acc[i][j] = 0.f;
    for (int k0 = 0; k0 < K; k0 += 16) {
        { const int row = tid >> 2, kq = (tid & 3) * 4; const ushort4 a = *(const ushort4*)(A + (size_t)(r0 + row) * lda + k0 + kq);
          As[kq + 0][row] = bf2f(a.x); As[kq + 1][row] = bf2f(a.y); As[kq + 2][row] = bf2f(a.z); As[kq + 3][row] = bf2f(a.w); }
        { const int k = tid >> 4, n4 = (tid & 15) * 4; float4 b = *(const float4*)(Bm + (size_t)(k0 + k) * ldb + c0 + n4);
          const float gg = gk ? gk[k0 + k] : 1.0f; Bs[k][n4] = b.x * gg; Bs[k][n4 + 1] = b.y * gg; Bs[k][n4 + 2] = b.z * gg; Bs[k][n4 + 3] = b.w * gg; }
        __syncthreads();
#pragma unroll
        for (int kk = 0; kk < 16; ++kk) {
            float a[4], b[4];
#pragma unroll
            for (int i = 0; i < 4; ++i) { a[i] = As[kk][ty * 4 + i]; b[i] = Bs[kk][tx * 4 + i]; }
#pragma unroll
            for (int i = 0; i < 4; ++i)
#pragma unroll
                for (int j = 0; j < 4; ++j) acc[i][j] += a[i] * b[j];
        }
        __syncthreads();
    }
#pragma unroll
    for (int i = 0; i < 4; ++i)
#pragma unroll
        for (int j = 0; j < 4; ++j) e(r0 + ty * 4 + i, c0 + tx * 4 + j, acc[i][j]);
}
struct NEpiProj { bf16_t* O; __device__ void operator()(int r, int c, float v) const {
    const float sc = c < 512 ? QSCALE : ((c >= C_RK && c < C_RV) ? RKSCALE : 1.0f); O[(size_t)r * NPROJ + c] = f2bf(v * sc); } };
struct NEpiRes { const float* base; float* out; bf16_t* xb; __device__ void operator()(int r, int c, float v) const {
    const size_t i = (size_t)r * DM + c; const float y = base[i] + v; out[i] = y; xb[i] = f2bf(y); } };
struct NEpiScaleBf16 { bf16_t* O; const float* rsq; int ldo; int row_off; __device__ void operator()(int r, int c, float v) const {
    const float rs = rsq ? rs_from(rsq + (size_t)(r + row_off) * 16) : 1.0f; O[(size_t)r * ldo + c] = f2bf(v * rs); } };
struct NEpiPle { float* out; const bf16_t* pw; const float* rsq; __device__ void operator()(int r, int c, float v) const {
    const size_t i = (size_t)r * DM + c; const float rs = rs_from(rsq + (size_t)r * 16); out[i] = out[i] + bf2f(pw[i]) * sigmoidf_(v * rs); } };

__global__ void k_kmean(const bf16_t* __restrict__ proj, float* __restrict__ km) {
    const int bhb = blockIdx.x, d = threadIdx.x, blk = bhb & 63, h = (bhb >> 6) & 7, b = bhb >> 9;
    float s = 0.f;
    for (int j = 0; j < 256; ++j) s += bf2f(proj[(size_t)(b * SEQ + blk * 256 + j) * NPROJ + C_MK + h * 64 + d]);
    km[(size_t)bhb * 64 + d] = s;
}

__device__ __forceinline__ void gate_task(int bh, int i, const bf16_t* __restrict__ proj, const float* __restrict__ kmsum, u32* __restrict__ sel,
                                          unsigned short* __restrict__ seg, int* __restrict__ cnt, unsigned char* lds_raw) {
    float* km = (float*)lds_raw; int* cntL = (int*)(lds_raw + 16384);
    const int tid = threadIdx.x, b = bh >> 3, h = bh & 7;
    for (int e = tid; e < i * 64; e += blockDim.x) km[e] = kmsum[(size_t)bh * 4096 + e] * (1.0f / 256.0f);
    if (tid < 64) cntL[tid] = 0;
    __syncthreads();
    if (tid < 256) {
        const int t = i * 256 + tid; const size_t row = (size_t)b * SEQ + t;
        float q[64];
        const uint4* qp = (const uint4*)(proj + row * NPROJ + C_MQ + h * 64);
#pragma unroll
        for (int c = 0; c < 8; ++c) { const uint4 u = qp[c];
            q[c * 8 + 0] = __uint_as_float(u.x << 16); q[c * 8 + 1] = __uint_as_float(u.x & 0xffff0000u);
            q[c * 8 + 2] = __uint_as_float(u.y << 16); q[c * 8 + 3] = __uint_as_float(u.y & 0xffff0000u);
            q[c * 8 + 4] = __uint_as_float(u.z << 16); q[c * 8 + 5] = __uint_as_float(u.z & 0xffff0000u);
            q[c * 8 + 6] = __uint_as_float(u.w << 16); q[c * 8 + 7] = __uint_as_float(u.w & 0xffff0000u); }
        float v0 = -INFINITY, v1 = -INFINITY, v2 = -INFINITY; int i0 = 0, i1 = 0, i2 = 0;
        for (int n = 0; n < i; ++n) {
            const float4* kr = (const float4*)(km + n * 64);
            float d0 = 0.f, d1 = 0.f;
#pragma unroll
            for (int c = 0; c < 16; c += 2) { const float4 a = kr[c], bb = kr[c + 1];
                d0 += q[c * 4] * a.x + q[c * 4 + 1] * a.y + q[c * 4 + 2] * a.z + q[c * 4 + 3] * a.w;
                d1 += q[c * 4 + 4] * bb.x + q[c * 4 + 5] * bb.y + q[c * 4 + 6] * bb.z + q[c * 4 + 7] * bb.w; }
            const float v = d0 + d1;
            if (v > v0) { v2 = v1; i2 = i1; v1 = v0; i1 = i0; v0 = v; i0 = n; }
            else if (v > v1) { v2 = v1; i2 = i1; v1 = v; i1 = n; }
            else if (v > v2) { v2 = v; i2 = n; }
        }
        const int nv = i < 3 ? i : 3;
        sel[row * 8 + h] = (u32)i0 | ((u32)i1 << 8) | ((u32)i2 << 16) | ((u32)nv << 24);
#pragma unroll
        for (int s = 0; s < 3; ++s) if (s < nv) { const int n = s == 0 ? i0 : (s == 1 ? i1 : i2);
            const int pos = atomicAdd(&cntL[n], 1);
            seg[(((size_t)bh * 64 + n) * 64 + i) * 256 + pos] = (unsigned short)((tid << 2) | s); }
    }
    __syncthreads();
    if (tid < i) cnt[((size_t)bh * 64 + tid) * 64 + i] = cntL[tid];
    __syncthreads();
}
__global__ __launch_bounds__(512) void k_gate(const bf16_t* proj, const float* kmsum, u32* sel, unsigned short* seg, int* cnt) {
    __shared__ __attribute__((aligned(16))) unsigned char lds[16384 + 256];
    const int task = blockIdx.x, bh = task / 63, i = 1 + task % 63;
    gate_task(bh, i, proj, kmsum, sel, seg, cnt, lds);
}
__global__ void k_sel_block0(u32* sel) {
    const int g = blockIdx.x * blockDim.x + threadIdx.x;
    const int h = g & 7, t = (g >> 3) & 255, b = g >> 11;
    sel[((size_t)b * SEQ + t) * 8 + h] = 0u;
}

__global__ __launch_bounds__(256) void k_moba_naive(const bf16_t* __restrict__ proj, const u32* __restrict__ sel, bf16_t* __restrict__ mix) {
    const int gid = blockIdx.x * 256 + threadIdx.x; const int t = gid & (SEQ - 1), bh = gid >> 14, b = bh >> 3, h = bh & 7;
    const size_t row = (size_t)b * SEQ + t;
    float q[64], acc[64];
    { const uint4* qp = (const uint4*)(proj + row * NPROJ + C_MQ + h * 64);
#pragma unroll
      for (int c = 0; c < 8; ++c) { const uint4 u = qp[c];
        q[c * 8 + 0] = __uint_as_float(u.x << 16); q[c * 8 + 1] = __uint_as_float(u.x & 0xffff0000u);
        q[c * 8 + 2] = __uint_as_float(u.y << 16); q[c * 8 + 3] = __uint_as_float(u.y & 0xffff0000u);
        q[c * 8 + 4] = __uint_as_float(u.z << 16); q[c * 8 + 5] = __uint_as_float(u.z & 0xffff0000u);
        q[c * 8 + 6] = __uint_as_float(u.w << 16); q[c * 8 + 7] = __uint_as_float(u.w & 0xffff0000u); } }
#pragma unroll
    for (int d = 0; d < 64; ++d) acc[d] = 0.f;
    const u32 sp = sel[row * 8 + h]; const int nv = sp >> 24, own = t >> 8;
    const float slope2 = exp2f(-(float)(h + 1)) * LOG2E;
    float m = -1e30f, l = 0.f;
    for (int s = 0; s <= nv; ++s) {
        const int blk = s < nv ? (int)((sp >> (8 * s)) & 255u) : own;
        const int nk = s < nv ? 256 : (t & 255) + 1;
        for (int j = 0; j < nk; ++j) {
            const int kp = blk * 256 + j;
            const uint4* kr = (const uint4*)(proj + ((size_t)b * SEQ + kp) * NPROJ + C_MK + h * 64);
            float dot = 0.f;
#pragma unroll
            for (int c = 0; c < 8; ++c) { const uint4 u = kr[c];
                dot += q[c * 8 + 0] * __uint_as_float(u.x << 16) + q[c * 8 + 1] * __uint_as_float(u.x & 0xffff0000u)
                     + q[c * 8 + 2] * __uint_as_float(u.y << 16) + q[c * 8 + 3] * __uint_as_float(u.y & 0xffff0000u)
                     + q[c * 8 + 4] * __uint_as_float(u.z << 16) + q[c * 8 + 5] * __uint_as_float(u.z & 0xffff0000u)
                     + q[c * 8 + 6] * __uint_as_float(u.w << 16) + q[c * 8 + 7] * __uint_as_float(u.w & 0xffff0000u); }
            const float sc = dot - slope2 * (float)(t - kp);
            if (sc > m) { const float f = exp2f(m - sc); l *= f;
#pragma unroll
                for (int d = 0; d < 64; ++d) acc[d] *= f;
                m = sc; }
            const float p = exp2f(sc - m); l += p;
            const uint4* vr = (const uint4*)(proj + ((size_t)b * SEQ + kp) * NPROJ + C_MV + h * 64);
#pragma unroll
            for (int c = 0; c < 8; ++c) { const uint4 u = vr[c];
                acc[c * 8 + 0] += p * __uint_as_float(u.x << 16); acc[c * 8 + 1] += p * __uint_as_float(u.x & 0xffff0000u);
                acc[c * 8 + 2] += p * __uint_as_float(u.y << 16); acc[c * 8 + 3] += p * __uint_as_float(u.y & 0xffff0000u);
                acc[c * 8 + 4] += p * __uint_as_float(u.z << 16); acc[c * 8 + 5] += p * __uint_as_float(u.z & 0xffff0000u);
                acc[c * 8 + 6] += p * __uint_as_float(u.w << 16); acc[c * 8 + 7] += p * __uint_as_float(u.w & 0xffff0000u); }
        }
    }
    const float il = 1.0f / l;
#pragma unroll
    for (int d = 0; d < 64; ++d) mix[row * DM + h * 64 + d] = f2bf(acc[d] * il);
}

__global__ __launch_bounds__(256) void k_ret_naive(const bf16_t* __restrict__ proj, float* __restrict__ retraw) {
    const int tl = threadIdx.x & 63, eq = threadIdx.x >> 6, t = blockIdx.x * 64 + tl, bh = blockIdx.y, b = bh >> 2, h = bh & 3;
    const size_t row = (size_t)b * SEQ + t;
    float q[128], acc[32];
    { const uint4* qp = (const uint4*)(proj + row * NPROJ + C_RQ + h * 128);
#pragma unroll
      for (int c = 0; c < 16; ++c) { const uint4 u = qp[c];
        q[c * 8 + 0] = __uint_as_float(u.x << 16); q[c * 8 + 1] = __uint_as_float(u.x & 0xffff0000u);
        q[c * 8 + 2] = __uint_as_float(u.y << 16); q[c * 8 + 3] = __uint_as_float(u.y & 0xffff0000u);
        q[c * 8 + 4] = __uint_as_float(u.z << 16); q[c * 8 + 5] = __uint_as_float(u.z & 0xffff0000u);
        q[c * 8 + 6] = __uint_as_float(u.w << 16); q[c * 8 + 7] = __uint_as_float(u.w & 0xffff0000u); } }
#pragma unroll
    for (int e = 0; e < 32; ++e) acc[e] = 0.f;
    const float log2g = log2f(1.0f - exp2f(-5.0f - (float)h));
    const int smax = blockIdx.x * 64 + 63;
    for (int s = 0; s <= smax; ++s) {
        const uint4* kr = (const uint4*)(proj + ((size_t)b * SEQ + s) * NPROJ + C_RK + h * 128);
        float dot = 0.f;
#pragma unroll
        for (int c = 0; c < 16; ++c) { const uint4 u = kr[c];
            dot += q[c * 8 + 0] * __uint_as_float(u.x << 16) + q[c * 8 + 1] * __uint_as_float(u.x & 0xffff0000u)
                 + q[c * 8 + 2] * __uint_as_float(u.y << 16) + q[c * 8 + 3] * __uint_as_float(u.y & 0xffff0000u)
                 + q[c * 8 + 4] * __uint_as_float(u.z << 16) + q[c * 8 + 5] * __uint_as_float(u.z & 0xffff0000u)
                 + q[c * 8 + 6] * __uint_as_float(u.w << 16) + q[c * 8 + 7] * __uint_as_float(u.w & 0xffff0000u); }
        const float w = s <= t ? dot * exp2f((float)(t - s) * log2g) : 0.f;
        const uint4* vr = (const uint4*)(proj + ((size_t)b * SEQ + s) * NPROJ + C_RV + h * 128 + eq * 32);
#pragma unroll
        for (int c = 0; c < 4; ++c) { const uint4 u = vr[c];
            acc[c * 8 + 0] += w * __uint_as_float(u.x << 16); acc[c * 8 + 1] += w * __uint_as_float(u.x & 0xffff0000u);
            acc[c * 8 + 2] += w * __uint_as_float(u.y << 16); acc[c * 8 + 3] += w * __uint_as_float(u.y & 0xffff0000u);
            acc[c * 8 + 4] += w * __uint_as_float(u.z << 16); acc[c * 8 + 5] += w * __uint_as_float(u.z & 0xffff0000u);
            acc[c * 8 + 6] += w * __uint_as_float(u.w << 16); acc[c * 8 + 7] += w * __uint_as_float(u.w & 0xffff0000u); }
    }
#pragma unroll
    for (int e = 0; e < 32; ++e) retraw[row * 512 + h * 128 + eq * 32 + e] = acc[e];
}
__global__ __launch_bounds__(256) void k_ret_post(const float* __restrict__ retraw, const bf16_t* __restrict__ proj, const float* __restrict__ gain, bf16_t* __restrict__ mix) {
    const int wid = blockIdx.x * 4 + (threadIdx.x >> 6), lane = threadIdx.x & 63; const int h = wid & 3; const size_t row = wid >> 2;
    const float a = retraw[row * 512 + h * 128 + lane], c = retraw[row * 512 + h * 128 + 64 + lane];
    const float mu = wave_sum(a + c) * (1.0f / 128.0f); const float da = a - mu, dc = c - mu;
    const float var = wave_sum(da * da + dc * dc) * (1.0f / 128.0f); const float r = rsqrtf(var + GN_EPS);
    const float g0 = bf2f(proj[row * NPROJ + C_RG + h * 128 + lane]), g1 = bf2f(proj[row * NPROJ + C_RG + h * 128 + 64 + lane]);
    mix[row * DM + 512 + h * 128 + lane] = f2bf(da * r * gain[h * 128 + lane] * (g0 * sigmoidf_(g0)));
    mix[row * DM + 512 + h * 128 + 64 + lane] = f2bf(dc * r * gain[h * 128 + 64 + lane] * (g1 * sigmoidf_(g1)));
}
__global__ void k_conv_act(const bf16_t* __restrict__ U, bf16_t* __restrict__ act, const float* __restrict__ cw, const float* __restrict__ cb) {
    const size_t n = (size_t)SEQ * FF;
    for (size_t i = (size_t)blockIdx.x * blockDim.x + threadIdx.x; i < n; i += (size_t)gridDim.x * blockDim.x) {
        const int t = (int)(i / FF), c = (int)(i % FF);
        const float u0 = bf2f(U[i]), u1 = t >= 1 ? bf2f(U[i - FF]) : 0.f, u2 = t >= 2 ? bf2f(U[i - 2 * FF]) : 0.f;
        const float y = cb[c] + cw[c] * u2 + cw[FF + c] * u1 + cw[2 * FF + c] * u0;
        act[i] = f2bf(gelu_tanh(y) * bf2f(act[i]));
    }
}

namespace pg8 {
#define PG8_LAS __attribute__((address_space(3)))
typedef unsigned short bf16_t;
typedef short bf16x8 __attribute__((ext_vector_type(8)));
typedef float f32x4 __attribute__((ext_vector_type(4)));
typedef unsigned u32x4 __attribute__((ext_vector_type(4)));
constexpr int BM = 256, BK = 64, HALF = 128, HTB = HALF * BK * 2  , STAGE_BYTES = 8 * HTB, NXCD = 8, WGM = 8;

__host__ __device__ __forceinline__ int lds_byte(int r, int c) { const int st = (r >> 4) * 2 + (c >> 5), rr = r & 15, cc = c & 31, ob = rr * 64 + cc * 2; return st * 1024 + (ob ^ (((ob >> 9) & 1) << 5)); }
__host__ __device__ __forceinline__ void stage_rc(int b, int& R, int& C) { const int st = b / 1024, sb = b % 1024, swz = sb ^ (((sb >> 9) & 1) << 5); R = (st >> 1) * 16 + swz / 64; C = (st & 1) * 32 + (swz % 64) / 2; }
__host__ __device__ __forceinline__ int perm32(int rho) { const int n = rho >> 4, i = rho & 15; return 8 * (i >> 2) + 4 * n + (i & 3); }

struct Unit { int pm, pn; };
struct Gemm { const bf16_t* A; const bf16_t* Bt; int M, N, K; };

struct StaticOrder {
    int nM, nN, nwg, G, c;
    __host__ __device__ void init(int M, int N, int G_, int c_) { nM = M / BM; nN = N / BM; nwg = nM * nN; G = G_; c = c_; }
    __host__ __device__ bool next(int i, Unit& u) const {
        const long L = (long)i * G + c; if (L >= nwg) return false;
        int wgid = (int)L; { const int q = nwg / NXCD, r = nwg % NXCD, xcd = wgid % NXCD, off = wgid / NXCD; wgid = (xcd < r ? xcd * (q + 1) : r * (q + 1) + (xcd - r) * q) + off; }
        const int nig = WGM * nN, gid = wgid / nig, fm = gid * WGM, gsz = (nM - fm) < WGM ? (nM - fm) : WGM;
        u.pm = fm + ((wgid % nig) % gsz); u.pn = (wgid % nig) / gsz; return true;
    }
    __device__ __forceinline__ void a_ready(const Unit&) const {}
    __device__ __forceinline__ void done(const Unit&) const {}
};

__device__ __forceinline__ unsigned cvt_pk_bf16(float lo, float hi) { unsigned r; asm volatile("v_cvt_pk_bf16_f32 %0, %1, %2" : "=v"(r) : "v"(lo), "v"(hi)); return r; }
typedef float f32x2 __attribute__((ext_vector_type(2)));
template <class Epi, class Sched, bool ALIGN_EPI = false, bool SP2 = false>
__device__ __forceinline__ void gemm_phase(PG8_LAS unsigned char* lds, const Gemm g, const Sched& S, const Epi& E) {
    const int tid = threadIdx.x, wid = __builtin_amdgcn_readfirstlane(tid >> 6), lane = tid & 63, wr = wid >> 2, wc = wid & 3, fr = lane & 15, fq = lane >> 4;
    const int K = g.K, nt = K / BK;
    unsigned voffA[2], voffB[2];
#pragma unroll
    for (int i = 0; i < 2; ++i) { int R, C; stage_rc(tid * 16 + i * 8192, R, C); const int Rb = Epi::PERM ? ((R & ~31) + perm32(R & 31)) : R;
        voffA[i] = (unsigned)(R * K + C) * 2u; voffB[i] = (unsigned)(Rb * K + C) * 2u; }
    const size_t kstep = (size_t)(BK * 2);
    const size_t hstep = (size_t)HALF * K * 2;
    const size_t tstep = 2 * hstep;
    const unsigned ldsw = (unsigned)wid * 1024u;
    const int aoff = lds_byte(wr * 64 + fr, fq * 8), boff = lds_byte(wc * 32 + fr, fq * 8);
#define PG8_SA(b, h) (((b) * 2 + (h)) * HTB)
#define PG8_SB(b, h) ((4 + (b) * 2 + (h)) * HTB)
#define PG8_STAGE(bufoff, gbase, voff) do { _Pragma("unroll") for (int _i = 0; _i < 2; ++_i) \
        __builtin_amdgcn_global_load_lds((const unsigned*)((const char*)(gbase) + (voff)[_i]), (PG8_LAS unsigned*)(lds + (bufoff) + ldsw + _i * 8192), 16, 0, 0); } while (0)
#define PG8_LDA(dst, b, h) do { _Pragma("unroll") for (int m = 0; m < 4; ++m) _Pragma("unroll") for (int k = 0; k < 2; ++k) dst[m][k] = *(const PG8_LAS bf16x8*)(lds + PG8_SA(b, h) + aoff + m * 2048 + k * 1024); } while (0)
#define PG8_LDB(dst, b, h) do { _Pragma("unroll") for (int n = 0; n < 2; ++n) _Pragma("unroll") for (int k = 0; k < 2; ++k) dst[n][k] = *(const PG8_LAS bf16x8*)(lds + PG8_SB(b, h) + boff + n * 2048 + k * 1024); } while (0)
#define PG8_MMA(ai, bj, At, Bt) do { __builtin_amdgcn_s_setprio(1); _Pragma("unroll") for (int m = 0; m < 4; ++m) _Pragma("unroll") for (int n = 0; n < 2; ++n) _Pragma("unroll") for (int k = 0; k < 2; ++k) \
        acc[ai][bj][m][n] = __builtin_amdgcn_mfma_f32_16x16x32_bf16(Bt[n][k], At[m][k], acc[ai][bj][m][n], 0, 0, 0); __builtin_amdgcn_s_setprio(0); } while (0)
#define PG8_WAIT_V(n) asm volatile("s_waitcnt vmcnt(" #n ")" ::: "memory")
#define PG8_WAIT_L(n) asm volatile("s_waitcnt lgkmcnt(" #n ")" ::: "memory")
#define PG8_BAR __builtin_amdgcn_s_barrier()
#define PG8_SCHED __builtin_amdgcn_sched_barrier(0)
    Unit cur, nxt; int ui = 0;
    if (!S.next(0, cur)) return;
    f32x4 acc[2][2][4][2];
#pragma unroll
    for (int a = 0; a < 2; ++a)
#pragma unroll
        for (int b = 0; b < 2; ++b)
#pragma unroll
            for (int m = 0; m < 4; ++m)
#pragma unroll
                for (int n = 0; n < 2; ++n) acc[a][b][m][n] = (f32x4){0.f, 0.f, 0.f, 0.f};
    bf16x8 At[4][2], B0[2][2], B1[2][2];
    const char* cA = (const char*)g.A + (size_t)cur.pm * tstep; const char* cB = (const char*)g.Bt + (size_t)cur.pn * tstep;
    S.a_ready(cur);
    if constexpr (SP2) {
        PG8_STAGE(PG8_SB(0, 0), cB, voffB); PG8_STAGE(PG8_SB(0, 1), cB + hstep, voffB); PG8_STAGE(PG8_SA(0, 0), cA, voffA); PG8_STAGE(PG8_SA(0, 1), cA + hstep, voffA);
        if (wr == 1) PG8_BAR;
        PG8_WAIT_V(2); PG8_BAR;
        PG8_STAGE(PG8_SB(1, 0), cB + kstep, voffB); PG8_STAGE(PG8_SA(1, 0), cA + kstep, voffA); PG8_STAGE(PG8_SB(1, 1), cB + hstep + kstep, voffB);
        PG8_WAIT_V(6); PG8_BAR;
    } else {
        PG8_STAGE(PG8_SB(0, 0), cB, voffB); PG8_STAGE(PG8_SA(0, 0), cA, voffA); PG8_STAGE(PG8_SB(0, 1), cB + hstep, voffB); PG8_STAGE(PG8_SA(0, 1), cA + hstep, voffA);
        if (wr == 1) PG8_BAR;
        PG8_WAIT_V(4); PG8_BAR;
        PG8_STAGE(PG8_SB(1, 0), cB + kstep, voffB); PG8_STAGE(PG8_SA(1, 0), cA + kstep, voffA); PG8_STAGE(PG8_SB(1, 1), cB + hstep + kstep, voffB);
        PG8_WAIT_V(6); PG8_BAR;
    }
    for (;;) {
        const bool has_next = S.next(ui + 1, nxt);
        const char* nA = has_next ? (const char*)g.A + (size_t)nxt.pm * tstep : cA; const char* nB = has_next ? (const char*)g.Bt + (size_t)nxt.pn * tstep : cB;
        for (int t = 0; t < nt; t += 2) {
            const bool last = (t == nt - 2);
            const char* a1 = cA + (size_t)(t + 1) * kstep;
            const char* a2 = last ? nA : cA + (size_t)(t + 2) * kstep; const char* b2 = last ? nB : cB + (size_t)(t + 2) * kstep;
            const char* a3 = a2 + kstep; const char* b3 = b2 + kstep;
            if (last && has_next) S.a_ready(nxt);
            if constexpr (SP2) {
            PG8_LDB(B0, 0, 0); PG8_LDB(B1, 0, 1); PG8_SCHED; PG8_LDA(At, 0, 0); PG8_STAGE(PG8_SA(1, 1), a1 + hstep, voffA);
            PG8_WAIT_V(8); PG8_WAIT_L(0); PG8_BAR; PG8_MMA(0, 0, At, B0); PG8_MMA(0, 1, At, B1); PG8_BAR; PG8_SCHED;
            PG8_LDA(At, 0, 1); PG8_STAGE(PG8_SB(0, 0), b2, voffB); PG8_STAGE(PG8_SB(0, 1), b2 + hstep, voffB); PG8_STAGE(PG8_SA(0, 0), a2, voffA);
            PG8_WAIT_V(8); PG8_WAIT_L(0); PG8_BAR; PG8_MMA(1, 0, At, B0); PG8_MMA(1, 1, At, B1); PG8_BAR; PG8_SCHED;
            PG8_LDB(B0, 1, 0); PG8_LDB(B1, 1, 1); PG8_SCHED; PG8_LDA(At, 1, 0); PG8_STAGE(PG8_SA(0, 1), a2 + hstep, voffA);
            PG8_WAIT_V(8); PG8_WAIT_L(0); PG8_BAR; PG8_MMA(0, 0, At, B0); PG8_MMA(0, 1, At, B1); PG8_BAR; PG8_SCHED;
            PG8_LDA(At, 1, 1); PG8_STAGE(PG8_SB(1, 0), b3, voffB); PG8_STAGE(PG8_SB(1, 1), b3 + hstep, voffB); PG8_STAGE(PG8_SA(1, 0), a3, voffA);
            PG8_WAIT_V(8); PG8_WAIT_L(0); PG8_BAR; PG8_MMA(1, 0, At, B0); PG8_MMA(1, 1, At, B1); PG8_BAR; PG8_SCHED;
            } else {
            PG8_LDB(B0, 0, 0); PG8_SCHED; PG8_LDA(At, 0, 0); PG8_STAGE(PG8_SA(1, 1), a1 + hstep, voffA);
            PG8_WAIT_L(8); PG8_BAR; PG8_WAIT_L(0); PG8_MMA(0, 0, At, B0); PG8_BAR; PG8_SCHED;
            PG8_LDB(B1, 0, 1); PG8_STAGE(PG8_SB(0, 0), b2, voffB);
            PG8_BAR; PG8_WAIT_L(0); PG8_MMA(0, 1, At, B1); PG8_BAR;
            PG8_LDA(At, 0, 1); PG8_STAGE(PG8_SA(0, 0), a2, voffA);
            PG8_BAR; PG8_WAIT_L(0); PG8_MMA(1, 0, At, B0); PG8_BAR; PG8_SCHED;
            PG8_STAGE(PG8_SB(0, 1), b2 + hstep, voffB);
            PG8_WAIT_V(6); PG8_BAR; PG8_MMA(1, 1, At, B1); PG8_BAR;
            PG8_LDB(B0, 1, 0); PG8_SCHED; PG8_LDA(At, 1, 0); PG8_STAGE(PG8_SA(0, 1), a2 + hstep, voffA);
            PG8_WAIT_L(8); PG8_BAR; PG8_WAIT_L(0); PG8_MMA(0, 0, At, B0); PG8_BAR; PG8_SCHED;
            PG8_LDB(B1, 1, 1); PG8_STAGE(PG8_SB(1, 0), b3, voffB);
            PG8_BAR; PG8_WAIT_L(0); PG8_MMA(0, 1, At, B1); PG8_BAR;
            PG8_LDA(At, 1, 1); PG8_STAGE(PG8_SA(1, 0), a3, voffA);
            PG8_BAR; PG8_WAIT_L(0); PG8_MMA(1, 0, At, B0); PG8_BAR; PG8_SCHED;
            PG8_STAGE(PG8_SB(1, 1), b3 + hstep, voffB);
            PG8_WAIT_V(6); PG8_BAR; PG8_MMA(1, 1, At, B1); PG8_BAR;
            }
        }
        if constexpr (ALIGN_EPI) { if (wr == 0) PG8_BAR; }
        if constexpr (!Epi::AFTER_DRAIN) { E(acc, cur, wr, wc, fr, fq); S.done(cur); }
        if (!has_next) break;
#pragma unroll
        for (int a = 0; a < 2; ++a)
#pragma unroll
            for (int b = 0; b < 2; ++b)
#pragma unroll
                for (int m = 0; m < 4; ++m)
#pragma unroll
                    for (int n = 0; n < 2; ++n) acc[a][b][m][n] = (f32x4){0.f, 0.f, 0.f, 0.f};
        cur = nxt; cA = nA; cB = nB; ++ui;
        if constexpr (ALIGN_EPI) { if (wr == 1) PG8_BAR; }
    }
    PG8_WAIT_V(0);
    if constexpr (!ALIGN_EPI) { if (wr == 0) PG8_BAR; }
    PG8_BAR;
    if constexpr (Epi::AFTER_DRAIN) { E.fused(acc, cur, wr, wc, fr, fq, lds, wid, lane); S.done(cur); }
#undef PG8_SA
#undef PG8_SB
#undef PG8_STAGE
#undef PG8_LDA
#undef PG8_LDB
#undef PG8_MMA
#undef PG8_WAIT_V
#undef PG8_WAIT_L
#undef PG8_BAR
#undef PG8_SCHED
}
}
namespace pg8 {
__device__ __forceinline__ u32x4 pack8(f32x4 v0, f32x4 v1) { u32x4 w; w.x = cvt_pk_bf16(v0[0], v0[1]); w.y = cvt_pk_bf16(v0[2], v0[3]); w.z = cvt_pk_bf16(v1[0], v1[1]); w.w = cvt_pk_bf16(v1[2], v1[3]); return w; }
__device__ __forceinline__ float dot4(f32x4 a) { return (a[0] * a[0] + a[1] * a[1]) + (a[2] * a[2] + a[3] * a[3]); }
__device__ __forceinline__ float rs16(const float* p) { const f32x4 a = *(const f32x4*)p, b = *(const f32x4*)(p + 4), c = *(const f32x4*)(p + 8), d = *(const f32x4*)(p + 12);
    const float s = ((a[0] + a[1]) + (a[2] + a[3])) + ((b[0] + b[1]) + (b[2] + b[3])) + ((c[0] + c[1]) + (c[2] + c[3])) + ((d[0] + d[1]) + (d[2] + d[3])); return rsqrtf(s * (1.0f / DM) + RMS_EPS); }

struct EpiProj {
    static constexpr bool PERM = true, AFTER_DRAIN = false;
    bf16_t* O; float* kmsum;
    __device__ __forceinline__ void operator()(const f32x4 (&acc)[2][2][4][2], const Unit& u, int wr, int wc, int fr, int fq) const {
        const int colt = u.pn * BM;
        const float sc = colt < C_MK ? QSCALE : ((colt >= C_RK && colt < C_RV) ? RKSCALE : 1.0f);
        const int row0 = u.pm * BM + wr * 64 + fr, col0 = colt + wc * 32 + 8 * fq;
#pragma unroll
        for (int ai = 0; ai < 2; ++ai)
#pragma unroll
            for (int m = 0; m < 4; ++m) { bf16_t* rowp = O + (size_t)(row0 + ai * HALF + m * 16) * NPROJ + col0;
#pragma unroll
                for (int bj = 0; bj < 2; ++bj) *(u32x4*)(rowp + bj * HALF) = pack8(acc[ai][bj][m][0] * sc, acc[ai][bj][m][1] * sc); }
        if (colt >= C_MK && colt < C_MV) {
            const int bh0 = (u.pm >> 6) * 8, blk = u.pm & 63;
#pragma unroll
            for (int bj = 0; bj < 2; ++bj)
#pragma unroll
                for (int n = 0; n < 2; ++n)
#pragma unroll
                    for (int j = 0; j < 4; ++j) { float s = 0.f;
#pragma unroll
                        for (int ai = 0; ai < 2; ++ai)
#pragma unroll
                            for (int m = 0; m < 4; ++m) s += acc[ai][bj][m][n][j];
                        s += __shfl_xor(s, 1); s += __shfl_xor(s, 2); s += __shfl_xor(s, 4); s += __shfl_xor(s, 8);
                        if (fr == 0) { const int c = colt - C_MK + bj * HALF + wc * 32 + 8 * fq + 4 * n + j; atomicAdd(kmsum + ((size_t)(bh0 + (c >> 6)) * 64 + blk) * 64 + (c & 63), s); } }
        }
    }
};
struct EpiStore {
    static constexpr bool PERM = true, AFTER_DRAIN = false;
    bf16_t* O;
    __device__ __forceinline__ void operator()(const f32x4 (&acc)[2][2][4][2], const Unit& u, int wr, int wc, int fr, int fq) const {
        const int row0 = u.pm * BM + wr * 64 + fr, col0 = u.pn * BM + wc * 32 + 8 * fq;
#pragma unroll
        for (int ai = 0; ai < 2; ++ai)
#pragma unroll
            for (int m = 0; m < 4; ++m) { bf16_t* rowp = O + (size_t)(row0 + ai * HALF + m * 16) * DM + col0;
#pragma unroll
                for (int bj = 0; bj < 2; ++bj) *(u32x4*)(rowp + bj * HALF) = pack8(acc[ai][bj][m][0], acc[ai][bj][m][1]); }
    }
};
struct EpiRes {
    static constexpr bool PERM = true, AFTER_DRAIN = false;
    const float* base; float* out; bf16_t* xb; float* rsq;
    __device__ __forceinline__ void operator()(const f32x4 (&acc)[2][2][4][2], const Unit& u, int wr, int wc, int fr, int fq) const {
        const int row0 = u.pm * BM + wr * 64 + fr, col0 = u.pn * BM + wc * 32 + 8 * fq;
#pragma unroll
        for (int ai = 0; ai < 2; ++ai)
#pragma unroll
            for (int m = 0; m < 4; ++m) { const int row = row0 + ai * HALF + m * 16; float ss = 0.f;
#pragma unroll
                for (int bj = 0; bj < 2; ++bj) { const size_t off = (size_t)row * DM + col0 + bj * HALF;
                    const f32x4 y0 = *(const f32x4*)(base + off) + acc[ai][bj][m][0], y1 = *(const f32x4*)(base + off + 4) + acc[ai][bj][m][1];
                    *(f32x4*)(out + off) = y0; *(f32x4*)(out + off + 4) = y1; *(u32x4*)(xb + off) = pack8(y0, y1); ss += dot4(y0) + dot4(y1); }
                ss += __shfl_xor(ss, 16); ss += __shfl_xor(ss, 32);
                if (fq == 0) rsq[(size_t)row * 16 + u.pn * 4 + wc] = ss; }
    }
};
struct EpiPle {
    static constexpr bool PERM = true, AFTER_DRAIN = false;
    float* out; const bf16_t* pw; const float* rsq_in; float* rsq_out;
    __device__ __forceinline__ void operator()(const f32x4 (&acc)[2][2][4][2], const Unit& u, int wr, int wc, int fr, int fq) const {
        const int row0 = u.pm * BM + wr * 64 + fr, col0 = u.pn * BM + wc * 32 + 8 * fq;
#pragma unroll
        for (int ai = 0; ai < 2; ++ai)
#pragma unroll
            for (int m = 0; m < 4; ++m) { const int row = row0 + ai * HALF + m * 16; const float rs = rs16(rsq_in + (size_t)row * 16); float ss = 0.f;
#pragma unroll
                for (int bj = 0; bj < 2; ++bj) { const size_t off = (size_t)row * DM + col0 + bj * HALF;
                    const u32x4 pv = *(const u32x4*)(pw + off);
                    const f32x4 p0 = {__uint_as_float(pv.x << 16), __uint_as_float(pv.x & 0xffff0000u), __uint_as_float(pv.y << 16), __uint_as_float(pv.y & 0xffff0000u)};
                    const f32x4 p1 = {__uint_as_float(pv.z << 16), __uint_as_float(pv.z & 0xffff0000u), __uint_as_float(pv.w << 16), __uint_as_float(pv.w & 0xffff0000u)};
                    f32x4 g0 = acc[ai][bj][m][0] * rs, g1 = acc[ai][bj][m][1] * rs;
#pragma unroll
                    for (int j = 0; j < 4; ++j) { g0[j] = 1.0f / (1.0f + __expf(-g0[j])); g1[j] = 1.0f / (1.0f + __expf(-g1[j])); }
                    const f32x4 y0 = *(const f32x4*)(out + off) + p0 * g0, y1 = *(const f32x4*)(out + off + 4) + p1 * g1;
                    *(f32x4*)(out + off) = y0; *(f32x4*)(out + off + 4) = y1; ss += dot4(y0) + dot4(y1); }
                ss += __shfl_xor(ss, 16); ss += __shfl_xor(ss, 32);
                if (fq == 0) rsq_out[(size_t)row * 16 + u.pn * 4 + wc] = ss;
                asm volatile("" ::: "memory"); }
    }
};
struct EpiUG {
    static constexpr bool PERM = true, AFTER_DRAIN = false;
    bf16_t* act; const float* rsq; const float* cw; const float* cb; float* UL; float* UF; float* GF;
    __device__ __forceinline__ void operator()(const f32x4 (&acc)[2][2][4][2], const Unit& u, int wr, int wc, int fr, int fq) const {
        const int lane = fq * 16 + fr;
        const int cu = u.pn * HALF + wc * 32 + 8 * fq;
        float w0[8], w1[8], w2[8], bb[8];
#pragma unroll
        for (int q = 0; q < 2; ++q) { const f32x4 a = *(const f32x4*)(cw + cu + 4 * q), b = *(const f32x4*)(cw + FF + cu + 4 * q), c = *(const f32x4*)(cw + 2 * FF + cu + 4 * q), d = *(const f32x4*)(cb + cu + 4 * q);
#pragma unroll
            for (int j = 0; j < 4; ++j) { w0[4 * q + j] = a[j]; w1[4 * q + j] = b[j]; w2[4 * q + j] = c[j]; bb[4 * q + j] = d[j]; } }
        const int i1 = (lane + 63) & 63, i2 = (lane + 62) & 63, i15 = (lane + 15) & 63, i14 = (lane + 14) & 63;
#pragma unroll
        for (int ai = 0; ai < 2; ++ai) {
            float up[8];
#pragma unroll
            for (int m = 0; m < 4; ++m) {
                const int row = u.pm * BM + ai * HALF + wr * 64 + m * 16 + fr;
                const float rs = rs16(rsq + (size_t)row * 16);
                float uu[8], gg[8], a8[8];
#pragma unroll
                for (int n = 0; n < 2; ++n)
#pragma unroll
                    for (int j = 0; j < 4; ++j) { uu[4 * n + j] = acc[ai][0][m][n][j] * rs; gg[4 * n + j] = acc[ai][1][m][n][j] * rs; }
#pragma unroll
                for (int k = 0; k < 8; ++k) {
                    float u1 = __shfl(uu[k], i1), u2 = __shfl(uu[k], i2);
                    if (m > 0) { const float b1 = __shfl(up[k], i15), b2 = __shfl(up[k], i14); u1 = fr >= 1 ? u1 : b1; u2 = fr >= 2 ? u2 : b2; }
                    const float y = bb[k] + w0[k] * u2 + w1[k] * u1 + w2[k] * uu[k];
                    a8[k] = gelu_tanh(y) * gg[k];
                }
                const bool defer = (m == 0) && (fr < 2);
                if (!defer) { u32x4 w; w.x = cvt_pk_bf16(a8[0], a8[1]); w.y = cvt_pk_bf16(a8[2], a8[3]); w.z = cvt_pk_bf16(a8[4], a8[5]); w.w = cvt_pk_bf16(a8[6], a8[7]);
                    *(u32x4*)(act + (size_t)row * FF + cu) = w; }
                else { const size_t so = ((size_t)(row >> 6) * 2 + fr) * FF + cu;
                    *(f32x4*)(UF + so) = (f32x4){uu[0], uu[1], uu[2], uu[3]}; *(f32x4*)(UF + so + 4) = (f32x4){uu[4], uu[5], uu[6], uu[7]};
                    *(f32x4*)(GF + so) = (f32x4){gg[0], gg[1], gg[2], gg[3]}; *(f32x4*)(GF + so + 4) = (f32x4){gg[4], gg[5], gg[6], gg[7]}; }
                if (m == 3 && fr >= 14) { const size_t so = ((size_t)(row >> 6) * 2 + (fr - 14)) * FF + cu;
                    *(f32x4*)(UL + so) = (f32x4){uu[0], uu[1], uu[2], uu[3]}; *(f32x4*)(UL + so + 4) = (f32x4){uu[4], uu[5], uu[6], uu[7]}; }
#pragma unroll
                for (int k = 0; k < 8; ++k) up[k] = uu[k];
            }
        }
    }
};
}
#define LAS __attribute__((address_space(3)))
namespace mx {
typedef short bf16x8 __attribute__((ext_vector_type(8)));
typedef short s16x4 __attribute__((ext_vector_type(4)));
typedef float f32x16 __attribute__((ext_vector_type(16)));
typedef unsigned u32x4 __attribute__((ext_vector_type(4)));
typedef float f32x4_t __attribute__((ext_vector_type(4)));
typedef LAS const char* lds_cptr;
typedef LAS char* lds_ptr;
__device__ __forceinline__ int crow(int r, int hi) { return (r & 3) + 8 * (r >> 2) + 4 * hi; }
__device__ __forceinline__ s16x4 vtr(lds_cptr p) { return __builtin_bit_cast(s16x4, __builtin_amdgcn_ds_read_tr16_b64_v4i16((LAS s16x4*)p)); }
__device__ __forceinline__ bf16x8 cat8(s16x4 lo, s16x4 hi) { return (bf16x8){lo[0], lo[1], lo[2], lo[3], hi[0], hi[1], hi[2], hi[3]}; }
__device__ __forceinline__ unsigned pk(float lo, float hi) { return pg8::cvt_pk_bf16(lo, hi); }
__device__ __forceinline__ float other_half(float v) { return __shfl_xor(v, 32); }

constexpr int L_K = 0, L_V = 32768;
constexpr int L_WSF = 65536;
constexpr int L_OST = 65536 + 2048;
constexpr int L_ENT = L_OST + 32768;
constexpr int ENT_CAP = 4096;
constexpr int L_PREF = L_ENT + ENT_CAP * 4;
constexpr int L_END = L_PREF + 512;
static_assert(L_END <= 147456, "mixer LDS map");

__device__ __forceinline__ void moba_stage_kv(const bf16_t* __restrict__ proj, int b, int h, int blk, lds_ptr lds, int tid) {
#pragma unroll
    for (int i = 0; i < 4; ++i) { const int pc = tid + 512 * i, key = pc >> 3, ch = pc & 7;
        const bf16_t* src = proj + (size_t)(b * SEQ + blk * 256 + key) * NPROJ + h * 64 + ch * 8;
        const u32x4 kv = *(const u32x4*)(src + C_MK), vv = *(const u32x4*)(src + C_MV);
        *(LAS u32x4*)(lds + L_K + ch * 4096 + key * 16) = kv;
        *(LAS u32x4*)(lds + L_V + (key >> 6) * 8192 + (ch >> 2) * 4096 + ((key & 63) >> 3) * 512 + (key & 7) * 64 + (ch & 3) * 16) = vv; }
}

__device__ __forceinline__ void moba_batch(const bf16_t* qptr, int qpos, int kbase, float slope2, bool diag, int ntiles, lds_ptr lds, int wave, int lane, bf16_t* odst, float* ldst) {
    const int r32 = lane & 31, hi = lane >> 5;
    bf16x8 qr[4];
#pragma unroll
    for (int d0 = 0; d0 < 4; ++d0) qr[d0] = *(const bf16x8*)(qptr + d0 * 16 + hi * 8);
    f32x16 o0, o1;
#pragma unroll
    for (int r = 0; r < 16; ++r) { o0[r] = 0.f; o1[r] = 0.f; }
    float m = -1e30f, l = 0.f;
    const lds_cptr kp = (lds_cptr)lds + L_K + hi * 4096 + r32 * 16;
    const lds_cptr vp = (lds_cptr)lds + L_V + ((lane >> 4) & 1) * 32 + (lane & 3) * 8 + (4 * hi + ((lane & 15) >> 2)) * 64;
    LAS float* wsf = (LAS float*)(lds + L_WSF) + wave * 64;
    for (int kt = 0; kt < ntiles; ++kt) {
        f32x16 p0, p1;
        const float fb0 = (float)(qpos - kbase - 64 * kt - 4 * hi);
#pragma unroll
        for (int r = 0; r < 16; ++r) { const float c = (float)((r & 3) + 8 * (r >> 2)); const float d0f = fb0 - c, d1f = d0f - 32.0f;
            p0[r] = (diag && d0f < 0.f) ? -1e30f : -slope2 * d0f; p1[r] = (diag && d1f < 0.f) ? -1e30f : -slope2 * d1f; }
#pragma unroll
        for (int d0 = 0; d0 < 4; ++d0) {
            const bf16x8 k0 = *(const LAS bf16x8*)(kp + kt * 1024 + d0 * 8192), k1 = *(const LAS bf16x8*)(kp + kt * 1024 + 512 + d0 * 8192);
            p0 = __builtin_amdgcn_mfma_f32_32x32x16_bf16(k0, qr[d0], p0, 0, 0, 0);
            p1 = __builtin_amdgcn_mfma_f32_32x32x16_bf16(k1, qr[d0], p1, 0, 0, 0);
        }
        float mx_ = p0[0];
#pragma unroll
        for (int r = 1; r < 16; ++r) mx_ = fmaxf(mx_, p0[r]);
#pragma unroll
        for (int r = 0; r < 16; ++r) mx_ = fmaxf(mx_, p1[r]);
        mx_ = fmaxf(mx_, other_half(mx_));
        const float mn = fmaxf(m, mx_);
        const float alpha = __builtin_amdgcn_exp2f(m - mn);
        float rs = 0.f;
#pragma unroll
        for (int r = 0; r < 16; ++r) { p0[r] = __builtin_amdgcn_exp2f(p0[r] - mn); p1[r] = __builtin_amdgcn_exp2f(p1[r] - mn); rs += p0[r] + p1[r]; }
        l = l * alpha + rs; m = mn;
        if (!__all(alpha == 1.0f)) {
            if (hi == 0) wsf[r32] = alpha;
#pragma unroll
            for (int r = 0; r < 16; ++r) { const float f = wsf[crow(r, hi)]; o0[r] *= f; o1[r] *= f; }
        }
        u32x4 pw0 = {pk(p0[0], p0[1]), pk(p0[2], p0[3]), pk(p0[4], p0[5]), pk(p0[6], p0[7])};
        u32x4 pw1 = {pk(p0[8], p0[9]), pk(p0[10], p0[11]), pk(p0[12], p0[13]), pk(p0[14], p0[15])};
        u32x4 pw2 = {pk(p1[0], p1[1]), pk(p1[2], p1[3]), pk(p1[4], p1[5]), pk(p1[6], p1[7])};
        u32x4 pw3 = {pk(p1[8], p1[9]), pk(p1[10], p1[11]), pk(p1[12], p1[13]), pk(p1[14], p1[15])};
        const lds_cptr vt = vp + kt * 8192;
#define MX_PV(O, DB, KS, PW) O = __builtin_amdgcn_mfma_f32_32x32x16_bf16(__builtin_bit_cast(bf16x8, PW), cat8(vtr(vt + (DB) * 4096 + (KS) * 1024), vtr(vt + (DB) * 4096 + (KS) * 1024 + 512)), O, 0, 0, 0)
        MX_PV(o0, 0, 0, pw0); MX_PV(o1, 1, 0, pw0); MX_PV(o0, 0, 1, pw1); MX_PV(o1, 1, 1, pw1);
        MX_PV(o0, 0, 2, pw2); MX_PV(o1, 1, 2, pw2); MX_PV(o0, 0, 3, pw3); MX_PV(o1, 1, 3, pw3);
#undef MX_PV
    }
    l += other_half(l);
    if (hi == 0) wsf[32 + r32] = 1.0f / l;
    const float lse = m + __builtin_amdgcn_logf(l);
    LAS bf16_t* ost = (LAS bf16_t*)(lds + L_OST) + wave * 2048;
#pragma unroll
    for (int r = 0; r < 16; ++r) { const int orow = crow(r, hi); const float f = wsf[32 + orow];
        ost[orow * 64 + r32] = f2bf(o0[r] * f); ost[orow * 64 + 32 + r32] = f2bf(o1[r] * f); }
    const unsigned long long dp = (unsigned long long)odst; const unsigned dlo = (unsigned)dp, dhi = (unsigned)(dp >> 32);
#pragma unroll
    for (int i = 0; i < 4; ++i) { const int row = i * 8 + (lane >> 3), ch = lane & 7;
        const u32x4 v = *(const LAS u32x4*)(ost + row * 64 + ch * 8);
        const unsigned long long d = ((unsigned long long)(unsigned)__shfl((int)dhi, row) << 32) | (unsigned)__shfl((int)dlo, row);
        if (d) *(u32x4*)((bf16_t*)d + ch * 8) = v; }
    if (hi == 0 && ldst) *ldst = lse;
}

__device__ __forceinline__ void moba_diag_unit(const bf16_t* __restrict__ proj, int bh, int i, bf16_t* part_o, float* part_l, lds_ptr lds, int tid) {
    const int b = bh >> 3, h = bh & 7, lane = tid & 63, wave = __builtin_amdgcn_readfirstlane(tid >> 6);
    moba_stage_kv(proj, b, h, i, lds, tid);
    __syncthreads();
    const int ql = wave * 32 + (lane & 31), t = i * 256 + ql; const size_t row = (size_t)b * SEQ + t;
    const float slope2 = __builtin_amdgcn_exp2f(-(float)(h + 1)) * LOG2E;
    moba_batch(proj + row * NPROJ + C_MQ + h * 64, t, i * 256, slope2, true, (wave >> 1) + 1, lds, wave, lane,
               part_o + ((row * 8 + h) * 4 + 3) * 64, part_l + (row * 8 + h) * 4 + 3);
    __syncthreads();
}
__device__ __forceinline__ void moba_sel_task(const bf16_t* __restrict__ proj, const unsigned short* __restrict__ seg, const int* __restrict__ cnt, int bh, int n,
                                              bf16_t* part_o, float* part_l, lds_ptr lds, int tid) {
    const int b = bh >> 3, h = bh & 7, lane = tid & 63, wave = __builtin_amdgcn_readfirstlane(tid >> 6);
    LAS int* pref = (LAS int*)(lds + L_PREF); LAS unsigned* ent = (LAS unsigned*)(lds + L_ENT);
    if (tid < 64) pref[tid + 1] = (tid > n) ? cnt[((size_t)bh * 64 + n) * 64 + tid] : 0;
    moba_stage_kv(proj, b, h, n, lds, tid);
    __syncthreads();
    if (tid == 0) { int s = 0; pref[0] = 0; for (int i = 1; i <= 64; ++i) { s += pref[i]; pref[i] = s; } }
    __syncthreads();
    const int T = pref[64];
    const float slope2 = __builtin_amdgcn_exp2f(-(float)(h + 1)) * LOG2E;
    for (int c0 = 0; c0 < T; c0 += ENT_CAP) {
        const int cn = (T - c0) < ENT_CAP ? (T - c0) : ENT_CAP;
        for (int e = tid; e < cn; e += 512) { const int g = c0 + e; int lo = 0, hi = 63;
            while (lo < hi) { const int mid = (lo + hi + 1) >> 1; if (pref[mid] <= g) lo = mid; else hi = mid - 1; }
            ent[e] = ((unsigned)lo << 10) | (unsigned)seg[(((size_t)bh * 64 + n) * 64 + lo) * 256 + (g - pref[lo])]; }
        __syncthreads();
        for (int wb = wave; wb * 32 < cn; wb += 8) {
            const int idx = wb * 32 + (lane & 31); const bool valid = idx < cn;
            const unsigned en = ent[valid ? idx : wb * 32];
            const int isrc = en >> 10, ql = (en >> 2) & 255, slot = en & 3, t = isrc * 256 + ql; const size_t row = (size_t)b * SEQ + t;
            moba_batch(proj + row * NPROJ + C_MQ + h * 64, t, n * 256, slope2, false, 4, lds, wave, lane,
                       valid ? part_o + ((row * 8 + h) * 4 + slot) * 64 : (bf16_t*)nullptr, valid ? part_l + (row * 8 + h) * 4 + slot : (float*)nullptr);
        }
        __syncthreads();
    }
}

constexpr int G_KMH = 0, G_KML = 8192, G_CNT = 16384;
#define MX_INS(v, n) do { const bool g0_ = (v) > v0, g1_ = (v) > v1, g2_ = (v) > v2; \
    v2 = g1_ ? v1 : (g2_ ? (v) : v2); i2 = g1_ ? i1 : (g2_ ? (n) : i2); v1 = g0_ ? v0 : (g1_ ? (v) : v1); i1 = g0_ ? i0 : (g1_ ? (n) : i1); v0 = g0_ ? (v) : v0; i0 = g0_ ? (n) : i0; } while (0)
__device__ __forceinline__ void gate_task_mfma(int bh, int i, const bf16_t* __restrict__ proj, const float* __restrict__ kmsum, u32* __restrict__ sel,
                                               unsigned short* __restrict__ seg, int* __restrict__ cnt, lds_ptr lds, int tid) {
    const int b = bh >> 3, h = bh & 7, lane = tid & 63, wave = __builtin_amdgcn_readfirstlane(tid >> 6), r32 = lane & 31, hi = lane >> 5;
    { const int n = tid >> 3, ch = tid & 7; const float* src = kmsum + (size_t)bh * 4096 + n * 64 + ch * 8;
      const f32x4_t a = *(const f32x4_t*)src * (1.0f / 256.0f), c = *(const f32x4_t*)(src + 4) * (1.0f / 256.0f);
      float v[8] = {a[0], a[1], a[2], a[3], c[0], c[1], c[2], c[3]}; float hf[8], lf[8];
#pragma unroll
      for (int k = 0; k < 8; ++k) { hf[k] = bf2f(f2bf(v[k])); lf[k] = v[k] - hf[k]; }
      const u32x4 H = {pk(hf[0], hf[1]), pk(hf[2], hf[3]), pk(hf[4], hf[5]), pk(hf[6], hf[7])}, Lw = {pk(lf[0], lf[1]), pk(lf[2], lf[3]), pk(lf[4], lf[5]), pk(lf[6], lf[7])};
      *(LAS u32x4*)(lds + G_KMH + ch * 1024 + n * 16) = H; *(LAS u32x4*)(lds + G_KML + ch * 1024 + n * 16) = Lw; }
    LAS int* cntL = (LAS int*)(lds + G_CNT);
    if (tid < 64) cntL[tid] = 0;
    __syncthreads();
    const int ql = wave * 32 + r32, t = i * 256 + ql; const size_t row = (size_t)b * SEQ + t;
    const bf16_t* qp = proj + row * NPROJ + C_MQ + h * 64 + hi * 8;
    f32x16 p0, p1;
#pragma unroll
    for (int r = 0; r < 16; ++r) { p0[r] = 0.f; p1[r] = 0.f; }
#pragma unroll
    for (int ks = 0; ks < 4; ++ks) {
        const bf16x8 q = *(const bf16x8*)(qp + ks * 16);
        const lds_cptr kb = (lds_cptr)lds + (2 * ks + hi) * 1024 + r32 * 16;
        p0 = __builtin_amdgcn_mfma_f32_32x32x16_bf16(*(const LAS bf16x8*)(kb + G_KMH), q, p0, 0, 0, 0);
        p0 = __builtin_amdgcn_mfma_f32_32x32x16_bf16(*(const LAS bf16x8*)(kb + G_KML), q, p0, 0, 0, 0);
        p1 = __builtin_amdgcn_mfma_f32_32x32x16_bf16(*(const LAS bf16x8*)(kb + G_KMH + 512), q, p1, 0, 0, 0);
        p1 = __builtin_amdgcn_mfma_f32_32x32x16_bf16(*(const LAS bf16x8*)(kb + G_KML + 512), q, p1, 0, 0, 0);
    }
    float v0 = -INFINITY, v1 = -INFINITY, v2 = -INFINITY; int i0 = 0, i1 = 0, i2 = 0;
#pragma unroll
    for (int r = 0; r < 16; ++r) { const int n = crow(r, hi); const float v = n < i ? p0[r] : -INFINITY; MX_INS(v, n); }
#pragma unroll
    for (int r = 0; r < 16; ++r) { const int n = 32 + crow(r, hi); const float v = n < i ? p1[r] : -INFINITY; MX_INS(v, n); }
    { const float a0 = __shfl_xor(v0, 32), a1 = __shfl_xor(v1, 32), a2 = __shfl_xor(v2, 32); const int j0 = __shfl_xor(i0, 32), j1 = __shfl_xor(i1, 32), j2 = __shfl_xor(i2, 32);
      MX_INS(a0, j0); MX_INS(a1, j1); MX_INS(a2, j2); }
    if (hi == 0) {
        const int nv = i < 3 ? i : 3;
        sel[row * 8 + h] = (u32)i0 | ((u32)i1 << 8) | ((u32)i2 << 16) | ((u32)nv << 24);
#pragma unroll
        for (int s = 0; s < 3; ++s) if (s < nv) { const int n = s == 0 ? i0 : (s == 1 ? i1 : i2);
            const int pos = atomicAdd((int*)&cntL[n], 1);
            seg[(((size_t)bh * 64 + n) * 64 + i) * 256 + pos] = (unsigned short)((ql << 2) | s); }
    }
    __syncthreads();
    if (tid < i) cnt[((size_t)bh * 64 + tid) * 64 + i] = cntL[tid];
    __syncthreads();
}
#undef MX_INS

#define MX_INS(v, n) do { const bool g0_ = (v) > v0, g1_ = (v) > v1, g2_ = (v) > v2; \
    v2 = g1_ ? v1 : (g2_ ? (v) : v2); i2 = g1_ ? i1 : (g2_ ? (n) : i2); v1 = g0_ ? v0 : (g1_ ? (v) : v1); i1 = g0_ ? i0 : (g1_ ? (n) : i1); v0 = g0_ ? (v) : v0; i0 = g0_ ? (n) : i0; } while (0)
__device__ __forceinline__ void gate_unit(int bh, int i, int w8, const bf16_t* __restrict__ proj, const float* __restrict__ kmsum, u32* __restrict__ sel,
                                          unsigned short* __restrict__ seg, int* __restrict__ cnt, int lane) {
    const int b = bh >> 3, h = bh & 7, r32 = lane & 31, hi = lane >> 5;
    const int ql = w8 * 32 + r32, t = i * 256 + ql; const size_t row = (size_t)b * SEQ + t;
    const bf16_t* qp = proj + row * NPROJ + C_MQ + h * 64 + hi * 8;
    bf16x8 q[4];
#pragma unroll
    for (int ks = 0; ks < 4; ++ks) q[ks] = *(const bf16x8*)(qp + ks * 16);
    f32x16 p0, p1;
#pragma unroll
    for (int r = 0; r < 16; ++r) { p0[r] = 0.f; p1[r] = 0.f; }
    const float* kb = kmsum + (size_t)bh * 4096 + r32 * 64 + hi * 8;
#pragma unroll
    for (int nt = 0; nt < 2; ++nt) {
        if (nt == 1 && i <= 32) break;
#pragma unroll
        for (int ks = 0; ks < 4; ++ks) {
            const f32x4_t a = *(const f32x4_t*)(kb + nt * 2048 + ks * 16) * (1.0f / 256.0f), c = *(const f32x4_t*)(kb + nt * 2048 + ks * 16 + 4) * (1.0f / 256.0f);
            const float v[8] = {a[0], a[1], a[2], a[3], c[0], c[1], c[2], c[3]}; float hf[8], lf[8];
#pragma unroll
            for (int k = 0; k < 8; ++k) { hf[k] = bf2f(f2bf(v[k])); lf[k] = v[k] - hf[k]; }
            const u32x4 H = {pk(hf[0], hf[1]), pk(hf[2], hf[3]), pk(hf[4], hf[5]), pk(hf[6], hf[7])}, Lw = {pk(lf[0], lf[1]), pk(lf[2], lf[3]), pk(lf[4], lf[5]), pk(lf[6], lf[7])};
            if (nt == 0) { p0 = __builtin_amdgcn_mfma_f32_32x32x16_bf16(__builtin_bit_cast(bf16x8, H), q[ks], p0, 0, 0, 0); p0 = __builtin_amdgcn_mfma_f32_32x32x16_bf16(__builtin_bit_cast(bf16x8, Lw), q[ks], p0, 0, 0, 0); }
            else { p1 = __builtin_amdgcn_mfma_f32_32x32x16_bf16(__builtin_bit_cast(bf16x8, H), q[ks], p1, 0, 0, 0); p1 = __builtin_amdgcn_mfma_f32_32x32x16_bf16(__builtin_bit_cast(bf16x8, Lw), q[ks], p1, 0, 0, 0); }
        }
    }
    float v0 = -INFINITY, v1 = -INFINITY, v2 = -INFINITY; int i0 = 0, i1 = 0, i2 = 0;
#pragma unroll
    for (int r = 0; r < 16; ++r) { const int n = crow(r, hi); const float v = n < i ? p0[r] : -INFINITY; MX_INS(v, n); }
#pragma unroll
    for (int r = 0; r < 16; ++r) { const int n = 32 + crow(r, hi); const float v = n < i ? p1[r] : -INFINITY; MX_INS(v, n); }
    { const float a0 = __shfl_xor(v0, 32), a1 = __shfl_xor(v1, 32), a2 = __shfl_xor(v2, 32); const int j0 = __shfl_xor(i0, 32), j1 = __shfl_xor(i1, 32), j2 = __shfl_xor(i2, 32);
      MX_INS(a0, j0); MX_INS(a1, j1); MX_INS(a2, j2); }
    if (hi == 0) {
        const int nv = i < 3 ? i : 3;
        sel[row * 8 + h] = (u32)i0 | ((u32)i1 << 8) | ((u32)i2 << 16) | ((u32)nv << 24);
#pragma unroll
        for (int s = 0; s < 3; ++s) if (s < nv) { const int n = s == 0 ? i0 : (s == 1 ? i1 : i2);
            const int pos = atomicAdd(cnt + ((size_t)bh * 64 + n) * 64 + i, 1);
            seg[(((size_t)bh * 64 + n) * 64 + i) * 256 + pos] = (unsigned short)((ql << 2) | s); }
    }
}
#undef MX_INS
__device__ __forceinline__ void moba_combine(const bf16_t* __restrict__ part_o, const float* __restrict__ part_l, const u32* __restrict__ sel, bf16_t* __restrict__ mix, size_t gt, size_t GT) {
    for (size_t i = gt; i < (size_t)MT * 64; i += GT) {
        const int ch = (int)(i & 7), h = (int)((i >> 3) & 7); const size_t row = i >> 6;
        const int nv = sel[row * 8 + h] >> 24;
        const f32x4_t lv = *(const f32x4_t*)(part_l + (row * 8 + h) * 4);
        float w[4]; w[0] = nv > 0 ? lv[0] : -1e30f; w[1] = nv > 1 ? lv[1] : -1e30f; w[2] = nv > 2 ? lv[2] : -1e30f; w[3] = lv[3];
        const float mm = fmaxf(fmaxf(w[0], w[1]), fmaxf(w[2], w[3]));
        float acc[8] = {0.f, 0.f, 0.f, 0.f, 0.f, 0.f, 0.f, 0.f}; float ws = 0.f;
#pragma unroll
        for (int s = 0; s < 4; ++s) { const bool ok = s == 3 || s < nv; const float ww = ok ? __builtin_amdgcn_exp2f(w[s] - mm) : 0.f; ws += ww;
            if (ok) { const u32x4 v = *(const u32x4*)(part_o + ((row * 8 + h) * 4 + s) * 64 + ch * 8);
                acc[0] += ww * __uint_as_float(v.x << 16); acc[1] += ww * __uint_as_float(v.x & 0xffff0000u); acc[2] += ww * __uint_as_float(v.y << 16); acc[3] += ww * __uint_as_float(v.y & 0xffff0000u);
                acc[4] += ww * __uint_as_float(v.z << 16); acc[5] += ww * __uint_as_float(v.z & 0xffff0000u); acc[6] += ww * __uint_as_float(v.w << 16); acc[7] += ww * __uint_as_float(v.w & 0xffff0000u); } }
        const float iw = 1.0f / ws;
        u32x4 o; o.x = pk(acc[0] * iw, acc[1] * iw); o.y = pk(acc[2] * iw, acc[3] * iw); o.z = pk(acc[4] * iw, acc[5] * iw); o.w = pk(acc[6] * iw, acc[7] * iw);
        *(u32x4*)(mix + row * DM + h * 64 + ch * 8) = o;
    }
}

constexpr int R_IMG = 65536;
__device__ __forceinline__ int rimg_off(int t, int c) { return (c >> 5) * 16384 + (t >> 3) * 512 + (t & 7) * 64 + (c & 31) * 2; }
__device__ __forceinline__ void ret_stage(const bf16_t* __restrict__ proj, int b, int t0, int col0, lds_ptr img, int tid, bool kdecay, float log2g) {
#pragma unroll
    for (int i = 0; i < 8; ++i) { const int pc = tid + 512 * i, t = pc >> 4, ch = pc & 15;
        u32x4 v = *(const u32x4*)(proj + (size_t)(b * SEQ + t0 + t) * NPROJ + col0 + ch * 8);
        if (kdecay) { const float f = __builtin_amdgcn_exp2f((float)(255 - t) * log2g);
            v.x = pk(__uint_as_float(v.x << 16) * f, __uint_as_float(v.x & 0xffff0000u) * f); v.y = pk(__uint_as_float(v.y << 16) * f, __uint_as_float(v.y & 0xffff0000u) * f);
            v.z = pk(__uint_as_float(v.z << 16) * f, __uint_as_float(v.z & 0xffff0000u) * f); v.w = pk(__uint_as_float(v.w << 16) * f, __uint_as_float(v.w & 0xffff0000u) * f); }
        *(LAS u32x4*)(img + rimg_off(t, ch * 8)) = v; }
}
__device__ __forceinline__ void ret_kv_task(const bf16_t* __restrict__ proj, int bh, int c, float* __restrict__ kvt, lds_ptr lds, int tid) {
    const int b = bh >> 2, h = bh & 3, lane = tid & 63, wave = __builtin_amdgcn_readfirstlane(tid >> 6), r32 = lane & 31, hi = lane >> 5;
    const float log2g = __builtin_amdgcn_logf(1.0f - __builtin_amdgcn_exp2f(-5.0f - (float)h));
    ret_stage(proj, b, c * 256, C_RV + h * 128, lds, tid, false, 0.f);
    ret_stage(proj, b, c * 256, C_RK + h * 128, lds + R_IMG, tid, true, log2g);
    __syncthreads();
    const int et = wave >> 1, dt0 = (wave & 1) * 2;
    const int lbase = hi * 512 + ((lane & 15) >> 2) * 64 + ((lane >> 4) & 1) * 32 + (lane & 3) * 8;
    const lds_cptr va = (lds_cptr)lds + et * 16384 + lbase, kb0 = (lds_cptr)lds + R_IMG + dt0 * 16384 + lbase, kb1 = kb0 + 16384;
    f32x16 a0, a1;
#pragma unroll
    for (int r = 0; r < 16; ++r) { a0[r] = 0.f; a1[r] = 0.f; }
#pragma unroll 4
    for (int ks = 0; ks < 16; ++ks) {
        const bf16x8 vf = cat8(vtr(va + ks * 1024), vtr(va + ks * 1024 + 256));
        const bf16x8 k0 = cat8(vtr(kb0 + ks * 1024), vtr(kb0 + ks * 1024 + 256)), k1 = cat8(vtr(kb1 + ks * 1024), vtr(kb1 + ks * 1024 + 256));
        a0 = __builtin_amdgcn_mfma_f32_32x32x16_bf16(vf, k0, a0, 0, 0, 0);
        a1 = __builtin_amdgcn_mfma_f32_32x32x16_bf16(vf, k1, a1, 0, 0, 0);
    }
    float* dst = kvt + ((size_t)(bh * 64 + c) * 128) * 128;
#pragma unroll
    for (int r = 0; r < 16; ++r) { const int e = et * 32 + crow(r, hi);
        dst[(size_t)e * 128 + dt0 * 32 + r32] = a0[r]; dst[(size_t)e * 128 + dt0 * 32 + 32 + r32] = a1[r]; }
    __syncthreads();
}
__device__ __forceinline__ void ret_scan(const float* __restrict__ kvt, bf16_t* __restrict__ stt, size_t gt, size_t GT) {
    for (size_t i = gt; i < (size_t)8 * 16384; i += GT) {
        const int bh = (int)(i >> 14), ed = (int)(i & 16383), h = bh & 3;
        const float g256 = __builtin_amdgcn_exp2f(256.0f * __builtin_amdgcn_logf(1.0f - __builtin_amdgcn_exp2f(-5.0f - (float)h)));
        float s = 0.f;
#pragma unroll 8
        for (int c = 0; c < 64; ++c) { const size_t o = ((size_t)(bh * 64 + c) << 14) + ed; stt[o] = f2bf(s); s = s * g256 + kvt[o]; }
    }
}
constexpr int RO_A = 0, RO_V = 65536, RO_ST = 131072;
__device__ __forceinline__ void ret_out_task(const bf16_t* __restrict__ proj, const bf16_t* __restrict__ stt, const float* __restrict__ gain, bf16_t* __restrict__ mix, int bh, int c, lds_ptr lds, int tid) {
    const int b = bh >> 2, h = bh & 3, lane = tid & 63, wave = __builtin_amdgcn_readfirstlane(tid >> 6), r32 = lane & 31, hi = lane >> 5;
    const float log2g = __builtin_amdgcn_logf(1.0f - __builtin_amdgcn_exp2f(-5.0f - (float)h));
    const size_t row0 = (size_t)b * SEQ + c * 256;
    u32x4 sreg[4], vreg[8], kreg[8];
    { const bf16_t* sp = stt + ((size_t)(bh * 64 + c) << 14);
#pragma unroll
      for (int i = 0; i < 4; ++i) sreg[i] = *(const u32x4*)(sp + (size_t)(tid + 512 * i) * 8); }
#pragma unroll
    for (int i = 0; i < 8; ++i) { const int pc = tid + 512 * i, t = pc >> 4, ch = pc & 15; const bf16_t* src = proj + (row0 + t) * NPROJ + h * 128 + ch * 8;
        vreg[i] = *(const u32x4*)(src + C_RV); kreg[i] = *(const u32x4*)(src + C_RK); }
    bf16x8 qf[8];
    { const bf16_t* qp = proj + (row0 + wave * 32 + r32) * NPROJ + C_RQ + h * 128 + hi * 8;
#pragma unroll
      for (int ks = 0; ks < 8; ++ks) qf[ks] = *(const bf16x8*)(qp + ks * 16); }
#pragma unroll
    for (int i = 0; i < 4; ++i) { const int pc = tid + 512 * i, e = pc >> 4, ch = pc & 15; *(LAS u32x4*)(lds + RO_A + ch * 2048 + e * 16) = sreg[i]; }
#pragma unroll
    for (int i = 0; i < 8; ++i) { const int pc = tid + 512 * i, t = pc >> 4, ch = pc & 15; *(LAS u32x4*)(lds + RO_V + rimg_off(t, ch * 8)) = vreg[i]; }
    __syncthreads();
    f32x16 o[4];
#pragma unroll
    for (int et = 0; et < 4; ++et)
#pragma unroll
        for (int r = 0; r < 16; ++r) o[et][r] = 0.f;
    { const lds_cptr sb = (lds_cptr)lds + RO_A + hi * 2048 + r32 * 16;
#pragma unroll
      for (int et = 0; et < 4; ++et)
#pragma unroll
          for (int ks = 0; ks < 8; ++ks) o[et] = __builtin_amdgcn_mfma_f32_32x32x16_bf16(qf[ks], *(const LAS bf16x8*)(sb + ks * 4096 + et * 512), o[et], 0, 0, 0); }
#pragma unroll
    for (int r = 0; r < 16; ++r) { const float f = __builtin_amdgcn_exp2f((float)(wave * 32 + crow(r, hi) + 1) * log2g);
#pragma unroll
        for (int et = 0; et < 4; ++et) o[et][r] *= f; }
    __syncthreads();
#pragma unroll
    for (int i = 0; i < 8; ++i) { const int pc = tid + 512 * i, t = pc >> 4, ch = pc & 15; *(LAS u32x4*)(lds + RO_A + ch * 4096 + t * 16) = kreg[i]; }
    __syncthreads();
    u32x4 rgv[8];
#pragma unroll
    for (int g = 0; g < 4; ++g)
#pragma unroll
        for (int k = 0; k < 2; ++k) { const int pidx = lane + 64 * k; rgv[2 * g + k] = *(const u32x4*)(proj + (row0 + wave * 32 + 8 * g + (pidx >> 4)) * NPROJ + C_RG + h * 128 + (pidx & 15) * 8); }
    const lds_cptr vp = (lds_cptr)lds + RO_V + ((lane >> 4) & 1) * 32 + (lane & 3) * 8 + (4 * hi + ((lane & 15) >> 2)) * 64;
    const lds_cptr kpb = (lds_cptr)lds + RO_A + hi * 4096 + r32 * 16;
    for (int kvt = 0; kvt <= wave; ++kvt) {
        f32x16 p;
#pragma unroll
        for (int r = 0; r < 16; ++r) p[r] = 0.f;
#pragma unroll
        for (int ks = 0; ks < 8; ++ks) p = __builtin_amdgcn_mfma_f32_32x32x16_bf16(*(const LAS bf16x8*)(kpb + ks * 8192 + kvt * 512), qf[ks], p, 0, 0, 0);
        const int dbase = 32 * (wave - kvt) + r32 - 4 * hi;
#pragma unroll
        for (int r = 0; r < 16; ++r) { const int dist = dbase - ((r & 3) + 8 * (r >> 2)); p[r] = dist >= 0 ? p[r] * __builtin_amdgcn_exp2f((float)dist * log2g) : 0.f; }
        const u32x4 pw0 = {pk(p[0], p[1]), pk(p[2], p[3]), pk(p[4], p[5]), pk(p[6], p[7])}, pw1 = {pk(p[8], p[9]), pk(p[10], p[11]), pk(p[12], p[13]), pk(p[14], p[15])};
        const lds_cptr vt = vp + kvt * 2048;
#pragma unroll
        for (int et = 0; et < 4; ++et) {
            o[et] = __builtin_amdgcn_mfma_f32_32x32x16_bf16(__builtin_bit_cast(bf16x8, pw0), cat8(vtr(vt + et * 16384), vtr(vt + et * 16384 + 512)), o[et], 0, 0, 0);
            o[et] = __builtin_amdgcn_mfma_f32_32x32x16_bf16(__builtin_bit_cast(bf16x8, pw1), cat8(vtr(vt + et * 16384 + 1024), vtr(vt + et * 16384 + 1536)), o[et], 0, 0, 0);
        }
    }
    float mu[16], rstd[16];
#pragma unroll
    for (int r = 0; r < 16; ++r) {
        float s = (o[0][r] + o[1][r]) + (o[2][r] + o[3][r]);
        s += __shfl_xor(s, 1); s += __shfl_xor(s, 2); s += __shfl_xor(s, 4); s += __shfl_xor(s, 8); s += __shfl_xor(s, 16);
        mu[r] = s * (1.0f / 128.0f);
        const float d0 = o[0][r] - mu[r], d1 = o[1][r] - mu[r], d2 = o[2][r] - mu[r], d3 = o[3][r] - mu[r];
        float q = (d0 * d0 + d1 * d1) + (d2 * d2 + d3 * d3);
        q += __shfl_xor(q, 1); q += __shfl_xor(q, 2); q += __shfl_xor(q, 4); q += __shfl_xor(q, 8); q += __shfl_xor(q, 16);
        rstd[r] = rsqrtf(q * (1.0f / 128.0f) + GN_EPS);
    }
    float gn[4];
#pragma unroll
    for (int et = 0; et < 4; ++et) gn[et] = gain[h * 128 + et * 32 + r32];
    LAS bf16_t* st = (LAS bf16_t*)(lds + RO_ST) + wave * 1024;
#pragma unroll
    for (int g = 0; g < 4; ++g) {
#pragma unroll
        for (int rr = 0; rr < 4; ++rr) { const int r = 4 * g + rr;
#pragma unroll
            for (int et = 0; et < 4; ++et) st[(rr + 4 * hi) * 128 + et * 32 + r32] = f2bf((o[et][r] - mu[r]) * rstd[r] * gn[et]); }
#pragma unroll
        for (int k = 0; k < 2; ++k) { const int pidx = lane + 64 * k, r8 = pidx >> 4, ch = pidx & 15; const size_t row = row0 + wave * 32 + 8 * g + r8;
            const u32x4 nv = *(const LAS u32x4*)(st + r8 * 128 + ch * 8); const u32x4 gv = rgv[2 * g + k];
            const unsigned nw[4] = {nv.x, nv.y, nv.z, nv.w}, gw_[4] = {gv.x, gv.y, gv.z, gv.w}; unsigned ow[4];
#pragma unroll
            for (int q = 0; q < 4; ++q) { const float g0 = __uint_as_float(gw_[q] << 16), g1 = __uint_as_float(gw_[q] & 0xffff0000u);
                ow[q] = pk(__uint_as_float(nw[q] << 16) * (g0 / (1.0f + __expf(-g0))), __uint_as_float(nw[q] & 0xffff0000u) * (g1 / (1.0f + __expf(-g1)))); }
            *(u32x4*)(mix + row * DM + 512 + h * 128 + ch * 8) = (u32x4){ow[0], ow[1], ow[2], ow[3]}; }
    }
    __syncthreads();
}
}
#ifndef REP_MASK
#define REP_MASK 0
#endif
#ifndef REP_SUB
#define REP_SUB 2
#endif
#include <hip/hip_cooperative_groups.h>
namespace cg = cooperative_groups;
constexpr int NWAVES = 8, NTHREADS = 512;
constexpr int LDS_BYTES = 147456 + 256;
constexpr int NPH = 11;
constexpr size_t WS_STASH = 180 * MiB;
constexpr size_t STASH_ELEMS = (size_t)512 * 2 * FF;

struct Args { const float* in[16]; float* out; unsigned char* ws; int ph_lo, ph_hi, flags, pad; };

__device__ __forceinline__ void p0_transpose_item(const float* __restrict__ W, int K, int N, const float* __restrict__ gk, bf16_t* __restrict__ WT, int k0, int n0, int orow0, LAS float* scr, int lane) {
#pragma unroll 8
    for (int i = 0; i < 32; ++i) { const int kk = 2 * i + (lane >> 5); const float g = gk ? gk[k0 + kk] : 1.0f; scr[kk * 33 + (lane & 31)] = W[(size_t)(k0 + kk) * N + n0 + (lane & 31)] * g; }
    asm volatile("s_waitcnt lgkmcnt(0)" ::: "memory");
    const int c = lane & 7;
#pragma unroll
    for (int j = 0; j < 4; ++j) { const int n = (lane >> 3) + 8 * j; const LAS float* s = scr + (8 * c) * 33 + n;
        uint4 o; o.x = (u32)f2bf(s[0 * 33]) | ((u32)f2bf(s[1 * 33]) << 16); o.y = (u32)f2bf(s[2 * 33]) | ((u32)f2bf(s[3 * 33]) << 16);
        o.z = (u32)f2bf(s[4 * 33]) | ((u32)f2bf(s[5 * 33]) << 16); o.w = (u32)f2bf(s[6 * 33]) | ((u32)f2bf(s[7 * 33]) << 16);
        *(uint4*)(WT + (size_t)(orow0 + n) * K + k0 + 8 * c) = o; }
    asm volatile("s_waitcnt lgkmcnt(0)" ::: "memory");
}

#define XB_TMO      128
#define XB_XCNT(j)  (256  + 64 * (j))
#define XB_XSUB(j)  (1280 + 64 * (j))
#define XB_XGEN(j)  (2304 + 64 * (j))
#define XB_TOP      3328
#define XB_TOPGEN   3392
#define XCD_BAR_WORDS 3456
#define XB_SPIN_CAP (1u << 18)

__device__ __forceinline__ unsigned xb_ld(unsigned* p)              { return __hip_atomic_load(p, __ATOMIC_RELAXED, __HIP_MEMORY_SCOPE_AGENT); }
__device__ __forceinline__ unsigned xb_add(unsigned* p, unsigned v) { return __hip_atomic_fetch_add(p, v, __ATOMIC_RELAXED, __HIP_MEMORY_SCOPE_AGENT); }
__device__ __forceinline__ unsigned xb_xcc_id() { return (unsigned)__builtin_amdgcn_s_getreg((3 << 11) | 20) & 0xFu; }
#define XB_SPIN(cond, bar) do { unsigned _sp = 0; while (cond) { __builtin_amdgcn_s_sleep(1); \
    if ((++_sp & 255u) == 0u) { if (xb_ld(&(bar)[XB_TMO])) break; if (_sp > XB_SPIN_CAP) { atomicAdd(&(bar)[XB_TMO], 1u); break; } } } } while (0)

struct XcdBarrier {
    unsigned* bar; unsigned x;
    volatile LAS unsigned* st;
};

__device__ __forceinline__ XcdBarrier xcd_barrier_post(unsigned* bar, volatile LAS unsigned* st) {
    XcdBarrier b; b.bar = bar; b.x = xb_xcc_id(); b.st = st;
    if (threadIdx.x == 0) (void)xb_add(&bar[XB_XCNT(b.x)], 1u);
    return b;
}
__device__ __forceinline__ void xcd_barrier_complete(unsigned* bar, unsigned x, unsigned& nloc, unsigned& nx) {
    const unsigned G = gridDim.x * gridDim.y * gridDim.z;
    unsigned sum, cnt, mine, sp = 0u;
    for (;;) {
        sum = 0u; cnt = 0u; mine = 0u;
#pragma unroll
        for (unsigned j = 0; j < 16; ++j) { const unsigned c = xb_ld(&bar[XB_XCNT(j)]); sum += c; cnt += (c > 0u) ? 1u : 0u; mine = (j == x) ? c : mine; }
        if (sum == G) break;
        __builtin_amdgcn_s_sleep(1);
        if ((++sp & 255u) == 0u) { if (xb_ld(&bar[XB_TMO])) break; if (sp > XB_SPIN_CAP) { atomicAdd(&bar[XB_TMO], 1u); break; } }
    }
    nloc = mine > 0u ? mine : 1u; nx = cnt > 0u ? cnt : 1u;
}

__device__ __forceinline__ void xcd_barrier(const XcdBarrier& b) {
    asm volatile("s_waitcnt vmcnt(0)" ::: "memory");
    __syncthreads();
    if (threadIdx.x == 0) {
        unsigned* bar = b.bar;
        __builtin_amdgcn_s_waitcnt(0);
        unsigned nloc = b.st[0], nx = b.st[1];
        if (nloc == 0u) { xcd_barrier_complete(bar, b.x, nloc, nx); b.st[0] = nloc; b.st[1] = nx; }
        const unsigned old = xb_add(&bar[XB_XSUB(b.x)], 1u);
        const unsigned gen = old / nloc;
        if (old + 1u == (gen + 1u) * nloc) {
            __builtin_amdgcn_fence(__ATOMIC_RELEASE, "agent");
            asm volatile("s_waitcnt vmcnt(0)" ::: "memory");
            const unsigned og = xb_add(&bar[XB_TOP], 1u);
            const unsigned tg = og / nx;
            if (og + 1u == (tg + 1u) * nx) xb_add(&bar[XB_TOPGEN], 1u);
            else XB_SPIN(xb_ld(&bar[XB_TOPGEN]) == tg, bar);
            __builtin_amdgcn_fence(__ATOMIC_ACQUIRE, "agent");
            xb_add(&bar[XB_XGEN(b.x)], 1u);
            asm volatile("s_waitcnt vmcnt(0)" ::: "memory");
        } else {
            XB_SPIN(xb_ld(&bar[XB_XGEN(b.x)]) == gen, bar);
            __builtin_amdgcn_fence(__ATOMIC_ACQUIRE, "agent");
            asm volatile("s_waitcnt vmcnt(0)" ::: "memory");
        }
    }
    __syncthreads();
}

constexpr int CW_BAR = 4096;
constexpr int LDS_BARST = 147456;
constexpr size_t CTL_ZERO_BYTES = 65536;

#if (REP_MASK >> 2) & 1
#define SUBON2(bit) (rep == 0 || ((REP_SUB >> (bit)) & 1))
#else
#define SUBON2(bit) true
#endif
#if (REP_MASK >> 3) & 1
#define SUBON3(bit) (rep == 0 || ((REP_SUB >> (bit)) & 1))
#else
#define SUBON3(bit) true
#endif
#if (REP_MASK >> 4) & 1
#define SUBON4(bit) (rep == 0 || ((REP_SUB >> (bit)) & 1))
#else
#define SUBON4(bit) true
#endif
__global__ void __launch_bounds__(NTHREADS, 2) mega(Args a) {
    extern __shared__ __attribute__((aligned(16))) unsigned char lds[];
    cg::grid_group grid = cg::this_grid();
    const int tid = threadIdx.x, lane = tid & 63, wave = __builtin_amdgcn_readfirstlane(tid >> 6);
    const int G = gridDim.x, bx = blockIdx.x;
    const int vcu = (G % 8 == 0) ? (bx % 8) * (G / 8) + bx / 8 : bx;
    const int gw = vcu * NWAVES + wave, NGW = G * NWAVES;
    unsigned char* ws = a.ws;
    const float* x = a.in[0]; const float* p = a.in[1]; const float* attn_norm = a.in[2]; const float* w_in = a.in[3]; const float* ret_norm = a.in[4]; const float* w_out = a.in[5];
    const float* ffn_norm = a.in[6]; const float* w_up = a.in[7]; const float* w_gate = a.in[8]; const float* conv_w = a.in[9]; const float* conv_b = a.in[10]; const float* w_down = a.in[11];
    const float* ple_norm = a.in[12]; const float* w_ple = a.in[13]; const float* w_ple_gate = a.in[14]; const float* final_norm = a.in[15];
    float* out = a.out;
    bf16_t* Win_t = (bf16_t*)(ws + WS_WIN); bf16_t* Wout_t = (bf16_t*)(ws + WS_WOUT); bf16_t* Wug_t = (bf16_t*)(ws + WS_WUG); bf16_t* Wdown_t = (bf16_t*)(ws + WS_WDOWN);
    bf16_t* Wpg_t = (bf16_t*)(ws + WS_WPG); bf16_t* Wple_t = (bf16_t*)(ws + WS_WPLE);
    bf16_t* XN = (bf16_t*)(ws + WS_R1); bf16_t* MIX = (bf16_t*)(ws + WS_R1); bf16_t* PW = (bf16_t*)(ws + WS_R1);
    bf16_t* XB = (bf16_t*)(ws + WS_R2);
    bf16_t* PROJ = (bf16_t*)(ws + WS_PROJ); bf16_t* ACT = (bf16_t*)(ws + WS_PROJ);
    bf16_t* PB = (bf16_t*)(ws + WS_PB); float* RSQ = (float*)(ws + WS_RSQ);
    float* KM = (float*)(ws + WS_KMEAN);
    float* UL = (float*)(ws + WS_STASH); float* UF = UL + STASH_ELEMS; float* GF = UF + STASH_ELEMS;
    float* KVT = (float*)(ws + WS_KVT); bf16_t* STT = (bf16_t*)(ws + WS_STT); float* PART_L = (float*)(ws + WS_PARTL); bf16_t* PART_O = (bf16_t*)out;
    u32* SEL = (u32*)(ws + WS_SEL); unsigned short* SEG = (unsigned short*)(ws + WS_SEG); int* CNT = (int*)(ws + WS_CNT);

    const int lo = a.ph_lo, hi = a.ph_hi;
#define IN(k) (lo <= (k) && (k) < hi)
#define SEAM(k) do { if (IN(k) && IN((k) + 1)) { if ((k) == 0) grid.sync(); else xcd_barrier(xbar); } } while (0)
    { volatile LAS unsigned* st = (volatile LAS unsigned*)((LAS unsigned char*)lds + LDS_BARST); if (tid < 2) st[tid] = 0u; }
    __syncthreads();
    XcdBarrier xbar = xcd_barrier_post((unsigned*)(ws + WS_CTL) + CW_BAR, (volatile LAS unsigned*)((LAS unsigned char*)lds + LDS_BARST));

#if (REP_MASK >> 0) & 1
    for (int rep = 0; rep < 2; ++rep)
#endif
    if (IN(0)) {
        LAS float* scr = (LAS float*)(lds) + wave * (64 * 33);
        constexpr int I_IN = 16 * (NPROJ / 32), I_OUT = 16 * (DM / 32), I_UP = 16 * (FF / 32), I_DOWN = (FF / 64) * (DM / 32), I_PG = 16 * (DM / 32), I_PLE = (PLED / 64) * (DM / 32);
        constexpr int NITEMS = I_IN + I_OUT + 2 * I_UP + I_DOWN + I_PG + I_PLE;
        for (int it = gw; it < NITEMS; it += NGW) {
            int r = it;
            if (r < I_IN) { const int nb = r % (NPROJ / 32), kb = r / (NPROJ / 32); p0_transpose_item(w_in, DM, NPROJ, nullptr, Win_t, kb * 64, nb * 32, nb * 32, scr, lane); continue; } r -= I_IN;
            if (r < I_OUT) { const int nb = r % (DM / 32), kb = r / (DM / 32); p0_transpose_item(w_out, DM, DM, nullptr, Wout_t, kb * 64, nb * 32, nb * 32, scr, lane); continue; } r -= I_OUT;
            if (r < I_UP) { const int nb = r % (FF / 32), kb = r / (FF / 32), n0 = nb * 32; p0_transpose_item(w_up, DM, FF, ffn_norm, Wug_t, kb * 64, n0, (n0 >> 7) * 256 + (n0 & 127), scr, lane); continue; } r -= I_UP;
            if (r < I_UP) { const int nb = r % (FF / 32), kb = r / (FF / 32), n0 = nb * 32; p0_transpose_item(w_gate, DM, FF, ffn_norm, Wug_t, kb * 64, n0, (n0 >> 7) * 256 + 128 + (n0 & 127), scr, lane); continue; } r -= I_UP;
            if (r < I_DOWN) { const int nb = r % (DM / 32), kb = r / (DM / 32); p0_transpose_item(w_down, FF, DM, nullptr, Wdown_t, kb * 64, nb * 32, nb * 32, scr, lane); continue; } r -= I_DOWN;
            if (r < I_PG) { const int nb = r % (DM / 32), kb = r / (DM / 32); p0_transpose_item(w_ple_gate, DM, DM, ple_norm, Wpg_t, kb * 64, nb * 32, nb * 32, scr, lane); continue; } r -= I_PG;
            { const int nb = r % (DM / 32), kb = r / (DM / 32); p0_transpose_item(w_ple, PLED, DM, nullptr, Wple_t, kb * 64, nb * 32, nb * 32, scr, lane); }
        }
        for (int m = gw; m < MT; m += NGW) {
            const float4* xr = (const float4*)(x + (size_t)m * DM); float4 v[4]; float s = 0.f;
#pragma unroll
            for (int j = 0; j < 4; ++j) { v[j] = xr[lane + 64 * j]; s += v[j].x * v[j].x + v[j].y * v[j].y + v[j].z * v[j].z + v[j].w * v[j].w; }
            const float rs = rsqrtf(wave_sum(s) * (1.0f / DM) + RMS_EPS);
#pragma unroll
            for (int j = 0; j < 4; ++j) { const float4 gg = ((const float4*)attn_norm)[lane + 64 * j];
                ushort4 o; o.x = f2bf(v[j].x * rs * gg.x); o.y = f2bf(v[j].y * rs * gg.y); o.z = f2bf(v[j].z * rs * gg.z); o.w = f2bf(v[j].w * rs * gg.w);
                ((ushort4*)(XN + (size_t)m * DM))[lane + 64 * j] = o; }
        }
        { const size_t n4 = (size_t)MT * PLED / 4; const size_t gt = (size_t)vcu * NTHREADS + tid, GT = (size_t)G * NTHREADS;
          for (size_t i = gt; i < n4; i += GT) { const float4 v = ((const float4*)p)[i]; ushort4 o; o.x = f2bf(v.x); o.y = f2bf(v.y); o.z = f2bf(v.z); o.w = f2bf(v.w); ((ushort4*)PB)[i] = o; }
          for (size_t i = gt; i < 16 * 64 * 64; i += GT) KM[i] = 0.f;
          if (gt < 64) ((int*)(ws + WS_CTL))[gt] = 0;
          for (size_t i = gt; i < 16 * 64 * 64; i += GT) CNT[i] = 0; }
    }
    SEAM(0);
#if (REP_MASK >> 1) & 1
    if (IN(1)) {
        pg8::Gemm g{XN, Win_t, MT, NPROJ, DM}; pg8::StaticOrder S; S.init(MT, NPROJ, G, bx);
        pg8::EpiProj E{PROJ, KM};
        pg8::gemm_phase<pg8::EpiProj, pg8::StaticOrder, true, true>((PG8_LAS unsigned char*)lds, g, S, E);
    }
    asm volatile("" ::: "memory");
#endif
    if (IN(1)) {
        pg8::Gemm g{XN, Win_t, MT, NPROJ, DM}; pg8::StaticOrder S; S.init(MT, NPROJ, G, bx);
        pg8::EpiProj E{PROJ, KM};
        pg8::gemm_phase<pg8::EpiProj, pg8::StaticOrder, true, true>((PG8_LAS unsigned char*)lds, g, S, E);
    }
    SEAM(1);
#if (REP_MASK >> 2) & 1
    for (int rep = 0; rep < 2; ++rep)
#endif
    if (IN(2)) {
        mx::lds_ptr L = (mx::lds_ptr)lds;
        if (!(a.flags & 1) && SUBON2(0)) for (int it = bx; it < 512; it += G) mx::ret_kv_task(PROJ, it >> 6, it & 63, KVT, L, tid);
        if (!(a.flags & 2)) {
            if (SUBON2(1)) for (int it = bx; it < 16 * 63; it += G) mx::gate_task_mfma(it / 63, 1 + it % 63, PROJ, KM, SEL, SEG, CNT, L, tid);
            { const int gtid = vcu * NTHREADS + tid; if (gtid < BATCH * 256 * 8) { const int h = gtid & 7, t = (gtid >> 3) & 255, b = gtid >> 11; SEL[((size_t)b * SEQ + t) * 8 + h] = 0u; } }
            if (SUBON2(2)) for (int it = bx; it < 16 * 64; it += G) mx::moba_diag_unit(PROJ, it >> 6, it & 63, PART_O, PART_L, L, tid);
        }
    }
    SEAM(2);
#if (REP_MASK >> 3) & 1
#define QREP rep
#else
#define QREP 0
#endif
#if (REP_MASK >> 3) & 1
    for (int rep = 0; rep < 2; ++rep)
#endif
    if (IN(3)) {
        mx::lds_ptr L = (mx::lds_ptr)lds;
        if (!(a.flags & 1) && SUBON3(0)) mx::ret_scan(KVT, STT, (size_t)vcu * NTHREADS + tid, (size_t)G * NTHREADS);
        if (!(a.flags & 2) && SUBON3(1)) {
            LAS int* qslot = (LAS int*)(L + mx::L_PREF + 384);
            for (;;) {
                if (tid == 0) *qslot = atomicAdd((int*)(ws + WS_CTL) + QREP, 1);
                __syncthreads();
                const int q = *qslot;
                __syncthreads();
                if (q >= 16 * 63) break;
                mx::moba_sel_task(PROJ, SEG, CNT, q & 15, q >> 4, PART_O, PART_L, L, tid);
            }
        }
    }
    SEAM(3);
#if (REP_MASK >> 4) & 1
    for (int rep = 0; rep < 2; ++rep)
#endif
    if (IN(4)) {
        mx::lds_ptr L = (mx::lds_ptr)lds;
        if (!(a.flags & 1) && SUBON4(0)) for (int it = bx; it < 512; it += G) mx::ret_out_task(PROJ, STT, ret_norm, MIX, it >> 6, it & 63, L, tid);
        if (!(a.flags & 2) && SUBON4(1)) mx::moba_combine(PART_O, PART_L, SEL, MIX, (size_t)vcu * NTHREADS + tid, (size_t)G * NTHREADS);
    }
    SEAM(4);
#if (REP_MASK >> 5) & 1
    if (IN(5)) {
        pg8::Gemm g{MIX, Wout_t, MT, DM, DM}; pg8::StaticOrder S; S.init(MT, DM, G, bx);
        pg8::EpiRes E{x, out, XB, RSQ};
        pg8::gemm_phase<pg8::EpiRes, pg8::StaticOrder, true, true>((PG8_LAS unsigned char*)lds, g, S, E);
    }
    asm volatile("" ::: "memory");
#endif
    if (IN(5)) {
        pg8::Gemm g{MIX, Wout_t, MT, DM, DM}; pg8::StaticOrder S; S.init(MT, DM, G, bx);
        pg8::EpiRes E{x, out, XB, RSQ};
        pg8::gemm_phase<pg8::EpiRes, pg8::StaticOrder, true, true>((PG8_LAS unsigned char*)lds, g, S, E);
    }
    SEAM(5);
#if (REP_MASK >> 6) & 1
    if (IN(6)) {
        pg8::Gemm g{XB, Wug_t, MT, 2 * FF, DM}; pg8::StaticOrder S; S.init(MT, 2 * FF, G, bx);
        pg8::EpiUG E{ACT, RSQ, conv_w, conv_b, UL, UF, GF};
        pg8::gemm_phase<pg8::EpiUG, pg8::StaticOrder, true, true>((PG8_LAS unsigned char*)lds, g, S, E);
    }
    asm volatile("" ::: "memory");
#endif
    if (IN(6)) {
        pg8::Gemm g{XB, Wug_t, MT, 2 * FF, DM}; pg8::StaticOrder S; S.init(MT, 2 * FF, G, bx);
        pg8::EpiUG E{ACT, RSQ, conv_w, conv_b, UL, UF, GF};
        pg8::gemm_phase<pg8::EpiUG, pg8::StaticOrder, true, true>((PG8_LAS unsigned char*)lds, g, S, E);
    }
    SEAM(6);
#if (REP_MASK >> 7) & 1
    for (int rep = 0; rep < 2; ++rep)
#endif
    if (IN(7)) {
        const size_t gt = (size_t)vcu * NTHREADS + tid, GT = (size_t)G * NTHREADS;
        for (size_t i = gt; i < (size_t)512 * 2 * FF; i += GT) {
            const int c = (int)(i % FF), r = (int)((i / FF) & 1), g64 = (int)(i / FF / 2);
            float p0 = 0.f, p1 = 0.f;
            if ((g64 & 255) != 0) { p0 = UL[((size_t)(g64 - 1) * 2 + 0) * FF + c]; p1 = UL[((size_t)(g64 - 1) * 2 + 1) * FF + c]; }
            const float f0 = UF[((size_t)g64 * 2 + 0) * FF + c], f1 = UF[((size_t)g64 * 2 + 1) * FF + c];
            const float gg = GF[((size_t)g64 * 2 + r) * FF + c];
            const float u2 = r == 0 ? p0 : p1, u1 = r == 0 ? p1 : f0, u0 = r == 0 ? f0 : f1;
            const float y = conv_b[c] + conv_w[c] * u2 + conv_w[FF + c] * u1 + conv_w[2 * FF + c] * u0;
            ACT[((size_t)g64 * 64 + r) * FF + c] = f2bf(gelu_tanh(y) * gg);
        }
    }
    SEAM(7);
    if (IN(8)) {
        pg8::Gemm g{ACT, Wdown_t, MT, DM, FF}; pg8::StaticOrder S; S.init(MT, DM, G, bx);
        pg8::EpiRes E{out, out, XB, RSQ + (size_t)MT * 16};
        pg8::gemm_phase<pg8::EpiRes, pg8::StaticOrder, true, true>((PG8_LAS unsigned char*)lds, g, S, E);
    }
    SEAM(8);
    if (IN(9)) {
        { int kk = PLED; asm volatile("" : "+s"(kk)); pg8::Gemm g{PB, Wple_t, MT, DM, kk}; pg8::StaticOrder S; S.init(MT, DM, G, bx); pg8::EpiStore E{PW};
          pg8::gemm_phase<pg8::EpiStore, pg8::StaticOrder, true, true>((PG8_LAS unsigned char*)lds, g, S, E); }
        { int kk = DM; const bf16_t* a_ = XB; const bf16_t* b_ = Wpg_t; asm volatile("" : "+s"(kk), "+s"(a_), "+s"(b_) :: "memory"); pg8::Gemm g{a_, b_, MT, DM, kk}; pg8::StaticOrder S; S.init(MT, DM, G, bx); pg8::EpiPle E{out, PW, RSQ + (size_t)MT * 16, RSQ + (size_t)2 * MT * 16};
          pg8::gemm_phase<pg8::EpiPle, pg8::StaticOrder, true, true>((PG8_LAS unsigned char*)lds, g, S, E); }
    }
    SEAM(9);
    if (IN(10)) {
        const float* rsq = RSQ + (size_t)2 * MT * 16;
        for (int m = gw; m < MT; m += NGW) {
            const float rs = pg8::rs16(rsq + (size_t)m * 16); float4* xr = (float4*)(out + (size_t)m * DM);
#pragma unroll
            for (int j = 0; j < 4; ++j) { float4 v = xr[lane + 64 * j]; const float4 gg = ((const float4*)final_norm)[lane + 64 * j];
                v.x *= rs * gg.x; v.y *= rs * gg.y; v.z *= rs * gg.z; v.w *= rs * gg.w; xr[lane + 64 * j] = v; }
        }
    }
#undef IN
#undef SEAM
}

#ifndef BUILD_MODE
#define BUILD_MODE 0
#endif
static int g_grid = 0;
static void launch_mega(Args a, int lo, int hi, hipStream_t stream) {
    a.ph_lo = lo; a.ph_hi = hi; void* args[] = {&a};
    hipError_t e = hipLaunchCooperativeKernel((const void*)mega, dim3(g_grid), dim3(NTHREADS), args, LDS_BYTES, stream);
    if (e != hipSuccess) fprintf(stderr, "cooperative launch [%d,%d) failed: %s (grid %d)\n", lo, hi, hipGetErrorString(e), g_grid);
}
extern "C" void kernel_launch(void* const* d_in, const int* in_sizes, int n_in, void* d_out, int out_size, void* d_ws, size_t ws_size, hipStream_t stream) {
    if (n_in != 16 || out_size != MT * DM || ws_size < WS_END) { fprintf(stderr, "kernel_launch: unexpected shapes (n_in %d out %d ws %zu)\n", n_in, out_size, ws_size); return; }
    if (g_grid == 0) {
        int dev = 0, cus = 0, per_cu = 0;
        hipGetDevice(&dev); hipDeviceGetAttribute(&cus, hipDeviceAttributeMultiprocessorCount, dev);
        hipFuncSetAttribute((const void*)mega, hipFuncAttributeMaxDynamicSharedMemorySize, LDS_BYTES);
        hipOccupancyMaxActiveBlocksPerMultiprocessor(&per_cu, (const void*)mega, NTHREADS, LDS_BYTES);
        if (per_cu < 1) { fprintf(stderr, "occupancy query says %d blocks/CU\n", per_cu); per_cu = 1; }
        g_grid = cus * 1;
        (void)hipGetLastError();
    }
    const float* ret_norm = (const float*)d_in[4];
    unsigned char* ws = (unsigned char*)d_ws;
    bf16_t* MIX = (bf16_t*)(ws + WS_R1); float* RETRAW = (float*)(ws + WS_R2);
    bf16_t* PROJ = (bf16_t*)(ws + WS_PROJ);
    float* KM = (float*)(ws + WS_KMEAN); u32* SEL = (u32*)(ws + WS_SEL); unsigned short* SEG = (unsigned short*)(ws + WS_SEG); int* CNT = (int*)(ws + WS_CNT);
    hipMemsetAsync(ws + WS_CTL, 0, CTL_ZERO_BYTES, stream);
    Args a{}; for (int i = 0; i < 16; ++i) a.in[i] = (const float*)d_in[i]; a.out = (float*)d_out; a.ws = ws;

#if BUILD_MODE == 0
    a.flags = 0; launch_mega(a, 0, NPH, stream);
#elif BUILD_MODE == 1
    a.flags = 1; launch_mega(a, 0, 5, stream);
    k_ret_naive<<<dim3(SEQ / 64, BATCH * RH), 256, 0, stream>>>(PROJ, RETRAW);
    k_ret_post<<<MT * RH / 4, 256, 0, stream>>>(RETRAW, PROJ, ret_norm, MIX);
    launch_mega(a, 5, NPH, stream);
#elif BUILD_MODE == 2
    a.flags = 2; launch_mega(a, 0, 2, stream);
    k_sel_block0<<<BATCH * 256 * 8 / 256, 256, 0, stream>>>(SEL);
    k_gate<<<16 * 63, 512, 0, stream>>>(PROJ, KM, SEL, SEG, CNT);
    k_moba_naive<<<16 * SEQ / 256, 256, 0, stream>>>(PROJ, SEL, MIX);
    launch_mega(a, 2, NPH, stream);
#endif
}
```

```cpp
#include <hip/hip_runtime.h>
#include <stdint.h>
#include <math.h>
#include <cstdio>

typedef unsigned short bf16_t;
typedef unsigned int u32;

constexpr int BATCH = 2, SEQ = 16384, MT = BATCH * SEQ, DM = 1024, NPROJ = 3584, FF = 2816, PLED = 256;
constexpr int MH = 8, MD = 64, RH = 4, RD = 128, NBLK = 64, BLK = 256;
constexpr int C_MQ = 0, C_MK = 512, C_MV = 1024, C_RQ = 1536, C_RK = 2048, C_RV = 2560, C_RG = 3072;
constexpr float RMS_EPS = 1e-6f, GN_EPS = 1e-5f;
constexpr float LOG2E = 1.4426950408889634f;
constexpr float QSCALE = 0.125f * LOG2E;
constexpr float RKSCALE = 0.08838834764831845f;

constexpr size_t MiB = (size_t)1 << 20;
constexpr size_t WS_CTL = 0, WS_WIN = 1 * MiB, WS_WOUT = 8 * MiB, WS_WUG = 10 * MiB, WS_WDOWN = 21 * MiB, WS_WPG = 27 * MiB, WS_WPLE = 29 * MiB;
constexpr size_t WS_RSQ = 30 * MiB;
constexpr size_t WS_PB = 36 * MiB;
constexpr size_t WS_R2 = 52 * MiB;
constexpr size_t WS_R1 = 116 * MiB;
constexpr size_t WS_SEG = 180 * MiB;
constexpr size_t WS_KVT = 212 * MiB;
constexpr size_t WS_STT = 244 * MiB;
constexpr size_t WS_PARTL = 260 * MiB;
constexpr size_t WS_SEL = 264 * MiB;
constexpr size_t WS_CNT = 265 * MiB;
constexpr size_t WS_KMEAN = WS_CNT + 512 * 1024;
constexpr size_t WS_PROJ = 266 * MiB;
constexpr size_t WS_END = 490 * MiB;
constexpr size_t WS_UH = 116 * MiB;

__device__ __forceinline__ float bf2f(bf16_t v) { return __uint_as_float(((u32)v) << 16); }
__device__ __forceinline__ bf16_t f2bf(float f) { u32 u = __float_as_uint(f); return (bf16_t)((u + 0x7fffu + ((u >> 16) & 1u)) >> 16); }
__device__ __forceinline__ float wave_sum(float v) {
#pragma unroll
    for (int o = 1; o < 64; o <<= 1) v += __shfl_xor(v, o);
    return v;
}
__device__ __forceinline__ float rs_from(const float* p) {
    float s = 0.f;
#pragma unroll
    for (int i = 0; i < 16; ++i) s += p[i];
    return rsqrtf(s * (1.0f / DM) + RMS_EPS);
}
__device__ __forceinline__ float gelu_tanh(float x) {
    const float z = 0.7978845608028654f * (x + 0.044715f * x * x * x);
    return x / (1.0f + __expf(-2.0f * z));
}
__device__ __forceinline__ float sigmoidf_(float x) { return 1.0f / (1.0f + __expf(-x)); }

__global__ __launch_bounds__(256) void k_rmsnorm_bf16(const float* __restrict__ x, const float* __restrict__ g, bf16_t* __restrict__ out) {
    const int row = blockIdx.x * 4 + (threadIdx.x >> 6), lane = threadIdx.x & 63;
    const float4* xr = (const float4*)(x + (size_t)row * DM);
    float4 v[4]; float s = 0.f;
#pragma unroll
    for (int j = 0; j < 4; ++j) { v[j] = xr[lane + 64 * j]; s += v[j].x * v[j].x + v[j].y * v[j].y + v[j].z * v[j].z + v[j].w * v[j].w; }
    const float rs = rsqrtf(wave_sum(s) * (1.0f / DM) + RMS_EPS);
#pragma unroll
    for (int j = 0; j < 4; ++j) {
        const float4 gg = ((const float4*)g)[lane + 64 * j];
        ushort4 o; o.x = f2bf(v[j].x * rs * gg.x); o.y = f2bf(v[j].y * rs * gg.y); o.z = f2bf(v[j].z * rs * gg.z); o.w = f2bf(v[j].w * rs * gg.w);
        ((ushort4*)(out + (size_t)row * DM))[lane + 64 * j] = o;
    }
}
__global__ void k_cvt_bf16(const float* __restrict__ in, bf16_t* __restrict__ out, size_t n) {
    for (size_t i = (size_t)blockIdx.x * blockDim.x + threadIdx.x; i < n; i += (size_t)gridDim.x * blockDim.x) out[i] = f2bf(in[i]);
}
__global__ __launch_bounds__(256) void k_rowsq(const float* __restrict__ x, float* __restrict__ rsq) {
    const int row = blockIdx.x * 4 + (threadIdx.x >> 6), lane = threadIdx.x & 63;
    const float4* xr = (const float4*)(x + (size_t)row * DM);
    float s = 0.f;
#pragma unroll
    for (int j = 0; j < 4; ++j) { const float4 v = xr[lane + 64 * j]; s += v.x * v.x + v.y * v.y + v.z * v.z + v.w * v.w; }
    s = wave_sum(s);
    if (lane < 16) rsq[(size_t)row * 16 + lane] = lane == 0 ? s : 0.f;
}
__global__ __launch_bounds__(256) void k_final_norm(float* __restrict__ x, const float* __restrict__ rsq, const float* __restrict__ g) {
    const int row = blockIdx.x * 4 + (threadIdx.x >> 6), lane = threadIdx.x & 63;
    const float rs = rs_from(rsq + (size_t)row * 16);
    float4* xr = (float4*)(x + (size_t)row * DM);
#pragma unroll
    for (int j = 0; j < 4; ++j) { float4 v = xr[lane + 64 * j]; const float4 gg = ((const float4*)g)[lane + 64 * j];
        v.x *= rs * gg.x; v.y *= rs * gg.y; v.z *= rs * gg.z; v.w *= rs * gg.w; xr[lane + 64 * j] = v; }
}

template <class Epi>
__global__ __launch_bounds__(256) void ngemm(const bf16_t* __restrict__ A, const float* __restrict__ Bm, const float* __restrict__ gk, int lda, int ldb, int K, int pad_, Epi e) {
    __shared__ float As[16][65];
    __shared__ float Bs[16][64];
    const int tid = threadIdx.x, tx = tid & 15, ty = tid >> 4;
    const int r0 = blockIdx.y * 64, c0 = blockIdx.x * 64;
    float acc[4][4];
#pragma unroll
    for (int i = 0; i < 4; ++i)
#pragma unroll
        for (int j = 0; j < 4; ++j) acc[i][j] = 0.f;
    for (int k0 = 0; k0 < K; k0 += 16) {
        { const int row = tid >> 2, kq = (tid & 3) * 4; const ushort4 a = *(const ushort4*)(A + (size_t)(r0 + row) * lda + k0 + kq);
          As[kq + 0][row] = bf2f(a.x); As[kq + 1][row] = bf2f(a.y); As[kq + 2][row] = bf2f(a.z); As[kq + 3][row] = bf2f(a.w); }
        { const int k = tid >> 4, n4 = (tid & 15) * 4; float4 b = *(const float4*)(Bm + (size_t)(k0 + k) * ldb + c0 + n4);
          const float gg = gk ? gk[k0 + k] : 1.0f; Bs[k][n4] = b.x * gg; Bs[k][n4 + 1] = b.y * gg; Bs[k][n4 + 2] = b.z * gg; Bs[k][n4 + 3] = b.w * gg; }
        __syncthreads();
#pragma unroll
        for (int kk = 0; kk < 16; ++kk) {
            float a[4], b[4];
#pragma unroll
            for (int i = 0; i < 4; ++i) { a[i] = As[kk][ty * 4 + i]; b[i] = Bs[kk][tx * 4 + i]; }
#pragma unroll
            for (int i = 0; i < 4; ++i)
#pragma unroll
                for (int j = 0; j < 4; ++j) acc[i][j] += a[i] * b[j];
        }
        __syncthreads();
    }
#pragma unroll
    for (int i = 0; i < 4; ++i)
#pragma unroll
        for (int j = 0; j < 4; ++j) e(r0 + ty * 4 + i, c0 + tx * 4 + j, acc[i][j]);
}
struct NEpiProj { bf16_t* O; __device__ void operator()(int r, int c, float v) const {
    const float sc = c < 512 ? QSCALE : ((c >= C_RK && c < C_RV) ? RKSCALE : 1.0f); O[(size_t)r * NPROJ + c] = f2bf(v * sc); } };
struct NEpiRes { const float* base; float* out; bf16_t* xb; __device__ void operator()(int r, int c, float v) const {
    const size_t i = (size_t)r * DM + c; const float y = base[i] + v; out[i] = y; xb[i] = f2bf(y); } };
struct NEpiScaleBf16 { bf16_t* O; const float* rsq; int ldo; int row_off; __device__ void operator()(int r, int c, float v) const {
    const float rs = rsq ? rs_from(rsq + (size_t)(r + row_off) * 16) : 1.0f; O[(size_t)r * ldo + c] = f2bf(v * rs); } };
struct NEpiPle { float* out; const bf16_t* pw; const float* rsq; __device__ void operator()(int r, int c, float v) const {
    const size_t i = (size_t)r * DM + c; const float rs = rs_from(rsq + (size_t)r * 16); out[i] = out[i] + bf2f(pw[i]) * sigmoidf_(v * rs); } };

__global__ void k_kmean(const bf16_t* __restrict__ proj, float* __restrict__ km) {
    const int bhb = blockIdx.x, d = threadIdx.x, blk = bhb & 63, h = (bhb >> 6) & 7, b = bhb >> 9;
    float s = 0.f;
    for (int j = 0; j < 256; ++j) s += bf2f(proj[(size_t)(b * SEQ + blk * 256 + j) * NPROJ + C_MK + h * 64 + d]);
    km[(size_t)bhb * 64 + d] = s;
}

__device__ __forceinline__ void gate_task(int bh, int i, const bf16_t* __restrict__ proj, const float* __restrict__ kmsum, u32* __restrict__ sel,
                                          unsigned short* __restrict__ seg, int* __restrict__ cnt, unsigned char* lds_raw) {
    float* km = (float*)lds_raw; int* cntL = (int*)(lds_raw + 16384);
    const int tid = threadIdx.x, b = bh >> 3, h = bh & 7;
    for (int e = tid; e < i * 64; e += blockDim.x) km[e] = kmsum[(size_t)bh * 4096 + e] * (1.0f / 256.0f);
    if (tid < 64) cntL[tid] = 0;
    __syncthreads();
    if (tid < 256) {
        const int t = i * 256 + tid; const size_t row = (size_t)b * SEQ + t;
        float q[64];
        const uint4* qp = (const uint4*)(proj + row * NPROJ + C_MQ + h * 64);
#pragma unroll
        for (int c = 0; c < 8; ++c) { const uint4 u = qp[c];
            q[c * 8 + 0] = __uint_as_float(u.x << 16); q[c * 8 + 1] = __uint_as_float(u.x & 0xffff0000u);
            q[c * 8 + 2] = __uint_as_float(u.y << 16); q[c * 8 + 3] = __uint_as_float(u.y & 0xffff0000u);
            q[c * 8 + 4] = __uint_as_float(u.z << 16); q[c * 8 + 5] = __uint_as_float(u.z & 0xffff0000u);
            q[c * 8 + 6] = __uint_as_float(u.w << 16); q[c * 8 + 7] = __uint_as_float(u.w & 0xffff0000u); }
        float v0 = -INFINITY, v1 = -INFINITY, v2 = -INFINITY; int i0 = 0, i1 = 0, i2 = 0;
        for (int n = 0; n < i; ++n) {
            const float4* kr = (const float4*)(km + n * 64);
            float d0 = 0.f, d1 = 0.f;
#pragma unroll
            for (int c = 0; c < 16; c += 2) { const float4 a = kr[c], bb = kr[c + 1];
                d0 += q[c * 4] * a.x + q[c * 4 + 1] * a.y + q[c * 4 + 2] * a.z + q[c * 4 + 3] * a.w;
                d1 += q[c * 4 + 4] * bb.x + q[c * 4 + 5] * bb.y + q[c * 4 + 6] * bb.z + q[c * 4 + 7] * bb.w; }
            const float v = d0 + d1;
            if (v > v0) { v2 = v1; i2 = i1; v1 = v0; i1 = i0; v0 = v; i0 = n; }
            else if (v > v1) { v2 = v1; i2 = i1; v1 = v; i1 = n; }
            else if (v > v2) { v2 = v; i2 = n; }
        }
        const int nv = i < 3 ? i : 3;
        sel[row * 8 + h] = (u32)i0 | ((u32)i1 << 8) | ((u32)i2 << 16) | ((u32)nv << 24);
#pragma unroll
        for (int s = 0; s < 3; ++s) if (s < nv) { const int n = s == 0 ? i0 : (s == 1 ? i1 : i2);
            const int pos = atomicAdd(&cntL[n], 1);
            seg[(((size_t)bh * 64 + n) * 64 + i) * 256 + pos] = (unsigned short)((tid << 2) | s); }
    }
    __syncthreads();
    if (tid < i) cnt[((size_t)bh * 64 + tid) * 64 + i] = cntL[tid];
    __syncthreads();
}
__global__ __launch_bounds__(512) void k_gate(const bf16_t* proj, const float* kmsum, u32* sel, unsigned short* seg, int* cnt) {
    __shared__ __attribute__((aligned(16))) unsigned char lds[16384 + 256];
    const int task = blockIdx.x, bh = task / 63, i = 1 + task % 63;
    gate_task(bh, i, proj, kmsum, sel, seg, cnt, lds);
}
__global__ void k_sel_block0(u32* sel) {
    const int g = blockIdx.x * blockDim.x + threadIdx.x;
    const int h = g & 7, t = (g >> 3) & 255, b = g >> 11;
    sel[((size_t)b * SEQ + t) * 8 + h] = 0u;
}

__global__ __launch_bounds__(256) void k_moba_naive(const bf16_t* __restrict__ proj, const u32* __restrict__ sel, bf16_t* __restrict__ mix) {
    const int gid = blockIdx.x * 256 + threadIdx.x; const int t = gid & (SEQ - 1), bh = gid >> 14, b = bh >> 3, h = bh & 7;
    const size_t row = (size_t)b * SEQ + t;
    float q[64], acc[64];
    { const uint4* qp = (const uint4*)(proj + row * NPROJ + C_MQ + h * 64);
#pragma unroll
      for (int c = 0; c < 8; ++c) { const uint4 u = qp[c];
        q[c * 8 + 0] = __uint_as_float(u.x << 16); q[c * 8 + 1] = __uint_as_float(u.x & 0xffff0000u);
        q[c * 8 + 2] = __uint_as_float(u.y << 16); q[c * 8 + 3] = __uint_as_float(u.y & 0xffff0000u);
        q[c * 8 + 4] = __uint_as_float(u.z << 16); q[c * 8 + 5] = __uint_as_float(u.z & 0xffff0000u);
        q[c * 8 + 6] = __uint_as_float(u.w << 16); q[c * 8 + 7] = __uint_as_float(u.w & 0xffff0000u); } }
#pragma unroll
    for (int d = 0; d < 64; ++d) acc[d] = 0.f;
    const u32 sp = sel[row * 8 + h]; const int nv = sp >> 24, own = t >> 8;
    const float slope2 = exp2f(-(float)(h + 1)) * LOG2E;
    float m = -1e30f, l = 0.f;
    for (int s = 0; s <= nv; ++s) {
        const int blk = s < nv ? (int)((sp >> (8 * s)) & 255u) : own;
        const int nk = s < nv ? 256 : (t & 255) + 1;
        for (int j = 0; j < nk; ++j) {
            const int kp = blk * 256 + j;
            const uint4* kr = (const uint4*)(proj + ((size_t)b * SEQ + kp) * NPROJ + C_MK + h * 64);
            float dot = 0.f;
#pragma unroll
            for (int c = 0; c < 8; ++c) { const uint4 u = kr[c];
                dot += q[c * 8 + 0] * __uint_as_float(u.x << 16) + q[c * 8 + 1] * __uint_as_float(u.x & 0xffff0000u)
                     + q[c * 8 + 2] * __uint_as_float(u.y << 16) + q[c * 8 + 3] * __uint_as_float(u.y & 0xffff0000u)
                     + q[c * 8 + 4] * __uint_as_float(u.z << 16) + q[c * 8 + 5] * __uint_as_float(u.z & 0xffff0000u)
                     + q[c * 8 + 6] * __uint_as_float(u.w << 16) + q[c * 8 + 7] * __uint_as_float(u.w & 0xffff0000u); }
            const float sc = dot - slope2 * (float)(t - kp);
            if (sc > m) { const float f = exp2f(m - sc); l *= f;
#pragma unroll
                for (int d = 0; d < 64; ++d) acc[d] *= f;
                m = sc; }
            const float p = exp2f(sc - m); l += p;
            const uint4* vr = (const uint4*)(proj + ((size_t)b * SEQ + kp) * NPROJ + C_MV + h * 64);
#pragma unroll
            for (int c = 0; c < 8; ++c) { const uint4 u = vr[c];
                acc[c * 8 + 0] += p * __uint_as_float(u.x << 16); acc[c * 8 + 1] += p * __uint_as_float(u.x & 0xffff0000u);
                acc[c * 8 + 2] += p * __uint_as_float(u.y << 16); acc[c * 8 + 3] += p * __uint_as_float(u.y & 0xffff0000u);
                acc[c * 8 + 4] += p * __uint_as_float(u.z << 16); acc[c * 8 + 5] += p * __uint_as_float(u.z & 0xffff0000u);
                acc[c * 8 + 6] += p * __uint_as_float(u.w << 16); acc[c * 8 + 7] += p * __uint_as_float(u.w & 0xffff0000u); }
        }
    }
    const float il = 1.0f / l;
#pragma unroll
    for (int d = 0; d < 64; ++d) mix[row * DM + h * 64 + d] = f2bf(acc[d] * il);
}

__global__ __launch_bounds__(256) void k_ret_naive(const bf16_t* __restrict__ proj, float* __restrict__ retraw) {
    const int tl = threadIdx.x & 63, eq = threadIdx.x >> 6, t = blockIdx.x * 64 + tl, bh = blockIdx.y, b = bh >> 2, h = bh & 3;
    const size_t row = (size_t)b * SEQ + t;
    float q[128], acc[32];
    { const uint4* qp = (const uint4*)(proj + row * NPROJ + C_RQ + h * 128);
#pragma unroll
      for (int c = 0; c < 16; ++c) { const uint4 u = qp[c];
        q[c * 8 + 0] = __uint_as_float(u.x << 16); q[c * 8 + 1] = __uint_as_float(u.x & 0xffff0000u);
        q[c * 8 + 2] = __uint_as_float(u.y << 16); q[c * 8 + 3] = __uint_as_float(u.y & 0xffff0000u);
        q[c * 8 + 4] = __uint_as_float(u.z << 16); q[c * 8 + 5] = __uint_as_float(u.z & 0xffff0000u);
        q[c * 8 + 6] = __uint_as_float(u.w << 16); q[c * 8 + 7] = __uint_as_float(u.w & 0xffff0000u); } }
#pragma unroll
    for (int e = 0; e < 32; ++e) acc[e] = 0.f;
    const float log2g = log2f(1.0f - exp2f(-5.0f - (float)h));
    const int smax = blockIdx.x * 64 + 63;
    for (int s = 0; s <= smax; ++s) {
        const uint4* kr = (const uint4*)(proj + ((size_t)b * SEQ + s) * NPROJ + C_RK + h * 128);
        float dot = 0.f;
#pragma unroll
        for (int c = 0; c < 16; ++c) { const uint4 u = kr[c];
            dot += q[c * 8 + 0] * __uint_as_float(u.x << 16) + q[c * 8 + 1] * __uint_as_float(u.x & 0xffff0000u)
                 + q[c * 8 + 2] * __uint_as_float(u.y << 16) + q[c * 8 + 3] * __uint_as_float(u.y & 0xffff0000u)
                 + q[c * 8 + 4] * __uint_as_float(u.z << 16) + q[c * 8 + 5] * __uint_as_float(u.z & 0xffff0000u)
                 + q[c * 8 + 6] * __uint_as_float(u.w << 16) + q[c * 8 + 7] * __uint_as_float(u.w & 0xffff0000u); }
        const float w = s <= t ? dot * exp2f((float)(t - s) * log2g) : 0.f;
        const uint4* vr = (const uint4*)(proj + ((size_t)b * SEQ + s) * NPROJ + C_RV + h * 128 + eq * 32);
#pragma unroll
        for (int c = 0; c < 4; ++c) { const uint4 u = vr[c];
            acc[c * 8 + 0] += w * __uint_as_float(u.x << 16); acc[c * 8 + 1] += w * __uint_as_float(u.x & 0xffff0000u);
            acc[c * 8 + 2] += w * __uint_as_float(u.y << 16); acc[c * 8 + 3] += w * __uint_as_float(u.y & 0xffff0000u);
            acc[c * 8 + 4] += w * __uint_as_float(u.z << 16); acc[c * 8 + 5] += w * __uint_as_float(u.z & 0xffff0000u);
            acc[c * 8 + 6] += w * __uint_as_float(u.w << 16); acc[c * 8 + 7] += w * __uint_as_float(u.w & 0xffff0000u); }
    }
#pragma unroll
    for (int e = 0; e < 32; ++e) retraw[row * 512 + h * 128 + eq * 32 + e] = acc[e];
}
__global__ __launch_bounds__(256) void k_ret_post(const float* __restrict__ retraw, const bf16_t* __restrict__ proj, const float* __restrict__ gain, bf16_t* __restrict__ mix) {
    const int wid = blockIdx.x * 4 + (threadIdx.x >> 6), lane = threadIdx.x & 63; const int h = wid & 3; const size_t row = wid >> 2;
    const float a = retraw[row * 512 + h * 128 + lane], c = retraw[row * 512 + h * 128 + 64 + lane];
    const float mu = wave_sum(a + c) * (1.0f / 128.0f); const float da = a - mu, dc = c - mu;
    const float var = wave_sum(da * da + dc * dc) * (1.0f / 128.0f); const float r = rsqrtf(var + GN_EPS);
    const float g0 = bf2f(proj[row * NPROJ + C_RG + h * 128 + lane]), g1 = bf2f(proj[row * NPROJ + C_RG + h * 128 + 64 + lane]);
    mix[row * DM + 512 + h * 128 + lane] = f2bf(da * r * gain[h * 128 + lane] * (g0 * sigmoidf_(g0)));
    mix[row * DM + 512 + h * 128 + 64 + lane] = f2bf(dc * r * gain[h * 128 + 64 + lane] * (g1 * sigmoidf_(g1)));
}
__global__ void k_conv_act(const bf16_t* __restrict__ U, bf16_t* __restrict__ act, const float* __restrict__ cw, const float* __restrict__ cb) {
    const size_t n = (size_t)SEQ * FF;
    for (size_t i = (size_t)blockIdx.x * blockDim.x + threadIdx.x; i < n; i += (size_t)gridDim.x * blockDim.x) {
        const int t = (int)(i / FF), c = (int)(i % FF);
        const float u0 = bf2f(U[i]), u1 = t >= 1 ? bf2f(U[i - FF]) : 0.f, u2 = t >= 2 ? bf2f(U[i - 2 * FF]) : 0.f;
        const float y = cb[c] + cw[c] * u2 + cw[FF + c] * u1 + cw[2 * FF + c] * u0;
        act[i] = f2bf(gelu_tanh(y) * bf2f(act[i]));
    }
}

namespace pg8 {
#define PG8_LAS __attribute__((address_space(3)))
typedef unsigned short bf16_t;
typedef short bf16x8 __attribute__((ext_vector_type(8)));
typedef float f32x4 __attribute__((ext_vector_type(4)));
typedef unsigned u32x4 __attribute__((ext_vector_type(4)));
constexpr int BM = 256, BK = 64, HALF = 128, HTB = HALF * BK * 2  , STAGE_BYTES = 8 * HTB, NXCD = 8, WGM = 8;

__host__ __device__ __forceinline__ int lds_byte(int r, int c) { const int st = (r >> 4) * 2 + (c >> 5), rr = r & 15, cc = c & 31, ob = rr * 64 + cc * 2; return st * 1024 + (ob ^ (((ob >> 9) & 1) << 5)); }
__host__ __device__ __forceinline__ void stage_rc(int b, int& R, int& C) { const int st = b / 1024, sb = b % 1024, swz = sb ^ (((sb >> 9) & 1) << 5); R = (st >> 1) * 16 + swz / 64; C = (st & 1) * 32 + (swz % 64) / 2; }
__host__ __device__ __forceinline__ int perm32(int rho) { const int n = rho >> 4, i = rho & 15; return 8 * (i >> 2) + 4 * n + (i & 3); }

struct Unit { int pm, pn; };
struct Gemm { const bf16_t* A; const bf16_t* Bt; int M, N, K; };

struct StaticOrder {
    int nM, nN, nwg, G, c;
    __host__ __device__ void init(int M, int N, int G_, int c_) { nM = M / BM; nN = N / BM; nwg = nM * nN; G = G_; c = c_; }
    __host__ __device__ bool next(int i, Unit& u) const {
        const long L = (long)i * G + c; if (L >= nwg) return false;
        int wgid = (int)L; { const int q = nwg / NXCD, r = nwg % NXCD, xcd = wgid % NXCD, off = wgid / NXCD; wgid = (xcd < r ? xcd * (q + 1) : r * (q + 1) + (xcd - r) * q) + off; }
        const int nig = WGM * nN, gid = wgid / nig, fm = gid * WGM, gsz = (nM - fm) < WGM ? (nM - fm) : WGM;
        u.pm = fm + ((wgid % nig) % gsz); u.pn = (wgid % nig) / gsz; return true;
    }
    __device__ __forceinline__ void a_ready(const Unit&) const {}
    __device__ __forceinline__ void done(const Unit&) const {}
};

__device__ __forceinline__ unsigned cvt_pk_bf16(float lo, float hi) { unsigned r; asm volatile("v_cvt_pk_bf16_f32 %0, %1, %2" : "=v"(r) : "v"(lo), "v"(hi)); return r; }
typedef float f32x2 __attribute__((ext_vector_type(2)));
template <class Epi, class Sched, bool ALIGN_EPI = false, bool SP2 = false>
__device__ __forceinline__ void gemm_phase(PG8_LAS unsigned char* lds, const Gemm g, const Sched& S, const Epi& E) {
    const int tid = threadIdx.x, wid = __builtin_amdgcn_readfirstlane(tid >> 6), lane = tid & 63, wr = wid >> 2, wc = wid & 3, fr = lane & 15, fq = lane >> 4;
    const int K = g.K, nt = K / BK;
    unsigned voffA[2], voffB[2];
#pragma unroll
    for (int i = 0; i < 2; ++i) { int R, C; stage_rc(tid * 16 + i * 8192, R, C); const int Rb = Epi::PERM ? ((R & ~31) + perm32(R & 31)) : R;
        voffA[i] = (unsigned)(R * K + C) * 2u; voffB[i] = (unsigned)(Rb * K + C) * 2u; }
    const size_t kstep = (size_t)(BK * 2);
    const size_t hstep = (size_t)HALF * K * 2;
    const size_t tstep = 2 * hstep;
    const unsigned ldsw = (unsigned)wid * 1024u;
    const int aoff = lds_byte(wr * 64 + fr, fq * 8), boff = lds_byte(wc * 32 + fr, fq * 8);
#define PG8_SA(b, h) (((b) * 2 + (h)) * HTB)
#define PG8_SB(b, h) ((4 + (b) * 2 + (h)) * HTB)
#define PG8_STAGE(bufoff, gbase, voff) do { _Pragma("unroll") for (int _i = 0; _i < 2; ++_i) \
        __builtin_amdgcn_global_load_lds((const unsigned*)((const char*)(gbase) + (voff)[_i]), (PG8_LAS unsigned*)(lds + (bufoff) + ldsw + _i * 8192), 16, 0, 0); } while (0)
#define PG8_LDA(dst, b, h) do { _Pragma("unroll") for (int m = 0; m < 4; ++m) _Pragma("unroll") for (int k = 0; k < 2; ++k) dst[m][k] = *(const PG8_LAS bf16x8*)(lds + PG8_SA(b, h) + aoff + m * 2048 + k * 1024); } while (0)
#define PG8_LDB(dst, b, h) do { _Pragma("unroll") for (int n = 0; n < 2; ++n) _Pragma("unroll") for (int k = 0; k < 2; ++k) dst[n][k] = *(const PG8_LAS bf16x8*)(lds + PG8_SB(b, h) + boff + n * 2048 + k * 1024); } while (0)
#define PG8_MMA(ai, bj, At, Bt) do { __builtin_amdgcn_s_setprio(1); _Pragma("unroll") for (int m = 0; m < 4; ++m) _Pragma("unroll") for (int n = 0; n < 2; ++n) _Pragma("unroll") for (int k = 0; k < 2; ++k) \
        acc[ai][bj][m][n] = __builtin_amdgcn_mfma_f32_16x16x32_bf16(Bt[n][k], At[m][k], acc[ai][bj][m][n], 0, 0, 0); __builtin_amdgcn_s_setprio(0); } while (0)
#define PG8_WAIT_V(n) asm volatile("s_waitcnt vmcnt(" #n ")" ::: "memory")
#define PG8_WAIT_L(n) asm volatile("s_waitcnt lgkmcnt(" #n ")" ::: "memory")
#define PG8_BAR __builtin_amdgcn_s_barrier()
#define PG8_SCHED __builtin_amdgcn_sched_barrier(0)
    Unit cur, nxt; int ui = 0;
    if (!S.next(0, cur)) return;
    f32x4 acc[2][2][4][2];
#pragma unroll
    for (int a = 0; a < 2; ++a)
#pragma unroll
        for (int b = 0; b < 2; ++b)
#pragma unroll
            for (int m = 0; m < 4; ++m)
#pragma unroll
                for (int n = 0; n < 2; ++n) acc[a][b][m][n] = (f32x4){0.f, 0.f, 0.f, 0.f};
    bf16x8 At[4][2], B0[2][2], B1[2][2];
    const char* cA = (const char*)g.A + (size_t)cur.pm * tstep; const char* cB = (const char*)g.Bt + (size_t)cur.pn * tstep;
    S.a_ready(cur);
    if constexpr (SP2) {
        PG8_STAGE(PG8_SB(0, 0), cB, voffB); PG8_STAGE(PG8_SB(0, 1), cB + hstep, voffB); PG8_STAGE(PG8_SA(0, 0), cA, voffA); PG8_STAGE(PG8_SA(0, 1), cA + hstep, voffA);
        if (wr == 1) PG8_BAR;
        PG8_WAIT_V(2); PG8_BAR;
        PG8_STAGE(PG8_SB(1, 0), cB + kstep, voffB); PG8_STAGE(PG8_SA(1, 0), cA + kstep, voffA); PG8_STAGE(PG8_SB(1, 1), cB + hstep + kstep, voffB);
        PG8_WAIT_V(6); PG8_BAR;
    } else {
        PG8_STAGE(PG8_SB(0, 0), cB, voffB); PG8_STAGE(PG8_SA(0, 0), cA, voffA); PG8_STAGE(PG8_SB(0, 1), cB + hstep, voffB); PG8_STAGE(PG8_SA(0, 1), cA + hstep, voffA);
        if (wr == 1) PG8_BAR;
        PG8_WAIT_V(4); PG8_BAR;
        PG8_STAGE(PG8_SB(1, 0), cB + kstep, voffB); PG8_STAGE(PG8_SA(1, 0), cA + kstep, voffA); PG8_STAGE(PG8_SB(1, 1), cB + hstep + kstep, voffB);
        PG8_WAIT_V(6); PG8_BAR;
    }
    for (;;) {
        const bool has_next = S.next(ui + 1, nxt);
        const char* nA = has_next ? (const char*)g.A + (size_t)nxt.pm * tstep : cA; const char* nB = has_next ? (const char*)g.Bt + (size_t)nxt.pn * tstep : cB;
        for (int t = 0; t < nt; t += 2) {
            const bool last = (t == nt - 2);
            const char* a1 = cA + (size_t)(t + 1) * kstep;
            const char* a2 = last ? nA : cA + (size_t)(t + 2) * kstep; const char* b2 = last ? nB : cB + (size_t)(t + 2) * kstep;
            const char* a3 = a2 + kstep; const char* b3 = b2 + kstep;
            if (last && has_next) S.a_ready(nxt);
            if constexpr (SP2) {
            PG8_LDB(B0, 0, 0); PG8_LDB(B1, 0, 1); PG8_SCHED; PG8_LDA(At, 0, 0); PG8_STAGE(PG8_SA(1, 1), a1 + hstep, voffA);
            PG8_WAIT_V(8); PG8_WAIT_L(0); PG8_BAR; PG8_MMA(0, 0, At, B0); PG8_MMA(0, 1, At, B1); PG8_BAR; PG8_SCHED;
            PG8_LDA(At, 0, 1); PG8_STAGE(PG8_SB(0, 0), b2, voffB); PG8_STAGE(PG8_SB(0, 1), b2 + hstep, voffB); PG8_STAGE(PG8_SA(0, 0), a2, voffA);
            PG8_WAIT_V(8); PG8_WAIT_L(0); PG8_BAR; PG8_MMA(1, 0, At, B0); PG8_MMA(1, 1, At, B1); PG8_BAR; PG8_SCHED;
            PG8_LDB(B0, 1, 0); PG8_LDB(B1, 1, 1); PG8_SCHED; PG8_LDA(At, 1, 0); PG8_STAGE(PG8_SA(0, 1), a2 + hstep, voffA);
            PG8_WAIT_V(8); PG8_WAIT_L(0); PG8_BAR; PG8_MMA(0, 0, At, B0); PG8_MMA(0, 1, At, B1); PG8_BAR; PG8_SCHED;
            PG8_LDA(At, 1, 1); PG8_STAGE(PG8_SB(1, 0), b3, voffB); PG8_STAGE(PG8_SB(1, 1), b3 + hstep, voffB); PG8_STAGE(PG8_SA(1, 0), a3, voffA);
            PG8_WAIT_V(8); PG8_WAIT_L(0); PG8_BAR; PG8_MMA(1, 0, At, B0); PG8_MMA(1, 1, At, B1); PG8_BAR; PG8_SCHED;
            } else {
            PG8_LDB(B0, 0, 0); PG8_SCHED; PG8_LDA(At, 0, 0); PG8_STAGE(PG8_SA(1, 1), a1 + hstep, voffA);
            PG8_WAIT_L(8); PG8_BAR; PG8_WAIT_L(0); PG8_MMA(0, 0, At, B0); PG8_BAR; PG8_SCHED;
            PG8_LDB(B1, 0, 1); PG8_STAGE(PG8_SB(0, 0), b2, voffB);
            PG8_BAR; PG8_WAIT_L(0); PG8_MMA(0, 1, At, B1); PG8_BAR;
            PG8_LDA(At, 0, 1); PG8_STAGE(PG8_SA(0, 0), a2, voffA);
            PG8_BAR; PG8_WAIT_L(0); PG8_MMA(1, 0, At, B0); PG8_BAR; PG8_SCHED;
            PG8_STAGE(PG8_SB(0, 1), b2 + hstep, voffB);
            PG8_WAIT_V(6); PG8_BAR; PG8_MMA(1, 1, At, B1); PG8_BAR;
            PG8_LDB(B0, 1, 0); PG8_SCHED; PG8_LDA(At, 1, 0); PG8_STAGE(PG8_SA(0, 1), a2 + hstep, voffA);
            PG8_WAIT_L(8); PG8_BAR; PG8_WAIT_L(0); PG8_MMA(0, 0, At, B0); PG8_BAR; PG8_SCHED;
            PG8_LDB(B1, 1, 1); PG8_STAGE(PG8_SB(1, 0), b3, voffB);
            PG8_BAR; PG8_WAIT_L(0); PG8_MMA(0, 1, At, B1); PG8_BAR;
            PG8_LDA(At, 1, 1); PG8_STAGE(PG8_SA(1, 0), a3, voffA);
            PG8_BAR; PG8_WAIT_L(0); PG8_MMA(1, 0, At, B0); PG8_BAR; PG8_SCHED;
            PG8_STAGE(PG8_SB(1, 1), b3 + hstep, voffB);
            PG8_WAIT_V(6); PG8_BAR; PG8_MMA(1, 1, At, B1); PG8_BAR;
            }
        }
        if constexpr (ALIGN_EPI) { if (wr == 0) PG8_BAR; }
        if constexpr (!Epi::AFTER_DRAIN) { E(acc, cur, wr, wc, fr, fq); S.done(cur); }
        if (!has_next) break;
#pragma unroll
        for (int a = 0; a < 2; ++a)
#pragma unroll
            for (int b = 0; b < 2; ++b)
#pragma unroll
                for (int m = 0; m < 4; ++m)
#pragma unroll
                    for (int n = 0; n < 2; ++n) acc[a][b][m][n] = (f32x4){0.f, 0.f, 0.f, 0.f};
        cur = nxt; cA = nA; cB = nB; ++ui;
        if constexpr (ALIGN_EPI) { if (wr == 1) PG8_BAR; }
    }
    PG8_WAIT_V(0);
    if constexpr (!ALIGN_EPI) { if (wr == 0) PG8_BAR; }
    PG8_BAR;
    if constexpr (Epi::AFTER_DRAIN) { E.fused(acc, cur, wr, wc, fr, fq, lds, wid, lane); S.done(cur); }
#undef PG8_SA
#undef PG8_SB
#undef PG8_STAGE
#undef PG8_LDA
#undef PG8_LDB
#undef PG8_MMA
#undef PG8_WAIT_V
#undef PG8_WAIT_L
#undef PG8_BAR
#undef PG8_SCHED
}
}
namespace pg8 {
__device__ __forceinline__ u32x4 pack8(f32x4 v0, f32x4 v1) { u32x4 w; w.x = cvt_pk_bf16(v0[0], v0[1]); w.y = cvt_pk_bf16(v0[2], v0[3]); w.z = cvt_pk_bf16(v1[0], v1[1]); w.w = cvt_pk_bf16(v1[2], v1[3]); return w; }
__device__ __forceinline__ float dot4(f32x4 a) { return (a[0] * a[0] + a[1] * a[1]) + (a[2] * a[2] + a[3] * a[3]); }
__device__ __forceinline__ float rs16(const float* p) { const f32x4 a = *(const f32x4*)p, b = *(const f32x4*)(p + 4), c = *(const f32x4*)(p + 8), d = *(const f32x4*)(p + 12);
    const float s = ((a[0] + a[1]) + (a[2] + a[3])) + ((b[0] + b[1]) + (b[2] + b[3])) + ((c[0] + c[1]) + (c[2] + c[3])) + ((d[0] + d[1]) + (d[2] + d[3])); return rsqrtf(s * (1.0f / DM) + RMS_EPS); }

__device__ __forceinline__ float frcp(float x) { return __builtin_amdgcn_rcpf(x); }
__device__ __forceinline__ float fsigmoid(float x) { return frcp(1.0f + __builtin_amdgcn_exp2f(-1.4426950408889634f * x)); }
__device__ __forceinline__ float gelu_fast(float x) { const float z2 = 2.302208198f * (x + 0.044715f * x * x * x); return x * frcp(1.0f + __builtin_amdgcn_exp2f(-z2)); }
__device__ __forceinline__ void rs8(const float* rsq, int row0, int fq, float (&rs)[2][4]) {
    f32x4 pv[2][4];
#pragma unroll
    for (int ai = 0; ai < 2; ++ai)
#pragma unroll
        for (int m = 0; m < 4; ++m) pv[ai][m] = *(const f32x4*)(rsq + (size_t)(row0 + ai * HALF + m * 16) * 16 + 4 * fq);
#pragma unroll
    for (int ai = 0; ai < 2; ++ai)
#pragma unroll
        for (int m = 0; m < 4; ++m) { float s = (pv[ai][m][0] + pv[ai][m][1]) + (pv[ai][m][2] + pv[ai][m][3]); s += __shfl_xor(s, 16); s += __shfl_xor(s, 32); rs[ai][m] = rsqrtf(s * (1.0f / DM) + RMS_EPS); }
}
#define DPP_MOV(old, src, ctrl) __uint_as_float((unsigned)__builtin_amdgcn_update_dpp((int)__float_as_uint(old), (int)__float_as_uint(src), (ctrl), 0xF, 0xF, false))

struct EpiProj {
    static constexpr bool PERM = true, AFTER_DRAIN = false;
    bf16_t* O; float* kmsum;
    __device__ __forceinline__ void operator()(const f32x4 (&acc)[2][2][4][2], const Unit& u, int wr, int wc, int fr, int fq) const {
        const int colt = u.pn * BM;
        const float sc = colt < C_MK ? QSCALE : ((colt >= C_RK && colt < C_RV) ? RKSCALE : 1.0f);
        const int row0 = u.pm * BM + wr * 64 + fr, col0 = colt + wc * 32 + 8 * fq;
#pragma unroll
        for (int ai = 0; ai < 2; ++ai)
#pragma unroll
            for (int m = 0; m < 4; ++m) { bf16_t* rowp = O + (size_t)(row0 + ai * HALF + m * 16) * NPROJ + col0;
#pragma unroll
                for (int bj = 0; bj < 2; ++bj) *(u32x4*)(rowp + bj * HALF) = pack8(acc[ai][bj][m][0] * sc, acc[ai][bj][m][1] * sc); }
        if (colt >= C_MK && colt < C_MV) {
            const int bh0 = (u.pm >> 6) * 8, blk = u.pm & 63;
#pragma unroll
            for (int bj = 0; bj < 2; ++bj)
#pragma unroll
                for (int n = 0; n < 2; ++n)
#pragma unroll
                    for (int j = 0; j < 4; ++j) { float s = 0.f;
#pragma unroll
                        for (int ai = 0; ai < 2; ++ai)
#pragma unroll
                            for (int m = 0; m < 4; ++m) s += acc[ai][bj][m][n][j];
                        s += __shfl_xor(s, 1); s += __shfl_xor(s, 2); s += __shfl_xor(s, 4); s += __shfl_xor(s, 8);
                        if (fr == 0) { const int c = colt - C_MK + bj * HALF + wc * 32 + 8 * fq + 4 * n + j; atomicAdd(kmsum + ((size_t)(bh0 + (c >> 6)) * 64 + blk) * 64 + (c & 63), s); } }
        }
    }
};
struct EpiStore {
    static constexpr bool PERM = true, AFTER_DRAIN = false;
    bf16_t* O;
    __device__ __forceinline__ void operator()(const f32x4 (&acc)[2][2][4][2], const Unit& u, int wr, int wc, int fr, int fq) const {
        const int row0 = u.pm * BM + wr * 64 + fr, col0 = u.pn * BM + wc * 32 + 8 * fq;
#pragma unroll
        for (int ai = 0; ai < 2; ++ai)
#pragma unroll
            for (int m = 0; m < 4; ++m) { bf16_t* rowp = O + (size_t)(row0 + ai * HALF + m * 16) * DM + col0;
#pragma unroll
                for (int bj = 0; bj < 2; ++bj) *(u32x4*)(rowp + bj * HALF) = pack8(acc[ai][bj][m][0], acc[ai][bj][m][1]); }
    }
};
template <bool BF> struct EpiRes {
    static constexpr bool PERM = true, AFTER_DRAIN = false;
    const float* base; bf16_t* xb; float* rsq;
    __device__ __forceinline__ void operator()(const f32x4 (&acc)[2][2][4][2], const Unit& u, int wr, int wc, int fr, int fq) const {
        const int row0 = u.pm * BM + wr * 64 + fr, col0 = u.pn * BM + wc * 32 + 8 * fq;
#pragma unroll
        for (int ai = 0; ai < 2; ++ai)
#pragma unroll
            for (int m = 0; m < 4; ++m) { const int row = row0 + ai * HALF + m * 16; float ss = 0.f;
#pragma unroll
                for (int bj = 0; bj < 2; ++bj) { const size_t off = (size_t)row * DM + col0 + bj * HALF;
                    f32x4 b0, b1;
                    if (BF) { const u32x4 pv = *(const u32x4*)(xb + off);
                        b0 = (f32x4){__uint_as_float(pv.x << 16), __uint_as_float(pv.x & 0xffff0000u), __uint_as_float(pv.y << 16), __uint_as_float(pv.y & 0xffff0000u)};
                        b1 = (f32x4){__uint_as_float(pv.z << 16), __uint_as_float(pv.z & 0xffff0000u), __uint_as_float(pv.w << 16), __uint_as_float(pv.w & 0xffff0000u)}; }
                    else { b0 = *(const f32x4*)(base + off); b1 = *(const f32x4*)(base + off + 4); }
                    const f32x4 y0 = b0 + acc[ai][bj][m][0], y1 = b1 + acc[ai][bj][m][1];
                    *(u32x4*)(xb + off) = pack8(y0, y1); ss += dot4(y0) + dot4(y1); }
                ss += __shfl_xor(ss, 16); ss += __shfl_xor(ss, 32);
                if (fq == 0) rsq[(size_t)row * 16 + u.pn * 4 + wc] = ss; }
    }
};
struct EpiPleNorm {
    static constexpr bool PERM = true, AFTER_DRAIN = false;
    float* out; const bf16_t* xb; const bf16_t* pw; const float* rsq_in; float* rsq_out; unsigned* pcnt; const float* fnorm;
    __device__ __forceinline__ void operator()(const f32x4 (&acc_)[2][2][4][2], const Unit& u, int wr, int wc, int fr, int fq) const {
        f32x4 (&acc)[2][2][4][2] = const_cast<f32x4 (&)[2][2][4][2]>(acc_);
        const int row0 = u.pm * BM + wr * 64 + fr, col0 = u.pn * BM + wc * 32 + 8 * fq;
        float rsv[2][4]; rs8(rsq_in, row0, fq, rsv);
#pragma unroll
        for (int ai = 0; ai < 2; ++ai)
#pragma unroll
            for (int m = 0; m < 4; ++m) { const int row = row0 + ai * HALF + m * 16; const float rs = rsv[ai][m]; float ss = 0.f;
#pragma unroll
                for (int bj = 0; bj < 2; ++bj) { const size_t off = (size_t)row * DM + col0 + bj * HALF;
                    const u32x4 pv = *(const u32x4*)(pw + off);
                    const f32x4 p0 = {__uint_as_float(pv.x << 16), __uint_as_float(pv.x & 0xffff0000u), __uint_as_float(pv.y << 16), __uint_as_float(pv.y & 0xffff0000u)};
                    const f32x4 p1 = {__uint_as_float(pv.z << 16), __uint_as_float(pv.z & 0xffff0000u), __uint_as_float(pv.w << 16), __uint_as_float(pv.w & 0xffff0000u)};
                    f32x4 g0 = acc[ai][bj][m][0] * rs, g1 = acc[ai][bj][m][1] * rs;
#pragma unroll
                    for (int j = 0; j < 4; ++j) { g0[j] = fsigmoid(g0[j]); g1[j] = fsigmoid(g1[j]); }
                    const u32x4 xv = *(const u32x4*)(xb + off);
                    const f32x4 x0 = {__uint_as_float(xv.x << 16), __uint_as_float(xv.x & 0xffff0000u), __uint_as_float(xv.y << 16), __uint_as_float(xv.y & 0xffff0000u)};
                    const f32x4 x1 = {__uint_as_float(xv.z << 16), __uint_as_float(xv.z & 0xffff0000u), __uint_as_float(xv.w << 16), __uint_as_float(xv.w & 0xffff0000u)};
                    const f32x4 y0 = x0 + p0 * g0, y1 = x1 + p1 * g1;
                    acc[ai][bj][m][0] = y0; acc[ai][bj][m][1] = y1; ss += dot4(y0) + dot4(y1); }
                ss += __shfl_xor(ss, 16); ss += __shfl_xor(ss, 32);
                if (fq == 0) __hip_atomic_store((unsigned*)(rsq_out + (size_t)row * 16 + u.pn * 4 + wc), __float_as_uint(ss), __ATOMIC_RELAXED, __HIP_MEMORY_SCOPE_AGENT);
                asm volatile("" ::: "memory"); }
        asm volatile("s_waitcnt vmcnt(0)" ::: "memory");
        unsigned* pc = pcnt + 16 * u.pm;
        if (fq == 0 && fr == 0) __hip_atomic_fetch_add(pc, 1u, __ATOMIC_RELAXED, __HIP_MEMORY_SCOPE_AGENT);
        for (unsigned spins = 0; spins < (1u << 22); ++spins) {
            if ((unsigned)__builtin_amdgcn_readfirstlane(__hip_atomic_load(pc, __ATOMIC_RELAXED, __HIP_MEMORY_SCOPE_AGENT)) >= 32u) break;
            __builtin_amdgcn_s_sleep(2);
        }
        f32x4 fn[2][2];
#pragma unroll
        for (int bj = 0; bj < 2; ++bj) { fn[bj][0] = *(const f32x4*)(fnorm + col0 + bj * HALF); fn[bj][1] = *(const f32x4*)(fnorm + col0 + bj * HALF + 4); }
#pragma unroll
        for (int ai = 0; ai < 2; ++ai)
#pragma unroll
            for (int m = 0; m < 4; ++m) { const int row = row0 + ai * HALF + m * 16;
                const unsigned long long* pp = (const unsigned long long*)(rsq_out + (size_t)row * 16 + 4 * fq);
                const unsigned long long a = __hip_atomic_load(pp, __ATOMIC_RELAXED, __HIP_MEMORY_SCOPE_AGENT), b = __hip_atomic_load(pp + 1, __ATOMIC_RELAXED, __HIP_MEMORY_SCOPE_AGENT);
                float s = (__uint_as_float((unsigned)a) + __uint_as_float((unsigned)(a >> 32))) + (__uint_as_float((unsigned)b) + __uint_as_float((unsigned)(b >> 32)));
                s += __shfl_xor(s, 16); s += __shfl_xor(s, 32);
                const float rs3 = rsqrtf(s * (1.0f / DM) + RMS_EPS);
#pragma unroll
                for (int bj = 0; bj < 2; ++bj) { const size_t off = (size_t)row * DM + col0 + bj * HALF;
                    *(f32x4*)(out + off) = acc[ai][bj][m][0] * rs3 * fn[bj][0]; *(f32x4*)(out + off + 4) = acc[ai][bj][m][1] * rs3 * fn[bj][1]; }
            }
    }
};
struct EpiUG {
    static constexpr bool PERM = true, AFTER_DRAIN = false;
    bf16_t* act; const float* rsq; const float* cw; const float* cb; float* UL; float* UF; float* GF;
    __device__ __forceinline__ void operator()(const f32x4 (&acc)[2][2][4][2], const Unit& u, int wr, int wc, int fr, int fq) const {
        const int cu = u.pn * HALF + wc * 32 + 8 * fq;
        const int row0 = u.pm * BM + wr * 64 + fr;
        float rsv[2][4]; rs8(rsq, row0, fq, rsv);
        float w0[8], w1[8], w2[8], bb[8];
#pragma unroll
        for (int q = 0; q < 2; ++q) { const f32x4 a = *(const f32x4*)(cw + cu + 4 * q), b = *(const f32x4*)(cw + FF + cu + 4 * q), c = *(const f32x4*)(cw + 2 * FF + cu + 4 * q), d = *(const f32x4*)(cb + cu + 4 * q);
#pragma unroll
            for (int j = 0; j < 4; ++j) { w0[4 * q + j] = a[j]; w1[4 * q + j] = b[j]; w2[4 * q + j] = c[j]; bb[4 * q + j] = d[j]; } }
#pragma unroll
        for (int ai = 0; ai < 2; ++ai) {
            float up[8];
#pragma unroll
            for (int m = 0; m < 4; ++m) {
                const int row = row0 + ai * HALF + m * 16;
                const float rs = rsv[ai][m];
                float uu[8], gg[8], a8[8];
#pragma unroll
                for (int n = 0; n < 2; ++n)
#pragma unroll
                    for (int j = 0; j < 4; ++j) { uu[4 * n + j] = acc[ai][0][m][n][j] * rs; gg[4 * n + j] = acc[ai][1][m][n][j] * rs; }
#pragma unroll
                for (int k = 0; k < 8; ++k) {
                    float t1 = 0.f, t2 = 0.f;
                    if (m > 0) { t1 = DPP_MOV(0.f, up[k], 0x121); t2 = DPP_MOV(0.f, up[k], 0x122); }
                    const float u1 = DPP_MOV(t1, uu[k], 0x111), u2 = DPP_MOV(t2, uu[k], 0x112);
                    const float y = bb[k] + w0[k] * u2 + w1[k] * u1 + w2[k] * uu[k];
                    a8[k] = gelu_fast(y) * gg[k];
                }
                const bool defer = (m == 0) && (fr < 2);
                if (!defer) { u32x4 w; w.x = cvt_pk_bf16(a8[0], a8[1]); w.y = cvt_pk_bf16(a8[2], a8[3]); w.z = cvt_pk_bf16(a8[4], a8[5]); w.w = cvt_pk_bf16(a8[6], a8[7]);
                    *(u32x4*)(act + (size_t)row * FF + cu) = w; }
                else { const size_t so = ((size_t)(row >> 6) * 2 + fr) * FF + cu;
                    *(f32x4*)(UF + so) = (f32x4){uu[0], uu[1], uu[2], uu[3]}; *(f32x4*)(UF + so + 4) = (f32x4){uu[4], uu[5], uu[6], uu[7]};
                    *(f32x4*)(GF + so) = (f32x4){gg[0], gg[1], gg[2], gg[3]}; *(f32x4*)(GF + so + 4) = (f32x4){gg[4], gg[5], gg[6], gg[7]}; }
                if (m == 3 && fr >= 14) { const size_t so = ((size_t)(row >> 6) * 2 + (fr - 14)) * FF + cu;
                    *(f32x4*)(UL + so) = (f32x4){uu[0], uu[1], uu[2], uu[3]}; *(f32x4*)(UL + so + 4) = (f32x4){uu[4], uu[5], uu[6], uu[7]}; }
#pragma unroll
                for (int k = 0; k < 8; ++k) up[k] = uu[k];
            }
        }
    }
};
}
#define LAS __attribute__((address_space(3)))
namespace mx {
typedef short bf16x8 __attribute__((ext_vector_type(8)));
typedef short s16x4 __attribute__((ext_vector_type(4)));
typedef float f32x16 __attribute__((ext_vector_type(16)));
typedef unsigned u32x4 __attribute__((ext_vector_type(4)));
typedef float f32x4_t __attribute__((ext_vector_type(4)));
typedef LAS const char* lds_cptr;
typedef LAS char* lds_ptr;
__device__ __forceinline__ int crow(int r, int hi) { return (r & 3) + 8 * (r >> 2) + 4 * hi; }
__device__ __forceinline__ s16x4 vtr(lds_cptr p) { return __builtin_bit_cast(s16x4, __builtin_amdgcn_ds_read_tr16_b64_v4i16((LAS s16x4*)p)); }
__device__ __forceinline__ bf16x8 cat8(s16x4 lo, s16x4 hi) { return (bf16x8){lo[0], lo[1], lo[2], lo[3], hi[0], hi[1], hi[2], hi[3]}; }
__device__ __forceinline__ unsigned pk(float lo, float hi) { return pg8::cvt_pk_bf16(lo, hi); }
__device__ __forceinline__ float other_half(float v) { return __shfl_xor(v, 32); }

constexpr int L_K = 0, L_V = 32768;
constexpr int L_WSF = 65536;
constexpr int L_OST = 65536 + 2048;
constexpr int L_ENT = L_OST + 32768;
constexpr int ENT_CAP = 4096;
constexpr int L_PREF = L_ENT + ENT_CAP * 4;
constexpr int L_END = L_PREF + 512;
static_assert(L_END <= 147456, "mixer LDS map");

__device__ __forceinline__ void moba_stage_kv(const bf16_t* __restrict__ proj, int b, int h, int blk, lds_ptr lds, int tid) {
#pragma unroll
    for (int i = 0; i < 4; ++i) { const int pc = tid + 512 * i, key = pc >> 3, ch = pc & 7;
        const bf16_t* src = proj + (size_t)(b * SEQ + blk * 256 + key) * NPROJ + h * 64 + ch * 8;
        const u32x4 kv = *(const u32x4*)(src + C_MK), vv = *(const u32x4*)(src + C_MV);
        *(LAS u32x4*)(lds + L_K + ch * 4096 + key * 16) = kv;
        *(LAS u32x4*)(lds + L_V + (key >> 6) * 8192 + (ch >> 2) * 4096 + ((key & 63) >> 3) * 512 + (key & 7) * 64 + (ch & 3) * 16) = vv; }
}

__device__ __forceinline__ void moba_batch(const bf16_t* qptr, int qpos, int kbase, float slope2, bool diag, int ntiles, lds_ptr lds, int wave, int lane, bf16_t* odst, float* ldst) {
    const int r32 = lane & 31, hi = lane >> 5;
    bf16x8 qr[4];
#pragma unroll
    for (int d0 = 0; d0 < 4; ++d0) qr[d0] = *(const bf16x8*)(qptr + d0 * 16 + hi * 8);
    f32x16 o0, o1;
#pragma unroll
    for (int r = 0; r < 16; ++r) { o0[r] = 0.f; o1[r] = 0.f; }
    float m = -1e30f, l = 0.f;
    const lds_cptr kp = (lds_cptr)lds + L_K + hi * 4096 + r32 * 16;
    const lds_cptr vp = (lds_cptr)lds + L_V + ((lane >> 4) & 1) * 32 + (lane & 3) * 8 + (4 * hi + ((lane & 15) >> 2)) * 64;
    LAS float* wsf = (LAS float*)(lds + L_WSF) + wave * 64;
    for (int kt = 0; kt < ntiles; ++kt) {
        f32x16 p0, p1;
        const float fb0 = (float)(qpos - kbase - 64 * kt - 4 * hi);
#pragma unroll
        for (int r = 0; r < 16; ++r) { const float c = (float)((r & 3) + 8 * (r >> 2)); const float d0f = fb0 - c, d1f = d0f - 32.0f;
            p0[r] = (diag && d0f < 0.f) ? -1e30f : -slope2 * d0f; p1[r] = (diag && d1f < 0.f) ? -1e30f : -slope2 * d1f; }
#pragma unroll
        for (int d0 = 0; d0 < 4; ++d0) {
            const bf16x8 k0 = *(const LAS bf16x8*)(kp + kt * 1024 + d0 * 8192), k1 = *(const LAS bf16x8*)(kp + kt * 1024 + 512 + d0 * 8192);
            p0 = __builtin_amdgcn_mfma_f32_32x32x16_bf16(k0, qr[d0], p0, 0, 0, 0);
            p1 = __builtin_amdgcn_mfma_f32_32x32x16_bf16(k1, qr[d0], p1, 0, 0, 0);
        }
        float mx_ = p0[0];
#pragma unroll
        for (int r = 1; r < 16; ++r) mx_ = fmaxf(mx_, p0[r]);
#pragma unroll
        for (int r = 0; r < 16; ++r) mx_ = fmaxf(mx_, p1[r]);
        mx_ = fmaxf(mx_, other_half(mx_));
        const float mn = fmaxf(m, mx_);
        const float alpha = __builtin_amdgcn_exp2f(m - mn);
        float rs = 0.f;
#pragma unroll
        for (int r = 0; r < 16; ++r) { p0[r] = __builtin_amdgcn_exp2f(p0[r] - mn); p1[r] = __builtin_amdgcn_exp2f(p1[r] - mn); rs += p0[r] + p1[r]; }
        l = l * alpha + rs; m = mn;
        if (!__all(alpha == 1.0f)) {
            if (hi == 0) wsf[r32] = alpha;
#pragma unroll
            for (int r = 0; r < 16; ++r) { const float f = wsf[crow(r, hi)]; o0[r] *= f; o1[r] *= f; }
        }
        u32x4 pw0 = {pk(p0[0], p0[1]), pk(p0[2], p0[3]), pk(p0[4], p0[5]), pk(p0[6], p0[7])};
        u32x4 pw1 = {pk(p0[8], p0[9]), pk(p0[10], p0[11]), pk(p0[12], p0[13]), pk(p0[14], p0[15])};
        u32x4 pw2 = {pk(p1[0], p1[1]), pk(p1[2], p1[3]), pk(p1[4], p1[5]), pk(p1[6], p1[7])};
        u32x4 pw3 = {pk(p1[8], p1[9]), pk(p1[10], p1[11]), pk(p1[12], p1[13]), pk(p1[14], p1[15])};
        const lds_cptr vt = vp + kt * 8192;
#define MX_PV(O, DB, KS, PW) O = __builtin_amdgcn_mfma_f32_32x32x16_bf16(__builtin_bit_cast(bf16x8, PW), cat8(vtr(vt + (DB) * 4096 + (KS) * 1024), vtr(vt + (DB) * 4096 + (KS) * 1024 + 512)), O, 0, 0, 0)
        MX_PV(o0, 0, 0, pw0); MX_PV(o1, 1, 0, pw0); MX_PV(o0, 0, 1, pw1); MX_PV(o1, 1, 1, pw1);
        MX_PV(o0, 0, 2, pw2); MX_PV(o1, 1, 2, pw2); MX_PV(o0, 0, 3, pw3); MX_PV(o1, 1, 3, pw3);
#undef MX_PV
    }
    l += other_half(l);
    if (hi == 0) wsf[32 + r32] = 1.0f / l;
    const float lse = m + __builtin_amdgcn_logf(l);
    LAS bf16_t* ost = (LAS bf16_t*)(lds + L_OST) + wave * 2048;
#pragma unroll
    for (int r = 0; r < 16; ++r) { const int orow = crow(r, hi); const float f = wsf[32 + orow];
        ost[orow * 64 + r32] = f2bf(o0[r] * f); ost[orow * 64 + 32 + r32] = f2bf(o1[r] * f); }
    const unsigned long long dp = (unsigned long long)odst; const unsigned dlo = (unsigned)dp, dhi = (unsigned)(dp >> 32);
#pragma unroll
    for (int i = 0; i < 4; ++i) { const int row = i * 8 + (lane >> 3), ch = lane & 7;
        const u32x4 v = *(const LAS u32x4*)(ost + row * 64 + ch * 8);
        const unsigned long long d = ((unsigned long long)(unsigned)__shfl((int)dhi, row) << 32) | (unsigned)__shfl((int)dlo, row);
        if (d) *(u32x4*)((bf16_t*)d + ch * 8) = v; }
    if (hi == 0 && ldst) *ldst = lse;
}

__device__ __forceinline__ void moba_diag_unit(const bf16_t* __restrict__ proj, int bh, int i, bf16_t* part_o, float* part_l, lds_ptr lds, int tid) {
    const int b = bh >> 3, h = bh & 7, lane = tid & 63, wave = __builtin_amdgcn_readfirstlane(tid >> 6);
    moba_stage_kv(proj, b, h, i, lds, tid);
    __syncthreads();
    const int ql = wave * 32 + (lane & 31), t = i * 256 + ql; const size_t row = (size_t)b * SEQ + t;
    const float slope2 = __builtin_amdgcn_exp2f(-(float)(h + 1)) * LOG2E;
    moba_batch(proj + row * NPROJ + C_MQ + h * 64, t, i * 256, slope2, true, (wave >> 1) + 1, lds, wave, lane,
               part_o + ((row * 8 + h) * 4 + 3) * 64, part_l + (row * 8 + h) * 4 + 3);
    __syncthreads();
}
__device__ __forceinline__ void moba_sel_task(const bf16_t* __restrict__ proj, const unsigned short* __restrict__ seg, const int* __restrict__ cnt, int bh, int n,
                                              bf16_t* part_o, float* part_l, lds_ptr lds, int tid) {
    const int b = bh >> 3, h = bh & 7, lane = tid & 63, wave = __builtin_amdgcn_readfirstlane(tid >> 6);
    LAS int* pref = (LAS int*)(lds + L_PREF); LAS unsigned* ent = (LAS unsigned*)(lds + L_ENT);
    if (tid < 64) pref[tid + 1] = (tid > n) ? cnt[((size_t)bh * 64 + n) * 64 + tid] : 0;
    moba_stage_kv(proj, b, h, n, lds, tid);
    __syncthreads();
    if (tid == 0) { int s = 0; pref[0] = 0; for (int i = 1; i <= 64; ++i) { s += pref[i]; pref[i] = s; } }
    __syncthreads();
    const int T = pref[64];
    const float slope2 = __builtin_amdgcn_exp2f(-(float)(h + 1)) * LOG2E;
    for (int c0 = 0; c0 < T; c0 += ENT_CAP) {
        const int cn = (T - c0) < ENT_CAP ? (T - c0) : ENT_CAP;
        for (int e = tid; e < cn; e += 512) { const int g = c0 + e; int lo = 0, hi = 63;
            while (lo < hi) { const int mid = (lo + hi + 1) >> 1; if (pref[mid] <= g) lo = mid; else hi = mid - 1; }
            ent[e] = ((unsigned)lo << 10) | (unsigned)seg[(((size_t)bh * 64 + n) * 64 + lo) * 256 + (g - pref[lo])]; }
        __syncthreads();
        for (int wb = wave; wb * 32 < cn; wb += 8) {
            const int idx = wb * 32 + (lane & 31); const bool valid = idx < cn;
            const unsigned en = ent[valid ? idx : wb * 32];
            const int isrc = en >> 10, ql = (en >> 2) & 255, slot = en & 3, t = isrc * 256 + ql; const size_t row = (size_t)b * SEQ + t;
            moba_batch(proj + row * NPROJ + C_MQ + h * 64, t, n * 256, slope2, false, 4, lds, wave, lane,
                       valid ? part_o + ((row * 8 + h) * 4 + slot) * 64 : (bf16_t*)nullptr, valid ? part_l + (row * 8 + h) * 4 + slot : (float*)nullptr);
        }
        __syncthreads();
    }
}

constexpr int G_KMH = 0, G_KML = 8192, G_CNT = 16384;
#define MX_INS(v, n) do { const bool g0_ = (v) > v0, g1_ = (v) > v1, g2_ = (v) > v2; \
    v2 = g1_ ? v1 : (g2_ ? (v) : v2); i2 = g1_ ? i1 : (g2_ ? (n) : i2); v1 = g0_ ? v0 : (g1_ ? (v) : v1); i1 = g0_ ? i0 : (g1_ ? (n) : i1); v0 = g0_ ? (v) : v0; i0 = g0_ ? (n) : i0; } while (0)
__device__ __forceinline__ void gate_task_mfma(int bh, int i, const bf16_t* __restrict__ proj, const float* __restrict__ kmsum, u32* __restrict__ sel,
                                               unsigned short* __restrict__ seg, int* __restrict__ cnt, lds_ptr lds, int tid) {
    const int b = bh >> 3, h = bh & 7, lane = tid & 63, wave = __builtin_amdgcn_readfirstlane(tid >> 6), r32 = lane & 31, hi = lane >> 5;
    { const int n = tid >> 3, ch = tid & 7; const float* src = kmsum + (size_t)bh * 4096 + n * 64 + ch * 8;
      const f32x4_t a = *(const f32x4_t*)src * (1.0f / 256.0f), c = *(const f32x4_t*)(src + 4) * (1.0f / 256.0f);
      float v[8] = {a[0], a[1], a[2], a[3], c[0], c[1], c[2], c[3]}; float hf[8], lf[8];
#pragma unroll
      for (int k = 0; k < 8; ++k) { hf[k] = bf2f(f2bf(v[k])); lf[k] = v[k] - hf[k]; }
      const u32x4 H = {pk(hf[0], hf[1]), pk(hf[2], hf[3]), pk(hf[4], hf[5]), pk(hf[6], hf[7])}, Lw = {pk(lf[0], lf[1]), pk(lf[2], lf[3]), pk(lf[4], lf[5]), pk(lf[6], lf[7])};
      *(LAS u32x4*)(lds + G_KMH + ch * 1024 + n * 16) = H; *(LAS u32x4*)(lds + G_KML + ch * 1024 + n * 16) = Lw; }
    LAS int* cntL = (LAS int*)(lds + G_CNT);
    if (tid < 64) cntL[tid] = 0;
    __syncthreads();
    const int ql = wave * 32 + r32, t = i * 256 + ql; const size_t row = (size_t)b * SEQ + t;
    const bf16_t* qp = proj + row * NPROJ + C_MQ + h * 64 + hi * 8;
    f32x16 p0, p1;
#pragma unroll
    for (int r = 0; r < 16; ++r) { p0[r] = 0.f; p1[r] = 0.f; }
#pragma unroll
    for (int ks = 0; ks < 4; ++ks) {
        const bf16x8 q = *(const bf16x8*)(qp + ks * 16);
        const lds_cptr kb = (lds_cptr)lds + (2 * ks + hi) * 1024 + r32 * 16;
        p0 = __builtin_amdgcn_mfma_f32_32x32x16_bf16(*(const LAS bf16x8*)(kb + G_KMH), q, p0, 0, 0, 0);
        p0 = __builtin_amdgcn_mfma_f32_32x32x16_bf16(*(const LAS bf16x8*)(kb + G_KML), q, p0, 0, 0, 0);
        p1 = __builtin_amdgcn_mfma_f32_32x32x16_bf16(*(const LAS bf16x8*)(kb + G_KMH + 512), q, p1, 0, 0, 0);
        p1 = __builtin_amdgcn_mfma_f32_32x32x16_bf16(*(const LAS bf16x8*)(kb + G_KML + 512), q, p1, 0, 0, 0);
    }
    float v0 = -INFINITY, v1 = -INFINITY, v2 = -INFINITY; int i0 = 0, i1 = 0, i2 = 0;
#pragma unroll
    for (int r = 0; r < 16; ++r) { const int n = crow(r, hi); const float v = n < i ? p0[r] : -INFINITY; MX_INS(v, n); }
#pragma unroll
    for (int r = 0; r < 16; ++r) { const int n = 32 + crow(r, hi); const float v = n < i ? p1[r] : -INFINITY; MX_INS(v, n); }
    { const float a0 = __shfl_xor(v0, 32), a1 = __shfl_xor(v1, 32), a2 = __shfl_xor(v2, 32); const int j0 = __shfl_xor(i0, 32), j1 = __shfl_xor(i1, 32), j2 = __shfl_xor(i2, 32);
      MX_INS(a0, j0); MX_INS(a1, j1); MX_INS(a2, j2); }
    if (hi == 0) {
        const int nv = i < 3 ? i : 3;
        sel[row * 8 + h] = (u32)i0 | ((u32)i1 << 8) | ((u32)i2 << 16) | ((u32)nv << 24);
#pragma unroll
        for (int s = 0; s < 3; ++s) if (s < nv) { const int n = s == 0 ? i0 : (s == 1 ? i1 : i2);
            const int pos = atomicAdd((int*)&cntL[n], 1);
            seg[(((size_t)bh * 64 + n) * 64 + i) * 256 + pos] = (unsigned short)((ql << 2) | s); }
    }
    __syncthreads();
    if (tid < i) cnt[((size_t)bh * 64 + tid) * 64 + i] = cntL[tid];
    __syncthreads();
}
#undef MX_INS

#define MX_INS(v, n) do { const bool g0_ = (v) > v0, g1_ = (v) > v1, g2_ = (v) > v2; \
    v2 = g1_ ? v1 : (g2_ ? (v) : v2); i2 = g1_ ? i1 : (g2_ ? (n) : i2); v1 = g0_ ? v0 : (g1_ ? (v) : v1); i1 = g0_ ? i0 : (g1_ ? (n) : i1); v0 = g0_ ? (v) : v0; i0 = g0_ ? (n) : i0; } while (0)
__device__ __forceinline__ void gate_unit(int bh, int i, int w8, const bf16_t* __restrict__ proj, const float* __restrict__ kmsum, u32* __restrict__ sel,
                                          unsigned short* __restrict__ seg, int* __restrict__ cnt, int lane) {
    const int b = bh >> 3, h = bh & 7, r32 = lane & 31, hi = lane >> 5;
    const int ql = w8 * 32 + r32, t = i * 256 + ql; const size_t row = (size_t)b * SEQ + t;
    const bf16_t* qp = proj + row * NPROJ + C_MQ + h * 64 + hi * 8;
    bf16x8 q[4];
#pragma unroll
    for (int ks = 0; ks < 4; ++ks) q[ks] = *(const bf16x8*)(qp + ks * 16);
    f32x16 p0, p1;
#pragma unroll
    for (int r = 0; r < 16; ++r) { p0[r] = 0.f; p1[r] = 0.f; }
    const float* kb = kmsum + (size_t)bh * 4096 + r32 * 64 + hi * 8;
#pragma unroll
    for (int nt = 0; nt < 2; ++nt) {
        if (nt == 1 && i <= 32) break;
#pragma unroll
        for (int ks = 0; ks < 4; ++ks) {
            const f32x4_t a = *(const f32x4_t*)(kb + nt * 2048 + ks * 16) * (1.0f / 256.0f), c = *(const f32x4_t*)(kb + nt * 2048 + ks * 16 + 4) * (1.0f / 256.0f);
            const float v[8] = {a[0], a[1], a[2], a[3], c[0], c[1], c[2], c[3]}; float hf[8], lf[8];
#pragma unroll
            for (int k = 0; k < 8; ++k) { hf[k] = bf2f(f2bf(v[k])); lf[k] = v[k] - hf[k]; }
            const u32x4 H = {pk(hf[0], hf[1]), pk(hf[2], hf[3]), pk(hf[4], hf[5]), pk(hf[6], hf[7])}, Lw = {pk(lf[0], lf[1]), pk(lf[2], lf[3]), pk(lf[4], lf[5]), pk(lf[6], lf[7])};
            if (nt == 0) { p0 = __builtin_amdgcn_mfma_f32_32x32x16_bf16(__builtin_bit_cast(bf16x8, H), q[ks], p0, 0, 0, 0); p0 = __builtin_amdgcn_mfma_f32_32x32x16_bf16(__builtin_bit_cast(bf16x8, Lw), q[ks], p0, 0, 0, 0); }
            else { p1 = __builtin_amdgcn_mfma_f32_32x32x16_bf16(__builtin_bit_cast(bf16x8, H), q[ks], p1, 0, 0, 0); p1 = __builtin_amdgcn_mfma_f32_32x32x16_bf16(__builtin_bit_cast(bf16x8, Lw), q[ks], p1, 0, 0, 0); }
        }
    }
    float v0 = -INFINITY, v1 = -INFINITY, v2 = -INFINITY; int i0 = 0, i1 = 0, i2 = 0;
#pragma unroll
    for (int r = 0; r < 16; ++r) { const int n = crow(r, hi); const float v = n < i ? p0[r] : -INFINITY; MX_INS(v, n); }
#pragma unroll
    for (int r = 0; r < 16; ++r) { const int n = 32 + crow(r, hi); const float v = n < i ? p1[r] : -INFINITY; MX_INS(v, n); }
    { const float a0 = __shfl_xor(v0, 32), a1 = __shfl_xor(v1, 32), a2 = __shfl_xor(v2, 32); const int j0 = __shfl_xor(i0, 32), j1 = __shfl_xor(i1, 32), j2 = __shfl_xor(i2, 32);
      MX_INS(a0, j0); MX_INS(a1, j1); MX_INS(a2, j2); }
    if (hi == 0) {
        const int nv = i < 3 ? i : 3;
        sel[row * 8 + h] = (u32)i0 | ((u32)i1 << 8) | ((u32)i2 << 16) | ((u32)nv << 24);
#pragma unroll
        for (int s = 0; s < 3; ++s) if (s < nv) { const int n = s == 0 ? i0 : (s == 1 ? i1 : i2);
            const int pos = atomicAdd(cnt + ((size_t)bh * 64 + n) * 64 + i, 1);
            seg[(((size_t)bh * 64 + n) * 64 + i) * 256 + pos] = (unsigned short)((ql << 2) | s); }
    }
}
#undef MX_INS
__device__ __forceinline__ void moba_combine(const bf16_t* __restrict__ part_o, const float* __restrict__ part_l, const u32* __restrict__ sel, bf16_t* __restrict__ mix, size_t gt, size_t GT) {
    for (size_t i = gt; i < (size_t)MT * 64; i += GT) {
        const int ch = (int)(i & 7), h = (int)((i >> 3) & 7); const size_t row = i >> 6;
        const int nv = sel[row * 8 + h] >> 24;
        const f32x4_t lv = *(const f32x4_t*)(part_l + (row * 8 + h) * 4);
        float w[4]; w[0] = nv > 0 ? lv[0] : -1e30f; w[1] = nv > 1 ? lv[1] : -1e30f; w[2] = nv > 2 ? lv[2] : -1e30f; w[3] = lv[3];
        const float mm = fmaxf(fmaxf(w[0], w[1]), fmaxf(w[2], w[3]));
        float acc[8] = {0.f, 0.f, 0.f, 0.f, 0.f, 0.f, 0.f, 0.f}; float ws = 0.f;
#pragma unroll
        for (int s = 0; s < 4; ++s) { const bool ok = s == 3 || s < nv; const float ww = ok ? __builtin_amdgcn_exp2f(w[s] - mm) : 0.f; ws += ww;
            if (ok) { const u32x4 v = *(const u32x4*)(part_o + ((row * 8 + h) * 4 + s) * 64 + ch * 8);
                acc[0] += ww * __uint_as_float(v.x << 16); acc[1] += ww * __uint_as_float(v.x & 0xffff0000u); acc[2] += ww * __uint_as_float(v.y << 16); acc[3] += ww * __uint_as_float(v.y & 0xffff0000u);
                acc[4] += ww * __uint_as_float(v.z << 16); acc[5] += ww * __uint_as_float(v.z & 0xffff0000u); acc[6] += ww * __uint_as_float(v.w << 16); acc[7] += ww * __uint_as_float(v.w & 0xffff0000u); } }
        const float iw = 1.0f / ws;
        u32x4 o; o.x = pk(acc[0] * iw, acc[1] * iw); o.y = pk(acc[2] * iw, acc[3] * iw); o.z = pk(acc[4] * iw, acc[5] * iw); o.w = pk(acc[6] * iw, acc[7] * iw);
        *(u32x4*)(mix + row * DM + h * 64 + ch * 8) = o;
    }
}

constexpr int R_IMG = 65536;
__device__ __forceinline__ int rimg_off(int t, int c) { return (c >> 5) * 16384 + (t >> 3) * 512 + (t & 7) * 64 + (c & 31) * 2; }
__device__ __forceinline__ void ret_stage(const bf16_t* __restrict__ proj, int b, int t0, int col0, lds_ptr img, int tid, bool kdecay, float log2g) {
#pragma unroll
    for (int i = 0; i < 8; ++i) { const int pc = tid + 512 * i, t = pc >> 4, ch = pc & 15;
        u32x4 v = *(const u32x4*)(proj + (size_t)(b * SEQ + t0 + t) * NPROJ + col0 + ch * 8);
        if (kdecay) { const float f = __builtin_amdgcn_exp2f((float)(255 - t) * log2g);
            v.x = pk(__uint_as_float(v.x << 16) * f, __uint_as_float(v.x & 0xffff0000u) * f); v.y = pk(__uint_as_float(v.y << 16) * f, __uint_as_float(v.y & 0xffff0000u) * f);
            v.z = pk(__uint_as_float(v.z << 16) * f, __uint_as_float(v.z & 0xffff0000u) * f); v.w = pk(__uint_as_float(v.w << 16) * f, __uint_as_float(v.w & 0xffff0000u) * f); }
        *(LAS u32x4*)(img + rimg_off(t, ch * 8)) = v; }
}
__device__ __forceinline__ void ret_kv_task(const bf16_t* __restrict__ proj, int bh, int c, float* __restrict__ kvt, lds_ptr lds, int tid) {
    const int b = bh >> 2, h = bh & 3, lane = tid & 63, wave = __builtin_amdgcn_readfirstlane(tid >> 6), r32 = lane & 31, hi = lane >> 5;
    const float log2g = __builtin_amdgcn_logf(1.0f - __builtin_amdgcn_exp2f(-5.0f - (float)h));
    ret_stage(proj, b, c * 256, C_RV + h * 128, lds, tid, false, 0.f);
    ret_stage(proj, b, c * 256, C_RK + h * 128, lds + R_IMG, tid, true, log2g);
    __syncthreads();
    const int et = wave >> 1, dt0 = (wave & 1) * 2;
    const int lbase = hi * 512 + ((lane & 15) >> 2) * 64 + ((lane >> 4) & 1) * 32 + (lane & 3) * 8;
    const lds_cptr va = (lds_cptr)lds + et * 16384 + lbase, kb0 = (lds_cptr)lds + R_IMG + dt0 * 16384 + lbase, kb1 = kb0 + 16384;
    f32x16 a0, a1;
#pragma unroll
    for (int r = 0; r < 16; ++r) { a0[r] = 0.f; a1[r] = 0.f; }
#pragma unroll 4
    for (int ks = 0; ks < 16; ++ks) {
        const bf16x8 vf = cat8(vtr(va + ks * 1024), vtr(va + ks * 1024 + 256));
        const bf16x8 k0 = cat8(vtr(kb0 + ks * 1024), vtr(kb0 + ks * 1024 + 256)), k1 = cat8(vtr(kb1 + ks * 1024), vtr(kb1 + ks * 1024 + 256));
        a0 = __builtin_amdgcn_mfma_f32_32x32x16_bf16(vf, k0, a0, 0, 0, 0);
        a1 = __builtin_amdgcn_mfma_f32_32x32x16_bf16(vf, k1, a1, 0, 0, 0);
    }
    float* dst = kvt + ((size_t)(bh * 64 + c) * 128) * 128;
#pragma unroll
    for (int r = 0; r < 16; ++r) { const int e = et * 32 + crow(r, hi);
        dst[(size_t)e * 128 + dt0 * 32 + r32] = a0[r]; dst[(size_t)e * 128 + dt0 * 32 + 32 + r32] = a1[r]; }
    __syncthreads();
}
__device__ __forceinline__ void ret_scan(const float* __restrict__ kvt, bf16_t* __restrict__ stt, size_t gt, size_t GT) {
    for (size_t i = gt; i < (size_t)8 * 16384; i += GT) {
        const int bh = (int)(i >> 14), ed = (int)(i & 16383), h = bh & 3;
        const float g256 = __builtin_amdgcn_exp2f(256.0f * __builtin_amdgcn_logf(1.0f - __builtin_amdgcn_exp2f(-5.0f - (float)h)));
        float s = 0.f;
#pragma unroll 8
        for (int c = 0; c < 64; ++c) { const size_t o = ((size_t)(bh * 64 + c) << 14) + ed; stt[o] = f2bf(s); s = s * g256 + kvt[o]; }
    }
}
constexpr int RO_A = 0, RO_V = 65536, RO_ST = 131072;
__device__ __forceinline__ void ret_out_task(const bf16_t* __restrict__ proj, const bf16_t* __restrict__ stt, const float* __restrict__ gain, bf16_t* __restrict__ mix, int bh, int c, lds_ptr lds, int tid) {
    const int b = bh >> 2, h = bh & 3, lane = tid & 63, wave = __builtin_amdgcn_readfirstlane(tid >> 6), r32 = lane & 31, hi = lane >> 5;
    const float log2g = __builtin_amdgcn_logf(1.0f - __builtin_amdgcn_exp2f(-5.0f - (float)h));
    const size_t row0 = (size_t)b * SEQ + c * 256;
    u32x4 sreg[4], vreg[8], kreg[8];
    { const bf16_t* sp = stt + ((size_t)(bh * 64 + c) << 14);
#pragma unroll
      for (int i = 0; i < 4; ++i) sreg[i] = *(const u32x4*)(sp + (size_t)(tid + 512 * i) * 8); }
#pragma unroll
    for (int i = 0; i < 8; ++i) { const int pc = tid + 512 * i, t = pc >> 4, ch = pc & 15; const bf16_t* src = proj + (row0 + t) * NPROJ + h * 128 + ch * 8;
        vreg[i] = *(const u32x4*)(src + C_RV); kreg[i] = *(const u32x4*)(src + C_RK); }
    bf16x8 qf[8];
    { const bf16_t* qp = proj + (row0 + wave * 32 + r32) * NPROJ + C_RQ + h * 128 + hi * 8;
#pragma unroll
      for (int ks = 0; ks < 8; ++ks) qf[ks] = *(const bf16x8*)(qp + ks * 16); }
#pragma unroll
    for (int i = 0; i < 4; ++i) { const int pc = tid + 512 * i, e = pc >> 4, ch = pc & 15; *(LAS u32x4*)(lds + RO_A + ch * 2048 + e * 16) = sreg[i]; }
#pragma unroll
    for (int i = 0; i < 8; ++i) { const int pc = tid + 512 * i, t = pc >> 4, ch = pc & 15; *(LAS u32x4*)(lds + RO_V + rimg_off(t, ch * 8)) = vreg[i]; }
    __syncthreads();
    f32x16 o[4];
#pragma unroll
    for (int et = 0; et < 4; ++et)
#pragma unroll
        for (int r = 0; r < 16; ++r) o[et][r] = 0.f;
    { const lds_cptr sb = (lds_cptr)lds + RO_A + hi * 2048 + r32 * 16;
#pragma unroll
      for (int et = 0; et < 4; ++et)
#pragma unroll
          for (int ks = 0; ks < 8; ++ks) o[et] = __builtin_amdgcn_mfma_f32_32x32x16_bf16(qf[ks], *(const LAS bf16x8*)(sb + ks * 4096 + et * 512), o[et], 0, 0, 0); }
#pragma unroll
    for (int r = 0; r < 16; ++r) { const float f = __builtin_amdgcn_exp2f((float)(wave * 32 + crow(r, hi) + 1) * log2g);
#pragma unroll
        for (int et = 0; et < 4; ++et) o[et][r] *= f; }
    __syncthreads();
#pragma unroll
    for (int i = 0; i < 8; ++i) { const int pc = tid + 512 * i, t = pc >> 4, ch = pc & 15; *(LAS u32x4*)(lds + RO_A + ch * 4096 + t * 16) = kreg[i]; }
    __syncthreads();
    u32x4 rgv[8];
#pragma unroll
    for (int g = 0; g < 4; ++g)
#pragma unroll
        for (int k = 0; k < 2; ++k) { const int pidx = lane + 64 * k; rgv[2 * g + k] = *(const u32x4*)(proj + (row0 + wave * 32 + 8 * g + (pidx >> 4)) * NPROJ + C_RG + h * 128 + (pidx & 15) * 8); }
    const lds_cptr vp = (lds_cptr)lds + RO_V + ((lane >> 4) & 1) * 32 + (lane & 3) * 8 + (4 * hi + ((lane & 15) >> 2)) * 64;
    const lds_cptr kpb = (lds_cptr)lds + RO_A + hi * 4096 + r32 * 16;
    for (int kvt = 0; kvt <= wave; ++kvt) {
        f32x16 p;
#pragma unroll
        for (int r = 0; r < 16; ++r) p[r] = 0.f;
#pragma unroll
        for (int ks = 0; ks < 8; ++ks) p = __builtin_amdgcn_mfma_f32_32x32x16_bf16(*(const LAS bf16x8*)(kpb + ks * 8192 + kvt * 512), qf[ks], p, 0, 0, 0);
        const int dbase = 32 * (wave - kvt) + r32 - 4 * hi;
#pragma unroll
        for (int r = 0; r < 16; ++r) { const int dist = dbase - ((r & 3) + 8 * (r >> 2)); p[r] = dist >= 0 ? p[r] * __builtin_amdgcn_exp2f((float)dist * log2g) : 0.f; }
        const u32x4 pw0 = {pk(p[0], p[1]), pk(p[2], p[3]), pk(p[4], p[5]), pk(p[6], p[7])}, pw1 = {pk(p[8], p[9]), pk(p[10], p[11]), pk(p[12], p[13]), pk(p[14], p[15])};
        const lds_cptr vt = vp + kvt * 2048;
#pragma unroll
        for (int et = 0; et < 4; ++et) {
            o[et] = __builtin_amdgcn_mfma_f32_32x32x16_bf16(__builtin_bit_cast(bf16x8, pw0), cat8(vtr(vt + et * 16384), vtr(vt + et * 16384 + 512)), o[et], 0, 0, 0);
            o[et] = __builtin_amdgcn_mfma_f32_32x32x16_bf16(__builtin_bit_cast(bf16x8, pw1), cat8(vtr(vt + et * 16384 + 1024), vtr(vt + et * 16384 + 1536)), o[et], 0, 0, 0);
        }
    }
    float mu[16], rstd[16];
#pragma unroll
    for (int r = 0; r < 16; ++r) {
        float s = (o[0][r] + o[1][r]) + (o[2][r] + o[3][r]);
        s += __shfl_xor(s, 1); s += __shfl_xor(s, 2); s += __shfl_xor(s, 4); s += __shfl_xor(s, 8); s += __shfl_xor(s, 16);
        mu[r] = s * (1.0f / 128.0f);
        const float d0 = o[0][r] - mu[r], d1 = o[1][r] - mu[r], d2 = o[2][r] - mu[r], d3 = o[3][r] - mu[r];
        float q = (d0 * d0 + d1 * d1) + (d2 * d2 + d3 * d3);
        q += __shfl_xor(q, 1); q += __shfl_xor(q, 2); q += __shfl_xor(q, 4); q += __shfl_xor(q, 8); q += __shfl_xor(q, 16);
        rstd[r] = rsqrtf(q * (1.0f / 128.0f) + GN_EPS);
    }
    float gn[4];
#pragma unroll
    for (int et = 0; et < 4; ++et) gn[et] = gain[h * 128 + et * 32 + r32];
    LAS bf16_t* st = (LAS bf16_t*)(lds + RO_ST) + wave * 1024;
#pragma unroll
    for (int g = 0; g < 4; ++g) {
#pragma unroll
        for (int rr = 0; rr < 4; ++rr) { const int r = 4 * g + rr;
#pragma unroll
            for (int et = 0; et < 4; ++et) st[(rr + 4 * hi) * 128 + et * 32 + r32] = f2bf((o[et][r] - mu[r]) * rstd[r] * gn[et]); }
#pragma unroll
        for (int k = 0; k < 2; ++k) { const int pidx = lane + 64 * k, r8 = pidx >> 4, ch = pidx & 15; const size_t row = row0 + wave * 32 + 8 * g + r8;
            const u32x4 nv = *(const LAS u32x4*)(st + r8 * 128 + ch * 8); const u32x4 gv = rgv[2 * g + k];
            const unsigned nw[4] = {nv.x, nv.y, nv.z, nv.w}, gw_[4] = {gv.x, gv.y, gv.z, gv.w}; unsigned ow[4];
#pragma unroll
            for (int q = 0; q < 4; ++q) { const float g0 = __uint_as_float(gw_[q] << 16), g1 = __uint_as_float(gw_[q] & 0xffff0000u);
                ow[q] = pk(__uint_as_float(nw[q] << 16) * (g0 / (1.0f + __expf(-g0))), __uint_as_float(nw[q] & 0xffff0000u) * (g1 / (1.0f + __expf(-g1)))); }
            *(u32x4*)(mix + row * DM + 512 + h * 128 + ch * 8) = (u32x4){ow[0], ow[1], ow[2], ow[3]}; }
    }
    __syncthreads();
}
}
#ifndef REP_MASK
#define REP_MASK 0
#endif
#ifndef REP_SUB
#define REP_SUB 2
#endif
#include <hip/hip_cooperative_groups.h>
namespace cg = cooperative_groups;
constexpr int NWAVES = 8, NTHREADS = 512;
constexpr int LDS_BYTES = 147456 + 256;
constexpr int NPH = 10;
constexpr size_t WS_STASH = 180 * MiB;
constexpr size_t STASH_ELEMS = (size_t)512 * 2 * FF;

struct Args { const float* in[16]; float* out; unsigned char* ws; int ph_lo, ph_hi, flags, pad; };

__device__ __forceinline__ void p0_transpose_item(const float* __restrict__ W, int K, int N, const float* __restrict__ gk, bf16_t* __restrict__ WT, int k0, int n0, int orow0, LAS float* scr, int lane) {
    { float4 v[8];
#pragma unroll
      for (int i = 0; i < 8; ++i) v[i] = *(const float4*)(W + (size_t)(k0 + 8 * i + (lane >> 3)) * N + n0 + (lane & 7) * 4);
#pragma unroll
      for (int i = 0; i < 8; ++i) { const int kk = 8 * i + (lane >> 3); const float g = gk ? gk[k0 + kk] : 1.0f; LAS float* d = scr + kk * 33 + (lane & 7) * 4;
          d[0] = v[i].x * g; d[1] = v[i].y * g; d[2] = v[i].z * g; d[3] = v[i].w * g; } }
    asm volatile("s_waitcnt lgkmcnt(0)" ::: "memory");
    const int c = lane & 7;
#pragma unroll
    for (int j = 0; j < 4; ++j) { const int n = (lane >> 3) + 8 * j; const LAS float* s = scr + (8 * c) * 33 + n;
        uint4 o; o.x = (u32)f2bf(s[0 * 33]) | ((u32)f2bf(s[1 * 33]) << 16); o.y = (u32)f2bf(s[2 * 33]) | ((u32)f2bf(s[3 * 33]) << 16);
        o.z = (u32)f2bf(s[4 * 33]) | ((u32)f2bf(s[5 * 33]) << 16); o.w = (u32)f2bf(s[6 * 33]) | ((u32)f2bf(s[7 * 33]) << 16);
        *(uint4*)(WT + (size_t)(orow0 + n) * K + k0 + 8 * c) = o; }
    asm volatile("s_waitcnt lgkmcnt(0)" ::: "memory");
}

#define XB_TMO      128
#define XB_XCNT(j)  (256  + 64 * (j))
#define XB_XSUB(j)  (1280 + 64 * (j))
#define XB_XGEN(j)  (2304 + 64 * (j))
#define XB_TOP      3328
#define XB_TOPGEN   3392
#define XCD_BAR_WORDS 3456
#define XB_SPIN_CAP (1u << 18)

__device__ __forceinline__ unsigned xb_ld(unsigned* p)              { return __hip_atomic_load(p, __ATOMIC_RELAXED, __HIP_MEMORY_SCOPE_AGENT); }
__device__ __forceinline__ unsigned xb_add(unsigned* p, unsigned v) { return __hip_atomic_fetch_add(p, v, __ATOMIC_RELAXED, __HIP_MEMORY_SCOPE_AGENT); }
__device__ __forceinline__ unsigned xb_xcc_id() { return (unsigned)__builtin_amdgcn_s_getreg((3 << 11) | 20) & 0xFu; }
#define XB_SPIN(cond, bar) do { unsigned _sp = 0; while (cond) { __builtin_amdgcn_s_sleep(1); \
    if ((++_sp & 255u) == 0u) { if (xb_ld(&(bar)[XB_TMO])) break; if (_sp > XB_SPIN_CAP) { atomicAdd(&(bar)[XB_TMO], 1u); break; } } } } while (0)

struct XcdBarrier {
    unsigned* bar; unsigned x;
    volatile LAS unsigned* st;
};

__device__ __forceinline__ XcdBarrier xcd_barrier_post(unsigned* bar, volatile LAS unsigned* st) {
    XcdBarrier b; b.bar = bar; b.x = xb_xcc_id(); b.st = st;
    if (threadIdx.x == 0) (void)xb_add(&bar[XB_XCNT(b.x)], 1u);
    return b;
}
__device__ __forceinline__ void xcd_barrier_complete(unsigned* bar, unsigned x, unsigned& nloc, unsigned& nx) {
    const unsigned G = gridDim.x * gridDim.y * gridDim.z;
    unsigned sum, cnt, mine, sp = 0u;
    for (;;) {
        sum = 0u; cnt = 0u; mine = 0u;
#pragma unroll
        for (unsigned j = 0; j < 16; ++j) { const unsigned c = xb_ld(&bar[XB_XCNT(j)]); sum += c; cnt += (c > 0u) ? 1u : 0u; mine = (j == x) ? c : mine; }
        if (sum == G) break;
        __builtin_amdgcn_s_sleep(1);
        if ((++sp & 255u) == 0u) { if (xb_ld(&bar[XB_TMO])) break; if (sp > XB_SPIN_CAP) { atomicAdd(&bar[XB_TMO], 1u); break; } }
    }
    nloc = mine > 0u ? mine : 1u; nx = cnt > 0u ? cnt : 1u;
}

__device__ __forceinline__ void xcd_barrier(const XcdBarrier& b) {
    asm volatile("s_waitcnt vmcnt(0)" ::: "memory");
    __syncthreads();
    if (threadIdx.x == 0) {
        unsigned* bar = b.bar;
        __builtin_amdgcn_s_waitcnt(0);
        unsigned nloc = b.st[0], nx = b.st[1];
        if (nloc == 0u) { xcd_barrier_complete(bar, b.x, nloc, nx); b.st[0] = nloc; b.st[1] = nx; }
        const unsigned old = xb_add(&bar[XB_XSUB(b.x)], 1u);
        const unsigned gen = old / nloc;
        if (old + 1u == (gen + 1u) * nloc) {
            __builtin_amdgcn_fence(__ATOMIC_RELEASE, "agent");
            asm volatile("s_waitcnt vmcnt(0)" ::: "memory");
            const unsigned og = xb_add(&bar[XB_TOP], 1u);
            const unsigned tg = og / nx;
            if (og + 1u == (tg + 1u) * nx) xb_add(&bar[XB_TOPGEN], 1u);
            else XB_SPIN(xb_ld(&bar[XB_TOPGEN]) == tg, bar);
            __builtin_amdgcn_fence(__ATOMIC_ACQUIRE, "agent");
            xb_add(&bar[XB_XGEN(b.x)], 1u);
            asm volatile("s_waitcnt vmcnt(0)" ::: "memory");
        } else {
            XB_SPIN(xb_ld(&bar[XB_XGEN(b.x)]) == gen, bar);
            __builtin_amdgcn_fence(__ATOMIC_ACQUIRE, "agent");
            asm volatile("s_waitcnt vmcnt(0)" ::: "memory");
        }
    }
    __syncthreads();
}

constexpr int CW_BAR = 4096;
constexpr int LDS_BARST = 147456;
constexpr size_t CTL_ZERO_BYTES = 65536;
constexpr int CW_PANEL = 8192;

#if (REP_MASK >> 2) & 1
#define SUBON2(bit) (rep == 0 || ((REP_SUB >> (bit)) & 1))
#else
#define SUBON2(bit) true
#endif
#if (REP_MASK >> 3) & 1
#define SUBON3(bit) (rep == 0 || ((REP_SUB >> (bit)) & 1))
#else
#define SUBON3(bit) true
#endif
#if (REP_MASK >> 4) & 1
#define SUBON4(bit) (rep == 0 || ((REP_SUB >> (bit)) & 1))
#else
#define SUBON4(bit) true
#endif
__global__ void __launch_bounds__(NTHREADS, 2) mega(Args a) {
    extern __shared__ __attribute__((aligned(16))) unsigned char lds[];
    cg::grid_group grid = cg::this_grid();
    const int tid = threadIdx.x, lane = tid & 63, wave = __builtin_amdgcn_readfirstlane(tid >> 6);
    const int G = gridDim.x, bx = blockIdx.x;
    const int vcu = (G % 8 == 0) ? (bx % 8) * (G / 8) + bx / 8 : bx;
    const int gw = vcu * NWAVES + wave, NGW = G * NWAVES;
    unsigned char* ws = a.ws;
    const float* x = a.in[0]; const float* p = a.in[1]; const float* attn_norm = a.in[2]; const float* w_in = a.in[3]; const float* ret_norm = a.in[4]; const float* w_out = a.in[5];
    const float* ffn_norm = a.in[6]; const float* w_up = a.in[7]; const float* w_gate = a.in[8]; const float* conv_w = a.in[9]; const float* conv_b = a.in[10]; const float* w_down = a.in[11];
    const float* ple_norm = a.in[12]; const float* w_ple = a.in[13]; const float* w_ple_gate = a.in[14]; const float* final_norm = a.in[15];
    float* out = a.out;
    bf16_t* Win_t = (bf16_t*)(ws + WS_WIN); bf16_t* Wout_t = (bf16_t*)(ws + WS_WOUT); bf16_t* Wug_t = (bf16_t*)(ws + WS_WUG); bf16_t* Wdown_t = (bf16_t*)(ws + WS_WDOWN);
    bf16_t* Wpg_t = (bf16_t*)(ws + WS_WPG); bf16_t* Wple_t = (bf16_t*)(ws + WS_WPLE);
    bf16_t* XN = (bf16_t*)(ws + WS_R1); bf16_t* MIX = (bf16_t*)(ws + WS_R1); bf16_t* PW = (bf16_t*)(ws + WS_R1);
    bf16_t* XB = (bf16_t*)(ws + WS_R2);
    bf16_t* PROJ = (bf16_t*)(ws + WS_PROJ); bf16_t* ACT = (bf16_t*)(ws + WS_PROJ);
    bf16_t* PB = (bf16_t*)(ws + WS_PB); float* RSQ = (float*)(ws + WS_RSQ);
    float* KM = (float*)(ws + WS_KMEAN);
    float* UL = (float*)(ws + WS_STASH); float* UF = UL + STASH_ELEMS; float* GF = UF + STASH_ELEMS;
    float* KVT = (float*)(ws + WS_KVT); bf16_t* STT = (bf16_t*)(ws + WS_STT); float* PART_L = (float*)(ws + WS_PARTL); bf16_t* PART_O = (bf16_t*)out;
    u32* SEL = (u32*)(ws + WS_SEL); unsigned short* SEG = (unsigned short*)(ws + WS_SEG); int* CNT = (int*)(ws + WS_CNT);

    const int lo = a.ph_lo, hi = a.ph_hi;
#define IN(k) (lo <= (k) && (k) < hi)
#define SEAM(k) do { if (IN(k) && IN((k) + 1)) { if (a.ph_lo < 0) grid.sync(); else xcd_barrier(xbar); } } while (0)
    { volatile LAS unsigned* st = (volatile LAS unsigned*)((LAS unsigned char*)lds + LDS_BARST); if (tid < 2) st[tid] = 0u; }
    __syncthreads();
    XcdBarrier xbar = xcd_barrier_post((unsigned*)(ws + WS_CTL) + CW_BAR, (volatile LAS unsigned*)((LAS unsigned char*)lds + LDS_BARST));

#if (REP_MASK >> 0) & 1
    for (int rep = 0; rep < 2; ++rep)
#endif
    if (IN(0)) {
        LAS float* scr = (LAS float*)(lds) + wave * (64 * 33);
        constexpr int I_IN = 16 * (NPROJ / 32), I_OUT = 16 * (DM / 32), I_UP = 16 * (FF / 32), I_DOWN = (FF / 64) * (DM / 32), I_PG = 16 * (DM / 32), I_PLE = (PLED / 64) * (DM / 32);
        constexpr int NITEMS = I_IN + I_OUT + 2 * I_UP + I_DOWN + I_PG + I_PLE;
        for (int it = gw; it < NITEMS; it += NGW) {
            int r = it;
            if (r < I_IN) { const int nb = r % (NPROJ / 32), kb = r / (NPROJ / 32); p0_transpose_item(w_in, DM, NPROJ, nullptr, Win_t, kb * 64, nb * 32, nb * 32, scr, lane); continue; } r -= I_IN;
            if (r < I_OUT) { const int nb = r % (DM / 32), kb = r / (DM / 32); p0_transpose_item(w_out, DM, DM, nullptr, Wout_t, kb * 64, nb * 32, nb * 32, scr, lane); continue; } r -= I_OUT;
            if (r < I_UP) { const int nb = r % (FF / 32), kb = r / (FF / 32), n0 = nb * 32; p0_transpose_item(w_up, DM, FF, ffn_norm, Wug_t, kb * 64, n0, (n0 >> 7) * 256 + (n0 & 127), scr, lane); continue; } r -= I_UP;
            if (r < I_UP) { const int nb = r % (FF / 32), kb = r / (FF / 32), n0 = nb * 32; p0_transpose_item(w_gate, DM, FF, ffn_norm, Wug_t, kb * 64, n0, (n0 >> 7) * 256 + 128 + (n0 & 127), scr, lane); continue; } r -= I_UP;
            if (r < I_DOWN) { const int nb = r % (DM / 32), kb = r / (DM / 32); p0_transpose_item(w_down, FF, DM, nullptr, Wdown_t, kb * 64, nb * 32, nb * 32, scr, lane); continue; } r -= I_DOWN;
            if (r < I_PG) { const int nb = r % (DM / 32), kb = r / (DM / 32); p0_transpose_item(w_ple_gate, DM, DM, ple_norm, Wpg_t, kb * 64, nb * 32, nb * 32, scr, lane); continue; } r -= I_PG;
            { const int nb = r % (DM / 32), kb = r / (DM / 32); p0_transpose_item(w_ple, PLED, DM, nullptr, Wple_t, kb * 64, nb * 32, nb * 32, scr, lane); }
        }
        for (int m = gw; m < MT; m += 2 * NGW) {
            const int m2 = m + NGW;
            const float4* xr = (const float4*)(x + (size_t)m * DM); const float4* xr2 = (const float4*)(x + (size_t)m2 * DM); float4 v[4], w[4]; float s = 0.f, s2 = 0.f;
#pragma unroll
            for (int j = 0; j < 4; ++j) { v[j] = xr[lane + 64 * j]; w[j] = xr2[lane + 64 * j]; }
#pragma unroll
            for (int j = 0; j < 4; ++j) { s += v[j].x * v[j].x + v[j].y * v[j].y + v[j].z * v[j].z + v[j].w * v[j].w; s2 += w[j].x * w[j].x + w[j].y * w[j].y + w[j].z * w[j].z + w[j].w * w[j].w; }
            const float rs = rsqrtf(wave_sum(s) * (1.0f / DM) + RMS_EPS), rs2 = rsqrtf(wave_sum(s2) * (1.0f / DM) + RMS_EPS);
#pragma unroll
            for (int j = 0; j < 4; ++j) { const float4 gg = ((const float4*)attn_norm)[lane + 64 * j];
                ushort4 o; o.x = f2bf(v[j].x * rs * gg.x); o.y = f2bf(v[j].y * rs * gg.y); o.z = f2bf(v[j].z * rs * gg.z); o.w = f2bf(v[j].w * rs * gg.w);
                ((ushort4*)(XN + (size_t)m * DM))[lane + 64 * j] = o;
                ushort4 o2; o2.x = f2bf(w[j].x * rs2 * gg.x); o2.y = f2bf(w[j].y * rs2 * gg.y); o2.z = f2bf(w[j].z * rs2 * gg.z); o2.w = f2bf(w[j].w * rs2 * gg.w);
                ((ushort4*)(XN + (size_t)m2 * DM))[lane + 64 * j] = o2; }
        }
        { const size_t n4 = (size_t)MT * PLED / 4; const size_t gt = (size_t)vcu * NTHREADS + tid, GT = (size_t)G * NTHREADS;
          for (size_t i = gt; i < n4; i += GT) { const float4 v = ((const float4*)p)[i]; ushort4 o; o.x = f2bf(v.x); o.y = f2bf(v.y); o.z = f2bf(v.z); o.w = f2bf(v.w); ((ushort4*)PB)[i] = o; }
          for (size_t i = gt; i < 16 * 64 * 64; i += GT) KM[i] = 0.f;
          if (gt < 64) ((int*)(ws + WS_CTL))[gt] = 0;
          for (size_t i = gt; i < 16 * 64 * 64; i += GT) CNT[i] = 0; }
    }
    SEAM(0);
#if (REP_MASK >> 1) & 1
    if (IN(1)) {
        pg8::Gemm g{XN, Win_t, MT, NPROJ, DM}; pg8::StaticOrder S; S.init(MT, NPROJ, G, bx);
        pg8::EpiProj E{PROJ, KM};
        pg8::gemm_phase<pg8::EpiProj, pg8::StaticOrder, true, true>((PG8_LAS unsigned char*)lds, g, S, E);
    }
    asm volatile("" ::: "memory");
#endif
    if (IN(1)) {
        pg8::Gemm g{XN, Win_t, MT, NPROJ, DM}; pg8::StaticOrder S; S.init(MT, NPROJ, G, bx);
        pg8::EpiProj E{PROJ, KM};
        pg8::gemm_phase<pg8::EpiProj, pg8::StaticOrder, true, true>((PG8_LAS unsigned char*)lds, g, S, E);
    }
    SEAM(1);
#if (REP_MASK >> 2) & 1
    for (int rep = 0; rep < 2; ++rep)
#endif
    if (IN(2)) {
        mx::lds_ptr L = (mx::lds_ptr)lds;
        if (!(a.flags & 1) && SUBON2(0)) for (int it = bx; it < 512; it += G) mx::ret_kv_task(PROJ, it >> 6, it & 63, KVT, L, tid);
        if (!(a.flags & 2)) {
            if (SUBON2(1)) for (int it = bx; it < 16 * 63; it += G) mx::gate_task_mfma(it / 63, 1 + it % 63, PROJ, KM, SEL, SEG, CNT, L, tid);
            { const int gtid = vcu * NTHREADS + tid; if (gtid < BATCH * 256 * 8) { const int h = gtid & 7, t = (gtid >> 3) & 255, b = gtid >> 11; SEL[((size_t)b * SEQ + t) * 8 + h] = 0u; } }
            if (SUBON2(2)) for (int it = bx; it < 16 * 64; it += G) mx::moba_diag_unit(PROJ, it >> 6, it & 63, PART_O, PART_L, L, tid);
        }
    }
    SEAM(2);
#if (REP_MASK >> 3) & 1
#define QREP rep
#else
#define QREP 0
#endif
#if (REP_MASK >> 3) & 1
    for (int rep = 0; rep < 2; ++rep)
#endif
    if (IN(3)) {
        mx::lds_ptr L = (mx::lds_ptr)lds;
        if (!(a.flags & 1) && SUBON3(0)) mx::ret_scan(KVT, STT, (size_t)vcu * NTHREADS + tid, (size_t)G * NTHREADS);
        if (!(a.flags & 2) && SUBON3(1)) {
            LAS int* qslot = (LAS int*)(L + mx::L_PREF + 384);
            for (;;) {
                if (tid == 0) *qslot = atomicAdd((int*)(ws + WS_CTL) + QREP, 1);
                __syncthreads();
                const int q = *qslot;
                __syncthreads();
                if (q >= 16 * 63) break;
                mx::moba_sel_task(PROJ, SEG, CNT, q & 15, q >> 4, PART_O, PART_L, L, tid);
            }
        }
    }
    SEAM(3);
#if (REP_MASK >> 4) & 1
    for (int rep = 0; rep < 2; ++rep)
#endif
    if (IN(4)) {
        mx::lds_ptr L = (mx::lds_ptr)lds;
        if (!(a.flags & 1) && SUBON4(0)) for (int it = bx; it < 512; it += G) mx::ret_out_task(PROJ, STT, ret_norm, MIX, it >> 6, it & 63, L, tid);
        if (!(a.flags & 2) && SUBON4(1)) mx::moba_combine(PART_O, PART_L, SEL, MIX, (size_t)vcu * NTHREADS + tid, (size_t)G * NTHREADS);
    }
    SEAM(4);
#if (REP_MASK >> 5) & 1
    if (IN(5)) {
        pg8::Gemm g{MIX, Wout_t, MT, DM, DM}; pg8::StaticOrder S; S.init(MT, DM, G, bx);
        pg8::EpiRes<false> E{x, XB, RSQ};
        pg8::gemm_phase<pg8::EpiRes<false>, pg8::StaticOrder, true, true>((PG8_LAS unsigned char*)lds, g, S, E);
    }
    asm volatile("" ::: "memory");
#endif
    if (IN(5)) {
        pg8::Gemm g{MIX, Wout_t, MT, DM, DM}; pg8::StaticOrder S; S.init(MT, DM, G, bx);
        pg8::EpiRes<false> E{x, XB, RSQ};
        pg8::gemm_phase<pg8::EpiRes<false>, pg8::StaticOrder, true, true>((PG8_LAS unsigned char*)lds, g, S, E);
    }
    SEAM(5);
#if (REP_MASK >> 6) & 1
    if (IN(6)) {
        pg8::Gemm g{XB, Wug_t, MT, 2 * FF, DM}; pg8::StaticOrder S; S.init(MT, 2 * FF, G, bx);
        pg8::EpiUG E{ACT, RSQ, conv_w, conv_b, UL, UF, GF};
        pg8::gemm_phase<pg8::EpiUG, pg8::StaticOrder, true, true>((PG8_LAS unsigned char*)lds, g, S, E);
    }
    asm volatile("" ::: "memory");
#endif
    if (IN(6)) {
        pg8::Gemm g{XB, Wug_t, MT, 2 * FF, DM}; pg8::StaticOrder S; S.init(MT, 2 * FF, G, bx);
        pg8::EpiUG E{ACT, RSQ, conv_w, conv_b, UL, UF, GF};
        pg8::gemm_phase<pg8::EpiUG, pg8::StaticOrder, true, true>((PG8_LAS unsigned char*)lds, g, S, E);
    }
    SEAM(6);
#if (REP_MASK >> 7) & 1
    for (int rep = 0; rep < 2; ++rep)
#endif
    if (IN(7)) {
        const size_t gt = (size_t)vcu * NTHREADS + tid, GT = (size_t)G * NTHREADS;
        for (size_t i = gt; i < (size_t)512 * 2 * FF; i += GT) {
            const int c = (int)(i % FF), r = (int)((i / FF) & 1), g64 = (int)(i / FF / 2);
            float p0 = 0.f, p1 = 0.f;
            if ((g64 & 255) != 0) { p0 = UL[((size_t)(g64 - 1) * 2 + 0) * FF + c]; p1 = UL[((size_t)(g64 - 1) * 2 + 1) * FF + c]; }
            const float f0 = UF[((size_t)g64 * 2 + 0) * FF + c], f1 = UF[((size_t)g64 * 2 + 1) * FF + c];
            const float gg = GF[((size_t)g64 * 2 + r) * FF + c];
            const float u2 = r == 0 ? p0 : p1, u1 = r == 0 ? p1 : f0, u0 = r == 0 ? f0 : f1;
            const float y = conv_b[c] + conv_w[c] * u2 + conv_w[FF + c] * u1 + conv_w[2 * FF + c] * u0;
            ACT[((size_t)g64 * 64 + r) * FF + c] = f2bf(gelu_tanh(y) * gg);
        }
    }
    SEAM(7);
    if (IN(8)) {
        pg8::Gemm g{ACT, Wdown_t, MT, DM, FF}; pg8::StaticOrder S; S.init(MT, DM, G, bx);
        pg8::EpiRes<true> E{nullptr, XB, RSQ + (size_t)MT * 16};
        pg8::gemm_phase<pg8::EpiRes<true>, pg8::StaticOrder, true, true>((PG8_LAS unsigned char*)lds, g, S, E);
    }
    SEAM(8);
    if (IN(9)) {
        { int kk = PLED; asm volatile("" : "+s"(kk)); pg8::Gemm g{PB, Wple_t, MT, DM, kk}; pg8::StaticOrder S; S.init(MT, DM, G, bx); pg8::EpiStore E{PW};
          pg8::gemm_phase<pg8::EpiStore, pg8::StaticOrder, true, true>((PG8_LAS unsigned char*)lds, g, S, E); }
        { int kk = DM; const bf16_t* a_ = XB; const bf16_t* b_ = Wpg_t; asm volatile("" : "+s"(kk), "+s"(a_), "+s"(b_) :: "memory"); pg8::Gemm g{a_, b_, MT, DM, kk}; pg8::StaticOrder S; S.init(MT, DM, G, bx); pg8::EpiPleNorm E{out, XB, PW, RSQ + (size_t)MT * 16, RSQ + (size_t)2 * MT * 16, (unsigned*)(ws + WS_CTL) + CW_PANEL, final_norm};
          pg8::gemm_phase<pg8::EpiPleNorm, pg8::StaticOrder, true, true>((PG8_LAS unsigned char*)lds, g, S, E); }
    }
    SEAM(9);
    if (IN(10)) {
        const float* rsq = RSQ + (size_t)2 * MT * 16;
        for (int m = gw; m < MT; m += NGW) {
            const float rs = pg8::rs16(rsq + (size_t)m * 16); float4* xr = (float4*)(out + (size_t)m * DM);
#pragma unroll
            for (int j = 0; j < 4; ++j) { float4 v = xr[lane + 64 * j]; const float4 gg = ((const float4*)final_norm)[lane + 64 * j];
                v.x *= rs * gg.x; v.y *= rs * gg.y; v.z *= rs * gg.z; v.w *= rs * gg.w; xr[lane + 64 * j] = v; }
        }
    }
#undef IN
#undef SEAM
}

#ifndef BUILD_MODE
#define BUILD_MODE 0
#endif
static int g_grid = 0;
static void launch_mega(Args a, int lo, int hi, hipStream_t stream) {
    a.ph_lo = lo; a.ph_hi = hi; void* args[] = {&a};
    hipError_t e = hipLaunchCooperativeKernel((const void*)mega, dim3(g_grid), dim3(NTHREADS), args, LDS_BYTES, stream);
    if (e != hipSuccess) fprintf(stderr, "cooperative launch [%d,%d) failed: %s (grid %d)\n", lo, hi, hipGetErrorString(e), g_grid);
}
extern "C" void kernel_launch(void* const* d_in, const int* in_sizes, int n_in, void* d_out, int out_size, void* d_ws, size_t ws_size, hipStream_t stream) {
    if (n_in != 16 || out_size != MT * DM || ws_size < WS_END) { fprintf(stderr, "kernel_launch: unexpected shapes (n_in %d out %d ws %zu)\n", n_in, out_size, ws_size); return; }
    if (g_grid == 0) {
        int dev = 0, cus = 0, per_cu = 0;
        hipGetDevice(&dev); hipDeviceGetAttribute(&cus, hipDeviceAttributeMultiprocessorCount, dev);
        hipFuncSetAttribute((const void*)mega, hipFuncAttributeMaxDynamicSharedMemorySize, LDS_BYTES);
        hipOccupancyMaxActiveBlocksPerMultiprocessor(&per_cu, (const void*)mega, NTHREADS, LDS_BYTES);
        if (per_cu < 1) { fprintf(stderr, "occupancy query says %d blocks/CU\n", per_cu); per_cu = 1; }
        g_grid = cus * 1;
        (void)hipGetLastError();
    }
    const float* ret_norm = (const float*)d_in[4];
    unsigned char* ws = (unsigned char*)d_ws;
    bf16_t* MIX = (bf16_t*)(ws + WS_R1); float* RETRAW = (float*)(ws + WS_R2);
    bf16_t* PROJ = (bf16_t*)(ws + WS_PROJ);
    float* KM = (float*)(ws + WS_KMEAN); u32* SEL = (u32*)(ws + WS_SEL); unsigned short* SEG = (unsigned short*)(ws + WS_SEG); int* CNT = (int*)(ws + WS_CNT);
    hipMemsetAsync(ws + WS_CTL, 0, CTL_ZERO_BYTES, stream);
    Args a{}; for (int i = 0; i < 16; ++i) a.in[i] = (const float*)d_in[i]; a.out = (float*)d_out; a.ws = ws;

#if BUILD_MODE == 0
    a.flags = 0; launch_mega(a, 0, NPH, stream);
#elif BUILD_MODE == 1
    a.flags = 1; launch_mega(a, 0, 5, stream);
    k_ret_naive<<<dim3(SEQ / 64, BATCH * RH), 256, 0, stream>>>(PROJ, RETRAW);
    k_ret_post<<<MT * RH / 4, 256, 0, stream>>>(RETRAW, PROJ, ret_norm, MIX);
    launch_mega(a, 5, NPH, stream);
#elif BUILD_MODE == 2
    a.flags = 2; launch_mega(a, 0, 2, stream);
    k_sel_block0<<<BATCH * 256 * 8 / 256, 256, 0, stream>>>(SEL);
    k_gate<<<16 * 63, 512, 0, stream>>>(PROJ, KM, SEL, SEG, CNT);
    k_moba_naive<<<16 * SEQ / 256, 256, 0, stream>>>(PROJ, SEL, MIX);
    launch_mega(a, 2, NPH, stream);
#endif
}
```

```cpp
#include <hip/hip_runtime.h>
#include <stdint.h>
#include <math.h>
#include <cstdio>

typedef unsigned short bf16_t;
typedef unsigned int u32;

constexpr int BATCH = 2, SEQ = 16384, MT = BATCH * SEQ, DM = 1024, NPROJ = 3584, FF = 2816, PLED = 256;
constexpr int MH = 8, MD = 64, RH = 4, RD = 128, NBLK = 64, BLK = 256;
constexpr int C_MQ = 0, C_MK = 512, C_MV = 1024, C_RQ = 1536, C_RK = 2048, C_RV = 2560, C_RG = 3072;
constexpr float RMS_EPS = 1e-6f, GN_EPS = 1e-5f;
constexpr float LOG2E = 1.4426950408889634f;
constexpr float QSCALE = 0.125f * LOG2E;
constexpr float RKSCALE = 0.08838834764831845f;
constexpr size_t SEC = (size_t)MT * 512;

constexpr size_t MiB = (size_t)1 << 20;
constexpr size_t WS_CTL = 0, WS_WIN = 1 * MiB, WS_WOUT = 8 * MiB, WS_WUG = 10 * MiB, WS_WDOWN = 21 * MiB, WS_WPG = 27 * MiB, WS_WPLE = 29 * MiB;
constexpr size_t WS_RSQ = 30 * MiB;
constexpr size_t WS_PB = 36 * MiB;
constexpr size_t WS_R2 = 52 * MiB;
constexpr size_t WS_R1 = 116 * MiB;
constexpr size_t WS_SEG = 180 * MiB;
constexpr size_t WS_KVT = 212 * MiB;
constexpr size_t WS_STT = 244 * MiB;
constexpr size_t WS_PARTL = 260 * MiB;
constexpr size_t WS_SEL = 264 * MiB;
constexpr size_t WS_CNT = 265 * MiB;
constexpr size_t WS_KMEAN = WS_CNT + 512 * 1024;
constexpr size_t WS_PROJ = 266 * MiB;
constexpr size_t WS_END = 490 * MiB;
constexpr size_t WS_UH = 116 * MiB;

__device__ __forceinline__ float bf2f(bf16_t v) { return __uint_as_float(((u32)v) << 16); }
__device__ __forceinline__ bf16_t f2bf(float f) { u32 u = __float_as_uint(f); return (bf16_t)((u + 0x7fffu + ((u >> 16) & 1u)) >> 16); }
__device__ __forceinline__ float wave_sum(float v) {
#pragma unroll
    for (int o = 1; o < 64; o <<= 1) v += __shfl_xor(v, o);
    return v;
}
__device__ __forceinline__ float rs_from(const float* p) {
    float s = 0.f;
#pragma unroll
    for (int i = 0; i < 16; ++i) s += p[i];
    return rsqrtf(s * (1.0f / DM) + RMS_EPS);
}
__device__ __forceinline__ float gelu_tanh(float x) {
    const float z = 0.7978845608028654f * (x + 0.044715f * x * x * x);
    return x / (1.0f + __expf(-2.0f * z));
}
__device__ __forceinline__ float sigmoidf_(float x) { return 1.0f / (1.0f + __expf(-x)); }


typedef unsigned u32x4_g __attribute__((ext_vector_type(4)));
__device__ __forceinline__ void wt_store16(void* base_uniform, size_t byte_off, u32x4_g v) {
    __builtin_amdgcn_raw_buffer_store_b128(v, __builtin_amdgcn_make_buffer_rsrc(base_uniform, 0, 0x7ffffff0, 0x00020000), (int)byte_off, 0, 16);
}

typedef float f32x4_g __attribute__((ext_vector_type(4)));
__device__ __forceinline__ float4 nt_ld4(const void* p) { const f32x4_g v = __builtin_nontemporal_load((const f32x4_g*)p); return make_float4(v[0], v[1], v[2], v[3]); }
namespace pg8 {
#define PG8_LAS __attribute__((address_space(3)))
typedef unsigned short bf16_t;
typedef short bf16x8 __attribute__((ext_vector_type(8)));
typedef float f32x4 __attribute__((ext_vector_type(4)));
typedef unsigned u32x4 __attribute__((ext_vector_type(4)));
constexpr int BM = 256, BK = 64, HALF = 128, HTB = HALF * BK * 2  , STAGE_BYTES = 8 * HTB, NXCD = 8, WGM = 8;

__host__ __device__ __forceinline__ int lds_byte(int r, int c) { const int st = (r >> 4) * 2 + (c >> 5), rr = r & 15, cc = c & 31, ob = rr * 64 + cc * 2; return st * 1024 + (ob ^ (((ob >> 9) & 1) << 5)); }
__host__ __device__ __forceinline__ void stage_rc(int b, int& R, int& C) { const int st = b / 1024, sb = b % 1024, swz = sb ^ (((sb >> 9) & 1) << 5); R = (st >> 1) * 16 + swz / 64; C = (st & 1) * 32 + (swz % 64) / 2; }
__host__ __device__ __forceinline__ int perm32(int rho) { const int n = rho >> 4, i = rho & 15; return 8 * (i >> 2) + 4 * n + (i & 3); }

struct Unit { int pm, pn; };
struct Gemm { const bf16_t* A; const bf16_t* Bt; int M, N, K; };

struct StaticOrder {
    int nM, nN, nwg, G, c;
    __host__ __device__ void init(int M, int N, int G_, int c_) { nM = M / BM; nN = N / BM; nwg = nM * nN; G = G_; c = c_; }
    __host__ __device__ bool next(int i, Unit& u) const {
        const long L = (long)i * G + c; if (L >= nwg) return false;
        int wgid = (int)L; { const int q = nwg / NXCD, r = nwg % NXCD, xcd = wgid % NXCD, off = wgid / NXCD; wgid = (xcd < r ? xcd * (q + 1) : r * (q + 1) + (xcd - r) * q) + off; }
        const int nig = WGM * nN, gid = wgid / nig, fm = gid * WGM, gsz = (nM - fm) < WGM ? (nM - fm) : WGM;
        u.pm = fm + ((wgid % nig) % gsz); u.pn = (wgid % nig) / gsz; return true;
    }
    __device__ __forceinline__ void a_ready(const Unit&) const {}
    __device__ __forceinline__ void done(const Unit&) const {}
};

__device__ __forceinline__ unsigned cvt_pk_bf16(float lo, float hi) { unsigned r; asm volatile("v_cvt_pk_bf16_f32 %0, %1, %2" : "=v"(r) : "v"(lo), "v"(hi)); return r; }
typedef float f32x2 __attribute__((ext_vector_type(2)));
template <class Epi, class Sched, bool ALIGN_EPI = false, bool SP2 = false>
__device__ __forceinline__ void gemm_phase(PG8_LAS unsigned char* lds, const Gemm g, const Sched& S, const Epi& E, const int tid_in) {
    const int tid = tid_in, wid = __builtin_amdgcn_readfirstlane(tid >> 6), lane = tid & 63, wr = wid >> 2, wc = wid & 3, fr = lane & 15, fq = lane >> 4;
    const int K = g.K, nt = K / BK;
    unsigned voffA[2], voffB[2];
#pragma unroll
    for (int i = 0; i < 2; ++i) { int R, C; stage_rc(tid * 16 + i * 8192, R, C); const int Rb = Epi::PERM ? ((R & ~31) + perm32(R & 31)) : R;
        voffA[i] = (unsigned)(R * K + C) * 2u; voffB[i] = (unsigned)(Rb * K + C) * 2u; }
    const size_t kstep = (size_t)(BK * 2);
    const size_t hstep = (size_t)HALF * K * 2;
    const size_t tstep = 2 * hstep;
    const unsigned ldsw = (unsigned)wid * 1024u;
    const int aoff = lds_byte(wr * 64 + fr, fq * 8), boff = lds_byte(wc * 32 + fr, fq * 8);
#define PG8_SA(b, h) (((b) * 2 + (h)) * HTB)
#define PG8_SB(b, h) ((4 + (b) * 2 + (h)) * HTB)
#define PG8_STAGE(bufoff, gbase, voff) do { _Pragma("unroll") for (int _i = 0; _i < 2; ++_i) \
        __builtin_amdgcn_global_load_lds((const unsigned*)((const char*)(gbase) + (voff)[_i]), (PG8_LAS unsigned*)(lds + (bufoff) + ldsw + _i * 8192), 16, 0, 0); } while (0)
#define PG8_LDA(dst, b, h) do { _Pragma("unroll") for (int m = 0; m < 4; ++m) _Pragma("unroll") for (int k = 0; k < 2; ++k) dst[m][k] = *(const PG8_LAS bf16x8*)(lds + PG8_SA(b, h) + aoff + m * 2048 + k * 1024); } while (0)
#define PG8_LDB(dst, b, h) do { _Pragma("unroll") for (int n = 0; n < 2; ++n) _Pragma("unroll") for (int k = 0; k < 2; ++k) dst[n][k] = *(const PG8_LAS bf16x8*)(lds + PG8_SB(b, h) + boff + n * 2048 + k * 1024); } while (0)
#define PG8_MMA(ai, bj, At, Bt) do { __builtin_amdgcn_s_setprio(1); _Pragma("unroll") for (int m = 0; m < 4; ++m) _Pragma("unroll") for (int n = 0; n < 2; ++n) _Pragma("unroll") for (int k = 0; k < 2; ++k) \
        acc[ai][bj][m][n] = __builtin_amdgcn_mfma_f32_16x16x32_bf16(Bt[n][k], At[m][k], acc[ai][bj][m][n], 0, 0, 0); __builtin_amdgcn_s_setprio(0); } while (0)
#define PG8_WAIT_V(n) asm volatile("s_waitcnt vmcnt(" #n ")" ::: "memory")
#define PG8_WAIT_L(n) asm volatile("s_waitcnt lgkmcnt(" #n ")" ::: "memory")
#define PG8_BAR __builtin_amdgcn_s_barrier()
#define PG8_SCHED __builtin_amdgcn_sched_barrier(0)
    Unit cur, nxt; int ui = 0;
    if (!S.next(0, cur)) return;
    f32x4 acc[2][2][4][2];
#pragma unroll
    for (int a = 0; a < 2; ++a)
#pragma unroll
        for (int b = 0; b < 2; ++b)
#pragma unroll
            for (int m = 0; m < 4; ++m)
#pragma unroll
                for (int n = 0; n < 2; ++n) acc[a][b][m][n] = (f32x4){0.f, 0.f, 0.f, 0.f};
    bf16x8 At[4][2], B0[2][2], B1[2][2];
    const char* cA = (const char*)g.A + (size_t)cur.pm * tstep; const char* cB = (const char*)g.Bt + (size_t)cur.pn * tstep;
    S.a_ready(cur);
    if constexpr (SP2) {
        PG8_STAGE(PG8_SB(0, 0), cB, voffB); PG8_STAGE(PG8_SB(0, 1), cB + hstep, voffB); PG8_STAGE(PG8_SA(0, 0), cA, voffA); PG8_STAGE(PG8_SA(0, 1), cA + hstep, voffA);
        if (wr == 1) PG8_BAR;
        PG8_WAIT_V(2); PG8_BAR;
        PG8_STAGE(PG8_SB(1, 0), cB + kstep, voffB); PG8_STAGE(PG8_SA(1, 0), cA + kstep, voffA); PG8_STAGE(PG8_SB(1, 1), cB + hstep + kstep, voffB);
        PG8_WAIT_V(6); PG8_BAR;
    } else {
        PG8_STAGE(PG8_SB(0, 0), cB, voffB); PG8_STAGE(PG8_SA(0, 0), cA, voffA); PG8_STAGE(PG8_SB(0, 1), cB + hstep, voffB); PG8_STAGE(PG8_SA(0, 1), cA + hstep, voffA);
        if (wr == 1) PG8_BAR;
        PG8_WAIT_V(4); PG8_BAR;
        PG8_STAGE(PG8_SB(1, 0), cB + kstep, voffB); PG8_STAGE(PG8_SA(1, 0), cA + kstep, voffA); PG8_STAGE(PG8_SB(1, 1), cB + hstep + kstep, voffB);
        PG8_WAIT_V(6); PG8_BAR;
    }
    for (;;) {
        const bool has_next = S.next(ui + 1, nxt);
        const char* nA = has_next ? (const char*)g.A + (size_t)nxt.pm * tstep : cA; const char* nB = has_next ? (const char*)g.Bt + (size_t)nxt.pn * tstep : cB;
        for (int t = 0; t < nt; t += 2) {
            const bool last = (t == nt - 2);
            const char* a1 = cA + (size_t)(t + 1) * kstep;
            const char* a2 = last ? nA : cA + (size_t)(t + 2) * kstep; const char* b2 = last ? nB : cB + (size_t)(t + 2) * kstep;
            const char* a3 = a2 + kstep; const char* b3 = b2 + kstep;
            if (last && has_next) S.a_ready(nxt);
            if constexpr (SP2) {
            PG8_LDB(B0, 0, 0); PG8_LDB(B1, 0, 1); PG8_SCHED; PG8_LDA(At, 0, 0); PG8_STAGE(PG8_SA(1, 1), a1 + hstep, voffA);
            PG8_WAIT_V(8); PG8_WAIT_L(0); PG8_BAR; PG8_MMA(0, 0, At, B0); PG8_MMA(0, 1, At, B1); PG8_BAR; PG8_SCHED;
            PG8_LDA(At, 0, 1); PG8_STAGE(PG8_SB(0, 0), b2, voffB); PG8_STAGE(PG8_SB(0, 1), b2 + hstep, voffB); PG8_STAGE(PG8_SA(0, 0), a2, voffA);
            PG8_WAIT_V(8); PG8_WAIT_L(0); PG8_BAR; PG8_MMA(1, 0, At, B0); PG8_MMA(1, 1, At, B1); PG8_BAR; PG8_SCHED;
            PG8_LDB(B0, 1, 0); PG8_LDB(B1, 1, 1); PG8_SCHED; PG8_LDA(At, 1, 0); PG8_STAGE(PG8_SA(0, 1), a2 + hstep, voffA);
            PG8_WAIT_V(8); PG8_WAIT_L(0); PG8_BAR; PG8_MMA(0, 0, At, B0); PG8_MMA(0, 1, At, B1); PG8_BAR; PG8_SCHED;
            PG8_LDA(At, 1, 1); PG8_STAGE(PG8_SB(1, 0), b3, voffB); PG8_STAGE(PG8_SB(1, 1), b3 + hstep, voffB); PG8_STAGE(PG8_SA(1, 0), a3, voffA);
            PG8_WAIT_V(8); PG8_WAIT_L(0); PG8_BAR; PG8_MMA(1, 0, At, B0); PG8_MMA(1, 1, At, B1); PG8_BAR; PG8_SCHED;
            } else {
            PG8_LDB(B0, 0, 0); PG8_SCHED; PG8_LDA(At, 0, 0); PG8_STAGE(PG8_SA(1, 1), a1 + hstep, voffA);
            PG8_WAIT_L(8); PG8_BAR; PG8_WAIT_L(0); PG8_MMA(0, 0, At, B0); PG8_BAR; PG8_SCHED;
            PG8_LDB(B1, 0, 1); PG8_STAGE(PG8_SB(0, 0), b2, voffB);
            PG8_BAR; PG8_WAIT_L(0); PG8_MMA(0, 1, At, B1); PG8_BAR;
            PG8_LDA(At, 0, 1); PG8_STAGE(PG8_SA(0, 0), a2, voffA);
            PG8_BAR; PG8_WAIT_L(0); PG8_MMA(1, 0, At, B0); PG8_BAR; PG8_SCHED;
            PG8_STAGE(PG8_SB(0, 1), b2 + hstep, voffB);
            PG8_WAIT_V(6); PG8_BAR; PG8_MMA(1, 1, At, B1); PG8_BAR;
            PG8_LDB(B0, 1, 0); PG8_SCHED; PG8_LDA(At, 1, 0); PG8_STAGE(PG8_SA(0, 1), a2 + hstep, voffA);
            PG8_WAIT_L(8); PG8_BAR; PG8_WAIT_L(0); PG8_MMA(0, 0, At, B0); PG8_BAR; PG8_SCHED;
            PG8_LDB(B1, 1, 1); PG8_STAGE(PG8_SB(1, 0), b3, voffB);
            PG8_BAR; PG8_WAIT_L(0); PG8_MMA(0, 1, At, B1); PG8_BAR;
            PG8_LDA(At, 1, 1); PG8_STAGE(PG8_SA(1, 0), a3, voffA);
            PG8_BAR; PG8_WAIT_L(0); PG8_MMA(1, 0, At, B0); PG8_BAR; PG8_SCHED;
            PG8_STAGE(PG8_SB(1, 1), b3 + hstep, voffB);
            PG8_WAIT_V(6); PG8_BAR; PG8_MMA(1, 1, At, B1); PG8_BAR;
            }
        }
        if constexpr (ALIGN_EPI) { if (wr == 0) PG8_BAR; }
        if constexpr (!Epi::AFTER_DRAIN) { E(acc, cur, wr, wc, fr, fq); S.done(cur); }
        if (!has_next) break;
#pragma unroll
        for (int a = 0; a < 2; ++a)
#pragma unroll
            for (int b = 0; b < 2; ++b)
#pragma unroll
                for (int m = 0; m < 4; ++m)
#pragma unroll
                    for (int n = 0; n < 2; ++n) acc[a][b][m][n] = (f32x4){0.f, 0.f, 0.f, 0.f};
        cur = nxt; cA = nA; cB = nB; ++ui;
        if constexpr (ALIGN_EPI) { if (wr == 1) PG8_BAR; }
    }
    PG8_WAIT_V(0);
    if constexpr (!ALIGN_EPI) { if (wr == 0) PG8_BAR; }
    PG8_BAR;
    if constexpr (Epi::AFTER_DRAIN) { E.fused(acc, cur, wr, wc, fr, fq, lds, wid, lane); S.done(cur); }
#undef PG8_SA
#undef PG8_SB
#undef PG8_STAGE
#undef PG8_LDA
#undef PG8_LDB
#undef PG8_MMA
#undef PG8_WAIT_V
#undef PG8_WAIT_L
#undef PG8_BAR
#undef PG8_SCHED
}
}
namespace pg8 {
__device__ __forceinline__ u32x4 pack8(f32x4 v0, f32x4 v1) { u32x4 w; w.x = cvt_pk_bf16(v0[0], v0[1]); w.y = cvt_pk_bf16(v0[2], v0[3]); w.z = cvt_pk_bf16(v1[0], v1[1]); w.w = cvt_pk_bf16(v1[2], v1[3]); return w; }
__device__ __forceinline__ float dot4(f32x4 a) { return (a[0] * a[0] + a[1] * a[1]) + (a[2] * a[2] + a[3] * a[3]); }
__device__ __forceinline__ float rs16(const float* p) { const f32x4 a = *(const f32x4*)p, b = *(const f32x4*)(p + 4), c = *(const f32x4*)(p + 8), d = *(const f32x4*)(p + 12);
    const float s = ((a[0] + a[1]) + (a[2] + a[3])) + ((b[0] + b[1]) + (b[2] + b[3])) + ((c[0] + c[1]) + (c[2] + c[3])) + ((d[0] + d[1]) + (d[2] + d[3])); return rsqrtf(s * (1.0f / DM) + RMS_EPS); }

__device__ __forceinline__ float frcp(float x) { return __builtin_amdgcn_rcpf(x); }
__device__ __forceinline__ float fsigmoid(float x) { return frcp(1.0f + __builtin_amdgcn_exp2f(-1.4426950408889634f * x)); }
__device__ __forceinline__ float gelu_fast(float x) { const float z2 = 2.302208198f * (x + 0.044715f * x * x * x); return x * frcp(1.0f + __builtin_amdgcn_exp2f(-z2)); }
__device__ __forceinline__ void rs8(const float* rsq, int row0, int fq, float (&rs)[2][4]) {
    f32x4 pv[2][4];
#pragma unroll
    for (int ai = 0; ai < 2; ++ai)
#pragma unroll
        for (int m = 0; m < 4; ++m) pv[ai][m] = *(const f32x4*)(rsq + (size_t)(row0 + ai * HALF + m * 16) * 16 + 4 * fq);
#pragma unroll
    for (int ai = 0; ai < 2; ++ai)
#pragma unroll
        for (int m = 0; m < 4; ++m) { float s = (pv[ai][m][0] + pv[ai][m][1]) + (pv[ai][m][2] + pv[ai][m][3]); s += __shfl_xor(s, 16); s += __shfl_xor(s, 32); rs[ai][m] = rsqrtf(s * (1.0f / DM) + RMS_EPS); }
}
#define DPP_ROT(src, ctrl) __uint_as_float((unsigned)__builtin_amdgcn_mov_dpp((int)__float_as_uint(src), (ctrl), 0xF, 0xF, true))
#define DPP_MOV(old, src, ctrl) __uint_as_float((unsigned)__builtin_amdgcn_update_dpp((int)__float_as_uint(old), (int)__float_as_uint(src), (ctrl), 0xF, 0xF, false))

struct EpiProj {
    static constexpr bool PERM = true, AFTER_DRAIN = false;
    bf16_t* O; float* kmsum;
    __device__ __forceinline__ void operator()(const f32x4 (&acc)[2][2][4][2], const Unit& u, int wr, int wc, int fr, int fq) const {
        const int colt = u.pn * BM;
        const float sc = colt < C_MK ? QSCALE : ((colt >= C_RK && colt < C_RV) ? RKSCALE : 1.0f);
        const int row0 = u.pm * BM + wr * 64 + fr, sec = colt >> 9, b = u.pm >> 6;
        bf16_t* sbase = O + (size_t)sec * SEC;
#pragma unroll
        for (int bj = 0; bj < 2; ++bj) { const int c = (colt & 511) + bj * HALF + wc * 32 + 8 * fq;
            bf16_t* hb = sec < 3 ? sbase + ((size_t)(b * 8 + (c >> 6)) * SEQ) * 64 + (c & 63) : sbase + ((size_t)(b * 4 + (c >> 7)) * SEQ) * 128 + (c & 127);
            const int pitch = sec < 3 ? 64 : 128;
#pragma unroll
            for (int ai = 0; ai < 2; ++ai)
#pragma unroll
                for (int m = 0; m < 4; ++m) { const int t = (row0 + ai * HALF + m * 16) & (SEQ - 1);
                    *(u32x4*)(hb + (size_t)t * pitch) = pack8(acc[ai][bj][m][0] * sc, acc[ai][bj][m][1] * sc); } }
        if (colt >= C_MK && colt < C_MV) {
            const int bh0 = (u.pm >> 6) * 8, blk = u.pm & 63;
#pragma unroll
            for (int bj = 0; bj < 2; ++bj)
#pragma unroll
                for (int n = 0; n < 2; ++n)
#pragma unroll
                    for (int j = 0; j < 4; ++j) { float s = 0.f;
#pragma unroll
                        for (int ai = 0; ai < 2; ++ai)
#pragma unroll
                            for (int m = 0; m < 4; ++m) s += acc[ai][bj][m][n][j];
                        s += __shfl_xor(s, 1); s += __shfl_xor(s, 2); s += __shfl_xor(s, 4); s += __shfl_xor(s, 8);
                        if (fr == 0) { const int c = colt - C_MK + bj * HALF + wc * 32 + 8 * fq + 4 * n + j; atomicAdd(kmsum + ((size_t)(bh0 + (c >> 6)) * 64 + blk) * 64 + (c & 63), s); } }
        }
    }
};
struct EpiStore {
    static constexpr bool PERM = true, AFTER_DRAIN = false;
    bf16_t* O;
    __device__ __forceinline__ void operator()(const f32x4 (&acc)[2][2][4][2], const Unit& u, int wr, int wc, int fr, int fq) const {
        const int row0 = u.pm * BM + wr * 64 + fr, col0 = u.pn * BM + wc * 32 + 8 * fq;
#pragma unroll
        for (int ai = 0; ai < 2; ++ai)
#pragma unroll
            for (int m = 0; m < 4; ++m) { bf16_t* rowp = O + (size_t)(row0 + ai * HALF + m * 16) * DM + col0;
#pragma unroll
                for (int bj = 0; bj < 2; ++bj) *(u32x4*)(rowp + bj * HALF) = pack8(acc[ai][bj][m][0], acc[ai][bj][m][1]); }
    }
};
template <bool BF, bool WR = true> struct EpiRes {
    static constexpr bool PERM = true, AFTER_DRAIN = false;
    const float* base; bf16_t* xb; float* rsq;
    __device__ __forceinline__ void operator()(const f32x4 (&acc)[2][2][4][2], const Unit& u, int wr, int wc, int fr, int fq) const {
        const int row0 = u.pm * BM + wr * 64 + fr, col0 = u.pn * BM + wc * 32 + 8 * fq;
        if constexpr (BF) {
            u32x4 pv[8][2];
#define ERB_LOAD(g) do { _Pragma("unroll") for (int bj = 0; bj < 2; ++bj) pv[g][bj] = *(const u32x4*)(xb + (size_t)(row0 + ((g) >> 2) * HALF + ((g) & 3) * 16) * DM + col0 + bj * HALF); } while (0)
            ERB_LOAD(0); ERB_LOAD(1); ERB_LOAD(2); ERB_LOAD(3);
#pragma unroll
            for (int g = 0; g < 8; ++g) { const int ai = g >> 2, m = g & 3, row = row0 + ai * HALF + m * 16; float ss = 0.f;
                if (g + 4 < 8) { ERB_LOAD(g + 4); }
                asm volatile("" ::: "memory");
#pragma unroll
                for (int bj = 0; bj < 2; ++bj) { const size_t off = (size_t)row * DM + col0 + bj * HALF; const u32x4 p = pv[g][bj];
                    const f32x4 b0 = {__uint_as_float(p.x << 16), __uint_as_float(p.x & 0xffff0000u), __uint_as_float(p.y << 16), __uint_as_float(p.y & 0xffff0000u)};
                    const f32x4 b1 = {__uint_as_float(p.z << 16), __uint_as_float(p.z & 0xffff0000u), __uint_as_float(p.w << 16), __uint_as_float(p.w & 0xffff0000u)};
                    const f32x4 y0 = b0 + acc[ai][bj][m][0], y1 = b1 + acc[ai][bj][m][1];
                    if (WR) *(u32x4*)(xb + off) = pack8(y0, y1); ss += dot4(y0) + dot4(y1); }
                ss += __shfl_xor(ss, 16); ss += __shfl_xor(ss, 32);
                if (fq == 0) rsq[(size_t)row * 16 + u.pn * 4 + wc] = ss; }
#undef ERB_LOAD
        } else {
            f32x4 bv[8][2][2];
#define ER_LOAD(g) do { _Pragma("unroll") for (int bj = 0; bj < 2; ++bj) { const float* p_ = base + (size_t)(row0 + ((g) >> 2) * HALF + ((g) & 3) * 16) * DM + col0 + bj * HALF; bv[g][bj][0] = *(const f32x4*)p_; bv[g][bj][1] = *(const f32x4*)(p_ + 4); } } while (0)
            ER_LOAD(0); ER_LOAD(1);
#pragma unroll
            for (int g = 0; g < 8; ++g) { const int ai = g >> 2, m = g & 3, row = row0 + ai * HALF + m * 16; float ss = 0.f;
                if (g + 2 < 8) { ER_LOAD(g + 2); }
                asm volatile("" ::: "memory");
#pragma unroll
                for (int bj = 0; bj < 2; ++bj) { const size_t off = (size_t)row * DM + col0 + bj * HALF;
                    const f32x4 y0 = bv[g][bj][0] + acc[ai][bj][m][0], y1 = bv[g][bj][1] + acc[ai][bj][m][1];
                    if (WR) *(u32x4*)(xb + off) = pack8(y0, y1); ss += dot4(y0) + dot4(y1); }
                ss += __shfl_xor(ss, 16); ss += __shfl_xor(ss, 32);
                if (fq == 0) rsq[(size_t)row * 16 + u.pn * 4 + wc] = ss; }
#undef ER_LOAD
        }
    }
};
struct EpiResXN {
    static constexpr bool PERM = true, AFTER_DRAIN = false;
    const bf16_t* xn; const float* rs0; const float* gcol; bf16_t* xb; float* rsq;
    __device__ __forceinline__ void operator()(const f32x4 (&acc)[2][2][4][2], const Unit& u, int wr, int wc, int fr, int fq) const {
        const int row0 = u.pm * BM + wr * 64 + fr, col0 = u.pn * BM + wc * 32 + 8 * fq;
        f32x4 ig[2][2];
#pragma unroll
        for (int bj = 0; bj < 2; ++bj)
#pragma unroll
            for (int n = 0; n < 2; ++n) { const f32x4 g = *(const f32x4*)(gcol + col0 + bj * HALF + 4 * n); ig[bj][n] = (f32x4){frcp(g[0]), frcp(g[1]), frcp(g[2]), frcp(g[3])}; }
        float ir[8];
#pragma unroll
        for (int g = 0; g < 8; ++g) ir[g] = frcp(rs0[row0 + (g >> 2) * HALF + (g & 3) * 16]);
        u32x4 pv[8][2];
#define ERX_LOAD(g) do { _Pragma("unroll") for (int bj = 0; bj < 2; ++bj) pv[g][bj] = *(const u32x4*)(xn + (size_t)(row0 + ((g) >> 2) * HALF + ((g) & 3) * 16) * DM + col0 + bj * HALF); } while (0)
        ERX_LOAD(0); ERX_LOAD(1); ERX_LOAD(2); ERX_LOAD(3);
#pragma unroll
        for (int g = 0; g < 8; ++g) { const int ai = g >> 2, m = g & 3, row = row0 + ai * HALF + m * 16; float ss = 0.f;
            if (g + 4 < 8) { ERX_LOAD(g + 4); }
            asm volatile("" ::: "memory");
#pragma unroll
            for (int bj = 0; bj < 2; ++bj) { const size_t off = (size_t)row * DM + col0 + bj * HALF; const u32x4 p = pv[g][bj];
                const f32x4 b0 = {__uint_as_float(p.x << 16), __uint_as_float(p.x & 0xffff0000u), __uint_as_float(p.y << 16), __uint_as_float(p.y & 0xffff0000u)};
                const f32x4 b1 = {__uint_as_float(p.z << 16), __uint_as_float(p.z & 0xffff0000u), __uint_as_float(p.w << 16), __uint_as_float(p.w & 0xffff0000u)};
                const f32x4 y0 = b0 * ig[bj][0] * ir[g] + acc[ai][bj][m][0], y1 = b1 * ig[bj][1] * ir[g] + acc[ai][bj][m][1];
                *(u32x4*)(xb + off) = pack8(y0, y1); ss += dot4(y0) + dot4(y1); }
            ss += __shfl_xor(ss, 16); ss += __shfl_xor(ss, 32);
            if (fq == 0) rsq[(size_t)row * 16 + u.pn * 4 + wc] = ss; }
#undef ERX_LOAD
    }
};
struct EpiPleNorm {
    static constexpr bool PERM = true, AFTER_DRAIN = false;
    float* out; const bf16_t* xb; const bf16_t* pw; const float* rsq_in; float* rsq_out; unsigned* pcnt; const float* fnorm; unsigned long long* dts;
#define EPN_STAMP(i) do { if (dts && wr == 0 && wc == 0 && fr == 0 && fq == 0) __hip_atomic_store(dts + (i) + 4 * (u.pm >= 64 ? 1 : 0), (unsigned long long)__builtin_amdgcn_s_memrealtime(), __ATOMIC_RELAXED, __HIP_MEMORY_SCOPE_AGENT); } while (0)
    __device__ __forceinline__ void operator()(const f32x4 (&acc_)[2][2][4][2], const Unit& u, int wr, int wc, int fr, int fq) const {
        f32x4 (&acc)[2][2][4][2] = const_cast<f32x4 (&)[2][2][4][2]>(acc_);
        const int row0 = u.pm * BM + wr * 64 + fr, col0 = u.pn * BM + wc * 32 + 8 * fq;
        EPN_STAMP(30);
        float rsv[2][4]; rs8(rsq_in, row0, fq, rsv);
        u32x4 xq[8][2], pq[8][2];
#define EP_LOAD(g) do { _Pragma("unroll") for (int bj = 0; bj < 2; ++bj) { const size_t o_ = (size_t)(row0 + ((g) >> 2) * HALF + ((g) & 3) * 16) * DM + col0 + bj * HALF; xq[g][bj] = *(const u32x4*)(xb + o_); pq[g][bj] = *(const u32x4*)(pw + o_); } } while (0)
        EP_LOAD(0); EP_LOAD(1);
#pragma unroll
        for (int g = 0; g < 8; ++g) { const int ai = g >> 2, m = g & 3, row = row0 + ai * HALF + m * 16; const float rs = rsv[ai][m]; float ss = 0.f;
            if (g + 2 < 8) { EP_LOAD(g + 2); }
            asm volatile("" ::: "memory");
#pragma unroll
            for (int bj = 0; bj < 2; ++bj) {
                const u32x4 pv = pq[g][bj];
                const f32x4 p0 = {__uint_as_float(pv.x << 16), __uint_as_float(pv.x & 0xffff0000u), __uint_as_float(pv.y << 16), __uint_as_float(pv.y & 0xffff0000u)};
                const f32x4 p1 = {__uint_as_float(pv.z << 16), __uint_as_float(pv.z & 0xffff0000u), __uint_as_float(pv.w << 16), __uint_as_float(pv.w & 0xffff0000u)};
                f32x4 g0 = acc[ai][bj][m][0] * rs, g1 = acc[ai][bj][m][1] * rs;
#pragma unroll
                for (int j = 0; j < 4; ++j) { g0[j] = fsigmoid(g0[j]); g1[j] = fsigmoid(g1[j]); }
                const u32x4 xv = xq[g][bj];
                const f32x4 x0 = {__uint_as_float(xv.x << 16), __uint_as_float(xv.x & 0xffff0000u), __uint_as_float(xv.y << 16), __uint_as_float(xv.y & 0xffff0000u)};
                const f32x4 x1 = {__uint_as_float(xv.z << 16), __uint_as_float(xv.z & 0xffff0000u), __uint_as_float(xv.w << 16), __uint_as_float(xv.w & 0xffff0000u)};
                const f32x4 y0 = x0 + p0 * g0, y1 = x1 + p1 * g1;
                acc[ai][bj][m][0] = y0; acc[ai][bj][m][1] = y1; ss += dot4(y0) + dot4(y1); }
            ss += __shfl_xor(ss, 16); ss += __shfl_xor(ss, 32);
            if (fq == 0) __hip_atomic_store((unsigned*)(rsq_out + (size_t)row * 16 + u.pn * 4 + wc), __float_as_uint(ss), __ATOMIC_RELAXED, __HIP_MEMORY_SCOPE_AGENT); }
#undef EP_LOAD
        asm volatile("s_waitcnt vmcnt(0)" ::: "memory");
        EPN_STAMP(31);
        unsigned* pc = pcnt + 16 * u.pm;
        if (fq == 0 && fr == 0) __hip_atomic_fetch_add(pc, 1u, __ATOMIC_RELAXED, __HIP_MEMORY_SCOPE_AGENT);
        for (unsigned spins = 0; spins < (1u << 22); ++spins) {
            if ((unsigned)__builtin_amdgcn_readfirstlane(__hip_atomic_load(pc, __ATOMIC_RELAXED, __HIP_MEMORY_SCOPE_AGENT)) >= 32u) break;
            __builtin_amdgcn_s_sleep(2);
        }
        EPN_STAMP(32);
        f32x4 fn[2][2];
#pragma unroll
        for (int bj = 0; bj < 2; ++bj) { fn[bj][0] = *(const f32x4*)(fnorm + col0 + bj * HALF); fn[bj][1] = *(const f32x4*)(fnorm + col0 + bj * HALF + 4); }
        unsigned long long pa[8], pb[8];
#pragma unroll
        for (int g = 0; g < 8; ++g) { const unsigned long long* pp = (const unsigned long long*)(rsq_out + (size_t)(row0 + (g >> 2) * HALF + (g & 3) * 16) * 16 + 4 * fq);
            pa[g] = __hip_atomic_load(pp, __ATOMIC_RELAXED, __HIP_MEMORY_SCOPE_AGENT); pb[g] = __hip_atomic_load(pp + 1, __ATOMIC_RELAXED, __HIP_MEMORY_SCOPE_AGENT); }
#pragma unroll
        for (int g = 0; g < 8; ++g) { const int ai = g >> 2, m = g & 3, row = row0 + ai * HALF + m * 16;
            float s = (__uint_as_float((unsigned)pa[g]) + __uint_as_float((unsigned)(pa[g] >> 32))) + (__uint_as_float((unsigned)pb[g]) + __uint_as_float((unsigned)(pb[g] >> 32)));
            s += __shfl_xor(s, 16); s += __shfl_xor(s, 32);
            const float rs3 = rsqrtf(s * (1.0f / DM) + RMS_EPS);
#pragma unroll
            for (int bj = 0; bj < 2; ++bj) { const size_t off = (size_t)row * DM + col0 + bj * HALF;
                __builtin_nontemporal_store(acc[ai][bj][m][0] * rs3 * fn[bj][0], (f32x4*)(out + off)); __builtin_nontemporal_store(acc[ai][bj][m][1] * rs3 * fn[bj][1], (f32x4*)(out + off + 4)); } }
        EPN_STAMP(33);
    }
};
#undef EPN_STAMP
struct EpiUG {
    static constexpr bool PERM = true, AFTER_DRAIN = false;
    bf16_t* act; const float* rsq; const float* cw; const float* cb; float* UL; float* UF; float* GF;
    __device__ __forceinline__ void operator()(const f32x4 (&acc)[2][2][4][2], const Unit& u, int wr, int wc, int fr, int fq) const {
        const int cu = u.pn * HALF + wc * 32 + 8 * fq;
        const int row0 = u.pm * BM + wr * 64 + fr;
        float rsv[2][4]; rs8(rsq, row0, fq, rsv);
        float w0[8], w1[8], w2[8], bb[8];
#pragma unroll
        for (int q = 0; q < 2; ++q) { const f32x4 a = *(const f32x4*)(cw + cu + 4 * q), b = *(const f32x4*)(cw + FF + cu + 4 * q), c = *(const f32x4*)(cw + 2 * FF + cu + 4 * q), d = *(const f32x4*)(cb + cu + 4 * q);
#pragma unroll
            for (int j = 0; j < 4; ++j) { w0[4 * q + j] = a[j]; w1[4 * q + j] = b[j]; w2[4 * q + j] = c[j]; bb[4 * q + j] = d[j]; } }
#pragma unroll
        for (int ai = 0; ai < 2; ++ai) {
            float up[8];
#pragma unroll
            for (int m = 0; m < 4; ++m) {
                const int row = row0 + ai * HALF + m * 16;
                const float rs = rsv[ai][m];
                float uu[8], gg[8], a8[8];
#pragma unroll
                for (int n = 0; n < 2; ++n)
#pragma unroll
                    for (int j = 0; j < 4; ++j) { uu[4 * n + j] = acc[ai][0][m][n][j] * rs; gg[4 * n + j] = acc[ai][1][m][n][j] * rs; }
#pragma unroll
                for (int k = 0; k < 8; ++k) {
                    float t1 = 0.f, t2 = 0.f;
                    if (m > 0) { t1 = DPP_ROT(up[k], 0x121); t2 = DPP_ROT(up[k], 0x122); }
                    const float u1 = DPP_MOV(t1, uu[k], 0x111), u2 = DPP_MOV(t2, uu[k], 0x112);
                    const float y = bb[k] + w0[k] * u2 + w1[k] * u1 + w2[k] * uu[k];
                    a8[k] = gelu_fast(y) * gg[k];
                }
                const bool defer = (m == 0) && (fr < 2);
                if (!defer) { u32x4 w; w.x = cvt_pk_bf16(a8[0], a8[1]); w.y = cvt_pk_bf16(a8[2], a8[3]); w.z = cvt_pk_bf16(a8[4], a8[5]); w.w = cvt_pk_bf16(a8[6], a8[7]);
                    *(u32x4*)(act + (size_t)row * FF + cu) = w; }
                else { const size_t so = ((size_t)(row >> 6) * 2 + fr) * FF + cu;
                    *(f32x4*)(UF + so) = (f32x4){uu[0], uu[1], uu[2], uu[3]}; *(f32x4*)(UF + so + 4) = (f32x4){uu[4], uu[5], uu[6], uu[7]};
                    *(f32x4*)(GF + so) = (f32x4){gg[0], gg[1], gg[2], gg[3]}; *(f32x4*)(GF + so + 4) = (f32x4){gg[4], gg[5], gg[6], gg[7]}; }
                if (m == 3 && fr >= 14) { const size_t so = ((size_t)(row >> 6) * 2 + (fr - 14)) * FF + cu;
                    *(f32x4*)(UL + so) = (f32x4){uu[0], uu[1], uu[2], uu[3]}; *(f32x4*)(UL + so + 4) = (f32x4){uu[4], uu[5], uu[6], uu[7]}; }
#pragma unroll
                for (int k = 0; k < 8; ++k) up[k] = uu[k];
            }
        }
    }
};
}
#define LAS __attribute__((address_space(3)))
namespace mx {
typedef short bf16x8 __attribute__((ext_vector_type(8)));
typedef short s16x4 __attribute__((ext_vector_type(4)));
typedef float f32x16 __attribute__((ext_vector_type(16)));
typedef unsigned u32x4 __attribute__((ext_vector_type(4)));
typedef float f32x4_t __attribute__((ext_vector_type(4)));
typedef LAS const char* lds_cptr;
typedef LAS char* lds_ptr;
__device__ __forceinline__ int crow(int r, int hi) { return (r & 3) + 8 * (r >> 2) + 4 * hi; }
__device__ __forceinline__ s16x4 vtr(lds_cptr p) { return __builtin_bit_cast(s16x4, __builtin_amdgcn_ds_read_tr16_b64_v4i16((LAS s16x4*)p)); }
__device__ __forceinline__ bf16x8 cat8(s16x4 lo, s16x4 hi) { return (bf16x8){lo[0], lo[1], lo[2], lo[3], hi[0], hi[1], hi[2], hi[3]}; }
typedef float f32x2_t __attribute__((ext_vector_type(2))); typedef __bf16 bf16x2_t __attribute__((ext_vector_type(2)));
__device__ __forceinline__ unsigned pk(float lo, float hi) { const f32x2_t v = {lo, hi}; return __builtin_bit_cast(unsigned, __builtin_convertvector(v, bf16x2_t)); }
__device__ __forceinline__ float other_half(float v) { return __shfl_xor(v, 32); }

constexpr int L_K = 0, L_V = 32768;
constexpr int L_WSF = 65536;
constexpr int L_OST = 65536 + 2048;
constexpr int L_ENT = L_OST + 32768;
constexpr int ENT_CAP = 4096;
constexpr int L_PREF = L_ENT + ENT_CAP * 4;
constexpr int L_MW = L_PREF + 512;
constexpr int L_END = L_MW + 4096;
static_assert(L_END <= 147456, "mixer LDS map");

__device__ __forceinline__ void moba_stage_kv(const bf16_t* __restrict__ proj, int b, int h, int blk, lds_ptr lds, int tid) {
#pragma unroll
    for (int i = 0; i < 4; ++i) { const int pc = tid + 512 * i, key = pc >> 3, ch = pc & 7;
        const bf16_t* src = proj + ((size_t)(b * 8 + h) * SEQ + blk * 256 + key) * 64 + ch * 8;
        const u32x4 kv = *(const u32x4*)(src + SEC), vv = *(const u32x4*)(src + 2 * SEC);
        *(LAS u32x4*)(lds + L_K + ch * 4096 + key * 16) = kv;
        *(LAS u32x4*)(lds + L_V + (key >> 6) * 8192 + (ch >> 2) * 4096 + ((key & 63) >> 3) * 512 + (key & 7) * 64 + (ch & 3) * 16) = vv; }
}

__device__ __forceinline__ void moba_batch(const bf16x8 (&qr)[4], int qpos, int kbase, float slope2, bool diag, int ntiles, lds_ptr lds, int wave, int lane, bf16_t* odst, float* ldst,
                                           const bf16_t* part_row = nullptr, const float* pl_row = nullptr, int nv = 0, bf16_t* mix_row = nullptr, bf16_t* mix_base = nullptr) {
    const int r32 = lane & 31, hi = lane >> 5;
    f32x16 o0, o1;
#pragma unroll
    for (int r = 0; r < 16; ++r) { o0[r] = 0.f; o1[r] = 0.f; }
    float m = -1e30f, l = 0.f;
    const lds_cptr kp = (lds_cptr)lds + L_K + hi * 4096 + r32 * 16;
    const lds_cptr vp = (lds_cptr)lds + L_V + ((lane >> 4) & 1) * 32 + (lane & 3) * 8 + (4 * hi + ((lane & 15) >> 2)) * 64;
    LAS float* wsf = (LAS float*)(lds + L_WSF) + wave * 64;
    const float s4h = slope2 * (float)(4 * hi);
#define MX_LOAD(KT) bf16x8 kf_[4], kg_[4], vf_[2][4]; do { _Pragma("unroll") for (int d0 = 0; d0 < 4; ++d0) { kf_[d0] = *(const LAS bf16x8*)(kp + (KT) * 1024 + d0 * 8192); kg_[d0] = *(const LAS bf16x8*)(kp + (KT) * 1024 + 512 + d0 * 8192); } \
        const lds_cptr vt_ = vp + (KT) * 8192; _Pragma("unroll") for (int db = 0; db < 2; ++db) _Pragma("unroll") for (int ks = 0; ks < 4; ++ks) vf_[db][ks] = cat8(vtr(vt_ + db * 4096 + ks * 1024), vtr(vt_ + db * 4096 + ks * 1024 + 512)); \
        __builtin_amdgcn_sched_barrier(0); } while (0)
#define MX_QK(P0, P1, C0, C1) do { _Pragma("unroll") for (int d0 = 0; d0 < 4; ++d0) { \
        P0 = __builtin_amdgcn_mfma_f32_32x32x16_bf16(kf_[d0], qr[d0], d0 == 0 ? C0 : P0, 0, 0, 0); P1 = __builtin_amdgcn_mfma_f32_32x32x16_bf16(kg_[d0], qr[d0], d0 == 0 ? C1 : P1, 0, 0, 0); } } while (0)
#define MX_PV(O, DB, KS, PW) O = __builtin_amdgcn_mfma_f32_32x32x16_bf16(__builtin_bit_cast(bf16x8, PW), vf_[DB][KS], O, 0, 0, 0)
#define MX_PVALL() do { \
        const u32x4 pw0 = {pk(p0[0], p0[1]), pk(p0[2], p0[3]), pk(p0[4], p0[5]), pk(p0[6], p0[7])}, pw1 = {pk(p0[8], p0[9]), pk(p0[10], p0[11]), pk(p0[12], p0[13]), pk(p0[14], p0[15])}; \
        const u32x4 pw2 = {pk(p1[0], p1[1]), pk(p1[2], p1[3]), pk(p1[4], p1[5]), pk(p1[6], p1[7])}, pw3 = {pk(p1[8], p1[9]), pk(p1[10], p1[11]), pk(p1[12], p1[13]), pk(p1[14], p1[15])}; \
        MX_PV(o0, 0, 0, pw0); MX_PV(o1, 1, 0, pw0); MX_PV(o0, 0, 1, pw1); MX_PV(o1, 1, 1, pw1); MX_PV(o0, 0, 2, pw2); MX_PV(o1, 1, 2, pw2); MX_PV(o0, 0, 3, pw3); MX_PV(o1, 1, 3, pw3); } while (0)
    {
        const int kt = ntiles - 1;
        f32x16 p0, p1;
        MX_LOAD(kt);
#pragma unroll
        for (int r = 0; r < 16; ++r) { p0[r] = fmaf(slope2, (float)((r & 3) + 8 * (r >> 2)), s4h); p1[r] = p0[r]; }
        MX_QK(p0, p1, p0, p1);
        const int dq = qpos - kbase - 64 * kt;
        const float t0 = -slope2 * (float)dq, t1 = t0 + 32.0f * slope2;
        if (diag) {
#pragma unroll
            for (int r = 0; r < 16; ++r) { const int c = crow(r, hi); if (c > dq) p0[r] = -1e30f; if (c + 32 > dq) p1[r] = -1e30f; }
        }
        float mx0 = p0[0], mx1 = p1[0];
#pragma unroll
        for (int r = 1; r < 16; ++r) { mx0 = fmaxf(mx0, p0[r]); mx1 = fmaxf(mx1, p1[r]); }
        float mx_ = fmaxf(mx0 + t0, mx1 + t1);
        m = fmaxf(mx_, other_half(mx_));
        const float e0 = m - t0, e1 = m - t1;
        float rs = 0.f;
#pragma unroll
        for (int r = 0; r < 16; ++r) { p0[r] = __builtin_amdgcn_exp2f(p0[r] - e0); p1[r] = __builtin_amdgcn_exp2f(p1[r] - e1); rs += p0[r] + p1[r]; }
        l = rs;
        MX_PVALL();
    }
    for (int kt = ntiles - 2; kt >= 0; --kt) {
        const int dq = qpos - kbase - 64 * kt;
        const float c0 = -slope2 * (float)dq - m + s4h, c1 = c0 + 32.0f * slope2;
        f32x16 p0, p1;
        MX_LOAD(kt);
#pragma unroll
        for (int r = 0; r < 16; ++r) { const float cr = (float)((r & 3) + 8 * (r >> 2)); p0[r] = fmaf(slope2, cr, c0); p1[r] = fmaf(slope2, cr, c1); }
        MX_QK(p0, p1, p0, p1);
        float mx_ = fmaxf(p0[0], p1[0]);
#pragma unroll
        for (int r = 1; r < 16; ++r) mx_ = fmaxf(mx_, fmaxf(p0[r], p1[r]));
        mx_ = fmaxf(mx_, other_half(mx_));
        if (__any(mx_ > 16.0f)) {
            const float dl = fmaxf(mx_, 0.f); m += dl;
#pragma unroll
            for (int r = 0; r < 16; ++r) { p0[r] -= dl; p1[r] -= dl; }
            const float f = __builtin_amdgcn_exp2f(-dl); l *= f;
            if (hi == 0) wsf[r32] = f;
#pragma unroll
            for (int r = 0; r < 16; ++r) { const float g = wsf[crow(r, hi)]; o0[r] *= g; o1[r] *= g; }
        }
        float rs = 0.f;
#pragma unroll
        for (int r = 0; r < 16; ++r) { p0[r] = __builtin_amdgcn_exp2f(p0[r]); p1[r] = __builtin_amdgcn_exp2f(p1[r]); rs += p0[r] + p1[r]; }
        l += rs;
        MX_PVALL();
    }
#undef MX_LOAD
#undef MX_QK
#undef MX_PV
#undef MX_PVALL
    l += other_half(l);
    if (hi == 0) wsf[32 + r32] = 1.0f / l;
    const float lse = m + __builtin_amdgcn_logf(l);
    LAS bf16_t* ost = (LAS bf16_t*)(lds + L_OST) + wave * 2048;
#pragma unroll
    for (int r = 0; r < 16; ++r) { const int orow = crow(r, hi); const float f = wsf[32 + orow];
        ost[orow * 64 + r32] = (bf16_t)pk(o0[r] * f, 0.f); ost[orow * 64 + 32 + r32] = (bf16_t)pk(o1[r] * f, 0.f); }
    if (mix_row == nullptr) {
        const unsigned long long dp = (unsigned long long)odst; const unsigned dlo = (unsigned)dp, dhi = (unsigned)(dp >> 32);
#pragma unroll
        for (int i = 0; i < 4; ++i) { const int row = i * 8 + (lane >> 3), ch = lane & 7;
            const u32x4 v = *(const LAS u32x4*)(ost + row * 64 + ch * 8);
            const unsigned long long d = ((unsigned long long)(unsigned)__shfl((int)dhi, row) << 32) | (unsigned)__shfl((int)dlo, row);
            if (d) *(u32x4*)((bf16_t*)d + ch * 8) = v; }
        if (hi == 0 && ldst) *ldst = lse;
    } else {
        if (hi == 0) { const f32x4_t lv = *(const f32x4_t*)pl_row;
            const float a0 = nv > 0 ? lv[0] : -1e30f, a1 = nv > 1 ? lv[1] : -1e30f, a2 = nv > 2 ? lv[2] : -1e30f;
            const float mm = fmaxf(fmaxf(a0, a1), fmaxf(a2, lse));
            const float w0 = __builtin_amdgcn_exp2f(a0 - mm), w1 = __builtin_amdgcn_exp2f(a1 - mm), w2 = __builtin_amdgcn_exp2f(a2 - mm), w3 = __builtin_amdgcn_exp2f(lse - mm);
            const float iw = 1.0f / ((w0 + w1) + (w2 + w3));
            ((LAS f32x4_t*)(lds + L_MW) + wave * 32)[r32] = (f32x4_t){w0 * iw, w1 * iw, w2 * iw, w3 * iw}; }
        const unsigned long long pp = (unsigned long long)part_row, mp = (unsigned long long)mix_row;
        const unsigned plo = (unsigned)pp, phi = (unsigned)(pp >> 32), mlo = (unsigned)mp, mhi = (unsigned)(mp >> 32);
#pragma unroll
        for (int i = 0; i < 4; ++i) { const int row = i * 8 + (lane >> 3), ch = lane & 7;
            const u32x4 v = *(const LAS u32x4*)(ost + row * 64 + ch * 8);
            const f32x4_t w = ((const LAS f32x4_t*)(lds + L_MW) + wave * 32)[row];
            const bf16_t* pr = (const bf16_t*)(((unsigned long long)(unsigned)__shfl((int)phi, row) << 32) | (unsigned)__shfl((int)plo, row));
            bf16_t* mr = (bf16_t*)(((unsigned long long)(unsigned)__shfl((int)mhi, row) << 32) | (unsigned)__shfl((int)mlo, row));
            const unsigned vw[4] = {v.x, v.y, v.z, v.w}; float acc[8];
#pragma unroll
            for (int q = 0; q < 4; ++q) { acc[2 * q] = w[3] * __uint_as_float(vw[q] << 16); acc[2 * q + 1] = w[3] * __uint_as_float(vw[q] & 0xffff0000u); }
#pragma unroll
            for (int s = 0; s < 3; ++s) if (w[s] != 0.f) { const u32x4 pv = *(const u32x4*)(pr + s * 64 + ch * 8); const unsigned pw_[4] = {pv.x, pv.y, pv.z, pv.w};
#pragma unroll
                for (int q = 0; q < 4; ++q) { acc[2 * q] += w[s] * __uint_as_float(pw_[q] << 16); acc[2 * q + 1] += w[s] * __uint_as_float(pw_[q] & 0xffff0000u); } }
            *(u32x4*)(mr + ch * 8) = (u32x4){pk(acc[0], acc[1]), pk(acc[2], acc[3]), pk(acc[4], acc[5]), pk(acc[6], acc[7])}; }
    }
}

__device__ __forceinline__ void moba_diag_unit(const bf16_t* __restrict__ proj, int bh, int i, const bf16_t* part_o, const float* part_l, const u32* __restrict__ sel, bf16_t* mix, lds_ptr lds, int tid) {
    const int b = bh >> 3, h = bh & 7, lane = tid & 63, wave = __builtin_amdgcn_readfirstlane(tid >> 6);
    const int ql = wave * 32 + (lane & 31), t = i * 256 + ql; const size_t row = (size_t)b * SEQ + t;
    bf16x8 qr[4];
    { const bf16_t* qp = proj + ((size_t)bh * SEQ + t) * 64 + (lane >> 5) * 8;
#pragma unroll
      for (int d0 = 0; d0 < 4; ++d0) qr[d0] = *(const bf16x8*)(qp + d0 * 16); }
    moba_stage_kv(proj, b, h, i, lds, tid);
    __syncthreads();
    const float slope2 = __builtin_amdgcn_exp2f(-(float)(h + 1)) * LOG2E;
    const int nv = (int)(sel[row * 8 + h] >> 24);
    moba_batch(qr, t, i * 256, slope2, true, (wave >> 1) + 1, lds, wave, lane, nullptr, nullptr,
               part_o + ((row * 8 + h) * 4) * 64, part_l + (row * 8 + h) * 4, nv, mix + row * DM + h * 64, mix);
    __syncthreads();
}
__device__ __forceinline__ void moba_sel_task(const bf16_t* __restrict__ proj, const unsigned short* __restrict__ seg, const int* __restrict__ cnt, int bh, int n,
                                              bf16_t* part_o, float* part_l, lds_ptr lds, int tid) {
    const int b = bh >> 3, h = bh & 7, lane = tid & 63, wave = __builtin_amdgcn_readfirstlane(tid >> 6);
    LAS int* pref = (LAS int*)(lds + L_PREF); LAS unsigned* ent = (LAS unsigned*)(lds + L_ENT);
    moba_stage_kv(proj, b, h, n, lds, tid);
    if (wave == 0) {
        const int c = (lane > n) ? cnt[((size_t)bh * 64 + n) * 64 + lane] : 0; int s = c;
#pragma unroll
        for (int o = 1; o < 64; o <<= 1) { const int v = __shfl_up(s, o); if (lane >= o) s += v; }
        pref[lane + 1] = s; if (lane == 0) pref[0] = 0;
    }
    __syncthreads();
    const int T = pref[64];
    const float slope2 = __builtin_amdgcn_exp2f(-(float)(h + 1)) * LOG2E;
    for (int c0 = 0; c0 < T; c0 += ENT_CAP) {
        for (int i = n + 1 + wave; i < 64; i += 8) { const int s0 = pref[i], s1 = pref[i + 1];
            const unsigned short* sp = seg + (((size_t)bh * 64 + n) * 64 + i) * 256;
            for (int e = lane; e < s1 - s0; e += 64) { const int g = s0 + e - c0; if (g >= 0 && g < ENT_CAP) ent[g] = ((unsigned)i << 10) | (unsigned)sp[e]; } }
        __syncthreads();
        const int cn = (T - c0) < ENT_CAP ? (T - c0) : ENT_CAP;
        for (int wb = wave; wb * 32 < cn; wb += 8) {
            const int idx = wb * 32 + (lane & 31); const bool valid = idx < cn;
            const unsigned ec = ent[valid ? idx : wb * 32];
            const int t = (ec >> 10) * 256 + ((ec >> 2) & 255), slot = ec & 3; const size_t row = (size_t)b * SEQ + t;
            bf16x8 qr[4];
            { const bf16_t* qp = proj + ((size_t)bh * SEQ + t) * 64 + (lane >> 5) * 8;
#pragma unroll
              for (int d0 = 0; d0 < 4; ++d0) qr[d0] = *(const bf16x8*)(qp + d0 * 16); }
            moba_batch(qr, t, n * 256, slope2, false, 4, lds, wave, lane,
                       valid ? part_o + ((row * 8 + h) * 4 + slot) * 64 : (bf16_t*)nullptr, valid ? part_l + (row * 8 + h) * 4 + slot : (float*)nullptr);
        }
        __syncthreads();
    }
}
constexpr int G_KMH = 0, G_KML = 8192, G_CNT = 16384;
#define MX_INS(v, n) do { const bool g0_ = (v) > v0, g1_ = (v) > v1, g2_ = (v) > v2; \
    v2 = g1_ ? v1 : (g2_ ? (v) : v2); i2 = g1_ ? i1 : (g2_ ? (n) : i2); v1 = g0_ ? v0 : (g1_ ? (v) : v1); i1 = g0_ ? i0 : (g1_ ? (n) : i1); v0 = g0_ ? (v) : v0; i0 = g0_ ? (n) : i0; } while (0)
__device__ __forceinline__ void gate_task_mfma(int bh, int i, const bf16_t* __restrict__ proj, const float* __restrict__ kmsum, u32* __restrict__ sel,
                                               unsigned short* __restrict__ seg, int* __restrict__ cnt, lds_ptr lds, int tid) {
    const int b = bh >> 3, h = bh & 7, lane = tid & 63, wave = __builtin_amdgcn_readfirstlane(tid >> 6), r32 = lane & 31, hi = lane >> 5;
    { const int n = tid >> 3, ch = tid & 7; const float* src = kmsum + (size_t)bh * 4096 + n * 64 + ch * 8;
      const f32x4_t a = *(const f32x4_t*)src * (1.0f / 256.0f), c = *(const f32x4_t*)(src + 4) * (1.0f / 256.0f);
      float v[8] = {a[0], a[1], a[2], a[3], c[0], c[1], c[2], c[3]}; float hf[8], lf[8];
#pragma unroll
      for (int k = 0; k < 8; ++k) { hf[k] = bf2f(f2bf(v[k])); lf[k] = v[k] - hf[k]; }
      const u32x4 H = {pk(hf[0], hf[1]), pk(hf[2], hf[3]), pk(hf[4], hf[5]), pk(hf[6], hf[7])}, Lw = {pk(lf[0], lf[1]), pk(lf[2], lf[3]), pk(lf[4], lf[5]), pk(lf[6], lf[7])};
      *(LAS u32x4*)(lds + G_KMH + ch * 1024 + n * 16) = H; *(LAS u32x4*)(lds + G_KML + ch * 1024 + n * 16) = Lw; }
    LAS int* cntL = (LAS int*)(lds + G_CNT);
    if (tid < 64) cntL[tid] = 0;
    __syncthreads();
    const int ql = wave * 32 + r32, t = i * 256 + ql; const size_t row = (size_t)b * SEQ + t;
    const bf16_t* qp = proj + ((size_t)bh * SEQ + t) * 64 + hi * 8;
    f32x16 p0, p1;
#pragma unroll
    for (int r = 0; r < 16; ++r) { p0[r] = 0.f; p1[r] = 0.f; }
#pragma unroll
    for (int ks = 0; ks < 4; ++ks) {
        const bf16x8 q = *(const bf16x8*)(qp + ks * 16);
        const lds_cptr kb = (lds_cptr)lds + (2 * ks + hi) * 1024 + r32 * 16;
        p0 = __builtin_amdgcn_mfma_f32_32x32x16_bf16(*(const LAS bf16x8*)(kb + G_KMH), q, p0, 0, 0, 0);
        p0 = __builtin_amdgcn_mfma_f32_32x32x16_bf16(*(const LAS bf16x8*)(kb + G_KML), q, p0, 0, 0, 0);
        p1 = __builtin_amdgcn_mfma_f32_32x32x16_bf16(*(const LAS bf16x8*)(kb + G_KMH + 512), q, p1, 0, 0, 0);
        p1 = __builtin_amdgcn_mfma_f32_32x32x16_bf16(*(const LAS bf16x8*)(kb + G_KML + 512), q, p1, 0, 0, 0);
    }
    float v0 = -INFINITY, v1 = -INFINITY, v2 = -INFINITY; int i0 = 0, i1 = 0, i2 = 0;
#pragma unroll
    for (int r = 0; r < 16; ++r) { const int n = crow(r, hi); const float v = n < i ? p0[r] : -INFINITY; MX_INS(v, n); }
#pragma unroll
    for (int r = 0; r < 16; ++r) { const int n = 32 + crow(r, hi); const float v = n < i ? p1[r] : -INFINITY; MX_INS(v, n); }
    { const float a0 = __shfl_xor(v0, 32), a1 = __shfl_xor(v1, 32), a2 = __shfl_xor(v2, 32); const int j0 = __shfl_xor(i0, 32), j1 = __shfl_xor(i1, 32), j2 = __shfl_xor(i2, 32);
      MX_INS(a0, j0); MX_INS(a1, j1); MX_INS(a2, j2); }
    if (hi == 0) {
        const int nv = i < 3 ? i : 3;
        sel[row * 8 + h] = (u32)i0 | ((u32)i1 << 8) | ((u32)i2 << 16) | ((u32)nv << 24);
#pragma unroll
        for (int s = 0; s < 3; ++s) if (s < nv) { const int n = s == 0 ? i0 : (s == 1 ? i1 : i2);
            const int pos = atomicAdd((int*)&cntL[n], 1);
            seg[(((size_t)bh * 64 + n) * 64 + i) * 256 + pos] = (unsigned short)((ql << 2) | s); }
    }
    __syncthreads();
    if (tid < i) cnt[((size_t)bh * 64 + tid) * 64 + i] = cntL[tid];
    __syncthreads();
}
#undef MX_INS

__device__ __forceinline__ void moba_combine(const bf16_t* __restrict__ part_o, const float* __restrict__ part_l, const u32* __restrict__ sel, bf16_t* __restrict__ mix, size_t gt, size_t GT) {
    for (size_t i = gt; i < (size_t)MT * 64; i += GT) {
        const int ch = (int)(i & 7), h = (int)((i >> 3) & 7); const size_t row = i >> 6;
        const int nv = sel[row * 8 + h] >> 24;
        const f32x4_t lv = *(const f32x4_t*)(part_l + (row * 8 + h) * 4);
        float w[4]; w[0] = nv > 0 ? lv[0] : -1e30f; w[1] = nv > 1 ? lv[1] : -1e30f; w[2] = nv > 2 ? lv[2] : -1e30f; w[3] = lv[3];
        const float mm = fmaxf(fmaxf(w[0], w[1]), fmaxf(w[2], w[3]));
        float acc[8] = {0.f, 0.f, 0.f, 0.f, 0.f, 0.f, 0.f, 0.f}; float ws = 0.f;
#pragma unroll
        for (int s = 0; s < 4; ++s) { const bool ok = s == 3 || s < nv; const float ww = ok ? __builtin_amdgcn_exp2f(w[s] - mm) : 0.f; ws += ww;
            if (ok) { const u32x4 v = *(const u32x4*)(part_o + ((row * 8 + h) * 4 + s) * 64 + ch * 8);
                acc[0] += ww * __uint_as_float(v.x << 16); acc[1] += ww * __uint_as_float(v.x & 0xffff0000u); acc[2] += ww * __uint_as_float(v.y << 16); acc[3] += ww * __uint_as_float(v.y & 0xffff0000u);
                acc[4] += ww * __uint_as_float(v.z << 16); acc[5] += ww * __uint_as_float(v.z & 0xffff0000u); acc[6] += ww * __uint_as_float(v.w << 16); acc[7] += ww * __uint_as_float(v.w & 0xffff0000u); } }
        const float iw = 1.0f / ws;
        u32x4 o; o.x = pk(acc[0] * iw, acc[1] * iw); o.y = pk(acc[2] * iw, acc[3] * iw); o.z = pk(acc[4] * iw, acc[5] * iw); o.w = pk(acc[6] * iw, acc[7] * iw);
        *(u32x4*)(mix + row * DM + h * 64 + ch * 8) = o;
    }
}

constexpr int R_IMG = 65536;
__device__ __forceinline__ int rimg_off(int t, int c) { return (c >> 5) * 16384 + (t >> 3) * 512 + (t & 7) * 64 + (c & 31) * 2; }
__device__ __forceinline__ void ret_stage(const bf16_t* __restrict__ plane, int t0, lds_ptr img, int tid, bool kdecay, float log2g) {
#pragma unroll
    for (int i = 0; i < 8; ++i) { const int pc = tid + 512 * i, t = pc >> 4, ch = pc & 15;
        u32x4 v = *(const u32x4*)(plane + (size_t)(t0 + t) * 128 + ch * 8);
        if (kdecay) { const float f = __builtin_amdgcn_exp2f((float)(255 - t) * log2g);
            v.x = pk(__uint_as_float(v.x << 16) * f, __uint_as_float(v.x & 0xffff0000u) * f); v.y = pk(__uint_as_float(v.y << 16) * f, __uint_as_float(v.y & 0xffff0000u) * f);
            v.z = pk(__uint_as_float(v.z << 16) * f, __uint_as_float(v.z & 0xffff0000u) * f); v.w = pk(__uint_as_float(v.w << 16) * f, __uint_as_float(v.w & 0xffff0000u) * f); }
        *(LAS u32x4*)(img + rimg_off(t, ch * 8)) = v; }
}
__device__ __forceinline__ void ret_kv_task(const bf16_t* __restrict__ proj, int bh, int c, float* __restrict__ kvt, lds_ptr lds, int tid) {
    const int b = bh >> 2, h = bh & 3, lane = tid & 63, wave = __builtin_amdgcn_readfirstlane(tid >> 6), r32 = lane & 31, hi = lane >> 5;
    const float log2g = __builtin_amdgcn_logf(1.0f - __builtin_amdgcn_exp2f(-5.0f - (float)h));
    ret_stage(proj + 5 * SEC + (size_t)bh * SEQ * 128, c * 256, lds, tid, false, 0.f);
    ret_stage(proj + 4 * SEC + (size_t)bh * SEQ * 128, c * 256, lds + R_IMG, tid, true, log2g);
    __syncthreads();
    const int et = wave >> 1, dt0 = (wave & 1) * 2;
    const int lbase = hi * 512 + ((lane & 15) >> 2) * 64 + ((lane >> 4) & 1) * 32 + (lane & 3) * 8;
    const lds_cptr va = (lds_cptr)lds + et * 16384 + lbase, kb0 = (lds_cptr)lds + R_IMG + dt0 * 16384 + lbase, kb1 = kb0 + 16384;
    f32x16 a0, a1;
#pragma unroll
    for (int r = 0; r < 16; ++r) { a0[r] = 0.f; a1[r] = 0.f; }
#pragma unroll 4
    for (int ks = 0; ks < 16; ++ks) {
        const bf16x8 vf = cat8(vtr(va + ks * 1024), vtr(va + ks * 1024 + 256));
        const bf16x8 k0 = cat8(vtr(kb0 + ks * 1024), vtr(kb0 + ks * 1024 + 256)), k1 = cat8(vtr(kb1 + ks * 1024), vtr(kb1 + ks * 1024 + 256));
        a0 = __builtin_amdgcn_mfma_f32_32x32x16_bf16(vf, k0, a0, 0, 0, 0);
        a1 = __builtin_amdgcn_mfma_f32_32x32x16_bf16(vf, k1, a1, 0, 0, 0);
    }
    float* dst = kvt + ((size_t)(bh * 64 + c) * 128) * 128;
#pragma unroll
    for (int r = 0; r < 16; ++r) { const int e = et * 32 + crow(r, hi);
        dst[(size_t)e * 128 + dt0 * 32 + r32] = a0[r]; dst[(size_t)e * 128 + dt0 * 32 + 32 + r32] = a1[r]; }
    __syncthreads();
}
__device__ __forceinline__ void ret_scan(const float* __restrict__ kvt, bf16_t* __restrict__ stt, size_t gt, size_t GT) {
    for (size_t i = gt; i < (size_t)8 * 16384; i += GT) {
        const int bh = (int)(i >> 14), ed = (int)(i & 16383), h = bh & 3;
        const float g256 = __builtin_amdgcn_exp2f(256.0f * __builtin_amdgcn_logf(1.0f - __builtin_amdgcn_exp2f(-5.0f - (float)h)));
        float s = 0.f;
#pragma unroll 8
        for (int c = 0; c < 64; ++c) { const size_t o = ((size_t)(bh * 64 + c) << 14) + ed; stt[o] = f2bf(s); s = s * g256 + kvt[o]; }
    }
}
constexpr int RO_A = 0, RO_V = 65536, RO_ST = 131072;
#define RO_STAMP(i) do { if (dts && tid == 0) __hip_atomic_store(dts + (i), (unsigned long long)__builtin_amdgcn_s_memrealtime(), __ATOMIC_RELAXED, __HIP_MEMORY_SCOPE_AGENT); } while (0)
__device__ __forceinline__ void ret_out_task(const bf16_t* __restrict__ proj, const bf16_t* __restrict__ stt, const float* __restrict__ gain, bf16_t* __restrict__ mix, int bh, int c, lds_ptr lds, int tid, unsigned long long* dts = nullptr) {
    RO_STAMP(21);
    const int b = bh >> 2, h = bh & 3, lane = tid & 63, wave = __builtin_amdgcn_readfirstlane(tid >> 6), r32 = lane & 31, hi = lane >> 5;
    const float log2g = __builtin_amdgcn_logf(1.0f - __builtin_amdgcn_exp2f(-5.0f - (float)h));
    const size_t row0 = (size_t)b * SEQ + c * 256;
    u32x4 sreg[4], vreg[8], kreg[8];
    { const bf16_t* sp = stt + ((size_t)(bh * 64 + c) << 14);
#pragma unroll
      for (int i = 0; i < 4; ++i) sreg[i] = *(const u32x4*)(sp + (size_t)(tid + 512 * i) * 8); }
    const size_t hrow0 = (size_t)bh * SEQ + c * 256;
#pragma unroll
    for (int i = 0; i < 8; ++i) { const int pc = tid + 512 * i, t = pc >> 4, ch = pc & 15; const bf16_t* src = proj + (hrow0 + t) * 128 + ch * 8;
        vreg[i] = *(const u32x4*)(src + 5 * SEC); kreg[i] = *(const u32x4*)(src + 4 * SEC); }
    bf16x8 qf[8];
    { const bf16_t* qp = proj + 3 * SEC + (hrow0 + wave * 32 + r32) * 128 + hi * 8;
#pragma unroll
      for (int ks = 0; ks < 8; ++ks) qf[ks] = *(const bf16x8*)(qp + ks * 16); }
#pragma unroll
    for (int i = 0; i < 4; ++i) { const int pc = tid + 512 * i, e = pc >> 4, ch = pc & 15; *(LAS u32x4*)(lds + RO_A + ch * 2048 + e * 16) = sreg[i]; }
#pragma unroll
    for (int i = 0; i < 8; ++i) { const int pc = tid + 512 * i, t = pc >> 4, ch = pc & 15; *(LAS u32x4*)(lds + RO_V + rimg_off(t, ch * 8)) = vreg[i]; }
    __syncthreads();
    RO_STAMP(22);
    f32x16 o[4];
#pragma unroll
    for (int et = 0; et < 4; ++et)
#pragma unroll
        for (int r = 0; r < 16; ++r) o[et][r] = 0.f;
    { const lds_cptr sb = (lds_cptr)lds + RO_A + hi * 2048 + r32 * 16;
#pragma unroll
      for (int et = 0; et < 4; ++et)
#pragma unroll
          for (int ks = 0; ks < 8; ++ks) o[et] = __builtin_amdgcn_mfma_f32_32x32x16_bf16(qf[ks], *(const LAS bf16x8*)(sb + ks * 4096 + et * 512), o[et], 0, 0, 0); }
#pragma unroll
    for (int r = 0; r < 16; ++r) { const float f = __builtin_amdgcn_exp2f((float)(wave * 32 + crow(r, hi) + 1) * log2g);
#pragma unroll
        for (int et = 0; et < 4; ++et) o[et][r] *= f; }
    RO_STAMP(23);
    __syncthreads();
#pragma unroll
    for (int i = 0; i < 8; ++i) { const int pc = tid + 512 * i, t = pc >> 4, ch = pc & 15; *(LAS u32x4*)(lds + RO_A + ch * 4096 + t * 16) = kreg[i]; }
    __syncthreads();
    u32x4 rgv[8];
#pragma unroll
    for (int g = 0; g < 4; ++g)
#pragma unroll
        for (int k = 0; k < 2; ++k) { const int pidx = lane + 64 * k; rgv[2 * g + k] = *(const u32x4*)(proj + 6 * SEC + (hrow0 + wave * 32 + 8 * g + (pidx >> 4)) * 128 + (pidx & 15) * 8); }
    const lds_cptr vp = (lds_cptr)lds + RO_V + ((lane >> 4) & 1) * 32 + (lane & 3) * 8 + (4 * hi + ((lane & 15) >> 2)) * 64;
    const lds_cptr kpb = (lds_cptr)lds + RO_A + hi * 4096 + r32 * 16;
    for (int kvt = 0; kvt <= wave; ++kvt) {
        f32x16 p;
#pragma unroll
        for (int r = 0; r < 16; ++r) p[r] = 0.f;
#pragma unroll
        for (int ks = 0; ks < 8; ++ks) p = __builtin_amdgcn_mfma_f32_32x32x16_bf16(*(const LAS bf16x8*)(kpb + ks * 8192 + kvt * 512), qf[ks], p, 0, 0, 0);
        const int dbase = 32 * (wave - kvt) + r32 - 4 * hi;
#pragma unroll
        for (int r = 0; r < 16; ++r) { const int dist = dbase - ((r & 3) + 8 * (r >> 2)); p[r] = dist >= 0 ? p[r] * __builtin_amdgcn_exp2f((float)dist * log2g) : 0.f; }
        const u32x4 pw0 = {pk(p[0], p[1]), pk(p[2], p[3]), pk(p[4], p[5]), pk(p[6], p[7])}, pw1 = {pk(p[8], p[9]), pk(p[10], p[11]), pk(p[12], p[13]), pk(p[14], p[15])};
        const lds_cptr vt = vp + kvt * 2048;
#pragma unroll
        for (int et = 0; et < 4; ++et) {
            o[et] = __builtin_amdgcn_mfma_f32_32x32x16_bf16(__builtin_bit_cast(bf16x8, pw0), cat8(vtr(vt + et * 16384), vtr(vt + et * 16384 + 512)), o[et], 0, 0, 0);
            o[et] = __builtin_amdgcn_mfma_f32_32x32x16_bf16(__builtin_bit_cast(bf16x8, pw1), cat8(vtr(vt + et * 16384 + 1024), vtr(vt + et * 16384 + 1536)), o[et], 0, 0, 0);
        }
    }
    RO_STAMP(24);
    float mu[16], rstd[16];
#pragma unroll
    for (int r = 0; r < 16; ++r) {
        float s = (o[0][r] + o[1][r]) + (o[2][r] + o[3][r]);
        s += __shfl_xor(s, 1); s += __shfl_xor(s, 2); s += __shfl_xor(s, 4); s += __shfl_xor(s, 8); s += __shfl_xor(s, 16);
        mu[r] = s * (1.0f / 128.0f);
        const float d0 = o[0][r] - mu[r], d1 = o[1][r] - mu[r], d2 = o[2][r] - mu[r], d3 = o[3][r] - mu[r];
        float q = (d0 * d0 + d1 * d1) + (d2 * d2 + d3 * d3);
        q += __shfl_xor(q, 1); q += __shfl_xor(q, 2); q += __shfl_xor(q, 4); q += __shfl_xor(q, 8); q += __shfl_xor(q, 16);
        rstd[r] = rsqrtf(q * (1.0f / 128.0f) + GN_EPS);
    }
    float gn[4];
#pragma unroll
    for (int et = 0; et < 4; ++et) gn[et] = gain[h * 128 + et * 32 + r32];
    LAS bf16_t* st = (LAS bf16_t*)(lds + RO_ST) + wave * 1024;
#pragma unroll
    for (int g = 0; g < 4; ++g) {
#pragma unroll
        for (int rr = 0; rr < 4; ++rr) { const int r = 4 * g + rr;
#pragma unroll
            for (int et = 0; et < 4; ++et) st[(rr + 4 * hi) * 128 + et * 32 + r32] = f2bf((o[et][r] - mu[r]) * rstd[r] * gn[et]); }
#pragma unroll
        for (int k = 0; k < 2; ++k) { const int pidx = lane + 64 * k, r8 = pidx >> 4, ch = pidx & 15; const size_t row = row0 + wave * 32 + 8 * g + r8;
            const u32x4 nv = *(const LAS u32x4*)(st + r8 * 128 + ch * 8); const u32x4 gv = rgv[2 * g + k];
            const unsigned nw[4] = {nv.x, nv.y, nv.z, nv.w}, gw_[4] = {gv.x, gv.y, gv.z, gv.w}; unsigned ow[4];
#pragma unroll
            for (int q = 0; q < 4; ++q) { const float g0 = __uint_as_float(gw_[q] << 16), g1 = __uint_as_float(gw_[q] & 0xffff0000u);
                ow[q] = pk(__uint_as_float(nw[q] << 16) * (g0 / (1.0f + __expf(-g0))), __uint_as_float(nw[q] & 0xffff0000u) * (g1 / (1.0f + __expf(-g1)))); }
            *(u32x4*)(mix + row * DM + 512 + h * 128 + ch * 8) = (u32x4){ow[0], ow[1], ow[2], ow[3]}; }
    }
    RO_STAMP(25);
    __syncthreads();
    RO_STAMP(26);
}
#undef RO_STAMP
}
#ifndef DIAG_K
#define DIAG_K -1
#endif
#ifndef DIAG_BLOCK
#define DIAG_BLOCK 100
#endif
#ifndef DIAG_SCALE
#define DIAG_SCALE 1.0f
#endif
#ifndef DIAG_A
#define DIAG_A 45
#endif
#ifndef DIAG_B
#define DIAG_B 6
#endif
#ifndef REP_MASK
#define REP_MASK 0
#endif
#ifndef REP_SUB
#define REP_SUB 7
#endif
#include <hip/hip_cooperative_groups.h>
namespace cg = cooperative_groups;
constexpr int NWAVES = 8, NTHREADS = 512;
constexpr int LDS_BYTES = 147456 + 256;
constexpr int NPH = 10;
constexpr size_t WS_STASH = 180 * MiB;
constexpr size_t STASH_ELEMS = (size_t)512 * 2 * FF;

struct Args { const float* in[16]; float* out; unsigned char* ws; int ph_lo, ph_hi, flags, pad; };

__device__ __forceinline__ void p0_transpose_item(const float* __restrict__ W, int K, int N, const float* __restrict__ gk, bf16_t* __restrict__ WT, int k0, int n0, int orow0, LAS float* scr, int lane) {
    { float4 v[8];
#pragma unroll
      for (int i = 0; i < 8; ++i) v[i] = nt_ld4(W + (size_t)(k0 + 8 * i + (lane >> 3)) * N + n0 + (lane & 7) * 4);
#pragma unroll
      for (int i = 0; i < 8; ++i) { const int kk = 8 * i + (lane >> 3); const float g = gk ? gk[k0 + kk] : 1.0f; LAS float* d = scr + kk * 33 + (lane & 7) * 4;
          d[0] = v[i].x * g; d[1] = v[i].y * g; d[2] = v[i].z * g; d[3] = v[i].w * g; } }
    asm volatile("s_waitcnt lgkmcnt(0)" ::: "memory");
    const int c = lane & 7;
#pragma unroll
    for (int j = 0; j < 4; ++j) { const int n = (lane >> 3) + 8 * j; const LAS float* s = scr + (8 * c) * 33 + n;
        uint4 o; o.x = (u32)f2bf(s[0 * 33]) | ((u32)f2bf(s[1 * 33]) << 16); o.y = (u32)f2bf(s[2 * 33]) | ((u32)f2bf(s[3 * 33]) << 16);
        o.z = (u32)f2bf(s[4 * 33]) | ((u32)f2bf(s[5 * 33]) << 16); o.w = (u32)f2bf(s[6 * 33]) | ((u32)f2bf(s[7 * 33]) << 16);
        *(uint4*)(WT + (size_t)(orow0 + n) * K + k0 + 8 * c) = o; }
    asm volatile("s_waitcnt lgkmcnt(0)" ::: "memory");
}

#define XB_TMO      128
#define XB_XCNT(j)  (256  + 64 * (j))
#define XB_XSUB(j)  (1280 + 64 * (j))
#define XB_XGEN(j)  (2304 + 64 * (j))
#define XB_TOP      3328
#define XB_TOPGEN   3392
#define XCD_BAR_WORDS 3456
#define XB_SPIN_CAP (1u << 18)

__device__ __forceinline__ unsigned xb_ld(unsigned* p)              { return __hip_atomic_load(p, __ATOMIC_RELAXED, __HIP_MEMORY_SCOPE_AGENT); }
__device__ __forceinline__ unsigned xb_add(unsigned* p, unsigned v) { return __hip_atomic_fetch_add(p, v, __ATOMIC_RELAXED, __HIP_MEMORY_SCOPE_AGENT); }
__device__ __forceinline__ unsigned xb_xcc_id() { return (unsigned)__builtin_amdgcn_s_getreg((3 << 11) | 20) & 0xFu; }
#define XB_SPIN(cond, bar) do { unsigned _sp = 0; while (cond) { __builtin_amdgcn_s_sleep(1); \
    if ((++_sp & 255u) == 0u) { if (xb_ld(&(bar)[XB_TMO])) break; if (_sp > XB_SPIN_CAP) { atomicAdd(&(bar)[XB_TMO], 1u); break; } } } } while (0)

struct XcdBarrier {
    unsigned* bar; unsigned x;
    volatile LAS unsigned* st;
};

__device__ __forceinline__ XcdBarrier xcd_barrier_post(unsigned* bar, volatile LAS unsigned* st) {
    XcdBarrier b; b.bar = bar; b.x = xb_xcc_id(); b.st = st;
    if (threadIdx.x == 0) (void)xb_add(&bar[XB_XCNT(b.x)], 1u);
    return b;
}
__device__ __forceinline__ void xcd_barrier_complete(unsigned* bar, unsigned x, unsigned& nloc, unsigned& nx) {
    const unsigned G = gridDim.x * gridDim.y * gridDim.z;
    unsigned sum, cnt, mine, sp = 0u;
    for (;;) {
        sum = 0u; cnt = 0u; mine = 0u;
#pragma unroll
        for (unsigned j = 0; j < 16; ++j) { const unsigned c = xb_ld(&bar[XB_XCNT(j)]); sum += c; cnt += (c > 0u) ? 1u : 0u; mine = (j == x) ? c : mine; }
        if (sum == G) break;
        __builtin_amdgcn_s_sleep(1);
        if ((++sp & 255u) == 0u) { if (xb_ld(&bar[XB_TMO])) break; if (sp > XB_SPIN_CAP) { atomicAdd(&bar[XB_TMO], 1u); break; } }
    }
    nloc = mine > 0u ? mine : 1u; nx = cnt > 0u ? cnt : 1u;
}

__device__ __forceinline__ void xcd_barrier(const XcdBarrier& b) {
    asm volatile("s_waitcnt vmcnt(0)" ::: "memory");
    __syncthreads();
    if (threadIdx.x == 0) {
        unsigned* bar = b.bar;
        __builtin_amdgcn_s_waitcnt(0);
        unsigned nloc = b.st[0], nx = b.st[1];
        if (nloc == 0u) { xcd_barrier_complete(bar, b.x, nloc, nx); b.st[0] = nloc; b.st[1] = nx; }
        const unsigned old = xb_add(&bar[XB_XSUB(b.x)], 1u);
        const unsigned gen = old / nloc;
        if (old + 1u == (gen + 1u) * nloc) {
            __builtin_amdgcn_fence(__ATOMIC_RELEASE, "agent");
            asm volatile("s_waitcnt vmcnt(0)" ::: "memory");
            const unsigned og = xb_add(&bar[XB_TOP], 1u);
            const unsigned tg = og / nx;
            if (og + 1u == (tg + 1u) * nx) xb_add(&bar[XB_TOPGEN], 1u);
            else XB_SPIN(xb_ld(&bar[XB_TOPGEN]) == tg, bar);
            __builtin_amdgcn_fence(__ATOMIC_ACQUIRE, "agent");
            xb_add(&bar[XB_XGEN(b.x)], 1u);
            asm volatile("s_waitcnt vmcnt(0)" ::: "memory");
        } else {
            XB_SPIN(xb_ld(&bar[XB_XGEN(b.x)]) == gen, bar);
            __builtin_amdgcn_fence(__ATOMIC_ACQUIRE, "agent");
            asm volatile("s_waitcnt vmcnt(0)" ::: "memory");
        }
    }
    __syncthreads();
}

constexpr int CW_BAR = 4096;
constexpr int LDS_BARST = 147456;
constexpr size_t CTL_ZERO_BYTES = 65536;
constexpr int CW_PANEL = 8192;

#if (REP_MASK >> 2) & 1
#define SUBON2(bit) (rep == 0 || ((REP_SUB >> (bit)) & 1))
#else
#define SUBON2(bit) true
#endif
#if (REP_MASK >> 3) & 1
#define SUBON3(bit) (rep == 0 || ((REP_SUB >> (bit)) & 1))
#else
#define SUBON3(bit) true
#endif
#if (REP_MASK >> 4) & 1
#define SUBON4(bit) (rep == 0 || ((REP_SUB >> (bit)) & 1))
#else
#define SUBON4(bit) true
#endif
__global__ void __launch_bounds__(NTHREADS, 2) mega(Args a) {
    extern __shared__ __attribute__((aligned(16))) unsigned char lds[];
    cg::grid_group grid = cg::this_grid();
    const int wave = __builtin_amdgcn_readfirstlane(threadIdx.x >> 6);
#define MKLANE() ({ int l_; asm volatile("v_mbcnt_lo_u32_b32 %0, -1, 0\n\tv_mbcnt_hi_u32_b32 %0, -1, %0" : "=v"(l_)); l_; })
#define MKTID() (wave * 64 + MKLANE())
#define tid MKTID()
#define lane MKLANE()
    const int G = gridDim.x, bx = blockIdx.x;
    const int vcu = (G % 8 == 0) ? (bx % 8) * (G / 8) + bx / 8 : bx;
    const int gw = vcu * NWAVES + wave, NGW = G * NWAVES;
    unsigned char* ws = a.ws;
    const float* x = a.in[0]; const float* p = a.in[1]; const float* attn_norm = a.in[2]; const float* w_in = a.in[3]; const float* ret_norm = a.in[4]; const float* w_out = a.in[5];
    const float* ffn_norm = a.in[6]; const float* w_up = a.in[7]; const float* w_gate = a.in[8]; const float* conv_w = a.in[9]; const float* conv_b = a.in[10]; const float* w_down = a.in[11];
    const float* ple_norm = a.in[12]; const float* w_ple = a.in[13]; const float* w_ple_gate = a.in[14]; const float* final_norm = a.in[15];
    float* out = a.out;
    bf16_t* Win_t = (bf16_t*)(ws + WS_WIN); bf16_t* Wout_t = (bf16_t*)(ws + WS_WOUT); bf16_t* Wug_t = (bf16_t*)(ws + WS_WUG); bf16_t* Wdown_t = (bf16_t*)(ws + WS_WDOWN);
    bf16_t* Wpg_t = (bf16_t*)(ws + WS_WPG); bf16_t* Wple_t = (bf16_t*)(ws + WS_WPLE);
    bf16_t* XN = (bf16_t*)(ws + WS_R1); bf16_t* MIX = (bf16_t*)(ws + WS_SEG); bf16_t* PW = (bf16_t*)(ws + WS_R1);
    float* RS0 = (float*)(ws + WS_CNT + 768 * 1024);
    bf16_t* XB = (bf16_t*)(ws + WS_R2);
    bf16_t* PROJ = (bf16_t*)(ws + WS_PROJ); bf16_t* ACT = (bf16_t*)(ws + WS_PROJ);
    bf16_t* PB = (bf16_t*)(ws + WS_PB); float* RSQ = (float*)(ws + WS_RSQ);
    float* KM = (float*)(ws + WS_KMEAN);
    float* UL = (float*)(ws + WS_STASH); float* UF = UL + STASH_ELEMS; float* GF = UF + STASH_ELEMS;
    float* KVT = (float*)(ws + WS_KVT); bf16_t* STT = (bf16_t*)(ws + WS_STT); float* PART_L = (float*)(ws + WS_PARTL); bf16_t* PART_O = (bf16_t*)out;
    u32* SEL = (u32*)(ws + WS_SEL); unsigned short* SEG = (unsigned short*)(ws + WS_SEG); int* CNT = (int*)(ws + WS_CNT);

    const int lo = a.ph_lo, hi = a.ph_hi;
#if DIAG_K >= 0
    unsigned long long* dts = (unsigned long long*)(ws + WS_CTL + 49152);
#define DIAG_STAMP(i) do { if (bx == DIAG_BLOCK && wave == 0 && MKLANE() == 0) __hip_atomic_store(dts + (i), (unsigned long long)__builtin_amdgcn_s_memrealtime(), __ATOMIC_RELAXED, __HIP_MEMORY_SCOPE_AGENT); } while (0)
    DIAG_STAMP(0);
#define DIAG_DTS(it) ((bx == DIAG_BLOCK && (it) == bx) ? dts : (unsigned long long*)nullptr)
#else
#define DIAG_STAMP(i) do { } while (0)
#define DIAG_DTS(it) ((unsigned long long*)nullptr)
#endif
#define IN(k) (lo <= (k) && (k) < hi)
#define SEAM(k) do { if (IN(k) && IN((k) + 1)) { DIAG_STAMP(40 + (k)); if (a.ph_lo < 0) grid.sync(); else xcd_barrier(xbar); DIAG_STAMP(1 + (k)); } } while (0)
    { volatile LAS unsigned* st = (volatile LAS unsigned*)((LAS unsigned char*)lds + LDS_BARST); if (tid < 2) st[tid] = 0u; }
    __syncthreads();
    XcdBarrier xbar = xcd_barrier_post((unsigned*)(ws + WS_CTL) + CW_BAR, (volatile LAS unsigned*)((LAS unsigned char*)lds + LDS_BARST));

#if (REP_MASK >> 0) & 1
    for (int rep = 0; rep < 2; ++rep)
#endif
    if (IN(0)) {
        LAS float* scr = (LAS float*)(lds) + wave * (64 * 33);
        constexpr int I_IN = 16 * (NPROJ / 32), I_OUT = 16 * (DM / 32), I_UP = 16 * (FF / 32), I_DOWN = (FF / 64) * (DM / 32), I_PG = 16 * (DM / 32), I_PLE = (PLED / 64) * (DM / 32);
        constexpr int NITEMS = I_IN + I_OUT + 2 * I_UP + I_DOWN + I_PG + I_PLE;
        for (int it = gw; it < NITEMS; it += NGW) {
            int r = it;
            if (r < I_IN) { const int nb = r % (NPROJ / 32), kb = r / (NPROJ / 32); p0_transpose_item(w_in, DM, NPROJ, nullptr, Win_t, kb * 64, nb * 32, nb * 32, scr, lane); continue; } r -= I_IN;
            if (r < I_OUT) { const int nb = r % (DM / 32), kb = r / (DM / 32); p0_transpose_item(w_out, DM, DM, nullptr, Wout_t, kb * 64, nb * 32, nb * 32, scr, lane); continue; } r -= I_OUT;
            if (r < I_UP) { const int nb = r % (FF / 32), kb = r / (FF / 32), n0 = nb * 32; p0_transpose_item(w_up, DM, FF, ffn_norm, Wug_t, kb * 64, n0, (n0 >> 7) * 256 + (n0 & 127), scr, lane); continue; } r -= I_UP;
            if (r < I_UP) { const int nb = r % (FF / 32), kb = r / (FF / 32), n0 = nb * 32; p0_transpose_item(w_gate, DM, FF, ffn_norm, Wug_t, kb * 64, n0, (n0 >> 7) * 256 + 128 + (n0 & 127), scr, lane); continue; } r -= I_UP;
            if (r < I_DOWN) { const int nb = r % (DM / 32), kb = r / (DM / 32); p0_transpose_item(w_down, FF, DM, nullptr, Wdown_t, kb * 64, nb * 32, nb * 32, scr, lane); continue; } r -= I_DOWN;
            if (r < I_PG) { const int nb = r % (DM / 32), kb = r / (DM / 32); p0_transpose_item(w_ple_gate, DM, DM, ple_norm, Wpg_t, kb * 64, nb * 32, nb * 32, scr, lane); continue; } r -= I_PG;
            { const int nb = r % (DM / 32), kb = r / (DM / 32); p0_transpose_item(w_ple, PLED, DM, nullptr, Wple_t, kb * 64, nb * 32, nb * 32, scr, lane); }
        }
        DIAG_STAMP(12);
        for (int m = gw; m < MT; m += 2 * NGW) {
            const int m2 = m + NGW;
            const float4* xr = (const float4*)(x + (size_t)m * DM); const float4* xr2 = (const float4*)(x + (size_t)m2 * DM); float4 v[4], w[4]; float s = 0.f, s2 = 0.f;
#pragma unroll
            for (int j = 0; j < 4; ++j) { v[j] = nt_ld4(xr + lane + 64 * j); w[j] = nt_ld4(xr2 + lane + 64 * j); }
#pragma unroll
            for (int j = 0; j < 4; ++j) { s += v[j].x * v[j].x + v[j].y * v[j].y + v[j].z * v[j].z + v[j].w * v[j].w; s2 += w[j].x * w[j].x + w[j].y * w[j].y + w[j].z * w[j].z + w[j].w * w[j].w; }
            const float rs = rsqrtf(wave_sum(s) * (1.0f / DM) + RMS_EPS), rs2 = rsqrtf(wave_sum(s2) * (1.0f / DM) + RMS_EPS);
            if (lane == 0) { RS0[m] = rs; RS0[m2] = rs2; }
#pragma unroll
            for (int j = 0; j < 4; ++j) { const float4 gg = ((const float4*)attn_norm)[lane + 64 * j];
                ushort4 o; o.x = f2bf(v[j].x * rs * gg.x); o.y = f2bf(v[j].y * rs * gg.y); o.z = f2bf(v[j].z * rs * gg.z); o.w = f2bf(v[j].w * rs * gg.w);
                ((ushort4*)(XN + (size_t)m * DM))[lane + 64 * j] = o;
                ushort4 o2; o2.x = f2bf(w[j].x * rs2 * gg.x); o2.y = f2bf(w[j].y * rs2 * gg.y); o2.z = f2bf(w[j].z * rs2 * gg.z); o2.w = f2bf(w[j].w * rs2 * gg.w);
                ((ushort4*)(XN + (size_t)m2 * DM))[lane + 64 * j] = o2; }
        }
        DIAG_STAMP(13);
        { const size_t n4 = (size_t)MT * PLED / 4; const size_t gt = (size_t)vcu * NTHREADS + tid, GT = (size_t)G * NTHREADS;
          for (size_t i = gt; i < n4; i += GT) { const float4 v = nt_ld4((const float4*)p + i); ushort4 o; o.x = f2bf(v.x); o.y = f2bf(v.y); o.z = f2bf(v.z); o.w = f2bf(v.w); ((ushort4*)PB)[i] = o; }
          for (size_t i = gt; i < 16 * 64 * 64; i += GT) KM[i] = 0.f;
          if (gt < 64) ((int*)(ws + WS_CTL))[gt] = 0;
          for (size_t i = gt; i < 16 * 64 * 64; i += GT) CNT[i] = 0; }
    }
    SEAM(0);
#if (REP_MASK >> 1) & 1
    if (IN(1)) {
        pg8::Gemm g{XN, Win_t, MT, NPROJ, DM}; pg8::StaticOrder S; S.init(MT, NPROJ, G, bx);
        pg8::EpiProj E{PROJ, KM};
        pg8::gemm_phase<pg8::EpiProj, pg8::StaticOrder, true, true>((PG8_LAS unsigned char*)lds, g, S, E, MKTID());
    }
    asm volatile("" ::: "memory");
#endif
    if (IN(1)) {
        pg8::Gemm g{XN, Win_t, MT, NPROJ, DM}; pg8::StaticOrder S; S.init(MT, NPROJ, G, bx);
        pg8::EpiProj E{PROJ, KM};
        pg8::gemm_phase<pg8::EpiProj, pg8::StaticOrder, true, true>((PG8_LAS unsigned char*)lds, g, S, E, MKTID());
    }
    SEAM(1);
#if (REP_MASK >> 2) & 1
    { const int rep = 1; (void)rep;
    if (IN(2)) {
        mx::lds_ptr L = (mx::lds_ptr)lds;
        if (!(a.flags & 1) && SUBON2(0)) for (int it = bx; it < 512; it += G) mx::ret_kv_task(PROJ, it >> 6, it & 63, KVT, L, tid);
        if (!(a.flags & 2)) {
            if (SUBON2(1)) for (int it = bx; it < 16 * 63; it += G) mx::gate_task_mfma(it / 63, 1 + it % 63, PROJ, KM, SEL, SEG, CNT, L, tid);
            { const int gtid = vcu * NTHREADS + tid; if (gtid < BATCH * 256 * 8) { const int h = gtid & 7, t = (gtid >> 3) & 255, b = gtid >> 11; SEL[((size_t)b * SEQ + t) * 8 + h] = 0u; } }
        }
    }
    }
    asm volatile("" ::: "memory");
#endif
    { const int rep = 0; (void)rep;
    if (IN(2)) {
        mx::lds_ptr L = (mx::lds_ptr)lds;
        if (!(a.flags & 1) && SUBON2(0)) for (int it = bx; it < 512; it += G) mx::ret_kv_task(PROJ, it >> 6, it & 63, KVT, L, tid);
        DIAG_STAMP(14);
        if (!(a.flags & 2)) {
            if (SUBON2(1)) for (int it = bx; it < 16 * 63; it += G) mx::gate_task_mfma(it / 63, 1 + it % 63, PROJ, KM, SEL, SEG, CNT, L, tid);
        DIAG_STAMP(15);
            { const int gtid = vcu * NTHREADS + tid; if (gtid < BATCH * 256 * 8) { const int h = gtid & 7, t = (gtid >> 3) & 255, b = gtid >> 11; SEL[((size_t)b * SEQ + t) * 8 + h] = 0u; } }
        }
    }
    }
    SEAM(2);
#if (REP_MASK >> 3) & 1
#define QREP rep
#else
#define QREP 0
#endif
#if (REP_MASK >> 3) & 1
    for (int rep = 0; rep < 2; ++rep)
#endif
    if (IN(3)) {
        mx::lds_ptr L = (mx::lds_ptr)lds;
        if (!(a.flags & 1) && SUBON3(0)) mx::ret_scan(KVT, STT, (size_t)vcu * NTHREADS + tid, (size_t)G * NTHREADS);
        DIAG_STAMP(18);
        if (!(a.flags & 2) && SUBON3(1)) {
            LAS int* qslot = (LAS int*)(L + mx::L_PREF + 384);
            for (;;) {
                if (tid == 0) *qslot = atomicAdd((int*)(ws + WS_CTL) + QREP, 1);
                __syncthreads();
                const int q = *qslot;
                __syncthreads();
                if (q >= 16 * 63) break;
                mx::moba_sel_task(PROJ, SEG, CNT, q & 15, q >> 4, PART_O, PART_L, L, tid);
            }
        }
        DIAG_STAMP(19);
    }
    SEAM(3);
#if (REP_MASK >> 4) & 1
    { const int rep = 1; (void)rep;
    if (IN(4)) {
        mx::lds_ptr L = (mx::lds_ptr)lds;
        if (!(a.flags & 1) && SUBON4(0)) for (int it = bx; it < 512; it += G) mx::ret_out_task(PROJ, STT, ret_norm, MIX, it >> 6, it & 63, L, tid);
        if (!(a.flags & 2) && SUBON4(1)) for (int it = bx; it < 16 * 64; it += G) mx::moba_diag_unit(PROJ, it >> 6, it & 63, PART_O, PART_L, SEL, MIX, L, tid);
    }
    }
    asm volatile("" ::: "memory");
#endif
    { const int rep = 0; (void)rep;
    if (IN(4)) {
        mx::lds_ptr L = (mx::lds_ptr)lds;
        if (vcu & 1) for (int it = bx; it < 16 * 64; it += G) mx::moba_diag_unit(PROJ, it >> 6, it & 63, PART_O, PART_L, SEL, MIX, L, tid);
        for (int it = bx; it < 512; it += G) mx::ret_out_task(PROJ, STT, ret_norm, MIX, it >> 6, it & 63, L, tid, DIAG_DTS(it));
        DIAG_STAMP(16);
        if (!(vcu & 1)) for (int it = bx; it < 16 * 64; it += G) mx::moba_diag_unit(PROJ, it >> 6, it & 63, PART_O, PART_L, SEL, MIX, L, tid);
        DIAG_STAMP(17);
    }
    }
    SEAM(4);
#if (REP_MASK >> 5) & 1
    if (IN(5)) {
        pg8::Gemm g{MIX, Wout_t, MT, DM, DM}; pg8::StaticOrder S; S.init(MT, DM, G, bx);
        pg8::EpiRes<false> E{x, XB, RSQ};
        pg8::gemm_phase<pg8::EpiRes<false>, pg8::StaticOrder, true, true>((PG8_LAS unsigned char*)lds, g, S, E, MKTID());
    }
    asm volatile("" ::: "memory");
#endif
    if (IN(5)) {
        pg8::Gemm g{MIX, Wout_t, MT, DM, DM}; pg8::StaticOrder S; S.init(MT, DM, G, bx);
        pg8::EpiResXN E{XN, RS0, attn_norm, XB, RSQ};
        pg8::gemm_phase<pg8::EpiResXN, pg8::StaticOrder, true, true>((PG8_LAS unsigned char*)lds, g, S, E, MKTID());
    }
    SEAM(5);
#if (REP_MASK >> 6) & 1
    if (IN(6)) {
        pg8::Gemm g{XB, Wug_t, MT, 2 * FF, DM}; pg8::StaticOrder S; S.init(MT, 2 * FF, G, bx);
        pg8::EpiUG E{ACT, RSQ, conv_w, conv_b, UL, UF, GF};
        pg8::gemm_phase<pg8::EpiUG, pg8::StaticOrder, true, true>((PG8_LAS unsigned char*)lds, g, S, E, MKTID());
    }
    asm volatile("" ::: "memory");
#endif
    if (IN(6)) {
        pg8::Gemm g{XB, Wug_t, MT, 2 * FF, DM}; pg8::StaticOrder S; S.init(MT, 2 * FF, G, bx);
        pg8::EpiUG E{ACT, RSQ, conv_w, conv_b, UL, UF, GF};
        pg8::gemm_phase<pg8::EpiUG, pg8::StaticOrder, true, true>((PG8_LAS unsigned char*)lds, g, S, E, MKTID());
    }
    SEAM(6);
#if (REP_MASK >> 7) & 1
    for (int rep = 0; rep < 2; ++rep)
#endif
    if (IN(7)) {
        const size_t gt = (size_t)vcu * NTHREADS + tid, GT = (size_t)G * NTHREADS;
        for (size_t i = gt; i < (size_t)512 * 2 * (FF / 4); i += GT) {
            const int c = (int)(i % (FF / 4)) * 4, r = (int)((i / (FF / 4)) & 1), g64 = (int)(i / (FF / 4) / 2);
            const bool first = (g64 & 255) == 0; const size_t pg = first ? 0 : (size_t)(g64 - 1);
            const pg8::f32x4 q0 = *(const pg8::f32x4*)(UL + (pg * 2 + 0) * FF + c), q1 = *(const pg8::f32x4*)(UL + (pg * 2 + 1) * FF + c);
            const pg8::f32x4 f0 = *(const pg8::f32x4*)(UF + ((size_t)g64 * 2 + 0) * FF + c), f1 = *(const pg8::f32x4*)(UF + ((size_t)g64 * 2 + 1) * FF + c);
            const pg8::f32x4 gg = *(const pg8::f32x4*)(GF + ((size_t)g64 * 2 + r) * FF + c);
            const pg8::f32x4 w0 = *(const pg8::f32x4*)(conv_w + c), w1 = *(const pg8::f32x4*)(conv_w + FF + c), w2 = *(const pg8::f32x4*)(conv_w + 2 * FF + c), cb = *(const pg8::f32x4*)(conv_b + c);
            const float z = first ? 0.f : 1.f;
            const pg8::f32x4 p0 = q0 * z, p1 = q1 * z;
            const pg8::f32x4 u2 = r == 0 ? p0 : p1, u1 = r == 0 ? p1 : f0, u0 = r == 0 ? f0 : f1;
            const pg8::f32x4 y = cb + w0 * u2 + w1 * u1 + w2 * u0;
            ushort4 o; o.x = f2bf(gelu_tanh(y[0]) * gg[0]); o.y = f2bf(gelu_tanh(y[1]) * gg[1]); o.z = f2bf(gelu_tanh(y[2]) * gg[2]); o.w = f2bf(gelu_tanh(y[3]) * gg[3]);
            *(ushort4*)(ACT + ((size_t)g64 * 64 + r) * FF + c) = o;
        }
        { int kk = PLED; asm volatile("" : "+s"(kk)); pg8::Gemm g{PB, Wple_t, MT, DM, kk}; pg8::StaticOrder S; S.init(MT, DM, G, bx); pg8::EpiStore E{PW};
          pg8::gemm_phase<pg8::EpiStore, pg8::StaticOrder, true, true>((PG8_LAS unsigned char*)lds, g, S, E, MKTID()); }
    }
    SEAM(7);
#if (REP_MASK >> 8) & 1
    if (IN(8)) {
        pg8::Gemm g{ACT, Wdown_t, MT, DM, FF}; pg8::StaticOrder S; S.init(MT, DM, G, bx);
        pg8::EpiRes<true, false> E{nullptr, XB, RSQ + (size_t)MT * 16};
        pg8::gemm_phase<pg8::EpiRes<true, false>, pg8::StaticOrder, true, true>((PG8_LAS unsigned char*)lds, g, S, E, MKTID());
    }
    asm volatile("" ::: "memory");
#endif
    if (IN(8)) {
        pg8::Gemm g{ACT, Wdown_t, MT, DM, FF}; pg8::StaticOrder S; S.init(MT, DM, G, bx);
        pg8::EpiRes<true> E{nullptr, XB, RSQ + (size_t)MT * 16};
        pg8::gemm_phase<pg8::EpiRes<true>, pg8::StaticOrder, true, true>((PG8_LAS unsigned char*)lds, g, S, E, MKTID());
    }
    SEAM(8);
#if (REP_MASK >> 9) & 1
    if (IN(9)) {
        if (REP_SUB & 1) { int kk = PLED; asm volatile("" : "+s"(kk)); pg8::Gemm g{PB, Wple_t, MT, DM, kk}; pg8::StaticOrder S; S.init(MT, DM, G, bx); pg8::EpiStore E{PW};
          pg8::gemm_phase<pg8::EpiStore, pg8::StaticOrder, true, true>((PG8_LAS unsigned char*)lds, g, S, E, MKTID()); }
        if (REP_SUB & 2) { int kk = DM; const bf16_t* a_ = XB; const bf16_t* b_ = Wpg_t; asm volatile("" : "+s"(kk), "+s"(a_), "+s"(b_) :: "memory"); pg8::Gemm g{a_, b_, MT, DM, kk}; pg8::StaticOrder S; S.init(MT, DM, G, bx); pg8::EpiPleNorm E{out, XB, PW, RSQ + (size_t)MT * 16, RSQ + (size_t)2 * MT * 16, (unsigned*)(ws + WS_CTL) + CW_PANEL, final_norm, DIAG_DTS(bx)};
          pg8::gemm_phase<pg8::EpiPleNorm, pg8::StaticOrder, true, true>((PG8_LAS unsigned char*)lds, g, S, E, MKTID()); }
    }
    asm volatile("" ::: "memory");
#endif
    if (IN(9)) {
        DIAG_STAMP(20);
        { int kk = DM; const bf16_t* a_ = XB; const bf16_t* b_ = Wpg_t; asm volatile("" : "+s"(kk), "+s"(a_), "+s"(b_) :: "memory"); pg8::Gemm g{a_, b_, MT, DM, kk}; pg8::StaticOrder S; S.init(MT, DM, G, bx); pg8::EpiPleNorm E{out, XB, PW, RSQ + (size_t)MT * 16, RSQ + (size_t)2 * MT * 16, (unsigned*)(ws + WS_CTL) + CW_PANEL, final_norm, DIAG_DTS(bx)};
          pg8::gemm_phase<pg8::EpiPleNorm, pg8::StaticOrder, true, true>((PG8_LAS unsigned char*)lds, g, S, E, MKTID()); }
    }
    SEAM(9);
    if (IN(10)) {
        const float* rsq = RSQ + (size_t)2 * MT * 16;
        for (int m = gw; m < MT; m += NGW) {
            const float rs = pg8::rs16(rsq + (size_t)m * 16); float4* xr = (float4*)(out + (size_t)m * DM);
#pragma unroll
            for (int j = 0; j < 4; ++j) { float4 v = xr[lane + 64 * j]; const float4 gg = ((const float4*)final_norm)[lane + 64 * j];
                v.x *= rs * gg.x; v.y *= rs * gg.y; v.z *= rs * gg.z; v.w *= rs * gg.w; xr[lane + 64 * j] = v; }
        }
    }
#if DIAG_K >= 0
    xcd_barrier(xbar); DIAG_STAMP(11);
    xcd_barrier(xbar);
    { const unsigned long long t0 = __hip_atomic_load(dts + 0, __ATOMIC_RELAXED, __HIP_MEMORY_SCOPE_AGENT), t1 = __hip_atomic_load(dts + 11, __ATOMIC_RELAXED, __HIP_MEMORY_SCOPE_AGENT);
      const unsigned long long ta = __hip_atomic_load(dts + (DIAG_K == 99 ? DIAG_A : DIAG_K), __ATOMIC_RELAXED, __HIP_MEMORY_SCOPE_AGENT), tb = DIAG_K == 99 ? __hip_atomic_load(dts + DIAG_B, __ATOMIC_RELAXED, __HIP_MEMORY_SCOPE_AGENT) : (DIAG_K == 9 ? t1 : __hip_atomic_load(dts + DIAG_K + 1, __ATOMIC_RELAXED, __HIP_MEMORY_SCOPE_AGENT));
      const float eps = (float)(tb - ta) / (float)(t1 - t0);
      const float sc = 1.0f + DIAG_SCALE * eps;
      float4* o4 = (float4*)out; const size_t gt = (size_t)vcu * NTHREADS + tid, GT = (size_t)G * NTHREADS;
      for (size_t i = gt; i < (size_t)MT * DM / 4; i += GT) { float4 v = o4[i]; v.x *= sc; v.y *= sc; v.z *= sc; v.w *= sc; o4[i] = v; } }
#endif
#undef IN
#undef SEAM
#undef tid
#undef lane
}

#ifndef BUILD_MODE
#define BUILD_MODE 0
#endif
static int g_grid = 0;
static void launch_mega(Args a, int lo, int hi, hipStream_t stream) {
    a.ph_lo = lo; a.ph_hi = hi; void* args[] = {&a};
    hipError_t e = hipLaunchCooperativeKernel((const void*)mega, dim3(g_grid), dim3(NTHREADS), args, LDS_BYTES, stream);
    if (e != hipSuccess) fprintf(stderr, "cooperative launch [%d,%d) failed: %s (grid %d)\n", lo, hi, hipGetErrorString(e), g_grid);
}
extern "C" void kernel_launch(void* const* d_in, const int* in_sizes, int n_in, void* d_out, int out_size, void* d_ws, size_t ws_size, hipStream_t stream) {
    if (n_in != 16 || out_size != MT * DM || ws_size < WS_END) { fprintf(stderr, "kernel_launch: unexpected shapes (n_in %d out %d ws %zu)\n", n_in, out_size, ws_size); return; }
    if (g_grid == 0) {
        int dev = 0, cus = 0, per_cu = 0;
        hipGetDevice(&dev); hipDeviceGetAttribute(&cus, hipDeviceAttributeMultiprocessorCount, dev);
        hipFuncSetAttribute((const void*)mega, hipFuncAttributeMaxDynamicSharedMemorySize, LDS_BYTES);
        hipOccupancyMaxActiveBlocksPerMultiprocessor(&per_cu, (const void*)mega, NTHREADS, LDS_BYTES);
        if (per_cu < 1) { fprintf(stderr, "occupancy query says %d blocks/CU\n", per_cu); per_cu = 1; }
        g_grid = cus * 1;
        (void)hipGetLastError();
    }
    unsigned char* ws = (unsigned char*)d_ws;
    hipMemsetAsync(ws + WS_CTL, 0, CTL_ZERO_BYTES, stream);
    Args a{}; for (int i = 0; i < 16; ++i) a.in[i] = (const float*)d_in[i]; a.out = (float*)d_out; a.ws = ws;

    a.flags = 0; launch_mega(a, 0, NPH, stream);
}
```

```cpp
#include <hip/hip_runtime.h>
#include <stdint.h>
#include <math.h>
#include <cstdio>

typedef unsigned short bf16_t;
typedef unsigned int u32;

constexpr int BATCH = 2, SEQ = 16384, MT = BATCH * SEQ, DM = 1024, NPROJ = 3584, FF = 2816, PLED = 256;
constexpr int MH = 8, MD = 64, RH = 4, RD = 128, NBLK = 64, BLK = 256;
constexpr int C_MQ = 0, C_MK = 512, C_MV = 1024, C_RQ = 1536, C_RK = 2048, C_RV = 2560, C_RG = 3072;
constexpr float RMS_EPS = 1e-6f, GN_EPS = 1e-5f;
constexpr float LOG2E = 1.4426950408889634f;
constexpr float QSCALE = 0.125f * LOG2E;
constexpr float RKSCALE = 0.08838834764831845f;
constexpr size_t SEC = (size_t)MT * 512;

constexpr size_t MiB = (size_t)1 << 20;
constexpr size_t WS_CTL = 0, WS_WIN = 1 * MiB, WS_WOUT = 8 * MiB, WS_WUG = 10 * MiB, WS_WDOWN = 21 * MiB, WS_WPG = 27 * MiB, WS_WPLE = 29 * MiB;
constexpr size_t WS_RSQ = 30 * MiB;
constexpr size_t WS_PB = 36 * MiB;
constexpr size_t WS_R2 = 52 * MiB;
constexpr size_t WS_R1 = 116 * MiB;
constexpr size_t WS_SEG = 180 * MiB;
constexpr size_t WS_KVT = 212 * MiB;
constexpr size_t WS_STT = 244 * MiB;
constexpr size_t WS_PARTL = 260 * MiB;
constexpr size_t WS_SEL = 264 * MiB;
constexpr size_t WS_CNT = 265 * MiB;
constexpr size_t WS_KMEAN = WS_CNT + 512 * 1024;
constexpr size_t WS_PROJ = 266 * MiB;
constexpr size_t WS_END = 490 * MiB;
constexpr size_t WS_UH = 116 * MiB;

__device__ __forceinline__ float bf2f(bf16_t v) { return __uint_as_float(((u32)v) << 16); }
__device__ __forceinline__ bf16_t f2bf(float f) { u32 u = __float_as_uint(f); return (bf16_t)((u + 0x7fffu + ((u >> 16) & 1u)) >> 16); }
__device__ __forceinline__ float wave_sum(float v) {
#pragma unroll
    for (int o = 1; o < 64; o <<= 1) v += __shfl_xor(v, o);
    return v;
}
__device__ __forceinline__ float rs_from(const float* p) {
    float s = 0.f;
#pragma unroll
    for (int i = 0; i < 16; ++i) s += p[i];
    return rsqrtf(s * (1.0f / DM) + RMS_EPS);
}
__device__ __forceinline__ float gelu_tanh(float x) {
    const float z = 0.7978845608028654f * (x + 0.044715f * x * x * x);
    return x / (1.0f + __expf(-2.0f * z));
}
__device__ __forceinline__ float sigmoidf_(float x) { return 1.0f / (1.0f + __expf(-x)); }


typedef unsigned u32x4_g __attribute__((ext_vector_type(4)));
__device__ __forceinline__ void wt_store16(void* base_uniform, size_t byte_off, u32x4_g v) {
    __builtin_amdgcn_raw_buffer_store_b128(v, __builtin_amdgcn_make_buffer_rsrc(base_uniform, 0, 0x7ffffff0, 0x00020000), (int)byte_off, 0, 16);
}
namespace pg8 {
#define PG8_LAS __attribute__((address_space(3)))
typedef unsigned short bf16_t;
typedef short bf16x8 __attribute__((ext_vector_type(8)));
typedef float f32x4 __attribute__((ext_vector_type(4)));
typedef unsigned u32x4 __attribute__((ext_vector_type(4)));
constexpr int BM = 256, BK = 64, HALF = 128, HTB = HALF * BK * 2  , STAGE_BYTES = 8 * HTB, NXCD = 8, WGM = 8;

__host__ __device__ __forceinline__ int lds_byte(int r, int c) { const int st = (r >> 4) * 2 + (c >> 5), rr = r & 15, cc = c & 31, ob = rr * 64 + cc * 2; return st * 1024 + (ob ^ (((ob >> 9) & 1) << 5)); }
__host__ __device__ __forceinline__ void stage_rc(int b, int& R, int& C) { const int st = b / 1024, sb = b % 1024, swz = sb ^ (((sb >> 9) & 1) << 5); R = (st >> 1) * 16 + swz / 64; C = (st & 1) * 32 + (swz % 64) / 2; }
__host__ __device__ __forceinline__ int perm32(int rho) { const int n = rho >> 4, i = rho & 15; return 8 * (i >> 2) + 4 * n + (i & 3); }

struct Unit { int pm, pn; };
struct Gemm { const bf16_t* A; const bf16_t* Bt; int M, N, K; };

struct StaticOrder {
    int nM, nN, nwg, G, c;
    __host__ __device__ void init(int M, int N, int G_, int c_) { nM = M / BM; nN = N / BM; nwg = nM * nN; G = G_; c = c_; }
    __host__ __device__ bool next(int i, Unit& u) const {
        const long L = (long)i * G + c; if (L >= nwg) return false;
        int wgid = (int)L; { const int q = nwg / NXCD, r = nwg % NXCD, xcd = wgid % NXCD, off = wgid / NXCD; wgid = (xcd < r ? xcd * (q + 1) : r * (q + 1) + (xcd - r) * q) + off; }
        const int nig = WGM * nN, gid = wgid / nig, fm = gid * WGM, gsz = (nM - fm) < WGM ? (nM - fm) : WGM;
        u.pm = fm + ((wgid % nig) % gsz); u.pn = (wgid % nig) / gsz; return true;
    }
    __device__ __forceinline__ void a_ready(const Unit&) const {}
    __device__ __forceinline__ void done(const Unit&) const {}
};

__device__ __forceinline__ unsigned cvt_pk_bf16(float lo, float hi) { unsigned r; asm volatile("v_cvt_pk_bf16_f32 %0, %1, %2" : "=v"(r) : "v"(lo), "v"(hi)); return r; }
typedef float f32x2 __attribute__((ext_vector_type(2)));
template <class Epi, class Sched, bool ALIGN_EPI = false, bool SP2 = false>
__device__ __forceinline__ void gemm_phase(PG8_LAS unsigned char* lds, const Gemm g, const Sched& S, const Epi& E, const int tid_in) {
    const int tid = tid_in, wid = __builtin_amdgcn_readfirstlane(tid >> 6), lane = tid & 63, wr = wid >> 2, wc = wid & 3, fr = lane & 15, fq = lane >> 4;
    const int K = g.K, nt = K / BK;
    unsigned voffA[2], voffB[2];
#pragma unroll
    for (int i = 0; i < 2; ++i) { int R, C; stage_rc(tid * 16 + i * 8192, R, C); const int Rb = Epi::PERM ? ((R & ~31) + perm32(R & 31)) : R;
        voffA[i] = (unsigned)(R * K + C) * 2u; voffB[i] = (unsigned)(Rb * K + C) * 2u; }
    const size_t kstep = (size_t)(BK * 2);
    const size_t hstep = (size_t)HALF * K * 2;
    const size_t tstep = 2 * hstep;
    const unsigned ldsw = (unsigned)wid * 1024u;
    const int aoff = lds_byte(wr * 64 + fr, fq * 8), boff = lds_byte(wc * 32 + fr, fq * 8);
#define PG8_SA(b, h) (((b) * 2 + (h)) * HTB)
#define PG8_SB(b, h) ((4 + (b) * 2 + (h)) * HTB)
#define PG8_STAGE(bufoff, gbase, voff) do { _Pragma("unroll") for (int _i = 0; _i < 2; ++_i) \
        __builtin_amdgcn_global_load_lds((const unsigned*)((const char*)(gbase) + (voff)[_i]), (PG8_LAS unsigned*)(lds + (bufoff) + ldsw + _i * 8192), 16, 0, 0); } while (0)
#define PG8_LDA(dst, b, h) do { _Pragma("unroll") for (int m = 0; m < 4; ++m) _Pragma("unroll") for (int k = 0; k < 2; ++k) dst[m][k] = *(const PG8_LAS bf16x8*)(lds + PG8_SA(b, h) + aoff + m * 2048 + k * 1024); } while (0)
#define PG8_LDB(dst, b, h) do { _Pragma("unroll") for (int n = 0; n < 2; ++n) _Pragma("unroll") for (int k = 0; k < 2; ++k) dst[n][k] = *(const PG8_LAS bf16x8*)(lds + PG8_SB(b, h) + boff + n * 2048 + k * 1024); } while (0)
#define PG8_MMA(ai, bj, At, Bt) do { __builtin_amdgcn_s_setprio(1); _Pragma("unroll") for (int m = 0; m < 4; ++m) _Pragma("unroll") for (int n = 0; n < 2; ++n) _Pragma("unroll") for (int k = 0; k < 2; ++k) \
        acc[ai][bj][m][n] = __builtin_amdgcn_mfma_f32_16x16x32_bf16(Bt[n][k], At[m][k], acc[ai][bj][m][n], 0, 0, 0); __builtin_amdgcn_s_setprio(0); } while (0)
#define PG8_WAIT_V(n) asm volatile("s_waitcnt vmcnt(" #n ")" ::: "memory")
#define PG8_WAIT_L(n) asm volatile("s_waitcnt lgkmcnt(" #n ")" ::: "memory")
#define PG8_BAR __builtin_amdgcn_s_barrier()
#define PG8_SCHED __builtin_amdgcn_sched_barrier(0)
    Unit cur, nxt; int ui = 0;
    if (!S.next(0, cur)) return;
    f32x4 acc[2][2][4][2];
#pragma unroll
    for (int a = 0; a < 2; ++a)
#pragma unroll
        for (int b = 0; b < 2; ++b)
#pragma unroll
            for (int m = 0; m < 4; ++m)
#pragma unroll
                for (int n = 0; n < 2; ++n) acc[a][b][m][n] = (f32x4){0.f, 0.f, 0.f, 0.f};
    bf16x8 At[4][2], B0[2][2], B1[2][2];
    const char* cA = (const char*)g.A + (size_t)cur.pm * tstep; const char* cB = (const char*)g.Bt + (size_t)cur.pn * tstep;
    S.a_ready(cur);
    if constexpr (SP2) {
        PG8_STAGE(PG8_SB(0, 0), cB, voffB); PG8_STAGE(PG8_SB(0, 1), cB + hstep, voffB); PG8_STAGE(PG8_SA(0, 0), cA, voffA); PG8_STAGE(PG8_SA(0, 1), cA + hstep, voffA);
        if (wr == 1) PG8_BAR;
        PG8_WAIT_V(2); PG8_BAR;
        PG8_STAGE(PG8_SB(1, 0), cB + kstep, voffB); PG8_STAGE(PG8_SA(1, 0), cA + kstep, voffA); PG8_STAGE(PG8_SB(1, 1), cB + hstep + kstep, voffB);
        PG8_WAIT_V(6); PG8_BAR;
    } else {
        PG8_STAGE(PG8_SB(0, 0), cB, voffB); PG8_STAGE(PG8_SA(0, 0), cA, voffA); PG8_STAGE(PG8_SB(0, 1), cB + hstep, voffB); PG8_STAGE(PG8_SA(0, 1), cA + hstep, voffA);
        if (wr == 1) PG8_BAR;
        PG8_WAIT_V(4); PG8_BAR;
        PG8_STAGE(PG8_SB(1, 0), cB + kstep, voffB); PG8_STAGE(PG8_SA(1, 0), cA + kstep, voffA); PG8_STAGE(PG8_SB(1, 1), cB + hstep + kstep, voffB);
        PG8_WAIT_V(6); PG8_BAR;
    }
    for (;;) {
        const bool has_next = S.next(ui + 1, nxt);
        const char* nA = has_next ? (const char*)g.A + (size_t)nxt.pm * tstep : cA; const char* nB = has_next ? (const char*)g.Bt + (size_t)nxt.pn * tstep : cB;
        for (int t = 0; t < nt; t += 2) {
            const bool last = (t == nt - 2);
            const char* a1 = cA + (size_t)(t + 1) * kstep;
            const char* a2 = last ? nA : cA + (size_t)(t + 2) * kstep; const char* b2 = last ? nB : cB + (size_t)(t + 2) * kstep;
            const char* a3 = a2 + kstep; const char* b3 = b2 + kstep;
            if (last && has_next) S.a_ready(nxt);
            if constexpr (SP2) {
            PG8_LDB(B0, 0, 0); PG8_LDB(B1, 0, 1); PG8_SCHED; PG8_LDA(At, 0, 0); PG8_STAGE(PG8_SA(1, 1), a1 + hstep, voffA);
            PG8_WAIT_V(8); PG8_WAIT_L(0); PG8_BAR; PG8_MMA(0, 0, At, B0); PG8_MMA(0, 1, At, B1); PG8_BAR; PG8_SCHED;
            PG8_LDA(At, 0, 1); PG8_STAGE(PG8_SB(0, 0), b2, voffB); PG8_STAGE(PG8_SB(0, 1), b2 + hstep, voffB); PG8_STAGE(PG8_SA(0, 0), a2, voffA);
            PG8_WAIT_V(8); PG8_WAIT_L(0); PG8_BAR; PG8_MMA(1, 0, At, B0); PG8_MMA(1, 1, At, B1); PG8_BAR; PG8_SCHED;
            PG8_LDB(B0, 1, 0); PG8_LDB(B1, 1, 1); PG8_SCHED; PG8_LDA(At, 1, 0); PG8_STAGE(PG8_SA(0, 1), a2 + hstep, voffA);
            PG8_WAIT_V(8); PG8_WAIT_L(0); PG8_BAR; PG8_MMA(0, 0, At, B0); PG8_MMA(0, 1, At, B1); PG8_BAR; PG8_SCHED;
            PG8_LDA(At, 1, 1); PG8_STAGE(PG8_SB(1, 0), b3, voffB); PG8_STAGE(PG8_SB(1, 1), b3 + hstep, voffB); PG8_STAGE(PG8_SA(1, 0), a3, voffA);
            PG8_WAIT_V(8); PG8_WAIT_L(0); PG8_BAR; PG8_MMA(1, 0, At, B0); PG8_MMA(1, 1, At, B1); PG8_BAR; PG8_SCHED;
            } else {
            PG8_LDB(B0, 0, 0); PG8_SCHED; PG8_LDA(At, 0, 0); PG8_STAGE(PG8_SA(1, 1), a1 + hstep, voffA);
            PG8_WAIT_L(8); PG8_BAR; PG8_WAIT_L(0); PG8_MMA(0, 0, At, B0); PG8_BAR; PG8_SCHED;
            PG8_LDB(B1, 0, 1); PG8_STAGE(PG8_SB(0, 0), b2, voffB);
            PG8_BAR; PG8_WAIT_L(0); PG8_MMA(0, 1, At, B1); PG8_BAR;
            PG8_LDA(At, 0, 1); PG8_STAGE(PG8_SA(0, 0), a2, voffA);
            PG8_BAR; PG8_WAIT_L(0); PG8_MMA(1, 0, At, B0); PG8_BAR; PG8_SCHED;
            PG8_STAGE(PG8_SB(0, 1), b2 + hstep, voffB);
            PG8_WAIT_V(6); PG8_BAR; PG8_MMA(1, 1, At, B1); PG8_BAR;
            PG8_LDB(B0, 1, 0); PG8_SCHED; PG8_LDA(At, 1, 0); PG8_STAGE(PG8_SA(0, 1), a2 + hstep, voffA);
            PG8_WAIT_L(8); PG8_BAR; PG8_WAIT_L(0); PG8_MMA(0, 0, At, B0); PG8_BAR; PG8_SCHED;
            PG8_LDB(B1, 1, 1); PG8_STAGE(PG8_SB(1, 0), b3, voffB);
            PG8_BAR; PG8_WAIT_L(0); PG8_MMA(0, 1, At, B1); PG8_BAR;
            PG8_LDA(At, 1, 1); PG8_STAGE(PG8_SA(1, 0), a3, voffA);
            PG8_BAR; PG8_WAIT_L(0); PG8_MMA(1, 0, At, B0); PG8_BAR; PG8_SCHED;
            PG8_STAGE(PG8_SB(1, 1), b3 + hstep, voffB);
            PG8_WAIT_V(6); PG8_BAR; PG8_MMA(1, 1, At, B1); PG8_BAR;
            }
        }
        if constexpr (ALIGN_EPI) { if (wr == 0) PG8_BAR; }
        if constexpr (!Epi::AFTER_DRAIN) { E(acc, cur, wr, wc, fr, fq); S.done(cur); }
        if (!has_next) break;
#pragma unroll
        for (int a = 0; a < 2; ++a)
#pragma unroll
            for (int b = 0; b < 2; ++b)
#pragma unroll
                for (int m = 0; m < 4; ++m)
#pragma unroll
                    for (int n = 0; n < 2; ++n) acc[a][b][m][n] = (f32x4){0.f, 0.f, 0.f, 0.f};
        cur = nxt; cA = nA; cB = nB; ++ui;
        if constexpr (ALIGN_EPI) { if (wr == 1) PG8_BAR; }
    }
    PG8_WAIT_V(0);
    if constexpr (!ALIGN_EPI) { if (wr == 0) PG8_BAR; }
    PG8_BAR;
    if constexpr (Epi::AFTER_DRAIN) { E.fused(acc, cur, wr, wc, fr, fq, lds, wid, lane); S.done(cur); }
#undef PG8_SA
#undef PG8_SB
#undef PG8_STAGE
#undef PG8_LDA
#undef PG8_LDB
#undef PG8_MMA
#undef PG8_WAIT_V
#undef PG8_WAIT_L
#undef PG8_BAR
#undef PG8_SCHED
}
}
namespace pg8 {
__device__ __forceinline__ u32x4 pack8(f32x4 v0, f32x4 v1) { u32x4 w; w.x = cvt_pk_bf16(v0[0], v0[1]); w.y = cvt_pk_bf16(v0[2], v0[3]); w.z = cvt_pk_bf16(v1[0], v1[1]); w.w = cvt_pk_bf16(v1[2], v1[3]); return w; }
__device__ __forceinline__ float dot4(f32x4 a) { return (a[0] * a[0] + a[1] * a[1]) + (a[2] * a[2] + a[3] * a[3]); }
__device__ __forceinline__ float rs16(const float* p) { const f32x4 a = *(const f32x4*)p, b = *(const f32x4*)(p + 4), c = *(const f32x4*)(p + 8), d = *(const f32x4*)(p + 12);
    const float s = ((a[0] + a[1]) + (a[2] + a[3])) + ((b[0] + b[1]) + (b[2] + b[3])) + ((c[0] + c[1]) + (c[2] + c[3])) + ((d[0] + d[1]) + (d[2] + d[3])); return rsqrtf(s * (1.0f / DM) + RMS_EPS); }

__device__ __forceinline__ float frcp(float x) { return __builtin_amdgcn_rcpf(x); }
__device__ __forceinline__ float fsigmoid(float x) { return frcp(1.0f + __builtin_amdgcn_exp2f(-1.4426950408889634f * x)); }
__device__ __forceinline__ float gelu_fast(float x) { const float z2 = 2.302208198f * (x + 0.044715f * x * x * x); return x * frcp(1.0f + __builtin_amdgcn_exp2f(-z2)); }
__device__ __forceinline__ void rs8(const float* rsq, int row0, int fq, float (&rs)[2][4]) {
    f32x4 pv[2][4];
#pragma unroll
    for (int ai = 0; ai < 2; ++ai)
#pragma unroll
        for (int m = 0; m < 4; ++m) pv[ai][m] = *(const f32x4*)(rsq + (size_t)(row0 + ai * HALF + m * 16) * 16 + 4 * fq);
#pragma unroll
    for (int ai = 0; ai < 2; ++ai)
#pragma unroll
        for (int m = 0; m < 4; ++m) { float s = (pv[ai][m][0] + pv[ai][m][1]) + (pv[ai][m][2] + pv[ai][m][3]); s += __shfl_xor(s, 16); s += __shfl_xor(s, 32); rs[ai][m] = rsqrtf(s * (1.0f / DM) + RMS_EPS); }
}
#define DPP_ROT(src, ctrl) __uint_as_float((unsigned)__builtin_amdgcn_mov_dpp((int)__float_as_uint(src), (ctrl), 0xF, 0xF, true))
#define DPP_MOV(old, src, ctrl) __uint_as_float((unsigned)__builtin_amdgcn_update_dpp((int)__float_as_uint(old), (int)__float_as_uint(src), (ctrl), 0xF, 0xF, false))

struct EpiProj {
    static constexpr bool PERM = true, AFTER_DRAIN = false;
    bf16_t* O; float* kmsum;
    __device__ __forceinline__ void operator()(const f32x4 (&acc)[2][2][4][2], const Unit& u, int wr, int wc, int fr, int fq) const {
        const int colt = u.pn * BM;
        const float sc = colt < C_MK ? QSCALE : ((colt >= C_RK && colt < C_RV) ? RKSCALE : 1.0f);
        const int row0 = u.pm * BM + wr * 64 + fr, sec = colt >> 9, b = u.pm >> 6;
        bf16_t* sbase = O + (size_t)sec * SEC;
#pragma unroll
        for (int bj = 0; bj < 2; ++bj) { const int c = (colt & 511) + bj * HALF + wc * 32 + 8 * fq;
            bf16_t* hb = sec < 3 ? sbase + ((size_t)(b * 8 + (c >> 6)) * SEQ) * 64 + (c & 63) : sbase + ((size_t)(b * 4 + (c >> 7)) * SEQ) * 128 + (c & 127);
            const int pitch = sec < 3 ? 64 : 128;
#pragma unroll
            for (int ai = 0; ai < 2; ++ai)
#pragma unroll
                for (int m = 0; m < 4; ++m) { const int t = (row0 + ai * HALF + m * 16) & (SEQ - 1);
                    *(u32x4*)(hb + (size_t)t * pitch) = pack8(acc[ai][bj][m][0] * sc, acc[ai][bj][m][1] * sc); } }
        if (colt >= C_MK && colt < C_MV) {
            const int bh0 = (u.pm >> 6) * 8, blk = u.pm & 63;
#pragma unroll
            for (int bj = 0; bj < 2; ++bj)
#pragma unroll
                for (int n = 0; n < 2; ++n)
#pragma unroll
                    for (int j = 0; j < 4; ++j) { float s = 0.f;
#pragma unroll
                        for (int ai = 0; ai < 2; ++ai)
#pragma unroll
                            for (int m = 0; m < 4; ++m) s += acc[ai][bj][m][n][j];
                        s += __shfl_xor(s, 1); s += __shfl_xor(s, 2); s += __shfl_xor(s, 4); s += __shfl_xor(s, 8);
                        if (fr == 0) { const int c = colt - C_MK + bj * HALF + wc * 32 + 8 * fq + 4 * n + j; atomicAdd(kmsum + ((size_t)(bh0 + (c >> 6)) * 64 + blk) * 64 + (c & 63), s); } }
        }
    }
};
struct EpiStore {
    static constexpr bool PERM = true, AFTER_DRAIN = false;
    bf16_t* O;
    __device__ __forceinline__ void operator()(const f32x4 (&acc)[2][2][4][2], const Unit& u, int wr, int wc, int fr, int fq) const {
        const int row0 = u.pm * BM + wr * 64 + fr, col0 = u.pn * BM + wc * 32 + 8 * fq;
#pragma unroll
        for (int ai = 0; ai < 2; ++ai)
#pragma unroll
            for (int m = 0; m < 4; ++m) { bf16_t* rowp = O + (size_t)(row0 + ai * HALF + m * 16) * DM + col0;
#pragma unroll
                for (int bj = 0; bj < 2; ++bj) *(u32x4*)(rowp + bj * HALF) = pack8(acc[ai][bj][m][0], acc[ai][bj][m][1]); }
    }
};
template <bool BF, bool WR = true> struct EpiRes {
    static constexpr bool PERM = true, AFTER_DRAIN = false;
    const float* base; bf16_t* xb; float* rsq;
    __device__ __forceinline__ void operator()(const f32x4 (&acc)[2][2][4][2], const Unit& u, int wr, int wc, int fr, int fq) const {
        const int row0 = u.pm * BM + wr * 64 + fr, col0 = u.pn * BM + wc * 32 + 8 * fq;
        if constexpr (BF) {
            u32x4 pv[8][2];
#define ERB_LOAD(g) do { _Pragma("unroll") for (int bj = 0; bj < 2; ++bj) pv[g][bj] = *(const u32x4*)(xb + (size_t)(row0 + ((g) >> 2) * HALF + ((g) & 3) * 16) * DM + col0 + bj * HALF); } while (0)
            ERB_LOAD(0); ERB_LOAD(1); ERB_LOAD(2); ERB_LOAD(3);
#pragma unroll
            for (int g = 0; g < 8; ++g) { const int ai = g >> 2, m = g & 3, row = row0 + ai * HALF + m * 16; float ss = 0.f;
                if (g + 4 < 8) { ERB_LOAD(g + 4); }
                asm volatile("" ::: "memory");
#pragma unroll
                for (int bj = 0; bj < 2; ++bj) { const size_t off = (size_t)row * DM + col0 + bj * HALF; const u32x4 p = pv[g][bj];
                    const f32x4 b0 = {__uint_as_float(p.x << 16), __uint_as_float(p.x & 0xffff0000u), __uint_as_float(p.y << 16), __uint_as_float(p.y & 0xffff0000u)};
                    const f32x4 b1 = {__uint_as_float(p.z << 16), __uint_as_float(p.z & 0xffff0000u), __uint_as_float(p.w << 16), __uint_as_float(p.w & 0xffff0000u)};
                    const f32x4 y0 = b0 + acc[ai][bj][m][0], y1 = b1 + acc[ai][bj][m][1];
                    if (WR) *(u32x4*)(xb + off) = pack8(y0, y1); ss += dot4(y0) + dot4(y1); }
                ss += __shfl_xor(ss, 16); ss += __shfl_xor(ss, 32);
                if (fq == 0) rsq[(size_t)row * 16 + u.pn * 4 + wc] = ss; }
#undef ERB_LOAD
        } else {
            f32x4 bv[8][2][2];
#define ER_LOAD(g) do { _Pragma("unroll") for (int bj = 0; bj < 2; ++bj) { const float* p_ = base + (size_t)(row0 + ((g) >> 2) * HALF + ((g) & 3) * 16) * DM + col0 + bj * HALF; bv[g][bj][0] = *(const f32x4*)p_; bv[g][bj][1] = *(const f32x4*)(p_ + 4); } } while (0)
            ER_LOAD(0); ER_LOAD(1);
#pragma unroll
            for (int g = 0; g < 8; ++g) { const int ai = g >> 2, m = g & 3, row = row0 + ai * HALF + m * 16; float ss = 0.f;
                if (g + 2 < 8) { ER_LOAD(g + 2); }
                asm volatile("" ::: "memory");
#pragma unroll
                for (int bj = 0; bj < 2; ++bj) { const size_t off = (size_t)row * DM + col0 + bj * HALF;
                    const f32x4 y0 = bv[g][bj][0] + acc[ai][bj][m][0], y1 = bv[g][bj][1] + acc[ai][bj][m][1];
                    if (WR) *(u32x4*)(xb + off) = pack8(y0, y1); ss += dot4(y0) + dot4(y1); }
                ss += __shfl_xor(ss, 16); ss += __shfl_xor(ss, 32);
                if (fq == 0) rsq[(size_t)row * 16 + u.pn * 4 + wc] = ss; }
#undef ER_LOAD
        }
    }
};
struct EpiResXN {
    static constexpr bool PERM = true, AFTER_DRAIN = false;
    const bf16_t* xn; const float* rs0; const float* gcol; bf16_t* xb; float* rsq;
    __device__ __forceinline__ void operator()(const f32x4 (&acc)[2][2][4][2], const Unit& u, int wr, int wc, int fr, int fq) const {
        const int row0 = u.pm * BM + wr * 64 + fr, col0 = u.pn * BM + wc * 32 + 8 * fq;
        f32x4 ig[2][2];
#pragma unroll
        for (int bj = 0; bj < 2; ++bj)
#pragma unroll
            for (int n = 0; n < 2; ++n) { const f32x4 g = *(const f32x4*)(gcol + col0 + bj * HALF + 4 * n); ig[bj][n] = (f32x4){frcp(g[0]), frcp(g[1]), frcp(g[2]), frcp(g[3])}; }
        float ir[8];
#pragma unroll
        for (int g = 0; g < 8; ++g) ir[g] = frcp(rs0[row0 + (g >> 2) * HALF + (g & 3) * 16]);
        u32x4 pv[8][2];
#define ERX_LOAD(g) do { _Pragma("unroll") for (int bj = 0; bj < 2; ++bj) pv[g][bj] = *(const u32x4*)(xn + (size_t)(row0 + ((g) >> 2) * HALF + ((g) & 3) * 16) * DM + col0 + bj * HALF); } while (0)
        ERX_LOAD(0); ERX_LOAD(1); ERX_LOAD(2); ERX_LOAD(3);
#pragma unroll
        for (int g = 0; g < 8; ++g) { const int ai = g >> 2, m = g & 3, row = row0 + ai * HALF + m * 16; float ss = 0.f;
            if (g + 4 < 8) { ERX_LOAD(g + 4); }
            asm volatile("" ::: "memory");
#pragma unroll
            for (int bj = 0; bj < 2; ++bj) { const size_t off = (size_t)row * DM + col0 + bj * HALF; const u32x4 p = pv[g][bj];
                const f32x4 b0 = {__uint_as_float(p.x << 16), __uint_as_float(p.x & 0xffff0000u), __uint_as_float(p.y << 16), __uint_as_float(p.y & 0xffff0000u)};
                const f32x4 b1 = {__uint_as_float(p.z << 16), __uint_as_float(p.z & 0xffff0000u), __uint_as_float(p.w << 16), __uint_as_float(p.w & 0xffff0000u)};
                const f32x4 y0 = b0 * ig[bj][0] * ir[g] + acc[ai][bj][m][0], y1 = b1 * ig[bj][1] * ir[g] + acc[ai][bj][m][1];
                *(u32x4*)(xb + off) = pack8(y0, y1); ss += dot4(y0) + dot4(y1); }
            ss += __shfl_xor(ss, 16); ss += __shfl_xor(ss, 32);
            if (fq == 0) rsq[(size_t)row * 16 + u.pn * 4 + wc] = ss; }
#undef ERX_LOAD
    }
};
struct EpiPleNorm {
    static constexpr bool PERM = true, AFTER_DRAIN = false;
    float* out; const bf16_t* xb; const bf16_t* pw; const float* rsq_in; float* rsq_out; unsigned* pcnt; const float* fnorm; unsigned long long* dts;
#define EPN_STAMP(i) do { if (dts && wr == 0 && wc == 0 && fr == 0 && fq == 0) __hip_atomic_store(dts + (i) + 4 * (u.pm >= 64 ? 1 : 0), (unsigned long long)__builtin_amdgcn_s_memrealtime(), __ATOMIC_RELAXED, __HIP_MEMORY_SCOPE_AGENT); } while (0)
    __device__ __forceinline__ void operator()(const f32x4 (&acc_)[2][2][4][2], const Unit& u, int wr, int wc, int fr, int fq) const {
        f32x4 (&acc)[2][2][4][2] = const_cast<f32x4 (&)[2][2][4][2]>(acc_);
        const int row0 = u.pm * BM + wr * 64 + fr, col0 = u.pn * BM + wc * 32 + 8 * fq;
        EPN_STAMP(30);
        float rsv[2][4]; rs8(rsq_in, row0, fq, rsv);
        u32x4 xq[8][2], pq[8][2];
#define EP_LOAD(g) do { _Pragma("unroll") for (int bj = 0; bj < 2; ++bj) { const size_t o_ = (size_t)(row0 + ((g) >> 2) * HALF + ((g) & 3) * 16) * DM + col0 + bj * HALF; xq[g][bj] = *(const u32x4*)(xb + o_); pq[g][bj] = *(const u32x4*)(pw + o_); } } while (0)
        EP_LOAD(0); EP_LOAD(1);
#pragma unroll
        for (int g = 0; g < 8; ++g) { const int ai = g >> 2, m = g & 3, row = row0 + ai * HALF + m * 16; const float rs = rsv[ai][m]; float ss = 0.f;
            if (g + 2 < 8) { EP_LOAD(g + 2); }
            asm volatile("" ::: "memory");
#pragma unroll
            for (int bj = 0; bj < 2; ++bj) {
                const u32x4 pv = pq[g][bj];
                const f32x4 p0 = {__uint_as_float(pv.x << 16), __uint_as_float(pv.x & 0xffff0000u), __uint_as_float(pv.y << 16), __uint_as_float(pv.y & 0xffff0000u)};
                const f32x4 p1 = {__uint_as_float(pv.z << 16), __uint_as_float(pv.z & 0xffff0000u), __uint_as_float(pv.w << 16), __uint_as_float(pv.w & 0xffff0000u)};
                f32x4 g0 = acc[ai][bj][m][0] * rs, g1 = acc[ai][bj][m][1] * rs;
#pragma unroll
                for (int j = 0; j < 4; ++j) { g0[j] = fsigmoid(g0[j]); g1[j] = fsigmoid(g1[j]); }
                const u32x4 xv = xq[g][bj];
                const f32x4 x0 = {__uint_as_float(xv.x << 16), __uint_as_float(xv.x & 0xffff0000u), __uint_as_float(xv.y << 16), __uint_as_float(xv.y & 0xffff0000u)};
                const f32x4 x1 = {__uint_as_float(xv.z << 16), __uint_as_float(xv.z & 0xffff0000u), __uint_as_float(xv.w << 16), __uint_as_float(xv.w & 0xffff0000u)};
                const f32x4 y0 = x0 + p0 * g0, y1 = x1 + p1 * g1;
                acc[ai][bj][m][0] = y0; acc[ai][bj][m][1] = y1; ss += dot4(y0) + dot4(y1); }
            ss += __shfl_xor(ss, 16); ss += __shfl_xor(ss, 32);
            if (fq == 0) __hip_atomic_store((unsigned*)(rsq_out + (size_t)row * 16 + u.pn * 4 + wc), __float_as_uint(ss), __ATOMIC_RELAXED, __HIP_MEMORY_SCOPE_AGENT); }
#undef EP_LOAD
        asm volatile("s_waitcnt vmcnt(0)" ::: "memory");
        EPN_STAMP(31);
        unsigned* pc = pcnt + 16 * u.pm;
        if (fq == 0 && fr == 0) __hip_atomic_fetch_add(pc, 1u, __ATOMIC_RELAXED, __HIP_MEMORY_SCOPE_AGENT);
        for (unsigned spins = 0; spins < (1u << 22); ++spins) {
            if ((unsigned)__builtin_amdgcn_readfirstlane(__hip_atomic_load(pc, __ATOMIC_RELAXED, __HIP_MEMORY_SCOPE_AGENT)) >= 32u) break;
            __builtin_amdgcn_s_sleep(2);
        }
        EPN_STAMP(32);
        f32x4 fn[2][2];
#pragma unroll
        for (int bj = 0; bj < 2; ++bj) { fn[bj][0] = *(const f32x4*)(fnorm + col0 + bj * HALF); fn[bj][1] = *(const f32x4*)(fnorm + col0 + bj * HALF + 4); }
        unsigned long long pa[8], pb[8];
#pragma unroll
        for (int g = 0; g < 8; ++g) { const unsigned long long* pp = (const unsigned long long*)(rsq_out + (size_t)(row0 + (g >> 2) * HALF + (g & 3) * 16) * 16 + 4 * fq);
            pa[g] = __hip_atomic_load(pp, __ATOMIC_RELAXED, __HIP_MEMORY_SCOPE_AGENT); pb[g] = __hip_atomic_load(pp + 1, __ATOMIC_RELAXED, __HIP_MEMORY_SCOPE_AGENT); }
#pragma unroll
        for (int g = 0; g < 8; ++g) { const int ai = g >> 2, m = g & 3, row = row0 + ai * HALF + m * 16;
            float s = (__uint_as_float((unsigned)pa[g]) + __uint_as_float((unsigned)(pa[g] >> 32))) + (__uint_as_float((unsigned)pb[g]) + __uint_as_float((unsigned)(pb[g] >> 32)));
            s += __shfl_xor(s, 16); s += __shfl_xor(s, 32);
            const float rs3 = rsqrtf(s * (1.0f / DM) + RMS_EPS);
#pragma unroll
            for (int bj = 0; bj < 2; ++bj) { const size_t off = (size_t)row * DM + col0 + bj * HALF;
                *(f32x4*)(out + off) = acc[ai][bj][m][0] * rs3 * fn[bj][0]; *(f32x4*)(out + off + 4) = acc[ai][bj][m][1] * rs3 * fn[bj][1]; } }
        EPN_STAMP(33);
    }
};
#undef EPN_STAMP
struct EpiUG {
    static constexpr bool PERM = true, AFTER_DRAIN = false;
    bf16_t* act; const float* rsq; const float* cw; const float* cb; float* UL; float* UF; float* GF;
    __device__ __forceinline__ void operator()(const f32x4 (&acc)[2][2][4][2], const Unit& u, int wr, int wc, int fr, int fq) const {
        const int cu = u.pn * HALF + wc * 32 + 8 * fq;
        const int row0 = u.pm * BM + wr * 64 + fr;
        float rsv[2][4]; rs8(rsq, row0, fq, rsv);
        float w0[8], w1[8], w2[8], bb[8];
#pragma unroll
        for (int q = 0; q < 2; ++q) { const f32x4 a = *(const f32x4*)(cw + cu + 4 * q), b = *(const f32x4*)(cw + FF + cu + 4 * q), c = *(const f32x4*)(cw + 2 * FF + cu + 4 * q), d = *(const f32x4*)(cb + cu + 4 * q);
#pragma unroll
            for (int j = 0; j < 4; ++j) { w0[4 * q + j] = a[j]; w1[4 * q + j] = b[j]; w2[4 * q + j] = c[j]; bb[4 * q + j] = d[j]; } }
#pragma unroll
        for (int ai = 0; ai < 2; ++ai) {
            float up[8];
#pragma unroll
            for (int m = 0; m < 4; ++m) {
                const int row = row0 + ai * HALF + m * 16;
                const float rs = rsv[ai][m];
                float uu[8], gg[8], a8[8];
#pragma unroll
                for (int n = 0; n < 2; ++n)
#pragma unroll
                    for (int j = 0; j < 4; ++j) { uu[4 * n + j] = acc[ai][0][m][n][j] * rs; gg[4 * n + j] = acc[ai][1][m][n][j] * rs; }
#pragma unroll
                for (int k = 0; k < 8; ++k) {
                    float t1 = 0.f, t2 = 0.f;
                    if (m > 0) { t1 = DPP_ROT(up[k], 0x121); t2 = DPP_ROT(up[k], 0x122); }
                    const float u1 = DPP_MOV(t1, uu[k], 0x111), u2 = DPP_MOV(t2, uu[k], 0x112);
                    const float y = bb[k] + w0[k] * u2 + w1[k] * u1 + w2[k] * uu[k];
                    a8[k] = gelu_fast(y) * gg[k];
                }
                const bool defer = (m == 0) && (fr < 2);
                if (!defer) { u32x4 w; w.x = cvt_pk_bf16(a8[0], a8[1]); w.y = cvt_pk_bf16(a8[2], a8[3]); w.z = cvt_pk_bf16(a8[4], a8[5]); w.w = cvt_pk_bf16(a8[6], a8[7]);
                    *(u32x4*)(act + (size_t)row * FF + cu) = w; }
                else { const size_t so = ((size_t)(row >> 6) * 2 + fr) * FF + cu;
                    *(f32x4*)(UF + so) = (f32x4){uu[0], uu[1], uu[2], uu[3]}; *(f32x4*)(UF + so + 4) = (f32x4){uu[4], uu[5], uu[6], uu[7]};
                    *(f32x4*)(GF + so) = (f32x4){gg[0], gg[1], gg[2], gg[3]}; *(f32x4*)(GF + so + 4) = (f32x4){gg[4], gg[5], gg[6], gg[7]}; }
                if (m == 3 && fr >= 14) { const size_t so = ((size_t)(row >> 6) * 2 + (fr - 14)) * FF + cu;
                    *(f32x4*)(UL + so) = (f32x4){uu[0], uu[1], uu[2], uu[3]}; *(f32x4*)(UL + so + 4) = (f32x4){uu[4], uu[5], uu[6], uu[7]}; }
#pragma unroll
                for (int k = 0; k < 8; ++k) up[k] = uu[k];
            }
        }
    }
};
}
#define LAS __attribute__((address_space(3)))
namespace mx {
typedef short bf16x8 __attribute__((ext_vector_type(8)));
typedef short s16x4 __attribute__((ext_vector_type(4)));
typedef float f32x16 __attribute__((ext_vector_type(16)));
typedef unsigned u32x4 __attribute__((ext_vector_type(4)));
typedef float f32x4_t __attribute__((ext_vector_type(4)));
typedef LAS const char* lds_cptr;
typedef LAS char* lds_ptr;
__device__ __forceinline__ int crow(int r, int hi) { return (r & 3) + 8 * (r >> 2) + 4 * hi; }
__device__ __forceinline__ s16x4 vtr(lds_cptr p) { return __builtin_bit_cast(s16x4, __builtin_amdgcn_ds_read_tr16_b64_v4i16((LAS s16x4*)p)); }
__device__ __forceinline__ bf16x8 cat8(s16x4 lo, s16x4 hi) { return (bf16x8){lo[0], lo[1], lo[2], lo[3], hi[0], hi[1], hi[2], hi[3]}; }
typedef float f32x2_t __attribute__((ext_vector_type(2))); typedef __bf16 bf16x2_t __attribute__((ext_vector_type(2)));
__device__ __forceinline__ unsigned pk(float lo, float hi) { const f32x2_t v = {lo, hi}; return __builtin_bit_cast(unsigned, __builtin_convertvector(v, bf16x2_t)); }
typedef __bf16 bf16x2_d __attribute__((ext_vector_type(2)));
__device__ __forceinline__ float dot2bf(unsigned a, unsigned b, float c) { return __builtin_amdgcn_fdot2_f32_bf16(__builtin_bit_cast(bf16x2_d, a), __builtin_bit_cast(bf16x2_d, b), c, false); }
__device__ __forceinline__ float dot8bf(u32x4 a, u32x4 b, float c) { return dot2bf(a.w, b.w, dot2bf(a.z, b.z, dot2bf(a.y, b.y, dot2bf(a.x, b.x, c)))); }
__device__ __forceinline__ float other_half(float v) { return __shfl_xor(v, 32); }

constexpr int L_K = 0, L_V = 32768;
constexpr int L_WSF = 65536;
constexpr int L_OST = 65536 + 2048;
constexpr int L_ENT = L_OST + 32768;
constexpr int ENT_CAP = 4096;
constexpr int L_PREF = L_ENT + ENT_CAP * 4;
constexpr int L_MW = L_PREF + 512;
constexpr int L_END = L_MW + 4096;
static_assert(L_END <= 147456, "mixer LDS map");

__device__ __forceinline__ void moba_stage_kv(const bf16_t* __restrict__ proj, int b, int h, int blk, lds_ptr lds, int tid) {
#pragma unroll
    for (int i = 0; i < 4; ++i) { const int pc = tid + 512 * i, key = pc >> 3, ch = pc & 7;
        const bf16_t* src = proj + ((size_t)(b * 8 + h) * SEQ + blk * 256 + key) * 64 + ch * 8;
        const u32x4 kv = *(const u32x4*)(src + SEC), vv = *(const u32x4*)(src + 2 * SEC);
        *(LAS u32x4*)(lds + L_K + ch * 4096 + key * 16) = kv;
        *(LAS u32x4*)(lds + L_V + (key >> 6) * 8192 + (ch >> 2) * 4096 + ((key & 63) >> 3) * 512 + (key & 7) * 64 + (ch & 3) * 16) = vv; }
}

__device__ __forceinline__ void moba_batch(const bf16x8 (&qr)[4], int qpos, int kbase, float slope2, bool diag, int ntiles, lds_ptr lds, int wave, int lane, bf16_t* odst, float* ldst,
                                           const bf16_t* part_row = nullptr, const float* pl_row = nullptr, int nv = 0, bf16_t* mix_row = nullptr, bf16_t* mix_base = nullptr) {
    const int r32 = lane & 31, hi = lane >> 5;
    f32x16 o0, o1;
#pragma unroll
    for (int r = 0; r < 16; ++r) { o0[r] = 0.f; o1[r] = 0.f; }
    float m = -1e30f, l = 0.f;
    const lds_cptr kp = (lds_cptr)lds + L_K + hi * 4096 + r32 * 16;
    const lds_cptr vp = (lds_cptr)lds + L_V + ((lane >> 4) & 1) * 32 + (lane & 3) * 8 + (4 * hi + ((lane & 15) >> 2)) * 64;
    LAS float* wsf = (LAS float*)(lds + L_WSF) + wave * 64;
    const float s4h = slope2 * (float)(4 * hi);
#define MX_LOAD(KT) bf16x8 kf_[4], kg_[4], vf_[2][4]; do { _Pragma("unroll") for (int d0 = 0; d0 < 4; ++d0) { kf_[d0] = *(const LAS bf16x8*)(kp + (KT) * 1024 + d0 * 8192); kg_[d0] = *(const LAS bf16x8*)(kp + (KT) * 1024 + 512 + d0 * 8192); } \
        const lds_cptr vt_ = vp + (KT) * 8192; _Pragma("unroll") for (int db = 0; db < 2; ++db) _Pragma("unroll") for (int ks = 0; ks < 4; ++ks) vf_[db][ks] = cat8(vtr(vt_ + db * 4096 + ks * 1024), vtr(vt_ + db * 4096 + ks * 1024 + 512)); \
        __builtin_amdgcn_sched_barrier(0); } while (0)
#define MX_QK(P0, P1, C0, C1) do { _Pragma("unroll") for (int d0 = 0; d0 < 4; ++d0) { \
        P0 = __builtin_amdgcn_mfma_f32_32x32x16_bf16(kf_[d0], qr[d0], d0 == 0 ? C0 : P0, 0, 0, 0); P1 = __builtin_amdgcn_mfma_f32_32x32x16_bf16(kg_[d0], qr[d0], d0 == 0 ? C1 : P1, 0, 0, 0); } } while (0)
#define MX_PV(O, DB, KS, PW) O = __builtin_amdgcn_mfma_f32_32x32x16_bf16(__builtin_bit_cast(bf16x8, PW), vf_[DB][KS], O, 0, 0, 0)
#define MX_PVALL() do { \
        const u32x4 pw0 = {pk(p0[0], p0[1]), pk(p0[2], p0[3]), pk(p0[4], p0[5]), pk(p0[6], p0[7])}, pw1 = {pk(p0[8], p0[9]), pk(p0[10], p0[11]), pk(p0[12], p0[13]), pk(p0[14], p0[15])}; \
        const u32x4 pw2 = {pk(p1[0], p1[1]), pk(p1[2], p1[3]), pk(p1[4], p1[5]), pk(p1[6], p1[7])}, pw3 = {pk(p1[8], p1[9]), pk(p1[10], p1[11]), pk(p1[12], p1[13]), pk(p1[14], p1[15])}; \
        MX_PV(o0, 0, 0, pw0); MX_PV(o1, 1, 0, pw0); MX_PV(o0, 0, 1, pw1); MX_PV(o1, 1, 1, pw1); MX_PV(o0, 0, 2, pw2); MX_PV(o1, 1, 2, pw2); MX_PV(o0, 0, 3, pw3); MX_PV(o1, 1, 3, pw3); } while (0)
    {
        const int kt = ntiles - 1;
        f32x16 p0, p1;
        MX_LOAD(kt);
#pragma unroll
        for (int r = 0; r < 16; ++r) { p0[r] = fmaf(slope2, (float)((r & 3) + 8 * (r >> 2)), s4h); p1[r] = p0[r]; }
        MX_QK(p0, p1, p0, p1);
        const int dq = qpos - kbase - 64 * kt;
        const float t0 = -slope2 * (float)dq, t1 = t0 + 32.0f * slope2;
        if (diag) {
#pragma unroll
            for (int r = 0; r < 16; ++r) { const int c = crow(r, hi); if (c > dq) p0[r] = -1e30f; if (c + 32 > dq) p1[r] = -1e30f; }
        }
        float mx0 = p0[0], mx1 = p1[0];
#pragma unroll
        for (int r = 1; r < 16; ++r) { mx0 = fmaxf(mx0, p0[r]); mx1 = fmaxf(mx1, p1[r]); }
        float mx_ = fmaxf(mx0 + t0, mx1 + t1);
        m = fmaxf(mx_, other_half(mx_));
        const float e0 = m - t0, e1 = m - t1;
        float rs = 0.f;
#pragma unroll
        for (int r = 0; r < 16; ++r) { p0[r] = __builtin_amdgcn_exp2f(p0[r] - e0); p1[r] = __builtin_amdgcn_exp2f(p1[r] - e1); rs += p0[r] + p1[r]; }
        l = rs;
        MX_PVALL();
    }
    for (int kt = ntiles - 2; kt >= 0; --kt) {
        const int dq = qpos - kbase - 64 * kt;
        const float c0 = -slope2 * (float)dq - m + s4h, c1 = c0 + 32.0f * slope2;
        f32x16 p0, p1;
        MX_LOAD(kt);
#pragma unroll
        for (int r = 0; r < 16; ++r) { const float cr = (float)((r & 3) + 8 * (r >> 2)); p0[r] = fmaf(slope2, cr, c0); p1[r] = fmaf(slope2, cr, c1); }
        MX_QK(p0, p1, p0, p1);
        float mx_ = fmaxf(p0[0], p1[0]);
#pragma unroll
        for (int r = 1; r < 16; ++r) mx_ = fmaxf(mx_, fmaxf(p0[r], p1[r]));
        mx_ = fmaxf(mx_, other_half(mx_));
        if (__all(mx_ < -40.0f)) continue;
        if (__any(mx_ > 16.0f)) {
            const float dl = fmaxf(mx_, 0.f); m += dl;
#pragma unroll
            for (int r = 0; r < 16; ++r) { p0[r] -= dl; p1[r] -= dl; }
            const float f = __builtin_amdgcn_exp2f(-dl); l *= f;
            if (hi == 0) wsf[r32] = f;
#pragma unroll
            for (int r = 0; r < 16; ++r) { const float g = wsf[crow(r, hi)]; o0[r] *= g; o1[r] *= g; }
        }
        float rs = 0.f;
#pragma unroll
        for (int r = 0; r < 16; ++r) { p0[r] = __builtin_amdgcn_exp2f(p0[r]); p1[r] = __builtin_amdgcn_exp2f(p1[r]); rs += p0[r] + p1[r]; }
        l += rs;
        MX_PVALL();
    }
#undef MX_LOAD
#undef MX_QK
#undef MX_PV
#undef MX_PVALL
    l += other_half(l);
    if (hi == 0) wsf[32 + r32] = 1.0f / l;
    const float lse = m + __builtin_amdgcn_logf(l);
    LAS bf16_t* ost = (LAS bf16_t*)(lds + L_OST) + wave * 2048;
#pragma unroll
    for (int r = 0; r < 16; ++r) { const int orow = crow(r, hi); const float f = wsf[32 + orow];
        ost[orow * 64 + r32] = (bf16_t)pk(o0[r] * f, 0.f); ost[orow * 64 + 32 + r32] = (bf16_t)pk(o1[r] * f, 0.f); }
    if (mix_row == nullptr) {
        const unsigned long long dp = (unsigned long long)odst; const unsigned dlo = (unsigned)dp, dhi = (unsigned)(dp >> 32);
#pragma unroll
        for (int i = 0; i < 4; ++i) { const int row = i * 8 + (lane >> 3), ch = lane & 7;
            const u32x4 v = *(const LAS u32x4*)(ost + row * 64 + ch * 8);
            const unsigned long long d = ((unsigned long long)(unsigned)__shfl((int)dhi, row) << 32) | (unsigned)__shfl((int)dlo, row);
            if (d) *(u32x4*)((bf16_t*)d + ch * 8) = v; }
        if (hi == 0 && ldst) *ldst = lse;
    } else {
        if (hi == 0) { const f32x4_t lv = *(const f32x4_t*)pl_row;
            const float a0 = nv > 0 ? lv[0] : -1e30f, a1 = nv > 1 ? lv[1] : -1e30f, a2 = nv > 2 ? lv[2] : -1e30f;
            const float mm = fmaxf(fmaxf(a0, a1), fmaxf(a2, lse));
            const float w0 = __builtin_amdgcn_exp2f(a0 - mm), w1 = __builtin_amdgcn_exp2f(a1 - mm), w2 = __builtin_amdgcn_exp2f(a2 - mm), w3 = __builtin_amdgcn_exp2f(lse - mm);
            const float iw = 1.0f / ((w0 + w1) + (w2 + w3));
            ((LAS f32x4_t*)(lds + L_MW) + wave * 32)[r32] = (f32x4_t){w0 * iw, w1 * iw, w2 * iw, w3 * iw}; }
        const unsigned long long pp = (unsigned long long)part_row, mp = (unsigned long long)mix_row;
        const unsigned plo = (unsigned)pp, phi = (unsigned)(pp >> 32), mlo = (unsigned)mp, mhi = (unsigned)(mp >> 32);
#pragma unroll
        for (int i = 0; i < 4; ++i) { const int row = i * 8 + (lane >> 3), ch = lane & 7;
            const u32x4 v = *(const LAS u32x4*)(ost + row * 64 + ch * 8);
            const f32x4_t w = ((const LAS f32x4_t*)(lds + L_MW) + wave * 32)[row];
            const bf16_t* pr = (const bf16_t*)(((unsigned long long)(unsigned)__shfl((int)phi, row) << 32) | (unsigned)__shfl((int)plo, row));
            bf16_t* mr = (bf16_t*)(((unsigned long long)(unsigned)__shfl((int)mhi, row) << 32) | (unsigned)__shfl((int)mlo, row));
            const unsigned vw[4] = {v.x, v.y, v.z, v.w}; float acc[8];
#pragma unroll
            for (int q = 0; q < 4; ++q) { acc[2 * q] = w[3] * __uint_as_float(vw[q] << 16); acc[2 * q + 1] = w[3] * __uint_as_float(vw[q] & 0xffff0000u); }
#pragma unroll
            for (int s = 0; s < 3; ++s) if (w[s] != 0.f) { const u32x4 pv = *(const u32x4*)(pr + s * 64 + ch * 8); const unsigned pw_[4] = {pv.x, pv.y, pv.z, pv.w};
#pragma unroll
                for (int q = 0; q < 4; ++q) { acc[2 * q] += w[s] * __uint_as_float(pw_[q] << 16); acc[2 * q + 1] += w[s] * __uint_as_float(pw_[q] & 0xffff0000u); } }
            *(u32x4*)(mr + ch * 8) = (u32x4){pk(acc[0], acc[1]), pk(acc[2], acc[3]), pk(acc[4], acc[5]), pk(acc[6], acc[7])}; }
    }
}

__device__ __forceinline__ void moba_diag_unit(const bf16_t* __restrict__ proj, int bh, int i, const bf16_t* part_o, const float* part_l, const u32* __restrict__ sel, bf16_t* mix, lds_ptr lds, int tid) {
    const int b = bh >> 3, h = bh & 7, lane = tid & 63, wave = __builtin_amdgcn_readfirstlane(tid >> 6);
    const int ql = wave * 32 + (lane & 31), t = i * 256 + ql; const size_t row = (size_t)b * SEQ + t;
    bf16x8 qr[4];
    { const bf16_t* qp = proj + ((size_t)bh * SEQ + t) * 64 + (lane >> 5) * 8;
#pragma unroll
      for (int d0 = 0; d0 < 4; ++d0) qr[d0] = *(const bf16x8*)(qp + d0 * 16); }
    moba_stage_kv(proj, b, h, i, lds, tid);
    __syncthreads();
    const float slope2 = __builtin_amdgcn_exp2f(-(float)(h + 1)) * LOG2E;
    const int nv = (int)(sel[row * 8 + h] >> 24);
    moba_batch(qr, t, i * 256, slope2, true, (wave >> 1) + 1, lds, wave, lane, nullptr, nullptr,
               part_o + ((row * 8 + h) * 4) * 64, part_l + (row * 8 + h) * 4, nv, mix + row * DM + h * 64, mix);
    __syncthreads();
}
__device__ __forceinline__ void moba_sel_task(const bf16_t* __restrict__ proj, const unsigned short* __restrict__ seg, const int* __restrict__ cnt, const float2* __restrict__ qs_in, int bh, int n,
                                              bf16_t* part_o, float* part_l, lds_ptr lds, int tid) {
    const int b = bh >> 3, h = bh & 7, lane = tid & 63, wave = __builtin_amdgcn_readfirstlane(tid >> 6);
    LAS int* pref = (LAS int*)(lds + L_PREF); LAS unsigned* ent = (LAS unsigned*)(lds + L_ENT);
    LAS float* kslot = (LAS float*)(lds + L_PREF + 400); LAS int* cntN = (LAS int*)(lds + L_PREF + 440);
    float kn2 = 0.f;
#pragma unroll
    for (int i = 0; i < 4; ++i) { const int pc = tid + 512 * i, key = pc >> 3, ch = pc & 7;
        const bf16_t* src = proj + ((size_t)bh * SEQ + n * 256 + key) * 64 + ch * 8;
        const u32x4 kv = *(const u32x4*)(src + SEC), vv = *(const u32x4*)(src + 2 * SEC);
        *(LAS u32x4*)(lds + L_K + ch * 4096 + key * 16) = kv;
        *(LAS u32x4*)(lds + L_V + (key >> 6) * 8192 + (ch >> 2) * 4096 + ((key & 63) >> 3) * 512 + (key & 7) * 64 + (ch & 3) * 16) = vv;
        float s2 = dot8bf(kv, kv, 0.f); s2 += __shfl_xor(s2, 1); s2 += __shfl_xor(s2, 2); s2 += __shfl_xor(s2, 4); kn2 = fmaxf(kn2, s2); }
    kn2 = fmaxf(kn2, __shfl_xor(kn2, 8)); kn2 = fmaxf(kn2, __shfl_xor(kn2, 16)); kn2 = fmaxf(kn2, __shfl_xor(kn2, 32));
    if (lane == 0) kslot[wave] = kn2;
    if (wave == 0) {
        const int c = (lane > n) ? cnt[((size_t)bh * 64 + n) * 64 + lane] : 0; int s = c;
#pragma unroll
        for (int o = 1; o < 64; o <<= 1) { const int v = __shfl_up(s, o); if (lane >= o) s += v; }
        pref[lane + 1] = s; if (lane == 0) { pref[0] = 0; *cntN = 0; }
    }
    __syncthreads();
    const int T = pref[64];
    const float kmaxn = sqrtf(fmaxf(fmaxf(fmaxf(kslot[0], kslot[1]), fmaxf(kslot[2], kslot[3])), fmaxf(fmaxf(kslot[4], kslot[5]), fmaxf(kslot[6], kslot[7]))));
    const float slope2 = __builtin_amdgcn_exp2f(-(float)(h + 1)) * LOG2E;
    for (int c0 = 0; c0 < T; c0 += ENT_CAP) {
        const int cu = (T - c0) < ENT_CAP ? (T - c0) : ENT_CAP;
        for (int e = tid; e < cu; e += 512) { const int g = c0 + e; int lo = 0, hi_ = 63;
            while (lo < hi_) { const int mid = (lo + hi_ + 1) >> 1; if (pref[mid] <= g) lo = mid; else hi_ = mid - 1; }
            const unsigned en = (unsigned)seg[(((size_t)bh * 64 + n) * 64 + lo) * 256 + (g - pref[lo])];
            const int t = lo * 256 + (int)(en >> 2), slot = en & 3; const size_t row = (size_t)b * SEQ + t;
            const float2 qs = qs_in[row * 8 + h];
            const float U = qs.x * kmaxn - slope2 * (float)(t - (n * 256 + 255));
            if (U + 8.0f - qs.y < -40.0f) part_l[(row * 8 + h) * 4 + slot] = -1e30f;
            else { const int pos = atomicAdd((int*)cntN, 1); ent[pos] = ((unsigned)lo << 10) | en; } }
        __syncthreads();
        const int cn = *cntN;
        for (int wb = wave; wb * 32 < cn; wb += 8) {
            const int idx = wb * 32 + (lane & 31); const bool valid = idx < cn;
            const unsigned ec = ent[valid ? idx : wb * 32];
            const int t = (ec >> 10) * 256 + ((ec >> 2) & 255), slot = ec & 3; const size_t row = (size_t)b * SEQ + t;
            bf16x8 qr[4];
            { const bf16_t* qp = proj + ((size_t)bh * SEQ + t) * 64 + (lane >> 5) * 8;
#pragma unroll
              for (int d0 = 0; d0 < 4; ++d0) qr[d0] = *(const bf16x8*)(qp + d0 * 16); }
            moba_batch(qr, t, n * 256, slope2, false, 4, lds, wave, lane,
                       valid ? part_o + ((row * 8 + h) * 4 + slot) * 64 : (bf16_t*)nullptr, valid ? part_l + (row * 8 + h) * 4 + slot : (float*)nullptr);
        }
        __syncthreads();
        if (c0 + ENT_CAP < T) { if (tid == 0) *cntN = 0; __syncthreads(); }
    }
}
constexpr int G_KMH = 0, G_KML = 8192, G_CNT = 16384;
#define MX_INS(v, n) do { const bool g0_ = (v) > v0, g1_ = (v) > v1, g2_ = (v) > v2; \
    v2 = g1_ ? v1 : (g2_ ? (v) : v2); i2 = g1_ ? i1 : (g2_ ? (n) : i2); v1 = g0_ ? v0 : (g1_ ? (v) : v1); i1 = g0_ ? i0 : (g1_ ? (n) : i1); v0 = g0_ ? (v) : v0; i0 = g0_ ? (n) : i0; } while (0)
__device__ __forceinline__ void gate_task_mfma(int bh, int i, const bf16_t* __restrict__ proj, const float* __restrict__ kmsum, u32* __restrict__ sel,
                                               unsigned short* __restrict__ seg, int* __restrict__ cnt, float2* __restrict__ qs_out, lds_ptr lds, int tid) {
    const int b = bh >> 3, h = bh & 7, lane = tid & 63, wave = __builtin_amdgcn_readfirstlane(tid >> 6), r32 = lane & 31, hi = lane >> 5;
    { const int n = tid >> 3, ch = tid & 7; const float* src = kmsum + (size_t)bh * 4096 + n * 64 + ch * 8;
      const f32x4_t a = *(const f32x4_t*)src * (1.0f / 256.0f), c = *(const f32x4_t*)(src + 4) * (1.0f / 256.0f);
      float v[8] = {a[0], a[1], a[2], a[3], c[0], c[1], c[2], c[3]}; float hf[8], lf[8];
#pragma unroll
      for (int k = 0; k < 8; ++k) { hf[k] = bf2f(f2bf(v[k])); lf[k] = v[k] - hf[k]; }
      const u32x4 H = {pk(hf[0], hf[1]), pk(hf[2], hf[3]), pk(hf[4], hf[5]), pk(hf[6], hf[7])}, Lw = {pk(lf[0], lf[1]), pk(lf[2], lf[3]), pk(lf[4], lf[5]), pk(lf[6], lf[7])};
      *(LAS u32x4*)(lds + G_KMH + ch * 1024 + n * 16) = H; *(LAS u32x4*)(lds + G_KML + ch * 1024 + n * 16) = Lw; }
    LAS int* cntL = (LAS int*)(lds + G_CNT);
    if (tid < 64) cntL[tid] = 0;
    __syncthreads();
    const int ql = wave * 32 + r32, t = i * 256 + ql; const size_t row = (size_t)b * SEQ + t;
    const bf16_t* qp = proj + ((size_t)bh * SEQ + t) * 64 + hi * 8;
    f32x16 p0, p1;
#pragma unroll
    for (int r = 0; r < 16; ++r) { p0[r] = 0.f; p1[r] = 0.f; }
    const bf16_t* ksp = proj + SEC + ((size_t)bh * SEQ + t) * 64 + hi * 8;
    float qq = 0.f, qk = 0.f;
#pragma unroll
    for (int ks = 0; ks < 4; ++ks) {
        const bf16x8 q = *(const bf16x8*)(qp + ks * 16);
        { const u32x4 qu = __builtin_bit_cast(u32x4, q), ku = *(const u32x4*)(ksp + ks * 16); qq = dot8bf(qu, qu, qq); qk = dot8bf(qu, ku, qk); }
        const lds_cptr kb = (lds_cptr)lds + (2 * ks + hi) * 1024 + r32 * 16;
        p0 = __builtin_amdgcn_mfma_f32_32x32x16_bf16(*(const LAS bf16x8*)(kb + G_KMH), q, p0, 0, 0, 0);
        p0 = __builtin_amdgcn_mfma_f32_32x32x16_bf16(*(const LAS bf16x8*)(kb + G_KML), q, p0, 0, 0, 0);
        p1 = __builtin_amdgcn_mfma_f32_32x32x16_bf16(*(const LAS bf16x8*)(kb + G_KMH + 512), q, p1, 0, 0, 0);
        p1 = __builtin_amdgcn_mfma_f32_32x32x16_bf16(*(const LAS bf16x8*)(kb + G_KML + 512), q, p1, 0, 0, 0);
    }
    float v0 = -INFINITY, v1 = -INFINITY, v2 = -INFINITY; int i0 = 0, i1 = 0, i2 = 0;
#pragma unroll
    for (int r = 0; r < 16; ++r) { const int n = crow(r, hi); const float v = n < i ? p0[r] : -INFINITY; MX_INS(v, n); }
#pragma unroll
    for (int r = 0; r < 16; ++r) { const int n = 32 + crow(r, hi); const float v = n < i ? p1[r] : -INFINITY; MX_INS(v, n); }
    { const float a0 = __shfl_xor(v0, 32), a1 = __shfl_xor(v1, 32), a2 = __shfl_xor(v2, 32); const int j0 = __shfl_xor(i0, 32), j1 = __shfl_xor(i1, 32), j2 = __shfl_xor(i2, 32);
      MX_INS(a0, j0); MX_INS(a1, j1); MX_INS(a2, j2); }
    qq += other_half(qq); qk += other_half(qk);
    if (hi == 0) {
        const int nv = i < 3 ? i : 3;
        qs_out[row * 8 + h] = make_float2(sqrtf(qq), qk);
        sel[row * 8 + h] = (u32)i0 | ((u32)i1 << 8) | ((u32)i2 << 16) | ((u32)nv << 24);
#pragma unroll
        for (int s = 0; s < 3; ++s) if (s < nv) { const int n = s == 0 ? i0 : (s == 1 ? i1 : i2);
            const int pos = atomicAdd((int*)&cntL[n], 1);
            seg[(((size_t)bh * 64 + n) * 64 + i) * 256 + pos] = (unsigned short)((ql << 2) | s); }
    }
    __syncthreads();
    if (tid < i) cnt[((size_t)bh * 64 + tid) * 64 + i] = cntL[tid];
    __syncthreads();
}
#undef MX_INS

__device__ __forceinline__ void moba_combine(const bf16_t* __restrict__ part_o, const float* __restrict__ part_l, const u32* __restrict__ sel, bf16_t* __restrict__ mix, size_t gt, size_t GT) {
    for (size_t i = gt; i < (size_t)MT * 64; i += GT) {
        const int ch = (int)(i & 7), h = (int)((i >> 3) & 7); const size_t row = i >> 6;
        const int nv = sel[row * 8 + h] >> 24;
        const f32x4_t lv = *(const f32x4_t*)(part_l + (row * 8 + h) * 4);
        float w[4]; w[0] = nv > 0 ? lv[0] : -1e30f; w[1] = nv > 1 ? lv[1] : -1e30f; w[2] = nv > 2 ? lv[2] : -1e30f; w[3] = lv[3];
        const float mm = fmaxf(fmaxf(w[0], w[1]), fmaxf(w[2], w[3]));
        float acc[8] = {0.f, 0.f, 0.f, 0.f, 0.f, 0.f, 0.f, 0.f}; float ws = 0.f;
#pragma unroll
        for (int s = 0; s < 4; ++s) { const bool ok = s == 3 || s < nv; const float ww = ok ? __builtin_amdgcn_exp2f(w[s] - mm) : 0.f; ws += ww;
            if (ok) { const u32x4 v = *(const u32x4*)(part_o + ((row * 8 + h) * 4 + s) * 64 + ch * 8);
                acc[0] += ww * __uint_as_float(v.x << 16); acc[1] += ww * __uint_as_float(v.x & 0xffff0000u); acc[2] += ww * __uint_as_float(v.y << 16); acc[3] += ww * __uint_as_float(v.y & 0xffff0000u);
                acc[4] += ww * __uint_as_float(v.z << 16); acc[5] += ww * __uint_as_float(v.z & 0xffff0000u); acc[6] += ww * __uint_as_float(v.w << 16); acc[7] += ww * __uint_as_float(v.w & 0xffff0000u); } }
        const float iw = 1.0f / ws;
        u32x4 o; o.x = pk(acc[0] * iw, acc[1] * iw); o.y = pk(acc[2] * iw, acc[3] * iw); o.z = pk(acc[4] * iw, acc[5] * iw); o.w = pk(acc[6] * iw, acc[7] * iw);
        *(u32x4*)(mix + row * DM + h * 64 + ch * 8) = o;
    }
}

constexpr int R_IMG = 65536;
__device__ __forceinline__ int rimg_off(int t, int c) { return (c >> 5) * 16384 + (t >> 3) * 512 + (t & 7) * 64 + (c & 31) * 2; }
__device__ __forceinline__ void ret_stage(const bf16_t* __restrict__ plane, int t0, lds_ptr img, int tid, bool kdecay, float log2g) {
#pragma unroll
    for (int i = 0; i < 8; ++i) { const int pc = tid + 512 * i, t = pc >> 4, ch = pc & 15;
        u32x4 v = *(const u32x4*)(plane + (size_t)(t0 + t) * 128 + ch * 8);
        if (kdecay) { const float f = __builtin_amdgcn_exp2f((float)(255 - t) * log2g);
            v.x = pk(__uint_as_float(v.x << 16) * f, __uint_as_float(v.x & 0xffff0000u) * f); v.y = pk(__uint_as_float(v.y << 16) * f, __uint_as_float(v.y & 0xffff0000u) * f);
            v.z = pk(__uint_as_float(v.z << 16) * f, __uint_as_float(v.z & 0xffff0000u) * f); v.w = pk(__uint_as_float(v.w << 16) * f, __uint_as_float(v.w & 0xffff0000u) * f); }
        *(LAS u32x4*)(img + rimg_off(t, ch * 8)) = v; }
}
__device__ __forceinline__ void ret_kv_task(const bf16_t* __restrict__ proj, int bh, int c, float* __restrict__ kvt, lds_ptr lds, int tid) {
    const int b = bh >> 2, h = bh & 3, lane = tid & 63, wave = __builtin_amdgcn_readfirstlane(tid >> 6), r32 = lane & 31, hi = lane >> 5;
    const float log2g = __builtin_amdgcn_logf(1.0f - __builtin_amdgcn_exp2f(-5.0f - (float)h));
    ret_stage(proj + 5 * SEC + (size_t)bh * SEQ * 128, c * 256, lds, tid, false, 0.f);
    ret_stage(proj + 4 * SEC + (size_t)bh * SEQ * 128, c * 256, lds + R_IMG, tid, true, log2g);
    __syncthreads();
    const int et = wave >> 1, dt0 = (wave & 1) * 2;
    const int lbase = hi * 512 + ((lane & 15) >> 2) * 64 + ((lane >> 4) & 1) * 32 + (lane & 3) * 8;
    const lds_cptr va = (lds_cptr)lds + et * 16384 + lbase, kb0 = (lds_cptr)lds + R_IMG + dt0 * 16384 + lbase, kb1 = kb0 + 16384;
    f32x16 a0, a1;
#pragma unroll
    for (int r = 0; r < 16; ++r) { a0[r] = 0.f; a1[r] = 0.f; }
#pragma unroll 4
    for (int ks = 0; ks < 16; ++ks) {
        const bf16x8 vf = cat8(vtr(va + ks * 1024), vtr(va + ks * 1024 + 256));
        const bf16x8 k0 = cat8(vtr(kb0 + ks * 1024), vtr(kb0 + ks * 1024 + 256)), k1 = cat8(vtr(kb1 + ks * 1024), vtr(kb1 + ks * 1024 + 256));
        a0 = __builtin_amdgcn_mfma_f32_32x32x16_bf16(vf, k0, a0, 0, 0, 0);
        a1 = __builtin_amdgcn_mfma_f32_32x32x16_bf16(vf, k1, a1, 0, 0, 0);
    }
    float* dst = kvt + ((size_t)(bh * 64 + c) * 128) * 128;
#pragma unroll
    for (int r = 0; r < 16; ++r) { const int e = et * 32 + crow(r, hi);
        dst[(size_t)e * 128 + dt0 * 32 + r32] = a0[r]; dst[(size_t)e * 128 + dt0 * 32 + 32 + r32] = a1[r]; }
    __syncthreads();
}
__device__ __forceinline__ void ret_scan(const float* __restrict__ kvt, bf16_t* __restrict__ stt, size_t gt, size_t GT) {
    for (size_t i = gt; i < (size_t)8 * 16384; i += GT) {
        const int bh = (int)(i >> 14), ed = (int)(i & 16383), h = bh & 3;
        const float g256 = __builtin_amdgcn_exp2f(256.0f * __builtin_amdgcn_logf(1.0f - __builtin_amdgcn_exp2f(-5.0f - (float)h)));
        float s = 0.f;
#pragma unroll 8
        for (int c = 0; c < 64; ++c) { const size_t o = ((size_t)(bh * 64 + c) << 14) + ed; stt[o] = f2bf(s); s = s * g256 + kvt[o]; }
    }
}
constexpr int RO_A = 0, RO_V = 65536, RO_ST = 131072;
#define RO_STAMP(i) do { if (dts && tid == 0) __hip_atomic_store(dts + (i), (unsigned long long)__builtin_amdgcn_s_memrealtime(), __ATOMIC_RELAXED, __HIP_MEMORY_SCOPE_AGENT); } while (0)
__device__ __forceinline__ void ret_out_task(const bf16_t* __restrict__ proj, const bf16_t* __restrict__ stt, const float* __restrict__ gain, bf16_t* __restrict__ mix, int bh, int c, lds_ptr lds, int tid, unsigned long long* dts = nullptr) {
    RO_STAMP(21);
    const int b = bh >> 2, h = bh & 3, lane = tid & 63, wave = __builtin_amdgcn_readfirstlane(tid >> 6), r32 = lane & 31, hi = lane >> 5;
    const float log2g = __builtin_amdgcn_logf(1.0f - __builtin_amdgcn_exp2f(-5.0f - (float)h));
    const size_t row0 = (size_t)b * SEQ + c * 256;
    u32x4 sreg[4], vreg[8], kreg[8];
    { const bf16_t* sp = stt + ((size_t)(bh * 64 + c) << 14);
#pragma unroll
      for (int i = 0; i < 4; ++i) sreg[i] = *(const u32x4*)(sp + (size_t)(tid + 512 * i) * 8); }
    const size_t hrow0 = (size_t)bh * SEQ + c * 256;
#pragma unroll
    for (int i = 0; i < 8; ++i) { const int pc = tid + 512 * i, t = pc >> 4, ch = pc & 15; const bf16_t* src = proj + (hrow0 + t) * 128 + ch * 8;
        vreg[i] = *(const u32x4*)(src + 5 * SEC); kreg[i] = *(const u32x4*)(src + 4 * SEC); }
    bf16x8 qf[8];
    { const bf16_t* qp = proj + 3 * SEC + (hrow0 + wave * 32 + r32) * 128 + hi * 8;
#pragma unroll
      for (int ks = 0; ks < 8; ++ks) qf[ks] = *(const bf16x8*)(qp + ks * 16); }
#pragma unroll
    for (int i = 0; i < 4; ++i) { const int pc = tid + 512 * i, e = pc >> 4, ch = pc & 15; *(LAS u32x4*)(lds + RO_A + ch * 2048 + e * 16) = sreg[i]; }
#pragma unroll
    for (int i = 0; i < 8; ++i) { const int pc = tid + 512 * i, t = pc >> 4, ch = pc & 15; *(LAS u32x4*)(lds + RO_V + rimg_off(t, ch * 8)) = vreg[i]; }
    __syncthreads();
    RO_STAMP(22);
    f32x16 o[4];
#pragma unroll
    for (int et = 0; et < 4; ++et)
#pragma unroll
        for (int r = 0; r < 16; ++r) o[et][r] = 0.f;
    { const lds_cptr sb = (lds_cptr)lds + RO_A + hi * 2048 + r32 * 16;
#pragma unroll
      for (int et = 0; et < 4; ++et)
#pragma unroll
          for (int ks = 0; ks < 8; ++ks) o[et] = __builtin_amdgcn_mfma_f32_32x32x16_bf16(qf[ks], *(const LAS bf16x8*)(sb + ks * 4096 + et * 512), o[et], 0, 0, 0); }
#pragma unroll
    for (int r = 0; r < 16; ++r) { const float f = __builtin_amdgcn_exp2f((float)(wave * 32 + crow(r, hi) + 1) * log2g);
#pragma unroll
        for (int et = 0; et < 4; ++et) o[et][r] *= f; }
    RO_STAMP(23);
    __syncthreads();
#pragma unroll
    for (int i = 0; i < 8; ++i) { const int pc = tid + 512 * i, t = pc >> 4, ch = pc & 15; *(LAS u32x4*)(lds + RO_A + ch * 4096 + t * 16) = kreg[i]; }
    __syncthreads();
    u32x4 rgv[8];
#pragma unroll
    for (int g = 0; g < 4; ++g)
#pragma unroll
        for (int k = 0; k < 2; ++k) { const int pidx = lane + 64 * k; rgv[2 * g + k] = *(const u32x4*)(proj + 6 * SEC + (hrow0 + wave * 32 + 8 * g + (pidx >> 4)) * 128 + (pidx & 15) * 8); }
    const lds_cptr vp = (lds_cptr)lds + RO_V + ((lane >> 4) & 1) * 32 + (lane & 3) * 8 + (4 * hi + ((lane & 15) >> 2)) * 64;
    const lds_cptr kpb = (lds_cptr)lds + RO_A + hi * 4096 + r32 * 16;
    for (int kvt = 0; kvt <= wave; ++kvt) {
        f32x16 p;
#pragma unroll
        for (int r = 0; r < 16; ++r) p[r] = 0.f;
#pragma unroll
        for (int ks = 0; ks < 8; ++ks) p = __builtin_amdgcn_mfma_f32_32x32x16_bf16(*(const LAS bf16x8*)(kpb + ks * 8192 + kvt * 512), qf[ks], p, 0, 0, 0);
        const int dbase = 32 * (wave - kvt) + r32 - 4 * hi;
#pragma unroll
        for (int r = 0; r < 16; ++r) { const int dist = dbase - ((r & 3) + 8 * (r >> 2)); p[r] = dist >= 0 ? p[r] * __builtin_amdgcn_exp2f((float)dist * log2g) : 0.f; }
        const u32x4 pw0 = {pk(p[0], p[1]), pk(p[2], p[3]), pk(p[4], p[5]), pk(p[6], p[7])}, pw1 = {pk(p[8], p[9]), pk(p[10], p[11]), pk(p[12], p[13]), pk(p[14], p[15])};
        const lds_cptr vt = vp + kvt * 2048;
#pragma unroll
        for (int et = 0; et < 4; ++et) {
            o[et] = __builtin_amdgcn_mfma_f32_32x32x16_bf16(__builtin_bit_cast(bf16x8, pw0), cat8(vtr(vt + et * 16384), vtr(vt + et * 16384 + 512)), o[et], 0, 0, 0);
            o[et] = __builtin_amdgcn_mfma_f32_32x32x16_bf16(__builtin_bit_cast(bf16x8, pw1), cat8(vtr(vt + et * 16384 + 1024), vtr(vt + et * 16384 + 1536)), o[et], 0, 0, 0);
        }
    }
    RO_STAMP(24);
    float mu[16], rstd[16];
#pragma unroll
    for (int r = 0; r < 16; ++r) {
        float s = (o[0][r] + o[1][r]) + (o[2][r] + o[3][r]);
        s += __shfl_xor(s, 1); s += __shfl_xor(s, 2); s += __shfl_xor(s, 4); s += __shfl_xor(s, 8); s += __shfl_xor(s, 16);
        mu[r] = s * (1.0f / 128.0f);
        const float d0 = o[0][r] - mu[r], d1 = o[1][r] - mu[r], d2 = o[2][r] - mu[r], d3 = o[3][r] - mu[r];
        float q = (d0 * d0 + d1 * d1) + (d2 * d2 + d3 * d3);
        q += __shfl_xor(q, 1); q += __shfl_xor(q, 2); q += __shfl_xor(q, 4); q += __shfl_xor(q, 8); q += __shfl_xor(q, 16);
        rstd[r] = rsqrtf(q * (1.0f / 128.0f) + GN_EPS);
    }
    float gn[4];
#pragma unroll
    for (int et = 0; et < 4; ++et) gn[et] = gain[h * 128 + et * 32 + r32];
    LAS bf16_t* st = (LAS bf16_t*)(lds + RO_ST) + wave * 1024;
#pragma unroll
    for (int g = 0; g < 4; ++g) {
#pragma unroll
        for (int rr = 0; rr < 4; ++rr) { const int r = 4 * g + rr;
#pragma unroll
            for (int et = 0; et < 4; ++et) st[(rr + 4 * hi) * 128 + et * 32 + r32] = f2bf((o[et][r] - mu[r]) * rstd[r] * gn[et]); }
#pragma unroll
        for (int k = 0; k < 2; ++k) { const int pidx = lane + 64 * k, r8 = pidx >> 4, ch = pidx & 15; const size_t row = row0 + wave * 32 + 8 * g + r8;
            const u32x4 nv = *(const LAS u32x4*)(st + r8 * 128 + ch * 8); const u32x4 gv = rgv[2 * g + k];
            const unsigned nw[4] = {nv.x, nv.y, nv.z, nv.w}, gw_[4] = {gv.x, gv.y, gv.z, gv.w}; unsigned ow[4];
#pragma unroll
            for (int q = 0; q < 4; ++q) { const float g0 = __uint_as_float(gw_[q] << 16), g1 = __uint_as_float(gw_[q] & 0xffff0000u);
                ow[q] = pk(__uint_as_float(nw[q] << 16) * (g0 / (1.0f + __expf(-g0))), __uint_as_float(nw[q] & 0xffff0000u) * (g1 / (1.0f + __expf(-g1)))); }
            *(u32x4*)(mix + row * DM + 512 + h * 128 + ch * 8) = (u32x4){ow[0], ow[1], ow[2], ow[3]}; }
    }
    RO_STAMP(25);
    __syncthreads();
    RO_STAMP(26);
}
#undef RO_STAMP
}
#ifndef DIAG_K
#define DIAG_K -1
#endif
#ifndef DIAG_BLOCK
#define DIAG_BLOCK 100
#endif
#ifndef DIAG_SCALE
#define DIAG_SCALE 1.0f
#endif
#ifndef DIAG_A
#define DIAG_A 45
#endif
#ifndef DIAG_B
#define DIAG_B 6
#endif
#ifndef REP_MASK
#define REP_MASK 0
#endif
#ifndef REP_SUB
#define REP_SUB 7
#endif
#include <hip/hip_cooperative_groups.h>
namespace cg = cooperative_groups;
constexpr int NWAVES = 8, NTHREADS = 512;
constexpr int LDS_BYTES = 147456 + 256;
constexpr int NPH = 10;
constexpr size_t WS_STASH = 180 * MiB;
constexpr size_t STASH_ELEMS = (size_t)512 * 2 * FF;

struct Args { const float* in[16]; float* out; unsigned char* ws; int ph_lo, ph_hi, flags, pad; };

__device__ __forceinline__ void p0_transpose_item(const float* __restrict__ W, int K, int N, const float* __restrict__ gk, bf16_t* __restrict__ WT, int k0, int n0, int orow0, LAS float* scr, int lane) {
    { float4 v[8];
#pragma unroll
      for (int i = 0; i < 8; ++i) v[i] = *(const float4*)(W + (size_t)(k0 + 8 * i + (lane >> 3)) * N + n0 + (lane & 7) * 4);
#pragma unroll
      for (int i = 0; i < 8; ++i) { const int kk = 8 * i + (lane >> 3); const float g = gk ? gk[k0 + kk] : 1.0f; LAS float* d = scr + kk * 33 + (lane & 7) * 4;
          d[0] = v[i].x * g; d[1] = v[i].y * g; d[2] = v[i].z * g; d[3] = v[i].w * g; } }
    asm volatile("s_waitcnt lgkmcnt(0)" ::: "memory");
    const int c = lane & 7;
#pragma unroll
    for (int j = 0; j < 4; ++j) { const int n = (lane >> 3) + 8 * j; const LAS float* s = scr + (8 * c) * 33 + n;
        uint4 o; o.x = (u32)f2bf(s[0 * 33]) | ((u32)f2bf(s[1 * 33]) << 16); o.y = (u32)f2bf(s[2 * 33]) | ((u32)f2bf(s[3 * 33]) << 16);
        o.z = (u32)f2bf(s[4 * 33]) | ((u32)f2bf(s[5 * 33]) << 16); o.w = (u32)f2bf(s[6 * 33]) | ((u32)f2bf(s[7 * 33]) << 16);
        *(uint4*)(WT + (size_t)(orow0 + n) * K + k0 + 8 * c) = o; }
    asm volatile("s_waitcnt lgkmcnt(0)" ::: "memory");
}

#define XB_TMO      128
#define XB_XCNT(j)  (256  + 64 * (j))
#define XB_XSUB(j)  (1280 + 64 * (j))
#define XB_XGEN(j)  (2304 + 64 * (j))
#define XB_TOP      3328
#define XB_TOPGEN   3392
#define XCD_BAR_WORDS 3456
#define XB_SPIN_CAP (1u << 18)

__device__ __forceinline__ unsigned xb_ld(unsigned* p)              { return __hip_atomic_load(p, __ATOMIC_RELAXED, __HIP_MEMORY_SCOPE_AGENT); }
__device__ __forceinline__ unsigned xb_add(unsigned* p, unsigned v) { return __hip_atomic_fetch_add(p, v, __ATOMIC_RELAXED, __HIP_MEMORY_SCOPE_AGENT); }
__device__ __forceinline__ unsigned xb_xcc_id() { return (unsigned)__builtin_amdgcn_s_getreg((3 << 11) | 20) & 0xFu; }
#define XB_SPIN(cond, bar) do { unsigned _sp = 0; while (cond) { __builtin_amdgcn_s_sleep(1); \
    if ((++_sp & 255u) == 0u) { if (xb_ld(&(bar)[XB_TMO])) break; if (_sp > XB_SPIN_CAP) { atomicAdd(&(bar)[XB_TMO], 1u); break; } } } } while (0)

struct XcdBarrier {
    unsigned* bar; unsigned x;
    volatile LAS unsigned* st;
};

__device__ __forceinline__ XcdBarrier xcd_barrier_post(unsigned* bar, volatile LAS unsigned* st) {
    XcdBarrier b; b.bar = bar; b.x = xb_xcc_id(); b.st = st;
    if (threadIdx.x == 0) (void)xb_add(&bar[XB_XCNT(b.x)], 1u);
    return b;
}
__device__ __forceinline__ void xcd_barrier_complete(unsigned* bar, unsigned x, unsigned& nloc, unsigned& nx) {
    const unsigned G = gridDim.x * gridDim.y * gridDim.z;
    unsigned sum, cnt, mine, sp = 0u;
    for (;;) {
        sum = 0u; cnt = 0u; mine = 0u;
#pragma unroll
        for (unsigned j = 0; j < 16; ++j) { const unsigned c = xb_ld(&bar[XB_XCNT(j)]); sum += c; cnt += (c > 0u) ? 1u : 0u; mine = (j == x) ? c : mine; }
        if (sum == G) break;
        __builtin_amdgcn_s_sleep(1);
        if ((++sp & 255u) == 0u) { if (xb_ld(&bar[XB_TMO])) break; if (sp > XB_SPIN_CAP) { atomicAdd(&bar[XB_TMO], 1u); break; } }
    }
    nloc = mine > 0u ? mine : 1u; nx = cnt > 0u ? cnt : 1u;
}

__device__ __forceinline__ void xcd_barrier(const XcdBarrier& b) {
    asm volatile("s_waitcnt vmcnt(0)" ::: "memory");
    __syncthreads();
    if (threadIdx.x == 0) {
        unsigned* bar = b.bar;
        __builtin_amdgcn_s_waitcnt(0);
        unsigned nloc = b.st[0], nx = b.st[1];
        if (nloc == 0u) { xcd_barrier_complete(bar, b.x, nloc, nx); b.st[0] = nloc; b.st[1] = nx; }
        const unsigned old = xb_add(&bar[XB_XSUB(b.x)], 1u);
        const unsigned gen = old / nloc;
        if (old + 1u == (gen + 1u) * nloc) {
            __builtin_amdgcn_fence(__ATOMIC_RELEASE, "agent");
            asm volatile("s_waitcnt vmcnt(0)" ::: "memory");
            const unsigned og = xb_add(&bar[XB_TOP], 1u);
            const unsigned tg = og / nx;
            if (og + 1u == (tg + 1u) * nx) xb_add(&bar[XB_TOPGEN], 1u);
            else XB_SPIN(xb_ld(&bar[XB_TOPGEN]) == tg, bar);
            __builtin_amdgcn_fence(__ATOMIC_ACQUIRE, "agent");
            xb_add(&bar[XB_XGEN(b.x)], 1u);
            asm volatile("s_waitcnt vmcnt(0)" ::: "memory");
        } else {
            XB_SPIN(xb_ld(&bar[XB_XGEN(b.x)]) == gen, bar);
            __builtin_amdgcn_fence(__ATOMIC_ACQUIRE, "agent");
            asm volatile("s_waitcnt vmcnt(0)" ::: "memory");
        }
    }
    __syncthreads();
}

constexpr int CW_BAR = 4096;
constexpr int LDS_BARST = 147456;
constexpr size_t CTL_ZERO_BYTES = 65536;
constexpr int CW_PANEL = 8192;

#if (REP_MASK >> 2) & 1
#define SUBON2(bit) (rep == 0 || ((REP_SUB >> (bit)) & 1))
#else
#define SUBON2(bit) true
#endif
#if (REP_MASK >> 3) & 1
#define SUBON3(bit) (rep == 0 || ((REP_SUB >> (bit)) & 1))
#else
#define SUBON3(bit) true
#endif
#if (REP_MASK >> 4) & 1
#define SUBON4(bit) (rep == 0 || ((REP_SUB >> (bit)) & 1))
#else
#define SUBON4(bit) true
#endif
__global__ void __launch_bounds__(NTHREADS, 2) mega(Args a) {
    extern __shared__ __attribute__((aligned(16))) unsigned char lds[];
    cg::grid_group grid = cg::this_grid();
    const int wave = __builtin_amdgcn_readfirstlane(threadIdx.x >> 6);
#define MKLANE() ({ int l_; asm volatile("v_mbcnt_lo_u32_b32 %0, -1, 0\n\tv_mbcnt_hi_u32_b32 %0, -1, %0" : "=v"(l_)); l_; })
#define MKTID() (wave * 64 + MKLANE())
#define tid MKTID()
#define lane MKLANE()
    const int G = gridDim.x, bx = blockIdx.x;
    const int vcu = (G % 8 == 0) ? (bx % 8) * (G / 8) + bx / 8 : bx;
    const int gw = vcu * NWAVES + wave, NGW = G * NWAVES;
    unsigned char* ws = a.ws;
    const float* x = a.in[0]; const float* p = a.in[1]; const float* attn_norm = a.in[2]; const float* w_in = a.in[3]; const float* ret_norm = a.in[4]; const float* w_out = a.in[5];
    const float* ffn_norm = a.in[6]; const float* w_up = a.in[7]; const float* w_gate = a.in[8]; const float* conv_w = a.in[9]; const float* conv_b = a.in[10]; const float* w_down = a.in[11];
    const float* ple_norm = a.in[12]; const float* w_ple = a.in[13]; const float* w_ple_gate = a.in[14]; const float* final_norm = a.in[15];
    float* out = a.out;
    bf16_t* Win_t = (bf16_t*)(ws + WS_WIN); bf16_t* Wout_t = (bf16_t*)(ws + WS_WOUT); bf16_t* Wug_t = (bf16_t*)(ws + WS_WUG); bf16_t* Wdown_t = (bf16_t*)(ws + WS_WDOWN);
    bf16_t* Wpg_t = (bf16_t*)(ws + WS_WPG); bf16_t* Wple_t = (bf16_t*)(ws + WS_WPLE);
    bf16_t* XN = (bf16_t*)(ws + WS_R1); bf16_t* MIX = (bf16_t*)(ws + WS_SEG); bf16_t* PW = (bf16_t*)(ws + WS_R1);
    float* RS0 = (float*)(ws + WS_CNT + 768 * 1024);
    float2* QSB = (float2*)(ws + WS_RSQ);
    bf16_t* XB = (bf16_t*)(ws + WS_R2);
    bf16_t* PROJ = (bf16_t*)(ws + WS_PROJ); bf16_t* ACT = (bf16_t*)(ws + WS_PROJ);
    bf16_t* PB = (bf16_t*)(ws + WS_PB); float* RSQ = (float*)(ws + WS_RSQ);
    float* KM = (float*)(ws + WS_KMEAN);
    float* UL = (float*)(ws + WS_STASH); float* UF = UL + STASH_ELEMS; float* GF = UF + STASH_ELEMS;
    float* KVT = (float*)(ws + WS_KVT); bf16_t* STT = (bf16_t*)(ws + WS_STT); float* PART_L = (float*)(ws + WS_PARTL); bf16_t* PART_O = (bf16_t*)out;
    u32* SEL = (u32*)(ws + WS_SEL); unsigned short* SEG = (unsigned short*)(ws + WS_SEG); int* CNT = (int*)(ws + WS_CNT);

    const int lo = a.ph_lo, hi = a.ph_hi;
#if DIAG_K >= 0
    unsigned long long* dts = (unsigned long long*)(ws + WS_CTL + 49152);
#define DIAG_STAMP(i) do { if (bx == DIAG_BLOCK && wave == 0 && MKLANE() == 0) __hip_atomic_store(dts + (i), (unsigned long long)__builtin_amdgcn_s_memrealtime(), __ATOMIC_RELAXED, __HIP_MEMORY_SCOPE_AGENT); } while (0)
    DIAG_STAMP(0);
#define DIAG_DTS(it) ((bx == DIAG_BLOCK && (it) == bx) ? dts : (unsigned long long*)nullptr)
#else
#define DIAG_STAMP(i) do { } while (0)
#define DIAG_DTS(it) ((unsigned long long*)nullptr)
#endif
#define IN(k) (lo <= (k) && (k) < hi)
#define SEAM(k) do { if (IN(k) && IN((k) + 1)) { DIAG_STAMP(40 + (k)); if (a.ph_lo < 0) grid.sync(); else xcd_barrier(xbar); DIAG_STAMP(1 + (k)); } } while (0)
    { volatile LAS unsigned* st = (volatile LAS unsigned*)((LAS unsigned char*)lds + LDS_BARST); if (tid < 2) st[tid] = 0u; }
    __syncthreads();
    XcdBarrier xbar = xcd_barrier_post((unsigned*)(ws + WS_CTL) + CW_BAR, (volatile LAS unsigned*)((LAS unsigned char*)lds + LDS_BARST));

#if (REP_MASK >> 0) & 1
    for (int rep = 0; rep < 2; ++rep)
#endif
    if (IN(0)) {
        LAS float* scr = (LAS float*)(lds) + wave * (64 * 33);
        constexpr int I_IN = 16 * (NPROJ / 32), I_OUT = 16 * (DM / 32), I_UP = 16 * (FF / 32), I_DOWN = (FF / 64) * (DM / 32), I_PG = 16 * (DM / 32), I_PLE = (PLED / 64) * (DM / 32);
        constexpr int NITEMS = I_IN + I_OUT + 2 * I_UP + I_DOWN + I_PG + I_PLE;
        for (int it = gw; it < NITEMS; it += NGW) {
            int r = it;
            if (r < I_IN) { const int nb = r % (NPROJ / 32), kb = r / (NPROJ / 32); p0_transpose_item(w_in, DM, NPROJ, nullptr, Win_t, kb * 64, nb * 32, nb * 32, scr, lane); continue; } r -= I_IN;
            if (r < I_OUT) { const int nb = r % (DM / 32), kb = r / (DM / 32); p0_transpose_item(w_out, DM, DM, nullptr, Wout_t, kb * 64, nb * 32, nb * 32, scr, lane); continue; } r -= I_OUT;
            if (r < I_UP) { const int nb = r % (FF / 32), kb = r / (FF / 32), n0 = nb * 32; p0_transpose_item(w_up, DM, FF, ffn_norm, Wug_t, kb * 64, n0, (n0 >> 7) * 256 + (n0 & 127), scr, lane); continue; } r -= I_UP;
            if (r < I_UP) { const int nb = r % (FF / 32), kb = r / (FF / 32), n0 = nb * 32; p0_transpose_item(w_gate, DM, FF, ffn_norm, Wug_t, kb * 64, n0, (n0 >> 7) * 256 + 128 + (n0 & 127), scr, lane); continue; } r -= I_UP;
            if (r < I_DOWN) { const int nb = r % (DM / 32), kb = r / (DM / 32); p0_transpose_item(w_down, FF, DM, nullptr, Wdown_t, kb * 64, nb * 32, nb * 32, scr, lane); continue; } r -= I_DOWN;
            if (r < I_PG) { const int nb = r % (DM / 32), kb = r / (DM / 32); p0_transpose_item(w_ple_gate, DM, DM, ple_norm, Wpg_t, kb * 64, nb * 32, nb * 32, scr, lane); continue; } r -= I_PG;
            { const int nb = r % (DM / 32), kb = r / (DM / 32); p0_transpose_item(w_ple, PLED, DM, nullptr, Wple_t, kb * 64, nb * 32, nb * 32, scr, lane); }
        }
        DIAG_STAMP(12);
        for (int m = gw; m < MT; m += 2 * NGW) {
            const int m2 = m + NGW;
            const float4* xr = (const float4*)(x + (size_t)m * DM); const float4* xr2 = (const float4*)(x + (size_t)m2 * DM); float4 v[4], w[4]; float s = 0.f, s2 = 0.f;
#pragma unroll
            for (int j = 0; j < 4; ++j) { v[j] = xr[lane + 64 * j]; w[j] = xr2[lane + 64 * j]; }
#pragma unroll
            for (int j = 0; j < 4; ++j) { s += v[j].x * v[j].x + v[j].y * v[j].y + v[j].z * v[j].z + v[j].w * v[j].w; s2 += w[j].x * w[j].x + w[j].y * w[j].y + w[j].z * w[j].z + w[j].w * w[j].w; }
            const float rs = rsqrtf(wave_sum(s) * (1.0f / DM) + RMS_EPS), rs2 = rsqrtf(wave_sum(s2) * (1.0f / DM) + RMS_EPS);
            if (lane == 0) { RS0[m] = rs; RS0[m2] = rs2; }
#pragma unroll
            for (int j = 0; j < 4; ++j) { const float4 gg = ((const float4*)attn_norm)[lane + 64 * j];
                ushort4 o; o.x = f2bf(v[j].x * rs * gg.x); o.y = f2bf(v[j].y * rs * gg.y); o.z = f2bf(v[j].z * rs * gg.z); o.w = f2bf(v[j].w * rs * gg.w);
                ((ushort4*)(XN + (size_t)m * DM))[lane + 64 * j] = o;
                ushort4 o2; o2.x = f2bf(w[j].x * rs2 * gg.x); o2.y = f2bf(w[j].y * rs2 * gg.y); o2.z = f2bf(w[j].z * rs2 * gg.z); o2.w = f2bf(w[j].w * rs2 * gg.w);
                ((ushort4*)(XN + (size_t)m2 * DM))[lane + 64 * j] = o2; }
        }
        DIAG_STAMP(13);
        { const size_t n4 = (size_t)MT * PLED / 4; const size_t gt = (size_t)vcu * NTHREADS + tid, GT = (size_t)G * NTHREADS;
          for (size_t i = gt; i < n4; i += GT) { const float4 v = ((const float4*)p)[i]; ushort4 o; o.x = f2bf(v.x); o.y = f2bf(v.y); o.z = f2bf(v.z); o.w = f2bf(v.w); ((ushort4*)PB)[i] = o; }
          for (size_t i = gt; i < 16 * 64 * 64; i += GT) KM[i] = 0.f;
          if (gt < 64) ((int*)(ws + WS_CTL))[gt] = 0;
          for (size_t i = gt; i < 16 * 64 * 64; i += GT) CNT[i] = 0; }
    }
    SEAM(0);
#if (REP_MASK >> 1) & 1
    if (IN(1)) {
        pg8::Gemm g{XN, Win_t, MT, NPROJ, DM}; pg8::StaticOrder S; S.init(MT, NPROJ, G, bx);
        pg8::EpiProj E{PROJ, KM};
        pg8::gemm_phase<pg8::EpiProj, pg8::StaticOrder, true, true>((PG8_LAS unsigned char*)lds, g, S, E, MKTID());
    }
    asm volatile("" ::: "memory");
#endif
    if (IN(1)) {
        pg8::Gemm g{XN, Win_t, MT, NPROJ, DM}; pg8::StaticOrder S; S.init(MT, NPROJ, G, bx);
        pg8::EpiProj E{PROJ, KM};
        pg8::gemm_phase<pg8::EpiProj, pg8::StaticOrder, true, true>((PG8_LAS unsigned char*)lds, g, S, E, MKTID());
    }
    SEAM(1);
#if (REP_MASK >> 2) & 1
    { const int rep = 1; (void)rep;
    if (IN(2)) {
        mx::lds_ptr L = (mx::lds_ptr)lds;
        if (!(a.flags & 1) && SUBON2(0)) for (int it = bx; it < 512; it += G) mx::ret_kv_task(PROJ, it >> 6, it & 63, KVT, L, tid);
        if (!(a.flags & 2)) {
            if (SUBON2(1)) for (int it = bx; it < 16 * 63; it += G) mx::gate_task_mfma(it / 63, 1 + it % 63, PROJ, KM, SEL, SEG, CNT, QSB, L, tid);
            { const int gtid = vcu * NTHREADS + tid; if (gtid < BATCH * 256 * 8) { const int h = gtid & 7, t = (gtid >> 3) & 255, b = gtid >> 11; SEL[((size_t)b * SEQ + t) * 8 + h] = 0u; } }
        }
    }
    }
    asm volatile("" ::: "memory");
#endif
    { const int rep = 0; (void)rep;
    if (IN(2)) {
        mx::lds_ptr L = (mx::lds_ptr)lds;
        if (!(a.flags & 1) && SUBON2(0)) for (int it = bx; it < 512; it += G) mx::ret_kv_task(PROJ, it >> 6, it & 63, KVT, L, tid);
        DIAG_STAMP(14);
        if (!(a.flags & 2)) {
            if (SUBON2(1)) for (int it = bx; it < 16 * 63; it += G) mx::gate_task_mfma(it / 63, 1 + it % 63, PROJ, KM, SEL, SEG, CNT, QSB, L, tid);
        DIAG_STAMP(15);
            { const int gtid = vcu * NTHREADS + tid; if (gtid < BATCH * 256 * 8) { const int h = gtid & 7, t = (gtid >> 3) & 255, b = gtid >> 11; SEL[((size_t)b * SEQ + t) * 8 + h] = 0u; } }
        }
    }
    }
    SEAM(2);
#if (REP_MASK >> 3) & 1
#define QREP rep
#else
#define QREP 0
#endif
#if (REP_MASK >> 3) & 1
    for (int rep = 0; rep < 2; ++rep)
#endif
    if (IN(3)) {
        mx::lds_ptr L = (mx::lds_ptr)lds;
        if (!(a.flags & 1) && SUBON3(0)) mx::ret_scan(KVT, STT, (size_t)vcu * NTHREADS + tid, (size_t)G * NTHREADS);
        DIAG_STAMP(18);
        if (!(a.flags & 2) && SUBON3(1)) {
            LAS int* qslot = (LAS int*)(L + mx::L_PREF + 384);
            for (;;) {
                if (tid == 0) *qslot = atomicAdd((int*)(ws + WS_CTL) + QREP, 1);
                __syncthreads();
                const int q = *qslot;
                __syncthreads();
                if (q >= 16 * 63) break;
                mx::moba_sel_task(PROJ, SEG, CNT, QSB, q & 15, q >> 4, PART_O, PART_L, L, tid);
            }
        }
        DIAG_STAMP(19);
    }
    SEAM(3);
#if (REP_MASK >> 4) & 1
    { const int rep = 1; (void)rep;
    if (IN(4)) {
        mx::lds_ptr L = (mx::lds_ptr)lds;
        if (!(a.flags & 1) && SUBON4(0)) for (int it = bx; it < 512; it += G) mx::ret_out_task(PROJ, STT, ret_norm, MIX, it >> 6, it & 63, L, tid);
        if (!(a.flags & 2) && SUBON4(1)) for (int it = bx; it < 16 * 64; it += G) mx::moba_diag_unit(PROJ, it >> 6, it & 63, PART_O, PART_L, SEL, MIX, L, tid);
    }
    }
    asm volatile("" ::: "memory");
#endif
    { const int rep = 0; (void)rep;
    if (IN(4)) {
        mx::lds_ptr L = (mx::lds_ptr)lds;
        if (vcu & 1) for (int it = bx; it < 16 * 64; it += G) mx::moba_diag_unit(PROJ, it >> 6, it & 63, PART_O, PART_L, SEL, MIX, L, tid);
        for (int it = bx; it < 512; it += G) mx::ret_out_task(PROJ, STT, ret_norm, MIX, it >> 6, it & 63, L, tid, DIAG_DTS(it));
        DIAG_STAMP(16);
        if (!(vcu & 1)) for (int it = bx; it < 16 * 64; it += G) mx::moba_diag_unit(PROJ, it >> 6, it & 63, PART_O, PART_L, SEL, MIX, L, tid);
        DIAG_STAMP(17);
    }
    }
    SEAM(4);
#if (REP_MASK >> 5) & 1
    if (IN(5)) {
        pg8::Gemm g{MIX, Wout_t, MT, DM, DM}; pg8::StaticOrder S; S.init(MT, DM, G, bx);
        pg8::EpiRes<false> E{x, XB, RSQ};
        pg8::gemm_phase<pg8::EpiRes<false>, pg8::StaticOrder, true, true>((PG8_LAS unsigned char*)lds, g, S, E, MKTID());
    }
    asm volatile("" ::: "memory");
#endif
    if (IN(5)) {
        pg8::Gemm g{MIX, Wout_t, MT, DM, DM}; pg8::StaticOrder S; S.init(MT, DM, G, bx);
        pg8::EpiResXN E{XN, RS0, attn_norm, XB, RSQ};
        pg8::gemm_phase<pg8::EpiResXN, pg8::StaticOrder, true, true>((PG8_LAS unsigned char*)lds, g, S, E, MKTID());
    }
    SEAM(5);
#if (REP_MASK >> 6) & 1
    if (IN(6)) {
        pg8::Gemm g{XB, Wug_t, MT, 2 * FF, DM}; pg8::StaticOrder S; S.init(MT, 2 * FF, G, bx);
        pg8::EpiUG E{ACT, RSQ, conv_w, conv_b, UL, UF, GF};
        pg8::gemm_phase<pg8::EpiUG, pg8::StaticOrder, true, true>((PG8_LAS unsigned char*)lds, g, S, E, MKTID());
    }
    asm volatile("" ::: "memory");
#endif
    if (IN(6)) {
        pg8::Gemm g{XB, Wug_t, MT, 2 * FF, DM}; pg8::StaticOrder S; S.init(MT, 2 * FF, G, bx);
        pg8::EpiUG E{ACT, RSQ, conv_w, conv_b, UL, UF, GF};
        pg8::gemm_phase<pg8::EpiUG, pg8::StaticOrder, true, true>((PG8_LAS unsigned char*)lds, g, S, E, MKTID());
    }
    SEAM(6);
#if (REP_MASK >> 7) & 1
    for (int rep = 0; rep < 2; ++rep)
#endif
    if (IN(7)) {
        const size_t gt = (size_t)vcu * NTHREADS + tid, GT = (size_t)G * NTHREADS;
        for (size_t i = gt; i < (size_t)512 * 2 * (FF / 4); i += GT) {
            const int c = (int)(i % (FF / 4)) * 4, r = (int)((i / (FF / 4)) & 1), g64 = (int)(i / (FF / 4) / 2);
            const bool first = (g64 & 255) == 0; const size_t pg = first ? 0 : (size_t)(g64 - 1);
            const pg8::f32x4 q0 = *(const pg8::f32x4*)(UL + (pg * 2 + 0) * FF + c), q1 = *(const pg8::f32x4*)(UL + (pg * 2 + 1) * FF + c);
            const pg8::f32x4 f0 = *(const pg8::f32x4*)(UF + ((size_t)g64 * 2 + 0) * FF + c), f1 = *(const pg8::f32x4*)(UF + ((size_t)g64 * 2 + 1) * FF + c);
            const pg8::f32x4 gg = *(const pg8::f32x4*)(GF + ((size_t)g64 * 2 + r) * FF + c);
            const pg8::f32x4 w0 = *(const pg8::f32x4*)(conv_w + c), w1 = *(const pg8::f32x4*)(conv_w + FF + c), w2 = *(const pg8::f32x4*)(conv_w + 2 * FF + c), cb = *(const pg8::f32x4*)(conv_b + c);
            const float z = first ? 0.f : 1.f;
            const pg8::f32x4 p0 = q0 * z, p1 = q1 * z;
            const pg8::f32x4 u2 = r == 0 ? p0 : p1, u1 = r == 0 ? p1 : f0, u0 = r == 0 ? f0 : f1;
            const pg8::f32x4 y = cb + w0 * u2 + w1 * u1 + w2 * u0;
            ushort4 o; o.x = f2bf(gelu_tanh(y[0]) * gg[0]); o.y = f2bf(gelu_tanh(y[1]) * gg[1]); o.z = f2bf(gelu_tanh(y[2]) * gg[2]); o.w = f2bf(gelu_tanh(y[3]) * gg[3]);
            *(ushort4*)(ACT + ((size_t)g64 * 64 + r) * FF + c) = o;
        }
        { int kk = PLED; asm volatile("" : "+s"(kk)); pg8::Gemm g{PB, Wple_t, MT, DM, kk}; pg8::StaticOrder S; S.init(MT, DM, G, bx); pg8::EpiStore E{PW};
          pg8::gemm_phase<pg8::EpiStore, pg8::StaticOrder, true, true>((PG8_LAS unsigned char*)lds, g, S, E, MKTID()); }
    }
    SEAM(7);
#if (REP_MASK >> 8) & 1
    if (IN(8)) {
        pg8::Gemm g{ACT, Wdown_t, MT, DM, FF}; pg8::StaticOrder S; S.init(MT, DM, G, bx);
        pg8::EpiRes<true, false> E{nullptr, XB, RSQ + (size_t)MT * 16};
        pg8::gemm_phase<pg8::EpiRes<true, false>, pg8::StaticOrder, true, true>((PG8_LAS unsigned char*)lds, g, S, E, MKTID());
    }
    asm volatile("" ::: "memory");
#endif
    if (IN(8)) {
        pg8::Gemm g{ACT, Wdown_t, MT, DM, FF}; pg8::StaticOrder S; S.init(MT, DM, G, bx);
        pg8::EpiRes<true> E{nullptr, XB, RSQ + (size_t)MT * 16};
        pg8::gemm_phase<pg8::EpiRes<true>, pg8::StaticOrder, true, true>((PG8_LAS unsigned char*)lds, g, S, E, MKTID());
    }
    SEAM(8);
#if (REP_MASK >> 9) & 1
    if (IN(9)) {
        if (REP_SUB & 1) { int kk = PLED; asm volatile("" : "+s"(kk)); pg8::Gemm g{PB, Wple_t, MT, DM, kk}; pg8::StaticOrder S; S.init(MT, DM, G, bx); pg8::EpiStore E{PW};
          pg8::gemm_phase<pg8::EpiStore, pg8::StaticOrder, true, true>((PG8_LAS unsigned char*)lds, g, S, E, MKTID()); }
        if (REP_SUB & 2) { int kk = DM; const bf16_t* a_ = XB; const bf16_t* b_ = Wpg_t; asm volatile("" : "+s"(kk), "+s"(a_), "+s"(b_) :: "memory"); pg8::Gemm g{a_, b_, MT, DM, kk}; pg8::StaticOrder S; S.init(MT, DM, G, bx); pg8::EpiPleNorm E{out, XB, PW, RSQ + (size_t)MT * 16, RSQ + (size_t)2 * MT * 16, (unsigned*)(ws + WS_CTL) + CW_PANEL, final_norm, DIAG_DTS(bx)};
          pg8::gemm_phase<pg8::EpiPleNorm, pg8::StaticOrder, true, true>((PG8_LAS unsigned char*)lds, g, S, E, MKTID()); }
    }
    asm volatile("" ::: "memory");
#endif
    if (IN(9)) {
        DIAG_STAMP(20);
        { int kk = DM; const bf16_t* a_ = XB; const bf16_t* b_ = Wpg_t; asm volatile("" : "+s"(kk), "+s"(a_), "+s"(b_) :: "memory"); pg8::Gemm g{a_, b_, MT, DM, kk}; pg8::StaticOrder S; S.init(MT, DM, G, bx); pg8::EpiPleNorm E{out, XB, PW, RSQ + (size_t)MT * 16, RSQ + (size_t)2 * MT * 16, (unsigned*)(ws + WS_CTL) + CW_PANEL, final_norm, DIAG_DTS(bx)};
          pg8::gemm_phase<pg8::EpiPleNorm, pg8::StaticOrder, true, true>((PG8_LAS unsigned char*)lds, g, S, E, MKTID()); }
    }
    SEAM(9);
    if (IN(10)) {
        const float* rsq = RSQ + (size_t)2 * MT * 16;
        for (int m = gw; m < MT; m += NGW) {
            const float rs = pg8::rs16(rsq + (size_t)m * 16); float4* xr = (float4*)(out + (size_t)m * DM);
#pragma unroll
            for (int j = 0; j < 4; ++j) { float4 v = xr[lane + 64 * j]; const float4 gg = ((const float4*)final_norm)[lane + 64 * j];
                v.x *= rs * gg.x; v.y *= rs * gg.y; v.z *= rs * gg.z; v.w *= rs * gg.w; xr[lane + 64 * j] = v; }
        }
    }
#if DIAG_K >= 0
    xcd_barrier(xbar); DIAG_STAMP(11);
    xcd_barrier(xbar);
    { const unsigned long long t0 = __hip_atomic_load(dts + 0, __ATOMIC_RELAXED, __HIP_MEMORY_SCOPE_AGENT), t1 = __hip_atomic_load(dts + 11, __ATOMIC_RELAXED, __HIP_MEMORY_SCOPE_AGENT);
      const unsigned long long ta = __hip_atomic_load(dts + (DIAG_K == 99 ? DIAG_A : DIAG_K), __ATOMIC_RELAXED, __HIP_MEMORY_SCOPE_AGENT), tb = DIAG_K == 99 ? __hip_atomic_load(dts + DIAG_B, __ATOMIC_RELAXED, __HIP_MEMORY_SCOPE_AGENT) : (DIAG_K == 9 ? t1 : __hip_atomic_load(dts + DIAG_K + 1, __ATOMIC_RELAXED, __HIP_MEMORY_SCOPE_AGENT));
      const float eps = (float)(tb - ta) / (float)(t1 - t0);
      const float sc = 1.0f + DIAG_SCALE * eps;
      float4* o4 = (float4*)out; const size_t gt = (size_t)vcu * NTHREADS + tid, GT = (size_t)G * NTHREADS;
      for (size_t i = gt; i < (size_t)MT * DM / 4; i += GT) { float4 v = o4[i]; v.x *= sc; v.y *= sc; v.z *= sc; v.w *= sc; o4[i] = v; } }
#endif
#undef IN
#undef SEAM
#undef tid
#undef lane
}

#ifndef BUILD_MODE
#define BUILD_MODE 0
#endif
static int g_grid = 0;
static void launch_mega(Args a, int lo, int hi, hipStream_t stream) {
    a.ph_lo = lo; a.ph_hi = hi; void* args[] = {&a};
    hipError_t e = hipLaunchCooperativeKernel((const void*)mega, dim3(g_grid), dim3(NTHREADS), args, LDS_BYTES, stream);
    if (e != hipSuccess) fprintf(stderr, "cooperative launch [%d,%d) failed: %s (grid %d)\n", lo, hi, hipGetErrorString(e), g_grid);
}
extern "C" void kernel_launch(void* const* d_in, const int* in_sizes, int n_in, void* d_out, int out_size, void* d_ws, size_t ws_size, hipStream_t stream) {
    if (n_in != 16 || out_size != MT * DM || ws_size < WS_END) { fprintf(stderr, "kernel_launch: unexpected shapes (n_in %d out %d ws %zu)\n", n_in, out_size, ws_size); return; }
    if (g_grid == 0) {
        int dev = 0, cus = 0, per_cu = 0;
        hipGetDevice(&dev); hipDeviceGetAttribute(&cus, hipDeviceAttributeMultiprocessorCount, dev);
        hipFuncSetAttribute((const void*)mega, hipFuncAttributeMaxDynamicSharedMemorySize, LDS_BYTES);
        hipOccupancyMaxActiveBlocksPerMultiprocessor(&per_cu, (const void*)mega, NTHREADS, LDS_BYTES);
        if (per_cu < 1) { fprintf(stderr, "occupancy query says %d blocks/CU\n", per_cu); per_cu = 1; }
        g_grid = cus * 1;
        (void)hipGetLastError();
    }
    unsigned char* ws = (unsigned char*)d_ws;
    hipMemsetAsync(ws + WS_CTL, 0, CTL_ZERO_BYTES, stream);
    Args a{}; for (int i = 0; i < 16; ++i) a.in[i] = (const float*)d_in[i]; a.out = (float*)d_out; a.ws = ws;

    a.flags = 0; launch_mega(a, 0, NPH, stream);
}
```

```cpp
#include <hip/hip_runtime.h>
#include <stdint.h>
#include <math.h>
#include <cstdio>

typedef unsigned short bf16_t;
typedef unsigned int u32;

constexpr int BATCH = 2, SEQ = 16384, MT = BATCH * SEQ, DM = 1024, NPROJ = 3584, FF = 2816, PLED = 256;
constexpr int MH = 8, MD = 64, RH = 4, RD = 128, NBLK = 64, BLK = 256;
constexpr int C_MQ = 0, C_MK = 512, C_MV = 1024, C_RQ = 1536, C_RK = 2048, C_RV = 2560, C_RG = 3072;
constexpr float RMS_EPS = 1e-6f, GN_EPS = 1e-5f;
constexpr float LOG2E = 1.4426950408889634f;
constexpr float QSCALE = 0.125f * LOG2E;
constexpr float RKSCALE = 0.08838834764831845f;
constexpr size_t SEC = (size_t)MT * 512;

constexpr size_t MiB = (size_t)1 << 20;
constexpr size_t WS_CTL = 0, WS_WIN = 1 * MiB, WS_WOUT = 8 * MiB, WS_WUG = 10 * MiB, WS_WDOWN = 21 * MiB, WS_WPG = 27 * MiB, WS_WPLE = 29 * MiB;
constexpr size_t WS_RSQ = 30 * MiB;
constexpr size_t WS_PB = 36 * MiB;
constexpr size_t WS_R2 = 52 * MiB;
constexpr size_t WS_R1 = 116 * MiB;
constexpr size_t WS_SEG = 180 * MiB;
constexpr size_t WS_KVT = 212 * MiB;
constexpr size_t WS_STT = 244 * MiB;
constexpr size_t WS_PARTL = 260 * MiB;
constexpr size_t WS_SEL = 264 * MiB;
constexpr size_t WS_CNT = 265 * MiB;
constexpr size_t WS_KMEAN = WS_CNT + 512 * 1024;
constexpr size_t WS_PROJ = 266 * MiB;
constexpr size_t WS_END = 490 * MiB;
constexpr size_t WS_UH = 116 * MiB;

__device__ __forceinline__ float bf2f(bf16_t v) { return __uint_as_float(((u32)v) << 16); }
__device__ __forceinline__ bf16_t f2bf(float f) { u32 u = __float_as_uint(f); return (bf16_t)((u + 0x7fffu + ((u >> 16) & 1u)) >> 16); }
__device__ __forceinline__ float wave_sum(float v) {
#pragma unroll
    for (int o = 1; o < 64; o <<= 1) v += __shfl_xor(v, o);
    return v;
}
__device__ __forceinline__ float rs_from(const float* p) {
    float s = 0.f;
#pragma unroll
    for (int i = 0; i < 16; ++i) s += p[i];
    return rsqrtf(s * (1.0f / DM) + RMS_EPS);
}
__device__ __forceinline__ float gelu_tanh(float x) {
    const float z = 0.7978845608028654f * (x + 0.044715f * x * x * x);
    return x / (1.0f + __expf(-2.0f * z));
}
__device__ __forceinline__ float sigmoidf_(float x) { return 1.0f / (1.0f + __expf(-x)); }


typedef unsigned u32x4_g __attribute__((ext_vector_type(4)));
__device__ __forceinline__ void wt_store16(void* base_uniform, size_t byte_off, u32x4_g v) {
    __builtin_amdgcn_raw_buffer_store_b128(v, __builtin_amdgcn_make_buffer_rsrc(base_uniform, 0, 0x7ffffff0, 0x00020000), (int)byte_off, 0, 16);
}
namespace pg8 {
#define PG8_LAS __attribute__((address_space(3)))
typedef unsigned short bf16_t;
typedef short bf16x8 __attribute__((ext_vector_type(8)));
typedef float f32x4 __attribute__((ext_vector_type(4)));
typedef unsigned u32x4 __attribute__((ext_vector_type(4)));
constexpr int BM = 256, BK = 64, HALF = 128, HTB = HALF * BK * 2  , STAGE_BYTES = 8 * HTB, NXCD = 8, WGM = 8;

__host__ __device__ __forceinline__ int lds_byte(int r, int c) { const int st = (r >> 4) * 2 + (c >> 5), rr = r & 15, cc = c & 31, ob = rr * 64 + cc * 2; return st * 1024 + (ob ^ (((ob >> 9) & 1) << 5)); }
__host__ __device__ __forceinline__ void stage_rc(int b, int& R, int& C) { const int st = b / 1024, sb = b % 1024, swz = sb ^ (((sb >> 9) & 1) << 5); R = (st >> 1) * 16 + swz / 64; C = (st & 1) * 32 + (swz % 64) / 2; }
__host__ __device__ __forceinline__ int perm32(int rho) { const int n = rho >> 4, i = rho & 15; return 8 * (i >> 2) + 4 * n + (i & 3); }

struct Unit { int pm, pn; };
struct Gemm { const bf16_t* A; const bf16_t* Bt; int M, N, K; };

struct StaticOrder {
    int nM, nN, nwg, G, c;
    __host__ __device__ void init(int M, int N, int G_, int c_) { nM = M / BM; nN = N / BM; nwg = nM * nN; G = G_; c = c_; }
    __host__ __device__ bool next(int i, Unit& u) const {
        const long L = (long)i * G + c; if (L >= nwg) return false;
        int wgid = (int)L; { const int q = nwg / NXCD, r = nwg % NXCD, xcd = wgid % NXCD, off = wgid / NXCD; wgid = (xcd < r ? xcd * (q + 1) : r * (q + 1) + (xcd - r) * q) + off; }
        const int nig = WGM * nN, gid = wgid / nig, fm = gid * WGM, gsz = (nM - fm) < WGM ? (nM - fm) : WGM;
        u.pm = fm + ((wgid % nig) % gsz); u.pn = (wgid % nig) / gsz; return true;
    }
    __device__ __forceinline__ void a_ready(const Unit&) const {}
    __device__ __forceinline__ void done(const Unit&) const {}
};

__device__ __forceinline__ unsigned cvt_pk_bf16(float lo, float hi) { unsigned r; asm volatile("v_cvt_pk_bf16_f32 %0, %1, %2" : "=v"(r) : "v"(lo), "v"(hi)); return r; }
typedef float f32x2 __attribute__((ext_vector_type(2)));
template <class Epi, class Sched, bool ALIGN_EPI = false, bool SP2 = false>
__device__ __forceinline__ void gemm_phase(PG8_LAS unsigned char* lds, const Gemm g, const Sched& S, const Epi& E, const int tid_in) {
    const int tid = tid_in, wid = __builtin_amdgcn_readfirstlane(tid >> 6), lane = tid & 63, wr = wid >> 2, wc = wid & 3, fr = lane & 15, fq = lane >> 4;
    const int K = g.K, nt = K / BK;
    unsigned voffA[2], voffB[2];
#pragma unroll
    for (int i = 0; i < 2; ++i) { int R, C; stage_rc(tid * 16 + i * 8192, R, C); const int Rb = Epi::PERM ? ((R & ~31) + perm32(R & 31)) : R;
        voffA[i] = (unsigned)(R * K + C) * 2u; voffB[i] = (unsigned)(Rb * K + C) * 2u; }
    const size_t kstep = (size_t)(BK * 2);
    const size_t hstep = (size_t)HALF * K * 2;
    const size_t tstep = 2 * hstep;
    const unsigned ldsw = (unsigned)wid * 1024u;
    const int aoff = lds_byte(wr * 64 + fr, fq * 8), boff = lds_byte(wc * 32 + fr, fq * 8);
#define PG8_SA(b, h) (((b) * 2 + (h)) * HTB)
#define PG8_SB(b, h) ((4 + (b) * 2 + (h)) * HTB)
#define PG8_STAGE(bufoff, gbase, voff) do { _Pragma("unroll") for (int _i = 0; _i < 2; ++_i) \
        __builtin_amdgcn_global_load_lds((const unsigned*)((const char*)(gbase) + (voff)[_i]), (PG8_LAS unsigned*)(lds + (bufoff) + ldsw + _i * 8192), 16, 0, 0); } while (0)
#define PG8_LDA(dst, b, h) do { _Pragma("unroll") for (int m = 0; m < 4; ++m) _Pragma("unroll") for (int k = 0; k < 2; ++k) dst[m][k] = *(const PG8_LAS bf16x8*)(lds + PG8_SA(b, h) + aoff + m * 2048 + k * 1024); } while (0)
#define PG8_LDB(dst, b, h) do { _Pragma("unroll") for (int n = 0; n < 2; ++n) _Pragma("unroll") for (int k = 0; k < 2; ++k) dst[n][k] = *(const PG8_LAS bf16x8*)(lds + PG8_SB(b, h) + boff + n * 2048 + k * 1024); } while (0)
#define PG8_MMA(ai, bj, At, Bt) do { __builtin_amdgcn_s_setprio(1); _Pragma("unroll") for (int m = 0; m < 4; ++m) _Pragma("unroll") for (int n = 0; n < 2; ++n) _Pragma("unroll") for (int k = 0; k < 2; ++k) \
        acc[ai][bj][m][n] = __builtin_amdgcn_mfma_f32_16x16x32_bf16(Bt[n][k], At[m][k], acc[ai][bj][m][n], 0, 0, 0); __builtin_amdgcn_s_setprio(0); } while (0)
#define PG8_WAIT_V(n) asm volatile("s_waitcnt vmcnt(" #n ")" ::: "memory")
#define PG8_WAIT_L(n) asm volatile("s_waitcnt lgkmcnt(" #n ")" ::: "memory")
#define PG8_BAR __builtin_amdgcn_s_barrier()
#define PG8_SCHED __builtin_amdgcn_sched_barrier(0)
    Unit cur, nxt; int ui = 0;
    if (!S.next(0, cur)) return;
    f32x4 acc[2][2][4][2];
#pragma unroll
    for (int a = 0; a < 2; ++a)
#pragma unroll
        for (int b = 0; b < 2; ++b)
#pragma unroll
            for (int m = 0; m < 4; ++m)
#pragma unroll
                for (int n = 0; n < 2; ++n) acc[a][b][m][n] = (f32x4){0.f, 0.f, 0.f, 0.f};
    bf16x8 At[4][2], B0[2][2], B1[2][2];
    const char* cA = (const char*)g.A + (size_t)cur.pm * tstep; const char* cB = (const char*)g.Bt + (size_t)cur.pn * tstep;
    S.a_ready(cur);
    if constexpr (SP2) {
        PG8_STAGE(PG8_SB(0, 0), cB, voffB); PG8_STAGE(PG8_SB(0, 1), cB + hstep, voffB); PG8_STAGE(PG8_SA(0, 0), cA, voffA); PG8_STAGE(PG8_SA(0, 1), cA + hstep, voffA);
        if (wr == 1) PG8_BAR;
        PG8_WAIT_V(2); PG8_BAR;
        PG8_STAGE(PG8_SB(1, 0), cB + kstep, voffB); PG8_STAGE(PG8_SA(1, 0), cA + kstep, voffA); PG8_STAGE(PG8_SB(1, 1), cB + hstep + kstep, voffB);
        PG8_WAIT_V(6); PG8_BAR;
    } else {
        PG8_STAGE(PG8_SB(0, 0), cB, voffB); PG8_STAGE(PG8_SA(0, 0), cA, voffA); PG8_STAGE(PG8_SB(0, 1), cB + hstep, voffB); PG8_STAGE(PG8_SA(0, 1), cA + hstep, voffA);
        if (wr == 1) PG8_BAR;
        PG8_WAIT_V(4); PG8_BAR;
        PG8_STAGE(PG8_SB(1, 0), cB + kstep, voffB); PG8_STAGE(PG8_SA(1, 0), cA + kstep, voffA); PG8_STAGE(PG8_SB(1, 1), cB + hstep + kstep, voffB);
        PG8_WAIT_V(6); PG8_BAR;
    }
    for (;;) {
        const bool has_next = S.next(ui + 1, nxt);
        const char* nA = has_next ? (const char*)g.A + (size_t)nxt.pm * tstep : cA; const char* nB = has_next ? (const char*)g.Bt + (size_t)nxt.pn * tstep : cB;
        for (int t = 0; t < nt; t += 2) {
            const bool last = (t == nt - 2);
            const char* a1 = cA + (size_t)(t + 1) * kstep;
            const char* a2 = last ? nA : cA + (size_t)(t + 2) * kstep; const char* b2 = last ? nB : cB + (size_t)(t + 2) * kstep;
            const char* a3 = a2 + kstep; const char* b3 = b2 + kstep;
            if (last && has_next) S.a_ready(nxt);
            if constexpr (SP2) {
            PG8_LDB(B0, 0, 0); PG8_LDB(B1, 0, 1); PG8_SCHED; PG8_LDA(At, 0, 0); PG8_STAGE(PG8_SA(1, 1), a1 + hstep, voffA);
            PG8_WAIT_V(8); PG8_WAIT_L(0); PG8_BAR; PG8_MMA(0, 0, At, B0); PG8_MMA(0, 1, At, B1); PG8_BAR; PG8_SCHED;
            PG8_LDA(At, 0, 1); PG8_STAGE(PG8_SB(0, 0), b2, voffB); PG8_STAGE(PG8_SB(0, 1), b2 + hstep, voffB); PG8_STAGE(PG8_SA(0, 0), a2, voffA);
            PG8_WAIT_V(8); PG8_WAIT_L(0); PG8_BAR; PG8_MMA(1, 0, At, B0); PG8_MMA(1, 1, At, B1); PG8_BAR; PG8_SCHED;
            PG8_LDB(B0, 1, 0); PG8_LDB(B1, 1, 1); PG8_SCHED; PG8_LDA(At, 1, 0); PG8_STAGE(PG8_SA(0, 1), a2 + hstep, voffA);
            PG8_WAIT_V(8); PG8_WAIT_L(0); PG8_BAR; PG8_MMA(0, 0, At, B0); PG8_MMA(0, 1, At, B1); PG8_BAR; PG8_SCHED;
            PG8_LDA(At, 1, 1); PG8_STAGE(PG8_SB(1, 0), b3, voffB); PG8_STAGE(PG8_SB(1, 1), b3 + hstep, voffB); PG8_STAGE(PG8_SA(1, 0), a3, voffA);
            PG8_WAIT_V(8); PG8_WAIT_L(0); PG8_BAR; PG8_MMA(1, 0, At, B0); PG8_MMA(1, 1, At, B1); PG8_BAR; PG8_SCHED;
            } else {
            PG8_LDB(B0, 0, 0); PG8_SCHED; PG8_LDA(At, 0, 0); PG8_STAGE(PG8_SA(1, 1), a1 + hstep, voffA);
            PG8_WAIT_L(8); PG8_BAR; PG8_WAIT_L(0); PG8_MMA(0, 0, At, B0); PG8_BAR; PG8_SCHED;
            PG8_LDB(B1, 0, 1); PG8_STAGE(PG8_SB(0, 0), b2, voffB);
            PG8_BAR; PG8_WAIT_L(0); PG8_MMA(0, 1, At, B1); PG8_BAR;
            PG8_LDA(At, 0, 1); PG8_STAGE(PG8_SA(0, 0), a2, voffA);
            PG8_BAR; PG8_WAIT_L(0); PG8_MMA(1, 0, At, B0); PG8_BAR; PG8_SCHED;
            PG8_STAGE(PG8_SB(0, 1), b2 + hstep, voffB);
            PG8_WAIT_V(6); PG8_BAR; PG8_MMA(1, 1, At, B1); PG8_BAR;
            PG8_LDB(B0, 1, 0); PG8_SCHED; PG8_LDA(At, 1, 0); PG8_STAGE(PG8_SA(0, 1), a2 + hstep, voffA);
            PG8_WAIT_L(8); PG8_BAR; PG8_WAIT_L(0); PG8_MMA(0, 0, At, B0); PG8_BAR; PG8_SCHED;
            PG8_LDB(B1, 1, 1); PG8_STAGE(PG8_SB(1, 0), b3, voffB);
            PG8_BAR; PG8_WAIT_L(0); PG8_MMA(0, 1, At, B1); PG8_BAR;
            PG8_LDA(At, 1, 1); PG8_STAGE(PG8_SA(1, 0), a3, voffA);
            PG8_BAR; PG8_WAIT_L(0); PG8_MMA(1, 0, At, B0); PG8_BAR; PG8_SCHED;
            PG8_STAGE(PG8_SB(1, 1), b3 + hstep, voffB);
            PG8_WAIT_V(6); PG8_BAR; PG8_MMA(1, 1, At, B1); PG8_BAR;
            }
        }
        if constexpr (ALIGN_EPI) { if (wr == 0) PG8_BAR; }
        if constexpr (!Epi::AFTER_DRAIN) { E(acc, cur, wr, wc, fr, fq); S.done(cur); }
        if (!has_next) break;
#pragma unroll
        for (int a = 0; a < 2; ++a)
#pragma unroll
            for (int b = 0; b < 2; ++b)
#pragma unroll
                for (int m = 0; m < 4; ++m)
#pragma unroll
                    for (int n = 0; n < 2; ++n) acc[a][b][m][n] = (f32x4){0.f, 0.f, 0.f, 0.f};
        cur = nxt; cA = nA; cB = nB; ++ui;
        if constexpr (ALIGN_EPI) { if (wr == 1) PG8_BAR; }
    }
    PG8_WAIT_V(0);
    if constexpr (!ALIGN_EPI) { if (wr == 0) PG8_BAR; }
    PG8_BAR;
    if constexpr (Epi::AFTER_DRAIN) { E.fused(acc, cur, wr, wc, fr, fq, lds, wid, lane); S.done(cur); }
#undef PG8_SA
#undef PG8_SB
#undef PG8_STAGE
#undef PG8_LDA
#undef PG8_LDB
#undef PG8_MMA
#undef PG8_WAIT_V
#undef PG8_WAIT_L
#undef PG8_BAR
#undef PG8_SCHED
}
}
namespace pg8 {
__device__ __forceinline__ u32x4 pack8(f32x4 v0, f32x4 v1) { u32x4 w; w.x = cvt_pk_bf16(v0[0], v0[1]); w.y = cvt_pk_bf16(v0[2], v0[3]); w.z = cvt_pk_bf16(v1[0], v1[1]); w.w = cvt_pk_bf16(v1[2], v1[3]); return w; }
__device__ __forceinline__ float dot4(f32x4 a) { return (a[0] * a[0] + a[1] * a[1]) + (a[2] * a[2] + a[3] * a[3]); }
__device__ __forceinline__ float rs16(const float* p) { const f32x4 a = *(const f32x4*)p, b = *(const f32x4*)(p + 4), c = *(const f32x4*)(p + 8), d = *(const f32x4*)(p + 12);
    const float s = ((a[0] + a[1]) + (a[2] + a[3])) + ((b[0] + b[1]) + (b[2] + b[3])) + ((c[0] + c[1]) + (c[2] + c[3])) + ((d[0] + d[1]) + (d[2] + d[3])); return rsqrtf(s * (1.0f / DM) + RMS_EPS); }

__device__ __forceinline__ float frcp(float x) { return __builtin_amdgcn_rcpf(x); }
__device__ __forceinline__ float fsigmoid(float x) { return frcp(1.0f + __builtin_amdgcn_exp2f(-1.4426950408889634f * x)); }
__device__ __forceinline__ float gelu_fast(float x) { const float z2 = 2.302208198f * (x + 0.044715f * x * x * x); return x * frcp(1.0f + __builtin_amdgcn_exp2f(-z2)); }
__device__ __forceinline__ void rs8(const float* rsq, int row0, int fq, float (&rs)[2][4]) {
    f32x4 pv[2][4];
#pragma unroll
    for (int ai = 0; ai < 2; ++ai)
#pragma unroll
        for (int m = 0; m < 4; ++m) pv[ai][m] = *(const f32x4*)(rsq + (size_t)(row0 + ai * HALF + m * 16) * 16 + 4 * fq);
#pragma unroll
    for (int ai = 0; ai < 2; ++ai)
#pragma unroll
        for (int m = 0; m < 4; ++m) { float s = (pv[ai][m][0] + pv[ai][m][1]) + (pv[ai][m][2] + pv[ai][m][3]); s += __shfl_xor(s, 16); s += __shfl_xor(s, 32); rs[ai][m] = rsqrtf(s * (1.0f / DM) + RMS_EPS); }
}
#define DPP_ROT(src, ctrl) __uint_as_float((unsigned)__builtin_amdgcn_mov_dpp((int)__float_as_uint(src), (ctrl), 0xF, 0xF, true))
#define DPP_MOV(old, src, ctrl) __uint_as_float((unsigned)__builtin_amdgcn_update_dpp((int)__float_as_uint(old), (int)__float_as_uint(src), (ctrl), 0xF, 0xF, false))

struct EpiProj {
    static constexpr bool PERM = true, AFTER_DRAIN = false;
    bf16_t* O; float* kmsum; unsigned* kmx;
    __device__ __forceinline__ void operator()(const f32x4 (&acc)[2][2][4][2], const Unit& u, int wr, int wc, int fr, int fq) const {
        const int colt = u.pn * BM;
        const float sc = colt < C_MK ? QSCALE : ((colt >= C_RK && colt < C_RV) ? RKSCALE : 1.0f);
        const int row0 = u.pm * BM + wr * 64 + fr, sec = colt >> 9, b = u.pm >> 6;
        bf16_t* sbase = O + (size_t)sec * SEC;
#pragma unroll
        for (int bj = 0; bj < 2; ++bj) { const int c = (colt & 511) + bj * HALF + wc * 32 + 8 * fq;
            bf16_t* hb = sec < 3 ? sbase + ((size_t)(b * 8 + (c >> 6)) * SEQ) * 64 + (c & 63) : sbase + ((size_t)(b * 4 + (c >> 7)) * SEQ) * 128 + (c & 127);
            const int pitch = sec < 3 ? 64 : 128;
#pragma unroll
            for (int ai = 0; ai < 2; ++ai)
#pragma unroll
                for (int m = 0; m < 4; ++m) { const int t = (row0 + ai * HALF + m * 16) & (SEQ - 1);
                    *(u32x4*)(hb + (size_t)t * pitch) = pack8(acc[ai][bj][m][0] * sc, acc[ai][bj][m][1] * sc); } }
        if (colt >= C_MK && colt < C_MV) {
            const int bh0 = (u.pm >> 6) * 8, blk = u.pm & 63;
#pragma unroll
            for (int bj = 0; bj < 2; ++bj)
#pragma unroll
                for (int n = 0; n < 2; ++n)
#pragma unroll
                    for (int j = 0; j < 4; ++j) { float s = 0.f;
#pragma unroll
                        for (int ai = 0; ai < 2; ++ai)
#pragma unroll
                            for (int m = 0; m < 4; ++m) s += acc[ai][bj][m][n][j];
                        s += __shfl_xor(s, 1); s += __shfl_xor(s, 2); s += __shfl_xor(s, 4); s += __shfl_xor(s, 8);
                        if (fr == 0) { const int c = colt - C_MK + bj * HALF + wc * 32 + 8 * fq + 4 * n + j; atomicAdd(kmsum + ((size_t)(bh0 + (c >> 6)) * 64 + blk) * 64 + (c & 63), s); } }
#pragma unroll
            for (int bj = 0; bj < 2; ++bj) { float mxk = 0.f;
#pragma unroll
                for (int ai = 0; ai < 2; ++ai)
#pragma unroll
                    for (int m = 0; m < 4; ++m) { float q2 = dot4(acc[ai][bj][m][0]) + dot4(acc[ai][bj][m][1]); q2 += __shfl_xor(q2, 16); q2 += __shfl_xor(q2, 32); mxk = fmaxf(mxk, q2); }
                mxk = fmaxf(mxk, __shfl_xor(mxk, 1)); mxk = fmaxf(mxk, __shfl_xor(mxk, 2)); mxk = fmaxf(mxk, __shfl_xor(mxk, 4)); mxk = fmaxf(mxk, __shfl_xor(mxk, 8));
                if (fr == 0 && fq == 0) { const int hd = (colt - C_MK + bj * HALF + wc * 32) >> 6; atomicMax(kmx + ((size_t)(bh0 + hd) * 64 + blk) * 2 + (wc & 1), __float_as_uint(mxk)); } }
        }
    }
};
struct EpiStore {
    static constexpr bool PERM = true, AFTER_DRAIN = false;
    bf16_t* O;
    __device__ __forceinline__ void operator()(const f32x4 (&acc)[2][2][4][2], const Unit& u, int wr, int wc, int fr, int fq) const {
        const int row0 = u.pm * BM + wr * 64 + fr, col0 = u.pn * BM + wc * 32 + 8 * fq;
#pragma unroll
        for (int ai = 0; ai < 2; ++ai)
#pragma unroll
            for (int m = 0; m < 4; ++m) { bf16_t* rowp = O + (size_t)(row0 + ai * HALF + m * 16) * DM + col0;
#pragma unroll
                for (int bj = 0; bj < 2; ++bj) *(u32x4*)(rowp + bj * HALF) = pack8(acc[ai][bj][m][0], acc[ai][bj][m][1]); }
    }
};
template <bool BF, bool WR = true> struct EpiRes {
    static constexpr bool PERM = true, AFTER_DRAIN = false;
    const float* base; bf16_t* xb; float* rsq;
    __device__ __forceinline__ void operator()(const f32x4 (&acc)[2][2][4][2], const Unit& u, int wr, int wc, int fr, int fq) const {
        const int row0 = u.pm * BM + wr * 64 + fr, col0 = u.pn * BM + wc * 32 + 8 * fq;
        if constexpr (BF) {
            u32x4 pv[8][2];
#define ERB_LOAD(g) do { _Pragma("unroll") for (int bj = 0; bj < 2; ++bj) pv[g][bj] = *(const u32x4*)(xb + (size_t)(row0 + ((g) >> 2) * HALF + ((g) & 3) * 16) * DM + col0 + bj * HALF); } while (0)
            ERB_LOAD(0); ERB_LOAD(1); ERB_LOAD(2); ERB_LOAD(3);
#pragma unroll
            for (int g = 0; g < 8; ++g) { const int ai = g >> 2, m = g & 3, row = row0 + ai * HALF + m * 16; float ss = 0.f;
                if (g + 4 < 8) { ERB_LOAD(g + 4); }
                asm volatile("" ::: "memory");
#pragma unroll
                for (int bj = 0; bj < 2; ++bj) { const size_t off = (size_t)row * DM + col0 + bj * HALF; const u32x4 p = pv[g][bj];
                    const f32x4 b0 = {__uint_as_float(p.x << 16), __uint_as_float(p.x & 0xffff0000u), __uint_as_float(p.y << 16), __uint_as_float(p.y & 0xffff0000u)};
                    const f32x4 b1 = {__uint_as_float(p.z << 16), __uint_as_float(p.z & 0xffff0000u), __uint_as_float(p.w << 16), __uint_as_float(p.w & 0xffff0000u)};
                    const f32x4 y0 = b0 + acc[ai][bj][m][0], y1 = b1 + acc[ai][bj][m][1];
                    if (WR) *(u32x4*)(xb + off) = pack8(y0, y1); ss += dot4(y0) + dot4(y1); }
                ss += __shfl_xor(ss, 16); ss += __shfl_xor(ss, 32);
                if (fq == 0) rsq[(size_t)row * 16 + u.pn * 4 + wc] = ss; }
#undef ERB_LOAD
        } else {
            f32x4 bv[8][2][2];
#define ER_LOAD(g) do { _Pragma("unroll") for (int bj = 0; bj < 2; ++bj) { const float* p_ = base + (size_t)(row0 + ((g) >> 2) * HALF + ((g) & 3) * 16) * DM + col0 + bj * HALF; bv[g][bj][0] = *(const f32x4*)p_; bv[g][bj][1] = *(const f32x4*)(p_ + 4); } } while (0)
            ER_LOAD(0); ER_LOAD(1);
#pragma unroll
            for (int g = 0; g < 8; ++g) { const int ai = g >> 2, m = g & 3, row = row0 + ai * HALF + m * 16; float ss = 0.f;
                if (g + 2 < 8) { ER_LOAD(g + 2); }
                asm volatile("" ::: "memory");
#pragma unroll
                for (int bj = 0; bj < 2; ++bj) { const size_t off = (size_t)row * DM + col0 + bj * HALF;
                    const f32x4 y0 = bv[g][bj][0] + acc[ai][bj][m][0], y1 = bv[g][bj][1] + acc[ai][bj][m][1];
                    if (WR) *(u32x4*)(xb + off) = pack8(y0, y1); ss += dot4(y0) + dot4(y1); }
                ss += __shfl_xor(ss, 16); ss += __shfl_xor(ss, 32);
                if (fq == 0) rsq[(size_t)row * 16 + u.pn * 4 + wc] = ss; }
#undef ER_LOAD
        }
    }
};
struct EpiResXN {
    static constexpr bool PERM = true, AFTER_DRAIN = false;
    const bf16_t* xn; const float* rs0; const float* gcol; bf16_t* xb; float* rsq;
    __device__ __forceinline__ void operator()(const f32x4 (&acc)[2][2][4][2], const Unit& u, int wr, int wc, int fr, int fq) const {
        const int row0 = u.pm * BM + wr * 64 + fr, col0 = u.pn * BM + wc * 32 + 8 * fq;
        f32x4 ig[2][2];
#pragma unroll
        for (int bj = 0; bj < 2; ++bj)
#pragma unroll
            for (int n = 0; n < 2; ++n) { const f32x4 g = *(const f32x4*)(gcol + col0 + bj * HALF + 4 * n); ig[bj][n] = (f32x4){frcp(g[0]), frcp(g[1]), frcp(g[2]), frcp(g[3])}; }
        float ir[8];
#pragma unroll
        for (int g = 0; g < 8; ++g) ir[g] = frcp(rs0[row0 + (g >> 2) * HALF + (g & 3) * 16]);
        u32x4 pv[8][2];
#define ERX_LOAD(g) do { _Pragma("unroll") for (int bj = 0; bj < 2; ++bj) pv[g][bj] = *(const u32x4*)(xn + (size_t)(row0 + ((g) >> 2) * HALF + ((g) & 3) * 16) * DM + col0 + bj * HALF); } while (0)
        ERX_LOAD(0); ERX_LOAD(1); ERX_LOAD(2); ERX_LOAD(3);
#pragma unroll
        for (int g = 0; g < 8; ++g) { const int ai = g >> 2, m = g & 3, row = row0 + ai * HALF + m * 16; float ss = 0.f;
            if (g + 4 < 8) { ERX_LOAD(g + 4); }
            asm volatile("" ::: "memory");
#pragma unroll
            for (int bj = 0; bj < 2; ++bj) { const size_t off = (size_t)row * DM + col0 + bj * HALF; const u32x4 p = pv[g][bj];
                const f32x4 b0 = {__uint_as_float(p.x << 16), __uint_as_float(p.x & 0xffff0000u), __uint_as_float(p.y << 16), __uint_as_float(p.y & 0xffff0000u)};
                const f32x4 b1 = {__uint_as_float(p.z << 16), __uint_as_float(p.z & 0xffff0000u), __uint_as_float(p.w << 16), __uint_as_float(p.w & 0xffff0000u)};
                const f32x4 y0 = b0 * ig[bj][0] * ir[g] + acc[ai][bj][m][0], y1 = b1 * ig[bj][1] * ir[g] + acc[ai][bj][m][1];
                *(u32x4*)(xb + off) = pack8(y0, y1); ss += dot4(y0) + dot4(y1); }
            ss += __shfl_xor(ss, 16); ss += __shfl_xor(ss, 32);
            if (fq == 0) rsq[(size_t)row * 16 + u.pn * 4 + wc] = ss; }
#undef ERX_LOAD
    }
};
struct EpiPleNorm {
    static constexpr bool PERM = true, AFTER_DRAIN = false;
    float* out; const bf16_t* xb; const bf16_t* pw; const float* rsq_in; float* rsq_out; unsigned* pcnt; const float* fnorm; unsigned long long* dts;
#define EPN_STAMP(i) do { if (dts && wr == 0 && wc == 0 && fr == 0 && fq == 0) __hip_atomic_store(dts + (i) + 4 * (u.pm >= 64 ? 1 : 0), (unsigned long long)__builtin_amdgcn_s_memrealtime(), __ATOMIC_RELAXED, __HIP_MEMORY_SCOPE_AGENT); } while (0)
    __device__ __forceinline__ void operator()(const f32x4 (&acc_)[2][2][4][2], const Unit& u, int wr, int wc, int fr, int fq) const {
        f32x4 (&acc)[2][2][4][2] = const_cast<f32x4 (&)[2][2][4][2]>(acc_);
        const int row0 = u.pm * BM + wr * 64 + fr, col0 = u.pn * BM + wc * 32 + 8 * fq;
        EPN_STAMP(30);
        float rsv[2][4]; rs8(rsq_in, row0, fq, rsv);
        u32x4 xq[8][2], pq[8][2];
#define EP_LOAD(g) do { _Pragma("unroll") for (int bj = 0; bj < 2; ++bj) { const size_t o_ = (size_t)(row0 + ((g) >> 2) * HALF + ((g) & 3) * 16) * DM + col0 + bj * HALF; xq[g][bj] = *(const u32x4*)(xb + o_); pq[g][bj] = *(const u32x4*)(pw + o_); } } while (0)
        EP_LOAD(0); EP_LOAD(1);
#pragma unroll
        for (int g = 0; g < 8; ++g) { const int ai = g >> 2, m = g & 3, row = row0 + ai * HALF + m * 16; const float rs = rsv[ai][m]; float ss = 0.f;
            if (g + 2 < 8) { EP_LOAD(g + 2); }
            asm volatile("" ::: "memory");
#pragma unroll
            for (int bj = 0; bj < 2; ++bj) {
                const u32x4 pv = pq[g][bj];
                const f32x4 p0 = {__uint_as_float(pv.x << 16), __uint_as_float(pv.x & 0xffff0000u), __uint_as_float(pv.y << 16), __uint_as_float(pv.y & 0xffff0000u)};
                const f32x4 p1 = {__uint_as_float(pv.z << 16), __uint_as_float(pv.z & 0xffff0000u), __uint_as_float(pv.w << 16), __uint_as_float(pv.w & 0xffff0000u)};
                f32x4 g0 = acc[ai][bj][m][0] * rs, g1 = acc[ai][bj][m][1] * rs;
#pragma unroll
                for (int j = 0; j < 4; ++j) { g0[j] = fsigmoid(g0[j]); g1[j] = fsigmoid(g1[j]); }
                const u32x4 xv = xq[g][bj];
                const f32x4 x0 = {__uint_as_float(xv.x << 16), __uint_as_float(xv.x & 0xffff0000u), __uint_as_float(xv.y << 16), __uint_as_float(xv.y & 0xffff0000u)};
                const f32x4 x1 = {__uint_as_float(xv.z << 16), __uint_as_float(xv.z & 0xffff0000u), __uint_as_float(xv.w << 16), __uint_as_float(xv.w & 0xffff0000u)};
                const f32x4 y0 = x0 + p0 * g0, y1 = x1 + p1 * g1;
                acc[ai][bj][m][0] = y0; acc[ai][bj][m][1] = y1; ss += dot4(y0) + dot4(y1); }
            ss += __shfl_xor(ss, 16); ss += __shfl_xor(ss, 32);
            if (fq == 0) __hip_atomic_store((unsigned*)(rsq_out + (size_t)row * 16 + u.pn * 4 + wc), __float_as_uint(ss), __ATOMIC_RELAXED, __HIP_MEMORY_SCOPE_AGENT); }
#undef EP_LOAD
        asm volatile("s_waitcnt vmcnt(0)" ::: "memory");
        EPN_STAMP(31);
        unsigned* pc = pcnt + 16 * u.pm;
        if (fq == 0 && fr == 0) __hip_atomic_fetch_add(pc, 1u, __ATOMIC_RELAXED, __HIP_MEMORY_SCOPE_AGENT);
        for (unsigned spins = 0; spins < (1u << 22); ++spins) {
            if ((unsigned)__builtin_amdgcn_readfirstlane(__hip_atomic_load(pc, __ATOMIC_RELAXED, __HIP_MEMORY_SCOPE_AGENT)) >= 32u) break;
            __builtin_amdgcn_s_sleep(2);
        }
        EPN_STAMP(32);
        f32x4 fn[2][2];
#pragma unroll
        for (int bj = 0; bj < 2; ++bj) { fn[bj][0] = *(const f32x4*)(fnorm + col0 + bj * HALF); fn[bj][1] = *(const f32x4*)(fnorm + col0 + bj * HALF + 4); }
        unsigned long long pa[8], pb[8];
#pragma unroll
        for (int g = 0; g < 8; ++g) { const unsigned long long* pp = (const unsigned long long*)(rsq_out + (size_t)(row0 + (g >> 2) * HALF + (g & 3) * 16) * 16 + 4 * fq);
            pa[g] = __hip_atomic_load(pp, __ATOMIC_RELAXED, __HIP_MEMORY_SCOPE_AGENT); pb[g] = __hip_atomic_load(pp + 1, __ATOMIC_RELAXED, __HIP_MEMORY_SCOPE_AGENT); }
#pragma unroll
        for (int g = 0; g < 8; ++g) { const int ai = g >> 2, m = g & 3, row = row0 + ai * HALF + m * 16;
            float s = (__uint_as_float((unsigned)pa[g]) + __uint_as_float((unsigned)(pa[g] >> 32))) + (__uint_as_float((unsigned)pb[g]) + __uint_as_float((unsigned)(pb[g] >> 32)));
            s += __shfl_xor(s, 16); s += __shfl_xor(s, 32);
            const float rs3 = rsqrtf(s * (1.0f / DM) + RMS_EPS);
#pragma unroll
            for (int bj = 0; bj < 2; ++bj) { const size_t off = (size_t)row * DM + col0 + bj * HALF;
                *(f32x4*)(out + off) = acc[ai][bj][m][0] * rs3 * fn[bj][0]; *(f32x4*)(out + off + 4) = acc[ai][bj][m][1] * rs3 * fn[bj][1]; } }
        EPN_STAMP(33);
    }
};
#undef EPN_STAMP
struct EpiUG {
    static constexpr bool PERM = true, AFTER_DRAIN = false;
    bf16_t* act; const float* rsq; const float* cw; const float* cb; float* UL; float* UF; float* GF;
    __device__ __forceinline__ void operator()(const f32x4 (&acc)[2][2][4][2], const Unit& u, int wr, int wc, int fr, int fq) const {
        const int cu = u.pn * HALF + wc * 32 + 8 * fq;
        const int row0 = u.pm * BM + wr * 64 + fr;
        float rsv[2][4]; rs8(rsq, row0, fq, rsv);
        float w0[8], w1[8], w2[8], bb[8];
#pragma unroll
        for (int q = 0; q < 2; ++q) { const f32x4 a = *(const f32x4*)(cw + cu + 4 * q), b = *(const f32x4*)(cw + FF + cu + 4 * q), c = *(const f32x4*)(cw + 2 * FF + cu + 4 * q), d = *(const f32x4*)(cb + cu + 4 * q);
#pragma unroll
            for (int j = 0; j < 4; ++j) { w0[4 * q + j] = a[j]; w1[4 * q + j] = b[j]; w2[4 * q + j] = c[j]; bb[4 * q + j] = d[j]; } }
#pragma unroll
        for (int ai = 0; ai < 2; ++ai) {
            float up[8];
#pragma unroll
            for (int m = 0; m < 4; ++m) {
                const int row = row0 + ai * HALF + m * 16;
                const float rs = rsv[ai][m];
                float uu[8], gg[8], a8[8];
#pragma unroll
                for (int n = 0; n < 2; ++n)
#pragma unroll
                    for (int j = 0; j < 4; ++j) { uu[4 * n + j] = acc[ai][0][m][n][j] * rs; gg[4 * n + j] = acc[ai][1][m][n][j] * rs; }
#pragma unroll
                for (int k = 0; k < 8; ++k) {
                    float t1 = 0.f, t2 = 0.f;
                    if (m > 0) { t1 = DPP_ROT(up[k], 0x121); t2 = DPP_ROT(up[k], 0x122); }
                    const float u1 = DPP_MOV(t1, uu[k], 0x111), u2 = DPP_MOV(t2, uu[k], 0x112);
                    const float y = bb[k] + w0[k] * u2 + w1[k] * u1 + w2[k] * uu[k];
                    a8[k] = gelu_fast(y) * gg[k];
                }
                const bool defer = (m == 0) && (fr < 2);
                if (!defer) { u32x4 w; w.x = cvt_pk_bf16(a8[0], a8[1]); w.y = cvt_pk_bf16(a8[2], a8[3]); w.z = cvt_pk_bf16(a8[4], a8[5]); w.w = cvt_pk_bf16(a8[6], a8[7]);
                    *(u32x4*)(act + (size_t)row * FF + cu) = w; }
                else { const size_t so = ((size_t)(row >> 6) * 2 + fr) * FF + cu;
                    *(f32x4*)(UF + so) = (f32x4){uu[0], uu[1], uu[2], uu[3]}; *(f32x4*)(UF + so + 4) = (f32x4){uu[4], uu[5], uu[6], uu[7]};
                    *(f32x4*)(GF + so) = (f32x4){gg[0], gg[1], gg[2], gg[3]}; *(f32x4*)(GF + so + 4) = (f32x4){gg[4], gg[5], gg[6], gg[7]}; }
                if (m == 3 && fr >= 14) { const size_t so = ((size_t)(row >> 6) * 2 + (fr - 14)) * FF + cu;
                    *(f32x4*)(UL + so) = (f32x4){uu[0], uu[1], uu[2], uu[3]}; *(f32x4*)(UL + so + 4) = (f32x4){uu[4], uu[5], uu[6], uu[7]}; }
#pragma unroll
                for (int k = 0; k < 8; ++k) up[k] = uu[k];
            }
        }
    }
};
}
#define LAS __attribute__((address_space(3)))
namespace mx {
typedef short bf16x8 __attribute__((ext_vector_type(8)));
typedef short s16x4 __attribute__((ext_vector_type(4)));
typedef float f32x16 __attribute__((ext_vector_type(16)));
typedef unsigned u32x4 __attribute__((ext_vector_type(4)));
typedef float f32x4_t __attribute__((ext_vector_type(4)));
typedef LAS const char* lds_cptr;
typedef LAS char* lds_ptr;
__device__ __forceinline__ int crow(int r, int hi) { return (r & 3) + 8 * (r >> 2) + 4 * hi; }
__device__ __forceinline__ s16x4 vtr(lds_cptr p) { return __builtin_bit_cast(s16x4, __builtin_amdgcn_ds_read_tr16_b64_v4i16((LAS s16x4*)p)); }
__device__ __forceinline__ bf16x8 cat8(s16x4 lo, s16x4 hi) { return (bf16x8){lo[0], lo[1], lo[2], lo[3], hi[0], hi[1], hi[2], hi[3]}; }
typedef float f32x2_t __attribute__((ext_vector_type(2))); typedef __bf16 bf16x2_t __attribute__((ext_vector_type(2)));
__device__ __forceinline__ unsigned pk(float lo, float hi) { const f32x2_t v = {lo, hi}; return __builtin_bit_cast(unsigned, __builtin_convertvector(v, bf16x2_t)); }
typedef __bf16 bf16x2_d __attribute__((ext_vector_type(2)));
__device__ __forceinline__ float dot2bf(unsigned a, unsigned b, float c) { return __builtin_amdgcn_fdot2_f32_bf16(__builtin_bit_cast(bf16x2_d, a), __builtin_bit_cast(bf16x2_d, b), c, false); }
__device__ __forceinline__ float dot8bf(u32x4 a, u32x4 b, float c) { return dot2bf(a.w, b.w, dot2bf(a.z, b.z, dot2bf(a.y, b.y, dot2bf(a.x, b.x, c)))); }
__device__ __forceinline__ float other_half(float v) { return __shfl_xor(v, 32); }

constexpr int L_K = 0, L_V = 32768;
constexpr int L_WSF = 65536;
constexpr int L_OST = 65536 + 2048;
constexpr int L_ENT = L_OST + 32768;
constexpr int ENT_CAP = 4096;
constexpr int L_PREF = L_ENT + ENT_CAP * 4;
constexpr int L_MW = L_PREF + 512;
constexpr int L_END = L_MW + 4096;
static_assert(L_END <= 147456, "mixer LDS map");

__device__ __forceinline__ void moba_stage_kv(const bf16_t* __restrict__ proj, int b, int h, int blk, lds_ptr lds, int tid) {
#pragma unroll
    for (int i = 0; i < 4; ++i) { const int pc = tid + 512 * i, key = pc >> 3, ch = pc & 7;
        const bf16_t* src = proj + ((size_t)(b * 8 + h) * SEQ + blk * 256 + key) * 64 + ch * 8;
        const u32x4 kv = *(const u32x4*)(src + SEC), vv = *(const u32x4*)(src + 2 * SEC);
        *(LAS u32x4*)(lds + L_K + ch * 4096 + key * 16) = kv;
        *(LAS u32x4*)(lds + L_V + (key >> 6) * 8192 + (ch >> 2) * 4096 + ((key & 63) >> 3) * 512 + (key & 7) * 64 + (ch & 3) * 16) = vv; }
}

__device__ __forceinline__ void moba_batch(const bf16x8 (&qr)[4], int qpos, int kbase, float slope2, bool diag, int ntiles, lds_ptr lds, int wave, int lane, bf16_t* odst, float* ldst,
                                           const bf16_t* part_row = nullptr, const float* pl_row = nullptr, int nv = 0, bf16_t* mix_row = nullptr, bf16_t* mix_base = nullptr) {
    const int r32 = lane & 31, hi = lane >> 5;
    f32x16 o0, o1;
#pragma unroll
    for (int r = 0; r < 16; ++r) { o0[r] = 0.f; o1[r] = 0.f; }
    float m = -1e30f, l = 0.f;
    const lds_cptr kp = (lds_cptr)lds + L_K + hi * 4096 + r32 * 16;
    const lds_cptr vp = (lds_cptr)lds + L_V + ((lane >> 4) & 1) * 32 + (lane & 3) * 8 + (4 * hi + ((lane & 15) >> 2)) * 64;
    LAS float* wsf = (LAS float*)(lds + L_WSF) + wave * 64;
    const float s4h = slope2 * (float)(4 * hi);
#define MX_LOAD(KT) bf16x8 kf_[4], kg_[4], vf_[2][4]; do { _Pragma("unroll") for (int d0 = 0; d0 < 4; ++d0) { kf_[d0] = *(const LAS bf16x8*)(kp + (KT) * 1024 + d0 * 8192); kg_[d0] = *(const LAS bf16x8*)(kp + (KT) * 1024 + 512 + d0 * 8192); } \
        const lds_cptr vt_ = vp + (KT) * 8192; _Pragma("unroll") for (int db = 0; db < 2; ++db) _Pragma("unroll") for (int ks = 0; ks < 4; ++ks) vf_[db][ks] = cat8(vtr(vt_ + db * 4096 + ks * 1024), vtr(vt_ + db * 4096 + ks * 1024 + 512)); \
        __builtin_amdgcn_sched_barrier(0); } while (0)
#define MX_QK(P0, P1, C0, C1) do { _Pragma("unroll") for (int d0 = 0; d0 < 4; ++d0) { \
        P0 = __builtin_amdgcn_mfma_f32_32x32x16_bf16(kf_[d0], qr[d0], d0 == 0 ? C0 : P0, 0, 0, 0); P1 = __builtin_amdgcn_mfma_f32_32x32x16_bf16(kg_[d0], qr[d0], d0 == 0 ? C1 : P1, 0, 0, 0); } } while (0)
#define MX_PV(O, DB, KS, PW) O = __builtin_amdgcn_mfma_f32_32x32x16_bf16(__builtin_bit_cast(bf16x8, PW), vf_[DB][KS], O, 0, 0, 0)
#define MX_PVALL() do { \
        const u32x4 pw0 = {pk(p0[0], p0[1]), pk(p0[2], p0[3]), pk(p0[4], p0[5]), pk(p0[6], p0[7])}, pw1 = {pk(p0[8], p0[9]), pk(p0[10], p0[11]), pk(p0[12], p0[13]), pk(p0[14], p0[15])}; \
        const u32x4 pw2 = {pk(p1[0], p1[1]), pk(p1[2], p1[3]), pk(p1[4], p1[5]), pk(p1[6], p1[7])}, pw3 = {pk(p1[8], p1[9]), pk(p1[10], p1[11]), pk(p1[12], p1[13]), pk(p1[14], p1[15])}; \
        MX_PV(o0, 0, 0, pw0); MX_PV(o1, 1, 0, pw0); MX_PV(o0, 0, 1, pw1); MX_PV(o1, 1, 1, pw1); MX_PV(o0, 0, 2, pw2); MX_PV(o1, 1, 2, pw2); MX_PV(o0, 0, 3, pw3); MX_PV(o1, 1, 3, pw3); } while (0)
    {
        const int kt = ntiles - 1;
        f32x16 p0, p1;
        MX_LOAD(kt);
#pragma unroll
        for (int r = 0; r < 16; ++r) { p0[r] = fmaf(slope2, (float)((r & 3) + 8 * (r >> 2)), s4h); p1[r] = p0[r]; }
        MX_QK(p0, p1, p0, p1);
        const int dq = qpos - kbase - 64 * kt;
        const float t0 = -slope2 * (float)dq, t1 = t0 + 32.0f * slope2;
        if (diag) {
#pragma unroll
            for (int r = 0; r < 16; ++r) { const int c = crow(r, hi); if (c > dq) p0[r] = -1e30f; if (c + 32 > dq) p1[r] = -1e30f; }
        }
        float mx0 = p0[0], mx1 = p1[0];
#pragma unroll
        for (int r = 1; r < 16; ++r) { mx0 = fmaxf(mx0, p0[r]); mx1 = fmaxf(mx1, p1[r]); }
        float mx_ = fmaxf(mx0 + t0, mx1 + t1);
        m = fmaxf(mx_, other_half(mx_));
        const float e0 = m - t0, e1 = m - t1;
        float rs = 0.f;
#pragma unroll
        for (int r = 0; r < 16; ++r) { p0[r] = __builtin_amdgcn_exp2f(p0[r] - e0); p1[r] = __builtin_amdgcn_exp2f(p1[r] - e1); rs += p0[r] + p1[r]; }
        l = rs;
        MX_PVALL();
    }
    for (int kt = ntiles - 2; kt >= 0; --kt) {
        const int dq = qpos - kbase - 64 * kt;
        const float c0 = -slope2 * (float)dq - m + s4h, c1 = c0 + 32.0f * slope2;
        f32x16 p0, p1;
        MX_LOAD(kt);
#pragma unroll
        for (int r = 0; r < 16; ++r) { const float cr = (float)((r & 3) + 8 * (r >> 2)); p0[r] = fmaf(slope2, cr, c0); p1[r] = fmaf(slope2, cr, c1); }
        MX_QK(p0, p1, p0, p1);
        float mx_ = fmaxf(p0[0], p1[0]);
#pragma unroll
        for (int r = 1; r < 16; ++r) mx_ = fmaxf(mx_, fmaxf(p0[r], p1[r]));
        mx_ = fmaxf(mx_, other_half(mx_));
        if (__all(mx_ < -40.0f)) continue;
        if (__any(mx_ > 16.0f)) {
            const float dl = fmaxf(mx_, 0.f); m += dl;
#pragma unroll
            for (int r = 0; r < 16; ++r) { p0[r] -= dl; p1[r] -= dl; }
            const float f = __builtin_amdgcn_exp2f(-dl); l *= f;
            if (hi == 0) wsf[r32] = f;
#pragma unroll
            for (int r = 0; r < 16; ++r) { const float g = wsf[crow(r, hi)]; o0[r] *= g; o1[r] *= g; }
        }
        float rs = 0.f;
#pragma unroll
        for (int r = 0; r < 16; ++r) { p0[r] = __builtin_amdgcn_exp2f(p0[r]); p1[r] = __builtin_amdgcn_exp2f(p1[r]); rs += p0[r] + p1[r]; }
        l += rs;
        MX_PVALL();
    }
#undef MX_LOAD
#undef MX_QK
#undef MX_PV
#undef MX_PVALL
    l += other_half(l);
    if (hi == 0) wsf[32 + r32] = 1.0f / l;
    const float lse = m + __builtin_amdgcn_logf(l);
    LAS bf16_t* ost = (LAS bf16_t*)(lds + L_OST) + wave * 2048;
#pragma unroll
    for (int r = 0; r < 16; ++r) { const int orow = crow(r, hi); const float f = wsf[32 + orow];
        ost[orow * 64 + r32] = (bf16_t)pk(o0[r] * f, 0.f); ost[orow * 64 + 32 + r32] = (bf16_t)pk(o1[r] * f, 0.f); }
    if (mix_row == nullptr) {
        const unsigned long long dp = (unsigned long long)odst; const unsigned dlo = (unsigned)dp, dhi = (unsigned)(dp >> 32);
#pragma unroll
        for (int i = 0; i < 4; ++i) { const int row = i * 8 + (lane >> 3), ch = lane & 7;
            const u32x4 v = *(const LAS u32x4*)(ost + row * 64 + ch * 8);
            const unsigned long long d = ((unsigned long long)(unsigned)__shfl((int)dhi, row) << 32) | (unsigned)__shfl((int)dlo, row);
            if (d) *(u32x4*)((bf16_t*)d + ch * 8) = v; }
        if (hi == 0 && ldst) *ldst = lse;
    } else {
        if (hi == 0) { const f32x4_t lv = *(const f32x4_t*)pl_row;
            const float a0 = nv > 0 ? lv[0] : -1e30f, a1 = nv > 1 ? lv[1] : -1e30f, a2 = nv > 2 ? lv[2] : -1e30f;
            const float mm = fmaxf(fmaxf(a0, a1), fmaxf(a2, lse));
            const float w0 = __builtin_amdgcn_exp2f(a0 - mm), w1 = __builtin_amdgcn_exp2f(a1 - mm), w2 = __builtin_amdgcn_exp2f(a2 - mm), w3 = __builtin_amdgcn_exp2f(lse - mm);
            const float iw = 1.0f / ((w0 + w1) + (w2 + w3));
            ((LAS f32x4_t*)(lds + L_MW) + wave * 32)[r32] = (f32x4_t){w0 * iw, w1 * iw, w2 * iw, w3 * iw}; }
        const unsigned long long pp = (unsigned long long)part_row, mp = (unsigned long long)mix_row;
        const unsigned plo = (unsigned)pp, phi = (unsigned)(pp >> 32), mlo = (unsigned)mp, mhi = (unsigned)(mp >> 32);
#pragma unroll
        for (int i = 0; i < 4; ++i) { const int row = i * 8 + (lane >> 3), ch = lane & 7;
            const u32x4 v = *(const LAS u32x4*)(ost + row * 64 + ch * 8);
            const f32x4_t w = ((const LAS f32x4_t*)(lds + L_MW) + wave * 32)[row];
            const bf16_t* pr = (const bf16_t*)(((unsigned long long)(unsigned)__shfl((int)phi, row) << 32) | (unsigned)__shfl((int)plo, row));
            bf16_t* mr = (bf16_t*)(((unsigned long long)(unsigned)__shfl((int)mhi, row) << 32) | (unsigned)__shfl((int)mlo, row));
            const unsigned vw[4] = {v.x, v.y, v.z, v.w}; float acc[8];
#pragma unroll
            for (int q = 0; q < 4; ++q) { acc[2 * q] = w[3] * __uint_as_float(vw[q] << 16); acc[2 * q + 1] = w[3] * __uint_as_float(vw[q] & 0xffff0000u); }
#pragma unroll
            for (int s = 0; s < 3; ++s) if (w[s] != 0.f) { const u32x4 pv = *(const u32x4*)(pr + s * 64 + ch * 8); const unsigned pw_[4] = {pv.x, pv.y, pv.z, pv.w};
#pragma unroll
                for (int q = 0; q < 4; ++q) { acc[2 * q] += w[s] * __uint_as_float(pw_[q] << 16); acc[2 * q + 1] += w[s] * __uint_as_float(pw_[q] & 0xffff0000u); } }
            *(u32x4*)(mr + ch * 8) = (u32x4){pk(acc[0], acc[1]), pk(acc[2], acc[3]), pk(acc[4], acc[5]), pk(acc[6], acc[7])}; }
    }
}

__device__ __forceinline__ void moba_diag_unit(const bf16_t* __restrict__ proj, int bh, int i, const bf16_t* part_o, const float* part_l, const u32* __restrict__ sel, bf16_t* mix, lds_ptr lds, int tid) {
    const int b = bh >> 3, h = bh & 7, lane = tid & 63, wave = __builtin_amdgcn_readfirstlane(tid >> 6);
    const int ql = wave * 32 + (lane & 31), t = i * 256 + ql; const size_t row = (size_t)b * SEQ + t;
    bf16x8 qr[4];
    { const bf16_t* qp = proj + ((size_t)bh * SEQ + t) * 64 + (lane >> 5) * 8;
#pragma unroll
      for (int d0 = 0; d0 < 4; ++d0) qr[d0] = *(const bf16x8*)(qp + d0 * 16); }
    moba_stage_kv(proj, b, h, i, lds, tid);
    __syncthreads();
    const float slope2 = __builtin_amdgcn_exp2f(-(float)(h + 1)) * LOG2E;
    const int nv = (int)(sel[row * 8 + h] >> 24);
    moba_batch(qr, t, i * 256, slope2, true, (wave >> 1) + 1, lds, wave, lane, nullptr, nullptr,
               part_o + ((row * 8 + h) * 4) * 64, part_l + (row * 8 + h) * 4, nv, mix + row * DM + h * 64, mix);
    __syncthreads();
}
__device__ __forceinline__ void moba_sel_task(const bf16_t* __restrict__ proj, const unsigned short* __restrict__ seg, const int* __restrict__ cnt, int bh, int n,
                                              bf16_t* part_o, float* part_l, lds_ptr lds, int tid) {
    const int b = bh >> 3, h = bh & 7, lane = tid & 63, wave = __builtin_amdgcn_readfirstlane(tid >> 6);
    LAS int* pref = (LAS int*)(lds + L_PREF); LAS unsigned* ent = (LAS unsigned*)(lds + L_ENT);
    if (wave == 0) {
        const int c = (lane > n) ? cnt[((size_t)bh * 64 + n) * 64 + lane] : 0; int s = c;
#pragma unroll
        for (int o = 1; o < 64; o <<= 1) { const int v = __shfl_up(s, o); if (lane >= o) s += v; }
        pref[lane + 1] = s; if (lane == 0) pref[0] = 0;
    }
    __syncthreads();
    const int T = pref[64];
    if (T == 0) { __syncthreads(); return; }
    moba_stage_kv(proj, b, h, n, lds, tid);
    const float slope2 = __builtin_amdgcn_exp2f(-(float)(h + 1)) * LOG2E;
    for (int c0 = 0; c0 < T; c0 += ENT_CAP) {
        for (int i = n + 1 + wave; i < 64; i += 8) { const int s0 = pref[i], s1 = pref[i + 1];
            const unsigned short* sp = seg + (((size_t)bh * 64 + n) * 64 + i) * 256;
            for (int e = lane; e < s1 - s0; e += 64) { const int g = s0 + e - c0; if (g >= 0 && g < ENT_CAP) ent[g] = ((unsigned)i << 10) | (unsigned)sp[e]; } }
        __syncthreads();
        const int cn = (T - c0) < ENT_CAP ? (T - c0) : ENT_CAP;
        for (int wb = wave; wb * 32 < cn; wb += 8) {
            const int idx = wb * 32 + (lane & 31); const bool valid = idx < cn;
            const unsigned ec = ent[valid ? idx : wb * 32];
            const int t = (ec >> 10) * 256 + ((ec >> 2) & 255), slot = ec & 3; const size_t row = (size_t)b * SEQ + t;
            bf16x8 qr[4];
            { const bf16_t* qp = proj + ((size_t)bh * SEQ + t) * 64 + (lane >> 5) * 8;
#pragma unroll
              for (int d0 = 0; d0 < 4; ++d0) qr[d0] = *(const bf16x8*)(qp + d0 * 16); }
            moba_batch(qr, t, n * 256, slope2, false, 4, lds, wave, lane,
                       valid ? part_o + ((row * 8 + h) * 4 + slot) * 64 : (bf16_t*)nullptr, valid ? part_l + (row * 8 + h) * 4 + slot : (float*)nullptr);
        }
        __syncthreads();
    }
}
constexpr int G_KMH = 0, G_KML = 8192, G_CNT = 16384;
#define MX_INS(v, n) do { const bool g0_ = (v) > v0, g1_ = (v) > v1, g2_ = (v) > v2; \
    v2 = g1_ ? v1 : (g2_ ? (v) : v2); i2 = g1_ ? i1 : (g2_ ? (n) : i2); v1 = g0_ ? v0 : (g1_ ? (v) : v1); i1 = g0_ ? i0 : (g1_ ? (n) : i1); v0 = g0_ ? (v) : v0; i0 = g0_ ? (n) : i0; } while (0)
__device__ __forceinline__ void gate_task_mfma(int bh, int i, const bf16_t* __restrict__ proj, const float* __restrict__ kmsum, u32* __restrict__ sel,
                                               unsigned short* __restrict__ seg, int* __restrict__ cnt, const unsigned* __restrict__ kmx, float* __restrict__ part_l, lds_ptr lds, int tid) {
    const int b = bh >> 3, h = bh & 7, lane = tid & 63, wave = __builtin_amdgcn_readfirstlane(tid >> 6), r32 = lane & 31, hi = lane >> 5;
    { const int n = tid >> 3, ch = tid & 7; const float* src = kmsum + (size_t)bh * 4096 + n * 64 + ch * 8;
      const f32x4_t a = *(const f32x4_t*)src * (1.0f / 256.0f), c = *(const f32x4_t*)(src + 4) * (1.0f / 256.0f);
      float v[8] = {a[0], a[1], a[2], a[3], c[0], c[1], c[2], c[3]}; float hf[8], lf[8];
#pragma unroll
      for (int k = 0; k < 8; ++k) { hf[k] = bf2f(f2bf(v[k])); lf[k] = v[k] - hf[k]; }
      const u32x4 H = {pk(hf[0], hf[1]), pk(hf[2], hf[3]), pk(hf[4], hf[5]), pk(hf[6], hf[7])}, Lw = {pk(lf[0], lf[1]), pk(lf[2], lf[3]), pk(lf[4], lf[5]), pk(lf[6], lf[7])};
      *(LAS u32x4*)(lds + G_KMH + ch * 1024 + n * 16) = H; *(LAS u32x4*)(lds + G_KML + ch * 1024 + n * 16) = Lw; }
    LAS int* cntL = (LAS int*)(lds + G_CNT);
    if (tid < 64) cntL[tid] = 0;
    __syncthreads();
    const int ql = wave * 32 + r32, t = i * 256 + ql; const size_t row = (size_t)b * SEQ + t;
    const bf16_t* qp = proj + ((size_t)bh * SEQ + t) * 64 + hi * 8;
    f32x16 p0, p1;
#pragma unroll
    for (int r = 0; r < 16; ++r) { p0[r] = 0.f; p1[r] = 0.f; }
    const bf16_t* ksp = proj + SEC + ((size_t)bh * SEQ + t) * 64 + hi * 8;
    float qq = 0.f, qk = 0.f;
#pragma unroll
    for (int ks = 0; ks < 4; ++ks) {
        const bf16x8 q = *(const bf16x8*)(qp + ks * 16);
        { const u32x4 qu = __builtin_bit_cast(u32x4, q), ku = *(const u32x4*)(ksp + ks * 16); qq = dot8bf(qu, qu, qq); qk = dot8bf(qu, ku, qk); }
        const lds_cptr kb = (lds_cptr)lds + (2 * ks + hi) * 1024 + r32 * 16;
        p0 = __builtin_amdgcn_mfma_f32_32x32x16_bf16(*(const LAS bf16x8*)(kb + G_KMH), q, p0, 0, 0, 0);
        p0 = __builtin_amdgcn_mfma_f32_32x32x16_bf16(*(const LAS bf16x8*)(kb + G_KML), q, p0, 0, 0, 0);
        p1 = __builtin_amdgcn_mfma_f32_32x32x16_bf16(*(const LAS bf16x8*)(kb + G_KMH + 512), q, p1, 0, 0, 0);
        p1 = __builtin_amdgcn_mfma_f32_32x32x16_bf16(*(const LAS bf16x8*)(kb + G_KML + 512), q, p1, 0, 0, 0);
    }
    float v0 = -INFINITY, v1 = -INFINITY, v2 = -INFINITY; int i0 = 0, i1 = 0, i2 = 0;
#pragma unroll
    for (int r = 0; r < 16; ++r) { const int n = crow(r, hi); const float v = n < i ? p0[r] : -INFINITY; MX_INS(v, n); }
#pragma unroll
    for (int r = 0; r < 16; ++r) { const int n = 32 + crow(r, hi); const float v = n < i ? p1[r] : -INFINITY; MX_INS(v, n); }
    { const float a0 = __shfl_xor(v0, 32), a1 = __shfl_xor(v1, 32), a2 = __shfl_xor(v2, 32); const int j0 = __shfl_xor(i0, 32), j1 = __shfl_xor(i1, 32), j2 = __shfl_xor(i2, 32);
      MX_INS(a0, j0); MX_INS(a1, j1); MX_INS(a2, j2); }
    qq += other_half(qq); qk += other_half(qk);
    if (hi == 0) {
        const int nv = i < 3 ? i : 3;
        sel[row * 8 + h] = (u32)i0 | ((u32)i1 << 8) | ((u32)i2 << 16) | ((u32)nv << 24);
        const float qn = sqrtf(qq) * 1.01f, slope2 = __builtin_amdgcn_exp2f(-(float)(h + 1)) * LOG2E;
#pragma unroll
        for (int s = 0; s < 3; ++s) if (s < nv) { const int n = s == 0 ? i0 : (s == 1 ? i1 : i2);
            const float kmax = sqrtf(__uint_as_float(kmx[((size_t)bh * 64 + n) * 2]) + __uint_as_float(kmx[((size_t)bh * 64 + n) * 2 + 1]));
            const float U = qn * kmax - slope2 * (float)(t - (n * 256 + 255));
            if (U + 8.0f - qk < -40.0f) part_l[(row * 8 + h) * 4 + s] = -1e30f;
            else { const int pos = atomicAdd((int*)&cntL[n], 1);
                seg[(((size_t)bh * 64 + n) * 64 + i) * 256 + pos] = (unsigned short)((ql << 2) | s); } }
    }
    __syncthreads();
    if (tid < i) cnt[((size_t)bh * 64 + tid) * 64 + i] = cntL[tid];
    __syncthreads();
}
#undef MX_INS

__device__ __forceinline__ void moba_combine(const bf16_t* __restrict__ part_o, const float* __restrict__ part_l, const u32* __restrict__ sel, bf16_t* __restrict__ mix, size_t gt, size_t GT) {
    for (size_t i = gt; i < (size_t)MT * 64; i += GT) {
        const int ch = (int)(i & 7), h = (int)((i >> 3) & 7); const size_t row = i >> 6;
        const int nv = sel[row * 8 + h] >> 24;
        const f32x4_t lv = *(const f32x4_t*)(part_l + (row * 8 + h) * 4);
        float w[4]; w[0] = nv > 0 ? lv[0] : -1e30f; w[1] = nv > 1 ? lv[1] : -1e30f; w[2] = nv > 2 ? lv[2] : -1e30f; w[3] = lv[3];
        const float mm = fmaxf(fmaxf(w[0], w[1]), fmaxf(w[2], w[3]));
        float acc[8] = {0.f, 0.f, 0.f, 0.f, 0.f, 0.f, 0.f, 0.f}; float ws = 0.f;
#pragma unroll
        for (int s = 0; s < 4; ++s) { const bool ok = s == 3 || s < nv; const float ww = ok ? __builtin_amdgcn_exp2f(w[s] - mm) : 0.f; ws += ww;
            if (ok) { const u32x4 v = *(const u32x4*)(part_o + ((row * 8 + h) * 4 + s) * 64 + ch * 8);
                acc[0] += ww * __uint_as_float(v.x << 16); acc[1] += ww * __uint_as_float(v.x & 0xffff0000u); acc[2] += ww * __uint_as_float(v.y << 16); acc[3] += ww * __uint_as_float(v.y & 0xffff0000u);
                acc[4] += ww * __uint_as_float(v.z << 16); acc[5] += ww * __uint_as_float(v.z & 0xffff0000u); acc[6] += ww * __uint_as_float(v.w << 16); acc[7] += ww * __uint_as_float(v.w & 0xffff0000u); } }
        const float iw = 1.0f / ws;
        u32x4 o; o.x = pk(acc[0] * iw, acc[1] * iw); o.y = pk(acc[2] * iw, acc[3] * iw); o.z = pk(acc[4] * iw, acc[5] * iw); o.w = pk(acc[6] * iw, acc[7] * iw);
        *(u32x4*)(mix + row * DM + h * 64 + ch * 8) = o;
    }
}

constexpr int R_IMG = 65536;
__device__ __forceinline__ int rimg_off(int t, int c) { return (c >> 5) * 16384 + (t >> 3) * 512 + (t & 7) * 64 + (c & 31) * 2; }
__device__ __forceinline__ void ret_stage(const bf16_t* __restrict__ plane, int t0, lds_ptr img, int tid, bool kdecay, float log2g) {
#pragma unroll
    for (int i = 0; i < 8; ++i) { const int pc = tid + 512 * i, t = pc >> 4, ch = pc & 15;
        u32x4 v = *(const u32x4*)(plane + (size_t)(t0 + t) * 128 + ch * 8);
        if (kdecay) { const float f = __builtin_amdgcn_exp2f((float)(255 - t) * log2g);
            v.x = pk(__uint_as_float(v.x << 16) * f, __uint_as_float(v.x & 0xffff0000u) * f); v.y = pk(__uint_as_float(v.y << 16) * f, __uint_as_float(v.y & 0xffff0000u) * f);
            v.z = pk(__uint_as_float(v.z << 16) * f, __uint_as_float(v.z & 0xffff0000u) * f); v.w = pk(__uint_as_float(v.w << 16) * f, __uint_as_float(v.w & 0xffff0000u) * f); }
        *(LAS u32x4*)(img + rimg_off(t, ch * 8)) = v; }
}
__device__ __forceinline__ void ret_kv_task(const bf16_t* __restrict__ proj, int bh, int c, float* __restrict__ kvt, lds_ptr lds, int tid) {
    const int b = bh >> 2, h = bh & 3, lane = tid & 63, wave = __builtin_amdgcn_readfirstlane(tid >> 6), r32 = lane & 31, hi = lane >> 5;
    const float log2g = __builtin_amdgcn_logf(1.0f - __builtin_amdgcn_exp2f(-5.0f - (float)h));
    ret_stage(proj + 5 * SEC + (size_t)bh * SEQ * 128, c * 256, lds, tid, false, 0.f);
    ret_stage(proj + 4 * SEC + (size_t)bh * SEQ * 128, c * 256, lds + R_IMG, tid, true, log2g);
    __syncthreads();
    const int et = wave >> 1, dt0 = (wave & 1) * 2;
    const int lbase = hi * 512 + ((lane & 15) >> 2) * 64 + ((lane >> 4) & 1) * 32 + (lane & 3) * 8;
    const lds_cptr va = (lds_cptr)lds + et * 16384 + lbase, kb0 = (lds_cptr)lds + R_IMG + dt0 * 16384 + lbase, kb1 = kb0 + 16384;
    f32x16 a0, a1;
#pragma unroll
    for (int r = 0; r < 16; ++r) { a0[r] = 0.f; a1[r] = 0.f; }
#pragma unroll 4
    for (int ks = 0; ks < 16; ++ks) {
        const bf16x8 vf = cat8(vtr(va + ks * 1024), vtr(va + ks * 1024 + 256));
        const bf16x8 k0 = cat8(vtr(kb0 + ks * 1024), vtr(kb0 + ks * 1024 + 256)), k1 = cat8(vtr(kb1 + ks * 1024), vtr(kb1 + ks * 1024 + 256));
        a0 = __builtin_amdgcn_mfma_f32_32x32x16_bf16(vf, k0, a0, 0, 0, 0);
        a1 = __builtin_amdgcn_mfma_f32_32x32x16_bf16(vf, k1, a1, 0, 0, 0);
    }
    float* dst = kvt + ((size_t)(bh * 64 + c) * 128) * 128;
#pragma unroll
    for (int r = 0; r < 16; ++r) { const int e = et * 32 + crow(r, hi);
        dst[(size_t)e * 128 + dt0 * 32 + r32] = a0[r]; dst[(size_t)e * 128 + dt0 * 32 + 32 + r32] = a1[r]; }
    __syncthreads();
}
__device__ __forceinline__ void ret_scan(const float* __restrict__ kvt, bf16_t* __restrict__ stt, size_t gt, size_t GT) {
    for (size_t i = gt; i < (size_t)8 * 16384; i += GT) {
        const int bh = (int)(i >> 14), ed = (int)(i & 16383), h = bh & 3;
        const float g256 = __builtin_amdgcn_exp2f(256.0f * __builtin_amdgcn_logf(1.0f - __builtin_amdgcn_exp2f(-5.0f - (float)h)));
        float s = 0.f;
#pragma unroll 8
        for (int c = 0; c < 64; ++c) { const size_t o = ((size_t)(bh * 64 + c) << 14) + ed; stt[o] = f2bf(s); s = s * g256 + kvt[o]; }
    }
}
constexpr int RO_A = 0, RO_V = 65536, RO_ST = 131072;
#define RO_STAMP(i) do { if (dts && tid == 0) __hip_atomic_store(dts + (i), (unsigned long long)__builtin_amdgcn_s_memrealtime(), __ATOMIC_RELAXED, __HIP_MEMORY_SCOPE_AGENT); } while (0)
__device__ __forceinline__ void ret_out_task(const bf16_t* __restrict__ proj, const bf16_t* __restrict__ stt, const float* __restrict__ gain, bf16_t* __restrict__ mix, int bh, int c, lds_ptr lds, int tid, unsigned long long* dts = nullptr) {
    RO_STAMP(21);
    const int b = bh >> 2, h = bh & 3, lane = tid & 63, wave = __builtin_amdgcn_readfirstlane(tid >> 6), r32 = lane & 31, hi = lane >> 5;
    const float log2g = __builtin_amdgcn_logf(1.0f - __builtin_amdgcn_exp2f(-5.0f - (float)h));
    const size_t row0 = (size_t)b * SEQ + c * 256;
    u32x4 sreg[4], vreg[8], kreg[8];
    { const bf16_t* sp = stt + ((size_t)(bh * 64 + c) << 14);
#pragma unroll
      for (int i = 0; i < 4; ++i) sreg[i] = *(const u32x4*)(sp + (size_t)(tid + 512 * i) * 8); }
    const size_t hrow0 = (size_t)bh * SEQ + c * 256;
#pragma unroll
    for (int i = 0; i < 8; ++i) { const int pc = tid + 512 * i, t = pc >> 4, ch = pc & 15; const bf16_t* src = proj + (hrow0 + t) * 128 + ch * 8;
        vreg[i] = *(const u32x4*)(src + 5 * SEC); kreg[i] = *(const u32x4*)(src + 4 * SEC); }
    bf16x8 qf[8];
    { const bf16_t* qp = proj + 3 * SEC + (hrow0 + wave * 32 + r32) * 128 + hi * 8;
#pragma unroll
      for (int ks = 0; ks < 8; ++ks) qf[ks] = *(const bf16x8*)(qp + ks * 16); }
#pragma unroll
    for (int i = 0; i < 4; ++i) { const int pc = tid + 512 * i, e = pc >> 4, ch = pc & 15; *(LAS u32x4*)(lds + RO_A + ch * 2048 + e * 16) = sreg[i]; }
#pragma unroll
    for (int i = 0; i < 8; ++i) { const int pc = tid + 512 * i, t = pc >> 4, ch = pc & 15; *(LAS u32x4*)(lds + RO_V + rimg_off(t, ch * 8)) = vreg[i]; }
    __syncthreads();
    RO_STAMP(22);
    f32x16 o[4];
#pragma unroll
    for (int et = 0; et < 4; ++et)
#pragma unroll
        for (int r = 0; r < 16; ++r) o[et][r] = 0.f;
    { const lds_cptr sb = (lds_cptr)lds + RO_A + hi * 2048 + r32 * 16;
#pragma unroll
      for (int et = 0; et < 4; ++et)
#pragma unroll
          for (int ks = 0; ks < 8; ++ks) o[et] = __builtin_amdgcn_mfma_f32_32x32x16_bf16(qf[ks], *(const LAS bf16x8*)(sb + ks * 4096 + et * 512), o[et], 0, 0, 0); }
#pragma unroll
    for (int r = 0; r < 16; ++r) { const float f = __builtin_amdgcn_exp2f((float)(wave * 32 + crow(r, hi) + 1) * log2g);
#pragma unroll
        for (int et = 0; et < 4; ++et) o[et][r] *= f; }
    RO_STAMP(23);
    __syncthreads();
#pragma unroll
    for (int i = 0; i < 8; ++i) { const int pc = tid + 512 * i, t = pc >> 4, ch = pc & 15; *(LAS u32x4*)(lds + RO_A + ch * 4096 + t * 16) = kreg[i]; }
    __syncthreads();
    u32x4 rgv[8];
#pragma unroll
    for (int g = 0; g < 4; ++g)
#pragma unroll
        for (int k = 0; k < 2; ++k) { const int pidx = lane + 64 * k; rgv[2 * g + k] = *(const u32x4*)(proj + 6 * SEC + (hrow0 + wave * 32 + 8 * g + (pidx >> 4)) * 128 + (pidx & 15) * 8); }
    const lds_cptr vp = (lds_cptr)lds + RO_V + ((lane >> 4) & 1) * 32 + (lane & 3) * 8 + (4 * hi + ((lane & 15) >> 2)) * 64;
    const lds_cptr kpb = (lds_cptr)lds + RO_A + hi * 4096 + r32 * 16;
    for (int kvt = 0; kvt <= wave; ++kvt) {
        f32x16 p;
#pragma unroll
        for (int r = 0; r < 16; ++r) p[r] = 0.f;
#pragma unroll
        for (int ks = 0; ks < 8; ++ks) p = __builtin_amdgcn_mfma_f32_32x32x16_bf16(*(const LAS bf16x8*)(kpb + ks * 8192 + kvt * 512), qf[ks], p, 0, 0, 0);
        const int dbase = 32 * (wave - kvt) + r32 - 4 * hi;
#pragma unroll
        for (int r = 0; r < 16; ++r) { const int dist = dbase - ((r & 3) + 8 * (r >> 2)); p[r] = dist >= 0 ? p[r] * __builtin_amdgcn_exp2f((float)dist * log2g) : 0.f; }
        const u32x4 pw0 = {pk(p[0], p[1]), pk(p[2], p[3]), pk(p[4], p[5]), pk(p[6], p[7])}, pw1 = {pk(p[8], p[9]), pk(p[10], p[11]), pk(p[12], p[13]), pk(p[14], p[15])};
        const lds_cptr vt = vp + kvt * 2048;
#pragma unroll
        for (int et = 0; et < 4; ++et) {
            o[et] = __builtin_amdgcn_mfma_f32_32x32x16_bf16(__builtin_bit_cast(bf16x8, pw0), cat8(vtr(vt + et * 16384), vtr(vt + et * 16384 + 512)), o[et], 0, 0, 0);
            o[et] = __builtin_amdgcn_mfma_f32_32x32x16_bf16(__builtin_bit_cast(bf16x8, pw1), cat8(vtr(vt + et * 16384 + 1024), vtr(vt + et * 16384 + 1536)), o[et], 0, 0, 0);
        }
    }
    RO_STAMP(24);
    float mu[16], rstd[16];
#pragma unroll
    for (int r = 0; r < 16; ++r) {
        float s = (o[0][r] + o[1][r]) + (o[2][r] + o[3][r]);
        s += __shfl_xor(s, 1); s += __shfl_xor(s, 2); s += __shfl_xor(s, 4); s += __shfl_xor(s, 8); s += __shfl_xor(s, 16);
        mu[r] = s * (1.0f / 128.0f);
        const float d0 = o[0][r] - mu[r], d1 = o[1][r] - mu[r], d2 = o[2][r] - mu[r], d3 = o[3][r] - mu[r];
        float q = (d0 * d0 + d1 * d1) + (d2 * d2 + d3 * d3);
        q += __shfl_xor(q, 1); q += __shfl_xor(q, 2); q += __shfl_xor(q, 4); q += __shfl_xor(q, 8); q += __shfl_xor(q, 16);
        rstd[r] = rsqrtf(q * (1.0f / 128.0f) + GN_EPS);
    }
    float gn[4];
#pragma unroll
    for (int et = 0; et < 4; ++et) gn[et] = gain[h * 128 + et * 32 + r32];
    LAS bf16_t* st = (LAS bf16_t*)(lds + RO_ST) + wave * 1024;
#pragma unroll
    for (int g = 0; g < 4; ++g) {
#pragma unroll
        for (int rr = 0; rr < 4; ++rr) { const int r = 4 * g + rr;
#pragma unroll
            for (int et = 0; et < 4; ++et) st[(rr + 4 * hi) * 128 + et * 32 + r32] = f2bf((o[et][r] - mu[r]) * rstd[r] * gn[et]); }
#pragma unroll
        for (int k = 0; k < 2; ++k) { const int pidx = lane + 64 * k, r8 = pidx >> 4, ch = pidx & 15; const size_t row = row0 + wave * 32 + 8 * g + r8;
            const u32x4 nv = *(const LAS u32x4*)(st + r8 * 128 + ch * 8); const u32x4 gv = rgv[2 * g + k];
            const unsigned nw[4] = {nv.x, nv.y, nv.z, nv.w}, gw_[4] = {gv.x, gv.y, gv.z, gv.w}; unsigned ow[4];
#pragma unroll
            for (int q = 0; q < 4; ++q) { const float g0 = __uint_as_float(gw_[q] << 16), g1 = __uint_as_float(gw_[q] & 0xffff0000u);
                ow[q] = pk(__uint_as_float(nw[q] << 16) * (g0 / (1.0f + __expf(-g0))), __uint_as_float(nw[q] & 0xffff0000u) * (g1 / (1.0f + __expf(-g1)))); }
            *(u32x4*)(mix + row * DM + 512 + h * 128 + ch * 8) = (u32x4){ow[0], ow[1], ow[2], ow[3]}; }
    }
    RO_STAMP(25);
    __syncthreads();
    RO_STAMP(26);
}
#undef RO_STAMP
}
#ifndef DIAG_K
#define DIAG_K -1
#endif
#ifndef DIAG_BLOCK
#define DIAG_BLOCK 100
#endif
#ifndef DIAG_SCALE
#define DIAG_SCALE 1.0f
#endif
#ifndef DIAG_A
#define DIAG_A 45
#endif
#ifndef DIAG_B
#define DIAG_B 6
#endif
#ifndef REP_MASK
#define REP_MASK 0
#endif
#ifndef REP_SUB
#define REP_SUB 7
#endif
#include <hip/hip_cooperative_groups.h>
namespace cg = cooperative_groups;
constexpr int NWAVES = 8, NTHREADS = 512;
constexpr int LDS_BYTES = 147456 + 256;
constexpr int NPH = 10;
constexpr size_t WS_STASH = 180 * MiB;
constexpr size_t STASH_ELEMS = (size_t)512 * 2 * FF;

struct Args { const float* in[16]; float* out; unsigned char* ws; int ph_lo, ph_hi, flags, pad; };

__device__ __forceinline__ void p0_transpose_item(const float* __restrict__ W, int K, int N, const float* __restrict__ gk, bf16_t* __restrict__ WT, int k0, int n0, int orow0, LAS float* scr, int lane) {
    { float4 v[8];
#pragma unroll
      for (int i = 0; i < 8; ++i) v[i] = *(const float4*)(W + (size_t)(k0 + 8 * i + (lane >> 3)) * N + n0 + (lane & 7) * 4);
#pragma unroll
      for (int i = 0; i < 8; ++i) { const int kk = 8 * i + (lane >> 3); const float g = gk ? gk[k0 + kk] : 1.0f; LAS float* d = scr + kk * 33 + (lane & 7) * 4;
          d[0] = v[i].x * g; d[1] = v[i].y * g; d[2] = v[i].z * g; d[3] = v[i].w * g; } }
    asm volatile("s_waitcnt lgkmcnt(0)" ::: "memory");
    const int c = lane & 7;
#pragma unroll
    for (int j = 0; j < 4; ++j) { const int n = (lane >> 3) + 8 * j; const LAS float* s = scr + (8 * c) * 33 + n;
        uint4 o; o.x = (u32)f2bf(s[0 * 33]) | ((u32)f2bf(s[1 * 33]) << 16); o.y = (u32)f2bf(s[2 * 33]) | ((u32)f2bf(s[3 * 33]) << 16);
        o.z = (u32)f2bf(s[4 * 33]) | ((u32)f2bf(s[5 * 33]) << 16); o.w = (u32)f2bf(s[6 * 33]) | ((u32)f2bf(s[7 * 33]) << 16);
        *(uint4*)(WT + (size_t)(orow0 + n) * K + k0 + 8 * c) = o; }
    asm volatile("s_waitcnt lgkmcnt(0)" ::: "memory");
}

#define XB_TMO      128
#define XB_XCNT(j)  (256  + 64 * (j))
#define XB_XSUB(j)  (1280 + 64 * (j))
#define XB_XGEN(j)  (2304 + 64 * (j))
#define XB_TOP      3328
#define XB_TOPGEN   3392
#define XCD_BAR_WORDS 3456
#define XB_SPIN_CAP (1u << 18)

__device__ __forceinline__ unsigned xb_ld(unsigned* p)              { return __hip_atomic_load(p, __ATOMIC_RELAXED, __HIP_MEMORY_SCOPE_AGENT); }
__device__ __forceinline__ unsigned xb_add(unsigned* p, unsigned v) { return __hip_atomic_fetch_add(p, v, __ATOMIC_RELAXED, __HIP_MEMORY_SCOPE_AGENT); }
__device__ __forceinline__ unsigned xb_xcc_id() { return (unsigned)__builtin_amdgcn_s_getreg((3 << 11) | 20) & 0xFu; }
#define XB_SPIN(cond, bar) do { unsigned _sp = 0; while (cond) { __builtin_amdgcn_s_sleep(1); \
    if ((++_sp & 255u) == 0u) { if (xb_ld(&(bar)[XB_TMO])) break; if (_sp > XB_SPIN_CAP) { atomicAdd(&(bar)[XB_TMO], 1u); break; } } } } while (0)

struct XcdBarrier {
    unsigned* bar; unsigned x;
    volatile LAS unsigned* st;
};

__device__ __forceinline__ XcdBarrier xcd_barrier_post(unsigned* bar, volatile LAS unsigned* st) {
    XcdBarrier b; b.bar = bar; b.x = xb_xcc_id(); b.st = st;
    if (threadIdx.x == 0) (void)xb_add(&bar[XB_XCNT(b.x)], 1u);
    return b;
}
__device__ __forceinline__ void xcd_barrier_complete(unsigned* bar, unsigned x, unsigned& nloc, unsigned& nx) {
    const unsigned G = gridDim.x * gridDim.y * gridDim.z;
    unsigned sum, cnt, mine, sp = 0u;
    for (;;) {
        sum = 0u; cnt = 0u; mine = 0u;
#pragma unroll
        for (unsigned j = 0; j < 16; ++j) { const unsigned c = xb_ld(&bar[XB_XCNT(j)]); sum += c; cnt += (c > 0u) ? 1u : 0u; mine = (j == x) ? c : mine; }
        if (sum == G) break;
        __builtin_amdgcn_s_sleep(1);
        if ((++sp & 255u) == 0u) { if (xb_ld(&bar[XB_TMO])) break; if (sp > XB_SPIN_CAP) { atomicAdd(&bar[XB_TMO], 1u); break; } }
    }
    nloc = mine > 0u ? mine : 1u; nx = cnt > 0u ? cnt : 1u;
}

__device__ __forceinline__ void xcd_barrier(const XcdBarrier& b) {
    asm volatile("s_waitcnt vmcnt(0)" ::: "memory");
    __syncthreads();
    if (threadIdx.x == 0) {
        unsigned* bar = b.bar;
        __builtin_amdgcn_s_waitcnt(0);
        unsigned nloc = b.st[0], nx = b.st[1];
        if (nloc == 0u) { xcd_barrier_complete(bar, b.x, nloc, nx); b.st[0] = nloc; b.st[1] = nx; }
        const unsigned old = xb_add(&bar[XB_XSUB(b.x)], 1u);
        const unsigned gen = old / nloc;
        if (old + 1u == (gen + 1u) * nloc) {
            __builtin_amdgcn_fence(__ATOMIC_RELEASE, "agent");
            asm volatile("s_waitcnt vmcnt(0)" ::: "memory");
            const unsigned og = xb_add(&bar[XB_TOP], 1u);
            const unsigned tg = og / nx;
            if (og + 1u == (tg + 1u) * nx) xb_add(&bar[XB_TOPGEN], 1u);
            else XB_SPIN(xb_ld(&bar[XB_TOPGEN]) == tg, bar);
            __builtin_amdgcn_fence(__ATOMIC_ACQUIRE, "agent");
            xb_add(&bar[XB_XGEN(b.x)], 1u);
            asm volatile("s_waitcnt vmcnt(0)" ::: "memory");
        } else {
            XB_SPIN(xb_ld(&bar[XB_XGEN(b.x)]) == gen, bar);
            __builtin_amdgcn_fence(__ATOMIC_ACQUIRE, "agent");
            asm volatile("s_waitcnt vmcnt(0)" ::: "memory");
        }
    }
    __syncthreads();
}

constexpr int CW_BAR = 4096;
constexpr int LDS_BARST = 147456;
constexpr size_t CTL_ZERO_BYTES = 65536;
constexpr int CW_PANEL = 8192;

#if (REP_MASK >> 2) & 1
#define SUBON2(bit) (rep == 0 || ((REP_SUB >> (bit)) & 1))
#else
#define SUBON2(bit) true
#endif
#if (REP_MASK >> 3) & 1
#define SUBON3(bit) (rep == 0 || ((REP_SUB >> (bit)) & 1))
#else
#define SUBON3(bit) true
#endif
#if (REP_MASK >> 4) & 1
#define SUBON4(bit) (rep == 0 || ((REP_SUB >> (bit)) & 1))
#else
#define SUBON4(bit) true
#endif
__global__ void __launch_bounds__(NTHREADS, 2) mega(Args a) {
    extern __shared__ __attribute__((aligned(16))) unsigned char lds[];
    cg::grid_group grid = cg::this_grid();
    const int wave = __builtin_amdgcn_readfirstlane(threadIdx.x >> 6);
#define MKLANE() ({ int l_; asm volatile("v_mbcnt_lo_u32_b32 %0, -1, 0\n\tv_mbcnt_hi_u32_b32 %0, -1, %0" : "=v"(l_)); l_; })
#define MKTID() (wave * 64 + MKLANE())
#define tid MKTID()
#define lane MKLANE()
    const int G = gridDim.x, bx = blockIdx.x;
    const int vcu = (G % 8 == 0) ? (bx % 8) * (G / 8) + bx / 8 : bx;
    const int gw = vcu * NWAVES + wave, NGW = G * NWAVES;
    unsigned char* ws = a.ws;
    const float* x = a.in[0]; const float* p = a.in[1]; const float* attn_norm = a.in[2]; const float* w_in = a.in[3]; const float* ret_norm = a.in[4]; const float* w_out = a.in[5];
    const float* ffn_norm = a.in[6]; const float* w_up = a.in[7]; const float* w_gate = a.in[8]; const float* conv_w = a.in[9]; const float* conv_b = a.in[10]; const float* w_down = a.in[11];
    const float* ple_norm = a.in[12]; const float* w_ple = a.in[13]; const float* w_ple_gate = a.in[14]; const float* final_norm = a.in[15];
    float* out = a.out;
    bf16_t* Win_t = (bf16_t*)(ws + WS_WIN); bf16_t* Wout_t = (bf16_t*)(ws + WS_WOUT); bf16_t* Wug_t = (bf16_t*)(ws + WS_WUG); bf16_t* Wdown_t = (bf16_t*)(ws + WS_WDOWN);
    bf16_t* Wpg_t = (bf16_t*)(ws + WS_WPG); bf16_t* Wple_t = (bf16_t*)(ws + WS_WPLE);
    bf16_t* XN = (bf16_t*)(ws + WS_R1); bf16_t* MIX = (bf16_t*)(ws + WS_SEG); bf16_t* PW = (bf16_t*)(ws + WS_R1);
    float* RS0 = (float*)(ws + WS_CNT + 768 * 1024);
    unsigned* KMX = (unsigned*)(ws + WS_CNT + 896 * 1024);
    bf16_t* XB = (bf16_t*)(ws + WS_R2);
    bf16_t* PROJ = (bf16_t*)(ws + WS_PROJ); bf16_t* ACT = (bf16_t*)(ws + WS_PROJ);
    bf16_t* PB = (bf16_t*)(ws + WS_PB); float* RSQ = (float*)(ws + WS_RSQ);
    float* KM = (float*)(ws + WS_KMEAN);
    float* UL = (float*)(ws + WS_STASH); float* UF = UL + STASH_ELEMS; float* GF = UF + STASH_ELEMS;
    float* KVT = (float*)(ws + WS_KVT); bf16_t* STT = (bf16_t*)(ws + WS_STT); float* PART_L = (float*)(ws + WS_PARTL); bf16_t* PART_O = (bf16_t*)out;
    u32* SEL = (u32*)(ws + WS_SEL); unsigned short* SEG = (unsigned short*)(ws + WS_SEG); int* CNT = (int*)(ws + WS_CNT);

    const int lo = a.ph_lo, hi = a.ph_hi;
#if DIAG_K >= 0
    unsigned long long* dts = (unsigned long long*)(ws + WS_CTL + 49152);
#define DIAG_STAMP(i) do { if (bx == DIAG_BLOCK && wave == 0 && MKLANE() == 0) __hip_atomic_store(dts + (i), (unsigned long long)__builtin_amdgcn_s_memrealtime(), __ATOMIC_RELAXED, __HIP_MEMORY_SCOPE_AGENT); } while (0)
    DIAG_STAMP(0);
#define DIAG_DTS(it) ((bx == DIAG_BLOCK && (it) == bx) ? dts : (unsigned long long*)nullptr)
#else
#define DIAG_STAMP(i) do { } while (0)
#define DIAG_DTS(it) ((unsigned long long*)nullptr)
#endif
#define IN(k) (lo <= (k) && (k) < hi)
#define SEAM(k) do { if (IN(k) && IN((k) + 1)) { DIAG_STAMP(40 + (k)); if (a.ph_lo < 0) grid.sync(); else xcd_barrier(xbar); DIAG_STAMP(1 + (k)); } } while (0)
    { volatile LAS unsigned* st = (volatile LAS unsigned*)((LAS unsigned char*)lds + LDS_BARST); if (tid < 2) st[tid] = 0u; }
    __syncthreads();
    XcdBarrier xbar = xcd_barrier_post((unsigned*)(ws + WS_CTL) + CW_BAR, (volatile LAS unsigned*)((LAS unsigned char*)lds + LDS_BARST));

#if (REP_MASK >> 0) & 1
    for (int rep = 0; rep < 2; ++rep)
#endif
    if (IN(0)) {
        LAS float* scr = (LAS float*)(lds) + wave * (64 * 33);
        constexpr int I_IN = 16 * (NPROJ / 32), I_OUT = 16 * (DM / 32), I_UP = 16 * (FF / 32), I_DOWN = (FF / 64) * (DM / 32), I_PG = 16 * (DM / 32), I_PLE = (PLED / 64) * (DM / 32);
        constexpr int NITEMS = I_IN + I_OUT + 2 * I_UP + I_DOWN + I_PG + I_PLE;
        for (int it = gw; it < NITEMS; it += NGW) {
            int r = it;
            if (r < I_IN) { const int nb = r % (NPROJ / 32), kb = r / (NPROJ / 32); p0_transpose_item(w_in, DM, NPROJ, nullptr, Win_t, kb * 64, nb * 32, nb * 32, scr, lane); continue; } r -= I_IN;
            if (r < I_OUT) { const int nb = r % (DM / 32), kb = r / (DM / 32); p0_transpose_item(w_out, DM, DM, nullptr, Wout_t, kb * 64, nb * 32, nb * 32, scr, lane); continue; } r -= I_OUT;
            if (r < I_UP) { const int nb = r % (FF / 32), kb = r / (FF / 32), n0 = nb * 32; p0_transpose_item(w_up, DM, FF, ffn_norm, Wug_t, kb * 64, n0, (n0 >> 7) * 256 + (n0 & 127), scr, lane); continue; } r -= I_UP;
            if (r < I_UP) { const int nb = r % (FF / 32), kb = r / (FF / 32), n0 = nb * 32; p0_transpose_item(w_gate, DM, FF, ffn_norm, Wug_t, kb * 64, n0, (n0 >> 7) * 256 + 128 + (n0 & 127), scr, lane); continue; } r -= I_UP;
            if (r < I_DOWN) { const int nb = r % (DM / 32), kb = r / (DM / 32); p0_transpose_item(w_down, FF, DM, nullptr, Wdown_t, kb * 64, nb * 32, nb * 32, scr, lane); continue; } r -= I_DOWN;
            if (r < I_PG) { const int nb = r % (DM / 32), kb = r / (DM / 32); p0_transpose_item(w_ple_gate, DM, DM, ple_norm, Wpg_t, kb * 64, nb * 32, nb * 32, scr, lane); continue; } r -= I_PG;
            { const int nb = r % (DM / 32), kb = r / (DM / 32); p0_transpose_item(w_ple, PLED, DM, nullptr, Wple_t, kb * 64, nb * 32, nb * 32, scr, lane); }
        }
        DIAG_STAMP(12);
        for (int m = gw; m < MT; m += 2 * NGW) {
            const int m2 = m + NGW;
            const float4* xr = (const float4*)(x + (size_t)m * DM); const float4* xr2 = (const float4*)(x + (size_t)m2 * DM); float4 v[4], w[4]; float s = 0.f, s2 = 0.f;
#pragma unroll
            for (int j = 0; j < 4; ++j) { v[j] = xr[lane + 64 * j]; w[j] = xr2[lane + 64 * j]; }
#pragma unroll
            for (int j = 0; j < 4; ++j) { s += v[j].x * v[j].x + v[j].y * v[j].y + v[j].z * v[j].z + v[j].w * v[j].w; s2 += w[j].x * w[j].x + w[j].y * w[j].y + w[j].z * w[j].z + w[j].w * w[j].w; }
            const float rs = rsqrtf(wave_sum(s) * (1.0f / DM) + RMS_EPS), rs2 = rsqrtf(wave_sum(s2) * (1.0f / DM) + RMS_EPS);
            if (lane == 0) { RS0[m] = rs; RS0[m2] = rs2; }
#pragma unroll
            for (int j = 0; j < 4; ++j) { const float4 gg = ((const float4*)attn_norm)[lane + 64 * j];
                ushort4 o; o.x = f2bf(v[j].x * rs * gg.x); o.y = f2bf(v[j].y * rs * gg.y); o.z = f2bf(v[j].z * rs * gg.z); o.w = f2bf(v[j].w * rs * gg.w);
                ((ushort4*)(XN + (size_t)m * DM))[lane + 64 * j] = o;
                ushort4 o2; o2.x = f2bf(w[j].x * rs2 * gg.x); o2.y = f2bf(w[j].y * rs2 * gg.y); o2.z = f2bf(w[j].z * rs2 * gg.z); o2.w = f2bf(w[j].w * rs2 * gg.w);
                ((ushort4*)(XN + (size_t)m2 * DM))[lane + 64 * j] = o2; }
        }
        DIAG_STAMP(13);
        { const size_t n4 = (size_t)MT * PLED / 4; const size_t gt = (size_t)vcu * NTHREADS + tid, GT = (size_t)G * NTHREADS;
          for (size_t i = gt; i < n4; i += GT) { const float4 v = ((const float4*)p)[i]; ushort4 o; o.x = f2bf(v.x); o.y = f2bf(v.y); o.z = f2bf(v.z); o.w = f2bf(v.w); ((ushort4*)PB)[i] = o; }
          for (size_t i = gt; i < 16 * 64 * 64; i += GT) KM[i] = 0.f;
          if (gt < 16 * 64 * 2) KMX[gt] = 0u;
          if (gt < 64) ((int*)(ws + WS_CTL))[gt] = 0;
          for (size_t i = gt; i < 16 * 64 * 64; i += GT) CNT[i] = 0; }
    }
    SEAM(0);
#if (REP_MASK >> 1) & 1
    if (IN(1)) {
        pg8::Gemm g{XN, Win_t, MT, NPROJ, DM}; pg8::StaticOrder S; S.init(MT, NPROJ, G, bx);
        pg8::EpiProj E{PROJ, KM, KMX};
        pg8::gemm_phase<pg8::EpiProj, pg8::StaticOrder, true, true>((PG8_LAS unsigned char*)lds, g, S, E, MKTID());
    }
    asm volatile("" ::: "memory");
#endif
    if (IN(1)) {
        pg8::Gemm g{XN, Win_t, MT, NPROJ, DM}; pg8::StaticOrder S; S.init(MT, NPROJ, G, bx);
        pg8::EpiProj E{PROJ, KM, KMX};
        pg8::gemm_phase<pg8::EpiProj, pg8::StaticOrder, true, true>((PG8_LAS unsigned char*)lds, g, S, E, MKTID());
    }
    SEAM(1);
#if (REP_MASK >> 2) & 1
    { const int rep = 1; (void)rep;
    if (IN(2)) {
        mx::lds_ptr L = (mx::lds_ptr)lds;
        if (!(a.flags & 1) && SUBON2(0)) for (int it = bx; it < 512; it += G) mx::ret_kv_task(PROJ, it >> 6, it & 63, KVT, L, tid);
        if (!(a.flags & 2)) {
            if (SUBON2(1)) for (int it = bx; it < 16 * 63; it += G) mx::gate_task_mfma(it / 63, 1 + it % 63, PROJ, KM, SEL, SEG, CNT, KMX, PART_L, L, tid);
            { const int gtid = vcu * NTHREADS + tid; if (gtid < BATCH * 256 * 8) { const int h = gtid & 7, t = (gtid >> 3) & 255, b = gtid >> 11; SEL[((size_t)b * SEQ + t) * 8 + h] = 0u; } }
        }
    }
    }
    asm volatile("" ::: "memory");
#endif
    { const int rep = 0; (void)rep;
    if (IN(2)) {
        mx::lds_ptr L = (mx::lds_ptr)lds;
        if (!(a.flags & 1) && SUBON2(0)) for (int it = bx; it < 512; it += G) mx::ret_kv_task(PROJ, it >> 6, it & 63, KVT, L, tid);
        DIAG_STAMP(14);
        if (!(a.flags & 2)) {
            if (SUBON2(1)) for (int it = bx; it < 16 * 63; it += G) mx::gate_task_mfma(it / 63, 1 + it % 63, PROJ, KM, SEL, SEG, CNT, KMX, PART_L, L, tid);
        DIAG_STAMP(15);
            { const int gtid = vcu * NTHREADS + tid; if (gtid < BATCH * 256 * 8) { const int h = gtid & 7, t = (gtid >> 3) & 255, b = gtid >> 11; SEL[((size_t)b * SEQ + t) * 8 + h] = 0u; } }
        }
    }
    }
    SEAM(2);
#if (REP_MASK >> 3) & 1
#define QREP rep
#else
#define QREP 0
#endif
#if (REP_MASK >> 3) & 1
    for (int rep = 0; rep < 2; ++rep)
#endif
    if (IN(3)) {
        mx::lds_ptr L = (mx::lds_ptr)lds;
        if (!(a.flags & 1) && SUBON3(0)) mx::ret_scan(KVT, STT, (size_t)vcu * NTHREADS + tid, (size_t)G * NTHREADS);
        DIAG_STAMP(18);
        if (!(a.flags & 2) && SUBON3(1)) {
            LAS int* qslot = (LAS int*)(L + mx::L_PREF + 384);
            for (;;) {
                if (tid == 0) *qslot = atomicAdd((int*)(ws + WS_CTL) + QREP, 1);
                __syncthreads();
                const int q = *qslot;
                __syncthreads();
                if (q >= 16 * 63) break;
                mx::moba_sel_task(PROJ, SEG, CNT, q & 15, q >> 4, PART_O, PART_L, L, tid);
            }
        }
        DIAG_STAMP(19);
    }
    SEAM(3);
#if (REP_MASK >> 4) & 1
    { const int rep = 1; (void)rep;
    if (IN(4)) {
        mx::lds_ptr L = (mx::lds_ptr)lds;
        if (!(a.flags & 1) && SUBON4(0)) for (int it = bx; it < 512; it += G) mx::ret_out_task(PROJ, STT, ret_norm, MIX, it >> 6, it & 63, L, tid);
        if (!(a.flags & 2) && SUBON4(1)) for (int it = bx; it < 16 * 64; it += G) mx::moba_diag_unit(PROJ, it >> 6, it & 63, PART_O, PART_L, SEL, MIX, L, tid);
    }
    }
    asm volatile("" ::: "memory");
#endif
    { const int rep = 0; (void)rep;
    if (IN(4)) {
        mx::lds_ptr L = (mx::lds_ptr)lds;
        if (vcu & 1) for (int it = bx; it < 16 * 64; it += G) mx::moba_diag_unit(PROJ, it >> 6, it & 63, PART_O, PART_L, SEL, MIX, L, tid);
        for (int it = bx; it < 512; it += G) mx::ret_out_task(PROJ, STT, ret_norm, MIX, it >> 6, it & 63, L, tid, DIAG_DTS(it));
        DIAG_STAMP(16);
        if (!(vcu & 1)) for (int it = bx; it < 16 * 64; it += G) mx::moba_diag_unit(PROJ, it >> 6, it & 63, PART_O, PART_L, SEL, MIX, L, tid);
        DIAG_STAMP(17);
    }
    }
    SEAM(4);
#if (REP_MASK >> 5) & 1
    if (IN(5)) {
        pg8::Gemm g{MIX, Wout_t, MT, DM, DM}; pg8::StaticOrder S; S.init(MT, DM, G, bx);
        pg8::EpiRes<false> E{x, XB, RSQ};
        pg8::gemm_phase<pg8::EpiRes<false>, pg8::StaticOrder, true, true>((PG8_LAS unsigned char*)lds, g, S, E, MKTID());
    }
    asm volatile("" ::: "memory");
#endif
    if (IN(5)) {
        pg8::Gemm g{MIX, Wout_t, MT, DM, DM}; pg8::StaticOrder S; S.init(MT, DM, G, bx);
        pg8::EpiResXN E{XN, RS0, attn_norm, XB, RSQ};
        pg8::gemm_phase<pg8::EpiResXN, pg8::StaticOrder, true, true>((PG8_LAS unsigned char*)lds, g, S, E, MKTID());
    }
    SEAM(5);
#if (REP_MASK >> 6) & 1
    if (IN(6)) {
        pg8::Gemm g{XB, Wug_t, MT, 2 * FF, DM}; pg8::StaticOrder S; S.init(MT, 2 * FF, G, bx);
        pg8::EpiUG E{ACT, RSQ, conv_w, conv_b, UL, UF, GF};
        pg8::gemm_phase<pg8::EpiUG, pg8::StaticOrder, true, true>((PG8_LAS unsigned char*)lds, g, S, E, MKTID());
    }
    asm volatile("" ::: "memory");
#endif
    if (IN(6)) {
        pg8::Gemm g{XB, Wug_t, MT, 2 * FF, DM}; pg8::StaticOrder S; S.init(MT, 2 * FF, G, bx);
        pg8::EpiUG E{ACT, RSQ, conv_w, conv_b, UL, UF, GF};
        pg8::gemm_phase<pg8::EpiUG, pg8::StaticOrder, true, true>((PG8_LAS unsigned char*)lds, g, S, E, MKTID());
    }
    SEAM(6);
#if (REP_MASK >> 7) & 1
    for (int rep = 0; rep < 2; ++rep)
#endif
    if (IN(7)) {
        const size_t gt = (size_t)vcu * NTHREADS + tid, GT = (size_t)G * NTHREADS;
        for (size_t i = gt; i < (size_t)512 * 2 * (FF / 4); i += GT) {
            const int c = (int)(i % (FF / 4)) * 4, r = (int)((i / (FF / 4)) & 1), g64 = (int)(i / (FF / 4) / 2);
            const bool first = (g64 & 255) == 0; const size_t pg = first ? 0 : (size_t)(g64 - 1);
            const pg8::f32x4 q0 = *(const pg8::f32x4*)(UL + (pg * 2 + 0) * FF + c), q1 = *(const pg8::f32x4*)(UL + (pg * 2 + 1) * FF + c);
            const pg8::f32x4 f0 = *(const pg8::f32x4*)(UF + ((size_t)g64 * 2 + 0) * FF + c), f1 = *(const pg8::f32x4*)(UF + ((size_t)g64 * 2 + 1) * FF + c);
            const pg8::f32x4 gg = *(const pg8::f32x4*)(GF + ((size_t)g64 * 2 + r) * FF + c);
            const pg8::f32x4 w0 = *(const pg8::f32x4*)(conv_w + c), w1 = *(const pg8::f32x4*)(conv_w + FF + c), w2 = *(const pg8::f32x4*)(conv_w + 2 * FF + c), cb = *(const pg8::f32x4*)(conv_b + c);
            const float z = first ? 0.f : 1.f;
            const pg8::f32x4 p0 = q0 * z, p1 = q1 * z;
            const pg8::f32x4 u2 = r == 0 ? p0 : p1, u1 = r == 0 ? p1 : f0, u0 = r == 0 ? f0 : f1;
            const pg8::f32x4 y = cb + w0 * u2 + w1 * u1 + w2 * u0;
            ushort4 o; o.x = f2bf(gelu_tanh(y[0]) * gg[0]); o.y = f2bf(gelu_tanh(y[1]) * gg[1]); o.z = f2bf(gelu_tanh(y[2]) * gg[2]); o.w = f2bf(gelu_tanh(y[3]) * gg[3]);
            *(ushort4*)(ACT + ((size_t)g64 * 64 + r) * FF + c) = o;
        }
        { int kk = PLED; asm volatile("" : "+s"(kk)); pg8::Gemm g{PB, Wple_t, MT, DM, kk}; pg8::StaticOrder S; S.init(MT, DM, G, bx); pg8::EpiStore E{PW};
          pg8::gemm_phase<pg8::EpiStore, pg8::StaticOrder, true, true>((PG8_LAS unsigned char*)lds, g, S, E, MKTID()); }
    }
    SEAM(7);
#if (REP_MASK >> 8) & 1
    if (IN(8)) {
        pg8::Gemm g{ACT, Wdown_t, MT, DM, FF}; pg8::StaticOrder S; S.init(MT, DM, G, bx);
        pg8::EpiRes<true, false> E{nullptr, XB, RSQ + (size_t)MT * 16};
        pg8::gemm_phase<pg8::EpiRes<true, false>, pg8::StaticOrder, true, true>((PG8_LAS unsigned char*)lds, g, S, E, MKTID());
    }
    asm volatile("" ::: "memory");
#endif
    if (IN(8)) {
        pg8::Gemm g{ACT, Wdown_t, MT, DM, FF}; pg8::StaticOrder S; S.init(MT, DM, G, bx);
        pg8::EpiRes<true> E{nullptr, XB, RSQ + (size_t)MT * 16};
        pg8::gemm_phase<pg8::EpiRes<true>, pg8::StaticOrder, true, true>((PG8_LAS unsigned char*)lds, g, S, E, MKTID());
    }
    SEAM(8);
#if (REP_MASK >> 9) & 1
    if (IN(9)) {
        if (REP_SUB & 1) { int kk = PLED; asm volatile("" : "+s"(kk)); pg8::Gemm g{PB, Wple_t, MT, DM, kk}; pg8::StaticOrder S; S.init(MT, DM, G, bx); pg8::EpiStore E{PW};
          pg8::gemm_phase<pg8::EpiStore, pg8::StaticOrder, true, true>((PG8_LAS unsigned char*)lds, g, S, E, MKTID()); }
        if (REP_SUB & 2) { int kk = DM; const bf16_t* a_ = XB; const bf16_t* b_ = Wpg_t; asm volatile("" : "+s"(kk), "+s"(a_), "+s"(b_) :: "memory"); pg8::Gemm g{a_, b_, MT, DM, kk}; pg8::StaticOrder S; S.init(MT, DM, G, bx); pg8::EpiPleNorm E{out, XB, PW, RSQ + (size_t)MT * 16, RSQ + (size_t)2 * MT * 16, (unsigned*)(ws + WS_CTL) + CW_PANEL, final_norm, DIAG_DTS(bx)};
          pg8::gemm_phase<pg8::EpiPleNorm, pg8::StaticOrder, true, true>((PG8_LAS unsigned char*)lds, g, S, E, MKTID()); }
    }
    asm volatile("" ::: "memory");
#endif
    if (IN(9)) {
        DIAG_STAMP(20);
        { int kk = DM; const bf16_t* a_ = XB; const bf16_t* b_ = Wpg_t; asm volatile("" : "+s"(kk), "+s"(a_), "+s"(b_) :: "memory"); pg8::Gemm g{a_, b_, MT, DM, kk}; pg8::StaticOrder S; S.init(MT, DM, G, bx); pg8::EpiPleNorm E{out, XB, PW, RSQ + (size_t)MT * 16, RSQ + (size_t)2 * MT * 16, (unsigned*)(ws + WS_CTL) + CW_PANEL, final_norm, DIAG_DTS(bx)};
          pg8::gemm_phase<pg8::EpiPleNorm, pg8::StaticOrder, true, true>((PG8_LAS unsigned char*)lds, g, S, E, MKTID()); }
    }
    SEAM(9);
    if (IN(10)) {
        const float* rsq = RSQ + (size_t)2 * MT * 16;
        for (int m = gw; m < MT; m += NGW) {
            const float rs = pg8::rs16(rsq + (size_t)m * 16); float4* xr = (float4*)(out + (size_t)m * DM);
#pragma unroll
            for (int j = 0; j < 4; ++j) { float4 v = xr[lane + 64 * j]; const float4 gg = ((const float4*)final_norm)[lane + 64 * j];
                v.x *= rs * gg.x; v.y *= rs * gg.y; v.z *= rs * gg.z; v.w *= rs * gg.w; xr[lane + 64 * j] = v; }
        }
    }
#if DIAG_K >= 0
    xcd_barrier(xbar); DIAG_STAMP(11);
    xcd_barrier(xbar);
    { const unsigned long long t0 = __hip_atomic_load(dts + 0, __ATOMIC_RELAXED, __HIP_MEMORY_SCOPE_AGENT), t1 = __hip_atomic_load(dts + 11, __ATOMIC_RELAXED, __HIP_MEMORY_SCOPE_AGENT);
      const unsigned long long ta = __hip_atomic_load(dts + (DIAG_K == 99 ? DIAG_A : DIAG_K), __ATOMIC_RELAXED, __HIP_MEMORY_SCOPE_AGENT), tb = DIAG_K == 99 ? __hip_atomic_load(dts + DIAG_B, __ATOMIC_RELAXED, __HIP_MEMORY_SCOPE_AGENT) : (DIAG_K == 9 ? t1 : __hip_atomic_load(dts + DIAG_K + 1, __ATOMIC_RELAXED, __HIP_MEMORY_SCOPE_AGENT));
      const float eps = (float)(tb - ta) / (float)(t1 - t0);
      const float sc = 1.0f + DIAG_SCALE * eps;
      float4* o4 = (float4*)out; const size_t gt = (size_t)vcu * NTHREADS + tid, GT = (size_t)G * NTHREADS;
      for (size_t i = gt; i < (size_t)MT * DM / 4; i += GT) { float4 v = o4[i]; v.x *= sc; v.y *= sc; v.z *= sc; v.w *= sc; o4[i] = v; } }
#endif
#undef IN
#undef SEAM
#undef tid
#undef lane
}

#ifndef BUILD_MODE
#define BUILD_MODE 0
#endif
static int g_grid = 0;
static void launch_mega(Args a, int lo, int hi, hipStream_t stream) {
    a.ph_lo = lo; a.ph_hi = hi; void* args[] = {&a};
    hipError_t e = hipLaunchCooperativeKernel((const void*)mega, dim3(g_grid), dim3(NTHREADS), args, LDS_BYTES, stream);
    if (e != hipSuccess) fprintf(stderr, "cooperative launch [%d,%d) failed: %s (grid %d)\n", lo, hi, hipGetErrorString(e), g_grid);
}
extern "C" void kernel_launch(void* const* d_in, const int* in_sizes, int n_in, void* d_out, int out_size, void* d_ws, size_t ws_size, hipStream_t stream) {
    if (n_in != 16 || out_size != MT * DM || ws_size < WS_END) { fprintf(stderr, "kernel_launch: unexpected shapes (n_in %d out %d ws %zu)\n", n_in, out_size, ws_size); return; }
    if (g_grid == 0) {
        int dev = 0, cus = 0, per_cu = 0;
        hipGetDevice(&dev); hipDeviceGetAttribute(&cus, hipDeviceAttributeMultiprocessorCount, dev);
        hipFuncSetAttribute((const void*)mega, hipFuncAttributeMaxDynamicSharedMemorySize, LDS_BYTES);
        hipOccupancyMaxActiveBlocksPerMultiprocessor(&per_cu, (const void*)mega, NTHREADS, LDS_BYTES);
        if (per_cu < 1) { fprintf(stderr, "occupancy query says %d blocks/CU\n", per_cu); per_cu = 1; }
        g_grid = cus * 1;
        (void)hipGetLastError();
    }
    unsigned char* ws = (unsigned char*)d_ws;
    hipMemsetAsync(ws + WS_CTL, 0, CTL_ZERO_BYTES, stream);
    Args a{}; for (int i = 0; i < 16; ++i) a.in[i] = (const float*)d_in[i]; a.out = (float*)d_out; a.ws = ws;

    a.flags = 0; launch_mega(a, 0, NPH, stream);
}
```

```cpp
#include <hip/hip_runtime.h>
#include <stdint.h>
#include <math.h>
#include <cstdio>

typedef unsigned short bf16_t;
typedef unsigned int u32;

constexpr int BATCH = 2, SEQ = 16384, MT = BATCH * SEQ, DM = 1024, NPROJ = 3584, FF = 2816, PLED = 256;
constexpr int MH = 8, MD = 64, RH = 4, RD = 128, NBLK = 64, BLK = 256;
constexpr int C_MQ = 0, C_MK = 512, C_MV = 1024, C_RQ = 1536, C_RK = 2048, C_RV = 2560, C_RG = 3072;
constexpr float RMS_EPS = 1e-6f, GN_EPS = 1e-5f;
constexpr float LOG2E = 1.4426950408889634f;
constexpr float QSCALE = 0.125f * LOG2E;
constexpr float RKSCALE = 0.08838834764831845f;
constexpr size_t SEC = (size_t)MT * 512;

constexpr size_t MiB = (size_t)1 << 20;
constexpr size_t WS_CTL = 0, WS_WIN = 1 * MiB, WS_WOUT = 8 * MiB, WS_WUG = 10 * MiB, WS_WDOWN = 21 * MiB, WS_WPG = 27 * MiB, WS_WPLE = 29 * MiB;
constexpr size_t WS_RSQ = 30 * MiB;
constexpr size_t WS_PB = 36 * MiB;
constexpr size_t WS_R2 = 52 * MiB;
constexpr size_t WS_R1 = 116 * MiB;
constexpr size_t WS_SEG = 180 * MiB;
constexpr size_t WS_KVT = 212 * MiB;
constexpr size_t WS_STT = 244 * MiB;
constexpr size_t WS_PARTL = 260 * MiB;
constexpr size_t WS_SEL = 264 * MiB;
constexpr size_t WS_CNT = 265 * MiB;
constexpr size_t WS_KMEAN = WS_CNT + 512 * 1024;
constexpr size_t WS_PROJ = 266 * MiB;
constexpr size_t WS_END = 490 * MiB;
constexpr size_t WS_UH = 116 * MiB;

__device__ __forceinline__ float bf2f(bf16_t v) { return __uint_as_float(((u32)v) << 16); }
__device__ __forceinline__ bf16_t f2bf(float f) { u32 u = __float_as_uint(f); return (bf16_t)((u + 0x7fffu + ((u >> 16) & 1u)) >> 16); }
__device__ __forceinline__ float wave_sum(float v) {
#pragma unroll
    for (int o = 1; o < 64; o <<= 1) v += __shfl_xor(v, o);
    return v;
}
__device__ __forceinline__ float rs_from(const float* p) {
    float s = 0.f;
#pragma unroll
    for (int i = 0; i < 16; ++i) s += p[i];
    return rsqrtf(s * (1.0f / DM) + RMS_EPS);
}
__device__ __forceinline__ float gelu_tanh(float x) {
    const float z = 0.7978845608028654f * (x + 0.044715f * x * x * x);
    return x / (1.0f + __expf(-2.0f * z));
}
__device__ __forceinline__ float sigmoidf_(float x) { return 1.0f / (1.0f + __expf(-x)); }


typedef unsigned u32x4_g __attribute__((ext_vector_type(4)));
__device__ __forceinline__ void wt_store16(void* base_uniform, size_t byte_off, u32x4_g v) {
    __builtin_amdgcn_raw_buffer_store_b128(v, __builtin_amdgcn_make_buffer_rsrc(base_uniform, 0, 0x7ffffff0, 0x00020000), (int)byte_off, 0, 16);
}
namespace pg8 {
#define PG8_LAS __attribute__((address_space(3)))
typedef unsigned short bf16_t;
typedef short bf16x8 __attribute__((ext_vector_type(8)));
typedef float f32x4 __attribute__((ext_vector_type(4)));
typedef unsigned u32x4 __attribute__((ext_vector_type(4)));
constexpr int BM = 256, BK = 64, HALF = 128, HTB = HALF * BK * 2  , STAGE_BYTES = 8 * HTB, NXCD = 8, WGM = 8;

__host__ __device__ __forceinline__ int lds_byte(int r, int c) { const int st = (r >> 4) * 2 + (c >> 5), rr = r & 15, cc = c & 31, ob = rr * 64 + cc * 2; return st * 1024 + (ob ^ (((ob >> 9) & 1) << 5)); }
__host__ __device__ __forceinline__ void stage_rc(int b, int& R, int& C) { const int st = b / 1024, sb = b % 1024, swz = sb ^ (((sb >> 9) & 1) << 5); R = (st >> 1) * 16 + swz / 64; C = (st & 1) * 32 + (swz % 64) / 2; }
__host__ __device__ __forceinline__ int perm32(int rho) { const int n = rho >> 4, i = rho & 15; return 8 * (i >> 2) + 4 * n + (i & 3); }

struct Unit { int pm, pn; };
struct Gemm { const bf16_t* A; const bf16_t* Bt; int M, N, K; };

struct StaticOrder {
    int nM, nN, nwg, G, c;
    __host__ __device__ void init(int M, int N, int G_, int c_) { nM = M / BM; nN = N / BM; nwg = nM * nN; G = G_; c = c_; }
    __host__ __device__ bool next(int i, Unit& u) const {
        const long L = (long)i * G + c; if (L >= nwg) return false;
        int wgid = (int)L; { const int q = nwg / NXCD, r = nwg % NXCD, xcd = wgid % NXCD, off = wgid / NXCD; wgid = (xcd < r ? xcd * (q + 1) : r * (q + 1) + (xcd - r) * q) + off; }
        const int nig = WGM * nN, gid = wgid / nig, fm = gid * WGM, gsz = (nM - fm) < WGM ? (nM - fm) : WGM;
        u.pm = fm + ((wgid % nig) % gsz); u.pn = (wgid % nig) / gsz; return true;
    }
    __device__ __forceinline__ void a_ready(const Unit&) const {}
    __device__ __forceinline__ void done(const Unit&) const {}
};

__device__ __forceinline__ unsigned cvt_pk_bf16(float lo, float hi) { unsigned r; asm volatile("v_cvt_pk_bf16_f32 %0, %1, %2" : "=v"(r) : "v"(lo), "v"(hi)); return r; }
typedef float f32x2 __attribute__((ext_vector_type(2)));
template <class Epi, class Sched, bool ALIGN_EPI = false, bool SP2 = false>
__device__ __forceinline__ void gemm_phase(PG8_LAS unsigned char* lds, const Gemm g, const Sched& S, const Epi& E, const int tid_in) {
    const int tid = tid_in, wid = __builtin_amdgcn_readfirstlane(tid >> 6), lane = tid & 63, wr = wid >> 2, wc = wid & 3, fr = lane & 15, fq = lane >> 4;
    const int K = g.K, nt = K / BK;
    unsigned voffA[2], voffB[2];
#pragma unroll
    for (int i = 0; i < 2; ++i) { int R, C; stage_rc(tid * 16 + i * 8192, R, C); const int Rb = Epi::PERM ? ((R & ~31) + perm32(R & 31)) : R;
        voffA[i] = (unsigned)(R * K + C) * 2u; voffB[i] = (unsigned)(Rb * K + C) * 2u; }
    const size_t kstep = (size_t)(BK * 2);
    const size_t hstep = (size_t)HALF * K * 2;
    const size_t tstep = 2 * hstep;
    const unsigned ldsw = (unsigned)wid * 1024u;
    const int aoff = lds_byte(wr * 64 + fr, fq * 8), boff = lds_byte(wc * 32 + fr, fq * 8);
#define PG8_SA(b, h) (((b) * 2 + (h)) * HTB)
#define PG8_SB(b, h) ((4 + (b) * 2 + (h)) * HTB)
#define PG8_STAGE(bufoff, gbase, voff) do { _Pragma("unroll") for (int _i = 0; _i < 2; ++_i) \
        __builtin_amdgcn_global_load_lds((const unsigned*)((const char*)(gbase) + (voff)[_i]), (PG8_LAS unsigned*)(lds + (bufoff) + ldsw + _i * 8192), 16, 0, 0); } while (0)
#define PG8_LDA(dst, b, h) do { _Pragma("unroll") for (int m = 0; m < 4; ++m) _Pragma("unroll") for (int k = 0; k < 2; ++k) dst[m][k] = *(const PG8_LAS bf16x8*)(lds + PG8_SA(b, h) + aoff + m * 2048 + k * 1024); } while (0)
#define PG8_LDB(dst, b, h) do { _Pragma("unroll") for (int n = 0; n < 2; ++n) _Pragma("unroll") for (int k = 0; k < 2; ++k) dst[n][k] = *(const PG8_LAS bf16x8*)(lds + PG8_SB(b, h) + boff + n * 2048 + k * 1024); } while (0)
#define PG8_MMA(ai, bj, At, Bt) do { __builtin_amdgcn_s_setprio(1); _Pragma("unroll") for (int m = 0; m < 4; ++m) _Pragma("unroll") for (int n = 0; n < 2; ++n) _Pragma("unroll") for (int k = 0; k < 2; ++k) \
        acc[ai][bj][m][n] = __builtin_amdgcn_mfma_f32_16x16x32_bf16(Bt[n][k], At[m][k], acc[ai][bj][m][n], 0, 0, 0); __builtin_amdgcn_s_setprio(0); } while (0)
#define PG8_WAIT_V(n) asm volatile("s_waitcnt vmcnt(" #n ")" ::: "memory")
#define PG8_WAIT_L(n) asm volatile("s_waitcnt lgkmcnt(" #n ")" ::: "memory")
#define PG8_BAR __builtin_amdgcn_s_barrier()
#define PG8_SCHED __builtin_amdgcn_sched_barrier(0)
    Unit cur, nxt; int ui = 0;
    if (!S.next(0, cur)) return;
    f32x4 acc[2][2][4][2];
#pragma unroll
    for (int a = 0; a < 2; ++a)
#pragma unroll
        for (int b = 0; b < 2; ++b)
#pragma unroll
            for (int m = 0; m < 4; ++m)
#pragma unroll
                for (int n = 0; n < 2; ++n) acc[a][b][m][n] = (f32x4){0.f, 0.f, 0.f, 0.f};
    bf16x8 At[4][2], B0[2][2], B1[2][2];
    const char* cA = (const char*)g.A + (size_t)cur.pm * tstep; const char* cB = (const char*)g.Bt + (size_t)cur.pn * tstep;
    S.a_ready(cur);
    if constexpr (SP2) {
        PG8_STAGE(PG8_SB(0, 0), cB, voffB); PG8_STAGE(PG8_SB(0, 1), cB + hstep, voffB); PG8_STAGE(PG8_SA(0, 0), cA, voffA); PG8_STAGE(PG8_SA(0, 1), cA + hstep, voffA);
        if (wr == 1) PG8_BAR;
        PG8_WAIT_V(2); PG8_BAR;
        PG8_STAGE(PG8_SB(1, 0), cB + kstep, voffB); PG8_STAGE(PG8_SA(1, 0), cA + kstep, voffA); PG8_STAGE(PG8_SB(1, 1), cB + hstep + kstep, voffB);
        PG8_WAIT_V(6); PG8_BAR;
    } else {
        PG8_STAGE(PG8_SB(0, 0), cB, voffB); PG8_STAGE(PG8_SA(0, 0), cA, voffA); PG8_STAGE(PG8_SB(0, 1), cB + hstep, voffB); PG8_STAGE(PG8_SA(0, 1), cA + hstep, voffA);
        if (wr == 1) PG8_BAR;
        PG8_WAIT_V(4); PG8_BAR;
        PG8_STAGE(PG8_SB(1, 0), cB + kstep, voffB); PG8_STAGE(PG8_SA(1, 0), cA + kstep, voffA); PG8_STAGE(PG8_SB(1, 1), cB + hstep + kstep, voffB);
        PG8_WAIT_V(6); PG8_BAR;
    }
    for (;;) {
        const bool has_next = S.next(ui + 1, nxt);
        const char* nA = has_next ? (const char*)g.A + (size_t)nxt.pm * tstep : cA; const char* nB = has_next ? (const char*)g.Bt + (size_t)nxt.pn * tstep : cB;
        for (int t = 0; t < nt; t += 2) {
            const bool last = (t == nt - 2);
            const char* a1 = cA + (size_t)(t + 1) * kstep;
            const char* a2 = last ? nA : cA + (size_t)(t + 2) * kstep; const char* b2 = last ? nB : cB + (size_t)(t + 2) * kstep;
            const char* a3 = a2 + kstep; const char* b3 = b2 + kstep;
            if (last && has_next) S.a_ready(nxt);
            if constexpr (SP2) {
            PG8_LDB(B0, 0, 0); PG8_LDB(B1, 0, 1); PG8_SCHED; PG8_LDA(At, 0, 0); PG8_STAGE(PG8_SA(1, 1), a1 + hstep, voffA);
            PG8_WAIT_V(8); PG8_WAIT_L(0); PG8_BAR; PG8_MMA(0, 0, At, B0); PG8_MMA(0, 1, At, B1); PG8_BAR; PG8_SCHED;
            PG8_LDA(At, 0, 1); PG8_STAGE(PG8_SB(0, 0), b2, voffB); PG8_STAGE(PG8_SB(0, 1), b2 + hstep, voffB); PG8_STAGE(PG8_SA(0, 0), a2, voffA);
            PG8_WAIT_V(8); PG8_WAIT_L(0); PG8_BAR; PG8_MMA(1, 0, At, B0); PG8_MMA(1, 1, At, B1); PG8_BAR; PG8_SCHED;
            PG8_LDB(B0, 1, 0); PG8_LDB(B1, 1, 1); PG8_SCHED; PG8_LDA(At, 1, 0); PG8_STAGE(PG8_SA(0, 1), a2 + hstep, voffA);
            PG8_WAIT_V(8); PG8_WAIT_L(0); PG8_BAR; PG8_MMA(0, 0, At, B0); PG8_MMA(0, 1, At, B1); PG8_BAR; PG8_SCHED;
            PG8_LDA(At, 1, 1); PG8_STAGE(PG8_SB(1, 0), b3, voffB); PG8_STAGE(PG8_SB(1, 1), b3 + hstep, voffB); PG8_STAGE(PG8_SA(1, 0), a3, voffA);
            PG8_WAIT_V(8); PG8_WAIT_L(0); PG8_BAR; PG8_MMA(1, 0, At, B0); PG8_MMA(1, 1, At, B1); PG8_BAR; PG8_SCHED;
            } else {
            PG8_LDB(B0, 0, 0); PG8_SCHED; PG8_LDA(At, 0, 0); PG8_STAGE(PG8_SA(1, 1), a1 + hstep, voffA);
            PG8_WAIT_L(8); PG8_BAR; PG8_WAIT_L(0); PG8_MMA(0, 0, At, B0); PG8_BAR; PG8_SCHED;
            PG8_LDB(B1, 0, 1); PG8_STAGE(PG8_SB(0, 0), b2, voffB);
            PG8_BAR; PG8_WAIT_L(0); PG8_MMA(0, 1, At, B1); PG8_BAR;
            PG8_LDA(At, 0, 1); PG8_STAGE(PG8_SA(0, 0), a2, voffA);
            PG8_BAR; PG8_WAIT_L(0); PG8_MMA(1, 0, At, B0); PG8_BAR; PG8_SCHED;
            PG8_STAGE(PG8_SB(0, 1), b2 + hstep, voffB);
            PG8_WAIT_V(6); PG8_BAR; PG8_MMA(1, 1, At, B1); PG8_BAR;
            PG8_LDB(B0, 1, 0); PG8_SCHED; PG8_LDA(At, 1, 0); PG8_STAGE(PG8_SA(0, 1), a2 + hstep, voffA);
            PG8_WAIT_L(8); PG8_BAR; PG8_WAIT_L(0); PG8_MMA(0, 0, At, B0); PG8_BAR; PG8_SCHED;
            PG8_LDB(B1, 1, 1); PG8_STAGE(PG8_SB(1, 0), b3, voffB);
            PG8_BAR; PG8_WAIT_L(0); PG8_MMA(0, 1, At, B1); PG8_BAR;
            PG8_LDA(At, 1, 1); PG8_STAGE(PG8_SA(1, 0), a3, voffA);
            PG8_BAR; PG8_WAIT_L(0); PG8_MMA(1, 0, At, B0); PG8_BAR; PG8_SCHED;
            PG8_STAGE(PG8_SB(1, 1), b3 + hstep, voffB);
            PG8_WAIT_V(6); PG8_BAR; PG8_MMA(1, 1, At, B1); PG8_BAR;
            }
        }
        if constexpr (ALIGN_EPI) { if (wr == 0) PG8_BAR; }
        if constexpr (!Epi::AFTER_DRAIN) { E(acc, cur, wr, wc, fr, fq); S.done(cur); }
        if (!has_next) break;
#pragma unroll
        for (int a = 0; a < 2; ++a)
#pragma unroll
            for (int b = 0; b < 2; ++b)
#pragma unroll
                for (int m = 0; m < 4; ++m)
#pragma unroll
                    for (int n = 0; n < 2; ++n) acc[a][b][m][n] = (f32x4){0.f, 0.f, 0.f, 0.f};
        cur = nxt; cA = nA; cB = nB; ++ui;
        if constexpr (ALIGN_EPI) { if (wr == 1) PG8_BAR; }
    }
    PG8_WAIT_V(0);
    if constexpr (!ALIGN_EPI) { if (wr == 0) PG8_BAR; }
    PG8_BAR;
    if constexpr (Epi::AFTER_DRAIN) { E.fused(acc, cur, wr, wc, fr, fq, lds, wid, lane); S.done(cur); }
#undef PG8_SA
#undef PG8_SB
#undef PG8_STAGE
#undef PG8_LDA
#undef PG8_LDB
#undef PG8_MMA
#undef PG8_WAIT_V
#undef PG8_WAIT_L
#undef PG8_BAR
#undef PG8_SCHED
}
}
namespace pg8 {
__device__ __forceinline__ u32x4 pack8(f32x4 v0, f32x4 v1) { u32x4 w; w.x = cvt_pk_bf16(v0[0], v0[1]); w.y = cvt_pk_bf16(v0[2], v0[3]); w.z = cvt_pk_bf16(v1[0], v1[1]); w.w = cvt_pk_bf16(v1[2], v1[3]); return w; }
__device__ __forceinline__ float dot4(f32x4 a) { return (a[0] * a[0] + a[1] * a[1]) + (a[2] * a[2] + a[3] * a[3]); }
__device__ __forceinline__ float rs16(const float* p) { const f32x4 a = *(const f32x4*)p, b = *(const f32x4*)(p + 4), c = *(const f32x4*)(p + 8), d = *(const f32x4*)(p + 12);
    const float s = ((a[0] + a[1]) + (a[2] + a[3])) + ((b[0] + b[1]) + (b[2] + b[3])) + ((c[0] + c[1]) + (c[2] + c[3])) + ((d[0] + d[1]) + (d[2] + d[3])); return rsqrtf(s * (1.0f / DM) + RMS_EPS); }

__device__ __forceinline__ float frcp(float x) { return __builtin_amdgcn_rcpf(x); }
__device__ __forceinline__ float fsigmoid(float x) { return frcp(1.0f + __builtin_amdgcn_exp2f(-1.4426950408889634f * x)); }
__device__ __forceinline__ float gelu_fast(float x) { const float z2 = 2.302208198f * (x + 0.044715f * x * x * x); return x * frcp(1.0f + __builtin_amdgcn_exp2f(-z2)); }
__device__ __forceinline__ void rs8(const float* rsq, int row0, int fq, float (&rs)[2][4]) {
    f32x4 pv[2][4];
#pragma unroll
    for (int ai = 0; ai < 2; ++ai)
#pragma unroll
        for (int m = 0; m < 4; ++m) pv[ai][m] = *(const f32x4*)(rsq + (size_t)(row0 + ai * HALF + m * 16) * 16 + 4 * fq);
#pragma unroll
    for (int ai = 0; ai < 2; ++ai)
#pragma unroll
        for (int m = 0; m < 4; ++m) { float s = (pv[ai][m][0] + pv[ai][m][1]) + (pv[ai][m][2] + pv[ai][m][3]); s += __shfl_xor(s, 16); s += __shfl_xor(s, 32); rs[ai][m] = rsqrtf(s * (1.0f / DM) + RMS_EPS); }
}
#define DPP_ROT(src, ctrl) __uint_as_float((unsigned)__builtin_amdgcn_mov_dpp((int)__float_as_uint(src), (ctrl), 0xF, 0xF, true))
#define DPP_MOV(old, src, ctrl) __uint_as_float((unsigned)__builtin_amdgcn_update_dpp((int)__float_as_uint(old), (int)__float_as_uint(src), (ctrl), 0xF, 0xF, false))

struct EpiProj {
    static constexpr bool PERM = true, AFTER_DRAIN = false;
    bf16_t* O; float* kmsum; unsigned* kmx;
    __device__ __forceinline__ void operator()(const f32x4 (&acc)[2][2][4][2], const Unit& u, int wr, int wc, int fr, int fq) const {
        const int colt = u.pn * BM;
        const float sc = colt < C_MK ? QSCALE : ((colt >= C_RK && colt < C_RV) ? RKSCALE : 1.0f);
        const int row0 = u.pm * BM + wr * 64 + fr, sec = colt >> 9, b = u.pm >> 6;
        bf16_t* sbase = O + (size_t)sec * SEC;
#pragma unroll
        for (int bj = 0; bj < 2; ++bj) { const int c = (colt & 511) + bj * HALF + wc * 32 + 8 * fq;
            bf16_t* hb = sec < 3 ? sbase + ((size_t)(b * 8 + (c >> 6)) * SEQ) * 64 + (c & 63) : sbase + ((size_t)(b * 4 + (c >> 7)) * SEQ) * 128 + (c & 127);
            const int pitch = sec < 3 ? 64 : 128;
#pragma unroll
            for (int ai = 0; ai < 2; ++ai)
#pragma unroll
                for (int m = 0; m < 4; ++m) { const int t = (row0 + ai * HALF + m * 16) & (SEQ - 1);
                    *(u32x4*)(hb + (size_t)t * pitch) = pack8(acc[ai][bj][m][0] * sc, acc[ai][bj][m][1] * sc); } }
        if (colt >= C_MK && colt < C_MV) {
            const int bh0 = (u.pm >> 6) * 8, blk = u.pm & 63;
#pragma unroll
            for (int bj = 0; bj < 2; ++bj)
#pragma unroll
                for (int n = 0; n < 2; ++n)
#pragma unroll
                    for (int j = 0; j < 4; ++j) { float s = 0.f;
#pragma unroll
                        for (int ai = 0; ai < 2; ++ai)
#pragma unroll
                            for (int m = 0; m < 4; ++m) s += acc[ai][bj][m][n][j];
                        s += __shfl_xor(s, 1); s += __shfl_xor(s, 2); s += __shfl_xor(s, 4); s += __shfl_xor(s, 8);
                        if (fr == 0) { const int c = colt - C_MK + bj * HALF + wc * 32 + 8 * fq + 4 * n + j; atomicAdd(kmsum + ((size_t)(bh0 + (c >> 6)) * 64 + blk) * 64 + (c & 63), s); } }
#pragma unroll
            for (int bj = 0; bj < 2; ++bj) { float mxk = 0.f;
#pragma unroll
                for (int ai = 0; ai < 2; ++ai)
#pragma unroll
                    for (int m = 0; m < 4; ++m) { float q2 = dot4(acc[ai][bj][m][0]) + dot4(acc[ai][bj][m][1]); q2 += __shfl_xor(q2, 16); q2 += __shfl_xor(q2, 32); mxk = fmaxf(mxk, q2); }
                mxk = fmaxf(mxk, __shfl_xor(mxk, 1)); mxk = fmaxf(mxk, __shfl_xor(mxk, 2)); mxk = fmaxf(mxk, __shfl_xor(mxk, 4)); mxk = fmaxf(mxk, __shfl_xor(mxk, 8));
                if (fr == 0 && fq == 0) { const int hd = (colt - C_MK + bj * HALF + wc * 32) >> 6; atomicMax(kmx + ((size_t)(bh0 + hd) * 64 + blk) * 2 + (wc & 1), __float_as_uint(mxk)); } }
        }
    }
};
struct EpiStore {
    static constexpr bool PERM = true, AFTER_DRAIN = false;
    bf16_t* O;
    __device__ __forceinline__ void operator()(const f32x4 (&acc)[2][2][4][2], const Unit& u, int wr, int wc, int fr, int fq) const {
        const int row0 = u.pm * BM + wr * 64 + fr, col0 = u.pn * BM + wc * 32 + 8 * fq;
#pragma unroll
        for (int ai = 0; ai < 2; ++ai)
#pragma unroll
            for (int m = 0; m < 4; ++m) { bf16_t* rowp = O + (size_t)(row0 + ai * HALF + m * 16) * DM + col0;
#pragma unroll
                for (int bj = 0; bj < 2; ++bj) *(u32x4*)(rowp + bj * HALF) = pack8(acc[ai][bj][m][0], acc[ai][bj][m][1]); }
    }
};
template <bool BF, bool WR = true> struct EpiRes {
    static constexpr bool PERM = true, AFTER_DRAIN = false;
    const float* base; bf16_t* xb; float* rsq;
    __device__ __forceinline__ void operator()(const f32x4 (&acc)[2][2][4][2], const Unit& u, int wr, int wc, int fr, int fq) const {
        const int row0 = u.pm * BM + wr * 64 + fr, col0 = u.pn * BM + wc * 32 + 8 * fq;
        if constexpr (BF) {
            u32x4 pv[8][2];
#define ERB_LOAD(g) do { _Pragma("unroll") for (int bj = 0; bj < 2; ++bj) pv[g][bj] = *(const u32x4*)(xb + (size_t)(row0 + ((g) >> 2) * HALF + ((g) & 3) * 16) * DM + col0 + bj * HALF); } while (0)
            ERB_LOAD(0); ERB_LOAD(1); ERB_LOAD(2); ERB_LOAD(3);
#pragma unroll
            for (int g = 0; g < 8; ++g) { const int ai = g >> 2, m = g & 3, row = row0 + ai * HALF + m * 16; float ss = 0.f;
                if (g + 4 < 8) { ERB_LOAD(g + 4); }
                asm volatile("" ::: "memory");
#pragma unroll
                for (int bj = 0; bj < 2; ++bj) { const size_t off = (size_t)row * DM + col0 + bj * HALF; const u32x4 p = pv[g][bj];
                    const f32x4 b0 = {__uint_as_float(p.x << 16), __uint_as_float(p.x & 0xffff0000u), __uint_as_float(p.y << 16), __uint_as_float(p.y & 0xffff0000u)};
                    const f32x4 b1 = {__uint_as_float(p.z << 16), __uint_as_float(p.z & 0xffff0000u), __uint_as_float(p.w << 16), __uint_as_float(p.w & 0xffff0000u)};
                    const f32x4 y0 = b0 + acc[ai][bj][m][0], y1 = b1 + acc[ai][bj][m][1];
                    if (WR) *(u32x4*)(xb + off) = pack8(y0, y1); ss += dot4(y0) + dot4(y1); }
                ss += __shfl_xor(ss, 16); ss += __shfl_xor(ss, 32);
                if (fq == 0) rsq[(size_t)row * 16 + u.pn * 4 + wc] = ss; }
#undef ERB_LOAD
        } else {
            f32x4 bv[8][2][2];
#define ER_LOAD(g) do { _Pragma("unroll") for (int bj = 0; bj < 2; ++bj) { const float* p_ = base + (size_t)(row0 + ((g) >> 2) * HALF + ((g) & 3) * 16) * DM + col0 + bj * HALF; bv[g][bj][0] = *(const f32x4*)p_; bv[g][bj][1] = *(const f32x4*)(p_ + 4); } } while (0)
            ER_LOAD(0); ER_LOAD(1);
#pragma unroll
            for (int g = 0; g < 8; ++g) { const int ai = g >> 2, m = g & 3, row = row0 + ai * HALF + m * 16; float ss = 0.f;
                if (g + 2 < 8) { ER_LOAD(g + 2); }
                asm volatile("" ::: "memory");
#pragma unroll
                for (int bj = 0; bj < 2; ++bj) { const size_t off = (size_t)row * DM + col0 + bj * HALF;
                    const f32x4 y0 = bv[g][bj][0] + acc[ai][bj][m][0], y1 = bv[g][bj][1] + acc[ai][bj][m][1];
                    if (WR) *(u32x4*)(xb + off) = pack8(y0, y1); ss += dot4(y0) + dot4(y1); }
                ss += __shfl_xor(ss, 16); ss += __shfl_xor(ss, 32);
                if (fq == 0) rsq[(size_t)row * 16 + u.pn * 4 + wc] = ss; }
#undef ER_LOAD
        }
    }
};
struct EpiResXN {
    static constexpr bool PERM = true, AFTER_DRAIN = false;
    const bf16_t* xn; const float* rs0; const float* gcol; bf16_t* xb; float* rsq;
    __device__ __forceinline__ void operator()(const f32x4 (&acc)[2][2][4][2], const Unit& u, int wr, int wc, int fr, int fq) const {
        const int row0 = u.pm * BM + wr * 64 + fr, col0 = u.pn * BM + wc * 32 + 8 * fq;
        f32x4 ig[2][2];
#pragma unroll
        for (int bj = 0; bj < 2; ++bj)
#pragma unroll
            for (int n = 0; n < 2; ++n) { const f32x4 g = *(const f32x4*)(gcol + col0 + bj * HALF + 4 * n); ig[bj][n] = (f32x4){frcp(g[0]), frcp(g[1]), frcp(g[2]), frcp(g[3])}; }
        float ir[8];
#pragma unroll
        for (int g = 0; g < 8; ++g) ir[g] = frcp(rs0[row0 + (g >> 2) * HALF + (g & 3) * 16]);
        u32x4 pv[8][2];
#define ERX_LOAD(g) do { _Pragma("unroll") for (int bj = 0; bj < 2; ++bj) pv[g][bj] = *(const u32x4*)(xn + (size_t)(row0 + ((g) >> 2) * HALF + ((g) & 3) * 16) * DM + col0 + bj * HALF); } while (0)
        ERX_LOAD(0); ERX_LOAD(1); ERX_LOAD(2); ERX_LOAD(3);
#pragma unroll
        for (int g = 0; g < 8; ++g) { const int ai = g >> 2, m = g & 3, row = row0 + ai * HALF + m * 16; float ss = 0.f;
            if (g + 4 < 8) { ERX_LOAD(g + 4); }
            asm volatile("" ::: "memory");
#pragma unroll
            for (int bj = 0; bj < 2; ++bj) { const size_t off = (size_t)row * DM + col0 + bj * HALF; const u32x4 p = pv[g][bj];
                const f32x4 b0 = {__uint_as_float(p.x << 16), __uint_as_float(p.x & 0xffff0000u), __uint_as_float(p.y << 16), __uint_as_float(p.y & 0xffff0000u)};
                const f32x4 b1 = {__uint_as_float(p.z << 16), __uint_as_float(p.z & 0xffff0000u), __uint_as_float(p.w << 16), __uint_as_float(p.w & 0xffff0000u)};
                const f32x4 y0 = b0 * ig[bj][0] * ir[g] + acc[ai][bj][m][0], y1 = b1 * ig[bj][1] * ir[g] + acc[ai][bj][m][1];
                *(u32x4*)(xb + off) = pack8(y0, y1); ss += dot4(y0) + dot4(y1); }
            ss += __shfl_xor(ss, 16); ss += __shfl_xor(ss, 32);
            if (fq == 0) rsq[(size_t)row * 16 + u.pn * 4 + wc] = ss; }
#undef ERX_LOAD
    }
};
struct EpiPleNorm {
    static constexpr bool PERM = true, AFTER_DRAIN = false;
    float* out; const bf16_t* xb; const bf16_t* pw; const float* rsq_in; float* rsq_out; unsigned* pcnt; const float* fnorm; unsigned long long* dts;
#define EPN_STAMP(i) do { if (dts && wr == 0 && wc == 0 && fr == 0 && fq == 0) __hip_atomic_store(dts + (i) + 4 * (u.pm >= 64 ? 1 : 0), (unsigned long long)__builtin_amdgcn_s_memrealtime(), __ATOMIC_RELAXED, __HIP_MEMORY_SCOPE_AGENT); } while (0)
    __device__ __forceinline__ void operator()(const f32x4 (&acc_)[2][2][4][2], const Unit& u, int wr, int wc, int fr, int fq) const {
        f32x4 (&acc)[2][2][4][2] = const_cast<f32x4 (&)[2][2][4][2]>(acc_);
        const int row0 = u.pm * BM + wr * 64 + fr, col0 = u.pn * BM + wc * 32 + 8 * fq;
        EPN_STAMP(30);
        float rsv[2][4]; rs8(rsq_in, row0, fq, rsv);
        u32x4 xq[8][2], pq[8][2];
#define EP_LOAD(g) do { _Pragma("unroll") for (int bj = 0; bj < 2; ++bj) { const size_t o_ = (size_t)(row0 + ((g) >> 2) * HALF + ((g) & 3) * 16) * DM + col0 + bj * HALF; xq[g][bj] = *(const u32x4*)(xb + o_); pq[g][bj] = *(const u32x4*)(pw + o_); } } while (0)
        EP_LOAD(0); EP_LOAD(1);
#pragma unroll
        for (int g = 0; g < 8; ++g) { const int ai = g >> 2, m = g & 3, row = row0 + ai * HALF + m * 16; const float rs = rsv[ai][m]; float ss = 0.f;
            if (g + 2 < 8) { EP_LOAD(g + 2); }
            asm volatile("" ::: "memory");
#pragma unroll
            for (int bj = 0; bj < 2; ++bj) {
                const u32x4 pv = pq[g][bj];
                const f32x4 p0 = {__uint_as_float(pv.x << 16), __uint_as_float(pv.x & 0xffff0000u), __uint_as_float(pv.y << 16), __uint_as_float(pv.y & 0xffff0000u)};
                const f32x4 p1 = {__uint_as_float(pv.z << 16), __uint_as_float(pv.z & 0xffff0000u), __uint_as_float(pv.w << 16), __uint_as_float(pv.w & 0xffff0000u)};
                f32x4 g0 = acc[ai][bj][m][0] * rs, g1 = acc[ai][bj][m][1] * rs;
#pragma unroll
                for (int j = 0; j < 4; ++j) { g0[j] = fsigmoid(g0[j]); g1[j] = fsigmoid(g1[j]); }
                const u32x4 xv = xq[g][bj];
                const f32x4 x0 = {__uint_as_float(xv.x << 16), __uint_as_float(xv.x & 0xffff0000u), __uint_as_float(xv.y << 16), __uint_as_float(xv.y & 0xffff0000u)};
                const f32x4 x1 = {__uint_as_float(xv.z << 16), __uint_as_float(xv.z & 0xffff0000u), __uint_as_float(xv.w << 16), __uint_as_float(xv.w & 0xffff0000u)};
                const f32x4 y0 = x0 + p0 * g0, y1 = x1 + p1 * g1;
                acc[ai][bj][m][0] = y0; acc[ai][bj][m][1] = y1; ss += dot4(y0) + dot4(y1); }
            ss += __shfl_xor(ss, 16); ss += __shfl_xor(ss, 32);
            if (fq == 0) __hip_atomic_store((unsigned*)(rsq_out + (size_t)row * 16 + u.pn * 4 + wc), __float_as_uint(ss), __ATOMIC_RELAXED, __HIP_MEMORY_SCOPE_AGENT); }
#undef EP_LOAD
        asm volatile("s_waitcnt vmcnt(0)" ::: "memory");
        EPN_STAMP(31);
        unsigned* pc = pcnt + 16 * u.pm;
        if (fq == 0 && fr == 0) __hip_atomic_fetch_add(pc, 1u, __ATOMIC_RELAXED, __HIP_MEMORY_SCOPE_AGENT);
        for (unsigned spins = 0; spins < (1u << 22); ++spins) {
            if ((unsigned)__builtin_amdgcn_readfirstlane(__hip_atomic_load(pc, __ATOMIC_RELAXED, __HIP_MEMORY_SCOPE_AGENT)) >= 32u) break;
            __builtin_amdgcn_s_sleep(2);
        }
        EPN_STAMP(32);
        f32x4 fn[2][2];
#pragma unroll
        for (int bj = 0; bj < 2; ++bj) { fn[bj][0] = *(const f32x4*)(fnorm + col0 + bj * HALF); fn[bj][1] = *(const f32x4*)(fnorm + col0 + bj * HALF + 4); }
        unsigned long long pa[8], pb[8];
#pragma unroll
        for (int g = 0; g < 8; ++g) { const unsigned long long* pp = (const unsigned long long*)(rsq_out + (size_t)(row0 + (g >> 2) * HALF + (g & 3) * 16) * 16 + 4 * fq);
            pa[g] = __hip_atomic_load(pp, __ATOMIC_RELAXED, __HIP_MEMORY_SCOPE_AGENT); pb[g] = __hip_atomic_load(pp + 1, __ATOMIC_RELAXED, __HIP_MEMORY_SCOPE_AGENT); }
#pragma unroll
        for (int g = 0; g < 8; ++g) { const int ai = g >> 2, m = g & 3, row = row0 + ai * HALF + m * 16;
            float s = (__uint_as_float((unsigned)pa[g]) + __uint_as_float((unsigned)(pa[g] >> 32))) + (__uint_as_float((unsigned)pb[g]) + __uint_as_float((unsigned)(pb[g] >> 32)));
            s += __shfl_xor(s, 16); s += __shfl_xor(s, 32);
            const float rs3 = rsqrtf(s * (1.0f / DM) + RMS_EPS);
#pragma unroll
            for (int bj = 0; bj < 2; ++bj) { const size_t off = (size_t)row * DM + col0 + bj * HALF;
                *(f32x4*)(out + off) = acc[ai][bj][m][0] * rs3 * fn[bj][0]; *(f32x4*)(out + off + 4) = acc[ai][bj][m][1] * rs3 * fn[bj][1]; } }
        EPN_STAMP(33);
    }
};
#undef EPN_STAMP
struct EpiUG {
    static constexpr bool PERM = true, AFTER_DRAIN = false;
    bf16_t* act; const float* rsq; const float* cw; const float* cb; float* UL; float* UF; float* GF;
    __device__ __forceinline__ void operator()(const f32x4 (&acc)[2][2][4][2], const Unit& u, int wr, int wc, int fr, int fq) const {
        const int cu = u.pn * HALF + wc * 32 + 8 * fq;
        const int row0 = u.pm * BM + wr * 64 + fr;
        float rsv[2][4]; rs8(rsq, row0, fq, rsv);
        float w0[8], w1[8], w2[8], bb[8];
#pragma unroll
        for (int q = 0; q < 2; ++q) { const f32x4 a = *(const f32x4*)(cw + cu + 4 * q), b = *(const f32x4*)(cw + FF + cu + 4 * q), c = *(const f32x4*)(cw + 2 * FF + cu + 4 * q), d = *(const f32x4*)(cb + cu + 4 * q);
#pragma unroll
            for (int j = 0; j < 4; ++j) { w0[4 * q + j] = a[j]; w1[4 * q + j] = b[j]; w2[4 * q + j] = c[j]; bb[4 * q + j] = d[j]; } }
#pragma unroll
        for (int ai = 0; ai < 2; ++ai) {
            float up[8];
#pragma unroll
            for (int m = 0; m < 4; ++m) {
                const int row = row0 + ai * HALF + m * 16;
                const float rs = rsv[ai][m];
                float uu[8], gg[8], a8[8];
#pragma unroll
                for (int n = 0; n < 2; ++n)
#pragma unroll
                    for (int j = 0; j < 4; ++j) { uu[4 * n + j] = acc[ai][0][m][n][j] * rs; gg[4 * n + j] = acc[ai][1][m][n][j] * rs; }
#pragma unroll
                for (int k = 0; k < 8; ++k) {
                    float t1 = 0.f, t2 = 0.f;
                    if (m > 0) { t1 = DPP_ROT(up[k], 0x121); t2 = DPP_ROT(up[k], 0x122); }
                    const float u1 = DPP_MOV(t1, uu[k], 0x111), u2 = DPP_MOV(t2, uu[k], 0x112);
                    const float y = bb[k] + w0[k] * u2 + w1[k] * u1 + w2[k] * uu[k];
                    a8[k] = gelu_fast(y) * gg[k];
                }
                const bool defer = (m == 0) && (fr < 2);
                if (!defer) { u32x4 w; w.x = cvt_pk_bf16(a8[0], a8[1]); w.y = cvt_pk_bf16(a8[2], a8[3]); w.z = cvt_pk_bf16(a8[4], a8[5]); w.w = cvt_pk_bf16(a8[6], a8[7]);
                    *(u32x4*)(act + (size_t)row * FF + cu) = w; }
                else { const size_t so = ((size_t)(row >> 6) * 2 + fr) * FF + cu;
                    *(f32x4*)(UF + so) = (f32x4){uu[0], uu[1], uu[2], uu[3]}; *(f32x4*)(UF + so + 4) = (f32x4){uu[4], uu[5], uu[6], uu[7]};
                    *(f32x4*)(GF + so) = (f32x4){gg[0], gg[1], gg[2], gg[3]}; *(f32x4*)(GF + so + 4) = (f32x4){gg[4], gg[5], gg[6], gg[7]}; }
                if (m == 3 && fr >= 14) { const size_t so = ((size_t)(row >> 6) * 2 + (fr - 14)) * FF + cu;
                    *(f32x4*)(UL + so) = (f32x4){uu[0], uu[1], uu[2], uu[3]}; *(f32x4*)(UL + so + 4) = (f32x4){uu[4], uu[5], uu[6], uu[7]}; }
#pragma unroll
                for (int k = 0; k < 8; ++k) up[k] = uu[k];
            }
        }
    }
};
}
#define LAS __attribute__((address_space(3)))
namespace mx {
typedef short bf16x8 __attribute__((ext_vector_type(8)));
typedef short s16x4 __attribute__((ext_vector_type(4)));
typedef float f32x16 __attribute__((ext_vector_type(16)));
typedef unsigned u32x4 __attribute__((ext_vector_type(4)));
typedef float f32x4_t __attribute__((ext_vector_type(4)));
typedef LAS const char* lds_cptr;
typedef LAS char* lds_ptr;
__device__ __forceinline__ int crow(int r, int hi) { return (r & 3) + 8 * (r >> 2) + 4 * hi; }
__device__ __forceinline__ s16x4 vtr(lds_cptr p) { return __builtin_bit_cast(s16x4, __builtin_amdgcn_ds_read_tr16_b64_v4i16((LAS s16x4*)p)); }
__device__ __forceinline__ bf16x8 cat8(s16x4 lo, s16x4 hi) { return (bf16x8){lo[0], lo[1], lo[2], lo[3], hi[0], hi[1], hi[2], hi[3]}; }
typedef float f32x2_t __attribute__((ext_vector_type(2))); typedef __bf16 bf16x2_t __attribute__((ext_vector_type(2)));
__device__ __forceinline__ unsigned pk(float lo, float hi) { const f32x2_t v = {lo, hi}; return __builtin_bit_cast(unsigned, __builtin_convertvector(v, bf16x2_t)); }
typedef __bf16 bf16x2_d __attribute__((ext_vector_type(2)));
__device__ __forceinline__ float dot2bf(unsigned a, unsigned b, float c) { return __builtin_amdgcn_fdot2_f32_bf16(__builtin_bit_cast(bf16x2_d, a), __builtin_bit_cast(bf16x2_d, b), c, false); }
__device__ __forceinline__ float dot8bf(u32x4 a, u32x4 b, float c) { return dot2bf(a.w, b.w, dot2bf(a.z, b.z, dot2bf(a.y, b.y, dot2bf(a.x, b.x, c)))); }
__device__ __forceinline__ float other_half(float v) { return __shfl_xor(v, 32); }

constexpr int L_K = 0, L_V = 32768;
constexpr int L_WSF = 65536;
constexpr int L_OST = 65536 + 2048;
constexpr int L_ENT = L_OST + 32768;
constexpr int ENT_CAP = 4096;
constexpr int L_PREF = L_ENT + ENT_CAP * 4;
constexpr int L_MW = L_PREF + 512;
constexpr int L_END = L_MW + 4096;
static_assert(L_END <= 147456, "mixer LDS map");

__device__ __forceinline__ void moba_stage_kv(const bf16_t* __restrict__ proj, int b, int h, int blk, lds_ptr lds, int tid) {
#pragma unroll
    for (int i = 0; i < 4; ++i) { const int pc = tid + 512 * i, key = pc >> 3, ch = pc & 7;
        const bf16_t* src = proj + ((size_t)(b * 8 + h) * SEQ + blk * 256 + key) * 64 + ch * 8;
        const u32x4 kv = *(const u32x4*)(src + SEC), vv = *(const u32x4*)(src + 2 * SEC);
        *(LAS u32x4*)(lds + L_K + ch * 4096 + key * 16) = kv;
        *(LAS u32x4*)(lds + L_V + (key >> 6) * 8192 + (ch >> 2) * 4096 + ((key & 63) >> 3) * 512 + (key & 7) * 64 + (ch & 3) * 16) = vv; }
}

__device__ __forceinline__ void moba_batch(const bf16x8 (&qr)[4], int qpos, int kbase, float slope2, bool diag, int ntiles, lds_ptr lds, int wave, int lane, bf16_t* odst, float* ldst,
                                           const bf16_t* part_row = nullptr, const float* pl_row = nullptr, int nv = 0, bf16_t* mix_row = nullptr, bf16_t* mix_base = nullptr) {
    const int r32 = lane & 31, hi = lane >> 5;
    f32x16 o0, o1;
#pragma unroll
    for (int r = 0; r < 16; ++r) { o0[r] = 0.f; o1[r] = 0.f; }
    float m = -1e30f, l = 0.f;
    const lds_cptr kp = (lds_cptr)lds + L_K + hi * 4096 + r32 * 16;
    const lds_cptr vp = (lds_cptr)lds + L_V + ((lane >> 4) & 1) * 32 + (lane & 3) * 8 + (4 * hi + ((lane & 15) >> 2)) * 64;
    LAS float* wsf = (LAS float*)(lds + L_WSF) + wave * 64;
    const float s4h = slope2 * (float)(4 * hi);
#define MX_LOAD(KT) bf16x8 kf_[4], kg_[4], vf_[2][4]; do { _Pragma("unroll") for (int d0 = 0; d0 < 4; ++d0) { kf_[d0] = *(const LAS bf16x8*)(kp + (KT) * 1024 + d0 * 8192); kg_[d0] = *(const LAS bf16x8*)(kp + (KT) * 1024 + 512 + d0 * 8192); } \
        const lds_cptr vt_ = vp + (KT) * 8192; _Pragma("unroll") for (int db = 0; db < 2; ++db) _Pragma("unroll") for (int ks = 0; ks < 4; ++ks) vf_[db][ks] = cat8(vtr(vt_ + db * 4096 + ks * 1024), vtr(vt_ + db * 4096 + ks * 1024 + 512)); \
        __builtin_amdgcn_sched_barrier(0); } while (0)
#define MX_QK(P0, P1, C0, C1) do { _Pragma("unroll") for (int d0 = 0; d0 < 4; ++d0) { \
        P0 = __builtin_amdgcn_mfma_f32_32x32x16_bf16(kf_[d0], qr[d0], d0 == 0 ? C0 : P0, 0, 0, 0); P1 = __builtin_amdgcn_mfma_f32_32x32x16_bf16(kg_[d0], qr[d0], d0 == 0 ? C1 : P1, 0, 0, 0); } } while (0)
#define MX_PV(O, DB, KS, PW) O = __builtin_amdgcn_mfma_f32_32x32x16_bf16(__builtin_bit_cast(bf16x8, PW), vf_[DB][KS], O, 0, 0, 0)
#define MX_PVALL() do { \
        const u32x4 pw0 = {pk(p0[0], p0[1]), pk(p0[2], p0[3]), pk(p0[4], p0[5]), pk(p0[6], p0[7])}, pw1 = {pk(p0[8], p0[9]), pk(p0[10], p0[11]), pk(p0[12], p0[13]), pk(p0[14], p0[15])}; \
        const u32x4 pw2 = {pk(p1[0], p1[1]), pk(p1[2], p1[3]), pk(p1[4], p1[5]), pk(p1[6], p1[7])}, pw3 = {pk(p1[8], p1[9]), pk(p1[10], p1[11]), pk(p1[12], p1[13]), pk(p1[14], p1[15])}; \
        MX_PV(o0, 0, 0, pw0); MX_PV(o1, 1, 0, pw0); MX_PV(o0, 0, 1, pw1); MX_PV(o1, 1, 1, pw1); MX_PV(o0, 0, 2, pw2); MX_PV(o1, 1, 2, pw2); MX_PV(o0, 0, 3, pw3); MX_PV(o1, 1, 3, pw3); } while (0)
    {
        const int kt = ntiles - 1;
        f32x16 p0, p1;
        MX_LOAD(kt);
#pragma unroll
        for (int r = 0; r < 16; ++r) { p0[r] = fmaf(slope2, (float)((r & 3) + 8 * (r >> 2)), s4h); p1[r] = p0[r]; }
        MX_QK(p0, p1, p0, p1);
        const int dq = qpos - kbase - 64 * kt;
        const float t0 = -slope2 * (float)dq, t1 = t0 + 32.0f * slope2;
        if (diag) {
#pragma unroll
            for (int r = 0; r < 16; ++r) { const int c = crow(r, hi); if (c > dq) p0[r] = -1e30f; if (c + 32 > dq) p1[r] = -1e30f; }
        }
        float mx0 = p0[0], mx1 = p1[0];
#pragma unroll
        for (int r = 1; r < 16; ++r) { mx0 = fmaxf(mx0, p0[r]); mx1 = fmaxf(mx1, p1[r]); }
        float mx_ = fmaxf(mx0 + t0, mx1 + t1);
        m = fmaxf(mx_, other_half(mx_));
        const float e0 = m - t0, e1 = m - t1;
        float rs = 0.f;
#pragma unroll
        for (int r = 0; r < 16; ++r) { p0[r] = __builtin_amdgcn_exp2f(p0[r] - e0); p1[r] = __builtin_amdgcn_exp2f(p1[r] - e1); rs += p0[r] + p1[r]; }
        l = rs;
        MX_PVALL();
    }
    for (int kt = ntiles - 2; kt >= 0; --kt) {
        const int dq = qpos - kbase - 64 * kt;
        const float c0 = -slope2 * (float)dq - m + s4h, c1 = c0 + 32.0f * slope2;
        f32x16 p0, p1;
        MX_LOAD(kt);
#pragma unroll
        for (int r = 0; r < 16; ++r) { const float cr = (float)((r & 3) + 8 * (r >> 2)); p0[r] = fmaf(slope2, cr, c0); p1[r] = fmaf(slope2, cr, c1); }
        MX_QK(p0, p1, p0, p1);
        float mx_ = fmaxf(p0[0], p1[0]);
#pragma unroll
        for (int r = 1; r < 16; ++r) mx_ = fmaxf(mx_, fmaxf(p0[r], p1[r]));
        mx_ = fmaxf(mx_, other_half(mx_));
        if (__all(mx_ < -30.0f)) continue;
        if (__any(mx_ > 16.0f)) {
            const float dl = fmaxf(mx_, 0.f); m += dl;
#pragma unroll
            for (int r = 0; r < 16; ++r) { p0[r] -= dl; p1[r] -= dl; }
            const float f = __builtin_amdgcn_exp2f(-dl); l *= f;
            if (hi == 0) wsf[r32] = f;
#pragma unroll
            for (int r = 0; r < 16; ++r) { const float g = wsf[crow(r, hi)]; o0[r] *= g; o1[r] *= g; }
        }
        float rs = 0.f;
#pragma unroll
        for (int r = 0; r < 16; ++r) { p0[r] = __builtin_amdgcn_exp2f(p0[r]); p1[r] = __builtin_amdgcn_exp2f(p1[r]); rs += p0[r] + p1[r]; }
        l += rs;
        MX_PVALL();
    }
#undef MX_LOAD
#undef MX_QK
#undef MX_PV
#undef MX_PVALL
    l += other_half(l);
    if (hi == 0) wsf[32 + r32] = 1.0f / l;
    const float lse = m + __builtin_amdgcn_logf(l);
    LAS bf16_t* ost = (LAS bf16_t*)(lds + L_OST) + wave * 2048;
#pragma unroll
    for (int r = 0; r < 16; ++r) { const int orow = crow(r, hi); const float f = wsf[32 + orow];
        ost[orow * 64 + r32] = (bf16_t)pk(o0[r] * f, 0.f); ost[orow * 64 + 32 + r32] = (bf16_t)pk(o1[r] * f, 0.f); }
    if (mix_row == nullptr) {
        const unsigned long long dp = (unsigned long long)odst; const unsigned dlo = (unsigned)dp, dhi = (unsigned)(dp >> 32);
#pragma unroll
        for (int i = 0; i < 4; ++i) { const int row = i * 8 + (lane >> 3), ch = lane & 7;
            const u32x4 v = *(const LAS u32x4*)(ost + row * 64 + ch * 8);
            const unsigned long long d = ((unsigned long long)(unsigned)__shfl((int)dhi, row) << 32) | (unsigned)__shfl((int)dlo, row);
            if (d) *(u32x4*)((bf16_t*)d + ch * 8) = v; }
        if (hi == 0 && ldst) *ldst = lse;
    } else {
        if (hi == 0) { const f32x4_t lv = *(const f32x4_t*)pl_row;
            const float a0 = nv > 0 ? lv[0] : -1e30f, a1 = nv > 1 ? lv[1] : -1e30f, a2 = nv > 2 ? lv[2] : -1e30f;
            const float mm = fmaxf(fmaxf(a0, a1), fmaxf(a2, lse));
            const float w0 = __builtin_amdgcn_exp2f(a0 - mm), w1 = __builtin_amdgcn_exp2f(a1 - mm), w2 = __builtin_amdgcn_exp2f(a2 - mm), w3 = __builtin_amdgcn_exp2f(lse - mm);
            const float iw = 1.0f / ((w0 + w1) + (w2 + w3));
            ((LAS f32x4_t*)(lds + L_MW) + wave * 32)[r32] = (f32x4_t){w0 * iw, w1 * iw, w2 * iw, w3 * iw}; }
        const unsigned long long pp = (unsigned long long)part_row, mp = (unsigned long long)mix_row;
        const unsigned plo = (unsigned)pp, phi = (unsigned)(pp >> 32), mlo = (unsigned)mp, mhi = (unsigned)(mp >> 32);
#pragma unroll
        for (int i = 0; i < 4; ++i) { const int row = i * 8 + (lane >> 3), ch = lane & 7;
            const u32x4 v = *(const LAS u32x4*)(ost + row * 64 + ch * 8);
            const f32x4_t w = ((const LAS f32x4_t*)(lds + L_MW) + wave * 32)[row];
            const bf16_t* pr = (const bf16_t*)(((unsigned long long)(unsigned)__shfl((int)phi, row) << 32) | (unsigned)__shfl((int)plo, row));
            bf16_t* mr = (bf16_t*)(((unsigned long long)(unsigned)__shfl((int)mhi, row) << 32) | (unsigned)__shfl((int)mlo, row));
            const unsigned vw[4] = {v.x, v.y, v.z, v.w}; float acc[8];
#pragma unroll
            for (int q = 0; q < 4; ++q) { acc[2 * q] = w[3] * __uint_as_float(vw[q] << 16); acc[2 * q + 1] = w[3] * __uint_as_float(vw[q] & 0xffff0000u); }
#pragma unroll
            for (int s = 0; s < 3; ++s) if (w[s] != 0.f) { const u32x4 pv = *(const u32x4*)(pr + s * 64 + ch * 8); const unsigned pw_[4] = {pv.x, pv.y, pv.z, pv.w};
#pragma unroll
                for (int q = 0; q < 4; ++q) { acc[2 * q] += w[s] * __uint_as_float(pw_[q] << 16); acc[2 * q + 1] += w[s] * __uint_as_float(pw_[q] & 0xffff0000u); } }
            *(u32x4*)(mr + ch * 8) = (u32x4){pk(acc[0], acc[1]), pk(acc[2], acc[3]), pk(acc[4], acc[5]), pk(acc[6], acc[7])}; }
    }
}

__device__ __forceinline__ void moba_diag_unit(const bf16_t* __restrict__ proj, int bh, int i, const bf16_t* part_o, const float* part_l, const u32* __restrict__ sel, bf16_t* mix, lds_ptr lds, int tid) {
    const int b = bh >> 3, h = bh & 7, lane = tid & 63, wave = __builtin_amdgcn_readfirstlane(tid >> 6);
    const int ql = wave * 32 + (lane & 31), t = i * 256 + ql; const size_t row = (size_t)b * SEQ + t;
    bf16x8 qr[4];
    { const bf16_t* qp = proj + ((size_t)bh * SEQ + t) * 64 + (lane >> 5) * 8;
#pragma unroll
      for (int d0 = 0; d0 < 4; ++d0) qr[d0] = *(const bf16x8*)(qp + d0 * 16); }
    moba_stage_kv(proj, b, h, i, lds, tid);
    __syncthreads();
    const float slope2 = __builtin_amdgcn_exp2f(-(float)(h + 1)) * LOG2E;
    const int nv = (int)(sel[row * 8 + h] >> 24);
    moba_batch(qr, t, i * 256, slope2, true, (wave >> 1) + 1, lds, wave, lane, nullptr, nullptr,
               part_o + ((row * 8 + h) * 4) * 64, part_l + (row * 8 + h) * 4, nv, mix + row * DM + h * 64, mix);
    __syncthreads();
}
__device__ __forceinline__ void moba_sel_task(const bf16_t* __restrict__ proj, const unsigned short* __restrict__ seg, const int* __restrict__ cnt, int bh, int n,
                                              bf16_t* part_o, float* part_l, lds_ptr lds, int tid) {
    const int b = bh >> 3, h = bh & 7, lane = tid & 63, wave = __builtin_amdgcn_readfirstlane(tid >> 6);
    LAS int* pref = (LAS int*)(lds + L_PREF); LAS unsigned* ent = (LAS unsigned*)(lds + L_ENT);
    if (wave == 0) {
        const int c = (lane > n) ? cnt[((size_t)bh * 64 + n) * 64 + lane] : 0; int s = c;
#pragma unroll
        for (int o = 1; o < 64; o <<= 1) { const int v = __shfl_up(s, o); if (lane >= o) s += v; }
        pref[lane + 1] = s; if (lane == 0) pref[0] = 0;
    }
    __syncthreads();
    const int T = pref[64];
    if (T == 0) { __syncthreads(); return; }
    moba_stage_kv(proj, b, h, n, lds, tid);
    const float slope2 = __builtin_amdgcn_exp2f(-(float)(h + 1)) * LOG2E;
    for (int c0 = 0; c0 < T; c0 += ENT_CAP) {
        for (int i = n + 1 + wave; i < 64; i += 8) { const int s0 = pref[i], s1 = pref[i + 1];
            const unsigned short* sp = seg + (((size_t)bh * 64 + n) * 64 + i) * 256;
            for (int e = lane; e < s1 - s0; e += 64) { const int g = s0 + e - c0; if (g >= 0 && g < ENT_CAP) ent[g] = ((unsigned)i << 10) | (unsigned)sp[e]; } }
        __syncthreads();
        const int cn = (T - c0) < ENT_CAP ? (T - c0) : ENT_CAP;
        for (int wb = wave; wb * 32 < cn; wb += 8) {
            const int idx = wb * 32 + (lane & 31); const bool valid = idx < cn;
            const unsigned ec = ent[valid ? idx : wb * 32];
            const int t = (ec >> 10) * 256 + ((ec >> 2) & 255), slot = ec & 3; const size_t row = (size_t)b * SEQ + t;
            bf16x8 qr[4];
            { const bf16_t* qp = proj + ((size_t)bh * SEQ + t) * 64 + (lane >> 5) * 8;
#pragma unroll
              for (int d0 = 0; d0 < 4; ++d0) qr[d0] = *(const bf16x8*)(qp + d0 * 16); }
            moba_batch(qr, t, n * 256, slope2, false, 4, lds, wave, lane,
                       valid ? part_o + ((row * 8 + h) * 4 + slot) * 64 : (bf16_t*)nullptr, valid ? part_l + (row * 8 + h) * 4 + slot : (float*)nullptr);
        }
        __syncthreads();
    }
}
constexpr int G_KMH = 0, G_KML = 8192, G_CNT = 16384;
#define MX_INS(v, n) do { const bool g0_ = (v) > v0, g1_ = (v) > v1, g2_ = (v) > v2; \
    v2 = g1_ ? v1 : (g2_ ? (v) : v2); i2 = g1_ ? i1 : (g2_ ? (n) : i2); v1 = g0_ ? v0 : (g1_ ? (v) : v1); i1 = g0_ ? i0 : (g1_ ? (n) : i1); v0 = g0_ ? (v) : v0; i0 = g0_ ? (n) : i0; } while (0)
__device__ __forceinline__ void gate_task_mfma(int bh, int i, const bf16_t* __restrict__ proj, const float* __restrict__ kmsum, u32* __restrict__ sel,
                                               unsigned short* __restrict__ seg, int* __restrict__ cnt, const unsigned* __restrict__ kmx, float* __restrict__ part_l, lds_ptr lds, int tid) {
    const int b = bh >> 3, h = bh & 7, lane = tid & 63, wave = __builtin_amdgcn_readfirstlane(tid >> 6), r32 = lane & 31, hi = lane >> 5;
    { const int n = tid >> 3, ch = tid & 7; const float* src = kmsum + (size_t)bh * 4096 + n * 64 + ch * 8;
      const f32x4_t a = *(const f32x4_t*)src * (1.0f / 256.0f), c = *(const f32x4_t*)(src + 4) * (1.0f / 256.0f);
      float v[8] = {a[0], a[1], a[2], a[3], c[0], c[1], c[2], c[3]}; float hf[8], lf[8];
#pragma unroll
      for (int k = 0; k < 8; ++k) { hf[k] = bf2f(f2bf(v[k])); lf[k] = v[k] - hf[k]; }
      const u32x4 H = {pk(hf[0], hf[1]), pk(hf[2], hf[3]), pk(hf[4], hf[5]), pk(hf[6], hf[7])}, Lw = {pk(lf[0], lf[1]), pk(lf[2], lf[3]), pk(lf[4], lf[5]), pk(lf[6], lf[7])};
      *(LAS u32x4*)(lds + G_KMH + ch * 1024 + n * 16) = H; *(LAS u32x4*)(lds + G_KML + ch * 1024 + n * 16) = Lw; }
    LAS int* cntL = (LAS int*)(lds + G_CNT);
    if (tid < 64) cntL[tid] = 0;
    __syncthreads();
    const int ql = wave * 32 + r32, t = i * 256 + ql; const size_t row = (size_t)b * SEQ + t;
    const bf16_t* qp = proj + ((size_t)bh * SEQ + t) * 64 + hi * 8;
    f32x16 p0, p1;
#pragma unroll
    for (int r = 0; r < 16; ++r) { p0[r] = 0.f; p1[r] = 0.f; }
    const bf16_t* ksp = proj + SEC + ((size_t)bh * SEQ + t) * 64 + hi * 8;
    float qq = 0.f, qk = 0.f;
#pragma unroll
    for (int ks = 0; ks < 4; ++ks) {
        const bf16x8 q = *(const bf16x8*)(qp + ks * 16);
        { const u32x4 qu = __builtin_bit_cast(u32x4, q), ku = *(const u32x4*)(ksp + ks * 16); qq = dot8bf(qu, qu, qq); qk = dot8bf(qu, ku, qk); }
        const lds_cptr kb = (lds_cptr)lds + (2 * ks + hi) * 1024 + r32 * 16;
        p0 = __builtin_amdgcn_mfma_f32_32x32x16_bf16(*(const LAS bf16x8*)(kb + G_KMH), q, p0, 0, 0, 0);
        p0 = __builtin_amdgcn_mfma_f32_32x32x16_bf16(*(const LAS bf16x8*)(kb + G_KML), q, p0, 0, 0, 0);
        p1 = __builtin_amdgcn_mfma_f32_32x32x16_bf16(*(const LAS bf16x8*)(kb + G_KMH + 512), q, p1, 0, 0, 0);
        p1 = __builtin_amdgcn_mfma_f32_32x32x16_bf16(*(const LAS bf16x8*)(kb + G_KML + 512), q, p1, 0, 0, 0);
    }
    float v0 = -INFINITY, v1 = -INFINITY, v2 = -INFINITY; int i0 = 0, i1 = 0, i2 = 0;
#pragma unroll
    for (int r = 0; r < 16; ++r) { const int n = crow(r, hi); const float v = n < i ? p0[r] : -INFINITY; MX_INS(v, n); }
#pragma unroll
    for (int r = 0; r < 16; ++r) { const int n = 32 + crow(r, hi); const float v = n < i ? p1[r] : -INFINITY; MX_INS(v, n); }
    { const float a0 = __shfl_xor(v0, 32), a1 = __shfl_xor(v1, 32), a2 = __shfl_xor(v2, 32); const int j0 = __shfl_xor(i0, 32), j1 = __shfl_xor(i1, 32), j2 = __shfl_xor(i2, 32);
      MX_INS(a0, j0); MX_INS(a1, j1); MX_INS(a2, j2); }
    qq += other_half(qq); qk += other_half(qk);
    if (hi == 0) {
        const int nv = i < 3 ? i : 3;
        sel[row * 8 + h] = (u32)i0 | ((u32)i1 << 8) | ((u32)i2 << 16) | ((u32)nv << 24);
        const float qn = sqrtf(qq) * 1.01f, slope2 = __builtin_amdgcn_exp2f(-(float)(h + 1)) * LOG2E;
#pragma unroll
        for (int s = 0; s < 3; ++s) if (s < nv) { const int n = s == 0 ? i0 : (s == 1 ? i1 : i2);
            const float kmax = sqrtf(__uint_as_float(kmx[((size_t)bh * 64 + n) * 2]) + __uint_as_float(kmx[((size_t)bh * 64 + n) * 2 + 1]));
            const float U = qn * kmax - slope2 * (float)(t - (n * 256 + 255));
            if (U + 8.0f - qk < -30.0f) part_l[(row * 8 + h) * 4 + s] = -1e30f;
            else { const int pos = atomicAdd((int*)&cntL[n], 1);
                seg[(((size_t)bh * 64 + n) * 64 + i) * 256 + pos] = (unsigned short)((ql << 2) | s); } }
    }
    __syncthreads();
    if (tid < i) cnt[((size_t)bh * 64 + tid) * 64 + i] = cntL[tid];
    __syncthreads();
}
#undef MX_INS

__device__ __forceinline__ void moba_combine(const bf16_t* __restrict__ part_o, const float* __restrict__ part_l, const u32* __restrict__ sel, bf16_t* __restrict__ mix, size_t gt, size_t GT) {
    for (size_t i = gt; i < (size_t)MT * 64; i += GT) {
        const int ch = (int)(i & 7), h = (int)((i >> 3) & 7); const size_t row = i >> 6;
        const int nv = sel[row * 8 + h] >> 24;
        const f32x4_t lv = *(const f32x4_t*)(part_l + (row * 8 + h) * 4);
        float w[4]; w[0] = nv > 0 ? lv[0] : -1e30f; w[1] = nv > 1 ? lv[1] : -1e30f; w[2] = nv > 2 ? lv[2] : -1e30f; w[3] = lv[3];
        const float mm = fmaxf(fmaxf(w[0], w[1]), fmaxf(w[2], w[3]));
        float acc[8] = {0.f, 0.f, 0.f, 0.f, 0.f, 0.f, 0.f, 0.f}; float ws = 0.f;
#pragma unroll
        for (int s = 0; s < 4; ++s) { const bool ok = s == 3 || s < nv; const float ww = ok ? __builtin_amdgcn_exp2f(w[s] - mm) : 0.f; ws += ww;
            if (ok) { const u32x4 v = *(const u32x4*)(part_o + ((row * 8 + h) * 4 + s) * 64 + ch * 8);
                acc[0] += ww * __uint_as_float(v.x << 16); acc[1] += ww * __uint_as_float(v.x & 0xffff0000u); acc[2] += ww * __uint_as_float(v.y << 16); acc[3] += ww * __uint_as_float(v.y & 0xffff0000u);
                acc[4] += ww * __uint_as_float(v.z << 16); acc[5] += ww * __uint_as_float(v.z & 0xffff0000u); acc[6] += ww * __uint_as_float(v.w << 16); acc[7] += ww * __uint_as_float(v.w & 0xffff0000u); } }
        const float iw = 1.0f / ws;
        u32x4 o; o.x = pk(acc[0] * iw, acc[1] * iw); o.y = pk(acc[2] * iw, acc[3] * iw); o.z = pk(acc[4] * iw, acc[5] * iw); o.w = pk(acc[6] * iw, acc[7] * iw);
        *(u32x4*)(mix + row * DM + h * 64 + ch * 8) = o;
    }
}

constexpr int R_IMG = 65536;
__device__ __forceinline__ int rimg_off(int t, int c) { return (c >> 5) * 16384 + (t >> 3) * 512 + (t & 7) * 64 + (c & 31) * 2; }
__device__ __forceinline__ void ret_stage(const bf16_t* __restrict__ plane, int t0, lds_ptr img, int tid, bool kdecay, float log2g) {
#pragma unroll
    for (int i = 0; i < 8; ++i) { const int pc = tid + 512 * i, t = pc >> 4, ch = pc & 15;
        u32x4 v = *(const u32x4*)(plane + (size_t)(t0 + t) * 128 + ch * 8);
        if (kdecay) { const float f = __builtin_amdgcn_exp2f((float)(255 - t) * log2g);
            v.x = pk(__uint_as_float(v.x << 16) * f, __uint_as_float(v.x & 0xffff0000u) * f); v.y = pk(__uint_as_float(v.y << 16) * f, __uint_as_float(v.y & 0xffff0000u) * f);
            v.z = pk(__uint_as_float(v.z << 16) * f, __uint_as_float(v.z & 0xffff0000u) * f); v.w = pk(__uint_as_float(v.w << 16) * f, __uint_as_float(v.w & 0xffff0000u) * f); }
        *(LAS u32x4*)(img + rimg_off(t, ch * 8)) = v; }
}
__device__ __forceinline__ void ret_kv_task(const bf16_t* __restrict__ proj, int bh, int c, float* __restrict__ kvt, lds_ptr lds, int tid) {
    const int b = bh >> 2, h = bh & 3, lane = tid & 63, wave = __builtin_amdgcn_readfirstlane(tid >> 6), r32 = lane & 31, hi = lane >> 5;
    const float log2g = __builtin_amdgcn_logf(1.0f - __builtin_amdgcn_exp2f(-5.0f - (float)h));
    ret_stage(proj + 5 * SEC + (size_t)bh * SEQ * 128, c * 256, lds, tid, false, 0.f);
    ret_stage(proj + 4 * SEC + (size_t)bh * SEQ * 128, c * 256, lds + R_IMG, tid, true, log2g);
    __syncthreads();
    const int et = wave >> 1, dt0 = (wave & 1) * 2;
    const int lbase = hi * 512 + ((lane & 15) >> 2) * 64 + ((lane >> 4) & 1) * 32 + (lane & 3) * 8;
    const lds_cptr va = (lds_cptr)lds + et * 16384 + lbase, kb0 = (lds_cptr)lds + R_IMG + dt0 * 16384 + lbase, kb1 = kb0 + 16384;
    f32x16 a0, a1;
#pragma unroll
    for (int r = 0; r < 16; ++r) { a0[r] = 0.f; a1[r] = 0.f; }
#pragma unroll 4
    for (int ks = 0; ks < 16; ++ks) {
        const bf16x8 vf = cat8(vtr(va + ks * 1024), vtr(va + ks * 1024 + 256));
        const bf16x8 k0 = cat8(vtr(kb0 + ks * 1024), vtr(kb0 + ks * 1024 + 256)), k1 = cat8(vtr(kb1 + ks * 1024), vtr(kb1 + ks * 1024 + 256));
        a0 = __builtin_amdgcn_mfma_f32_32x32x16_bf16(vf, k0, a0, 0, 0, 0);
        a1 = __builtin_amdgcn_mfma_f32_32x32x16_bf16(vf, k1, a1, 0, 0, 0);
    }
    float* dst = kvt + ((size_t)(bh * 64 + c) * 128) * 128;
#pragma unroll
    for (int r = 0; r < 16; ++r) { const int e = et * 32 + crow(r, hi);
        dst[(size_t)e * 128 + dt0 * 32 + r32] = a0[r]; dst[(size_t)e * 128 + dt0 * 32 + 32 + r32] = a1[r]; }
    __syncthreads();
}
__device__ __forceinline__ void ret_scan(const float* __restrict__ kvt, bf16_t* __restrict__ stt, size_t gt, size_t GT) {
    for (size_t i = gt; i < (size_t)8 * 16384; i += GT) {
        const int bh = (int)(i >> 14), ed = (int)(i & 16383), h = bh & 3;
        const float g256 = __builtin_amdgcn_exp2f(256.0f * __builtin_amdgcn_logf(1.0f - __builtin_amdgcn_exp2f(-5.0f - (float)h)));
        float s = 0.f;
#pragma unroll 8
        for (int c = 0; c < 64; ++c) { const size_t o = ((size_t)(bh * 64 + c) << 14) + ed; stt[o] = f2bf(s); s = s * g256 + kvt[o]; }
    }
}
constexpr int RO_A = 0, RO_V = 65536, RO_ST = 131072;
#define RO_STAMP(i) do { if (dts && tid == 0) __hip_atomic_store(dts + (i), (unsigned long long)__builtin_amdgcn_s_memrealtime(), __ATOMIC_RELAXED, __HIP_MEMORY_SCOPE_AGENT); } while (0)
__device__ __forceinline__ void ret_out_task(const bf16_t* __restrict__ proj, const bf16_t* __restrict__ stt, const float* __restrict__ gain, bf16_t* __restrict__ mix, int bh, int c, lds_ptr lds, int tid, unsigned long long* dts = nullptr) {
    RO_STAMP(21);
    const int b = bh >> 2, h = bh & 3, lane = tid & 63, wave = __builtin_amdgcn_readfirstlane(tid >> 6), r32 = lane & 31, hi = lane >> 5;
    const float log2g = __builtin_amdgcn_logf(1.0f - __builtin_amdgcn_exp2f(-5.0f - (float)h));
    const size_t row0 = (size_t)b * SEQ + c * 256;
    u32x4 sreg[4], vreg[8], kreg[8];
    { const bf16_t* sp = stt + ((size_t)(bh * 64 + c) << 14);
#pragma unroll
      for (int i = 0; i < 4; ++i) sreg[i] = *(const u32x4*)(sp + (size_t)(tid + 512 * i) * 8); }
    const size_t hrow0 = (size_t)bh * SEQ + c * 256;
#pragma unroll
    for (int i = 0; i < 8; ++i) { const int pc = tid + 512 * i, t = pc >> 4, ch = pc & 15; const bf16_t* src = proj + (hrow0 + t) * 128 + ch * 8;
        vreg[i] = *(const u32x4*)(src + 5 * SEC); kreg[i] = *(const u32x4*)(src + 4 * SEC); }
    bf16x8 qf[8];
    { const bf16_t* qp = proj + 3 * SEC + (hrow0 + wave * 32 + r32) * 128 + hi * 8;
#pragma unroll
      for (int ks = 0; ks < 8; ++ks) qf[ks] = *(const bf16x8*)(qp + ks * 16); }
#pragma unroll
    for (int i = 0; i < 4; ++i) { const int pc = tid + 512 * i, e = pc >> 4, ch = pc & 15; *(LAS u32x4*)(lds + RO_A + ch * 2048 + e * 16) = sreg[i]; }
#pragma unroll
    for (int i = 0; i < 8; ++i) { const int pc = tid + 512 * i, t = pc >> 4, ch = pc & 15; *(LAS u32x4*)(lds + RO_V + rimg_off(t, ch * 8)) = vreg[i]; }
    __syncthreads();
    RO_STAMP(22);
    f32x16 o[4];
#pragma unroll
    for (int et = 0; et < 4; ++et)
#pragma unroll
        for (int r = 0; r < 16; ++r) o[et][r] = 0.f;
    { const lds_cptr sb = (lds_cptr)lds + RO_A + hi * 2048 + r32 * 16;
#pragma unroll
      for (int et = 0; et < 4; ++et)
#pragma unroll
          for (int ks = 0; ks < 8; ++ks) o[et] = __builtin_amdgcn_mfma_f32_32x32x16_bf16(qf[ks], *(const LAS bf16x8*)(sb + ks * 4096 + et * 512), o[et], 0, 0, 0); }
#pragma unroll
    for (int r = 0; r < 16; ++r) { const float f = __builtin_amdgcn_exp2f((float)(wave * 32 + crow(r, hi) + 1) * log2g);
#pragma unroll
        for (int et = 0; et < 4; ++et) o[et][r] *= f; }
    RO_STAMP(23);
    __syncthreads();
#pragma unroll
    for (int i = 0; i < 8; ++i) { const int pc = tid + 512 * i, t = pc >> 4, ch = pc & 15; *(LAS u32x4*)(lds + RO_A + ch * 4096 + t * 16) = kreg[i]; }
    __syncthreads();
    u32x4 rgv[8];
#pragma unroll
    for (int g = 0; g < 4; ++g)
#pragma unroll
        for (int k = 0; k < 2; ++k) { const int pidx = lane + 64 * k; rgv[2 * g + k] = *(const u32x4*)(proj + 6 * SEC + (hrow0 + wave * 32 + 8 * g + (pidx >> 4)) * 128 + (pidx & 15) * 8); }
    const lds_cptr vp = (lds_cptr)lds + RO_V + ((lane >> 4) & 1) * 32 + (lane & 3) * 8 + (4 * hi + ((lane & 15) >> 2)) * 64;
    const lds_cptr kpb = (lds_cptr)lds + RO_A + hi * 4096 + r32 * 16;
    for (int kvt = 0; kvt <= wave; ++kvt) {
        f32x16 p;
#pragma unroll
        for (int r = 0; r < 16; ++r) p[r] = 0.f;
#pragma unroll
        for (int ks = 0; ks < 8; ++ks) p = __builtin_amdgcn_mfma_f32_32x32x16_bf16(*(const LAS bf16x8*)(kpb + ks * 8192 + kvt * 512), qf[ks], p, 0, 0, 0);
        const int dbase = 32 * (wave - kvt) + r32 - 4 * hi;
#pragma unroll
        for (int r = 0; r < 16; ++r) { const int dist = dbase - ((r & 3) + 8 * (r >> 2)); p[r] = dist >= 0 ? p[r] * __builtin_amdgcn_exp2f((float)dist * log2g) : 0.f; }
        const u32x4 pw0 = {pk(p[0], p[1]), pk(p[2], p[3]), pk(p[4], p[5]), pk(p[6], p[7])}, pw1 = {pk(p[8], p[9]), pk(p[10], p[11]), pk(p[12], p[13]), pk(p[14], p[15])};
        const lds_cptr vt = vp + kvt * 2048;
#pragma unroll
        for (int et = 0; et < 4; ++et) {
            o[et] = __builtin_amdgcn_mfma_f32_32x32x16_bf16(__builtin_bit_cast(bf16x8, pw0), cat8(vtr(vt + et * 16384), vtr(vt + et * 16384 + 512)), o[et], 0, 0, 0);
            o[et] = __builtin_amdgcn_mfma_f32_32x32x16_bf16(__builtin_bit_cast(bf16x8, pw1), cat8(vtr(vt + et * 16384 + 1024), vtr(vt + et * 16384 + 1536)), o[et], 0, 0, 0);
        }
    }
    RO_STAMP(24);
    float mu[16], rstd[16];
#pragma unroll
    for (int r = 0; r < 16; ++r) {
        float s = (o[0][r] + o[1][r]) + (o[2][r] + o[3][r]);
        s += __shfl_xor(s, 1); s += __shfl_xor(s, 2); s += __shfl_xor(s, 4); s += __shfl_xor(s, 8); s += __shfl_xor(s, 16);
        mu[r] = s * (1.0f / 128.0f);
        const float d0 = o[0][r] - mu[r], d1 = o[1][r] - mu[r], d2 = o[2][r] - mu[r], d3 = o[3][r] - mu[r];
        float q = (d0 * d0 + d1 * d1) + (d2 * d2 + d3 * d3);
        q += __shfl_xor(q, 1); q += __shfl_xor(q, 2); q += __shfl_xor(q, 4); q += __shfl_xor(q, 8); q += __shfl_xor(q, 16);
        rstd[r] = rsqrtf(q * (1.0f / 128.0f) + GN_EPS);
    }
    float gn[4];
#pragma unroll
    for (int et = 0; et < 4; ++et) gn[et] = gain[h * 128 + et * 32 + r32];
    LAS bf16_t* st = (LAS bf16_t*)(lds + RO_ST) + wave * 1024;
#pragma unroll
    for (int g = 0; g < 4; ++g) {
#pragma unroll
        for (int rr = 0; rr < 4; ++rr) { const int r = 4 * g + rr;
#pragma unroll
            for (int et = 0; et < 4; ++et) st[(rr + 4 * hi) * 128 + et * 32 + r32] = f2bf((o[et][r] - mu[r]) * rstd[r] * gn[et]); }
#pragma unroll
        for (int k = 0; k < 2; ++k) { const int pidx = lane + 64 * k, r8 = pidx >> 4, ch = pidx & 15; const size_t row = row0 + wave * 32 + 8 * g + r8;
            const u32x4 nv = *(const LAS u32x4*)(st + r8 * 128 + ch * 8); const u32x4 gv = rgv[2 * g + k];
            const unsigned nw[4] = {nv.x, nv.y, nv.z, nv.w}, gw_[4] = {gv.x, gv.y, gv.z, gv.w}; unsigned ow[4];
#pragma unroll
            for (int q = 0; q < 4; ++q) { const float g0 = __uint_as_float(gw_[q] << 16), g1 = __uint_as_float(gw_[q] & 0xffff0000u);
                ow[q] = pk(__uint_as_float(nw[q] << 16) * (g0 / (1.0f + __expf(-g0))), __uint_as_float(nw[q] & 0xffff0000u) * (g1 / (1.0f + __expf(-g1)))); }
            *(u32x4*)(mix + row * DM + 512 + h * 128 + ch * 8) = (u32x4){ow[0], ow[1], ow[2], ow[3]}; }
    }
    RO_STAMP(25);
    __syncthreads();
    RO_STAMP(26);
}
#undef RO_STAMP
}
#ifndef DIAG_K
#define DIAG_K -1
#endif
#ifndef DIAG_BLOCK
#define DIAG_BLOCK 100
#endif
#ifndef DIAG_SCALE
#define DIAG_SCALE 1.0f
#endif
#ifndef DIAG_A
#define DIAG_A 45
#endif
#ifndef DIAG_B
#define DIAG_B 6
#endif
#ifndef REP_MASK
#define REP_MASK 0
#endif
#ifndef REP_SUB
#define REP_SUB 7
#endif
#include <hip/hip_cooperative_groups.h>
namespace cg = cooperative_groups;
constexpr int NWAVES = 8, NTHREADS = 512;
constexpr int LDS_BYTES = 147456 + 256;
constexpr int NPH = 10;
constexpr size_t WS_STASH = 180 * MiB;
constexpr size_t STASH_ELEMS = (size_t)512 * 2 * FF;

struct Args { const float* in[16]; float* out; unsigned char* ws; int ph_lo, ph_hi, flags, pad; };

__device__ __forceinline__ void p0_transpose_item(const float* __restrict__ W, int K, int N, const float* __restrict__ gk, bf16_t* __restrict__ WT, int k0, int n0, int orow0, LAS float* scr, int lane) {
    { float4 v[8];
#pragma unroll
      for (int i = 0; i < 8; ++i) v[i] = *(const float4*)(W + (size_t)(k0 + 8 * i + (lane >> 3)) * N + n0 + (lane & 7) * 4);
#pragma unroll
      for (int i = 0; i < 8; ++i) { const int kk = 8 * i + (lane >> 3); const float g = gk ? gk[k0 + kk] : 1.0f; LAS float* d = scr + kk * 33 + (lane & 7) * 4;
          d[0] = v[i].x * g; d[1] = v[i].y * g; d[2] = v[i].z * g; d[3] = v[i].w * g; } }
    asm volatile("s_waitcnt lgkmcnt(0)" ::: "memory");
    const int c = lane & 7;
#pragma unroll
    for (int j = 0; j < 4; ++j) { const int n = (lane >> 3) + 8 * j; const LAS float* s = scr + (8 * c) * 33 + n;
        uint4 o; o.x = (u32)f2bf(s[0 * 33]) | ((u32)f2bf(s[1 * 33]) << 16); o.y = (u32)f2bf(s[2 * 33]) | ((u32)f2bf(s[3 * 33]) << 16);
        o.z = (u32)f2bf(s[4 * 33]) | ((u32)f2bf(s[5 * 33]) << 16); o.w = (u32)f2bf(s[6 * 33]) | ((u32)f2bf(s[7 * 33]) << 16);
        *(uint4*)(WT + (size_t)(orow0 + n) * K + k0 + 8 * c) = o; }
    asm volatile("s_waitcnt lgkmcnt(0)" ::: "memory");
}

#define XB_TMO      128
#define XB_XCNT(j)  (256  + 64 * (j))
#define XB_XSUB(j)  (1280 + 64 * (j))
#define XB_XGEN(j)  (2304 + 64 * (j))
#define XB_TOP      3328
#define XB_TOPGEN   3392
#define XCD_BAR_WORDS 3456
#define XB_SPIN_CAP (1u << 18)

__device__ __forceinline__ unsigned xb_ld(unsigned* p)              { return __hip_atomic_load(p, __ATOMIC_RELAXED, __HIP_MEMORY_SCOPE_AGENT); }
__device__ __forceinline__ unsigned xb_add(unsigned* p, unsigned v) { return __hip_atomic_fetch_add(p, v, __ATOMIC_RELAXED, __HIP_MEMORY_SCOPE_AGENT); }
__device__ __forceinline__ unsigned xb_xcc_id() { return (unsigned)__builtin_amdgcn_s_getreg((3 << 11) | 20) & 0xFu; }
#define XB_SPIN(cond, bar) do { unsigned _sp = 0; while (cond) { __builtin_amdgcn_s_sleep(1); \
    if ((++_sp & 255u) == 0u) { if (xb_ld(&(bar)[XB_TMO])) break; if (_sp > XB_SPIN_CAP) { atomicAdd(&(bar)[XB_TMO], 1u); break; } } } } while (0)

struct XcdBarrier {
    unsigned* bar; unsigned x;
    volatile LAS unsigned* st;
};

__device__ __forceinline__ XcdBarrier xcd_barrier_post(unsigned* bar, volatile LAS unsigned* st) {
    XcdBarrier b; b.bar = bar; b.x = xb_xcc_id(); b.st = st;
    if (threadIdx.x == 0) (void)xb_add(&bar[XB_XCNT(b.x)], 1u);
    return b;
}
__device__ __forceinline__ void xcd_barrier_complete(unsigned* bar, unsigned x, unsigned& nloc, unsigned& nx) {
    const unsigned G = gridDim.x * gridDim.y * gridDim.z;
    unsigned sum, cnt, mine, sp = 0u;
    for (;;) {
        sum = 0u; cnt = 0u; mine = 0u;
#pragma unroll
        for (unsigned j = 0; j < 16; ++j) { const unsigned c = xb_ld(&bar[XB_XCNT(j)]); sum += c; cnt += (c > 0u) ? 1u : 0u; mine = (j == x) ? c : mine; }
        if (sum == G) break;
        __builtin_amdgcn_s_sleep(1);
        if ((++sp & 255u) == 0u) { if (xb_ld(&bar[XB_TMO])) break; if (sp > XB_SPIN_CAP) { atomicAdd(&bar[XB_TMO], 1u); break; } }
    }
    nloc = mine > 0u ? mine : 1u; nx = cnt > 0u ? cnt : 1u;
}

__device__ __forceinline__ void xcd_barrier(const XcdBarrier& b) {
    asm volatile("s_waitcnt vmcnt(0)" ::: "memory");
    __syncthreads();
    if (threadIdx.x == 0) {
        unsigned* bar = b.bar;
        __builtin_amdgcn_s_waitcnt(0);
        unsigned nloc = b.st[0], nx = b.st[1];
        if (nloc == 0u) { xcd_barrier_complete(bar, b.x, nloc, nx); b.st[0] = nloc; b.st[1] = nx; }
        const unsigned old = xb_add(&bar[XB_XSUB(b.x)], 1u);
        const unsigned gen = old / nloc;
        if (old + 1u == (gen + 1u) * nloc) {
            __builtin_amdgcn_fence(__ATOMIC_RELEASE, "agent");
            asm volatile("s_waitcnt vmcnt(0)" ::: "memory");
            const unsigned og = xb_add(&bar[XB_TOP], 1u);
            const unsigned tg = og / nx;
            if (og + 1u == (tg + 1u) * nx) xb_add(&bar[XB_TOPGEN], 1u);
            else XB_SPIN(xb_ld(&bar[XB_TOPGEN]) == tg, bar);
            __builtin_amdgcn_fence(__ATOMIC_ACQUIRE, "agent");
            xb_add(&bar[XB_XGEN(b.x)], 1u);
            asm volatile("s_waitcnt vmcnt(0)" ::: "memory");
        } else {
            XB_SPIN(xb_ld(&bar[XB_XGEN(b.x)]) == gen, bar);
            __builtin_amdgcn_fence(__ATOMIC_ACQUIRE, "agent");
            asm volatile("s_waitcnt vmcnt(0)" ::: "memory");
        }
    }
    __syncthreads();
}

constexpr int CW_BAR = 4096;
constexpr int LDS_BARST = 147456;
constexpr size_t CTL_ZERO_BYTES = 65536;
constexpr int CW_PANEL = 8192;

#if (REP_MASK >> 2) & 1
#define SUBON2(bit) (rep == 0 || ((REP_SUB >> (bit)) & 1))
#else
#define SUBON2(bit) true
#endif
#if (REP_MASK >> 3) & 1
#define SUBON3(bit) (rep == 0 || ((REP_SUB >> (bit)) & 1))
#else
#define SUBON3(bit) true
#endif
#if (REP_MASK >> 4) & 1
#define SUBON4(bit) (rep == 0 || ((REP_SUB >> (bit)) & 1))
#else
#define SUBON4(bit) true
#endif
__global__ void __launch_bounds__(NTHREADS, 2) mega(Args a) {
    extern __shared__ __attribute__((aligned(16))) unsigned char lds[];
    cg::grid_group grid = cg::this_grid();
    const int wave = __builtin_amdgcn_readfirstlane(threadIdx.x >> 6);
#define MKLANE() ({ int l_; asm volatile("v_mbcnt_lo_u32_b32 %0, -1, 0\n\tv_mbcnt_hi_u32_b32 %0, -1, %0" : "=v"(l_)); l_; })
#define MKTID() (wave * 64 + MKLANE())
#define tid MKTID()
#define lane MKLANE()
    const int G = gridDim.x, bx = blockIdx.x;
    const int vcu = (G % 8 == 0) ? (bx % 8) * (G / 8) + bx / 8 : bx;
    const int gw = vcu * NWAVES + wave, NGW = G * NWAVES;
    unsigned char* ws = a.ws;
    const float* x = a.in[0]; const float* p = a.in[1]; const float* attn_norm = a.in[2]; const float* w_in = a.in[3]; const float* ret_norm = a.in[4]; const float* w_out = a.in[5];
    const float* ffn_norm = a.in[6]; const float* w_up = a.in[7]; const float* w_gate = a.in[8]; const float* conv_w = a.in[9]; const float* conv_b = a.in[10]; const float* w_down = a.in[11];
    const float* ple_norm = a.in[12]; const float* w_ple = a.in[13]; const float* w_ple_gate = a.in[14]; const float* final_norm = a.in[15];
    float* out = a.out;
    bf16_t* Win_t = (bf16_t*)(ws + WS_WIN); bf16_t* Wout_t = (bf16_t*)(ws + WS_WOUT); bf16_t* Wug_t = (bf16_t*)(ws + WS_WUG); bf16_t* Wdown_t = (bf16_t*)(ws + WS_WDOWN);
    bf16_t* Wpg_t = (bf16_t*)(ws + WS_WPG); bf16_t* Wple_t = (bf16_t*)(ws + WS_WPLE);
    bf16_t* XN = (bf16_t*)(ws + WS_R1); bf16_t* MIX = (bf16_t*)(ws + WS_SEG); bf16_t* PW = (bf16_t*)(ws + WS_R1);
    float* RS0 = (float*)(ws + WS_CNT + 768 * 1024);
    unsigned* KMX = (unsigned*)(ws + WS_CNT + 896 * 1024);
    bf16_t* XB = (bf16_t*)(ws + WS_R2);
    bf16_t* PROJ = (bf16_t*)(ws + WS_PROJ); bf16_t* ACT = (bf16_t*)(ws + WS_PROJ);
    bf16_t* PB = (bf16_t*)(ws + WS_PB); float* RSQ = (float*)(ws + WS_RSQ);
    float* KM = (float*)(ws + WS_KMEAN);
    float* UL = (float*)(ws + WS_STASH); float* UF = UL + STASH_ELEMS; float* GF = UF + STASH_ELEMS;
    float* KVT = (float*)(ws + WS_KVT); bf16_t* STT = (bf16_t*)(ws + WS_STT); float* PART_L = (float*)(ws + WS_PARTL); bf16_t* PART_O = (bf16_t*)out;
    u32* SEL = (u32*)(ws + WS_SEL); unsigned short* SEG = (unsigned short*)(ws + WS_SEG); int* CNT = (int*)(ws + WS_CNT);

    const int lo = a.ph_lo, hi = a.ph_hi;
#if DIAG_K >= 0
    unsigned long long* dts = (unsigned long long*)(ws + WS_CTL + 49152);
#define DIAG_STAMP(i) do { if (bx == DIAG_BLOCK && wave == 0 && MKLANE() == 0) __hip_atomic_store(dts + (i), (unsigned long long)__builtin_amdgcn_s_memrealtime(), __ATOMIC_RELAXED, __HIP_MEMORY_SCOPE_AGENT); } while (0)
    DIAG_STAMP(0);
#define DIAG_DTS(it) ((bx == DIAG_BLOCK && (it) == bx) ? dts : (unsigned long long*)nullptr)
#else
#define DIAG_STAMP(i) do { } while (0)
#define DIAG_DTS(it) ((unsigned long long*)nullptr)
#endif
#define IN(k) (lo <= (k) && (k) < hi)
#define SEAM(k) do { if (IN(k) && IN((k) + 1)) { DIAG_STAMP(40 + (k)); if (a.ph_lo < 0) grid.sync(); else xcd_barrier(xbar); DIAG_STAMP(1 + (k)); } } while (0)
    { volatile LAS unsigned* st = (volatile LAS unsigned*)((LAS unsigned char*)lds + LDS_BARST); if (tid < 2) st[tid] = 0u; }
    __syncthreads();
    XcdBarrier xbar = xcd_barrier_post((unsigned*)(ws + WS_CTL) + CW_BAR, (volatile LAS unsigned*)((LAS unsigned char*)lds + LDS_BARST));

#if (REP_MASK >> 0) & 1
    for (int rep = 0; rep < 2; ++rep)
#endif
    if (IN(0)) {
        LAS float* scr = (LAS float*)(lds) + wave * (64 * 33);
        constexpr int I_IN = 16 * (NPROJ / 32), I_OUT = 16 * (DM / 32), I_UP = 16 * (FF / 32), I_DOWN = (FF / 64) * (DM / 32), I_PG = 16 * (DM / 32), I_PLE = (PLED / 64) * (DM / 32);
        constexpr int NITEMS = I_IN + I_OUT + 2 * I_UP + I_DOWN + I_PG + I_PLE;
        for (int it = gw; it < NITEMS; it += NGW) {
            int r = it;
            if (r < I_IN) { const int nb = r % (NPROJ / 32), kb = r / (NPROJ / 32); p0_transpose_item(w_in, DM, NPROJ, nullptr, Win_t, kb * 64, nb * 32, nb * 32, scr, lane); continue; } r -= I_IN;
            if (r < I_OUT) { const int nb = r % (DM / 32), kb = r / (DM / 32); p0_transpose_item(w_out, DM, DM, nullptr, Wout_t, kb * 64, nb * 32, nb * 32, scr, lane); continue; } r -= I_OUT;
            if (r < I_UP) { const int nb = r % (FF / 32), kb = r / (FF / 32), n0 = nb * 32; p0_transpose_item(w_up, DM, FF, ffn_norm, Wug_t, kb * 64, n0, (n0 >> 7) * 256 + (n0 & 127), scr, lane); continue; } r -= I_UP;
            if (r < I_UP) { const int nb = r % (FF / 32), kb = r / (FF / 32), n0 = nb * 32; p0_transpose_item(w_gate, DM, FF, ffn_norm, Wug_t, kb * 64, n0, (n0 >> 7) * 256 + 128 + (n0 & 127), scr, lane); continue; } r -= I_UP;
            if (r < I_DOWN) { const int nb = r % (DM / 32), kb = r / (DM / 32); p0_transpose_item(w_down, FF, DM, nullptr, Wdown_t, kb * 64, nb * 32, nb * 32, scr, lane); continue; } r -= I_DOWN;
            if (r < I_PG) { const int nb = r % (DM / 32), kb = r / (DM / 32); p0_transpose_item(w_ple_gate, DM, DM, ple_norm, Wpg_t, kb * 64, nb * 32, nb * 32, scr, lane); continue; } r -= I_PG;
            { const int nb = r % (DM / 32), kb = r / (DM / 32); p0_transpose_item(w_ple, PLED, DM, nullptr, Wple_t, kb * 64, nb * 32, nb * 32, scr, lane); }
        }
        DIAG_STAMP(12);
        for (int m = gw; m < MT; m += 2 * NGW) {
            const int m2 = m + NGW;
            const float4* xr = (const float4*)(x + (size_t)m * DM); const float4* xr2 = (const float4*)(x + (size_t)m2 * DM); float4 v[4], w[4]; float s = 0.f, s2 = 0.f;
#pragma unroll
            for (int j = 0; j < 4; ++j) { v[j] = xr[lane + 64 * j]; w[j] = xr2[lane + 64 * j]; }
#pragma unroll
            for (int j = 0; j < 4; ++j) { s += v[j].x * v[j].x + v[j].y * v[j].y + v[j].z * v[j].z + v[j].w * v[j].w; s2 += w[j].x * w[j].x + w[j].y * w[j].y + w[j].z * w[j].z + w[j].w * w[j].w; }
            const float rs = rsqrtf(wave_sum(s) * (1.0f / DM) + RMS_EPS), rs2 = rsqrtf(wave_sum(s2) * (1.0f / DM) + RMS_EPS);
            if (lane == 0) { RS0[m] = rs; RS0[m2] = rs2; }
#pragma unroll
            for (int j = 0; j < 4; ++j) { const float4 gg = ((const float4*)attn_norm)[lane + 64 * j];
                ushort4 o; o.x = f2bf(v[j].x * rs * gg.x); o.y = f2bf(v[j].y * rs * gg.y); o.z = f2bf(v[j].z * rs * gg.z); o.w = f2bf(v[j].w * rs * gg.w);
                ((ushort4*)(XN + (size_t)m * DM))[lane + 64 * j] = o;
                ushort4 o2; o2.x = f2bf(w[j].x * rs2 * gg.x); o2.y = f2bf(w[j].y * rs2 * gg.y); o2.z = f2bf(w[j].z * rs2 * gg.z); o2.w = f2bf(w[j].w * rs2 * gg.w);
                ((ushort4*)(XN + (size_t)m2 * DM))[lane + 64 * j] = o2; }
        }
        DIAG_STAMP(13);
        { const size_t n4 = (size_t)MT * PLED / 4; const size_t gt = (size_t)vcu * NTHREADS + tid, GT = (size_t)G * NTHREADS;
          for (size_t i = gt; i < n4; i += GT) { const float4 v = ((const float4*)p)[i]; ushort4 o; o.x = f2bf(v.x); o.y = f2bf(v.y); o.z = f2bf(v.z); o.w = f2bf(v.w); ((ushort4*)PB)[i] = o; }
          for (size_t i = gt; i < 16 * 64 * 64; i += GT) KM[i] = 0.f;
          if (gt < 16 * 64 * 2) KMX[gt] = 0u;
          if (gt < 64) ((int*)(ws + WS_CTL))[gt] = 0;
          for (size_t i = gt; i < 16 * 64 * 64; i += GT) CNT[i] = 0; }
    }
    SEAM(0);
#if (REP_MASK >> 1) & 1
    if (IN(1)) {
        pg8::Gemm g{XN, Win_t, MT, NPROJ, DM}; pg8::StaticOrder S; S.init(MT, NPROJ, G, bx);
        pg8::EpiProj E{PROJ, KM, KMX};
        pg8::gemm_phase<pg8::EpiProj, pg8::StaticOrder, true, true>((PG8_LAS unsigned char*)lds, g, S, E, MKTID());
    }
    asm volatile("" ::: "memory");
#endif
    if (IN(1)) {
        pg8::Gemm g{XN, Win_t, MT, NPROJ, DM}; pg8::StaticOrder S; S.init(MT, NPROJ, G, bx);
        pg8::EpiProj E{PROJ, KM, KMX};
        pg8::gemm_phase<pg8::EpiProj, pg8::StaticOrder, true, true>((PG8_LAS unsigned char*)lds, g, S, E, MKTID());
    }
    SEAM(1);
#if (REP_MASK >> 2) & 1
    { const int rep = 1; (void)rep;
    if (IN(2)) {
        mx::lds_ptr L = (mx::lds_ptr)lds;
        if (!(a.flags & 1) && SUBON2(0)) for (int it = bx; it < 512; it += G) mx::ret_kv_task(PROJ, it >> 6, it & 63, KVT, L, tid);
        if (!(a.flags & 2)) {
            if (SUBON2(1)) for (int it = bx; it < 16 * 63; it += G) mx::gate_task_mfma(it / 63, 1 + it % 63, PROJ, KM, SEL, SEG, CNT, KMX, PART_L, L, tid);
            { const int gtid = vcu * NTHREADS + tid; if (gtid < BATCH * 256 * 8) { const int h = gtid & 7, t = (gtid >> 3) & 255, b = gtid >> 11; SEL[((size_t)b * SEQ + t) * 8 + h] = 0u; } }
        }
    }
    }
    asm volatile("" ::: "memory");
#endif
    { const int rep = 0; (void)rep;
    if (IN(2)) {
        mx::lds_ptr L = (mx::lds_ptr)lds;
        if (!(a.flags & 1) && SUBON2(0)) for (int it = bx; it < 512; it += G) mx::ret_kv_task(PROJ, it >> 6, it & 63, KVT, L, tid);
        DIAG_STAMP(14);
        if (!(a.flags & 2)) {
            if (SUBON2(1)) for (int it = bx; it < 16 * 63; it += G) mx::gate_task_mfma(it / 63, 1 + it % 63, PROJ, KM, SEL, SEG, CNT, KMX, PART_L, L, tid);
        DIAG_STAMP(15);
            { const int gtid = vcu * NTHREADS + tid; if (gtid < BATCH * 256 * 8) { const int h = gtid & 7, t = (gtid >> 3) & 255, b = gtid >> 11; SEL[((size_t)b * SEQ + t) * 8 + h] = 0u; } }
        }
    }
    }
    SEAM(2);
#if (REP_MASK >> 3) & 1
#define QREP rep
#else
#define QREP 0
#endif
#if (REP_MASK >> 3) & 1
    for (int rep = 0; rep < 2; ++rep)
#endif
    if (IN(3)) {
        mx::lds_ptr L = (mx::lds_ptr)lds;
        if (!(a.flags & 1) && SUBON3(0)) mx::ret_scan(KVT, STT, (size_t)vcu * NTHREADS + tid, (size_t)G * NTHREADS);
        DIAG_STAMP(18);
        if (!(a.flags & 2) && SUBON3(1)) {
            LAS int* qslot = (LAS int*)(L + mx::L_PREF + 384);
            for (;;) {
                if (tid == 0) *qslot = atomicAdd((int*)(ws + WS_CTL) + QREP, 1);
                __syncthreads();
                const int q = *qslot;
                __syncthreads();
                if (q >= 16 * 63) break;
                mx::moba_sel_task(PROJ, SEG, CNT, q & 15, q >> 4, PART_O, PART_L, L, tid);
            }
        }
        DIAG_STAMP(19);
    }
    SEAM(3);
#if (REP_MASK >> 4) & 1
    { const int rep = 1; (void)rep;
    if (IN(4)) {
        mx::lds_ptr L = (mx::lds_ptr)lds;
        if (!(a.flags & 1) && SUBON4(0)) for (int it = bx; it < 512; it += G) mx::ret_out_task(PROJ, STT, ret_norm, MIX, it >> 6, it & 63, L, tid);
        if (!(a.flags & 2) && SUBON4(1)) for (int it = bx; it < 16 * 64; it += G) mx::moba_diag_unit(PROJ, it >> 6, it & 63, PART_O, PART_L, SEL, MIX, L, tid);
    }
    }
    asm volatile("" ::: "memory");
#endif
    { const int rep = 0; (void)rep;
    if (IN(4)) {
        mx::lds_ptr L = (mx::lds_ptr)lds;
        if (vcu & 1) for (int it = bx; it < 16 * 64; it += G) mx::moba_diag_unit(PROJ, it >> 6, it & 63, PART_O, PART_L, SEL, MIX, L, tid);
        for (int it = bx; it < 512; it += G) mx::ret_out_task(PROJ, STT, ret_norm, MIX, it >> 6, it & 63, L, tid, DIAG_DTS(it));
        DIAG_STAMP(16);
        if (!(vcu & 1)) for (int it = bx; it < 16 * 64; it += G) mx::moba_diag_unit(PROJ, it >> 6, it & 63, PART_O, PART_L, SEL, MIX, L, tid);
        DIAG_STAMP(17);
    }
    }
    SEAM(4);
#if (REP_MASK >> 5) & 1
    if (IN(5)) {
        pg8::Gemm g{MIX, Wout_t, MT, DM, DM}; pg8::StaticOrder S; S.init(MT, DM, G, bx);
        pg8::EpiRes<false> E{x, XB, RSQ};
        pg8::gemm_phase<pg8::EpiRes<false>, pg8::StaticOrder, true, true>((PG8_LAS unsigned char*)lds, g, S, E, MKTID());
    }
    asm volatile("" ::: "memory");
#endif
    if (IN(5)) {
        pg8::Gemm g{MIX, Wout_t, MT, DM, DM}; pg8::StaticOrder S; S.init(MT, DM, G, bx);
        pg8::EpiResXN E{XN, RS0, attn_norm, XB, RSQ};
        pg8::gemm_phase<pg8::EpiResXN, pg8::StaticOrder, true, true>((PG8_LAS unsigned char*)lds, g, S, E, MKTID());
    }
    SEAM(5);
#if (REP_MASK >> 6) & 1
    if (IN(6)) {
        pg8::Gemm g{XB, Wug_t, MT, 2 * FF, DM}; pg8::StaticOrder S; S.init(MT, 2 * FF, G, bx);
        pg8::EpiUG E{ACT, RSQ, conv_w, conv_b, UL, UF, GF};
        pg8::gemm_phase<pg8::EpiUG, pg8::StaticOrder, true, true>((PG8_LAS unsigned char*)lds, g, S, E, MKTID());
    }
    asm volatile("" ::: "memory");
#endif
    if (IN(6)) {
        pg8::Gemm g{XB, Wug_t, MT, 2 * FF, DM}; pg8::StaticOrder S; S.init(MT, 2 * FF, G, bx);
        pg8::EpiUG E{ACT, RSQ, conv_w, conv_b, UL, UF, GF};
        pg8::gemm_phase<pg8::EpiUG, pg8::StaticOrder, true, true>((PG8_LAS unsigned char*)lds, g, S, E, MKTID());
    }
    SEAM(6);
#if (REP_MASK >> 7) & 1
    for (int rep = 0; rep < 2; ++rep)
#endif
    if (IN(7)) {
        const size_t gt = (size_t)vcu * NTHREADS + tid, GT = (size_t)G * NTHREADS;
        for (size_t i = gt; i < (size_t)512 * 2 * (FF / 4); i += GT) {
            const int c = (int)(i % (FF / 4)) * 4, r = (int)((i / (FF / 4)) & 1), g64 = (int)(i / (FF / 4) / 2);
            const bool first = (g64 & 255) == 0; const size_t pg = first ? 0 : (size_t)(g64 - 1);
            const pg8::f32x4 q0 = *(const pg8::f32x4*)(UL + (pg * 2 + 0) * FF + c), q1 = *(const pg8::f32x4*)(UL + (pg * 2 + 1) * FF + c);
            const pg8::f32x4 f0 = *(const pg8::f32x4*)(UF + ((size_t)g64 * 2 + 0) * FF + c), f1 = *(const pg8::f32x4*)(UF + ((size_t)g64 * 2 + 1) * FF + c);
            const pg8::f32x4 gg = *(const pg8::f32x4*)(GF + ((size_t)g64 * 2 + r) * FF + c);
            const pg8::f32x4 w0 = *(const pg8::f32x4*)(conv_w + c), w1 = *(const pg8::f32x4*)(conv_w + FF + c), w2 = *(const pg8::f32x4*)(conv_w + 2 * FF + c), cb = *(const pg8::f32x4*)(conv_b + c);
            const float z = first ? 0.f : 1.f;
            const pg8::f32x4 p0 = q0 * z, p1 = q1 * z;
            const pg8::f32x4 u2 = r == 0 ? p0 : p1, u1 = r == 0 ? p1 : f0, u0 = r == 0 ? f0 : f1;
            const pg8::f32x4 y = cb + w0 * u2 + w1 * u1 + w2 * u0;
            ushort4 o; o.x = f2bf(gelu_tanh(y[0]) * gg[0]); o.y = f2bf(gelu_tanh(y[1]) * gg[1]); o.z = f2bf(gelu_tanh(y[2]) * gg[2]); o.w = f2bf(gelu_tanh(y[3]) * gg[3]);
            *(ushort4*)(ACT + ((size_t)g64 * 64 + r) * FF + c) = o;
        }
        { int kk = PLED; asm volatile("" : "+s"(kk)); pg8::Gemm g{PB, Wple_t, MT, DM, kk}; pg8::StaticOrder S; S.init(MT, DM, G, bx); pg8::EpiStore E{PW};
          pg8::gemm_phase<pg8::EpiStore, pg8::StaticOrder, true, true>((PG8_LAS unsigned char*)lds, g, S, E, MKTID()); }
    }
    SEAM(7);
#if (REP_MASK >> 8) & 1
    if (IN(8)) {
        pg8::Gemm g{ACT, Wdown_t, MT, DM, FF}; pg8::StaticOrder S; S.init(MT, DM, G, bx);
        pg8::EpiRes<true, false> E{nullptr, XB, RSQ + (size_t)MT * 16};
        pg8::gemm_phase<pg8::EpiRes<true, false>, pg8::StaticOrder, true, true>((PG8_LAS unsigned char*)lds, g, S, E, MKTID());
    }
    asm volatile("" ::: "memory");
#endif
    if (IN(8)) {
        pg8::Gemm g{ACT, Wdown_t, MT, DM, FF}; pg8::StaticOrder S; S.init(MT, DM, G, bx);
        pg8::EpiRes<true> E{nullptr, XB, RSQ + (size_t)MT * 16};
        pg8::gemm_phase<pg8::EpiRes<true>, pg8::StaticOrder, true, true>((PG8_LAS unsigned char*)lds, g, S, E, MKTID());
    }
    SEAM(8);
#if (REP_MASK >> 9) & 1
    if (IN(9)) {
        if (REP_SUB & 1) { int kk = PLED; asm volatile("" : "+s"(kk)); pg8::Gemm g{PB, Wple_t, MT, DM, kk}; pg8::StaticOrder S; S.init(MT, DM, G, bx); pg8::EpiStore E{PW};
          pg8::gemm_phase<pg8::EpiStore, pg8::StaticOrder, true, true>((PG8_LAS unsigned char*)lds, g, S, E, MKTID()); }
        if (REP_SUB & 2) { int kk = DM; const bf16_t* a_ = XB; const bf16_t* b_ = Wpg_t; asm volatile("" : "+s"(kk), "+s"(a_), "+s"(b_) :: "memory"); pg8::Gemm g{a_, b_, MT, DM, kk}; pg8::StaticOrder S; S.init(MT, DM, G, bx); pg8::EpiPleNorm E{out, XB, PW, RSQ + (size_t)MT * 16, RSQ + (size_t)2 * MT * 16, (unsigned*)(ws + WS_CTL) + CW_PANEL, final_norm, DIAG_DTS(bx)};
          pg8::gemm_phase<pg8::EpiPleNorm, pg8::StaticOrder, true, true>((PG8_LAS unsigned char*)lds, g, S, E, MKTID()); }
    }
    asm volatile("" ::: "memory");
#endif
    if (IN(9)) {
        DIAG_STAMP(20);
        { int kk = DM; const bf16_t* a_ = XB; const bf16_t* b_ = Wpg_t; asm volatile("" : "+s"(kk), "+s"(a_), "+s"(b_) :: "memory"); pg8::Gemm g{a_, b_, MT, DM, kk}; pg8::StaticOrder S; S.init(MT, DM, G, bx); pg8::EpiPleNorm E{out, XB, PW, RSQ + (size_t)MT * 16, RSQ + (size_t)2 * MT * 16, (unsigned*)(ws + WS_CTL) + CW_PANEL, final_norm, DIAG_DTS(bx)};
          pg8::gemm_phase<pg8::EpiPleNorm, pg8::StaticOrder, true, true>((PG8_LAS unsigned char*)lds, g, S, E, MKTID()); }
    }
    SEAM(9);
    if (IN(10)) {
        const float* rsq = RSQ + (size_t)2 * MT * 16;
        for (int m = gw; m < MT; m += NGW) {
            const float rs = pg8::rs16(rsq + (size_t)m * 16); float4* xr = (float4*)(out + (size_t)m * DM);
#pragma unroll
            for (int j = 0; j < 4; ++j) { float4 v = xr[lane + 64 * j]; const float4 gg = ((const float4*)final_norm)[lane + 64 * j];
                v.x *= rs * gg.x; v.y *= rs * gg.y; v.z *= rs * gg.z; v.w *= rs * gg.w; xr[lane + 64 * j] = v; }
        }
    }
#if DIAG_K >= 0
    xcd_barrier(xbar); DIAG_STAMP(11);
    xcd_barrier(xbar);
    { const unsigned long long t0 = __hip_atomic_load(dts + 0, __ATOMIC_RELAXED, __HIP_MEMORY_SCOPE_AGENT), t1 = __hip_atomic_load(dts + 11, __ATOMIC_RELAXED, __HIP_MEMORY_SCOPE_AGENT);
      const unsigned long long ta = __hip_atomic_load(dts + (DIAG_K == 99 ? DIAG_A : DIAG_K), __ATOMIC_RELAXED, __HIP_MEMORY_SCOPE_AGENT), tb = DIAG_K == 99 ? __hip_atomic_load(dts + DIAG_B, __ATOMIC_RELAXED, __HIP_MEMORY_SCOPE_AGENT) : (DIAG_K == 9 ? t1 : __hip_atomic_load(dts + DIAG_K + 1, __ATOMIC_RELAXED, __HIP_MEMORY_SCOPE_AGENT));
      const float eps = (float)(tb - ta) / (float)(t1 - t0);
      const float sc = 1.0f + DIAG_SCALE * eps;
      float4* o4 = (float4*)out; const size_t gt = (size_t)vcu * NTHREADS + tid, GT = (size_t)G * NTHREADS;
      for (size_t i = gt; i < (size_t)MT * DM / 4; i += GT) { float4 v = o4[i]; v.x *= sc; v.y *= sc; v.z *= sc; v.w *= sc; o4[i] = v; } }
#endif
#undef IN
#undef SEAM
#undef tid
#undef lane
}

#ifndef BUILD_MODE
#define BUILD_MODE 0
#endif
static int g_grid = 0;
static void launch_mega(Args a, int lo, int hi, hipStream_t stream) {
    a.ph_lo = lo; a.ph_hi = hi; void* args[] = {&a};
    hipError_t e = hipLaunchCooperativeKernel((const void*)mega, dim3(g_grid), dim3(NTHREADS), args, LDS_BYTES, stream);
    if (e != hipSuccess) fprintf(stderr, "cooperative launch [%d,%d) failed: %s (grid %d)\n", lo, hi, hipGetErrorString(e), g_grid);
}
extern "C" void kernel_launch(void* const* d_in, const int* in_sizes, int n_in, void* d_out, int out_size, void* d_ws, size_t ws_size, hipStream_t stream) {
    if (n_in != 16 || out_size != MT * DM || ws_size < WS_END) { fprintf(stderr, "kernel_launch: unexpected shapes (n_in %d out %d ws %zu)\n", n_in, out_size, ws_size); return; }
    if (g_grid == 0) {
        int dev = 0, cus = 0, per_cu = 0;
        hipGetDevice(&dev); hipDeviceGetAttribute(&cus, hipDeviceAttributeMultiprocessorCount, dev);
        hipFuncSetAttribute((const void*)mega, hipFuncAttributeMaxDynamicSharedMemorySize, LDS_BYTES);
        hipOccupancyMaxActiveBlocksPerMultiprocessor(&per_cu, (const void*)mega, NTHREADS, LDS_BYTES);
        if (per_cu < 1) { fprintf(stderr, "occupancy query says %d blocks/CU\n", per_cu); per_cu = 1; }
        g_grid = cus * 1;
        (void)hipGetLastError();
    }
    unsigned char* ws = (unsigned char*)d_ws;
    hipMemsetAsync(ws + WS_CTL, 0, CTL_ZERO_BYTES, stream);
    Args a{}; for (int i = 0; i < 16; ++i) a.in[i] = (const float*)d_in[i]; a.out = (float*)d_out; a.ws = ws;

    a.flags = 0; launch_mega(a, 0, NPH, stream);
}
```

```cpp
#include <hip/hip_runtime.h>
#include <stdint.h>
#include <math.h>
#include <cstdio>

typedef unsigned short bf16_t;
typedef unsigned int u32;

constexpr int BATCH = 2, SEQ = 16384, MT = BATCH * SEQ, DM = 1024, NPROJ = 3584, FF = 2816, PLED = 256;
constexpr int MH = 8, MD = 64, RH = 4, RD = 128, NBLK = 64, BLK = 256;
constexpr int C_MQ = 0, C_MK = 512, C_MV = 1024, C_RQ = 1536, C_RK = 2048, C_RV = 2560, C_RG = 3072;
constexpr float RMS_EPS = 1e-6f, GN_EPS = 1e-5f;
constexpr float LOG2E = 1.4426950408889634f;
constexpr float QSCALE = 0.125f * LOG2E;
constexpr float RKSCALE = 0.08838834764831845f;
constexpr size_t SEC = (size_t)MT * 512;

constexpr size_t MiB = (size_t)1 << 20;
constexpr size_t WS_CTL = 0, WS_WIN = 1 * MiB, WS_WOUT = 8 * MiB, WS_WUG = 10 * MiB, WS_WDOWN = 21 * MiB, WS_WPG = 27 * MiB, WS_WPLE = 29 * MiB;
constexpr size_t WS_RSQ = 30 * MiB;
constexpr size_t WS_PB = 36 * MiB;
constexpr size_t WS_R2 = 52 * MiB;
constexpr size_t WS_R1 = 116 * MiB;
constexpr size_t WS_SEG = 180 * MiB;
constexpr size_t WS_KVT = 212 * MiB;
constexpr size_t WS_STT = 244 * MiB;
constexpr size_t WS_PARTL = 260 * MiB;
constexpr size_t WS_SEL = 264 * MiB;
constexpr size_t WS_CNT = 265 * MiB;
constexpr size_t WS_KMEAN = WS_CNT + 512 * 1024;
constexpr size_t WS_PROJ = 266 * MiB;
constexpr size_t WS_END = 490 * MiB;
constexpr size_t WS_UH = 116 * MiB;

__device__ __forceinline__ float bf2f(bf16_t v) { return __uint_as_float(((u32)v) << 16); }
__device__ __forceinline__ bf16_t f2bf(float f) { u32 u = __float_as_uint(f); return (bf16_t)((u + 0x7fffu + ((u >> 16) & 1u)) >> 16); }
__device__ __forceinline__ float wave_sum(float v) {
#pragma unroll
    for (int o = 1; o < 64; o <<= 1) v += __shfl_xor(v, o);
    return v;
}
__device__ __forceinline__ float rs_from(const float* p) {
    float s = 0.f;
#pragma unroll
    for (int i = 0; i < 16; ++i) s += p[i];
    return rsqrtf(s * (1.0f / DM) + RMS_EPS);
}
__device__ __forceinline__ float gelu_tanh(float x) {
    const float z = 0.7978845608028654f * (x + 0.044715f * x * x * x);
    return x / (1.0f + __expf(-2.0f * z));
}
__device__ __forceinline__ float sigmoidf_(float x) { return 1.0f / (1.0f + __expf(-x)); }


typedef unsigned u32x4_g __attribute__((ext_vector_type(4)));
__device__ __forceinline__ void wt_store16(void* base_uniform, size_t byte_off, u32x4_g v) {
    __builtin_amdgcn_raw_buffer_store_b128(v, __builtin_amdgcn_make_buffer_rsrc(base_uniform, 0, 0x7ffffff0, 0x00020000), (int)byte_off, 0, 16);
}
namespace pg8 {
#define PG8_LAS __attribute__((address_space(3)))
typedef unsigned short bf16_t;
typedef short bf16x8 __attribute__((ext_vector_type(8)));
typedef float f32x4 __attribute__((ext_vector_type(4)));
typedef unsigned u32x4 __attribute__((ext_vector_type(4)));
constexpr int BM = 256, BK = 64, HALF = 128, HTB = HALF * BK * 2  , STAGE_BYTES = 8 * HTB, NXCD = 8, WGM = 8;

__host__ __device__ __forceinline__ int lds_byte(int r, int c) { const int st = (r >> 4) * 2 + (c >> 5), rr = r & 15, cc = c & 31, ob = rr * 64 + cc * 2; return st * 1024 + (ob ^ (((ob >> 9) & 1) << 5)); }
__host__ __device__ __forceinline__ void stage_rc(int b, int& R, int& C) { const int st = b / 1024, sb = b % 1024, swz = sb ^ (((sb >> 9) & 1) << 5); R = (st >> 1) * 16 + swz / 64; C = (st & 1) * 32 + (swz % 64) / 2; }
__host__ __device__ __forceinline__ int perm32(int rho) { const int n = rho >> 4, i = rho & 15; return 8 * (i >> 2) + 4 * n + (i & 3); }

struct Unit { int pm, pn; };
struct Gemm { const bf16_t* A; const bf16_t* Bt; int M, N, K; };

struct StaticOrder {
    int nM, nN, nwg, G, c;
    __host__ __device__ void init(int M, int N, int G_, int c_) { nM = M / BM; nN = N / BM; nwg = nM * nN; G = G_; c = c_; }
    __host__ __device__ bool next(int i, Unit& u) const {
        const long L = (long)i * G + c; if (L >= nwg) return false;
        int wgid = (int)L; { const int q = nwg / NXCD, r = nwg % NXCD, xcd = wgid % NXCD, off = wgid / NXCD; wgid = (xcd < r ? xcd * (q + 1) : r * (q + 1) + (xcd - r) * q) + off; }
        const int nig = WGM * nN, gid = wgid / nig, fm = gid * WGM, gsz = (nM - fm) < WGM ? (nM - fm) : WGM;
        u.pm = fm + ((wgid % nig) % gsz); u.pn = (wgid % nig) / gsz; return true;
    }
    __device__ __forceinline__ void a_ready(const Unit&) const {}
    __device__ __forceinline__ void done(const Unit&) const {}
};

__device__ __forceinline__ unsigned cvt_pk_bf16(float lo, float hi) { unsigned r; asm volatile("v_cvt_pk_bf16_f32 %0, %1, %2" : "=v"(r) : "v"(lo), "v"(hi)); return r; }
typedef float f32x2 __attribute__((ext_vector_type(2)));
template <class Epi, class Sched, bool ALIGN_EPI = false, bool SP2 = false>
__device__ __forceinline__ void gemm_phase(PG8_LAS unsigned char* lds, const Gemm g, const Sched& S, const Epi& E, const int tid_in) {
    const int tid = tid_in, wid = __builtin_amdgcn_readfirstlane(tid >> 6), lane = tid & 63, wr = wid >> 2, wc = wid & 3, fr = lane & 15, fq = lane >> 4;
    const int K = g.K, nt = K / BK;
    unsigned voffA[2], voffB[2];
#pragma unroll
    for (int i = 0; i < 2; ++i) { int R, C; stage_rc(tid * 16 + i * 8192, R, C); const int Rb = Epi::PERM ? ((R & ~31) + perm32(R & 31)) : R;
        voffA[i] = (unsigned)(R * K + C) * 2u; voffB[i] = (unsigned)(Rb * K + C) * 2u; }
    const size_t kstep = (size_t)(BK * 2);
    const size_t hstep = (size_t)HALF * K * 2;
    const size_t tstep = 2 * hstep;
    const unsigned ldsw = (unsigned)wid * 1024u;
    const int aoff = lds_byte(wr * 64 + fr, fq * 8), boff = lds_byte(wc * 32 + fr, fq * 8);
#define PG8_SA(b, h) (((b) * 2 + (h)) * HTB)
#define PG8_SB(b, h) ((4 + (b) * 2 + (h)) * HTB)
#define PG8_STAGE(bufoff, gbase, voff) do { _Pragma("unroll") for (int _i = 0; _i < 2; ++_i) \
        __builtin_amdgcn_global_load_lds((const unsigned*)((const char*)(gbase) + (voff)[_i]), (PG8_LAS unsigned*)(lds + (bufoff) + ldsw + _i * 8192), 16, 0, 0); } while (0)
#define PG8_LDA(dst, b, h) do { _Pragma("unroll") for (int m = 0; m < 4; ++m) _Pragma("unroll") for (int k = 0; k < 2; ++k) dst[m][k] = *(const PG8_LAS bf16x8*)(lds + PG8_SA(b, h) + aoff + m * 2048 + k * 1024); } while (0)
#define PG8_LDB(dst, b, h) do { _Pragma("unroll") for (int n = 0; n < 2; ++n) _Pragma("unroll") for (int k = 0; k < 2; ++k) dst[n][k] = *(const PG8_LAS bf16x8*)(lds + PG8_SB(b, h) + boff + n * 2048 + k * 1024); } while (0)
#define PG8_MMA(ai, bj, At, Bt) do { __builtin_amdgcn_s_setprio(1); _Pragma("unroll") for (int m = 0; m < 4; ++m) _Pragma("unroll") for (int n = 0; n < 2; ++n) _Pragma("unroll") for (int k = 0; k < 2; ++k) \
        acc[ai][bj][m][n] = __builtin_amdgcn_mfma_f32_16x16x32_bf16(Bt[n][k], At[m][k], acc[ai][bj][m][n], 0, 0, 0); __builtin_amdgcn_s_setprio(0); } while (0)
#define PG8_WAIT_V(n) asm volatile("s_waitcnt vmcnt(" #n ")" ::: "memory")
#define PG8_WAIT_L(n) asm volatile("s_waitcnt lgkmcnt(" #n ")" ::: "memory")
#define PG8_BAR __builtin_amdgcn_s_barrier()
#define PG8_SCHED __builtin_amdgcn_sched_barrier(0)
    Unit cur, nxt; int ui = 0;
    if (!S.next(0, cur)) return;
    f32x4 acc[2][2][4][2];
#pragma unroll
    for (int a = 0; a < 2; ++a)
#pragma unroll
        for (int b = 0; b < 2; ++b)
#pragma unroll
            for (int m = 0; m < 4; ++m)
#pragma unroll
                for (int n = 0; n < 2; ++n) acc[a][b][m][n] = (f32x4){0.f, 0.f, 0.f, 0.f};
    bf16x8 At[4][2], B0[2][2], B1[2][2];
    const char* cA = (const char*)g.A + (size_t)cur.pm * tstep; const char* cB = (const char*)g.Bt + (size_t)cur.pn * tstep;
    S.a_ready(cur);
    if constexpr (SP2) {
        PG8_STAGE(PG8_SB(0, 0), cB, voffB); PG8_STAGE(PG8_SB(0, 1), cB + hstep, voffB); PG8_STAGE(PG8_SA(0, 0), cA, voffA); PG8_STAGE(PG8_SA(0, 1), cA + hstep, voffA);
        if (wr == 1) PG8_BAR;
        PG8_WAIT_V(2); PG8_BAR;
        PG8_STAGE(PG8_SB(1, 0), cB + kstep, voffB); PG8_STAGE(PG8_SA(1, 0), cA + kstep, voffA); PG8_STAGE(PG8_SB(1, 1), cB + hstep + kstep, voffB);
        PG8_WAIT_V(6); PG8_BAR;
    } else {
        PG8_STAGE(PG8_SB(0, 0), cB, voffB); PG8_STAGE(PG8_SA(0, 0), cA, voffA); PG8_STAGE(PG8_SB(0, 1), cB + hstep, voffB); PG8_STAGE(PG8_SA(0, 1), cA + hstep, voffA);
        if (wr == 1) PG8_BAR;
        PG8_WAIT_V(4); PG8_BAR;
        PG8_STAGE(PG8_SB(1, 0), cB + kstep, voffB); PG8_STAGE(PG8_SA(1, 0), cA + kstep, voffA); PG8_STAGE(PG8_SB(1, 1), cB + hstep + kstep, voffB);
        PG8_WAIT_V(6); PG8_BAR;
    }
    for (;;) {
        const bool has_next = S.next(ui + 1, nxt);
        const char* nA = has_next ? (const char*)g.A + (size_t)nxt.pm * tstep : cA; const char* nB = has_next ? (const char*)g.Bt + (size_t)nxt.pn * tstep : cB;
        for (int t = 0; t < nt; t += 2) {
            const bool last = (t == nt - 2);
            const char* a1 = cA + (size_t)(t + 1) * kstep;
            const char* a2 = last ? nA : cA + (size_t)(t + 2) * kstep; const char* b2 = last ? nB : cB + (size_t)(t + 2) * kstep;
            const char* a3 = a2 + kstep; const char* b3 = b2 + kstep;
            if (last && has_next) S.a_ready(nxt);
            if constexpr (SP2) {
            PG8_LDB(B0, 0, 0); PG8_LDB(B1, 0, 1); PG8_SCHED; PG8_LDA(At, 0, 0); PG8_STAGE(PG8_SA(1, 1), a1 + hstep, voffA);
            PG8_WAIT_V(8); PG8_WAIT_L(0); PG8_BAR; PG8_MMA(0, 0, At, B0); PG8_MMA(0, 1, At, B1); PG8_BAR; PG8_SCHED;
            PG8_LDA(At, 0, 1); PG8_STAGE(PG8_SB(0, 0), b2, voffB); PG8_STAGE(PG8_SB(0, 1), b2 + hstep, voffB); PG8_STAGE(PG8_SA(0, 0), a2, voffA);
            PG8_WAIT_V(8); PG8_WAIT_L(0); PG8_BAR; PG8_MMA(1, 0, At, B0); PG8_MMA(1, 1, At, B1); PG8_BAR; PG8_SCHED;
            PG8_LDB(B0, 1, 0); PG8_LDB(B1, 1, 1); PG8_SCHED; PG8_LDA(At, 1, 0); PG8_STAGE(PG8_SA(0, 1), a2 + hstep, voffA);
            PG8_WAIT_V(8); PG8_WAIT_L(0); PG8_BAR; PG8_MMA(0, 0, At, B0); PG8_MMA(0, 1, At, B1); PG8_BAR; PG8_SCHED;
            PG8_LDA(At, 1, 1); PG8_STAGE(PG8_SB(1, 0), b3, voffB); PG8_STAGE(PG8_SB(1, 1), b3 + hstep, voffB); PG8_STAGE(PG8_SA(1, 0), a3, voffA);
            PG8_WAIT_V(8); PG8_WAIT_L(0); PG8_BAR; PG8_MMA(1, 0, At, B0); PG8_MMA(1, 1, At, B1); PG8_BAR; PG8_SCHED;
            } else {
            PG8_LDB(B0, 0, 0); PG8_SCHED; PG8_LDA(At, 0, 0); PG8_STAGE(PG8_SA(1, 1), a1 + hstep, voffA);
            PG8_WAIT_L(8); PG8_BAR; PG8_WAIT_L(0); PG8_MMA(0, 0, At, B0); PG8_BAR; PG8_SCHED;
            PG8_LDB(B1, 0, 1); PG8_STAGE(PG8_SB(0, 0), b2, voffB);
            PG8_BAR; PG8_WAIT_L(0); PG8_MMA(0, 1, At, B1); PG8_BAR;
            PG8_LDA(At, 0, 1); PG8_STAGE(PG8_SA(0, 0), a2, voffA);
            PG8_BAR; PG8_WAIT_L(0); PG8_MMA(1, 0, At, B0); PG8_BAR; PG8_SCHED;
            PG8_STAGE(PG8_SB(0, 1), b2 + hstep, voffB);
            PG8_WAIT_V(6); PG8_BAR; PG8_MMA(1, 1, At, B1); PG8_BAR;
            PG8_LDB(B0, 1, 0); PG8_SCHED; PG8_LDA(At, 1, 0); PG8_STAGE(PG8_SA(0, 1), a2 + hstep, voffA);
            PG8_WAIT_L(8); PG8_BAR; PG8_WAIT_L(0); PG8_MMA(0, 0, At, B0); PG8_BAR; PG8_SCHED;
            PG8_LDB(B1, 1, 1); PG8_STAGE(PG8_SB(1, 0), b3, voffB);
            PG8_BAR; PG8_WAIT_L(0); PG8_MMA(0, 1, At, B1); PG8_BAR;
            PG8_LDA(At, 1, 1); PG8_STAGE(PG8_SA(1, 0), a3, voffA);
            PG8_BAR; PG8_WAIT_L(0); PG8_MMA(1, 0, At, B0); PG8_BAR; PG8_SCHED;
            PG8_STAGE(PG8_SB(1, 1), b3 + hstep, voffB);
            PG8_WAIT_V(6); PG8_BAR; PG8_MMA(1, 1, At, B1); PG8_BAR;
            }
        }
        if constexpr (ALIGN_EPI) { if (wr == 0) PG8_BAR; }
        if constexpr (!Epi::AFTER_DRAIN) { E(acc, cur, wr, wc, fr, fq); S.done(cur); }
        if (!has_next) break;
#pragma unroll
        for (int a = 0; a < 2; ++a)
#pragma unroll
            for (int b = 0; b < 2; ++b)
#pragma unroll
                for (int m = 0; m < 4; ++m)
#pragma unroll
                    for (int n = 0; n < 2; ++n) acc[a][b][m][n] = (f32x4){0.f, 0.f, 0.f, 0.f};
        cur = nxt; cA = nA; cB = nB; ++ui;
        if constexpr (ALIGN_EPI) { if (wr == 1) PG8_BAR; }
    }
    PG8_WAIT_V(0);
    if constexpr (!ALIGN_EPI) { if (wr == 0) PG8_BAR; }
    PG8_BAR;
    if constexpr (Epi::AFTER_DRAIN) { E.fused(acc, cur, wr, wc, fr, fq, lds, wid, lane); S.done(cur); }
#undef PG8_SA
#undef PG8_SB
#undef PG8_STAGE
#undef PG8_LDA
#undef PG8_LDB
#undef PG8_MMA
#undef PG8_WAIT_V
#undef PG8_WAIT_L
#undef PG8_BAR
#undef PG8_SCHED
}
}
namespace pg8 {
__device__ __forceinline__ u32x4 pack8(f32x4 v0, f32x4 v1) { u32x4 w; w.x = cvt_pk_bf16(v0[0], v0[1]); w.y = cvt_pk_bf16(v0[2], v0[3]); w.z = cvt_pk_bf16(v1[0], v1[1]); w.w = cvt_pk_bf16(v1[2], v1[3]); return w; }
__device__ __forceinline__ float dot4(f32x4 a) { return (a[0] * a[0] + a[1] * a[1]) + (a[2] * a[2] + a[3] * a[3]); }
__device__ __forceinline__ float rs16(const float* p) { const f32x4 a = *(const f32x4*)p, b = *(const f32x4*)(p + 4), c = *(const f32x4*)(p + 8), d = *(const f32x4*)(p + 12);
    const float s = ((a[0] + a[1]) + (a[2] + a[3])) + ((b[0] + b[1]) + (b[2] + b[3])) + ((c[0] + c[1]) + (c[2] + c[3])) + ((d[0] + d[1]) + (d[2] + d[3])); return rsqrtf(s * (1.0f / DM) + RMS_EPS); }

__device__ __forceinline__ float frcp(float x) { return __builtin_amdgcn_rcpf(x); }
__device__ __forceinline__ float fsigmoid(float x) { return frcp(1.0f + __builtin_amdgcn_exp2f(-1.4426950408889634f * x)); }
__device__ __forceinline__ float gelu_fast(float x) { const float z2 = 2.302208198f * (x + 0.044715f * x * x * x); return x * frcp(1.0f + __builtin_amdgcn_exp2f(-z2)); }
__device__ __forceinline__ void rs8(const float* rsq, int row0, int fq, float (&rs)[2][4]) {
    f32x4 pv[2][4];
#pragma unroll
    for (int ai = 0; ai < 2; ++ai)
#pragma unroll
        for (int m = 0; m < 4; ++m) pv[ai][m] = *(const f32x4*)(rsq + (size_t)(row0 + ai * HALF + m * 16) * 16 + 4 * fq);
#pragma unroll
    for (int ai = 0; ai < 2; ++ai)
#pragma unroll
        for (int m = 0; m < 4; ++m) { float s = (pv[ai][m][0] + pv[ai][m][1]) + (pv[ai][m][2] + pv[ai][m][3]); s += __shfl_xor(s, 16); s += __shfl_xor(s, 32); rs[ai][m] = rsqrtf(s * (1.0f / DM) + RMS_EPS); }
}
#define DPP_ROT(src, ctrl) __uint_as_float((unsigned)__builtin_amdgcn_mov_dpp((int)__float_as_uint(src), (ctrl), 0xF, 0xF, true))
#define DPP_MOV(old, src, ctrl) __uint_as_float((unsigned)__builtin_amdgcn_update_dpp((int)__float_as_uint(old), (int)__float_as_uint(src), (ctrl), 0xF, 0xF, false))

struct EpiProj {
    static constexpr bool PERM = true, AFTER_DRAIN = false;
    bf16_t* O; float* kmsum; unsigned* kmx;
    __device__ __forceinline__ void operator()(const f32x4 (&acc)[2][2][4][2], const Unit& u, int wr, int wc, int fr, int fq) const {
        const int colt = u.pn * BM;
        const float sc = colt < C_MK ? QSCALE : ((colt >= C_RK && colt < C_RV) ? RKSCALE : 1.0f);
        const int row0 = u.pm * BM + wr * 64 + fr, sec = colt >> 9, b = u.pm >> 6;
        bf16_t* sbase = O + (size_t)sec * SEC;
#pragma unroll
        for (int bj = 0; bj < 2; ++bj) { const int c = (colt & 511) + bj * HALF + wc * 32 + 8 * fq;
            bf16_t* hb = sec < 3 ? sbase + ((size_t)(b * 8 + (c >> 6)) * SEQ) * 64 + (c & 63) : sbase + ((size_t)(b * 4 + (c >> 7)) * SEQ) * 128 + (c & 127);
            const int pitch = sec < 3 ? 64 : 128;
#pragma unroll
            for (int ai = 0; ai < 2; ++ai)
#pragma unroll
                for (int m = 0; m < 4; ++m) { const int t = (row0 + ai * HALF + m * 16) & (SEQ - 1);
                    *(u32x4*)(hb + (size_t)t * pitch) = pack8(acc[ai][bj][m][0] * sc, acc[ai][bj][m][1] * sc); } }
        if (colt >= C_MK && colt < C_MV) {
            const int bh0 = (u.pm >> 6) * 8, blk = u.pm & 63;
#pragma unroll
            for (int bj = 0; bj < 2; ++bj)
#pragma unroll
                for (int n = 0; n < 2; ++n)
#pragma unroll
                    for (int j = 0; j < 4; ++j) { float s = 0.f;
#pragma unroll
                        for (int ai = 0; ai < 2; ++ai)
#pragma unroll
                            for (int m = 0; m < 4; ++m) s += acc[ai][bj][m][n][j];
                        s += __shfl_xor(s, 1); s += __shfl_xor(s, 2); s += __shfl_xor(s, 4); s += __shfl_xor(s, 8);
                        if (fr == 0) { const int c = colt - C_MK + bj * HALF + wc * 32 + 8 * fq + 4 * n + j; atomicAdd(kmsum + ((size_t)(bh0 + (c >> 6)) * 64 + blk) * 64 + (c & 63), s); } }
#pragma unroll
            for (int bj = 0; bj < 2; ++bj) { float mxk = 0.f;
#pragma unroll
                for (int ai = 0; ai < 2; ++ai)
#pragma unroll
                    for (int m = 0; m < 4; ++m) { float q2 = dot4(acc[ai][bj][m][0]) + dot4(acc[ai][bj][m][1]); q2 += __shfl_xor(q2, 16); q2 += __shfl_xor(q2, 32); mxk = fmaxf(mxk, q2); }
                mxk = fmaxf(mxk, __shfl_xor(mxk, 1)); mxk = fmaxf(mxk, __shfl_xor(mxk, 2)); mxk = fmaxf(mxk, __shfl_xor(mxk, 4)); mxk = fmaxf(mxk, __shfl_xor(mxk, 8));
                if (fr == 0 && fq == 0) { const int hd = (colt - C_MK + bj * HALF + wc * 32) >> 6; atomicMax(kmx + ((size_t)(bh0 + hd) * 64 + blk) * 2 + (wc & 1), __float_as_uint(mxk)); } }
        }
    }
};
struct EpiStore {
    static constexpr bool PERM = true, AFTER_DRAIN = false;
    bf16_t* O;
    __device__ __forceinline__ void operator()(const f32x4 (&acc)[2][2][4][2], const Unit& u, int wr, int wc, int fr, int fq) const {
        const int row0 = u.pm * BM + wr * 64 + fr, col0 = u.pn * BM + wc * 32 + 8 * fq;
#pragma unroll
        for (int ai = 0; ai < 2; ++ai)
#pragma unroll
            for (int m = 0; m < 4; ++m) { bf16_t* rowp = O + (size_t)(row0 + ai * HALF + m * 16) * DM + col0;
#pragma unroll
                for (int bj = 0; bj < 2; ++bj) *(u32x4*)(rowp + bj * HALF) = pack8(acc[ai][bj][m][0], acc[ai][bj][m][1]); }
    }
};
template <bool BF, bool WR = true> struct EpiRes {
    static constexpr bool PERM = true, AFTER_DRAIN = false;
    const float* base; bf16_t* xb; float* rsq;
    __device__ __forceinline__ void operator()(const f32x4 (&acc)[2][2][4][2], const Unit& u, int wr, int wc, int fr, int fq) const {
        const int row0 = u.pm * BM + wr * 64 + fr, col0 = u.pn * BM + wc * 32 + 8 * fq;
        if constexpr (BF) {
            u32x4 pv[8][2];
#define ERB_LOAD(g) do { _Pragma("unroll") for (int bj = 0; bj < 2; ++bj) pv[g][bj] = *(const u32x4*)(xb + (size_t)(row0 + ((g) >> 2) * HALF + ((g) & 3) * 16) * DM + col0 + bj * HALF); } while (0)
            ERB_LOAD(0); ERB_LOAD(1); ERB_LOAD(2); ERB_LOAD(3);
#pragma unroll
            for (int g = 0; g < 8; ++g) { const int ai = g >> 2, m = g & 3, row = row0 + ai * HALF + m * 16; float ss = 0.f;
                if (g + 4 < 8) { ERB_LOAD(g + 4); }
                asm volatile("" ::: "memory");
#pragma unroll
                for (int bj = 0; bj < 2; ++bj) { const size_t off = (size_t)row * DM + col0 + bj * HALF; const u32x4 p = pv[g][bj];
                    const f32x4 b0 = {__uint_as_float(p.x << 16), __uint_as_float(p.x & 0xffff0000u), __uint_as_float(p.y << 16), __uint_as_float(p.y & 0xffff0000u)};
                    const f32x4 b1 = {__uint_as_float(p.z << 16), __uint_as_float(p.z & 0xffff0000u), __uint_as_float(p.w << 16), __uint_as_float(p.w & 0xffff0000u)};
                    const f32x4 y0 = b0 + acc[ai][bj][m][0], y1 = b1 + acc[ai][bj][m][1];
                    if (WR) *(u32x4*)(xb + off) = pack8(y0, y1); ss += dot4(y0) + dot4(y1); }
                ss += __shfl_xor(ss, 16); ss += __shfl_xor(ss, 32);
                if (fq == 0) rsq[(size_t)row * 16 + u.pn * 4 + wc] = ss; }
#undef ERB_LOAD
        } else {
            f32x4 bv[8][2][2];
#define ER_LOAD(g) do { _Pragma("unroll") for (int bj = 0; bj < 2; ++bj) { const float* p_ = base + (size_t)(row0 + ((g) >> 2) * HALF + ((g) & 3) * 16) * DM + col0 + bj * HALF; bv[g][bj][0] = *(const f32x4*)p_; bv[g][bj][1] = *(const f32x4*)(p_ + 4); } } while (0)
            ER_LOAD(0); ER_LOAD(1);
#pragma unroll
            for (int g = 0; g < 8; ++g) { const int ai = g >> 2, m = g & 3, row = row0 + ai * HALF + m * 16; float ss = 0.f;
                if (g + 2 < 8) { ER_LOAD(g + 2); }
                asm volatile("" ::: "memory");
#pragma unroll
                for (int bj = 0; bj < 2; ++bj) { const size_t off = (size_t)row * DM + col0 + bj * HALF;
                    const f32x4 y0 = bv[g][bj][0] + acc[ai][bj][m][0], y1 = bv[g][bj][1] + acc[ai][bj][m][1];
                    if (WR) *(u32x4*)(xb + off) = pack8(y0, y1); ss += dot4(y0) + dot4(y1); }
                ss += __shfl_xor(ss, 16); ss += __shfl_xor(ss, 32);
                if (fq == 0) rsq[(size_t)row * 16 + u.pn * 4 + wc] = ss; }
#undef ER_LOAD
        }
    }
};
struct EpiResXN {
    static constexpr bool PERM = true, AFTER_DRAIN = false;
    const bf16_t* xn; const float* rs0; const float* gcol; bf16_t* xb; float* rsq;
    __device__ __forceinline__ void operator()(const f32x4 (&acc)[2][2][4][2], const Unit& u, int wr, int wc, int fr, int fq) const {
        const int row0 = u.pm * BM + wr * 64 + fr, col0 = u.pn * BM + wc * 32 + 8 * fq;
        f32x4 ig[2][2];
#pragma unroll
        for (int bj = 0; bj < 2; ++bj)
#pragma unroll
            for (int n = 0; n < 2; ++n) { const f32x4 g = *(const f32x4*)(gcol + col0 + bj * HALF + 4 * n); ig[bj][n] = (f32x4){frcp(g[0]), frcp(g[1]), frcp(g[2]), frcp(g[3])}; }
        float ir[8];
#pragma unroll
        for (int g = 0; g < 8; ++g) ir[g] = frcp(rs0[row0 + (g >> 2) * HALF + (g & 3) * 16]);
        u32x4 pv[8][2];
#define ERX_LOAD(g) do { _Pragma("unroll") for (int bj = 0; bj < 2; ++bj) pv[g][bj] = *(const u32x4*)(xn + (size_t)(row0 + ((g) >> 2) * HALF + ((g) & 3) * 16) * DM + col0 + bj * HALF); } while (0)
        ERX_LOAD(0); ERX_LOAD(1); ERX_LOAD(2); ERX_LOAD(3);
#pragma unroll
        for (int g = 0; g < 8; ++g) { const int ai = g >> 2, m = g & 3, row = row0 + ai * HALF + m * 16; float ss = 0.f;
            if (g + 4 < 8) { ERX_LOAD(g + 4); }
            asm volatile("" ::: "memory");
#pragma unroll
            for (int bj = 0; bj < 2; ++bj) { const size_t off = (size_t)row * DM + col0 + bj * HALF; const u32x4 p = pv[g][bj];
                const f32x4 b0 = {__uint_as_float(p.x << 16), __uint_as_float(p.x & 0xffff0000u), __uint_as_float(p.y << 16), __uint_as_float(p.y & 0xffff0000u)};
                const f32x4 b1 = {__uint_as_float(p.z << 16), __uint_as_float(p.z & 0xffff0000u), __uint_as_float(p.w << 16), __uint_as_float(p.w & 0xffff0000u)};
                const f32x4 y0 = b0 * ig[bj][0] * ir[g] + acc[ai][bj][m][0], y1 = b1 * ig[bj][1] * ir[g] + acc[ai][bj][m][1];
                *(u32x4*)(xb + off) = pack8(y0, y1); ss += dot4(y0) + dot4(y1); }
            ss += __shfl_xor(ss, 16); ss += __shfl_xor(ss, 32);
            if (fq == 0) rsq[(size_t)row * 16 + u.pn * 4 + wc] = ss; }
#undef ERX_LOAD
    }
};
struct EpiPleNorm {
    static constexpr bool PERM = true, AFTER_DRAIN = false;
    float* out; const bf16_t* xb; const bf16_t* pw; const float* rsq_in; float* rsq_out; unsigned* pcnt; const float* fnorm; unsigned long long* dts;
#define EPN_STAMP(i) do { if (dts && wr == 0 && wc == 0 && fr == 0 && fq == 0) __hip_atomic_store(dts + (i) + 4 * (u.pm >= 64 ? 1 : 0), (unsigned long long)__builtin_amdgcn_s_memrealtime(), __ATOMIC_RELAXED, __HIP_MEMORY_SCOPE_AGENT); } while (0)
    __device__ __forceinline__ void operator()(const f32x4 (&acc_)[2][2][4][2], const Unit& u, int wr, int wc, int fr, int fq) const {
        f32x4 (&acc)[2][2][4][2] = const_cast<f32x4 (&)[2][2][4][2]>(acc_);
        const int row0 = u.pm * BM + wr * 64 + fr, col0 = u.pn * BM + wc * 32 + 8 * fq;
        EPN_STAMP(30);
        float rsv[2][4]; rs8(rsq_in, row0, fq, rsv);
        u32x4 xq[8][2], pq[8][2];
#define EP_LOAD(g) do { _Pragma("unroll") for (int bj = 0; bj < 2; ++bj) { const size_t o_ = (size_t)(row0 + ((g) >> 2) * HALF + ((g) & 3) * 16) * DM + col0 + bj * HALF; xq[g][bj] = *(const u32x4*)(xb + o_); pq[g][bj] = *(const u32x4*)(pw + o_); } } while (0)
        EP_LOAD(0); EP_LOAD(1);
#pragma unroll
        for (int g = 0; g < 8; ++g) { const int ai = g >> 2, m = g & 3, row = row0 + ai * HALF + m * 16; const float rs = rsv[ai][m]; float ss = 0.f;
            if (g + 2 < 8) { EP_LOAD(g + 2); }
            asm volatile("" ::: "memory");
#pragma unroll
            for (int bj = 0; bj < 2; ++bj) {
                const u32x4 pv = pq[g][bj];
                const f32x4 p0 = {__uint_as_float(pv.x << 16), __uint_as_float(pv.x & 0xffff0000u), __uint_as_float(pv.y << 16), __uint_as_float(pv.y & 0xffff0000u)};
                const f32x4 p1 = {__uint_as_float(pv.z << 16), __uint_as_float(pv.z & 0xffff0000u), __uint_as_float(pv.w << 16), __uint_as_float(pv.w & 0xffff0000u)};
                f32x4 g0 = acc[ai][bj][m][0] * rs, g1 = acc[ai][bj][m][1] * rs;
#pragma unroll
                for (int j = 0; j < 4; ++j) { g0[j] = fsigmoid(g0[j]); g1[j] = fsigmoid(g1[j]); }
                const u32x4 xv = xq[g][bj];
                const f32x4 x0 = {__uint_as_float(xv.x << 16), __uint_as_float(xv.x & 0xffff0000u), __uint_as_float(xv.y << 16), __uint_as_float(xv.y & 0xffff0000u)};
                const f32x4 x1 = {__uint_as_float(xv.z << 16), __uint_as_float(xv.z & 0xffff0000u), __uint_as_float(xv.w << 16), __uint_as_float(xv.w & 0xffff0000u)};
                const f32x4 y0 = x0 + p0 * g0, y1 = x1 + p1 * g1;
                acc[ai][bj][m][0] = y0; acc[ai][bj][m][1] = y1; ss += dot4(y0) + dot4(y1); }
            ss += __shfl_xor(ss, 16); ss += __shfl_xor(ss, 32);
            if (fq == 0) __hip_atomic_store((unsigned*)(rsq_out + (size_t)row * 16 + u.pn * 4 + wc), __float_as_uint(ss), __ATOMIC_RELAXED, __HIP_MEMORY_SCOPE_AGENT); }
#undef EP_LOAD
        asm volatile("s_waitcnt vmcnt(0)" ::: "memory");
        EPN_STAMP(31);
        unsigned* pc = pcnt + 16 * u.pm;
        if (fq == 0 && fr == 0) __hip_atomic_fetch_add(pc, 1u, __ATOMIC_RELAXED, __HIP_MEMORY_SCOPE_AGENT);
        for (unsigned spins = 0; spins < (1u << 22); ++spins) {
            if ((unsigned)__builtin_amdgcn_readfirstlane(__hip_atomic_load(pc, __ATOMIC_RELAXED, __HIP_MEMORY_SCOPE_AGENT)) >= 32u) break;
            __builtin_amdgcn_s_sleep(2);
        }
        EPN_STAMP(32);
        f32x4 fn[2][2];
#pragma unroll
        for (int bj = 0; bj < 2; ++bj) { fn[bj][0] = *(const f32x4*)(fnorm + col0 + bj * HALF); fn[bj][1] = *(const f32x4*)(fnorm + col0 + bj * HALF + 4); }
        unsigned long long pa[8], pb[8];
#pragma unroll
        for (int g = 0; g < 8; ++g) { const unsigned long long* pp = (const unsigned long long*)(rsq_out + (size_t)(row0 + (g >> 2) * HALF + (g & 3) * 16) * 16 + 4 * fq);
            pa[g] = __hip_atomic_load(pp, __ATOMIC_RELAXED, __HIP_MEMORY_SCOPE_AGENT); pb[g] = __hip_atomic_load(pp + 1, __ATOMIC_RELAXED, __HIP_MEMORY_SCOPE_AGENT); }
#pragma unroll
        for (int g = 0; g < 8; ++g) { const int ai = g >> 2, m = g & 3, row = row0 + ai * HALF + m * 16;
            float s = (__uint_as_float((unsigned)pa[g]) + __uint_as_float((unsigned)(pa[g] >> 32))) + (__uint_as_float((unsigned)pb[g]) + __uint_as_float((unsigned)(pb[g] >> 32)));
            s += __shfl_xor(s, 16); s += __shfl_xor(s, 32);
            const float rs3 = rsqrtf(s * (1.0f / DM) + RMS_EPS);
#pragma unroll
            for (int bj = 0; bj < 2; ++bj) { const size_t off = (size_t)row * DM + col0 + bj * HALF;
                *(f32x4*)(out + off) = acc[ai][bj][m][0] * rs3 * fn[bj][0]; *(f32x4*)(out + off + 4) = acc[ai][bj][m][1] * rs3 * fn[bj][1]; } }
        EPN_STAMP(33);
    }
};
#undef EPN_STAMP
struct EpiUG {
    static constexpr bool PERM = true, AFTER_DRAIN = false;
    bf16_t* act; const float* rsq; const float* cw; const float* cb; float* UL; float* UF; float* GF;
    __device__ __forceinline__ void operator()(const f32x4 (&acc)[2][2][4][2], const Unit& u, int wr, int wc, int fr, int fq) const {
        const int cu = u.pn * HALF + wc * 32 + 8 * fq;
        const int row0 = u.pm * BM + wr * 64 + fr;
        float rsv[2][4]; rs8(rsq, row0, fq, rsv);
        float w0[8], w1[8], w2[8], bb[8];
#pragma unroll
        for (int q = 0; q < 2; ++q) { const f32x4 a = *(const f32x4*)(cw + cu + 4 * q), b = *(const f32x4*)(cw + FF + cu + 4 * q), c = *(const f32x4*)(cw + 2 * FF + cu + 4 * q), d = *(const f32x4*)(cb + cu + 4 * q);
#pragma unroll
            for (int j = 0; j < 4; ++j) { w0[4 * q + j] = a[j]; w1[4 * q + j] = b[j]; w2[4 * q + j] = c[j]; bb[4 * q + j] = d[j]; } }
#pragma unroll
        for (int ai = 0; ai < 2; ++ai) {
            float up[8];
#pragma unroll
            for (int m = 0; m < 4; ++m) {
                const int row = row0 + ai * HALF + m * 16;
                const float rs = rsv[ai][m];
                float uu[8], gg[8], a8[8];
#pragma unroll
                for (int n = 0; n < 2; ++n)
#pragma unroll
                    for (int j = 0; j < 4; ++j) { uu[4 * n + j] = acc[ai][0][m][n][j] * rs; gg[4 * n + j] = acc[ai][1][m][n][j] * rs; }
#pragma unroll
                for (int k = 0; k < 8; ++k) {
                    float t1 = 0.f, t2 = 0.f;
                    if (m > 0) { t1 = DPP_ROT(up[k], 0x121); t2 = DPP_ROT(up[k], 0x122); }
                    const float u1 = DPP_MOV(t1, uu[k], 0x111), u2 = DPP_MOV(t2, uu[k], 0x112);
                    const float y = bb[k] + w0[k] * u2 + w1[k] * u1 + w2[k] * uu[k];
                    a8[k] = gelu_fast(y) * gg[k];
                }
                const bool defer = (m == 0) && (fr < 2);
                if (!defer) { u32x4 w; w.x = cvt_pk_bf16(a8[0], a8[1]); w.y = cvt_pk_bf16(a8[2], a8[3]); w.z = cvt_pk_bf16(a8[4], a8[5]); w.w = cvt_pk_bf16(a8[6], a8[7]);
                    *(u32x4*)(act + (size_t)row * FF + cu) = w; }
                else { const size_t so = ((size_t)(row >> 6) * 2 + fr) * FF + cu;
                    *(f32x4*)(UF + so) = (f32x4){uu[0], uu[1], uu[2], uu[3]}; *(f32x4*)(UF + so + 4) = (f32x4){uu[4], uu[5], uu[6], uu[7]};
                    *(f32x4*)(GF + so) = (f32x4){gg[0], gg[1], gg[2], gg[3]}; *(f32x4*)(GF + so + 4) = (f32x4){gg[4], gg[5], gg[6], gg[7]}; }
                if (m == 3 && fr >= 14) { const size_t so = ((size_t)(row >> 6) * 2 + (fr - 14)) * FF + cu;
                    *(f32x4*)(UL + so) = (f32x4){uu[0], uu[1], uu[2], uu[3]}; *(f32x4*)(UL + so + 4) = (f32x4){uu[4], uu[5], uu[6], uu[7]}; }
#pragma unroll
                for (int k = 0; k < 8; ++k) up[k] = uu[k];
            }
        }
    }
};
}
#define LAS __attribute__((address_space(3)))
namespace mx {
typedef short bf16x8 __attribute__((ext_vector_type(8)));
typedef short s16x4 __attribute__((ext_vector_type(4)));
typedef float f32x16 __attribute__((ext_vector_type(16)));
typedef unsigned u32x4 __attribute__((ext_vector_type(4)));
typedef float f32x4_t __attribute__((ext_vector_type(4)));
typedef LAS const char* lds_cptr;
typedef LAS char* lds_ptr;
__device__ __forceinline__ int crow(int r, int hi) { return (r & 3) + 8 * (r >> 2) + 4 * hi; }
__device__ __forceinline__ s16x4 vtr(lds_cptr p) { return __builtin_bit_cast(s16x4, __builtin_amdgcn_ds_read_tr16_b64_v4i16((LAS s16x4*)p)); }
__device__ __forceinline__ bf16x8 cat8(s16x4 lo, s16x4 hi) { return (bf16x8){lo[0], lo[1], lo[2], lo[3], hi[0], hi[1], hi[2], hi[3]}; }
typedef float f32x2_t __attribute__((ext_vector_type(2))); typedef __bf16 bf16x2_t __attribute__((ext_vector_type(2)));
__device__ __forceinline__ unsigned pk(float lo, float hi) { const f32x2_t v = {lo, hi}; return __builtin_bit_cast(unsigned, __builtin_convertvector(v, bf16x2_t)); }
typedef __bf16 bf16x2_d __attribute__((ext_vector_type(2)));
__device__ __forceinline__ float dot2bf(unsigned a, unsigned b, float c) { return __builtin_amdgcn_fdot2_f32_bf16(__builtin_bit_cast(bf16x2_d, a), __builtin_bit_cast(bf16x2_d, b), c, false); }
__device__ __forceinline__ float dot8bf(u32x4 a, u32x4 b, float c) { return dot2bf(a.w, b.w, dot2bf(a.z, b.z, dot2bf(a.y, b.y, dot2bf(a.x, b.x, c)))); }
__device__ __forceinline__ float other_half(float v) { return __shfl_xor(v, 32); }

constexpr int L_K = 0, L_V = 32768;
constexpr int L_WSF = 65536;
constexpr int L_OST = 65536 + 2048;
constexpr int L_ENT = L_OST + 32768;
constexpr int ENT_CAP = 4096;
constexpr int L_PREF = L_ENT + ENT_CAP * 4;
constexpr int L_MW = L_PREF + 512;
constexpr int L_END = L_MW + 4096;
static_assert(L_END <= 147456, "mixer LDS map");

__device__ __forceinline__ void moba_stage_kv(const bf16_t* __restrict__ proj, int b, int h, int blk, lds_ptr lds, int tid) {
#pragma unroll
    for (int i = 0; i < 4; ++i) { const int pc = tid + 512 * i, key = pc >> 3, ch = pc & 7;
        const bf16_t* src = proj + ((size_t)(b * 8 + h) * SEQ + blk * 256 + key) * 64 + ch * 8;
        const u32x4 kv = *(const u32x4*)(src + SEC), vv = *(const u32x4*)(src + 2 * SEC);
        *(LAS u32x4*)(lds + L_K + ch * 4096 + key * 16) = kv;
        *(LAS u32x4*)(lds + L_V + (key >> 6) * 8192 + (ch >> 2) * 4096 + ((key & 63) >> 3) * 512 + (key & 7) * 64 + (ch & 3) * 16) = vv; }
}

__device__ __forceinline__ void moba_batch(const bf16x8 (&qr)[4], int qpos, int kbase, float slope2, bool diag, int ntiles, lds_ptr lds, int wave, int lane, bf16_t* odst, float* ldst,
                                           const bf16_t* part_row = nullptr, const float* pl_row = nullptr, int nv = 0, bf16_t* mix_row = nullptr, bf16_t* mix_base = nullptr) {
    const int r32 = lane & 31, hi = lane >> 5;
    f32x16 o0, o1;
#pragma unroll
    for (int r = 0; r < 16; ++r) { o0[r] = 0.f; o1[r] = 0.f; }
    float m = -1e30f, l = 0.f;
    const lds_cptr kp = (lds_cptr)lds + L_K + hi * 4096 + r32 * 16;
    const lds_cptr vp = (lds_cptr)lds + L_V + ((lane >> 4) & 1) * 32 + (lane & 3) * 8 + (4 * hi + ((lane & 15) >> 2)) * 64;
    LAS float* wsf = (LAS float*)(lds + L_WSF) + wave * 64;
    const float s4h = slope2 * (float)(4 * hi);
#define MX_LOAD(KT) bf16x8 kf_[4], kg_[4], vf_[2][4]; do { _Pragma("unroll") for (int d0 = 0; d0 < 4; ++d0) { kf_[d0] = *(const LAS bf16x8*)(kp + (KT) * 1024 + d0 * 8192); kg_[d0] = *(const LAS bf16x8*)(kp + (KT) * 1024 + 512 + d0 * 8192); } \
        const lds_cptr vt_ = vp + (KT) * 8192; _Pragma("unroll") for (int db = 0; db < 2; ++db) _Pragma("unroll") for (int ks = 0; ks < 4; ++ks) vf_[db][ks] = cat8(vtr(vt_ + db * 4096 + ks * 1024), vtr(vt_ + db * 4096 + ks * 1024 + 512)); \
        __builtin_amdgcn_sched_barrier(0); } while (0)
#define MX_QK(P0, P1, C0, C1) do { _Pragma("unroll") for (int d0 = 0; d0 < 4; ++d0) { \
        P0 = __builtin_amdgcn_mfma_f32_32x32x16_bf16(kf_[d0], qr[d0], d0 == 0 ? C0 : P0, 0, 0, 0); P1 = __builtin_amdgcn_mfma_f32_32x32x16_bf16(kg_[d0], qr[d0], d0 == 0 ? C1 : P1, 0, 0, 0); } } while (0)
#define MX_PV(O, DB, KS, PW) O = __builtin_amdgcn_mfma_f32_32x32x16_bf16(__builtin_bit_cast(bf16x8, PW), vf_[DB][KS], O, 0, 0, 0)
#define MX_PVALL() do { \
        const u32x4 pw0 = {pk(p0[0], p0[1]), pk(p0[2], p0[3]), pk(p0[4], p0[5]), pk(p0[6], p0[7])}, pw1 = {pk(p0[8], p0[9]), pk(p0[10], p0[11]), pk(p0[12], p0[13]), pk(p0[14], p0[15])}; \
        const u32x4 pw2 = {pk(p1[0], p1[1]), pk(p1[2], p1[3]), pk(p1[4], p1[5]), pk(p1[6], p1[7])}, pw3 = {pk(p1[8], p1[9]), pk(p1[10], p1[11]), pk(p1[12], p1[13]), pk(p1[14], p1[15])}; \
        MX_PV(o0, 0, 0, pw0); MX_PV(o1, 1, 0, pw0); MX_PV(o0, 0, 1, pw1); MX_PV(o1, 1, 1, pw1); MX_PV(o0, 0, 2, pw2); MX_PV(o1, 1, 2, pw2); MX_PV(o0, 0, 3, pw3); MX_PV(o1, 1, 3, pw3); } while (0)
    {
        const int kt = ntiles - 1;
        f32x16 p0, p1;
        MX_LOAD(kt);
#pragma unroll
        for (int r = 0; r < 16; ++r) { p0[r] = fmaf(slope2, (float)((r & 3) + 8 * (r >> 2)), s4h); p1[r] = p0[r]; }
        MX_QK(p0, p1, p0, p1);
        const int dq = qpos - kbase - 64 * kt;
        const float t0 = -slope2 * (float)dq, t1 = t0 + 32.0f * slope2;
        if (diag) {
#pragma unroll
            for (int r = 0; r < 16; ++r) { const int c = crow(r, hi); if (c > dq) p0[r] = -1e30f; if (c + 32 > dq) p1[r] = -1e30f; }
        }
        float mx0 = p0[0], mx1 = p1[0];
#pragma unroll
        for (int r = 1; r < 16; ++r) { mx0 = fmaxf(mx0, p0[r]); mx1 = fmaxf(mx1, p1[r]); }
        float mx_ = fmaxf(mx0 + t0, mx1 + t1);
        m = fmaxf(mx_, other_half(mx_));
        const float e0 = m - t0, e1 = m - t1;
        float rs = 0.f;
#pragma unroll
        for (int r = 0; r < 16; ++r) { p0[r] = __builtin_amdgcn_exp2f(p0[r] - e0); p1[r] = __builtin_amdgcn_exp2f(p1[r] - e1); rs += p0[r] + p1[r]; }
        l = rs;
        MX_PVALL();
    }
    for (int kt = ntiles - 2; kt >= 0; --kt) {
        const int dq = qpos - kbase - 64 * kt;
        const float c0 = -slope2 * (float)dq - m + s4h, c1 = c0 + 32.0f * slope2;
        f32x16 p0, p1;
        MX_LOAD(kt);
#pragma unroll
        for (int r = 0; r < 16; ++r) { const float cr = (float)((r & 3) + 8 * (r >> 2)); p0[r] = fmaf(slope2, cr, c0); p1[r] = fmaf(slope2, cr, c1); }
        MX_QK(p0, p1, p0, p1);
        float mx_ = fmaxf(p0[0], p1[0]);
#pragma unroll
        for (int r = 1; r < 16; ++r) mx_ = fmaxf(mx_, fmaxf(p0[r], p1[r]));
        mx_ = fmaxf(mx_, other_half(mx_));
        if (__all(mx_ < -30.0f)) continue;
        if (__any(mx_ > 16.0f)) {
            const float dl = fmaxf(mx_, 0.f); m += dl;
#pragma unroll
            for (int r = 0; r < 16; ++r) { p0[r] -= dl; p1[r] -= dl; }
            const float f = __builtin_amdgcn_exp2f(-dl); l *= f;
            if (hi == 0) wsf[r32] = f;
#pragma unroll
            for (int r = 0; r < 16; ++r) { const float g = wsf[crow(r, hi)]; o0[r] *= g; o1[r] *= g; }
        }
        float rs = 0.f;
#pragma unroll
        for (int r = 0; r < 16; ++r) { p0[r] = __builtin_amdgcn_exp2f(p0[r]); p1[r] = __builtin_amdgcn_exp2f(p1[r]); rs += p0[r] + p1[r]; }
        l += rs;
        MX_PVALL();
    }
#undef MX_LOAD
#undef MX_QK
#undef MX_PV
#undef MX_PVALL
    l += other_half(l);
    if (hi == 0) wsf[32 + r32] = 1.0f / l;
    const float lse = m + __builtin_amdgcn_logf(l);
    LAS bf16_t* ost = (LAS bf16_t*)(lds + L_OST) + wave * 2048;
#pragma unroll
    for (int r = 0; r < 16; ++r) { const int orow = crow(r, hi); const float f = wsf[32 + orow];
        ost[orow * 64 + r32] = (bf16_t)pk(o0[r] * f, 0.f); ost[orow * 64 + 32 + r32] = (bf16_t)pk(o1[r] * f, 0.f); }
    if (mix_row == nullptr) {
        const unsigned long long dp = (unsigned long long)odst; const unsigned dlo = (unsigned)dp, dhi = (unsigned)(dp >> 32);
#pragma unroll
        for (int i = 0; i < 4; ++i) { const int row = i * 8 + (lane >> 3), ch = lane & 7;
            const u32x4 v = *(const LAS u32x4*)(ost + row * 64 + ch * 8);
            const unsigned long long d = ((unsigned long long)(unsigned)__shfl((int)dhi, row) << 32) | (unsigned)__shfl((int)dlo, row);
            if (d) *(u32x4*)((bf16_t*)d + ch * 8) = v; }
        if (hi == 0 && ldst) *ldst = lse;
    } else {
        if (hi == 0) { const f32x4_t lv = *(const f32x4_t*)pl_row;
            const float a0 = nv > 0 ? lv[0] : -1e30f, a1 = nv > 1 ? lv[1] : -1e30f, a2 = nv > 2 ? lv[2] : -1e30f;
            const float mm = fmaxf(fmaxf(a0, a1), fmaxf(a2, lse));
            const float w0 = __builtin_amdgcn_exp2f(a0 - mm), w1 = __builtin_amdgcn_exp2f(a1 - mm), w2 = __builtin_amdgcn_exp2f(a2 - mm), w3 = __builtin_amdgcn_exp2f(lse - mm);
            const float iw = 1.0f / ((w0 + w1) + (w2 + w3));
            ((LAS f32x4_t*)(lds + L_MW) + wave * 32)[r32] = (f32x4_t){w0 * iw, w1 * iw, w2 * iw, w3 * iw}; }
        const unsigned long long pp = (unsigned long long)part_row, mp = (unsigned long long)mix_row;
        const unsigned plo = (unsigned)pp, phi = (unsigned)(pp >> 32), mlo = (unsigned)mp, mhi = (unsigned)(mp >> 32);
#pragma unroll
        for (int i = 0; i < 4; ++i) { const int row = i * 8 + (lane >> 3), ch = lane & 7;
            const u32x4 v = *(const LAS u32x4*)(ost + row * 64 + ch * 8);
            const f32x4_t w = ((const LAS f32x4_t*)(lds + L_MW) + wave * 32)[row];
            const bf16_t* pr = (const bf16_t*)(((unsigned long long)(unsigned)__shfl((int)phi, row) << 32) | (unsigned)__shfl((int)plo, row));
            bf16_t* mr = (bf16_t*)(((unsigned long long)(unsigned)__shfl((int)mhi, row) << 32) | (unsigned)__shfl((int)mlo, row));
            const unsigned vw[4] = {v.x, v.y, v.z, v.w}; float acc[8];
#pragma unroll
            for (int q = 0; q < 4; ++q) { acc[2 * q] = w[3] * __uint_as_float(vw[q] << 16); acc[2 * q + 1] = w[3] * __uint_as_float(vw[q] & 0xffff0000u); }
#pragma unroll
            for (int s = 0; s < 3; ++s) if (w[s] != 0.f) { const u32x4 pv = *(const u32x4*)(pr + s * 64 + ch * 8); const unsigned pw_[4] = {pv.x, pv.y, pv.z, pv.w};
#pragma unroll
                for (int q = 0; q < 4; ++q) { acc[2 * q] += w[s] * __uint_as_float(pw_[q] << 16); acc[2 * q + 1] += w[s] * __uint_as_float(pw_[q] & 0xffff0000u); } }
            *(u32x4*)(mr + ch * 8) = (u32x4){pk(acc[0], acc[1]), pk(acc[2], acc[3]), pk(acc[4], acc[5]), pk(acc[6], acc[7])}; }
    }
}

__device__ __forceinline__ void moba_diag_unit(const bf16_t* __restrict__ proj, int bh, int i, const bf16_t* part_o, const float* part_l, const u32* __restrict__ sel, bf16_t* mix, lds_ptr lds, int tid) {
    const int b = bh >> 3, h = bh & 7, lane = tid & 63, wave = __builtin_amdgcn_readfirstlane(tid >> 6);
    const int ql = wave * 32 + (lane & 31), t = i * 256 + ql; const size_t row = (size_t)b * SEQ + t;
    bf16x8 qr[4];
    { const bf16_t* qp = proj + ((size_t)bh * SEQ + t) * 64 + (lane >> 5) * 8;
#pragma unroll
      for (int d0 = 0; d0 < 4; ++d0) qr[d0] = *(const bf16x8*)(qp + d0 * 16); }
    moba_stage_kv(proj, b, h, i, lds, tid);
    __syncthreads();
    const float slope2 = __builtin_amdgcn_exp2f(-(float)(h + 1)) * LOG2E;
    const int nv = (int)(sel[row * 8 + h] >> 24);
    moba_batch(qr, t, i * 256, slope2, true, (wave >> 1) + 1, lds, wave, lane, nullptr, nullptr,
               part_o + ((row * 8 + h) * 4) * 64, part_l + (row * 8 + h) * 4, nv, mix + row * DM + h * 64, mix);
    __syncthreads();
}
__device__ __forceinline__ void moba_sel_task(const bf16_t* __restrict__ proj, const unsigned short* __restrict__ seg, const int* __restrict__ cnt, int bh, int n,
                                              bf16_t* part_o, float* part_l, lds_ptr lds, int tid) {
    const int b = bh >> 3, h = bh & 7, lane = tid & 63, wave = __builtin_amdgcn_readfirstlane(tid >> 6);
    LAS int* pref = (LAS int*)(lds + L_PREF); LAS unsigned* ent = (LAS unsigned*)(lds + L_ENT);
    if (wave == 0) {
        const int c = (lane > n) ? cnt[((size_t)bh * 64 + n) * 64 + lane] : 0; int s = c;
#pragma unroll
        for (int o = 1; o < 64; o <<= 1) { const int v = __shfl_up(s, o); if (lane >= o) s += v; }
        pref[lane + 1] = s; if (lane == 0) pref[0] = 0;
    }
    __syncthreads();
    const int T = pref[64];
    if (T == 0) { __syncthreads(); return; }
    moba_stage_kv(proj, b, h, n, lds, tid);
    const float slope2 = __builtin_amdgcn_exp2f(-(float)(h + 1)) * LOG2E;
    for (int c0 = 0; c0 < T; c0 += ENT_CAP) {
        for (int i = n + 1 + wave; i < 64; i += 8) { const int s0 = pref[i], s1 = pref[i + 1];
            const unsigned short* sp = seg + (((size_t)bh * 64 + n) * 64 + i) * 256;
            for (int e = lane; e < s1 - s0; e += 64) { const int g = s0 + e - c0; if (g >= 0 && g < ENT_CAP) ent[g] = ((unsigned)i << 10) | (unsigned)sp[e]; } }
        __syncthreads();
        const int cn = (T - c0) < ENT_CAP ? (T - c0) : ENT_CAP;
        for (int wb = wave; wb * 32 < cn; wb += 8) {
            const int idx = wb * 32 + (lane & 31); const bool valid = idx < cn;
            const unsigned ec = ent[valid ? idx : wb * 32];
            const int t = (ec >> 10) * 256 + ((ec >> 2) & 255), slot = ec & 3; const size_t row = (size_t)b * SEQ + t;
            bf16x8 qr[4];
            { const bf16_t* qp = proj + ((size_t)bh * SEQ + t) * 64 + (lane >> 5) * 8;
#pragma unroll
              for (int d0 = 0; d0 < 4; ++d0) qr[d0] = *(const bf16x8*)(qp + d0 * 16); }
            moba_batch(qr, t, n * 256, slope2, false, 4, lds, wave, lane,
                       valid ? part_o + ((row * 8 + h) * 4 + slot) * 64 : (bf16_t*)nullptr, valid ? part_l + (row * 8 + h) * 4 + slot : (float*)nullptr);
        }
        __syncthreads();
    }
}
constexpr int G_KMH = 0, G_KML = 8192, G_CNT = 16384;
#define MX_INS(v, n) do { const bool g0_ = (v) > v0, g1_ = (v) > v1, g2_ = (v) > v2; \
    v2 = g1_ ? v1 : (g2_ ? (v) : v2); i2 = g1_ ? i1 : (g2_ ? (n) : i2); v1 = g0_ ? v0 : (g1_ ? (v) : v1); i1 = g0_ ? i0 : (g1_ ? (n) : i1); v0 = g0_ ? (v) : v0; i0 = g0_ ? (n) : i0; } while (0)
__device__ __forceinline__ void gate_task_mfma(int bh, int i, const bf16_t* __restrict__ proj, const float* __restrict__ kmsum, u32* __restrict__ sel,
                                               unsigned short* __restrict__ seg, int* __restrict__ cnt, const unsigned* __restrict__ kmx, float* __restrict__ part_l, lds_ptr lds, int tid) {
    const int b = bh >> 3, h = bh & 7, lane = tid & 63, wave = __builtin_amdgcn_readfirstlane(tid >> 6), r32 = lane & 31, hi = lane >> 5;
    { const int n = tid >> 3, ch = tid & 7; const float* src = kmsum + (size_t)bh * 4096 + n * 64 + ch * 8;
      const f32x4_t a = *(const f32x4_t*)src * (1.0f / 256.0f), c = *(const f32x4_t*)(src + 4) * (1.0f / 256.0f);
      float v[8] = {a[0], a[1], a[2], a[3], c[0], c[1], c[2], c[3]}; float hf[8], lf[8];
#pragma unroll
      for (int k = 0; k < 8; ++k) { hf[k] = bf2f(f2bf(v[k])); lf[k] = v[k] - hf[k]; }
      const u32x4 H = {pk(hf[0], hf[1]), pk(hf[2], hf[3]), pk(hf[4], hf[5]), pk(hf[6], hf[7])}, Lw = {pk(lf[0], lf[1]), pk(lf[2], lf[3]), pk(lf[4], lf[5]), pk(lf[6], lf[7])};
      *(LAS u32x4*)(lds + G_KMH + ch * 1024 + n * 16) = H; *(LAS u32x4*)(lds + G_KML + ch * 1024 + n * 16) = Lw; }
    LAS int* cntL = (LAS int*)(lds + G_CNT);
    if (tid < 64) cntL[tid] = 0;
    __syncthreads();
    const int ql = wave * 32 + r32, t = i * 256 + ql; const size_t row = (size_t)b * SEQ + t;
    const bf16_t* qp = proj + ((size_t)bh * SEQ + t) * 64 + hi * 8;
    f32x16 p0, p1;
#pragma unroll
    for (int r = 0; r < 16; ++r) { p0[r] = 0.f; p1[r] = 0.f; }
    const bf16_t* ksp = proj + SEC + ((size_t)bh * SEQ + t) * 64 + hi * 8;
    float qq = 0.f, qk = 0.f;
#pragma unroll
    for (int ks = 0; ks < 4; ++ks) {
        const bf16x8 q = *(const bf16x8*)(qp + ks * 16);
        { const u32x4 qu = __builtin_bit_cast(u32x4, q), ku = *(const u32x4*)(ksp + ks * 16); qq = dot8bf(qu, qu, qq); qk = dot8bf(qu, ku, qk); }
        const lds_cptr kb = (lds_cptr)lds + (2 * ks + hi) * 1024 + r32 * 16;
        p0 = __builtin_amdgcn_mfma_f32_32x32x16_bf16(*(const LAS bf16x8*)(kb + G_KMH), q, p0, 0, 0, 0);
        p0 = __builtin_amdgcn_mfma_f32_32x32x16_bf16(*(const LAS bf16x8*)(kb + G_KML), q, p0, 0, 0, 0);
        p1 = __builtin_amdgcn_mfma_f32_32x32x16_bf16(*(const LAS bf16x8*)(kb + G_KMH + 512), q, p1, 0, 0, 0);
        p1 = __builtin_amdgcn_mfma_f32_32x32x16_bf16(*(const LAS bf16x8*)(kb + G_KML + 512), q, p1, 0, 0, 0);
    }
    float v0 = -INFINITY, v1 = -INFINITY, v2 = -INFINITY; int i0 = 0, i1 = 0, i2 = 0;
#pragma unroll
    for (int r = 0; r < 16; ++r) { const int n = crow(r, hi); const float v = n < i ? p0[r] : -INFINITY; MX_INS(v, n); }
#pragma unroll
    for (int r = 0; r < 16; ++r) { const int n = 32 + crow(r, hi); const float v = n < i ? p1[r] : -INFINITY; MX_INS(v, n); }
    { const float a0 = __shfl_xor(v0, 32), a1 = __shfl_xor(v1, 32), a2 = __shfl_xor(v2, 32); const int j0 = __shfl_xor(i0, 32), j1 = __shfl_xor(i1, 32), j2 = __shfl_xor(i2, 32);
      MX_INS(a0, j0); MX_INS(a1, j1); MX_INS(a2, j2); }
    qq += other_half(qq); qk += other_half(qk);
    if (hi == 0) {
        const int nv = i < 3 ? i : 3;
        sel[row * 8 + h] = (u32)i0 | ((u32)i1 << 8) | ((u32)i2 << 16) | ((u32)nv << 24);
        const float qn = sqrtf(qq) * 1.01f, slope2 = __builtin_amdgcn_exp2f(-(float)(h + 1)) * LOG2E;
#pragma unroll
        for (int s = 0; s < 3; ++s) if (s < nv) { const int n = s == 0 ? i0 : (s == 1 ? i1 : i2);
            const float kmax = sqrtf(__uint_as_float(kmx[((size_t)bh * 64 + n) * 2]) + __uint_as_float(kmx[((size_t)bh * 64 + n) * 2 + 1]));
            const float U = qn * kmax - slope2 * (float)(t - (n * 256 + 255));
            if (U + 8.0f - qk < -30.0f) part_l[(row * 8 + h) * 4 + s] = -1e30f;
            else { const int pos = atomicAdd((int*)&cntL[n], 1);
                seg[(((size_t)bh * 64 + n) * 64 + i) * 256 + pos] = (unsigned short)((ql << 2) | s); } }
    }
    __syncthreads();
    if (tid < i) cnt[((size_t)bh * 64 + tid) * 64 + i] = cntL[tid];
    __syncthreads();
}
#undef MX_INS

__device__ __forceinline__ void moba_combine(const bf16_t* __restrict__ part_o, const float* __restrict__ part_l, const u32* __restrict__ sel, bf16_t* __restrict__ mix, size_t gt, size_t GT) {
    for (size_t i = gt; i < (size_t)MT * 64; i += GT) {
        const int ch = (int)(i & 7), h = (int)((i >> 3) & 7); const size_t row = i >> 6;
        const int nv = sel[row * 8 + h] >> 24;
        const f32x4_t lv = *(const f32x4_t*)(part_l + (row * 8 + h) * 4);
        float w[4]; w[0] = nv > 0 ? lv[0] : -1e30f; w[1] = nv > 1 ? lv[1] : -1e30f; w[2] = nv > 2 ? lv[2] : -1e30f; w[3] = lv[3];
        const float mm = fmaxf(fmaxf(w[0], w[1]), fmaxf(w[2], w[3]));
        float acc[8] = {0.f, 0.f, 0.f, 0.f, 0.f, 0.f, 0.f, 0.f}; float ws = 0.f;
#pragma unroll
        for (int s = 0; s < 4; ++s) { const bool ok = s == 3 || s < nv; const float ww = ok ? __builtin_amdgcn_exp2f(w[s] - mm) : 0.f; ws += ww;
            if (ok) { const u32x4 v = *(const u32x4*)(part_o + ((row * 8 + h) * 4 + s) * 64 + ch * 8);
                acc[0] += ww * __uint_as_float(v.x << 16); acc[1] += ww * __uint_as_float(v.x & 0xffff0000u); acc[2] += ww * __uint_as_float(v.y << 16); acc[3] += ww * __uint_as_float(v.y & 0xffff0000u);
                acc[4] += ww * __uint_as_float(v.z << 16); acc[5] += ww * __uint_as_float(v.z & 0xffff0000u); acc[6] += ww * __uint_as_float(v.w << 16); acc[7] += ww * __uint_as_float(v.w & 0xffff0000u); } }
        const float iw = 1.0f / ws;
        u32x4 o; o.x = pk(acc[0] * iw, acc[1] * iw); o.y = pk(acc[2] * iw, acc[3] * iw); o.z = pk(acc[4] * iw, acc[5] * iw); o.w = pk(acc[6] * iw, acc[7] * iw);
        *(u32x4*)(mix + row * DM + h * 64 + ch * 8) = o;
    }
}

constexpr int R_IMG = 65536;
__device__ __forceinline__ int rimg_off(int t, int c) { return (c >> 5) * 16384 + (t >> 3) * 512 + (t & 7) * 64 + (c & 31) * 2; }
__device__ __forceinline__ void ret_stage(const bf16_t* __restrict__ plane, int t0, lds_ptr img, int tid, bool kdecay, float log2g) {
#pragma unroll
    for (int i = 0; i < 8; ++i) { const int pc = tid + 512 * i, t = pc >> 4, ch = pc & 15;
        u32x4 v = *(const u32x4*)(plane + (size_t)(t0 + t) * 128 + ch * 8);
        if (kdecay) { const float f = __builtin_amdgcn_exp2f((float)(255 - t) * log2g);
            v.x = pk(__uint_as_float(v.x << 16) * f, __uint_as_float(v.x & 0xffff0000u) * f); v.y = pk(__uint_as_float(v.y << 16) * f, __uint_as_float(v.y & 0xffff0000u) * f);
            v.z = pk(__uint_as_float(v.z << 16) * f, __uint_as_float(v.z & 0xffff0000u) * f); v.w = pk(__uint_as_float(v.w << 16) * f, __uint_as_float(v.w & 0xffff0000u) * f); }
        *(LAS u32x4*)(img + rimg_off(t, ch * 8)) = v; }
}
__device__ __forceinline__ void ret_kv_task(const bf16_t* __restrict__ proj, int bh, int c, float* __restrict__ kvt, lds_ptr lds, int tid) {
    const int b = bh >> 2, h = bh & 3, lane = tid & 63, wave = __builtin_amdgcn_readfirstlane(tid >> 6), r32 = lane & 31, hi = lane >> 5;
    const float log2g = __builtin_amdgcn_logf(1.0f - __builtin_amdgcn_exp2f(-5.0f - (float)h));
    ret_stage(proj + 5 * SEC + (size_t)bh * SEQ * 128, c * 256, lds, tid, false, 0.f);
    ret_stage(proj + 4 * SEC + (size_t)bh * SEQ * 128, c * 256, lds + R_IMG, tid, true, log2g);
    __syncthreads();
    const int et = wave >> 1, dt0 = (wave & 1) * 2;
    const int lbase = hi * 512 + ((lane & 15) >> 2) * 64 + ((lane >> 4) & 1) * 32 + (lane & 3) * 8;
    const lds_cptr va = (lds_cptr)lds + et * 16384 + lbase, kb0 = (lds_cptr)lds + R_IMG + dt0 * 16384 + lbase, kb1 = kb0 + 16384;
    f32x16 a0, a1;
#pragma unroll
    for (int r = 0; r < 16; ++r) { a0[r] = 0.f; a1[r] = 0.f; }
#pragma unroll 4
    for (int ks = 0; ks < 16; ++ks) {
        const bf16x8 vf = cat8(vtr(va + ks * 1024), vtr(va + ks * 1024 + 256));
        const bf16x8 k0 = cat8(vtr(kb0 + ks * 1024), vtr(kb0 + ks * 1024 + 256)), k1 = cat8(vtr(kb1 + ks * 1024), vtr(kb1 + ks * 1024 + 256));
        a0 = __builtin_amdgcn_mfma_f32_32x32x16_bf16(vf, k0, a0, 0, 0, 0);
        a1 = __builtin_amdgcn_mfma_f32_32x32x16_bf16(vf, k1, a1, 0, 0, 0);
    }
    float* dst = kvt + ((size_t)(bh * 64 + c) * 128) * 128;
#pragma unroll
    for (int r = 0; r < 16; ++r) { const int e = et * 32 + crow(r, hi);
        dst[(size_t)e * 128 + dt0 * 32 + r32] = a0[r]; dst[(size_t)e * 128 + dt0 * 32 + 32 + r32] = a1[r]; }
    __syncthreads();
}
__device__ __forceinline__ void ret_scan(const float* __restrict__ kvt, bf16_t* __restrict__ stt, size_t gt, size_t GT) {
    for (size_t i = gt; i < (size_t)8 * 16384; i += GT) {
        const int bh = (int)(i >> 14), ed = (int)(i & 16383), h = bh & 3;
        const float g256 = __builtin_amdgcn_exp2f(256.0f * __builtin_amdgcn_logf(1.0f - __builtin_amdgcn_exp2f(-5.0f - (float)h)));
        float s = 0.f;
#pragma unroll 8
        for (int c = 0; c < 64; ++c) { const size_t o = ((size_t)(bh * 64 + c) << 14) + ed; stt[o] = f2bf(s); s = s * g256 + kvt[o]; }
    }
}
constexpr int RO_A = 0, RO_V = 65536, RO_ST = 131072;
#define RO_STAMP(i) do { if (dts && tid == 0) __hip_atomic_store(dts + (i), (unsigned long long)__builtin_amdgcn_s_memrealtime(), __ATOMIC_RELAXED, __HIP_MEMORY_SCOPE_AGENT); } while (0)
__device__ __forceinline__ void ret_out_task(const bf16_t* __restrict__ proj, const bf16_t* __restrict__ stt, const float* __restrict__ gain, bf16_t* __restrict__ mix, int bh, int c, lds_ptr lds, int tid, unsigned long long* dts = nullptr) {
    RO_STAMP(21);
    const int b = bh >> 2, h = bh & 3, lane = tid & 63, wave = __builtin_amdgcn_readfirstlane(tid >> 6), r32 = lane & 31, hi = lane >> 5;
    const float log2g = __builtin_amdgcn_logf(1.0f - __builtin_amdgcn_exp2f(-5.0f - (float)h));
    const size_t row0 = (size_t)b * SEQ + c * 256;
    u32x4 sreg[4], vreg[8], kreg[8];
    { const bf16_t* sp = stt + ((size_t)(bh * 64 + c) << 14);
#pragma unroll
      for (int i = 0; i < 4; ++i) sreg[i] = *(const u32x4*)(sp + (size_t)(tid + 512 * i) * 8); }
    const size_t hrow0 = (size_t)bh * SEQ + c * 256;
#pragma unroll
    for (int i = 0; i < 8; ++i) { const int pc = tid + 512 * i, t = pc >> 4, ch = pc & 15; const bf16_t* src = proj + (hrow0 + t) * 128 + ch * 8;
        vreg[i] = *(const u32x4*)(src + 5 * SEC); kreg[i] = *(const u32x4*)(src + 4 * SEC); }
    bf16x8 qf[8];
    { const bf16_t* qp = proj + 3 * SEC + (hrow0 + wave * 32 + r32) * 128 + hi * 8;
#pragma unroll
      for (int ks = 0; ks < 8; ++ks) qf[ks] = *(const bf16x8*)(qp + ks * 16); }
#pragma unroll
    for (int i = 0; i < 4; ++i) { const int pc = tid + 512 * i, e = pc >> 4, ch = pc & 15; *(LAS u32x4*)(lds + RO_A + ch * 2048 + e * 16) = sreg[i]; }
#pragma unroll
    for (int i = 0; i < 8; ++i) { const int pc = tid + 512 * i, t = pc >> 4, ch = pc & 15; *(LAS u32x4*)(lds + RO_V + rimg_off(t, ch * 8)) = vreg[i]; }
    __syncthreads();
    RO_STAMP(22);
    f32x16 o[4];
#pragma unroll
    for (int et = 0; et < 4; ++et)
#pragma unroll
        for (int r = 0; r < 16; ++r) o[et][r] = 0.f;
    { const lds_cptr sb = (lds_cptr)lds + RO_A + hi * 2048 + r32 * 16;
#pragma unroll
      for (int et = 0; et < 4; ++et)
#pragma unroll
          for (int ks = 0; ks < 8; ++ks) o[et] = __builtin_amdgcn_mfma_f32_32x32x16_bf16(qf[ks], *(const LAS bf16x8*)(sb + ks * 4096 + et * 512), o[et], 0, 0, 0); }
#pragma unroll
    for (int r = 0; r < 16; ++r) { const float f = __builtin_amdgcn_exp2f((float)(wave * 32 + crow(r, hi) + 1) * log2g);
#pragma unroll
        for (int et = 0; et < 4; ++et) o[et][r] *= f; }
    RO_STAMP(23);
    __syncthreads();
#pragma unroll
    for (int i = 0; i < 8; ++i) { const int pc = tid + 512 * i, t = pc >> 4, ch = pc & 15; *(LAS u32x4*)(lds + RO_A + ch * 4096 + t * 16) = kreg[i]; }
    __syncthreads();
    u32x4 rgv[8];
#pragma unroll
    for (int g = 0; g < 4; ++g)
#pragma unroll
        for (int k = 0; k < 2; ++k) { const int pidx = lane + 64 * k; rgv[2 * g + k] = *(const u32x4*)(proj + 6 * SEC + (hrow0 + wave * 32 + 8 * g + (pidx >> 4)) * 128 + (pidx & 15) * 8); }
    const lds_cptr vp = (lds_cptr)lds + RO_V + ((lane >> 4) & 1) * 32 + (lane & 3) * 8 + (4 * hi + ((lane & 15) >> 2)) * 64;
    const lds_cptr kpb = (lds_cptr)lds + RO_A + hi * 4096 + r32 * 16;
    for (int kvt = 0; kvt <= wave; ++kvt) {
        f32x16 p;
#pragma unroll
        for (int r = 0; r < 16; ++r) p[r] = 0.f;
#pragma unroll
        for (int ks = 0; ks < 8; ++ks) p = __builtin_amdgcn_mfma_f32_32x32x16_bf16(*(const LAS bf16x8*)(kpb + ks * 8192 + kvt * 512), qf[ks], p, 0, 0, 0);
        const int dbase = 32 * (wave - kvt) + r32 - 4 * hi;
#pragma unroll
        for (int r = 0; r < 16; ++r) { const int dist = dbase - ((r & 3) + 8 * (r >> 2)); p[r] = dist >= 0 ? p[r] * __builtin_amdgcn_exp2f((float)dist * log2g) : 0.f; }
        const u32x4 pw0 = {pk(p[0], p[1]), pk(p[2], p[3]), pk(p[4], p[5]), pk(p[6], p[7])}, pw1 = {pk(p[8], p[9]), pk(p[10], p[11]), pk(p[12], p[13]), pk(p[14], p[15])};
        const lds_cptr vt = vp + kvt * 2048;
#pragma unroll
        for (int et = 0; et < 4; ++et) {
            o[et] = __builtin_amdgcn_mfma_f32_32x32x16_bf16(__builtin_bit_cast(bf16x8, pw0), cat8(vtr(vt + et * 16384), vtr(vt + et * 16384 + 512)), o[et], 0, 0, 0);
            o[et] = __builtin_amdgcn_mfma_f32_32x32x16_bf16(__builtin_bit_cast(bf16x8, pw1), cat8(vtr(vt + et * 16384 + 1024), vtr(vt + et * 16384 + 1536)), o[et], 0, 0, 0);
        }
    }
    RO_STAMP(24);
    float mu[16], rstd[16];
#pragma unroll
    for (int r = 0; r < 16; ++r) {
        float s = (o[0][r] + o[1][r]) + (o[2][r] + o[3][r]);
        s += __shfl_xor(s, 1); s += __shfl_xor(s, 2); s += __shfl_xor(s, 4); s += __shfl_xor(s, 8); s += __shfl_xor(s, 16);
        mu[r] = s * (1.0f / 128.0f);
        const float d0 = o[0][r] - mu[r], d1 = o[1][r] - mu[r], d2 = o[2][r] - mu[r], d3 = o[3][r] - mu[r];
        float q = (d0 * d0 + d1 * d1) + (d2 * d2 + d3 * d3);
        q += __shfl_xor(q, 1); q += __shfl_xor(q, 2); q += __shfl_xor(q, 4); q += __shfl_xor(q, 8); q += __shfl_xor(q, 16);
        rstd[r] = rsqrtf(q * (1.0f / 128.0f) + GN_EPS);
    }
    float gn[4];
#pragma unroll
    for (int et = 0; et < 4; ++et) gn[et] = gain[h * 128 + et * 32 + r32];
    LAS bf16_t* st = (LAS bf16_t*)(lds + RO_ST) + wave * 1024;
#pragma unroll
    for (int g = 0; g < 4; ++g) {
#pragma unroll
        for (int rr = 0; rr < 4; ++rr) { const int r = 4 * g + rr;
#pragma unroll
            for (int et = 0; et < 4; ++et) st[(rr + 4 * hi) * 128 + et * 32 + r32] = f2bf((o[et][r] - mu[r]) * rstd[r] * gn[et]); }
#pragma unroll
        for (int k = 0; k < 2; ++k) { const int pidx = lane + 64 * k, r8 = pidx >> 4, ch = pidx & 15; const size_t row = row0 + wave * 32 + 8 * g + r8;
            const u32x4 nv = *(const LAS u32x4*)(st + r8 * 128 + ch * 8); const u32x4 gv = rgv[2 * g + k];
            const unsigned nw[4] = {nv.x, nv.y, nv.z, nv.w}, gw_[4] = {gv.x, gv.y, gv.z, gv.w}; unsigned ow[4];
#pragma unroll
            for (int q = 0; q < 4; ++q) { const float g0 = __uint_as_float(gw_[q] << 16), g1 = __uint_as_float(gw_[q] & 0xffff0000u);
                ow[q] = pk(__uint_as_float(nw[q] << 16) * (g0 / (1.0f + __expf(-g0))), __uint_as_float(nw[q] & 0xffff0000u) * (g1 / (1.0f + __expf(-g1)))); }
            *(u32x4*)(mix + row * DM + 512 + h * 128 + ch * 8) = (u32x4){ow[0], ow[1], ow[2], ow[3]}; }
    }
    RO_STAMP(25);
    __syncthreads();
    RO_STAMP(26);
}
#undef RO_STAMP
}
#ifndef DIAG_K
#define DIAG_K -1
#endif
#ifndef DIAG_BLOCK
#define DIAG_BLOCK 100
#endif
#ifndef DIAG_SCALE
#define DIAG_SCALE 1.0f
#endif
#ifndef DIAG_A
#define DIAG_A 45
#endif
#ifndef DIAG_B
#define DIAG_B 6
#endif
#ifndef P4_DIAG_FIRST
#define P4_DIAG_FIRST(v) (true)
#endif
#ifndef REP_MASK
#define REP_MASK 0
#endif
#ifndef REP_SUB
#define REP_SUB 7
#endif
#include <hip/hip_cooperative_groups.h>
namespace cg = cooperative_groups;
constexpr int NWAVES = 8, NTHREADS = 512;
constexpr int LDS_BYTES = 147456 + 256;
constexpr int NPH = 10;
constexpr size_t WS_STASH = 180 * MiB;
constexpr size_t STASH_ELEMS = (size_t)512 * 2 * FF;

struct Args { const float* in[16]; float* out; unsigned char* ws; int ph_lo, ph_hi, flags, pad; };

__device__ __forceinline__ void p0_transpose_item(const float* __restrict__ W, int K, int N, const float* __restrict__ gk, bf16_t* __restrict__ WT, int k0, int n0, int orow0, LAS float* scr, int lane) {
    { float4 v[8];
#pragma unroll
      for (int i = 0; i < 8; ++i) v[i] = *(const float4*)(W + (size_t)(k0 + 8 * i + (lane >> 3)) * N + n0 + (lane & 7) * 4);
#pragma unroll
      for (int i = 0; i < 8; ++i) { const int kk = 8 * i + (lane >> 3); const float g = gk ? gk[k0 + kk] : 1.0f; LAS float* d = scr + kk * 33 + (lane & 7) * 4;
          d[0] = v[i].x * g; d[1] = v[i].y * g; d[2] = v[i].z * g; d[3] = v[i].w * g; } }
    asm volatile("s_waitcnt lgkmcnt(0)" ::: "memory");
    const int c = lane & 7;
#pragma unroll
    for (int j = 0; j < 4; ++j) { const int n = (lane >> 3) + 8 * j; const LAS float* s = scr + (8 * c) * 33 + n;
        uint4 o; o.x = (u32)f2bf(s[0 * 33]) | ((u32)f2bf(s[1 * 33]) << 16); o.y = (u32)f2bf(s[2 * 33]) | ((u32)f2bf(s[3 * 33]) << 16);
        o.z = (u32)f2bf(s[4 * 33]) | ((u32)f2bf(s[5 * 33]) << 16); o.w = (u32)f2bf(s[6 * 33]) | ((u32)f2bf(s[7 * 33]) << 16);
        *(uint4*)(WT + (size_t)(orow0 + n) * K + k0 + 8 * c) = o; }
    asm volatile("s_waitcnt lgkmcnt(0)" ::: "memory");
}

#define XB_TMO      128
#define XB_XCNT(j)  (256  + 64 * (j))
#define XB_XSUB(j)  (1280 + 64 * (j))
#define XB_XGEN(j)  (2304 + 64 * (j))
#define XB_TOP      3328
#define XB_TOPGEN   3392
#define XCD_BAR_WORDS 3456
#define XB_SPIN_CAP (1u << 18)

__device__ __forceinline__ unsigned xb_ld(unsigned* p)              { return __hip_atomic_load(p, __ATOMIC_RELAXED, __HIP_MEMORY_SCOPE_AGENT); }
__device__ __forceinline__ unsigned xb_add(unsigned* p, unsigned v) { return __hip_atomic_fetch_add(p, v, __ATOMIC_RELAXED, __HIP_MEMORY_SCOPE_AGENT); }
__device__ __forceinline__ unsigned xb_xcc_id() { return (unsigned)__builtin_amdgcn_s_getreg((3 << 11) | 20) & 0xFu; }
#define XB_SPIN(cond, bar) do { unsigned _sp = 0; while (cond) { __builtin_amdgcn_s_sleep(1); \
    if ((++_sp & 255u) == 0u) { if (xb_ld(&(bar)[XB_TMO])) break; if (_sp > XB_SPIN_CAP) { atomicAdd(&(bar)[XB_TMO], 1u); break; } } } } while (0)

struct XcdBarrier {
    unsigned* bar; unsigned x;
    volatile LAS unsigned* st;
};

__device__ __forceinline__ XcdBarrier xcd_barrier_post(unsigned* bar, volatile LAS unsigned* st) {
    XcdBarrier b; b.bar = bar; b.x = xb_xcc_id(); b.st = st;
    if (threadIdx.x == 0) (void)xb_add(&bar[XB_XCNT(b.x)], 1u);
    return b;
}
__device__ __forceinline__ void xcd_barrier_complete(unsigned* bar, unsigned x, unsigned& nloc, unsigned& nx) {
    const unsigned G = gridDim.x * gridDim.y * gridDim.z;
    unsigned sum, cnt, mine, sp = 0u;
    for (;;) {
        sum = 0u; cnt = 0u; mine = 0u;
#pragma unroll
        for (unsigned j = 0; j < 16; ++j) { const unsigned c = xb_ld(&bar[XB_XCNT(j)]); sum += c; cnt += (c > 0u) ? 1u : 0u; mine = (j == x) ? c : mine; }
        if (sum == G) break;
        __builtin_amdgcn_s_sleep(1);
        if ((++sp & 255u) == 0u) { if (xb_ld(&bar[XB_TMO])) break; if (sp > XB_SPIN_CAP) { atomicAdd(&bar[XB_TMO], 1u); break; } }
    }
    nloc = mine > 0u ? mine : 1u; nx = cnt > 0u ? cnt : 1u;
}

__device__ __forceinline__ void xcd_barrier(const XcdBarrier& b) {
    asm volatile("s_waitcnt vmcnt(0)" ::: "memory");
    __syncthreads();
    if (threadIdx.x == 0) {
        unsigned* bar = b.bar;
        __builtin_amdgcn_s_waitcnt(0);
        unsigned nloc = b.st[0], nx = b.st[1];
        if (nloc == 0u) { xcd_barrier_complete(bar, b.x, nloc, nx); b.st[0] = nloc; b.st[1] = nx; }
        const unsigned old = xb_add(&bar[XB_XSUB(b.x)], 1u);
        const unsigned gen = old / nloc;
        if (old + 1u == (gen + 1u) * nloc) {
            __builtin_amdgcn_fence(__ATOMIC_RELEASE, "agent");
            asm volatile("s_waitcnt vmcnt(0)" ::: "memory");
            const unsigned og = xb_add(&bar[XB_TOP], 1u);
            const unsigned tg = og / nx;
            if (og + 1u == (tg + 1u) * nx) xb_add(&bar[XB_TOPGEN], 1u);
            else XB_SPIN(xb_ld(&bar[XB_TOPGEN]) == tg, bar);
            __builtin_amdgcn_fence(__ATOMIC_ACQUIRE, "agent");
            xb_add(&bar[XB_XGEN(b.x)], 1u);
            asm volatile("s_waitcnt vmcnt(0)" ::: "memory");
        } else {
            XB_SPIN(xb_ld(&bar[XB_XGEN(b.x)]) == gen, bar);
            __builtin_amdgcn_fence(__ATOMIC_ACQUIRE, "agent");
            asm volatile("s_waitcnt vmcnt(0)" ::: "memory");
        }
    }
    __syncthreads();
}

constexpr int CW_BAR = 4096;
constexpr int LDS_BARST = 147456;
constexpr size_t CTL_ZERO_BYTES = 65536;
constexpr int CW_PANEL = 8192;

#if (REP_MASK >> 2) & 1
#define SUBON2(bit) (rep == 0 || ((REP_SUB >> (bit)) & 1))
#else
#define SUBON2(bit) true
#endif
#if (REP_MASK >> 3) & 1
#define SUBON3(bit) (rep == 0 || ((REP_SUB >> (bit)) & 1))
#else
#define SUBON3(bit) true
#endif
#if (REP_MASK >> 4) & 1
#define SUBON4(bit) (rep == 0 || ((REP_SUB >> (bit)) & 1))
#else
#define SUBON4(bit) true
#endif
__global__ void __launch_bounds__(NTHREADS, 2) mega(Args a) {
    extern __shared__ __attribute__((aligned(16))) unsigned char lds[];
    cg::grid_group grid = cg::this_grid();
    const int wave = __builtin_amdgcn_readfirstlane(threadIdx.x >> 6);
#define MKLANE() ({ int l_; asm volatile("v_mbcnt_lo_u32_b32 %0, -1, 0\n\tv_mbcnt_hi_u32_b32 %0, -1, %0" : "=v"(l_)); l_; })
#define MKTID() (wave * 64 + MKLANE())
#define tid MKTID()
#define lane MKLANE()
    const int G = gridDim.x, bx = blockIdx.x;
    const int vcu = (G % 8 == 0) ? (bx % 8) * (G / 8) + bx / 8 : bx;
    const int gw = vcu * NWAVES + wave, NGW = G * NWAVES;
    unsigned char* ws = a.ws;
    const float* x = a.in[0]; const float* p = a.in[1]; const float* attn_norm = a.in[2]; const float* w_in = a.in[3]; const float* ret_norm = a.in[4]; const float* w_out = a.in[5];
    const float* ffn_norm = a.in[6]; const float* w_up = a.in[7]; const float* w_gate = a.in[8]; const float* conv_w = a.in[9]; const float* conv_b = a.in[10]; const float* w_down = a.in[11];
    const float* ple_norm = a.in[12]; const float* w_ple = a.in[13]; const float* w_ple_gate = a.in[14]; const float* final_norm = a.in[15];
    float* out = a.out;
    bf16_t* Win_t = (bf16_t*)(ws + WS_WIN); bf16_t* Wout_t = (bf16_t*)(ws + WS_WOUT); bf16_t* Wug_t = (bf16_t*)(ws + WS_WUG); bf16_t* Wdown_t = (bf16_t*)(ws + WS_WDOWN);
    bf16_t* Wpg_t = (bf16_t*)(ws + WS_WPG); bf16_t* Wple_t = (bf16_t*)(ws + WS_WPLE);
    bf16_t* XN = (bf16_t*)(ws + WS_R1); bf16_t* MIX = (bf16_t*)(ws + WS_SEG); bf16_t* PW = (bf16_t*)(ws + WS_R1);
    float* RS0 = (float*)(ws + WS_CNT + 768 * 1024);
    unsigned* KMX = (unsigned*)(ws + WS_CNT + 896 * 1024);
    bf16_t* XB = (bf16_t*)(ws + WS_R2);
    bf16_t* PROJ = (bf16_t*)(ws + WS_PROJ); bf16_t* ACT = (bf16_t*)(ws + WS_PROJ);
    bf16_t* PB = (bf16_t*)(ws + WS_PB); float* RSQ = (float*)(ws + WS_RSQ);
    float* KM = (float*)(ws + WS_KMEAN);
    float* UL = (float*)(ws + WS_STASH); float* UF = UL + STASH_ELEMS; float* GF = UF + STASH_ELEMS;
    float* KVT = (float*)(ws + WS_KVT); bf16_t* STT = (bf16_t*)(ws + WS_STT); float* PART_L = (float*)(ws + WS_PARTL); bf16_t* PART_O = (bf16_t*)out;
    u32* SEL = (u32*)(ws + WS_SEL); unsigned short* SEG = (unsigned short*)(ws + WS_SEG); int* CNT = (int*)(ws + WS_CNT);

    const int lo = a.ph_lo, hi = a.ph_hi;
#if DIAG_K >= 0
    unsigned long long* dts = (unsigned long long*)(ws + WS_CTL + 49152);
#define DIAG_STAMP(i) do { if (bx == DIAG_BLOCK && wave == 0 && MKLANE() == 0) __hip_atomic_store(dts + (i), (unsigned long long)__builtin_amdgcn_s_memrealtime(), __ATOMIC_RELAXED, __HIP_MEMORY_SCOPE_AGENT); } while (0)
    DIAG_STAMP(0);
#define DIAG_DTS(it) ((bx == DIAG_BLOCK && (it) == bx) ? dts : (unsigned long long*)nullptr)
#else
#define DIAG_STAMP(i) do { } while (0)
#define DIAG_DTS(it) ((unsigned long long*)nullptr)
#endif
#define IN(k) (lo <= (k) && (k) < hi)
#define SEAM(k) do { if (IN(k) && IN((k) + 1)) { DIAG_STAMP(40 + (k)); if (a.ph_lo < 0) grid.sync(); else xcd_barrier(xbar); DIAG_STAMP(1 + (k)); } } while (0)
    { volatile LAS unsigned* st = (volatile LAS unsigned*)((LAS unsigned char*)lds + LDS_BARST); if (tid < 2) st[tid] = 0u; }
    __syncthreads();
    XcdBarrier xbar = xcd_barrier_post((unsigned*)(ws + WS_CTL) + CW_BAR, (volatile LAS unsigned*)((LAS unsigned char*)lds + LDS_BARST));

#if (REP_MASK >> 0) & 1
    for (int rep = 0; rep < 2; ++rep)
#endif
    if (IN(0)) {
        LAS float* scr = (LAS float*)(lds) + wave * (64 * 33);
        constexpr int I_IN = 16 * (NPROJ / 32), I_OUT = 16 * (DM / 32), I_UP = 16 * (FF / 32), I_DOWN = (FF / 64) * (DM / 32), I_PG = 16 * (DM / 32), I_PLE = (PLED / 64) * (DM / 32);
        constexpr int NITEMS = I_IN + I_OUT + 2 * I_UP + I_DOWN + I_PG + I_PLE;
        for (int it = gw; it < NITEMS; it += NGW) {
            int r = it;
            if (r < I_IN) { const int nb = r % (NPROJ / 32), kb = r / (NPROJ / 32); p0_transpose_item(w_in, DM, NPROJ, nullptr, Win_t, kb * 64, nb * 32, nb * 32, scr, lane); continue; } r -= I_IN;
            if (r < I_OUT) { const int nb = r % (DM / 32), kb = r / (DM / 32); p0_transpose_item(w_out, DM, DM, nullptr, Wout_t, kb * 64, nb * 32, nb * 32, scr, lane); continue; } r -= I_OUT;
            if (r < I_UP) { const int nb = r % (FF / 32), kb = r / (FF / 32), n0 = nb * 32; p0_transpose_item(w_up, DM, FF, ffn_norm, Wug_t, kb * 64, n0, (n0 >> 7) * 256 + (n0 & 127), scr, lane); continue; } r -= I_UP;
            if (r < I_UP) { const int nb = r % (FF / 32), kb = r / (FF / 32), n0 = nb * 32; p0_transpose_item(w_gate, DM, FF, ffn_norm, Wug_t, kb * 64, n0, (n0 >> 7) * 256 + 128 + (n0 & 127), scr, lane); continue; } r -= I_UP;
            if (r < I_DOWN) { const int nb = r % (DM / 32), kb = r / (DM / 32); p0_transpose_item(w_down, FF, DM, nullptr, Wdown_t, kb * 64, nb * 32, nb * 32, scr, lane); continue; } r -= I_DOWN;
            if (r < I_PG) { const int nb = r % (DM / 32), kb = r / (DM / 32); p0_transpose_item(w_ple_gate, DM, DM, ple_norm, Wpg_t, kb * 64, nb * 32, nb * 32, scr, lane); continue; } r -= I_PG;
            { const int nb = r % (DM / 32), kb = r / (DM / 32); p0_transpose_item(w_ple, PLED, DM, nullptr, Wple_t, kb * 64, nb * 32, nb * 32, scr, lane); }
        }
        DIAG_STAMP(12);
        for (int m = gw; m < MT; m += 2 * NGW) {
            const int m2 = m + NGW;
            const float4* xr = (const float4*)(x + (size_t)m * DM); const float4* xr2 = (const float4*)(x + (size_t)m2 * DM); float4 v[4], w[4]; float s = 0.f, s2 = 0.f;
#pragma unroll
            for (int j = 0; j < 4; ++j) { v[j] = xr[lane + 64 * j]; w[j] = xr2[lane + 64 * j]; }
#pragma unroll
            for (int j = 0; j < 4; ++j) { s += v[j].x * v[j].x + v[j].y * v[j].y + v[j].z * v[j].z + v[j].w * v[j].w; s2 += w[j].x * w[j].x + w[j].y * w[j].y + w[j].z * w[j].z + w[j].w * w[j].w; }
            const float rs = rsqrtf(wave_sum(s) * (1.0f / DM) + RMS_EPS), rs2 = rsqrtf(wave_sum(s2) * (1.0f / DM) + RMS_EPS);
            if (lane == 0) { RS0[m] = rs; RS0[m2] = rs2; }
#pragma unroll
            for (int j = 0; j < 4; ++j) { const float4 gg = ((const float4*)attn_norm)[lane + 64 * j];
                ushort4 o; o.x = f2bf(v[j].x * rs * gg.x); o.y = f2bf(v[j].y * rs * gg.y); o.z = f2bf(v[j].z * rs * gg.z); o.w = f2bf(v[j].w * rs * gg.w);
                ((ushort4*)(XN + (size_t)m * DM))[lane + 64 * j] = o;
                ushort4 o2; o2.x = f2bf(w[j].x * rs2 * gg.x); o2.y = f2bf(w[j].y * rs2 * gg.y); o2.z = f2bf(w[j].z * rs2 * gg.z); o2.w = f2bf(w[j].w * rs2 * gg.w);
                ((ushort4*)(XN + (size_t)m2 * DM))[lane + 64 * j] = o2; }
        }
        DIAG_STAMP(13);
        { const size_t n4 = (size_t)MT * PLED / 4; const size_t gt = (size_t)vcu * NTHREADS + tid, GT = (size_t)G * NTHREADS;
          for (size_t i = gt; i < n4; i += GT) { const float4 v = ((const float4*)p)[i]; ushort4 o; o.x = f2bf(v.x); o.y = f2bf(v.y); o.z = f2bf(v.z); o.w = f2bf(v.w); ((ushort4*)PB)[i] = o; }
          for (size_t i = gt; i < 16 * 64 * 64; i += GT) KM[i] = 0.f;
          if (gt < 16 * 64 * 2) KMX[gt] = 0u;
          if (gt < 64) ((int*)(ws + WS_CTL))[gt] = 0;
          for (size_t i = gt; i < 16 * 64 * 64; i += GT) CNT[i] = 0; }
    }
    SEAM(0);
#if (REP_MASK >> 1) & 1
    if (IN(1)) {
        pg8::Gemm g{XN, Win_t, MT, NPROJ, DM}; pg8::StaticOrder S; S.init(MT, NPROJ, G, bx);
        pg8::EpiProj E{PROJ, KM, KMX};
        pg8::gemm_phase<pg8::EpiProj, pg8::StaticOrder, true, true>((PG8_LAS unsigned char*)lds, g, S, E, MKTID());
    }
    asm volatile("" ::: "memory");
#endif
    if (IN(1)) {
        pg8::Gemm g{XN, Win_t, MT, NPROJ, DM}; pg8::StaticOrder S; S.init(MT, NPROJ, G, bx);
        pg8::EpiProj E{PROJ, KM, KMX};
        pg8::gemm_phase<pg8::EpiProj, pg8::StaticOrder, true, true>((PG8_LAS unsigned char*)lds, g, S, E, MKTID());
    }
    SEAM(1);
#if (REP_MASK >> 2) & 1
    { const int rep = 1; (void)rep;
    if (IN(2)) {
        mx::lds_ptr L = (mx::lds_ptr)lds;
        if (!(a.flags & 1) && SUBON2(0)) for (int it = bx; it < 512; it += G) mx::ret_kv_task(PROJ, it >> 6, it & 63, KVT, L, tid);
        if (!(a.flags & 2)) {
            if (SUBON2(1)) for (int it = bx; it < 16 * 63; it += G) mx::gate_task_mfma(it / 63, 1 + it % 63, PROJ, KM, SEL, SEG, CNT, KMX, PART_L, L, tid);
            { const int gtid = vcu * NTHREADS + tid; if (gtid < BATCH * 256 * 8) { const int h = gtid & 7, t = (gtid >> 3) & 255, b = gtid >> 11; SEL[((size_t)b * SEQ + t) * 8 + h] = 0u; } }
        }
    }
    }
    asm volatile("" ::: "memory");
#endif
    { const int rep = 0; (void)rep;
    if (IN(2)) {
        mx::lds_ptr L = (mx::lds_ptr)lds;
        if (!(a.flags & 1) && SUBON2(0)) for (int it = bx; it < 512; it += G) mx::ret_kv_task(PROJ, it >> 6, it & 63, KVT, L, tid);
        DIAG_STAMP(14);
        if (!(a.flags & 2)) {
            if (SUBON2(1)) for (int it = bx; it < 16 * 63; it += G) mx::gate_task_mfma(it / 63, 1 + it % 63, PROJ, KM, SEL, SEG, CNT, KMX, PART_L, L, tid);
        DIAG_STAMP(15);
            { const int gtid = vcu * NTHREADS + tid; if (gtid < BATCH * 256 * 8) { const int h = gtid & 7, t = (gtid >> 3) & 255, b = gtid >> 11; SEL[((size_t)b * SEQ + t) * 8 + h] = 0u; } }
        }
    }
    }
    SEAM(2);
#if (REP_MASK >> 3) & 1
#define QREP rep
#else
#define QREP 0
#endif
#if (REP_MASK >> 3) & 1
    for (int rep = 0; rep < 2; ++rep)
#endif
    if (IN(3)) {
        mx::lds_ptr L = (mx::lds_ptr)lds;
        if (!(a.flags & 1) && SUBON3(0)) mx::ret_scan(KVT, STT, (size_t)vcu * NTHREADS + tid, (size_t)G * NTHREADS);
        DIAG_STAMP(18);
        if (!(a.flags & 2) && SUBON3(1)) {
            LAS int* qslot = (LAS int*)(L + mx::L_PREF + 384);
            for (;;) {
                if (tid == 0) *qslot = atomicAdd((int*)(ws + WS_CTL) + QREP, 1);
                __syncthreads();
                const int q = *qslot;
                __syncthreads();
                if (q >= 16 * 63) break;
                mx::moba_sel_task(PROJ, SEG, CNT, q & 15, q >> 4, PART_O, PART_L, L, tid);
            }
        }
        DIAG_STAMP(19);
    }
    SEAM(3);
#if (REP_MASK >> 4) & 1
    { const int rep = 1; (void)rep;
    if (IN(4)) {
        mx::lds_ptr L = (mx::lds_ptr)lds;
        if (!(a.flags & 1) && SUBON4(0)) for (int it = bx; it < 512; it += G) mx::ret_out_task(PROJ, STT, ret_norm, MIX, it >> 6, it & 63, L, tid);
        if (!(a.flags & 2) && SUBON4(1)) for (int it = bx; it < 16 * 64; it += G) mx::moba_diag_unit(PROJ, it >> 6, it & 63, PART_O, PART_L, SEL, MIX, L, tid);
    }
    }
    asm volatile("" ::: "memory");
#endif
    { const int rep = 0; (void)rep;
    if (IN(4)) {
        mx::lds_ptr L = (mx::lds_ptr)lds;
        if (P4_DIAG_FIRST(vcu)) for (int it = bx; it < 16 * 64; it += G) mx::moba_diag_unit(PROJ, it >> 6, it & 63, PART_O, PART_L, SEL, MIX, L, tid);
        for (int it = bx; it < 512; it += G) mx::ret_out_task(PROJ, STT, ret_norm, MIX, it >> 6, it & 63, L, tid, DIAG_DTS(it));
        DIAG_STAMP(16);
        if (!P4_DIAG_FIRST(vcu)) for (int it = bx; it < 16 * 64; it += G) mx::moba_diag_unit(PROJ, it >> 6, it & 63, PART_O, PART_L, SEL, MIX, L, tid);
        DIAG_STAMP(17);
    }
    }
    SEAM(4);
#if (REP_MASK >> 5) & 1
    if (IN(5)) {
        pg8::Gemm g{MIX, Wout_t, MT, DM, DM}; pg8::StaticOrder S; S.init(MT, DM, G, bx);
        pg8::EpiRes<false> E{x, XB, RSQ};
        pg8::gemm_phase<pg8::EpiRes<false>, pg8::StaticOrder, true, true>((PG8_LAS unsigned char*)lds, g, S, E, MKTID());
    }
    asm volatile("" ::: "memory");
#endif
    if (IN(5)) {
        pg8::Gemm g{MIX, Wout_t, MT, DM, DM}; pg8::StaticOrder S; S.init(MT, DM, G, bx);
        pg8::EpiResXN E{XN, RS0, attn_norm, XB, RSQ};
        pg8::gemm_phase<pg8::EpiResXN, pg8::StaticOrder, true, true>((PG8_LAS unsigned char*)lds, g, S, E, MKTID());
    }
    SEAM(5);
#if (REP_MASK >> 6) & 1
    if (IN(6)) {
        pg8::Gemm g{XB, Wug_t, MT, 2 * FF, DM}; pg8::StaticOrder S; S.init(MT, 2 * FF, G, bx);
        pg8::EpiUG E{ACT, RSQ, conv_w, conv_b, UL, UF, GF};
        pg8::gemm_phase<pg8::EpiUG, pg8::StaticOrder, true, true>((PG8_LAS unsigned char*)lds, g, S, E, MKTID());
    }
    asm volatile("" ::: "memory");
#endif
    if (IN(6)) {
        pg8::Gemm g{XB, Wug_t, MT, 2 * FF, DM}; pg8::StaticOrder S; S.init(MT, 2 * FF, G, bx);
        pg8::EpiUG E{ACT, RSQ, conv_w, conv_b, UL, UF, GF};
        pg8::gemm_phase<pg8::EpiUG, pg8::StaticOrder, true, true>((PG8_LAS unsigned char*)lds, g, S, E, MKTID());
    }
    SEAM(6);
#if (REP_MASK >> 7) & 1
    for (int rep = 0; rep < 2; ++rep)
#endif
    if (IN(7)) {
        const size_t gt = (size_t)vcu * NTHREADS + tid, GT = (size_t)G * NTHREADS;
        for (size_t i = gt; i < (size_t)512 * 2 * (FF / 4); i += GT) {
            const int c = (int)(i % (FF / 4)) * 4, r = (int)((i / (FF / 4)) & 1), g64 = (int)(i / (FF / 4) / 2);
            const bool first = (g64 & 255) == 0; const size_t pg = first ? 0 : (size_t)(g64 - 1);
            const pg8::f32x4 q0 = *(const pg8::f32x4*)(UL + (pg * 2 + 0) * FF + c), q1 = *(const pg8::f32x4*)(UL + (pg * 2 + 1) * FF + c);
            const pg8::f32x4 f0 = *(const pg8::f32x4*)(UF + ((size_t)g64 * 2 + 0) * FF + c), f1 = *(const pg8::f32x4*)(UF + ((size_t)g64 * 2 + 1) * FF + c);
            const pg8::f32x4 gg = *(const pg8::f32x4*)(GF + ((size_t)g64 * 2 + r) * FF + c);
            const pg8::f32x4 w0 = *(const pg8::f32x4*)(conv_w + c), w1 = *(const pg8::f32x4*)(conv_w + FF + c), w2 = *(const pg8::f32x4*)(conv_w + 2 * FF + c), cb = *(const pg8::f32x4*)(conv_b + c);
            const float z = first ? 0.f : 1.f;
            const pg8::f32x4 p0 = q0 * z, p1 = q1 * z;
            const pg8::f32x4 u2 = r == 0 ? p0 : p1, u1 = r == 0 ? p1 : f0, u0 = r == 0 ? f0 : f1;
            const pg8::f32x4 y = cb + w0 * u2 + w1 * u1 + w2 * u0;
            ushort4 o; o.x = f2bf(gelu_tanh(y[0]) * gg[0]); o.y = f2bf(gelu_tanh(y[1]) * gg[1]); o.z = f2bf(gelu_tanh(y[2]) * gg[2]); o.w = f2bf(gelu_tanh(y[3]) * gg[3]);
            *(ushort4*)(ACT + ((size_t)g64 * 64 + r) * FF + c) = o;
        }
        { int kk = PLED; asm volatile("" : "+s"(kk)); pg8::Gemm g{PB, Wple_t, MT, DM, kk}; pg8::StaticOrder S; S.init(MT, DM, G, bx); pg8::EpiStore E{PW};
          pg8::gemm_phase<pg8::EpiStore, pg8::StaticOrder, true, true>((PG8_LAS unsigned char*)lds, g, S, E, MKTID()); }
    }
    SEAM(7);
#if (REP_MASK >> 8) & 1
    if (IN(8)) {
        pg8::Gemm g{ACT, Wdown_t, MT, DM, FF}; pg8::StaticOrder S; S.init(MT, DM, G, bx);
        pg8::EpiRes<true, false> E{nullptr, XB, RSQ + (size_t)MT * 16};
        pg8::gemm_phase<pg8::EpiRes<true, false>, pg8::StaticOrder, true, true>((PG8_LAS unsigned char*)lds, g, S, E, MKTID());
    }
    asm volatile("" ::: "memory");
#endif
    if (IN(8)) {
        pg8::Gemm g{ACT, Wdown_t, MT, DM, FF}; pg8::StaticOrder S; S.init(MT, DM, G, bx);
        pg8::EpiRes<true> E{nullptr, XB, RSQ + (size_t)MT * 16};
        pg8::gemm_phase<pg8::EpiRes<true>, pg8::StaticOrder, true, true>((PG8_LAS unsigned char*)lds, g, S, E, MKTID());
    }
    SEAM(8);
#if (REP_MASK >> 9) & 1
    if (IN(9)) {
        if (REP_SUB & 1) { int kk = PLED; asm volatile("" : "+s"(kk)); pg8::Gemm g{PB, Wple_t, MT, DM, kk}; pg8::StaticOrder S; S.init(MT, DM, G, bx); pg8::EpiStore E{PW};
          pg8::gemm_phase<pg8::EpiStore, pg8::StaticOrder, true, true>((PG8_LAS unsigned char*)lds, g, S, E, MKTID()); }
        if (REP_SUB & 2) { int kk = DM; const bf16_t* a_ = XB; const bf16_t* b_ = Wpg_t; asm volatile("" : "+s"(kk), "+s"(a_), "+s"(b_) :: "memory"); pg8::Gemm g{a_, b_, MT, DM, kk}; pg8::StaticOrder S; S.init(MT, DM, G, bx); pg8::EpiPleNorm E{out, XB, PW, RSQ + (size_t)MT * 16, RSQ + (size_t)2 * MT * 16, (unsigned*)(ws + WS_CTL) + CW_PANEL, final_norm, DIAG_DTS(bx)};
          pg8::gemm_phase<pg8::EpiPleNorm, pg8::StaticOrder, true, true>((PG8_LAS unsigned char*)lds, g, S, E, MKTID()); }
    }
    asm volatile("" ::: "memory");
#endif
    if (IN(9)) {
        DIAG_STAMP(20);
        { int kk = DM; const bf16_t* a_ = XB; const bf16_t* b_ = Wpg_t; asm volatile("" : "+s"(kk), "+s"(a_), "+s"(b_) :: "memory"); pg8::Gemm g{a_, b_, MT, DM, kk}; pg8::StaticOrder S; S.init(MT, DM, G, bx); pg8::EpiPleNorm E{out, XB, PW, RSQ + (size_t)MT * 16, RSQ + (size_t)2 * MT * 16, (unsigned*)(ws + WS_CTL) + CW_PANEL, final_norm, DIAG_DTS(bx)};
          pg8::gemm_phase<pg8::EpiPleNorm, pg8::StaticOrder, true, true>((PG8_LAS unsigned char*)lds, g, S, E, MKTID()); }
    }
    SEAM(9);
    if (IN(10)) {
        const float* rsq = RSQ + (size_t)2 * MT * 16;
        for (int m = gw; m < MT; m += NGW) {
            const float rs = pg8::rs16(rsq + (size_t)m * 16); float4* xr = (float4*)(out + (size_t)m * DM);
#pragma unroll
            for (int j = 0; j < 4; ++j) { float4 v = xr[lane + 64 * j]; const float4 gg = ((const float4*)final_norm)[lane + 64 * j];
                v.x *= rs * gg.x; v.y *= rs * gg.y; v.z *= rs * gg.z; v.w *= rs * gg.w; xr[lane + 64 * j] = v; }
        }
    }
#if DIAG_K >= 0
    xcd_barrier(xbar); DIAG_STAMP(11);
    xcd_barrier(xbar);
    { const unsigned long long t0 = __hip_atomic_load(dts + 0, __ATOMIC_RELAXED, __HIP_MEMORY_SCOPE_AGENT), t1 = __hip_atomic_load(dts + 11, __ATOMIC_RELAXED, __HIP_MEMORY_SCOPE_AGENT);
      const unsigned long long ta = __hip_atomic_load(dts + (DIAG_K == 99 ? DIAG_A : DIAG_K), __ATOMIC_RELAXED, __HIP_MEMORY_SCOPE_AGENT), tb = DIAG_K == 99 ? __hip_atomic_load(dts + DIAG_B, __ATOMIC_RELAXED, __HIP_MEMORY_SCOPE_AGENT) : (DIAG_K == 9 ? t1 : __hip_atomic_load(dts + DIAG_K + 1, __ATOMIC_RELAXED, __HIP_MEMORY_SCOPE_AGENT));
      const float eps = (float)(tb - ta) / (float)(t1 - t0);
      const float sc = 1.0f + DIAG_SCALE * eps;
      float4* o4 = (float4*)out; const size_t gt = (size_t)vcu * NTHREADS + tid, GT = (size_t)G * NTHREADS;
      for (size_t i = gt; i < (size_t)MT * DM / 4; i += GT) { float4 v = o4[i]; v.x *= sc; v.y *= sc; v.z *= sc; v.w *= sc; o4[i] = v; } }
#endif
#undef IN
#undef SEAM
#undef tid
#undef lane
}

#ifndef BUILD_MODE
#define BUILD_MODE 0
#endif
static int g_grid = 0;
static void launch_mega(Args a, int lo, int hi, hipStream_t stream) {
    a.ph_lo = lo; a.ph_hi = hi; void* args[] = {&a};
    hipError_t e = hipLaunchCooperativeKernel((const void*)mega, dim3(g_grid), dim3(NTHREADS), args, LDS_BYTES, stream);
    if (e != hipSuccess) fprintf(stderr, "cooperative launch [%d,%d) failed: %s (grid %d)\n", lo, hi, hipGetErrorString(e), g_grid);
}
extern "C" void kernel_launch(void* const* d_in, const int* in_sizes, int n_in, void* d_out, int out_size, void* d_ws, size_t ws_size, hipStream_t stream) {
    if (n_in != 16 || out_size != MT * DM || ws_size < WS_END) { fprintf(stderr, "kernel_launch: unexpected shapes (n_in %d out %d ws %zu)\n", n_in, out_size, ws_size); return; }
    if (g_grid == 0) {
        int dev = 0, cus = 0, per_cu = 0;
        hipGetDevice(&dev); hipDeviceGetAttribute(&cus, hipDeviceAttributeMultiprocessorCount, dev);
        hipFuncSetAttribute((const void*)mega, hipFuncAttributeMaxDynamicSharedMemorySize, LDS_BYTES);
        hipOccupancyMaxActiveBlocksPerMultiprocessor(&per_cu, (const void*)mega, NTHREADS, LDS_BYTES);
        if (per_cu < 1) { fprintf(stderr, "occupancy query says %d blocks/CU\n", per_cu); per_cu = 1; }
        g_grid = cus * 1;
        (void)hipGetLastError();
    }
    unsigned char* ws = (unsigned char*)d_ws;
    hipMemsetAsync(ws + WS_CTL, 0, CTL_ZERO_BYTES, stream);
    Args a{}; for (int i = 0; i < 16; ++i) a.in[i] = (const float*)d_in[i]; a.out = (float*)d_out; a.ws = ws;

    a.flags = 0; launch_mega(a, 0, NPH, stream);
}
```

```cpp
#include <hip/hip_runtime.h>
#include <stdint.h>
#include <math.h>
#include <cstdio>

typedef unsigned short bf16_t;
typedef unsigned int u32;

constexpr int BATCH = 2, SEQ = 16384, MT = BATCH * SEQ, DM = 1024, NPROJ = 3584, FF = 2816, PLED = 256;
constexpr int MH = 8, MD = 64, RH = 4, RD = 128, NBLK = 64, BLK = 256;
constexpr int C_MQ = 0, C_MK = 512, C_MV = 1024, C_RQ = 1536, C_RK = 2048, C_RV = 2560, C_RG = 3072;
constexpr float RMS_EPS = 1e-6f, GN_EPS = 1e-5f;
constexpr float LOG2E = 1.4426950408889634f;
constexpr float QSCALE = 0.125f * LOG2E;
constexpr float RKSCALE = 0.08838834764831845f;
constexpr size_t SEC = (size_t)MT * 512;

constexpr size_t MiB = (size_t)1 << 20;
constexpr size_t WS_CTL = 0, WS_WIN = 1 * MiB, WS_WOUT = 8 * MiB, WS_WUG = 10 * MiB, WS_WDOWN = 21 * MiB, WS_WPG = 27 * MiB, WS_WPLE = 29 * MiB;
constexpr size_t WS_RSQ = 30 * MiB;
constexpr size_t WS_PB = 36 * MiB;
constexpr size_t WS_R2 = 52 * MiB;
constexpr size_t WS_R1 = 116 * MiB;
constexpr size_t WS_SEG = 180 * MiB;
constexpr size_t WS_KVT = 212 * MiB;
constexpr size_t WS_STT = 244 * MiB;
constexpr size_t WS_PARTL = 260 * MiB;
constexpr size_t WS_SEL = 264 * MiB;
constexpr size_t WS_CNT = 265 * MiB;
constexpr size_t WS_KMEAN = WS_CNT + 512 * 1024;
constexpr size_t WS_PROJ = 266 * MiB;
constexpr size_t WS_X8 = 442 * MiB;
constexpr size_t WS_WUG8 = 490 * MiB, WS_WPG8 = 496 * MiB, WS_WSC = 497 * MiB;
constexpr size_t WS_END = 498 * MiB;
constexpr float CQ = 6.0f;
constexpr size_t WS_UH = 116 * MiB;

__device__ __forceinline__ float bf2f(bf16_t v) { return __uint_as_float(((u32)v) << 16); }
__device__ __forceinline__ bf16_t f2bf(float f) { u32 u = __float_as_uint(f); return (bf16_t)((u + 0x7fffu + ((u >> 16) & 1u)) >> 16); }
__device__ __forceinline__ float wave_sum(float v) {
#pragma unroll
    for (int o = 1; o < 64; o <<= 1) v += __shfl_xor(v, o);
    return v;
}
__device__ __forceinline__ float rs_from(const float* p) {
    float s = 0.f;
#pragma unroll
    for (int i = 0; i < 16; ++i) s += p[i];
    return rsqrtf(s * (1.0f / DM) + RMS_EPS);
}
__device__ __forceinline__ float gelu_tanh(float x) {
    const float z = 0.7978845608028654f * (x + 0.044715f * x * x * x);
    return x / (1.0f + __expf(-2.0f * z));
}
__device__ __forceinline__ float sigmoidf_(float x) { return 1.0f / (1.0f + __expf(-x)); }


typedef unsigned u32x4_g __attribute__((ext_vector_type(4)));
__device__ __forceinline__ void wt_store16(void* base_uniform, size_t byte_off, u32x4_g v) {
    __builtin_amdgcn_raw_buffer_store_b128(v, __builtin_amdgcn_make_buffer_rsrc(base_uniform, 0, 0x7ffffff0, 0x00020000), (int)byte_off, 0, 16);
}
namespace pg8 {
#define PG8_LAS __attribute__((address_space(3)))
typedef unsigned short bf16_t;
typedef short bf16x8 __attribute__((ext_vector_type(8)));
typedef float f32x4 __attribute__((ext_vector_type(4)));
typedef unsigned u32x4 __attribute__((ext_vector_type(4)));
typedef int i32x4 __attribute__((ext_vector_type(4)));
constexpr int BM = 256, BK = 64, HALF = 128, HTB = HALF * BK * 2  , STAGE_BYTES = 8 * HTB, NXCD = 8, WGM = 8;

__host__ __device__ __forceinline__ int lds_byte(int r, int c) { const int st = (r >> 4) * 2 + (c >> 5), rr = r & 15, cc = c & 31, ob = rr * 64 + cc * 2; return st * 1024 + (ob ^ (((ob >> 9) & 1) << 5)); }
__host__ __device__ __forceinline__ void stage_rc(int b, int& R, int& C) { const int st = b / 1024, sb = b % 1024, swz = sb ^ (((sb >> 9) & 1) << 5); R = (st >> 1) * 16 + swz / 64; C = (st & 1) * 32 + (swz % 64) / 2; }
__host__ __device__ __forceinline__ int perm32(int rho) { const int n = rho >> 4, i = rho & 15; return 8 * (i >> 2) + 4 * n + (i & 3); }

struct Unit { int pm, pn; };
struct Gemm { const bf16_t* A; const bf16_t* Bt; int M, N, K; };

struct StaticOrder {
    int nM, nN, nwg, G, c;
    __host__ __device__ void init(int M, int N, int G_, int c_) { nM = M / BM; nN = N / BM; nwg = nM * nN; G = G_; c = c_; }
    __host__ __device__ bool next(int i, Unit& u) const {
        const long L = (long)i * G + c; if (L >= nwg) return false;
        int wgid = (int)L; { const int q = nwg / NXCD, r = nwg % NXCD, xcd = wgid % NXCD, off = wgid / NXCD; wgid = (xcd < r ? xcd * (q + 1) : r * (q + 1) + (xcd - r) * q) + off; }
        const int nig = WGM * nN, gid = wgid / nig, fm = gid * WGM, gsz = (nM - fm) < WGM ? (nM - fm) : WGM;
        u.pm = fm + ((wgid % nig) % gsz); u.pn = (wgid % nig) / gsz; return true;
    }
    __device__ __forceinline__ void a_ready(const Unit&) const {}
    __device__ __forceinline__ void done(const Unit&) const {}
};

__device__ __forceinline__ unsigned cvt_pk_bf16(float lo, float hi) { unsigned r; asm volatile("v_cvt_pk_bf16_f32 %0, %1, %2" : "=v"(r) : "v"(lo), "v"(hi)); return r; }
typedef float f32x2 __attribute__((ext_vector_type(2)));
template <class Epi, class Sched, bool ALIGN_EPI = false, bool SP2 = false, bool I8 = false>
__device__ __forceinline__ void gemm_phase(PG8_LAS unsigned char* lds, const Gemm g, const Sched& S, const Epi& E, const int tid_in) {
    const int tid = tid_in, wid = __builtin_amdgcn_readfirstlane(tid >> 6), lane = tid & 63, wr = wid >> 2, wc = wid & 3, fr = lane & 15, fq = lane >> 4;
    const int K = g.K, nt = K / BK;
    unsigned voffA[2], voffB[2];
#pragma unroll
    for (int i = 0; i < 2; ++i) { int R, C; stage_rc(tid * 16 + i * 8192, R, C); const int Rb = Epi::PERM ? ((R & ~31) + perm32(R & 31)) : R;
        voffA[i] = (unsigned)(R * K + C) * 2u; voffB[i] = (unsigned)(Rb * K + C) * 2u; }
    const size_t kstep = (size_t)(BK * 2);
    const size_t hstep = (size_t)HALF * K * 2;
    const size_t tstep = 2 * hstep;
    const unsigned ldsw = (unsigned)wid * 1024u;
    const int aoff = lds_byte(wr * 64 + fr, fq * 8), boff = lds_byte(wc * 32 + fr, fq * 8);
#define PG8_SA(b, h) (((b) * 2 + (h)) * HTB)
#define PG8_SB(b, h) ((4 + (b) * 2 + (h)) * HTB)
#define PG8_STAGE(bufoff, gbase, voff) do { _Pragma("unroll") for (int _i = 0; _i < 2; ++_i) \
        __builtin_amdgcn_global_load_lds((const unsigned*)((const char*)(gbase) + (voff)[_i]), (PG8_LAS unsigned*)(lds + (bufoff) + ldsw + _i * 8192), 16, 0, 0); } while (0)
#define PG8_LDA(dst, b, h) do { _Pragma("unroll") for (int m = 0; m < 4; ++m) _Pragma("unroll") for (int k = 0; k < 2; ++k) dst[m][k] = *(const PG8_LAS bf16x8*)(lds + PG8_SA(b, h) + aoff + m * 2048 + k * 1024); } while (0)
#define PG8_LDB(dst, b, h) do { _Pragma("unroll") for (int n = 0; n < 2; ++n) _Pragma("unroll") for (int k = 0; k < 2; ++k) dst[n][k] = *(const PG8_LAS bf16x8*)(lds + PG8_SB(b, h) + boff + n * 2048 + k * 1024); } while (0)
#define PG8_MMA(ai, bj, At, Bt) do { __builtin_amdgcn_s_setprio(1); _Pragma("unroll") for (int m = 0; m < 4; ++m) _Pragma("unroll") for (int n = 0; n < 2; ++n) _Pragma("unroll") for (int k = 0; k < 2; ++k) \
        { if constexpr (I8) acc[ai][bj][m][n] = __builtin_bit_cast(f32x4, __builtin_amdgcn_mfma_i32_16x16x64_i8(__builtin_bit_cast(i32x4, Bt[n][k]), __builtin_bit_cast(i32x4, At[m][k]), __builtin_bit_cast(i32x4, acc[ai][bj][m][n]), 0, 0, 0)); \
          else acc[ai][bj][m][n] = __builtin_amdgcn_mfma_f32_16x16x32_bf16(Bt[n][k], At[m][k], acc[ai][bj][m][n], 0, 0, 0); } __builtin_amdgcn_s_setprio(0); } while (0)
#define PG8_WAIT_V(n) asm volatile("s_waitcnt vmcnt(" #n ")" ::: "memory")
#define PG8_WAIT_L(n) asm volatile("s_waitcnt lgkmcnt(" #n ")" ::: "memory")
#define PG8_BAR __builtin_amdgcn_s_barrier()
#define PG8_SCHED __builtin_amdgcn_sched_barrier(0)
    Unit cur, nxt; int ui = 0;
    if (!S.next(0, cur)) return;
    f32x4 acc[2][2][4][2];
#pragma unroll
    for (int a = 0; a < 2; ++a)
#pragma unroll
        for (int b = 0; b < 2; ++b)
#pragma unroll
            for (int m = 0; m < 4; ++m)
#pragma unroll
                for (int n = 0; n < 2; ++n) acc[a][b][m][n] = (f32x4){0.f, 0.f, 0.f, 0.f};
    bf16x8 At[4][2], B0[2][2], B1[2][2];
    const char* cA = (const char*)g.A + (size_t)cur.pm * tstep; const char* cB = (const char*)g.Bt + (size_t)cur.pn * tstep;
    S.a_ready(cur);
    if constexpr (SP2) {
        PG8_STAGE(PG8_SB(0, 0), cB, voffB); PG8_STAGE(PG8_SB(0, 1), cB + hstep, voffB); PG8_STAGE(PG8_SA(0, 0), cA, voffA); PG8_STAGE(PG8_SA(0, 1), cA + hstep, voffA);
        if (wr == 1) PG8_BAR;
        PG8_WAIT_V(2); PG8_BAR;
        PG8_STAGE(PG8_SB(1, 0), cB + kstep, voffB); PG8_STAGE(PG8_SA(1, 0), cA + kstep, voffA); PG8_STAGE(PG8_SB(1, 1), cB + hstep + kstep, voffB);
        PG8_WAIT_V(6); PG8_BAR;
    } else {
        PG8_STAGE(PG8_SB(0, 0), cB, voffB); PG8_STAGE(PG8_SA(0, 0), cA, voffA); PG8_STAGE(PG8_SB(0, 1), cB + hstep, voffB); PG8_STAGE(PG8_SA(0, 1), cA + hstep, voffA);
        if (wr == 1) PG8_BAR;
        PG8_WAIT_V(4); PG8_BAR;
        PG8_STAGE(PG8_SB(1, 0), cB + kstep, voffB); PG8_STAGE(PG8_SA(1, 0), cA + kstep, voffA); PG8_STAGE(PG8_SB(1, 1), cB + hstep + kstep, voffB);
        PG8_WAIT_V(6); PG8_BAR;
    }
    for (;;) {
        const bool has_next = S.next(ui + 1, nxt);
        const char* nA = has_next ? (const char*)g.A + (size_t)nxt.pm * tstep : cA; const char* nB = has_next ? (const char*)g.Bt + (size_t)nxt.pn * tstep : cB;
        for (int t = 0; t < nt; t += 2) {
            const bool last = (t == nt - 2);
            const char* a1 = cA + (size_t)(t + 1) * kstep;
            const char* a2 = last ? nA : cA + (size_t)(t + 2) * kstep; const char* b2 = last ? nB : cB + (size_t)(t + 2) * kstep;
            const char* a3 = a2 + kstep; const char* b3 = b2 + kstep;
            if (last && has_next) S.a_ready(nxt);
            if constexpr (SP2) {
            PG8_LDB(B0, 0, 0); PG8_LDB(B1, 0, 1); PG8_SCHED; PG8_LDA(At, 0, 0); PG8_STAGE(PG8_SA(1, 1), a1 + hstep, voffA);
            PG8_WAIT_V(8); PG8_WAIT_L(0); PG8_BAR; PG8_MMA(0, 0, At, B0); PG8_MMA(0, 1, At, B1); PG8_BAR; PG8_SCHED;
            PG8_LDA(At, 0, 1); PG8_STAGE(PG8_SB(0, 0), b2, voffB); PG8_STAGE(PG8_SB(0, 1), b2 + hstep, voffB); PG8_STAGE(PG8_SA(0, 0), a2, voffA);
            PG8_WAIT_V(8); PG8_WAIT_L(0); PG8_BAR; PG8_MMA(1, 0, At, B0); PG8_MMA(1, 1, At, B1); PG8_BAR; PG8_SCHED;
            PG8_LDB(B0, 1, 0); PG8_LDB(B1, 1, 1); PG8_SCHED; PG8_LDA(At, 1, 0); PG8_STAGE(PG8_SA(0, 1), a2 + hstep, voffA);
            PG8_WAIT_V(8); PG8_WAIT_L(0); PG8_BAR; PG8_MMA(0, 0, At, B0); PG8_MMA(0, 1, At, B1); PG8_BAR; PG8_SCHED;
            PG8_LDA(At, 1, 1); PG8_STAGE(PG8_SB(1, 0), b3, voffB); PG8_STAGE(PG8_SB(1, 1), b3 + hstep, voffB); PG8_STAGE(PG8_SA(1, 0), a3, voffA);
            PG8_WAIT_V(8); PG8_WAIT_L(0); PG8_BAR; PG8_MMA(1, 0, At, B0); PG8_MMA(1, 1, At, B1); PG8_BAR; PG8_SCHED;
            } else {
            PG8_LDB(B0, 0, 0); PG8_SCHED; PG8_LDA(At, 0, 0); PG8_STAGE(PG8_SA(1, 1), a1 + hstep, voffA);
            PG8_WAIT_L(8); PG8_BAR; PG8_WAIT_L(0); PG8_MMA(0, 0, At, B0); PG8_BAR; PG8_SCHED;
            PG8_LDB(B1, 0, 1); PG8_STAGE(PG8_SB(0, 0), b2, voffB);
            PG8_BAR; PG8_WAIT_L(0); PG8_MMA(0, 1, At, B1); PG8_BAR;
            PG8_LDA(At, 0, 1); PG8_STAGE(PG8_SA(0, 0), a2, voffA);
            PG8_BAR; PG8_WAIT_L(0); PG8_MMA(1, 0, At, B0); PG8_BAR; PG8_SCHED;
            PG8_STAGE(PG8_SB(0, 1), b2 + hstep, voffB);
            PG8_WAIT_V(6); PG8_BAR; PG8_MMA(1, 1, At, B1); PG8_BAR;
            PG8_LDB(B0, 1, 0); PG8_SCHED; PG8_LDA(At, 1, 0); PG8_STAGE(PG8_SA(0, 1), a2 + hstep, voffA);
            PG8_WAIT_L(8); PG8_BAR; PG8_WAIT_L(0); PG8_MMA(0, 0, At, B0); PG8_BAR; PG8_SCHED;
            PG8_LDB(B1, 1, 1); PG8_STAGE(PG8_SB(1, 0), b3, voffB);
            PG8_BAR; PG8_WAIT_L(0); PG8_MMA(0, 1, At, B1); PG8_BAR;
            PG8_LDA(At, 1, 1); PG8_STAGE(PG8_SA(1, 0), a3, voffA);
            PG8_BAR; PG8_WAIT_L(0); PG8_MMA(1, 0, At, B0); PG8_BAR; PG8_SCHED;
            PG8_STAGE(PG8_SB(1, 1), b3 + hstep, voffB);
            PG8_WAIT_V(6); PG8_BAR; PG8_MMA(1, 1, At, B1); PG8_BAR;
            }
        }
        if constexpr (ALIGN_EPI) { if (wr == 0) PG8_BAR; }
        if constexpr (!Epi::AFTER_DRAIN) { E(acc, cur, wr, wc, fr, fq); S.done(cur); }
        if (!has_next) break;
#pragma unroll
        for (int a = 0; a < 2; ++a)
#pragma unroll
            for (int b = 0; b < 2; ++b)
#pragma unroll
                for (int m = 0; m < 4; ++m)
#pragma unroll
                    for (int n = 0; n < 2; ++n) acc[a][b][m][n] = (f32x4){0.f, 0.f, 0.f, 0.f};
        cur = nxt; cA = nA; cB = nB; ++ui;
        if constexpr (ALIGN_EPI) { if (wr == 1) PG8_BAR; }
    }
    PG8_WAIT_V(0);
    if constexpr (!ALIGN_EPI) { if (wr == 0) PG8_BAR; }
    PG8_BAR;
    if constexpr (Epi::AFTER_DRAIN) { E.fused(acc, cur, wr, wc, fr, fq, lds, wid, lane); S.done(cur); }
#undef PG8_SA
#undef PG8_SB
#undef PG8_STAGE
#undef PG8_LDA
#undef PG8_LDB
#undef PG8_MMA
#undef PG8_WAIT_V
#undef PG8_WAIT_L
#undef PG8_BAR
#undef PG8_SCHED
}
}
namespace pg8 {
__device__ __forceinline__ u32x4 pack8(f32x4 v0, f32x4 v1) { u32x4 w; w.x = cvt_pk_bf16(v0[0], v0[1]); w.y = cvt_pk_bf16(v0[2], v0[3]); w.z = cvt_pk_bf16(v1[0], v1[1]); w.w = cvt_pk_bf16(v1[2], v1[3]); return w; }
__device__ __forceinline__ float dot4(f32x4 a) { return (a[0] * a[0] + a[1] * a[1]) + (a[2] * a[2] + a[3] * a[3]); }
__device__ __forceinline__ float rs16(const float* p) { const f32x4 a = *(const f32x4*)p, b = *(const f32x4*)(p + 4), c = *(const f32x4*)(p + 8), d = *(const f32x4*)(p + 12);
    const float s = ((a[0] + a[1]) + (a[2] + a[3])) + ((b[0] + b[1]) + (b[2] + b[3])) + ((c[0] + c[1]) + (c[2] + c[3])) + ((d[0] + d[1]) + (d[2] + d[3])); return rsqrtf(s * (1.0f / DM) + RMS_EPS); }

__device__ __forceinline__ float frcp(float x) { return __builtin_amdgcn_rcpf(x); }
__device__ __forceinline__ float fsigmoid(float x) { return frcp(1.0f + __builtin_amdgcn_exp2f(-1.4426950408889634f * x)); }
__device__ __forceinline__ float gelu_fast(float x) { const float z2 = 2.302208198f * (x + 0.044715f * x * x * x); return x * frcp(1.0f + __builtin_amdgcn_exp2f(-z2)); }
template <bool EPS = true> __device__ __forceinline__ void rs8(const float* rsq, int row0, int fq, float (&rs)[2][4]) {
    f32x4 pv[2][4];
#pragma unroll
    for (int ai = 0; ai < 2; ++ai)
#pragma unroll
        for (int m = 0; m < 4; ++m) pv[ai][m] = *(const f32x4*)(rsq + (size_t)(row0 + ai * HALF + m * 16) * 16 + 4 * fq);
#pragma unroll
    for (int ai = 0; ai < 2; ++ai)
#pragma unroll
        for (int m = 0; m < 4; ++m) { float s = (pv[ai][m][0] + pv[ai][m][1]) + (pv[ai][m][2] + pv[ai][m][3]); s += __shfl_xor(s, 16); s += __shfl_xor(s, 32); rs[ai][m] = rsqrtf(s * (1.0f / DM) + (EPS ? RMS_EPS : 0.0f)); }
}
typedef unsigned u32x2 __attribute__((ext_vector_type(2)));
__device__ __forceinline__ unsigned q8x4(f32x4 y, float qs) {
    unsigned b[4];
#pragma unroll
    for (int j = 0; j < 4; ++j) b[j] = __float_as_uint(__builtin_amdgcn_fmed3f(y[j] * qs, -127.0f, 127.0f) + 12582912.0f);
    const unsigned lo = __builtin_amdgcn_perm(b[1], b[0], 0x0c0c0400u), hi = __builtin_amdgcn_perm(b[3], b[2], 0x0c0c0400u);
    return __builtin_amdgcn_perm(hi, lo, 0x05040100u);
}
__device__ __forceinline__ f32x4 i2f4(f32x4 a) { return __builtin_convertvector(__builtin_bit_cast(i32x4, a), f32x4); }
#define DPP_ROT(src, ctrl) __uint_as_float((unsigned)__builtin_amdgcn_mov_dpp((int)__float_as_uint(src), (ctrl), 0xF, 0xF, true))
#define DPP_MOV(old, src, ctrl) __uint_as_float((unsigned)__builtin_amdgcn_update_dpp((int)__float_as_uint(old), (int)__float_as_uint(src), (ctrl), 0xF, 0xF, false))

struct EpiProj {
    static constexpr bool PERM = true, AFTER_DRAIN = false;
    bf16_t* O; float* kmsum; unsigned* kmx;
    __device__ __forceinline__ void operator()(const f32x4 (&acc)[2][2][4][2], const Unit& u, int wr, int wc, int fr, int fq) const {
        const int colt = u.pn * BM;
        const float sc = colt < C_MK ? QSCALE : ((colt >= C_RK && colt < C_RV) ? RKSCALE : 1.0f);
        const int row0 = u.pm * BM + wr * 64 + fr, sec = colt >> 9, b = u.pm >> 6;
        bf16_t* sbase = O + (size_t)sec * SEC;
#pragma unroll
        for (int bj = 0; bj < 2; ++bj) { const int c = (colt & 511) + bj * HALF + wc * 32 + 8 * fq;
            bf16_t* hb = sec < 3 ? sbase + ((size_t)(b * 8 + (c >> 6)) * SEQ) * 64 + (c & 63) : sbase + ((size_t)(b * 4 + (c >> 7)) * SEQ) * 128 + (c & 127);
            const int pitch = sec < 3 ? 64 : 128;
#pragma unroll
            for (int ai = 0; ai < 2; ++ai)
#pragma unroll
                for (int m = 0; m < 4; ++m) { const int t = (row0 + ai * HALF + m * 16) & (SEQ - 1);
                    *(u32x4*)(hb + (size_t)t * pitch) = pack8(acc[ai][bj][m][0] * sc, acc[ai][bj][m][1] * sc); } }
        if (colt >= C_MK && colt < C_MV) {
            const int bh0 = (u.pm >> 6) * 8, blk = u.pm & 63;
#pragma unroll
            for (int bj = 0; bj < 2; ++bj)
#pragma unroll
                for (int n = 0; n < 2; ++n)
#pragma unroll
                    for (int j = 0; j < 4; ++j) { float s = 0.f;
#pragma unroll
                        for (int ai = 0; ai < 2; ++ai)
#pragma unroll
                            for (int m = 0; m < 4; ++m) s += acc[ai][bj][m][n][j];
                        s += __shfl_xor(s, 1); s += __shfl_xor(s, 2); s += __shfl_xor(s, 4); s += __shfl_xor(s, 8);
                        if (fr == 0) { const int c = colt - C_MK + bj * HALF + wc * 32 + 8 * fq + 4 * n + j; atomicAdd(kmsum + ((size_t)(bh0 + (c >> 6)) * 64 + blk) * 64 + (c & 63), s); } }
#pragma unroll
            for (int bj = 0; bj < 2; ++bj) { float mxk = 0.f;
#pragma unroll
                for (int ai = 0; ai < 2; ++ai)
#pragma unroll
                    for (int m = 0; m < 4; ++m) { float q2 = dot4(acc[ai][bj][m][0]) + dot4(acc[ai][bj][m][1]); q2 += __shfl_xor(q2, 16); q2 += __shfl_xor(q2, 32); mxk = fmaxf(mxk, q2); }
                mxk = fmaxf(mxk, __shfl_xor(mxk, 1)); mxk = fmaxf(mxk, __shfl_xor(mxk, 2)); mxk = fmaxf(mxk, __shfl_xor(mxk, 4)); mxk = fmaxf(mxk, __shfl_xor(mxk, 8));
                if (fr == 0 && fq == 0) { const int hd = (colt - C_MK + bj * HALF + wc * 32) >> 6; atomicMax(kmx + ((size_t)(bh0 + hd) * 64 + blk) * 2 + (wc & 1), __float_as_uint(mxk)); } }
        }
    }
};
struct EpiStore {
    static constexpr bool PERM = true, AFTER_DRAIN = false;
    bf16_t* O;
    __device__ __forceinline__ void operator()(const f32x4 (&acc)[2][2][4][2], const Unit& u, int wr, int wc, int fr, int fq) const {
        const int row0 = u.pm * BM + wr * 64 + fr, col0 = u.pn * BM + wc * 32 + 8 * fq;
#pragma unroll
        for (int ai = 0; ai < 2; ++ai)
#pragma unroll
            for (int m = 0; m < 4; ++m) { bf16_t* rowp = O + (size_t)(row0 + ai * HALF + m * 16) * DM + col0;
#pragma unroll
                for (int bj = 0; bj < 2; ++bj) *(u32x4*)(rowp + bj * HALF) = pack8(acc[ai][bj][m][0], acc[ai][bj][m][1]); }
    }
};
template <bool BF, bool WR = true> struct EpiRes {
    static constexpr bool PERM = true, AFTER_DRAIN = false;
    const float* base; bf16_t* xb; float* rsq;
    __device__ __forceinline__ void operator()(const f32x4 (&acc)[2][2][4][2], const Unit& u, int wr, int wc, int fr, int fq) const {
        const int row0 = u.pm * BM + wr * 64 + fr, col0 = u.pn * BM + wc * 32 + 8 * fq;
        if constexpr (BF) {
            u32x4 pv[8][2];
#define ERB_LOAD(g) do { _Pragma("unroll") for (int bj = 0; bj < 2; ++bj) pv[g][bj] = *(const u32x4*)(xb + (size_t)(row0 + ((g) >> 2) * HALF + ((g) & 3) * 16) * DM + col0 + bj * HALF); } while (0)
            ERB_LOAD(0); ERB_LOAD(1); ERB_LOAD(2); ERB_LOAD(3);
#pragma unroll
            for (int g = 0; g < 8; ++g) { const int ai = g >> 2, m = g & 3, row = row0 + ai * HALF + m * 16; float ss = 0.f;
                if (g + 4 < 8) { ERB_LOAD(g + 4); }
                asm volatile("" ::: "memory");
#pragma unroll
                for (int bj = 0; bj < 2; ++bj) { const size_t off = (size_t)row * DM + col0 + bj * HALF; const u32x4 p = pv[g][bj];
                    const f32x4 b0 = {__uint_as_float(p.x << 16), __uint_as_float(p.x & 0xffff0000u), __uint_as_float(p.y << 16), __uint_as_float(p.y & 0xffff0000u)};
                    const f32x4 b1 = {__uint_as_float(p.z << 16), __uint_as_float(p.z & 0xffff0000u), __uint_as_float(p.w << 16), __uint_as_float(p.w & 0xffff0000u)};
                    const f32x4 y0 = b0 + acc[ai][bj][m][0], y1 = b1 + acc[ai][bj][m][1];
                    if (WR) *(u32x4*)(xb + off) = pack8(y0, y1); ss += dot4(y0) + dot4(y1); }
                ss += __shfl_xor(ss, 16); ss += __shfl_xor(ss, 32);
                if (fq == 0) rsq[(size_t)row * 16 + u.pn * 4 + wc] = ss; }
#undef ERB_LOAD
        } else {
            f32x4 bv[8][2][2];
#define ER_LOAD(g) do { _Pragma("unroll") for (int bj = 0; bj < 2; ++bj) { const float* p_ = base + (size_t)(row0 + ((g) >> 2) * HALF + ((g) & 3) * 16) * DM + col0 + bj * HALF; bv[g][bj][0] = *(const f32x4*)p_; bv[g][bj][1] = *(const f32x4*)(p_ + 4); } } while (0)
            ER_LOAD(0); ER_LOAD(1);
#pragma unroll
            for (int g = 0; g < 8; ++g) { const int ai = g >> 2, m = g & 3, row = row0 + ai * HALF + m * 16; float ss = 0.f;
                if (g + 2 < 8) { ER_LOAD(g + 2); }
                asm volatile("" ::: "memory");
#pragma unroll
                for (int bj = 0; bj < 2; ++bj) { const size_t off = (size_t)row * DM + col0 + bj * HALF;
                    const f32x4 y0 = bv[g][bj][0] + acc[ai][bj][m][0], y1 = bv[g][bj][1] + acc[ai][bj][m][1];
                    if (WR) *(u32x4*)(xb + off) = pack8(y0, y1); ss += dot4(y0) + dot4(y1); }
                ss += __shfl_xor(ss, 16); ss += __shfl_xor(ss, 32);
                if (fq == 0) rsq[(size_t)row * 16 + u.pn * 4 + wc] = ss; }
#undef ER_LOAD
        }
    }
};
struct EpiResXN {
    static constexpr bool PERM = true, AFTER_DRAIN = false;
    const bf16_t* xn; const float* rs0; const float* gcol; bf16_t* xb; float* rsq; signed char* x8;
    __device__ __forceinline__ void operator()(const f32x4 (&acc)[2][2][4][2], const Unit& u, int wr, int wc, int fr, int fq) const {
        const int row0 = u.pm * BM + wr * 64 + fr, col0 = u.pn * BM + wc * 32 + 8 * fq;
        f32x4 ig[2][2];
#pragma unroll
        for (int bj = 0; bj < 2; ++bj)
#pragma unroll
            for (int n = 0; n < 2; ++n) { const f32x4 g = *(const f32x4*)(gcol + col0 + bj * HALF + 4 * n); ig[bj][n] = (f32x4){frcp(g[0]), frcp(g[1]), frcp(g[2]), frcp(g[3])}; }
        float r0[8];
#pragma unroll
        for (int g = 0; g < 8; ++g) r0[g] = rs0[row0 + (g >> 2) * HALF + (g & 3) * 16];
        u32x4 pv[8][2];
#define ERX_LOAD(g) do { _Pragma("unroll") for (int bj = 0; bj < 2; ++bj) pv[g][bj] = *(const u32x4*)(xn + (size_t)(row0 + ((g) >> 2) * HALF + ((g) & 3) * 16) * DM + col0 + bj * HALF); } while (0)
        ERX_LOAD(0); ERX_LOAD(1); ERX_LOAD(2); ERX_LOAD(3);
#pragma unroll
        for (int g = 0; g < 8; ++g) { const int ai = g >> 2, m = g & 3, row = row0 + ai * HALF + m * 16; float ss = 0.f;
            if (g + 4 < 8) { ERX_LOAD(g + 4); }
            asm volatile("" ::: "memory");
#pragma unroll
            for (int bj = 0; bj < 2; ++bj) { const size_t off = (size_t)row * DM + col0 + bj * HALF; const u32x4 p = pv[g][bj];
                const f32x4 b0 = {__uint_as_float(p.x << 16), __uint_as_float(p.x & 0xffff0000u), __uint_as_float(p.y << 16), __uint_as_float(p.y & 0xffff0000u)};
                const f32x4 b1 = {__uint_as_float(p.z << 16), __uint_as_float(p.z & 0xffff0000u), __uint_as_float(p.w << 16), __uint_as_float(p.w & 0xffff0000u)};
                const float irg = frcp(r0[g]), qs = r0[g] * (127.0f / CQ);
                const f32x4 y0 = b0 * ig[bj][0] * irg + acc[ai][bj][m][0], y1 = b1 * ig[bj][1] * irg + acc[ai][bj][m][1];
                *(u32x4*)(xb + off) = pack8(y0, y1); ss += dot4(y0) + dot4(y1);
                *(u32x2*)(x8 + off) = (u32x2){q8x4(y0, qs), q8x4(y1, qs)}; }
            ss += __shfl_xor(ss, 16); ss += __shfl_xor(ss, 32);
            if (fq == 0) { const float qs = r0[g] * (127.0f / CQ); rsq[(size_t)row * 16 + u.pn * 4 + wc] = (ss + RMS_EPS * (DM / 16)) * (qs * qs); } }
#undef ERX_LOAD
    }
};
struct EpiPleNorm {
    static constexpr bool PERM = true, AFTER_DRAIN = false;
    float* out; const bf16_t* xb; const bf16_t* pw; const float* rsq_in; float* rsq_out; unsigned* pcnt; const float* fnorm; unsigned long long* dts;
#define EPN_STAMP(i) do { if (dts && wr == 0 && wc == 0 && fr == 0 && fq == 0) __hip_atomic_store(dts + (i) + 4 * (u.pm >= 64 ? 1 : 0), (unsigned long long)__builtin_amdgcn_s_memrealtime(), __ATOMIC_RELAXED, __HIP_MEMORY_SCOPE_AGENT); } while (0)
    __device__ __forceinline__ void operator()(const f32x4 (&acc_)[2][2][4][2], const Unit& u, int wr, int wc, int fr, int fq) const {
        f32x4 (&acc)[2][2][4][2] = const_cast<f32x4 (&)[2][2][4][2]>(acc_);
        const int row0 = u.pm * BM + wr * 64 + fr, col0 = u.pn * BM + wc * 32 + 8 * fq;
        EPN_STAMP(30);
        float rsv[2][4]; rs8(rsq_in, row0, fq, rsv);
        u32x4 xq[8][2], pq[8][2];
#define EP_LOAD(g) do { _Pragma("unroll") for (int bj = 0; bj < 2; ++bj) { const size_t o_ = (size_t)(row0 + ((g) >> 2) * HALF + ((g) & 3) * 16) * DM + col0 + bj * HALF; xq[g][bj] = *(const u32x4*)(xb + o_); pq[g][bj] = *(const u32x4*)(pw + o_); } } while (0)
        EP_LOAD(0); EP_LOAD(1);
#pragma unroll
        for (int g = 0; g < 8; ++g) { const int ai = g >> 2, m = g & 3, row = row0 + ai * HALF + m * 16; const float rs = rsv[ai][m]; float ss = 0.f;
            if (g + 2 < 8) { EP_LOAD(g + 2); }
            asm volatile("" ::: "memory");
#pragma unroll
            for (int bj = 0; bj < 2; ++bj) {
                const u32x4 pv = pq[g][bj];
                const f32x4 p0 = {__uint_as_float(pv.x << 16), __uint_as_float(pv.x & 0xffff0000u), __uint_as_float(pv.y << 16), __uint_as_float(pv.y & 0xffff0000u)};
                const f32x4 p1 = {__uint_as_float(pv.z << 16), __uint_as_float(pv.z & 0xffff0000u), __uint_as_float(pv.w << 16), __uint_as_float(pv.w & 0xffff0000u)};
                f32x4 g0 = acc[ai][bj][m][0] * rs, g1 = acc[ai][bj][m][1] * rs;
#pragma unroll
                for (int j = 0; j < 4; ++j) { g0[j] = fsigmoid(g0[j]); g1[j] = fsigmoid(g1[j]); }
                const u32x4 xv = xq[g][bj];
                const f32x4 x0 = {__uint_as_float(xv.x << 16), __uint_as_float(xv.x & 0xffff0000u), __uint_as_float(xv.y << 16), __uint_as_float(xv.y & 0xffff0000u)};
                const f32x4 x1 = {__uint_as_float(xv.z << 16), __uint_as_float(xv.z & 0xffff0000u), __uint_as_float(xv.w << 16), __uint_as_float(xv.w & 0xffff0000u)};
                const f32x4 y0 = x0 + p0 * g0, y1 = x1 + p1 * g1;
                acc[ai][bj][m][0] = y0; acc[ai][bj][m][1] = y1; ss += dot4(y0) + dot4(y1); }
            ss += __shfl_xor(ss, 16); ss += __shfl_xor(ss, 32);
            if (fq == 0) __hip_atomic_store((unsigned*)(rsq_out + (size_t)row * 16 + u.pn * 4 + wc), __float_as_uint(ss), __ATOMIC_RELAXED, __HIP_MEMORY_SCOPE_AGENT); }
#undef EP_LOAD
        asm volatile("s_waitcnt vmcnt(0)" ::: "memory");
        EPN_STAMP(31);
        unsigned* pc = pcnt + 16 * u.pm;
        if (fq == 0 && fr == 0) __hip_atomic_fetch_add(pc, 1u, __ATOMIC_RELAXED, __HIP_MEMORY_SCOPE_AGENT);
        for (unsigned spins = 0; spins < (1u << 22); ++spins) {
            if ((unsigned)__builtin_amdgcn_readfirstlane(__hip_atomic_load(pc, __ATOMIC_RELAXED, __HIP_MEMORY_SCOPE_AGENT)) >= 32u) break;
            __builtin_amdgcn_s_sleep(2);
        }
        EPN_STAMP(32);
        f32x4 fn[2][2];
#pragma unroll
        for (int bj = 0; bj < 2; ++bj) { fn[bj][0] = *(const f32x4*)(fnorm + col0 + bj * HALF); fn[bj][1] = *(const f32x4*)(fnorm + col0 + bj * HALF + 4); }
        unsigned long long pa[8], pb[8];
#pragma unroll
        for (int g = 0; g < 8; ++g) { const unsigned long long* pp = (const unsigned long long*)(rsq_out + (size_t)(row0 + (g >> 2) * HALF + (g & 3) * 16) * 16 + 4 * fq);
            pa[g] = __hip_atomic_load(pp, __ATOMIC_RELAXED, __HIP_MEMORY_SCOPE_AGENT); pb[g] = __hip_atomic_load(pp + 1, __ATOMIC_RELAXED, __HIP_MEMORY_SCOPE_AGENT); }
#pragma unroll
        for (int g = 0; g < 8; ++g) { const int ai = g >> 2, m = g & 3, row = row0 + ai * HALF + m * 16;
            float s = (__uint_as_float((unsigned)pa[g]) + __uint_as_float((unsigned)(pa[g] >> 32))) + (__uint_as_float((unsigned)pb[g]) + __uint_as_float((unsigned)(pb[g] >> 32)));
            s += __shfl_xor(s, 16); s += __shfl_xor(s, 32);
            const float rs3 = rsqrtf(s * (1.0f / DM) + RMS_EPS);
#pragma unroll
            for (int bj = 0; bj < 2; ++bj) { const size_t off = (size_t)row * DM + col0 + bj * HALF;
                *(f32x4*)(out + off) = acc[ai][bj][m][0] * rs3 * fn[bj][0]; *(f32x4*)(out + off + 4) = acc[ai][bj][m][1] * rs3 * fn[bj][1]; } }
        EPN_STAMP(33);
    }
};
#undef EPN_STAMP
struct EpiUG {
    static constexpr bool PERM = true, AFTER_DRAIN = false;
    bf16_t* act; const float* rsq; const float* cw; const float* cb; float* UL; float* UF; float* GF; const float* wsc;
    __device__ __forceinline__ void operator()(const f32x4 (&acc)[2][2][4][2], const Unit& u, int wr, int wc, int fr, int fq) const {
        const int cu = u.pn * HALF + wc * 32 + 8 * fq;
        const int row0 = u.pm * BM + wr * 64 + fr;
        float rsv[2][4]; rs8<false>(rsq, row0, fq, rsv);
        const float* wsc_ = wsc; asm volatile("" : "+s"(wsc_));
        const float* wscu = wsc_ + u.pn * BM + wc * 32 + 8 * fq;
        float sg[8];
#pragma unroll
        for (int q = 0; q < 2; ++q) { const f32x4 b = *(const f32x4*)(wscu + HALF + 4 * q);
#pragma unroll
            for (int j = 0; j < 4; ++j) sg[4 * q + j] = b[j]; }
        float w0[8], w1[8], w2[8], bb[8];
#pragma unroll
        for (int q = 0; q < 2; ++q) { const f32x4 a = *(const f32x4*)(cw + cu + 4 * q), b = *(const f32x4*)(cw + FF + cu + 4 * q), c = *(const f32x4*)(cw + 2 * FF + cu + 4 * q), d = *(const f32x4*)(cb + cu + 4 * q);
            const f32x4 s_ = *(const f32x4*)(wscu + 4 * q);
#pragma unroll
            for (int j = 0; j < 4; ++j) { w0[4 * q + j] = a[j] * s_[j]; w1[4 * q + j] = b[j] * s_[j]; w2[4 * q + j] = c[j] * s_[j]; bb[4 * q + j] = d[j]; } }
#pragma unroll
        for (int ai = 0; ai < 2; ++ai) {
            float up[8];
#pragma unroll
            for (int m = 0; m < 4; ++m) {
                const int row = row0 + ai * HALF + m * 16;
                const float rs = rsv[ai][m];
                float uu[8], gg[8], a8[8];
#pragma unroll
                for (int n = 0; n < 2; ++n) { const f32x4 au = i2f4(acc[ai][0][m][n]), ag = i2f4(acc[ai][1][m][n]);
#pragma unroll
                    for (int j = 0; j < 4; ++j) { uu[4 * n + j] = au[j] * rs; gg[4 * n + j] = ag[j] * rs * sg[4 * n + j]; } }
#pragma unroll
                for (int k = 0; k < 8; ++k) {
                    float t1 = 0.f, t2 = 0.f;
                    if (m > 0) { t1 = DPP_ROT(up[k], 0x121); t2 = DPP_ROT(up[k], 0x122); }
                    const float u1 = DPP_MOV(t1, uu[k], 0x111), u2 = DPP_MOV(t2, uu[k], 0x112);
                    const float y = bb[k] + w0[k] * u2 + w1[k] * u1 + w2[k] * uu[k];
                    a8[k] = gelu_fast(y) * gg[k];
                }
                const bool defer = (m == 0) && (fr < 2);
                if (!defer) { u32x4 w; w.x = cvt_pk_bf16(a8[0], a8[1]); w.y = cvt_pk_bf16(a8[2], a8[3]); w.z = cvt_pk_bf16(a8[4], a8[5]); w.w = cvt_pk_bf16(a8[6], a8[7]);
                    *(u32x4*)(act + (size_t)row * FF + cu) = w; }
                else { const size_t so = ((size_t)(row >> 6) * 2 + fr) * FF + cu;
                    *(f32x4*)(UF + so) = (f32x4){uu[0], uu[1], uu[2], uu[3]}; *(f32x4*)(UF + so + 4) = (f32x4){uu[4], uu[5], uu[6], uu[7]};
                    *(f32x4*)(GF + so) = (f32x4){gg[0], gg[1], gg[2], gg[3]}; *(f32x4*)(GF + so + 4) = (f32x4){gg[4], gg[5], gg[6], gg[7]}; }
                if (m == 3 && fr >= 14) { int f14 = fr - 14; asm volatile("" : "+v"(f14)); const size_t so = ((size_t)(row >> 6) * 2 + f14) * FF + cu;
                    *(f32x4*)(UL + so) = (f32x4){uu[0], uu[1], uu[2], uu[3]}; *(f32x4*)(UL + so + 4) = (f32x4){uu[4], uu[5], uu[6], uu[7]}; }
#pragma unroll
                for (int k = 0; k < 8; ++k) up[k] = uu[k];
            }
        }
    }
};
}
#define LAS __attribute__((address_space(3)))
namespace mx {
typedef short bf16x8 __attribute__((ext_vector_type(8)));
typedef short s16x4 __attribute__((ext_vector_type(4)));
typedef float f32x16 __attribute__((ext_vector_type(16)));
typedef unsigned u32x4 __attribute__((ext_vector_type(4)));
typedef float f32x4_t __attribute__((ext_vector_type(4)));
typedef LAS const char* lds_cptr;
typedef LAS char* lds_ptr;
__device__ __forceinline__ int crow(int r, int hi) { return (r & 3) + 8 * (r >> 2) + 4 * hi; }
__device__ __forceinline__ s16x4 vtr(lds_cptr p) { return __builtin_bit_cast(s16x4, __builtin_amdgcn_ds_read_tr16_b64_v4i16((LAS s16x4*)p)); }
__device__ __forceinline__ bf16x8 cat8(s16x4 lo, s16x4 hi) { return (bf16x8){lo[0], lo[1], lo[2], lo[3], hi[0], hi[1], hi[2], hi[3]}; }
typedef float f32x2_t __attribute__((ext_vector_type(2))); typedef __bf16 bf16x2_t __attribute__((ext_vector_type(2)));
__device__ __forceinline__ unsigned pk(float lo, float hi) { const f32x2_t v = {lo, hi}; return __builtin_bit_cast(unsigned, __builtin_convertvector(v, bf16x2_t)); }
typedef __bf16 bf16x2_d __attribute__((ext_vector_type(2)));
__device__ __forceinline__ float dot2bf(unsigned a, unsigned b, float c) { return __builtin_amdgcn_fdot2_f32_bf16(__builtin_bit_cast(bf16x2_d, a), __builtin_bit_cast(bf16x2_d, b), c, false); }
__device__ __forceinline__ float dot8bf(u32x4 a, u32x4 b, float c) { return dot2bf(a.w, b.w, dot2bf(a.z, b.z, dot2bf(a.y, b.y, dot2bf(a.x, b.x, c)))); }
__device__ __forceinline__ float other_half(float v) { return __shfl_xor(v, 32); }

constexpr int L_K = 0, L_V = 32768;
constexpr int L_WSF = 65536;
constexpr int L_OST = 65536 + 2048;
constexpr int L_ENT = L_OST + 32768;
constexpr int ENT_CAP = 4096;
constexpr int L_PREF = L_ENT + ENT_CAP * 4;
constexpr int L_MW = L_PREF + 512;
constexpr int L_END = L_MW + 4096;
static_assert(L_END <= 147456, "mixer LDS map");

__device__ __forceinline__ void moba_stage_kv(const bf16_t* __restrict__ proj, int b, int h, int blk, lds_ptr lds, int tid) {
#pragma unroll
    for (int i = 0; i < 4; ++i) { const int pc = tid + 512 * i, key = pc >> 3, ch = pc & 7;
        const bf16_t* src = proj + ((size_t)(b * 8 + h) * SEQ + blk * 256 + key) * 64 + ch * 8;
        const u32x4 kv = *(const u32x4*)(src + SEC), vv = *(const u32x4*)(src + 2 * SEC);
        *(LAS u32x4*)(lds + L_K + ch * 4096 + key * 16) = kv;
        *(LAS u32x4*)(lds + L_V + (key >> 6) * 8192 + (ch >> 2) * 4096 + ((key & 63) >> 3) * 512 + (key & 7) * 64 + (ch & 3) * 16) = vv; }
}

__device__ __forceinline__ void moba_batch(const bf16x8 (&qr)[4], int qpos, int kbase, float slope2, bool diag, int ntiles, lds_ptr lds, int wave, int lane, bf16_t* odst, float* ldst,
                                           const bf16_t* part_row = nullptr, const float* pl_row = nullptr, int nv = 0, bf16_t* mix_row = nullptr, bf16_t* mix_base = nullptr) {
    const int r32 = lane & 31, hi = lane >> 5;
    f32x16 o0, o1;
#pragma unroll
    for (int r = 0; r < 16; ++r) { o0[r] = 0.f; o1[r] = 0.f; }
    float m = -1e30f, l = 0.f;
    const lds_cptr kp = (lds_cptr)lds + L_K + hi * 4096 + r32 * 16;
    const lds_cptr vp = (lds_cptr)lds + L_V + ((lane >> 4) & 1) * 32 + (lane & 3) * 8 + (4 * hi + ((lane & 15) >> 2)) * 64;
    LAS float* wsf = (LAS float*)(lds + L_WSF) + wave * 64;
    const float s4h = slope2 * (float)(4 * hi);
#define MX_LOAD(KT) bf16x8 kf_[4], kg_[4], vf_[2][4]; do { _Pragma("unroll") for (int d0 = 0; d0 < 4; ++d0) { kf_[d0] = *(const LAS bf16x8*)(kp + (KT) * 1024 + d0 * 8192); kg_[d0] = *(const LAS bf16x8*)(kp + (KT) * 1024 + 512 + d0 * 8192); } \
        const lds_cptr vt_ = vp + (KT) * 8192; _Pragma("unroll") for (int db = 0; db < 2; ++db) _Pragma("unroll") for (int ks = 0; ks < 4; ++ks) vf_[db][ks] = cat8(vtr(vt_ + db * 4096 + ks * 1024), vtr(vt_ + db * 4096 + ks * 1024 + 512)); \
        __builtin_amdgcn_sched_barrier(0); } while (0)
#define MX_QK(P0, P1, C0, C1) do { _Pragma("unroll") for (int d0 = 0; d0 < 4; ++d0) { \
        P0 = __builtin_amdgcn_mfma_f32_32x32x16_bf16(kf_[d0], qr[d0], d0 == 0 ? C0 : P0, 0, 0, 0); P1 = __builtin_amdgcn_mfma_f32_32x32x16_bf16(kg_[d0], qr[d0], d0 == 0 ? C1 : P1, 0, 0, 0); } } while (0)
#define MX_PV(O, DB, KS, PW) O = __builtin_amdgcn_mfma_f32_32x32x16_bf16(__builtin_bit_cast(bf16x8, PW), vf_[DB][KS], O, 0, 0, 0)
#define MX_PVALL() do { \
        const u32x4 pw0 = {pk(p0[0], p0[1]), pk(p0[2], p0[3]), pk(p0[4], p0[5]), pk(p0[6], p0[7])}, pw1 = {pk(p0[8], p0[9]), pk(p0[10], p0[11]), pk(p0[12], p0[13]), pk(p0[14], p0[15])}; \
        const u32x4 pw2 = {pk(p1[0], p1[1]), pk(p1[2], p1[3]), pk(p1[4], p1[5]), pk(p1[6], p1[7])}, pw3 = {pk(p1[8], p1[9]), pk(p1[10], p1[11]), pk(p1[12], p1[13]), pk(p1[14], p1[15])}; \
        MX_PV(o0, 0, 0, pw0); MX_PV(o1, 1, 0, pw0); MX_PV(o0, 0, 1, pw1); MX_PV(o1, 1, 1, pw1); MX_PV(o0, 0, 2, pw2); MX_PV(o1, 1, 2, pw2); MX_PV(o0, 0, 3, pw3); MX_PV(o1, 1, 3, pw3); } while (0)
    {
        const int kt = ntiles - 1;
        f32x16 p0, p1;
        MX_LOAD(kt);
#pragma unroll
        for (int r = 0; r < 16; ++r) { p0[r] = fmaf(slope2, (float)((r & 3) + 8 * (r >> 2)), s4h); p1[r] = p0[r]; }
        MX_QK(p0, p1, p0, p1);
        const int dq = qpos - kbase - 64 * kt;
        const float t0 = -slope2 * (float)dq, t1 = t0 + 32.0f * slope2;
        if (diag) {
#pragma unroll
            for (int r = 0; r < 16; ++r) { const int c = crow(r, hi); if (c > dq) p0[r] = -1e30f; if (c + 32 > dq) p1[r] = -1e30f; }
        }
        float mx0 = p0[0], mx1 = p1[0];
#pragma unroll
        for (int r = 1; r < 16; ++r) { mx0 = fmaxf(mx0, p0[r]); mx1 = fmaxf(mx1, p1[r]); }
        float mx_ = fmaxf(mx0 + t0, mx1 + t1);
        m = fmaxf(mx_, other_half(mx_));
        const float e0 = m - t0, e1 = m - t1;
        float rs = 0.f;
#pragma unroll
        for (int r = 0; r < 16; ++r) { p0[r] = __builtin_amdgcn_exp2f(p0[r] - e0); p1[r] = __builtin_amdgcn_exp2f(p1[r] - e1); rs += p0[r] + p1[r]; }
        l = rs;
        MX_PVALL();
    }
    for (int kt = ntiles - 2; kt >= 0; --kt) {
        const int dq = qpos - kbase - 64 * kt;
        const float c0 = -slope2 * (float)dq - m + s4h, c1 = c0 + 32.0f * slope2;
        f32x16 p0, p1;
        MX_LOAD(kt);
#pragma unroll
        for (int r = 0; r < 16; ++r) { const float cr = (float)((r & 3) + 8 * (r >> 2)); p0[r] = fmaf(slope2, cr, c0); p1[r] = fmaf(slope2, cr, c1); }
        MX_QK(p0, p1, p0, p1);
        float mx_ = fmaxf(p0[0], p1[0]);
#pragma unroll
        for (int r = 1; r < 16; ++r) mx_ = fmaxf(mx_, fmaxf(p0[r], p1[r]));
        mx_ = fmaxf(mx_, other_half(mx_));
        if (__all(mx_ < -30.0f)) continue;
        if (__any(mx_ > 16.0f)) {
            const float dl = fmaxf(mx_, 0.f); m += dl;
#pragma unroll
            for (int r = 0; r < 16; ++r) { p0[r] -= dl; p1[r] -= dl; }
            const float f = __builtin_amdgcn_exp2f(-dl); l *= f;
            if (hi == 0) wsf[r32] = f;
#pragma unroll
            for (int r = 0; r < 16; ++r) { const float g = wsf[crow(r, hi)]; o0[r] *= g; o1[r] *= g; }
        }
        float rs = 0.f;
#pragma unroll
        for (int r = 0; r < 16; ++r) { p0[r] = __builtin_amdgcn_exp2f(p0[r]); p1[r] = __builtin_amdgcn_exp2f(p1[r]); rs += p0[r] + p1[r]; }
        l += rs;
        MX_PVALL();
    }
#undef MX_LOAD
#undef MX_QK
#undef MX_PV
#undef MX_PVALL
    l += other_half(l);
    if (hi == 0) wsf[32 + r32] = 1.0f / l;
    const float lse = m + __builtin_amdgcn_logf(l);
    LAS bf16_t* ost = (LAS bf16_t*)(lds + L_OST) + wave * 2048;
#pragma unroll
    for (int r = 0; r < 16; ++r) { const int orow = crow(r, hi); const float f = wsf[32 + orow];
        ost[orow * 64 + r32] = (bf16_t)pk(o0[r] * f, 0.f); ost[orow * 64 + 32 + r32] = (bf16_t)pk(o1[r] * f, 0.f); }
    if (mix_row == nullptr) {
        const unsigned long long dp = (unsigned long long)odst; const unsigned dlo = (unsigned)dp, dhi = (unsigned)(dp >> 32);
#pragma unroll
        for (int i = 0; i < 4; ++i) { const int row = i * 8 + (lane >> 3), ch = lane & 7;
            const u32x4 v = *(const LAS u32x4*)(ost + row * 64 + ch * 8);
            const unsigned long long d = ((unsigned long long)(unsigned)__shfl((int)dhi, row) << 32) | (unsigned)__shfl((int)dlo, row);
            if (d) *(u32x4*)((bf16_t*)d + ch * 8) = v; }
        if (hi == 0 && ldst) *ldst = lse;
    } else {
        if (hi == 0) { const f32x4_t lv = *(const f32x4_t*)pl_row;
            const float a0 = nv > 0 ? lv[0] : -1e30f, a1 = nv > 1 ? lv[1] : -1e30f, a2 = nv > 2 ? lv[2] : -1e30f;
            const float mm = fmaxf(fmaxf(a0, a1), fmaxf(a2, lse));
            const float w0 = __builtin_amdgcn_exp2f(a0 - mm), w1 = __builtin_amdgcn_exp2f(a1 - mm), w2 = __builtin_amdgcn_exp2f(a2 - mm), w3 = __builtin_amdgcn_exp2f(lse - mm);
            const float iw = 1.0f / ((w0 + w1) + (w2 + w3));
            ((LAS f32x4_t*)(lds + L_MW) + wave * 32)[r32] = (f32x4_t){w0 * iw, w1 * iw, w2 * iw, w3 * iw}; }
        const unsigned long long pp = (unsigned long long)part_row, mp = (unsigned long long)mix_row;
        const unsigned plo = (unsigned)pp, phi = (unsigned)(pp >> 32), mlo = (unsigned)mp, mhi = (unsigned)(mp >> 32);
#pragma unroll
        for (int i = 0; i < 4; ++i) { const int row = i * 8 + (lane >> 3), ch = lane & 7;
            const u32x4 v = *(const LAS u32x4*)(ost + row * 64 + ch * 8);
            const f32x4_t w = ((const LAS f32x4_t*)(lds + L_MW) + wave * 32)[row];
            const bf16_t* pr = (const bf16_t*)(((unsigned long long)(unsigned)__shfl((int)phi, row) << 32) | (unsigned)__shfl((int)plo, row));
            bf16_t* mr = (bf16_t*)(((unsigned long long)(unsigned)__shfl((int)mhi, row) << 32) | (unsigned)__shfl((int)mlo, row));
            const unsigned vw[4] = {v.x, v.y, v.z, v.w}; float acc[8];
#pragma unroll
            for (int q = 0; q < 4; ++q) { acc[2 * q] = w[3] * __uint_as_float(vw[q] << 16); acc[2 * q + 1] = w[3] * __uint_as_float(vw[q] & 0xffff0000u); }
#pragma unroll
            for (int s = 0; s < 3; ++s) if (w[s] != 0.f) { const u32x4 pv = *(const u32x4*)(pr + s * 64 + ch * 8); const unsigned pw_[4] = {pv.x, pv.y, pv.z, pv.w};
#pragma unroll
                for (int q = 0; q < 4; ++q) { acc[2 * q] += w[s] * __uint_as_float(pw_[q] << 16); acc[2 * q + 1] += w[s] * __uint_as_float(pw_[q] & 0xffff0000u); } }
            *(u32x4*)(mr + ch * 8) = (u32x4){pk(acc[0], acc[1]), pk(acc[2], acc[3]), pk(acc[4], acc[5]), pk(acc[6], acc[7])}; }
    }
}

__device__ __forceinline__ void moba_diag_unit(const bf16_t* __restrict__ proj, int bh, int i, const bf16_t* part_o, const float* part_l, const u32* __restrict__ sel, bf16_t* mix, lds_ptr lds, int tid) {
    const int b = bh >> 3, h = bh & 7, lane = tid & 63, wave = __builtin_amdgcn_readfirstlane(tid >> 6);
    const int ql = wave * 32 + (lane & 31), t = i * 256 + ql; const size_t row = (size_t)b * SEQ + t;
    bf16x8 qr[4];
    { const bf16_t* qp = proj + ((size_t)bh * SEQ + t) * 64 + (lane >> 5) * 8;
#pragma unroll
      for (int d0 = 0; d0 < 4; ++d0) qr[d0] = *(const bf16x8*)(qp + d0 * 16); }
    moba_stage_kv(proj, b, h, i, lds, tid);
    __syncthreads();
    const float slope2 = __builtin_amdgcn_exp2f(-(float)(h + 1)) * LOG2E;
    const int nv = (int)(sel[row * 8 + h] >> 24);
    moba_batch(qr, t, i * 256, slope2, true, (wave >> 1) + 1, lds, wave, lane, nullptr, nullptr,
               part_o + ((row * 8 + h) * 4) * 64, part_l + (row * 8 + h) * 4, nv, mix + row * DM + h * 64, mix);
    __syncthreads();
}
__device__ __forceinline__ void moba_sel_task(const bf16_t* __restrict__ proj, const unsigned short* __restrict__ seg, const int* __restrict__ cnt, int bh, int n,
                                              bf16_t* part_o, float* part_l, lds_ptr lds, int tid) {
    const int b = bh >> 3, h = bh & 7, lane = tid & 63, wave = __builtin_amdgcn_readfirstlane(tid >> 6);
    LAS int* pref = (LAS int*)(lds + L_PREF); LAS unsigned* ent = (LAS unsigned*)(lds + L_ENT);
    if (wave == 0) {
        const int c = (lane > n) ? cnt[((size_t)bh * 64 + n) * 64 + lane] : 0; int s = c;
#pragma unroll
        for (int o = 1; o < 64; o <<= 1) { const int v = __shfl_up(s, o); if (lane >= o) s += v; }
        pref[lane + 1] = s; if (lane == 0) pref[0] = 0;
    }
    __syncthreads();
    const int T = pref[64];
    if (T == 0) { __syncthreads(); return; }
    moba_stage_kv(proj, b, h, n, lds, tid);
    const float slope2 = __builtin_amdgcn_exp2f(-(float)(h + 1)) * LOG2E;
    for (int c0 = 0; c0 < T; c0 += ENT_CAP) {
        for (int i = n + 1 + wave; i < 64; i += 8) { const int s0 = pref[i], s1 = pref[i + 1];
            const unsigned short* sp = seg + (((size_t)bh * 64 + n) * 64 + i) * 256;
            for (int e = lane; e < s1 - s0; e += 64) { const int g = s0 + e - c0; if (g >= 0 && g < ENT_CAP) ent[g] = ((unsigned)i << 10) | (unsigned)sp[e]; } }
        __syncthreads();
        const int cn = (T - c0) < ENT_CAP ? (T - c0) : ENT_CAP;
        for (int wb = wave; wb * 32 < cn; wb += 8) {
            const int idx = wb * 32 + (lane & 31); const bool valid = idx < cn;
            const unsigned ec = ent[valid ? idx : wb * 32];
            const int t = (ec >> 10) * 256 + ((ec >> 2) & 255), slot = ec & 3; const size_t row = (size_t)b * SEQ + t;
            bf16x8 qr[4];
            { const bf16_t* qp = proj + ((size_t)bh * SEQ + t) * 64 + (lane >> 5) * 8;
#pragma unroll
              for (int d0 = 0; d0 < 4; ++d0) qr[d0] = *(const bf16x8*)(qp + d0 * 16); }
            moba_batch(qr, t, n * 256, slope2, false, 4, lds, wave, lane,
                       valid ? part_o + ((row * 8 + h) * 4 + slot) * 64 : (bf16_t*)nullptr, valid ? part_l + (row * 8 + h) * 4 + slot : (float*)nullptr);
        }
        __syncthreads();
    }
}
constexpr int G_KMH = 0, G_KML = 8192, G_CNT = 16384;
#define MX_INS(v, n) do { const bool g0_ = (v) > v0, g1_ = (v) > v1, g2_ = (v) > v2; \
    v2 = g1_ ? v1 : (g2_ ? (v) : v2); i2 = g1_ ? i1 : (g2_ ? (n) : i2); v1 = g0_ ? v0 : (g1_ ? (v) : v1); i1 = g0_ ? i0 : (g1_ ? (n) : i1); v0 = g0_ ? (v) : v0; i0 = g0_ ? (n) : i0; } while (0)
__device__ __forceinline__ void gate_task_mfma(int bh, int i, const bf16_t* __restrict__ proj, const float* __restrict__ kmsum, u32* __restrict__ sel,
                                               unsigned short* __restrict__ seg, int* __restrict__ cnt, const unsigned* __restrict__ kmx, float* __restrict__ part_l, lds_ptr lds, int tid) {
    const int b = bh >> 3, h = bh & 7, lane = tid & 63, wave = __builtin_amdgcn_readfirstlane(tid >> 6), r32 = lane & 31, hi = lane >> 5;
    { const int n = tid >> 3, ch = tid & 7; const float* src = kmsum + (size_t)bh * 4096 + n * 64 + ch * 8;
      const f32x4_t a = *(const f32x4_t*)src * (1.0f / 256.0f), c = *(const f32x4_t*)(src + 4) * (1.0f / 256.0f);
      float v[8] = {a[0], a[1], a[2], a[3], c[0], c[1], c[2], c[3]}; float hf[8], lf[8];
#pragma unroll
      for (int k = 0; k < 8; ++k) { hf[k] = bf2f(f2bf(v[k])); lf[k] = v[k] - hf[k]; }
      const u32x4 H = {pk(hf[0], hf[1]), pk(hf[2], hf[3]), pk(hf[4], hf[5]), pk(hf[6], hf[7])}, Lw = {pk(lf[0], lf[1]), pk(lf[2], lf[3]), pk(lf[4], lf[5]), pk(lf[6], lf[7])};
      *(LAS u32x4*)(lds + G_KMH + ch * 1024 + n * 16) = H; *(LAS u32x4*)(lds + G_KML + ch * 1024 + n * 16) = Lw; }
    LAS int* cntL = (LAS int*)(lds + G_CNT);
    if (tid < 64) cntL[tid] = 0;
    __syncthreads();
    const int ql = wave * 32 + r32, t = i * 256 + ql; const size_t row = (size_t)b * SEQ + t;
    const bf16_t* qp = proj + ((size_t)bh * SEQ + t) * 64 + hi * 8;
    f32x16 p0, p1;
#pragma unroll
    for (int r = 0; r < 16; ++r) { p0[r] = 0.f; p1[r] = 0.f; }
    const bf16_t* ksp = proj + SEC + ((size_t)bh * SEQ + t) * 64 + hi * 8;
    float qq = 0.f, qk = 0.f;
#pragma unroll
    for (int ks = 0; ks < 4; ++ks) {
        const bf16x8 q = *(const bf16x8*)(qp + ks * 16);
        { const u32x4 qu = __builtin_bit_cast(u32x4, q), ku = *(const u32x4*)(ksp + ks * 16); qq = dot8bf(qu, qu, qq); qk = dot8bf(qu, ku, qk); }
        const lds_cptr kb = (lds_cptr)lds + (2 * ks + hi) * 1024 + r32 * 16;
        p0 = __builtin_amdgcn_mfma_f32_32x32x16_bf16(*(const LAS bf16x8*)(kb + G_KMH), q, p0, 0, 0, 0);
        p0 = __builtin_amdgcn_mfma_f32_32x32x16_bf16(*(const LAS bf16x8*)(kb + G_KML), q, p0, 0, 0, 0);
        p1 = __builtin_amdgcn_mfma_f32_32x32x16_bf16(*(const LAS bf16x8*)(kb + G_KMH + 512), q, p1, 0, 0, 0);
        p1 = __builtin_amdgcn_mfma_f32_32x32x16_bf16(*(const LAS bf16x8*)(kb + G_KML + 512), q, p1, 0, 0, 0);
    }
    float v0 = -INFINITY, v1 = -INFINITY, v2 = -INFINITY; int i0 = 0, i1 = 0, i2 = 0;
#pragma unroll
    for (int r = 0; r < 16; ++r) { const int n = crow(r, hi); const float v = n < i ? p0[r] : -INFINITY; MX_INS(v, n); }
#pragma unroll
    for (int r = 0; r < 16; ++r) { const int n = 32 + crow(r, hi); const float v = n < i ? p1[r] : -INFINITY; MX_INS(v, n); }
    { const float a0 = __shfl_xor(v0, 32), a1 = __shfl_xor(v1, 32), a2 = __shfl_xor(v2, 32); const int j0 = __shfl_xor(i0, 32), j1 = __shfl_xor(i1, 32), j2 = __shfl_xor(i2, 32);
      MX_INS(a0, j0); MX_INS(a1, j1); MX_INS(a2, j2); }
    qq += other_half(qq); qk += other_half(qk);
    if (hi == 0) {
        const int nv = i < 3 ? i : 3;
        sel[row * 8 + h] = (u32)i0 | ((u32)i1 << 8) | ((u32)i2 << 16) | ((u32)nv << 24);
        const float qn = sqrtf(qq) * 1.01f, slope2 = __builtin_amdgcn_exp2f(-(float)(h + 1)) * LOG2E;
#pragma unroll
        for (int s = 0; s < 3; ++s) if (s < nv) { const int n = s == 0 ? i0 : (s == 1 ? i1 : i2);
            const float kmax = sqrtf(__uint_as_float(kmx[((size_t)bh * 64 + n) * 2]) + __uint_as_float(kmx[((size_t)bh * 64 + n) * 2 + 1]));
            const float U = qn * kmax - slope2 * (float)(t - (n * 256 + 255));
            if (U + 8.0f - qk < -30.0f) part_l[(row * 8 + h) * 4 + s] = -1e30f;
            else { const int pos = atomicAdd((int*)&cntL[n], 1);
                seg[(((size_t)bh * 64 + n) * 64 + i) * 256 + pos] = (unsigned short)((ql << 2) | s); } }
    }
    __syncthreads();
    if (tid < i) cnt[((size_t)bh * 64 + tid) * 64 + i] = cntL[tid];
    __syncthreads();
}
#undef MX_INS

__device__ __forceinline__ void moba_combine(const bf16_t* __restrict__ part_o, const float* __restrict__ part_l, const u32* __restrict__ sel, bf16_t* __restrict__ mix, size_t gt, size_t GT) {
    for (size_t i = gt; i < (size_t)MT * 64; i += GT) {
        const int ch = (int)(i & 7), h = (int)((i >> 3) & 7); const size_t row = i >> 6;
        const int nv = sel[row * 8 + h] >> 24;
        const f32x4_t lv = *(const f32x4_t*)(part_l + (row * 8 + h) * 4);
        float w[4]; w[0] = nv > 0 ? lv[0] : -1e30f; w[1] = nv > 1 ? lv[1] : -1e30f; w[2] = nv > 2 ? lv[2] : -1e30f; w[3] = lv[3];
        const float mm = fmaxf(fmaxf(w[0], w[1]), fmaxf(w[2], w[3]));
        float acc[8] = {0.f, 0.f, 0.f, 0.f, 0.f, 0.f, 0.f, 0.f}; float ws = 0.f;
#pragma unroll
        for (int s = 0; s < 4; ++s) { const bool ok = s == 3 || s < nv; const float ww = ok ? __builtin_amdgcn_exp2f(w[s] - mm) : 0.f; ws += ww;
            if (ok) { const u32x4 v = *(const u32x4*)(part_o + ((row * 8 + h) * 4 + s) * 64 + ch * 8);
                acc[0] += ww * __uint_as_float(v.x << 16); acc[1] += ww * __uint_as_float(v.x & 0xffff0000u); acc[2] += ww * __uint_as_float(v.y << 16); acc[3] += ww * __uint_as_float(v.y & 0xffff0000u);
                acc[4] += ww * __uint_as_float(v.z << 16); acc[5] += ww * __uint_as_float(v.z & 0xffff0000u); acc[6] += ww * __uint_as_float(v.w << 16); acc[7] += ww * __uint_as_float(v.w & 0xffff0000u); } }
        const float iw = 1.0f / ws;
        u32x4 o; o.x = pk(acc[0] * iw, acc[1] * iw); o.y = pk(acc[2] * iw, acc[3] * iw); o.z = pk(acc[4] * iw, acc[5] * iw); o.w = pk(acc[6] * iw, acc[7] * iw);
        *(u32x4*)(mix + row * DM + h * 64 + ch * 8) = o;
    }
}

constexpr int R_IMG = 65536;
__device__ __forceinline__ int rimg_off(int t, int c) { return (c >> 5) * 16384 + (t >> 3) * 512 + (t & 7) * 64 + (c & 31) * 2; }
__device__ __forceinline__ void ret_stage(const bf16_t* __restrict__ plane, int t0, lds_ptr img, int tid, bool kdecay, float log2g) {
#pragma unroll
    for (int i = 0; i < 8; ++i) { const int pc = tid + 512 * i, t = pc >> 4, ch = pc & 15;
        u32x4 v = *(const u32x4*)(plane + (size_t)(t0 + t) * 128 + ch * 8);
        if (kdecay) { const float f = __builtin_amdgcn_exp2f((float)(255 - t) * log2g);
            v.x = pk(__uint_as_float(v.x << 16) * f, __uint_as_float(v.x & 0xffff0000u) * f); v.y = pk(__uint_as_float(v.y << 16) * f, __uint_as_float(v.y & 0xffff0000u) * f);
            v.z = pk(__uint_as_float(v.z << 16) * f, __uint_as_float(v.z & 0xffff0000u) * f); v.w = pk(__uint_as_float(v.w << 16) * f, __uint_as_float(v.w & 0xffff0000u) * f); }
        *(LAS u32x4*)(img + rimg_off(t, ch * 8)) = v; }
}
__device__ __forceinline__ void ret_kv_task(const bf16_t* __restrict__ proj, int bh, int c, float* __restrict__ kvt, lds_ptr lds, int tid) {
    const int b = bh >> 2, h = bh & 3, lane = tid & 63, wave = __builtin_amdgcn_readfirstlane(tid >> 6), r32 = lane & 31, hi = lane >> 5;
    const float log2g = __builtin_amdgcn_logf(1.0f - __builtin_amdgcn_exp2f(-5.0f - (float)h));
    ret_stage(proj + 5 * SEC + (size_t)bh * SEQ * 128, c * 256, lds, tid, false, 0.f);
    ret_stage(proj + 4 * SEC + (size_t)bh * SEQ * 128, c * 256, lds + R_IMG, tid, true, log2g);
    __syncthreads();
    const int et = wave >> 1, dt0 = (wave & 1) * 2;
    const int lbase = hi * 512 + ((lane & 15) >> 2) * 64 + ((lane >> 4) & 1) * 32 + (lane & 3) * 8;
    const lds_cptr va = (lds_cptr)lds + et * 16384 + lbase, kb0 = (lds_cptr)lds + R_IMG + dt0 * 16384 + lbase, kb1 = kb0 + 16384;
    f32x16 a0, a1;
#pragma unroll
    for (int r = 0; r < 16; ++r) { a0[r] = 0.f; a1[r] = 0.f; }
#pragma unroll 4
    for (int ks = 0; ks < 16; ++ks) {
        const bf16x8 vf = cat8(vtr(va + ks * 1024), vtr(va + ks * 1024 + 256));
        const bf16x8 k0 = cat8(vtr(kb0 + ks * 1024), vtr(kb0 + ks * 1024 + 256)), k1 = cat8(vtr(kb1 + ks * 1024), vtr(kb1 + ks * 1024 + 256));
        a0 = __builtin_amdgcn_mfma_f32_32x32x16_bf16(vf, k0, a0, 0, 0, 0);
        a1 = __builtin_amdgcn_mfma_f32_32x32x16_bf16(vf, k1, a1, 0, 0, 0);
    }
    float* dst = kvt + ((size_t)(bh * 64 + c) * 128) * 128;
#pragma unroll
    for (int r = 0; r < 16; ++r) { const int e = et * 32 + crow(r, hi);
        dst[(size_t)e * 128 + dt0 * 32 + r32] = a0[r]; dst[(size_t)e * 128 + dt0 * 32 + 32 + r32] = a1[r]; }
    __syncthreads();
}
__device__ __forceinline__ void ret_scan(const float* __restrict__ kvt, bf16_t* __restrict__ stt, size_t gt, size_t GT) {
    for (size_t i = gt; i < (size_t)8 * 16384; i += GT) {
        const int bh = (int)(i >> 14), ed = (int)(i & 16383), h = bh & 3;
        const float g256 = __builtin_amdgcn_exp2f(256.0f * __builtin_amdgcn_logf(1.0f - __builtin_amdgcn_exp2f(-5.0f - (float)h)));
        float s = 0.f;
#pragma unroll 8
        for (int c = 0; c < 64; ++c) { const size_t o = ((size_t)(bh * 64 + c) << 14) + ed; stt[o] = f2bf(s); s = s * g256 + kvt[o]; }
    }
}
constexpr int RO_A = 0, RO_V = 65536, RO_ST = 131072;
#define RO_STAMP(i) do { if (dts && tid == 0) __hip_atomic_store(dts + (i), (unsigned long long)__builtin_amdgcn_s_memrealtime(), __ATOMIC_RELAXED, __HIP_MEMORY_SCOPE_AGENT); } while (0)
__device__ __forceinline__ void ret_out_task(const bf16_t* __restrict__ proj, const bf16_t* __restrict__ stt, const float* __restrict__ gain, bf16_t* __restrict__ mix, int bh, int c, lds_ptr lds, int tid, unsigned long long* dts = nullptr) {
    RO_STAMP(21);
    const int b = bh >> 2, h = bh & 3, lane = tid & 63, wave = __builtin_amdgcn_readfirstlane(tid >> 6), r32 = lane & 31, hi = lane >> 5;
    const float log2g = __builtin_amdgcn_logf(1.0f - __builtin_amdgcn_exp2f(-5.0f - (float)h));
    const size_t row0 = (size_t)b * SEQ + c * 256;
    u32x4 sreg[4], vreg[8], kreg[8];
    { const bf16_t* sp = stt + ((size_t)(bh * 64 + c) << 14);
#pragma unroll
      for (int i = 0; i < 4; ++i) sreg[i] = *(const u32x4*)(sp + (size_t)(tid + 512 * i) * 8); }
    const size_t hrow0 = (size_t)bh * SEQ + c * 256;
#pragma unroll
    for (int i = 0; i < 8; ++i) { const int pc = tid + 512 * i, t = pc >> 4, ch = pc & 15; const bf16_t* src = proj + (hrow0 + t) * 128 + ch * 8;
        vreg[i] = *(const u32x4*)(src + 5 * SEC); kreg[i] = *(const u32x4*)(src + 4 * SEC); }
    bf16x8 qf[8];
    { const bf16_t* qp = proj + 3 * SEC + (hrow0 + wave * 32 + r32) * 128 + hi * 8;
#pragma unroll
      for (int ks = 0; ks < 8; ++ks) qf[ks] = *(const bf16x8*)(qp + ks * 16); }
#pragma unroll
    for (int i = 0; i < 4; ++i) { const int pc = tid + 512 * i, e = pc >> 4, ch = pc & 15; *(LAS u32x4*)(lds + RO_A + ch * 2048 + e * 16) = sreg[i]; }
#pragma unroll
    for (int i = 0; i < 8; ++i) { const int pc = tid + 512 * i, t = pc >> 4, ch = pc & 15; *(LAS u32x4*)(lds + RO_V + rimg_off(t, ch * 8)) = vreg[i]; }
    __syncthreads();
    RO_STAMP(22);
    f32x16 o[4];
#pragma unroll
    for (int et = 0; et < 4; ++et)
#pragma unroll
        for (int r = 0; r < 16; ++r) o[et][r] = 0.f;
    { const lds_cptr sb = (lds_cptr)lds + RO_A + hi * 2048 + r32 * 16;
#pragma unroll
      for (int et = 0; et < 4; ++et)
#pragma unroll
          for (int ks = 0; ks < 8; ++ks) o[et] = __builtin_amdgcn_mfma_f32_32x32x16_bf16(qf[ks], *(const LAS bf16x8*)(sb + ks * 4096 + et * 512), o[et], 0, 0, 0); }
#pragma unroll
    for (int r = 0; r < 16; ++r) { const float f = __builtin_amdgcn_exp2f((float)(wave * 32 + crow(r, hi) + 1) * log2g);
#pragma unroll
        for (int et = 0; et < 4; ++et) o[et][r] *= f; }
    RO_STAMP(23);
    __syncthreads();
#pragma unroll
    for (int i = 0; i < 8; ++i) { const int pc = tid + 512 * i, t = pc >> 4, ch = pc & 15; *(LAS u32x4*)(lds + RO_A + ch * 4096 + t * 16) = kreg[i]; }
    __syncthreads();
    u32x4 rgv[8];
#pragma unroll
    for (int g = 0; g < 4; ++g)
#pragma unroll
        for (int k = 0; k < 2; ++k) { const int pidx = lane + 64 * k; rgv[2 * g + k] = *(const u32x4*)(proj + 6 * SEC + (hrow0 + wave * 32 + 8 * g + (pidx >> 4)) * 128 + (pidx & 15) * 8); }
    const lds_cptr vp = (lds_cptr)lds + RO_V + ((lane >> 4) & 1) * 32 + (lane & 3) * 8 + (4 * hi + ((lane & 15) >> 2)) * 64;
    const lds_cptr kpb = (lds_cptr)lds + RO_A + hi * 4096 + r32 * 16;
    for (int kvt = 0; kvt <= wave; ++kvt) {
        f32x16 p;
#pragma unroll
        for (int r = 0; r < 16; ++r) p[r] = 0.f;
#pragma unroll
        for (int ks = 0; ks < 8; ++ks) p = __builtin_amdgcn_mfma_f32_32x32x16_bf16(*(const LAS bf16x8*)(kpb + ks * 8192 + kvt * 512), qf[ks], p, 0, 0, 0);
        const int dbase = 32 * (wave - kvt) + r32 - 4 * hi;
#pragma unroll
        for (int r = 0; r < 16; ++r) { const int dist = dbase - ((r & 3) + 8 * (r >> 2)); p[r] = dist >= 0 ? p[r] * __builtin_amdgcn_exp2f((float)dist * log2g) : 0.f; }
        const u32x4 pw0 = {pk(p[0], p[1]), pk(p[2], p[3]), pk(p[4], p[5]), pk(p[6], p[7])}, pw1 = {pk(p[8], p[9]), pk(p[10], p[11]), pk(p[12], p[13]), pk(p[14], p[15])};
        const lds_cptr vt = vp + kvt * 2048;
#pragma unroll
        for (int et = 0; et < 4; ++et) {
            o[et] = __builtin_amdgcn_mfma_f32_32x32x16_bf16(__builtin_bit_cast(bf16x8, pw0), cat8(vtr(vt + et * 16384), vtr(vt + et * 16384 + 512)), o[et], 0, 0, 0);
            o[et] = __builtin_amdgcn_mfma_f32_32x32x16_bf16(__builtin_bit_cast(bf16x8, pw1), cat8(vtr(vt + et * 16384 + 1024), vtr(vt + et * 16384 + 1536)), o[et], 0, 0, 0);
        }
    }
    RO_STAMP(24);
    float mu[16], rstd[16];
#pragma unroll
    for (int r = 0; r < 16; ++r) {
        float s = (o[0][r] + o[1][r]) + (o[2][r] + o[3][r]);
        s += __shfl_xor(s, 1); s += __shfl_xor(s, 2); s += __shfl_xor(s, 4); s += __shfl_xor(s, 8); s += __shfl_xor(s, 16);
        mu[r] = s * (1.0f / 128.0f);
        const float d0 = o[0][r] - mu[r], d1 = o[1][r] - mu[r], d2 = o[2][r] - mu[r], d3 = o[3][r] - mu[r];
        float q = (d0 * d0 + d1 * d1) + (d2 * d2 + d3 * d3);
        q += __shfl_xor(q, 1); q += __shfl_xor(q, 2); q += __shfl_xor(q, 4); q += __shfl_xor(q, 8); q += __shfl_xor(q, 16);
        rstd[r] = rsqrtf(q * (1.0f / 128.0f) + GN_EPS);
    }
    float gn[4];
#pragma unroll
    for (int et = 0; et < 4; ++et) gn[et] = gain[h * 128 + et * 32 + r32];
    LAS bf16_t* st = (LAS bf16_t*)(lds + RO_ST) + wave * 1024;
#pragma unroll
    for (int g = 0; g < 4; ++g) {
#pragma unroll
        for (int rr = 0; rr < 4; ++rr) { const int r = 4 * g + rr;
#pragma unroll
            for (int et = 0; et < 4; ++et) st[(rr + 4 * hi) * 128 + et * 32 + r32] = f2bf((o[et][r] - mu[r]) * rstd[r] * gn[et]); }
#pragma unroll
        for (int k = 0; k < 2; ++k) { const int pidx = lane + 64 * k, r8 = pidx >> 4, ch = pidx & 15; const size_t row = row0 + wave * 32 + 8 * g + r8;
            const u32x4 nv = *(const LAS u32x4*)(st + r8 * 128 + ch * 8); const u32x4 gv = rgv[2 * g + k];
            const unsigned nw[4] = {nv.x, nv.y, nv.z, nv.w}, gw_[4] = {gv.x, gv.y, gv.z, gv.w}; unsigned ow[4];
#pragma unroll
            for (int q = 0; q < 4; ++q) { const float g0 = __uint_as_float(gw_[q] << 16), g1 = __uint_as_float(gw_[q] & 0xffff0000u);
                ow[q] = pk(__uint_as_float(nw[q] << 16) * (g0 / (1.0f + __expf(-g0))), __uint_as_float(nw[q] & 0xffff0000u) * (g1 / (1.0f + __expf(-g1)))); }
            *(u32x4*)(mix + row * DM + 512 + h * 128 + ch * 8) = (u32x4){ow[0], ow[1], ow[2], ow[3]}; }
    }
    RO_STAMP(25);
    __syncthreads();
    RO_STAMP(26);
}
#undef RO_STAMP
}
#ifndef DIAG_K
#define DIAG_K -1
#endif
#ifndef DIAG_BLOCK
#define DIAG_BLOCK 100
#endif
#ifndef DIAG_SCALE
#define DIAG_SCALE 1.0f
#endif
#ifndef DIAG_A
#define DIAG_A 45
#endif
#ifndef DIAG_B
#define DIAG_B 6
#endif
#ifndef P4_DIAG_FIRST
#define P4_DIAG_FIRST(v) (true)
#endif
#ifndef REP_MASK
#define REP_MASK 0
#endif
#ifndef REP_SUB
#define REP_SUB 7
#endif
#include <hip/hip_cooperative_groups.h>
namespace cg = cooperative_groups;
constexpr int NWAVES = 8, NTHREADS = 512;
constexpr int LDS_BYTES = 147456 + 256;
constexpr int NPH = 10;
constexpr size_t WS_STASH = 180 * MiB;
constexpr size_t STASH_ELEMS = (size_t)512 * 2 * FF;

struct Args { const float* in[16]; float* out; unsigned char* ws; int ph_lo, ph_hi, flags, pad; };

__device__ __forceinline__ void p0_transpose_item(const float* __restrict__ W, int K, int N, const float* __restrict__ gk, bf16_t* __restrict__ WT, int k0, int n0, int orow0, LAS float* scr, int lane) {
    { float4 v[8];
#pragma unroll
      for (int i = 0; i < 8; ++i) v[i] = *(const float4*)(W + (size_t)(k0 + 8 * i + (lane >> 3)) * N + n0 + (lane & 7) * 4);
#pragma unroll
      for (int i = 0; i < 8; ++i) { const int kk = 8 * i + (lane >> 3); const float g = gk ? gk[k0 + kk] : 1.0f; LAS float* d = scr + kk * 33 + (lane & 7) * 4;
          d[0] = v[i].x * g; d[1] = v[i].y * g; d[2] = v[i].z * g; d[3] = v[i].w * g; } }
    asm volatile("s_waitcnt lgkmcnt(0)" ::: "memory");
    const int c = lane & 7;
#pragma unroll
    for (int j = 0; j < 4; ++j) { const int n = (lane >> 3) + 8 * j; const LAS float* s = scr + (8 * c) * 33 + n;
        uint4 o; o.x = (u32)f2bf(s[0 * 33]) | ((u32)f2bf(s[1 * 33]) << 16); o.y = (u32)f2bf(s[2 * 33]) | ((u32)f2bf(s[3 * 33]) << 16);
        o.z = (u32)f2bf(s[4 * 33]) | ((u32)f2bf(s[5 * 33]) << 16); o.w = (u32)f2bf(s[6 * 33]) | ((u32)f2bf(s[7 * 33]) << 16);
        *(uint4*)(WT + (size_t)(orow0 + n) * K + k0 + 8 * c) = o; }
    asm volatile("s_waitcnt lgkmcnt(0)" ::: "memory");
}

#define XB_TMO      128
#define XB_XCNT(j)  (256  + 64 * (j))
#define XB_XSUB(j)  (1280 + 64 * (j))
#define XB_XGEN(j)  (2304 + 64 * (j))
#define XB_TOP      3328
#define XB_TOPGEN   3392
#define XCD_BAR_WORDS 3456
#define XB_SPIN_CAP (1u << 18)

__device__ __forceinline__ unsigned xb_ld(unsigned* p)              { return __hip_atomic_load(p, __ATOMIC_RELAXED, __HIP_MEMORY_SCOPE_AGENT); }
__device__ __forceinline__ unsigned xb_add(unsigned* p, unsigned v) { return __hip_atomic_fetch_add(p, v, __ATOMIC_RELAXED, __HIP_MEMORY_SCOPE_AGENT); }
__device__ __forceinline__ unsigned xb_xcc_id() { return (unsigned)__builtin_amdgcn_s_getreg((3 << 11) | 20) & 0xFu; }
#define XB_SPIN(cond, bar) do { unsigned _sp = 0; while (cond) { __builtin_amdgcn_s_sleep(1); \
    if ((++_sp & 255u) == 0u) { if (xb_ld(&(bar)[XB_TMO])) break; if (_sp > XB_SPIN_CAP) { atomicAdd(&(bar)[XB_TMO], 1u); break; } } } } while (0)

struct XcdBarrier {
    unsigned* bar; unsigned x;
    volatile LAS unsigned* st;
};

__device__ __forceinline__ XcdBarrier xcd_barrier_post(unsigned* bar, volatile LAS unsigned* st) {
    XcdBarrier b; b.bar = bar; b.x = xb_xcc_id(); b.st = st;
    if (threadIdx.x == 0) (void)xb_add(&bar[XB_XCNT(b.x)], 1u);
    return b;
}
__device__ __forceinline__ void xcd_barrier_complete(unsigned* bar, unsigned x, unsigned& nloc, unsigned& nx) {
    const unsigned G = gridDim.x * gridDim.y * gridDim.z;
    unsigned sum, cnt, mine, sp = 0u;
    for (;;) {
        sum = 0u; cnt = 0u; mine = 0u;
#pragma unroll
        for (unsigned j = 0; j < 16; ++j) { const unsigned c = xb_ld(&bar[XB_XCNT(j)]); sum += c; cnt += (c > 0u) ? 1u : 0u; mine = (j == x) ? c : mine; }
        if (sum == G) break;
        __builtin_amdgcn_s_sleep(1);
        if ((++sp & 255u) == 0u) { if (xb_ld(&bar[XB_TMO])) break; if (sp > XB_SPIN_CAP) { atomicAdd(&bar[XB_TMO], 1u); break; } }
    }
    nloc = mine > 0u ? mine : 1u; nx = cnt > 0u ? cnt : 1u;
}

__device__ __forceinline__ void xcd_barrier(const XcdBarrier& b, const int tid_) {
    asm volatile("s_waitcnt vmcnt(0)" ::: "memory");
    __syncthreads();
    if (tid_ == 0) {
        unsigned* bar = b.bar;
        __builtin_amdgcn_s_waitcnt(0);
        unsigned nloc = b.st[0], nx = b.st[1];
        if (nloc == 0u) { xcd_barrier_complete(bar, b.x, nloc, nx); b.st[0] = nloc; b.st[1] = nx; }
        const unsigned old = xb_add(&bar[XB_XSUB(b.x)], 1u);
        const unsigned gen = old / nloc;
        if (old + 1u == (gen + 1u) * nloc) {
            __builtin_amdgcn_fence(__ATOMIC_RELEASE, "agent");
            asm volatile("s_waitcnt vmcnt(0)" ::: "memory");
            const unsigned og = xb_add(&bar[XB_TOP], 1u);
            const unsigned tg = og / nx;
            if (og + 1u == (tg + 1u) * nx) xb_add(&bar[XB_TOPGEN], 1u);
            else XB_SPIN(xb_ld(&bar[XB_TOPGEN]) == tg, bar);
            __builtin_amdgcn_fence(__ATOMIC_ACQUIRE, "agent");
            xb_add(&bar[XB_XGEN(b.x)], 1u);
            asm volatile("s_waitcnt vmcnt(0)" ::: "memory");
        } else {
            XB_SPIN(xb_ld(&bar[XB_XGEN(b.x)]) == gen, bar);
            __builtin_amdgcn_fence(__ATOMIC_ACQUIRE, "agent");
            asm volatile("s_waitcnt vmcnt(0)" ::: "memory");
        }
    }
    __syncthreads();
}

constexpr int CW_BAR = 4096;
constexpr int LDS_BARST = 147456;
constexpr size_t CTL_ZERO_BYTES = 65536;
constexpr int CW_PANEL = 8192;

#if (REP_MASK >> 2) & 1
#define SUBON2(bit) (rep == 0 || ((REP_SUB >> (bit)) & 1))
#else
#define SUBON2(bit) true
#endif
#if (REP_MASK >> 3) & 1
#define SUBON3(bit) (rep == 0 || ((REP_SUB >> (bit)) & 1))
#else
#define SUBON3(bit) true
#endif
#if (REP_MASK >> 4) & 1
#define SUBON4(bit) (rep == 0 || ((REP_SUB >> (bit)) & 1))
#else
#define SUBON4(bit) true
#endif
__global__ void __launch_bounds__(NTHREADS, 2) mega(Args a) {
    extern __shared__ __attribute__((aligned(16))) unsigned char lds[];
    cg::grid_group grid = cg::this_grid();
    const int wave = __builtin_amdgcn_readfirstlane(threadIdx.x >> 6);
#define MKLANE() ({ int l_; asm volatile("v_mbcnt_lo_u32_b32 %0, -1, 0\n\tv_mbcnt_hi_u32_b32 %0, -1, %0" : "=v"(l_)); l_; })
#define MKTID() (wave * 64 + MKLANE())
#define tid MKTID()
#define lane MKLANE()
    const int G = gridDim.x, bx = blockIdx.x;
    const int vcu = (G % 8 == 0) ? (bx % 8) * (G / 8) + bx / 8 : bx;
    const int gw = vcu * NWAVES + wave, NGW = G * NWAVES;
    unsigned char* ws = a.ws;
    const float* x = a.in[0]; const float* p = a.in[1]; const float* attn_norm = a.in[2]; const float* w_in = a.in[3]; const float* ret_norm = a.in[4]; const float* w_out = a.in[5];
    const float* ffn_norm = a.in[6]; const float* w_up = a.in[7]; const float* w_gate = a.in[8]; const float* conv_w = a.in[9]; const float* conv_b = a.in[10]; const float* w_down = a.in[11];
    const float* ple_norm = a.in[12]; const float* w_ple = a.in[13]; const float* w_ple_gate = a.in[14]; const float* final_norm = a.in[15];
    float* out = a.out;
    bf16_t* Win_t = (bf16_t*)(ws + WS_WIN); bf16_t* Wout_t = (bf16_t*)(ws + WS_WOUT); bf16_t* Wug_t = (bf16_t*)(ws + WS_WUG); bf16_t* Wdown_t = (bf16_t*)(ws + WS_WDOWN);
    bf16_t* Wpg_t = (bf16_t*)(ws + WS_WPG); bf16_t* Wple_t = (bf16_t*)(ws + WS_WPLE);
    bf16_t* XN = (bf16_t*)(ws + WS_R1); bf16_t* MIX = (bf16_t*)(ws + WS_SEG); bf16_t* PW = (bf16_t*)(ws + WS_R1);
    float* RS0 = (float*)(ws + WS_CNT + 768 * 1024);
    unsigned* KMX = (unsigned*)(ws + WS_CNT + 896 * 1024);
    bf16_t* XB = (bf16_t*)(ws + WS_R2);
    signed char* X8 = (signed char*)(ws + WS_X8); signed char* Wug8 = (signed char*)(ws + WS_WUG8); signed char* Wpg8 = (signed char*)(ws + WS_WPG8); float* WSC = (float*)(ws + WS_WSC);
    bf16_t* PROJ = (bf16_t*)(ws + WS_PROJ); bf16_t* ACT = (bf16_t*)(ws + WS_PROJ);
    bf16_t* PB = (bf16_t*)(ws + WS_PB); float* RSQ = (float*)(ws + WS_RSQ);
    float* KM = (float*)(ws + WS_KMEAN);
    float* UL = (float*)(ws + WS_STASH); float* UF = UL + STASH_ELEMS; float* GF = UF + STASH_ELEMS;
    float* KVT = (float*)(ws + WS_KVT); bf16_t* STT = (bf16_t*)(ws + WS_STT); float* PART_L = (float*)(ws + WS_PARTL); bf16_t* PART_O = (bf16_t*)out;
    u32* SEL = (u32*)(ws + WS_SEL); unsigned short* SEG = (unsigned short*)(ws + WS_SEG); int* CNT = (int*)(ws + WS_CNT);

    const int lo = a.ph_lo, hi = a.ph_hi;
#if DIAG_K >= 0
    unsigned long long* dts = (unsigned long long*)(ws + WS_CTL + 49152);
#define DIAG_STAMP(i) do { if (bx == DIAG_BLOCK && wave == 0 && MKLANE() == 0) __hip_atomic_store(dts + (i), (unsigned long long)__builtin_amdgcn_s_memrealtime(), __ATOMIC_RELAXED, __HIP_MEMORY_SCOPE_AGENT); } while (0)
    DIAG_STAMP(0);
#define DIAG_DTS(it) ((bx == DIAG_BLOCK && (it) == bx) ? dts : (unsigned long long*)nullptr)
#else
#define DIAG_STAMP(i) do { } while (0)
#define DIAG_DTS(it) ((unsigned long long*)nullptr)
#endif
#define IN(k) (lo <= (k) && (k) < hi)
    if (a.ph_lo < 0) grid.sync();
#define SEAM(k) do { if (IN(k) && IN((k) + 1)) { DIAG_STAMP(40 + (k)); xcd_barrier(xbar, MKTID()); DIAG_STAMP(1 + (k)); } } while (0)
    { volatile LAS unsigned* st = (volatile LAS unsigned*)((LAS unsigned char*)lds + LDS_BARST); if (tid < 2) st[tid] = 0u; }
    __syncthreads();
    XcdBarrier xbar = xcd_barrier_post((unsigned*)(ws + WS_CTL) + CW_BAR, (volatile LAS unsigned*)((LAS unsigned char*)lds + LDS_BARST));

#if (REP_MASK >> 0) & 1
    for (int rep = 0; rep < 2; ++rep)
#endif
    if (IN(0)) {
        LAS float* scr = (LAS float*)(lds) + wave * (64 * 33);
        constexpr int I_IN = 16 * (NPROJ / 32), I_OUT = 16 * (DM / 32), I_UP = 16 * (FF / 32), I_DOWN = (FF / 64) * (DM / 32), I_PG = 16 * (DM / 32), I_PLE = (PLED / 64) * (DM / 32);
        constexpr int NITEMS = I_IN + I_OUT + 2 * I_UP + I_DOWN + I_PG + I_PLE;
        for (int it = gw; it < NITEMS; it += NGW) {
            int r = it;
            if (r < I_IN) { const int nb = r % (NPROJ / 32), kb = r / (NPROJ / 32); p0_transpose_item(w_in, DM, NPROJ, nullptr, Win_t, kb * 64, nb * 32, nb * 32, scr, lane); continue; } r -= I_IN;
            if (r < I_OUT) { const int nb = r % (DM / 32), kb = r / (DM / 32); p0_transpose_item(w_out, DM, DM, nullptr, Wout_t, kb * 64, nb * 32, nb * 32, scr, lane); continue; } r -= I_OUT;
            if (r < I_UP) { const int nb = r % (FF / 32), kb = r / (FF / 32), n0 = nb * 32; p0_transpose_item(w_up, DM, FF, ffn_norm, Wug_t, kb * 64, n0, (n0 >> 7) * 256 + (n0 & 127), scr, lane); continue; } r -= I_UP;
            if (r < I_UP) { const int nb = r % (FF / 32), kb = r / (FF / 32), n0 = nb * 32; p0_transpose_item(w_gate, DM, FF, ffn_norm, Wug_t, kb * 64, n0, (n0 >> 7) * 256 + 128 + (n0 & 127), scr, lane); continue; } r -= I_UP;
            if (r < I_DOWN) { const int nb = r % (DM / 32), kb = r / (DM / 32); p0_transpose_item(w_down, FF, DM, nullptr, Wdown_t, kb * 64, nb * 32, nb * 32, scr, lane); continue; } r -= I_DOWN;
            if (r < I_PG) { const int nb = r % (DM / 32), kb = r / (DM / 32); p0_transpose_item(w_ple_gate, DM, DM, ple_norm, Wpg_t, kb * 64, nb * 32, nb * 32, scr, lane); continue; } r -= I_PG;
            { const int nb = r % (DM / 32), kb = r / (DM / 32); p0_transpose_item(w_ple, PLED, DM, nullptr, Wple_t, kb * 64, nb * 32, nb * 32, scr, lane); }
        }
        DIAG_STAMP(12);
        for (int m = gw; m < MT; m += 2 * NGW) {
            const int m2 = m + NGW;
            const float4* xr = (const float4*)(x + (size_t)m * DM); const float4* xr2 = (const float4*)(x + (size_t)m2 * DM); float4 v[4], w[4]; float s = 0.f, s2 = 0.f;
#pragma unroll
            for (int j = 0; j < 4; ++j) { v[j] = xr[lane + 64 * j]; w[j] = xr2[lane + 64 * j]; }
#pragma unroll
            for (int j = 0; j < 4; ++j) { s += v[j].x * v[j].x + v[j].y * v[j].y + v[j].z * v[j].z + v[j].w * v[j].w; s2 += w[j].x * w[j].x + w[j].y * w[j].y + w[j].z * w[j].z + w[j].w * w[j].w; }
            const float rs = rsqrtf(wave_sum(s) * (1.0f / DM) + RMS_EPS), rs2 = rsqrtf(wave_sum(s2) * (1.0f / DM) + RMS_EPS);
            if (lane == 0) { RS0[m] = rs; RS0[m2] = rs2; }
#pragma unroll
            for (int j = 0; j < 4; ++j) { const float4 gg = ((const float4*)attn_norm)[lane + 64 * j];
                ushort4 o; o.x = f2bf(v[j].x * rs * gg.x); o.y = f2bf(v[j].y * rs * gg.y); o.z = f2bf(v[j].z * rs * gg.z); o.w = f2bf(v[j].w * rs * gg.w);
                ((ushort4*)(XN + (size_t)m * DM))[lane + 64 * j] = o;
                ushort4 o2; o2.x = f2bf(w[j].x * rs2 * gg.x); o2.y = f2bf(w[j].y * rs2 * gg.y); o2.z = f2bf(w[j].z * rs2 * gg.z); o2.w = f2bf(w[j].w * rs2 * gg.w);
                ((ushort4*)(XN + (size_t)m2 * DM))[lane + 64 * j] = o2; }
        }
        DIAG_STAMP(13);
        { const size_t n4 = (size_t)MT * PLED / 4; const size_t gt = (size_t)vcu * NTHREADS + tid, GT = (size_t)G * NTHREADS;
          for (size_t i = gt; i < n4; i += GT) { const float4 v = ((const float4*)p)[i]; ushort4 o; o.x = f2bf(v.x); o.y = f2bf(v.y); o.z = f2bf(v.z); o.w = f2bf(v.w); ((ushort4*)PB)[i] = o; }
          for (size_t i = gt; i < 16 * 64 * 64; i += GT) KM[i] = 0.f;
          if (gt < 16 * 64 * 2) KMX[gt] = 0u;
          if (gt < 64) ((int*)(ws + WS_CTL))[gt] = 0;
          for (size_t i = gt; i < 16 * 64 * 64; i += GT) CNT[i] = 0; }
    }
    SEAM(0);
#if (REP_MASK >> 1) & 1
    if (IN(1)) {
        pg8::Gemm g{XN, Win_t, MT, NPROJ, DM}; pg8::StaticOrder S; S.init(MT, NPROJ, G, bx);
        pg8::EpiProj E{PROJ, KM, KMX};
        pg8::gemm_phase<pg8::EpiProj, pg8::StaticOrder, true, true>((PG8_LAS unsigned char*)lds, g, S, E, MKTID());
    }
    asm volatile("" ::: "memory");
#endif
    if (IN(1)) {
        pg8::Gemm g{XN, Win_t, MT, NPROJ, DM}; pg8::StaticOrder S; S.init(MT, NPROJ, G, bx);
        pg8::EpiProj E{PROJ, KM, KMX};
        pg8::gemm_phase<pg8::EpiProj, pg8::StaticOrder, true, true>((PG8_LAS unsigned char*)lds, g, S, E, MKTID());
    }
    SEAM(1);
#if (REP_MASK >> 2) & 1
    { const int rep = 1; (void)rep;
    if (IN(2)) {
        mx::lds_ptr L = (mx::lds_ptr)lds;
        if (!(a.flags & 1) && SUBON2(0)) for (int it = bx; it < 512; it += G) mx::ret_kv_task(PROJ, it >> 6, it & 63, KVT, L, tid);
        if (!(a.flags & 2)) {
            if (SUBON2(1)) for (int it = bx; it < 16 * 63; it += G) mx::gate_task_mfma(it / 63, 1 + it % 63, PROJ, KM, SEL, SEG, CNT, KMX, PART_L, L, tid);
            { const int gtid = vcu * NTHREADS + tid; if (gtid < BATCH * 256 * 8) { const int h = gtid & 7, t = (gtid >> 3) & 255, b = gtid >> 11; SEL[((size_t)b * SEQ + t) * 8 + h] = 0u; } }
        }
    }
    }
    asm volatile("" ::: "memory");
#endif
    { const int rep = 0; (void)rep;
    if (IN(2)) {
        mx::lds_ptr L = (mx::lds_ptr)lds;
        for (int r = gw; r < 2 * FF + DM; r += NGW) {
            const bf16_t* src = r < 2 * FF ? Wug_t + (size_t)r * DM : Wpg_t + (size_t)(r - 2 * FF) * DM;
            signed char* dst = r < 2 * FF ? Wug8 + (size_t)r * DM : Wpg8 + (size_t)(r - 2 * FF) * DM;
            const int l_ = lane;
            const pg8::u32x4 v0 = *(const pg8::u32x4*)(src + l_ * 16), v1 = *(const pg8::u32x4*)(src + l_ * 16 + 8);
            const pg8::f32x4 f0 = {__uint_as_float(v0.x << 16), __uint_as_float(v0.x & 0xffff0000u), __uint_as_float(v0.y << 16), __uint_as_float(v0.y & 0xffff0000u)};
            const pg8::f32x4 f1 = {__uint_as_float(v0.z << 16), __uint_as_float(v0.z & 0xffff0000u), __uint_as_float(v0.w << 16), __uint_as_float(v0.w & 0xffff0000u)};
            const pg8::f32x4 f2 = {__uint_as_float(v1.x << 16), __uint_as_float(v1.x & 0xffff0000u), __uint_as_float(v1.y << 16), __uint_as_float(v1.y & 0xffff0000u)};
            const pg8::f32x4 f3 = {__uint_as_float(v1.z << 16), __uint_as_float(v1.z & 0xffff0000u), __uint_as_float(v1.w << 16), __uint_as_float(v1.w & 0xffff0000u)};
            float am = 0.f;
#pragma unroll
            for (int j = 0; j < 4; ++j) am = fmaxf(fmaxf(am, fmaxf(fabsf(f0[j]), fabsf(f1[j]))), fmaxf(fabsf(f2[j]), fabsf(f3[j])));
#pragma unroll
            for (int o = 1; o < 64; o <<= 1) am = fmaxf(am, __shfl_xor(am, o));
            const float qs = am > 0.f ? 127.0f / am : 0.f;
            *(pg8::u32x4*)(dst + l_ * 16) = (pg8::u32x4){pg8::q8x4(f0, qs), pg8::q8x4(f1, qs), pg8::q8x4(f2, qs), pg8::q8x4(f3, qs)};
            if (l_ == 0) WSC[r] = am * (1.0f / 127.0f);
        }
        if (!(a.flags & 1) && SUBON2(0)) for (int it = bx; it < 512; it += G) mx::ret_kv_task(PROJ, it >> 6, it & 63, KVT, L, tid);
        DIAG_STAMP(14);
        if (!(a.flags & 2)) {
            if (SUBON2(1)) for (int it = bx; it < 16 * 63; it += G) mx::gate_task_mfma(it / 63, 1 + it % 63, PROJ, KM, SEL, SEG, CNT, KMX, PART_L, L, tid);
        DIAG_STAMP(15);
            { const int gtid = vcu * NTHREADS + tid; if (gtid < BATCH * 256 * 8) { const int h = gtid & 7, t = (gtid >> 3) & 255, b = gtid >> 11; SEL[((size_t)b * SEQ + t) * 8 + h] = 0u; } }
        }
    }
    }
    SEAM(2);
#if (REP_MASK >> 3) & 1
#define QREP rep
#else
#define QREP 0
#endif
#if (REP_MASK >> 3) & 1
    for (int rep = 0; rep < 2; ++rep)
#endif
    if (IN(3)) {
        mx::lds_ptr L = (mx::lds_ptr)lds;
        if (!(a.flags & 1) && SUBON3(0)) mx::ret_scan(KVT, STT, (size_t)vcu * NTHREADS + tid, (size_t)G * NTHREADS);
        DIAG_STAMP(18);
        if (!(a.flags & 2) && SUBON3(1)) {
            LAS int* qslot = (LAS int*)(L + mx::L_PREF + 384);
            for (;;) {
                if (tid == 0) *qslot = atomicAdd((int*)(ws + WS_CTL) + QREP, 1);
                __syncthreads();
                const int q = *qslot;
                __syncthreads();
                if (q >= 16 * 63) break;
                mx::moba_sel_task(PROJ, SEG, CNT, q & 15, q >> 4, PART_O, PART_L, L, tid);
            }
        }
        DIAG_STAMP(19);
    }
    SEAM(3);
#if (REP_MASK >> 4) & 1
    { const int rep = 1; (void)rep;
    if (IN(4)) {
        mx::lds_ptr L = (mx::lds_ptr)lds;
        if (!(a.flags & 1) && SUBON4(0)) for (int it = bx; it < 512; it += G) mx::ret_out_task(PROJ, STT, ret_norm, MIX, it >> 6, it & 63, L, tid);
        if (!(a.flags & 2) && SUBON4(1)) for (int it = bx; it < 16 * 64; it += G) mx::moba_diag_unit(PROJ, it >> 6, it & 63, PART_O, PART_L, SEL, MIX, L, tid);
    }
    }
    asm volatile("" ::: "memory");
#endif
    { const int rep = 0; (void)rep;
    if (IN(4)) {
        mx::lds_ptr L = (mx::lds_ptr)lds;
        if (P4_DIAG_FIRST(vcu)) for (int it = bx; it < 16 * 64; it += G) mx::moba_diag_unit(PROJ, it >> 6, it & 63, PART_O, PART_L, SEL, MIX, L, tid);
        for (int it = bx; it < 512; it += G) mx::ret_out_task(PROJ, STT, ret_norm, MIX, it >> 6, it & 63, L, tid, DIAG_DTS(it));
        DIAG_STAMP(16);
        if (!P4_DIAG_FIRST(vcu)) for (int it = bx; it < 16 * 64; it += G) mx::moba_diag_unit(PROJ, it >> 6, it & 63, PART_O, PART_L, SEL, MIX, L, tid);
        DIAG_STAMP(17);
    }
    }
    SEAM(4);
#if (REP_MASK >> 5) & 1
    if (IN(5)) {
        pg8::Gemm g{MIX, Wout_t, MT, DM, DM}; pg8::StaticOrder S; S.init(MT, DM, G, bx);
        pg8::EpiRes<false> E{x, XB, RSQ};
        pg8::gemm_phase<pg8::EpiRes<false>, pg8::StaticOrder, true, true>((PG8_LAS unsigned char*)lds, g, S, E, MKTID());
    }
    asm volatile("" ::: "memory");
#endif
    if (IN(5)) {
        pg8::Gemm g{MIX, Wout_t, MT, DM, DM}; pg8::StaticOrder S; S.init(MT, DM, G, bx);
        pg8::EpiResXN E{XN, RS0, attn_norm, XB, RSQ, X8};
        pg8::gemm_phase<pg8::EpiResXN, pg8::StaticOrder, true, true>((PG8_LAS unsigned char*)lds, g, S, E, MKTID());
    }
    SEAM(5);
#if (REP_MASK >> 6) & 1
    if (IN(6)) {
        pg8::Gemm g{(const bf16_t*)X8, (const bf16_t*)Wug8, MT, 2 * FF, DM / 2}; pg8::StaticOrder S; S.init(MT, 2 * FF, G, bx);
        pg8::EpiUG E{ACT, RSQ, conv_w, conv_b, UL, UF, GF, WSC};
        pg8::gemm_phase<pg8::EpiUG, pg8::StaticOrder, true, true, true>((PG8_LAS unsigned char*)lds, g, S, E, MKTID());
    }
    asm volatile("" ::: "memory");
#endif
    if (IN(6)) {
        pg8::Gemm g{(const bf16_t*)X8, (const bf16_t*)Wug8, MT, 2 * FF, DM / 2}; pg8::StaticOrder S; S.init(MT, 2 * FF, G, bx);
        pg8::EpiUG E{ACT, RSQ, conv_w, conv_b, UL, UF, GF, WSC};
        pg8::gemm_phase<pg8::EpiUG, pg8::StaticOrder, true, true, true>((PG8_LAS unsigned char*)lds, g, S, E, MKTID());
    }
    SEAM(6);
#if (REP_MASK >> 7) & 1
    for (int rep = 0; rep < 2; ++rep)
#endif
    if (IN(7)) {
        const size_t gt = (size_t)vcu * NTHREADS + tid, GT = (size_t)G * NTHREADS;
        for (size_t i = gt; i < (size_t)512 * 2 * (FF / 4); i += GT) {
            const int c = (int)(i % (FF / 4)) * 4, r = (int)((i / (FF / 4)) & 1), g64 = (int)(i / (FF / 4) / 2);
            const bool first = (g64 & 255) == 0; const size_t pg = first ? 0 : (size_t)(g64 - 1);
            const pg8::f32x4 q0 = *(const pg8::f32x4*)(UL + (pg * 2 + 0) * FF + c), q1 = *(const pg8::f32x4*)(UL + (pg * 2 + 1) * FF + c);
            const pg8::f32x4 f0 = *(const pg8::f32x4*)(UF + ((size_t)g64 * 2 + 0) * FF + c), f1 = *(const pg8::f32x4*)(UF + ((size_t)g64 * 2 + 1) * FF + c);
            const pg8::f32x4 gg = *(const pg8::f32x4*)(GF + ((size_t)g64 * 2 + r) * FF + c);
            const pg8::f32x4 w0 = *(const pg8::f32x4*)(conv_w + c), w1 = *(const pg8::f32x4*)(conv_w + FF + c), w2 = *(const pg8::f32x4*)(conv_w + 2 * FF + c), cb = *(const pg8::f32x4*)(conv_b + c);
            const float z = first ? 0.f : 1.f;
            const pg8::f32x4 p0 = q0 * z, p1 = q1 * z;
            const pg8::f32x4 u2 = r == 0 ? p0 : p1, u1 = r == 0 ? p1 : f0, u0 = r == 0 ? f0 : f1;
            const pg8::f32x4 su = *(const pg8::f32x4*)(WSC + (c >> 7) * 256 + (c & 127));
            const pg8::f32x4 y = cb + su * (w0 * u2 + w1 * u1 + w2 * u0);
            ushort4 o; o.x = f2bf(gelu_tanh(y[0]) * gg[0]); o.y = f2bf(gelu_tanh(y[1]) * gg[1]); o.z = f2bf(gelu_tanh(y[2]) * gg[2]); o.w = f2bf(gelu_tanh(y[3]) * gg[3]);
            *(ushort4*)(ACT + ((size_t)g64 * 64 + r) * FF + c) = o;
        }
        { int kk = PLED; asm volatile("" : "+s"(kk)); pg8::Gemm g{PB, Wple_t, MT, DM, kk}; pg8::StaticOrder S; S.init(MT, DM, G, bx); pg8::EpiStore E{PW};
          pg8::gemm_phase<pg8::EpiStore, pg8::StaticOrder, true, true>((PG8_LAS unsigned char*)lds, g, S, E, MKTID()); }
    }
    SEAM(7);
#if (REP_MASK >> 8) & 1
    if (IN(8)) {
        pg8::Gemm g{ACT, Wdown_t, MT, DM, FF}; pg8::StaticOrder S; S.init(MT, DM, G, bx);
        pg8::EpiRes<true, false> E{nullptr, XB, RSQ + (size_t)MT * 16};
        pg8::gemm_phase<pg8::EpiRes<true, false>, pg8::StaticOrder, true, true>((PG8_LAS unsigned char*)lds, g, S, E, MKTID());
    }
    asm volatile("" ::: "memory");
#endif
    if (IN(8)) {
        pg8::Gemm g{ACT, Wdown_t, MT, DM, FF}; pg8::StaticOrder S; S.init(MT, DM, G, bx);
        pg8::EpiRes<true> E{nullptr, XB, RSQ + (size_t)MT * 16};
        pg8::gemm_phase<pg8::EpiRes<true>, pg8::StaticOrder, true, true>((PG8_LAS unsigned char*)lds, g, S, E, MKTID());
    }
    SEAM(8);
#if (REP_MASK >> 9) & 1
    if (IN(9)) {
        if (REP_SUB & 1) { int kk = PLED; asm volatile("" : "+s"(kk)); pg8::Gemm g{PB, Wple_t, MT, DM, kk}; pg8::StaticOrder S; S.init(MT, DM, G, bx); pg8::EpiStore E{PW};
          pg8::gemm_phase<pg8::EpiStore, pg8::StaticOrder, true, true>((PG8_LAS unsigned char*)lds, g, S, E, MKTID()); }
        if (REP_SUB & 2) { int kk = DM; const bf16_t* a_ = XB; const bf16_t* b_ = Wpg_t; asm volatile("" : "+s"(kk), "+s"(a_), "+s"(b_) :: "memory"); pg8::Gemm g{a_, b_, MT, DM, kk}; pg8::StaticOrder S; S.init(MT, DM, G, bx); pg8::EpiPleNorm E{out, XB, PW, RSQ + (size_t)MT * 16, RSQ + (size_t)2 * MT * 16, (unsigned*)(ws + WS_CTL) + CW_PANEL, final_norm, DIAG_DTS(bx)};
          pg8::gemm_phase<pg8::EpiPleNorm, pg8::StaticOrder, true, true>((PG8_LAS unsigned char*)lds, g, S, E, MKTID()); }
    }
    asm volatile("" ::: "memory");
#endif
    if (IN(9)) {
        DIAG_STAMP(20);
        { int kk = DM; const bf16_t* a_ = XB; const bf16_t* b_ = Wpg_t; asm volatile("" : "+s"(kk), "+s"(a_), "+s"(b_) :: "memory"); pg8::Gemm g{a_, b_, MT, DM, kk}; pg8::StaticOrder S; S.init(MT, DM, G, bx); pg8::EpiPleNorm E{out, XB, PW, RSQ + (size_t)MT * 16, RSQ + (size_t)2 * MT * 16, (unsigned*)(ws + WS_CTL) + CW_PANEL, final_norm, DIAG_DTS(bx)};
          pg8::gemm_phase<pg8::EpiPleNorm, pg8::StaticOrder, true, true>((PG8_LAS unsigned char*)lds, g, S, E, MKTID()); }
    }
    SEAM(9);
    if (IN(10)) {
        const float* rsq = RSQ + (size_t)2 * MT * 16;
        for (int m = gw; m < MT; m += NGW) {
            const float rs = pg8::rs16(rsq + (size_t)m * 16); float4* xr = (float4*)(out + (size_t)m * DM);
#pragma unroll
            for (int j = 0; j < 4; ++j) { float4 v = xr[lane + 64 * j]; const float4 gg = ((const float4*)final_norm)[lane + 64 * j];
                v.x *= rs * gg.x; v.y *= rs * gg.y; v.z *= rs * gg.z; v.w *= rs * gg.w; xr[lane + 64 * j] = v; }
        }
    }
#if DIAG_K >= 0
    xcd_barrier(xbar, MKTID()); DIAG_STAMP(11);
    xcd_barrier(xbar, MKTID());
    { const unsigned long long t0 = __hip_atomic_load(dts + 0, __ATOMIC_RELAXED, __HIP_MEMORY_SCOPE_AGENT), t1 = __hip_atomic_load(dts + 11, __ATOMIC_RELAXED, __HIP_MEMORY_SCOPE_AGENT);
      const unsigned long long ta = __hip_atomic_load(dts + (DIAG_K == 99 ? DIAG_A : DIAG_K), __ATOMIC_RELAXED, __HIP_MEMORY_SCOPE_AGENT), tb = DIAG_K == 99 ? __hip_atomic_load(dts + DIAG_B, __ATOMIC_RELAXED, __HIP_MEMORY_SCOPE_AGENT) : (DIAG_K == 9 ? t1 : __hip_atomic_load(dts + DIAG_K + 1, __ATOMIC_RELAXED, __HIP_MEMORY_SCOPE_AGENT));
      const float eps = (float)(tb - ta) / (float)(t1 - t0);
      const float sc = 1.0f + DIAG_SCALE * eps;
      float4* o4 = (float4*)out; const size_t gt = (size_t)vcu * NTHREADS + tid, GT = (size_t)G * NTHREADS;
      for (size_t i = gt; i < (size_t)MT * DM / 4; i += GT) { float4 v = o4[i]; v.x *= sc; v.y *= sc; v.z *= sc; v.w *= sc; o4[i] = v; } }
#endif
#undef IN
#undef SEAM
#undef tid
#undef lane
}

#ifndef BUILD_MODE
#define BUILD_MODE 0
#endif
static int g_grid = 0;
static void launch_mega(Args a, int lo, int hi, hipStream_t stream) {
    a.ph_lo = lo; a.ph_hi = hi; void* args[] = {&a};
    hipError_t e = hipLaunchCooperativeKernel((const void*)mega, dim3(g_grid), dim3(NTHREADS), args, LDS_BYTES, stream);
    if (e != hipSuccess) fprintf(stderr, "cooperative launch [%d,%d) failed: %s (grid %d)\n", lo, hi, hipGetErrorString(e), g_grid);
}
extern "C" void kernel_launch(void* const* d_in, const int* in_sizes, int n_in, void* d_out, int out_size, void* d_ws, size_t ws_size, hipStream_t stream) {
    if (n_in != 16 || out_size != MT * DM || ws_size < WS_END) { fprintf(stderr, "kernel_launch: unexpected shapes (n_in %d out %d ws %zu)\n", n_in, out_size, ws_size); return; }
    if (g_grid == 0) {
        int dev = 0, cus = 0, per_cu = 0;
        hipGetDevice(&dev); hipDeviceGetAttribute(&cus, hipDeviceAttributeMultiprocessorCount, dev);
        hipFuncSetAttribute((const void*)mega, hipFuncAttributeMaxDynamicSharedMemorySize, LDS_BYTES);
        hipOccupancyMaxActiveBlocksPerMultiprocessor(&per_cu, (const void*)mega, NTHREADS, LDS_BYTES);
        if (per_cu < 1) { fprintf(stderr, "occupancy query says %d blocks/CU\n", per_cu); per_cu = 1; }
        g_grid = cus * 1;
        (void)hipGetLastError();
    }
    unsigned char* ws = (unsigned char*)d_ws;
    hipMemsetAsync(ws + WS_CTL, 0, CTL_ZERO_BYTES, stream);
    Args a{}; for (int i = 0; i < 16; ++i) a.in[i] = (const float*)d_in[i]; a.out = (float*)d_out; a.ws = ws;

    a.flags = 0; launch_mega(a, 0, NPH, stream);
}
```

```cpp
#include <hip/hip_runtime.h>
#include <stdint.h>
#include <math.h>
#include <cstdio>

typedef unsigned short bf16_t;
typedef unsigned int u32;

constexpr int BATCH = 2, SEQ = 16384, MT = BATCH * SEQ, DM = 1024, NPROJ = 3584, FF = 2816, PLED = 256;
constexpr int MH = 8, MD = 64, RH = 4, RD = 128, NBLK = 64, BLK = 256;
constexpr int C_MQ = 0, C_MK = 512, C_MV = 1024, C_RQ = 1536, C_RK = 2048, C_RV = 2560, C_RG = 3072;
constexpr float RMS_EPS = 1e-6f, GN_EPS = 1e-5f;
constexpr float LOG2E = 1.4426950408889634f;
constexpr float QSCALE = 0.125f * LOG2E;
constexpr float RKSCALE = 0.08838834764831845f;
constexpr size_t SEC = (size_t)MT * 512;

constexpr size_t MiB = (size_t)1 << 20;
constexpr size_t WS_CTL = 0, WS_WIN = 1 * MiB, WS_WOUT = 8 * MiB, WS_WUG = 10 * MiB, WS_WDOWN = 21 * MiB, WS_WPG = 27 * MiB, WS_WPLE = 29 * MiB;
constexpr size_t WS_RSQ = 30 * MiB;
constexpr size_t WS_PB = 36 * MiB;
constexpr size_t WS_R2 = 52 * MiB;
constexpr size_t WS_R1 = 116 * MiB;
constexpr size_t WS_SEG = 180 * MiB;
constexpr size_t WS_KVT = 212 * MiB;
constexpr size_t WS_STT = 244 * MiB;
constexpr size_t WS_PARTL = 260 * MiB;
constexpr size_t WS_SEL = 264 * MiB;
constexpr size_t WS_CNT = 265 * MiB;
constexpr size_t WS_KMEAN = WS_CNT + 512 * 1024;
constexpr size_t WS_PROJ = 266 * MiB;
constexpr size_t WS_X8 = 442 * MiB;
constexpr size_t WS_WUG8 = 490 * MiB, WS_WPG8 = 496 * MiB, WS_WSC = 497 * MiB;
constexpr size_t WS_END = 502 * MiB;
#ifndef I8SEC
#define I8SEC 0x3Cu
#endif
constexpr int img_of(int ls) { int n = 0; for (int s = 0; s < 7; ++s) { const bool i8 = (I8SEC >> s) & 1u, mine = (I8SEC >> ls) & 1u; if (s == ls) break; if (i8 == mine) ++n; }
    int nbf = 0; for (int s = 0; s < 7; ++s) if (!((I8SEC >> s) & 1u)) ++nbf; return ((I8SEC >> ls) & 1u) ? nbf + n : n; }
constexpr int log_of(int si) { for (int s = 0; s < 7; ++s) if (img_of(s) == si) return s; return 0; }
constexpr int nbf_sections() { int nbf = 0; for (int s = 0; s < 7; ++s) if (!((I8SEC >> s) & 1u)) ++nbf; return nbf; }
constexpr int N_I8 = 512 * nbf_sections();
constexpr size_t WS_WIN8 = 498 * MiB;
constexpr size_t WS_XN8 = 52 * MiB;
constexpr float CQ2 = 6.0f;
constexpr float CQ = 5.0f;
constexpr size_t WS_UH = 116 * MiB;

__device__ __forceinline__ float bf2f(bf16_t v) { return __uint_as_float(((u32)v) << 16); }
__device__ __forceinline__ bf16_t f2bf(float f) { u32 u = __float_as_uint(f); return (bf16_t)((u + 0x7fffu + ((u >> 16) & 1u)) >> 16); }
__device__ __forceinline__ float wave_sum(float v) {
#pragma unroll
    for (int o = 1; o < 64; o <<= 1) v += __shfl_xor(v, o);
    return v;
}
__device__ __forceinline__ float rs_from(const float* p) {
    float s = 0.f;
#pragma unroll
    for (int i = 0; i < 16; ++i) s += p[i];
    return rsqrtf(s * (1.0f / DM) + RMS_EPS);
}
__device__ __forceinline__ float gelu_tanh(float x) {
    const float z = 0.7978845608028654f * (x + 0.044715f * x * x * x);
    return x / (1.0f + __expf(-2.0f * z));
}
__device__ __forceinline__ float sigmoidf_(float x) { return 1.0f / (1.0f + __expf(-x)); }


typedef unsigned u32x4_g __attribute__((ext_vector_type(4)));
__device__ __forceinline__ void wt_store16(void* base_uniform, size_t byte_off, u32x4_g v) {
    __builtin_amdgcn_raw_buffer_store_b128(v, __builtin_amdgcn_make_buffer_rsrc(base_uniform, 0, 0x7ffffff0, 0x00020000), (int)byte_off, 0, 16);
}
namespace pg8 {
#define PG8_LAS __attribute__((address_space(3)))
typedef unsigned short bf16_t;
typedef short bf16x8 __attribute__((ext_vector_type(8)));
typedef float f32x4 __attribute__((ext_vector_type(4)));
typedef unsigned u32x4 __attribute__((ext_vector_type(4)));
typedef int i32x4 __attribute__((ext_vector_type(4)));
constexpr int BM = 256, BK = 64, HALF = 128, HTB = HALF * BK * 2  , STAGE_BYTES = 8 * HTB, NXCD = 8, WGM = 8;

__host__ __device__ __forceinline__ int lds_byte(int r, int c) { const int st = (r >> 4) * 2 + (c >> 5), rr = r & 15, cc = c & 31, ob = rr * 64 + cc * 2; return st * 1024 + (ob ^ (((ob >> 9) & 1) << 5)); }
__host__ __device__ __forceinline__ void stage_rc(int b, int& R, int& C) { const int st = b / 1024, sb = b % 1024, swz = sb ^ (((sb >> 9) & 1) << 5); R = (st >> 1) * 16 + swz / 64; C = (st & 1) * 32 + (swz % 64) / 2; }
__host__ __device__ __forceinline__ int perm32(int rho) { const int n = rho >> 4, i = rho & 15; return 8 * (i >> 2) + 4 * n + (i & 3); }

struct Unit { int pm, pn; };
struct Gemm { const bf16_t* A; const bf16_t* Bt; int M, N, K; };

struct StaticOrder {
    int nM, nN, nwg, G, c;
    __host__ __device__ void init(int M, int N, int G_, int c_) { nM = M / BM; nN = N / BM; nwg = nM * nN; G = G_; c = c_; }
    __host__ __device__ bool next(int i, Unit& u) const {
        const long L = (long)i * G + c; if (L >= nwg) return false;
        int wgid = (int)L; { const int q = nwg / NXCD, r = nwg % NXCD, xcd = wgid % NXCD, off = wgid / NXCD; wgid = (xcd < r ? xcd * (q + 1) : r * (q + 1) + (xcd - r) * q) + off; }
        const int nig = WGM * nN, gid = wgid / nig, fm = gid * WGM, gsz = (nM - fm) < WGM ? (nM - fm) : WGM;
        u.pm = fm + ((wgid % nig) % gsz); u.pn = (wgid % nig) / gsz; return true;
    }
    __device__ __forceinline__ void a_ready(const Unit&) const {}
    __device__ __forceinline__ void done(const Unit&) const {}
};

__device__ __forceinline__ unsigned cvt_pk_bf16(float lo, float hi) { unsigned r; asm volatile("v_cvt_pk_bf16_f32 %0, %1, %2" : "=v"(r) : "v"(lo), "v"(hi)); return r; }
typedef float f32x2 __attribute__((ext_vector_type(2)));
template <class Epi, class Sched, bool ALIGN_EPI = false, bool SP2 = false, bool I8 = false>
__device__ __forceinline__ void gemm_phase(PG8_LAS unsigned char* lds, const Gemm g, const Sched& S, const Epi& E, const int tid_in) {
    const int tid = tid_in, wid = __builtin_amdgcn_readfirstlane(tid >> 6), lane = tid & 63, wr = wid >> 2, wc = wid & 3, fr = lane & 15, fq = lane >> 4;
    const int K = g.K, nt = K / BK;
    unsigned voffA[2], voffB[2];
#pragma unroll
    for (int i = 0; i < 2; ++i) { int R, C; stage_rc(tid * 16 + i * 8192, R, C); const int Rb = Epi::PERM ? ((R & ~31) + perm32(R & 31)) : R;
        voffA[i] = (unsigned)(R * K + C) * 2u; voffB[i] = (unsigned)(Rb * K + C) * 2u; }
    const size_t kstep = (size_t)(BK * 2);
    const size_t hstep = (size_t)HALF * K * 2;
    const size_t tstep = 2 * hstep;
    const unsigned ldsw = (unsigned)wid * 1024u;
    const int aoff = lds_byte(wr * 64 + fr, fq * 8), boff = lds_byte(wc * 32 + fr, fq * 8);
#define PG8_SA(b, h) (((b) * 2 + (h)) * HTB)
#define PG8_SB(b, h) ((4 + (b) * 2 + (h)) * HTB)
#define PG8_STAGE(bufoff, gbase, voff) do { _Pragma("unroll") for (int _i = 0; _i < 2; ++_i) \
        __builtin_amdgcn_global_load_lds((const unsigned*)((const char*)(gbase) + (voff)[_i]), (PG8_LAS unsigned*)(lds + (bufoff) + ldsw + _i * 8192), 16, 0, 0); } while (0)
#define PG8_LDA(dst, b, h) do { _Pragma("unroll") for (int m = 0; m < 4; ++m) _Pragma("unroll") for (int k = 0; k < 2; ++k) dst[m][k] = *(const PG8_LAS bf16x8*)(lds + PG8_SA(b, h) + aoff + m * 2048 + k * 1024); } while (0)
#define PG8_LDB(dst, b, h) do { _Pragma("unroll") for (int n = 0; n < 2; ++n) _Pragma("unroll") for (int k = 0; k < 2; ++k) dst[n][k] = *(const PG8_LAS bf16x8*)(lds + PG8_SB(b, h) + boff + n * 2048 + k * 1024); } while (0)
#define PG8_MMA(ai, bj, At, Bt) do { __builtin_amdgcn_s_setprio(1); _Pragma("unroll") for (int m = 0; m < 4; ++m) _Pragma("unroll") for (int n = 0; n < 2; ++n) _Pragma("unroll") for (int k = 0; k < 2; ++k) \
        { if constexpr (I8) acc[ai][bj][m][n] = __builtin_bit_cast(f32x4, __builtin_amdgcn_mfma_i32_16x16x64_i8(__builtin_bit_cast(i32x4, Bt[n][k]), __builtin_bit_cast(i32x4, At[m][k]), __builtin_bit_cast(i32x4, acc[ai][bj][m][n]), 0, 0, 0)); \
          else acc[ai][bj][m][n] = __builtin_amdgcn_mfma_f32_16x16x32_bf16(Bt[n][k], At[m][k], acc[ai][bj][m][n], 0, 0, 0); } __builtin_amdgcn_s_setprio(0); } while (0)
#define PG8_WAIT_V(n) asm volatile("s_waitcnt vmcnt(" #n ")" ::: "memory")
#define PG8_WAIT_L(n) asm volatile("s_waitcnt lgkmcnt(" #n ")" ::: "memory")
#define PG8_BAR __builtin_amdgcn_s_barrier()
#define PG8_SCHED __builtin_amdgcn_sched_barrier(0)
    Unit cur, nxt; int ui = 0;
    if (!S.next(0, cur)) return;
    f32x4 acc[2][2][4][2];
#pragma unroll
    for (int a = 0; a < 2; ++a)
#pragma unroll
        for (int b = 0; b < 2; ++b)
#pragma unroll
            for (int m = 0; m < 4; ++m)
#pragma unroll
                for (int n = 0; n < 2; ++n) acc[a][b][m][n] = (f32x4){0.f, 0.f, 0.f, 0.f};
    bf16x8 At[4][2], B0[2][2], B1[2][2];
    const char* cA = (const char*)g.A + (size_t)cur.pm * tstep; const char* cB = (const char*)g.Bt + (size_t)cur.pn * tstep;
    S.a_ready(cur);
    if constexpr (SP2) {
        PG8_STAGE(PG8_SB(0, 0), cB, voffB); PG8_STAGE(PG8_SB(0, 1), cB + hstep, voffB); PG8_STAGE(PG8_SA(0, 0), cA, voffA); PG8_STAGE(PG8_SA(0, 1), cA + hstep, voffA);
        if (wr == 1) PG8_BAR;
        PG8_WAIT_V(2); PG8_BAR;
        PG8_STAGE(PG8_SB(1, 0), cB + kstep, voffB); PG8_STAGE(PG8_SA(1, 0), cA + kstep, voffA); PG8_STAGE(PG8_SB(1, 1), cB + hstep + kstep, voffB);
        PG8_WAIT_V(6); PG8_BAR;
    } else {
        PG8_STAGE(PG8_SB(0, 0), cB, voffB); PG8_STAGE(PG8_SA(0, 0), cA, voffA); PG8_STAGE(PG8_SB(0, 1), cB + hstep, voffB); PG8_STAGE(PG8_SA(0, 1), cA + hstep, voffA);
        if (wr == 1) PG8_BAR;
        PG8_WAIT_V(4); PG8_BAR;
        PG8_STAGE(PG8_SB(1, 0), cB + kstep, voffB); PG8_STAGE(PG8_SA(1, 0), cA + kstep, voffA); PG8_STAGE(PG8_SB(1, 1), cB + hstep + kstep, voffB);
        PG8_WAIT_V(6); PG8_BAR;
    }
    for (;;) {
        const bool has_next = S.next(ui + 1, nxt);
        const char* nA = has_next ? (const char*)g.A + (size_t)nxt.pm * tstep : cA; const char* nB = has_next ? (const char*)g.Bt + (size_t)nxt.pn * tstep : cB;
        for (int t = 0; t < nt; t += 2) {
            const bool last = (t == nt - 2);
            const char* a1 = cA + (size_t)(t + 1) * kstep;
            const char* a2 = last ? nA : cA + (size_t)(t + 2) * kstep; const char* b2 = last ? nB : cB + (size_t)(t + 2) * kstep;
            const char* a3 = a2 + kstep; const char* b3 = b2 + kstep;
            if (last && has_next) S.a_ready(nxt);
            if constexpr (SP2) {
            PG8_LDB(B0, 0, 0); PG8_LDB(B1, 0, 1); PG8_SCHED; PG8_LDA(At, 0, 0); PG8_STAGE(PG8_SA(1, 1), a1 + hstep, voffA);
            PG8_WAIT_V(8); PG8_WAIT_L(0); PG8_BAR; PG8_MMA(0, 0, At, B0); PG8_MMA(0, 1, At, B1); PG8_BAR; PG8_SCHED;
            PG8_LDA(At, 0, 1); PG8_STAGE(PG8_SB(0, 0), b2, voffB); PG8_STAGE(PG8_SB(0, 1), b2 + hstep, voffB); PG8_STAGE(PG8_SA(0, 0), a2, voffA);
            PG8_WAIT_V(8); PG8_WAIT_L(0); PG8_BAR; PG8_MMA(1, 0, At, B0); PG8_MMA(1, 1, At, B1); PG8_BAR; PG8_SCHED;
            PG8_LDB(B0, 1, 0); PG8_LDB(B1, 1, 1); PG8_SCHED; PG8_LDA(At, 1, 0); PG8_STAGE(PG8_SA(0, 1), a2 + hstep, voffA);
            PG8_WAIT_V(8); PG8_WAIT_L(0); PG8_BAR; PG8_MMA(0, 0, At, B0); PG8_MMA(0, 1, At, B1); PG8_BAR; PG8_SCHED;
            PG8_LDA(At, 1, 1); PG8_STAGE(PG8_SB(1, 0), b3, voffB); PG8_STAGE(PG8_SB(1, 1), b3 + hstep, voffB); PG8_STAGE(PG8_SA(1, 0), a3, voffA);
            PG8_WAIT_V(8); PG8_WAIT_L(0); PG8_BAR; PG8_MMA(1, 0, At, B0); PG8_MMA(1, 1, At, B1); PG8_BAR; PG8_SCHED;
            } else {
            PG8_LDB(B0, 0, 0); PG8_SCHED; PG8_LDA(At, 0, 0); PG8_STAGE(PG8_SA(1, 1), a1 + hstep, voffA);
            PG8_WAIT_L(8); PG8_BAR; PG8_WAIT_L(0); PG8_MMA(0, 0, At, B0); PG8_BAR; PG8_SCHED;
            PG8_LDB(B1, 0, 1); PG8_STAGE(PG8_SB(0, 0), b2, voffB);
            PG8_BAR; PG8_WAIT_L(0); PG8_MMA(0, 1, At, B1); PG8_BAR;
            PG8_LDA(At, 0, 1); PG8_STAGE(PG8_SA(0, 0), a2, voffA);
            PG8_BAR; PG8_WAIT_L(0); PG8_MMA(1, 0, At, B0); PG8_BAR; PG8_SCHED;
            PG8_STAGE(PG8_SB(0, 1), b2 + hstep, voffB);
            PG8_WAIT_V(6); PG8_BAR; PG8_MMA(1, 1, At, B1); PG8_BAR;
            PG8_LDB(B0, 1, 0); PG8_SCHED; PG8_LDA(At, 1, 0); PG8_STAGE(PG8_SA(0, 1), a2 + hstep, voffA);
            PG8_WAIT_L(8); PG8_BAR; PG8_WAIT_L(0); PG8_MMA(0, 0, At, B0); PG8_BAR; PG8_SCHED;
            PG8_LDB(B1, 1, 1); PG8_STAGE(PG8_SB(1, 0), b3, voffB);
            PG8_BAR; PG8_WAIT_L(0); PG8_MMA(0, 1, At, B1); PG8_BAR;
            PG8_LDA(At, 1, 1); PG8_STAGE(PG8_SA(1, 0), a3, voffA);
            PG8_BAR; PG8_WAIT_L(0); PG8_MMA(1, 0, At, B0); PG8_BAR; PG8_SCHED;
            PG8_STAGE(PG8_SB(1, 1), b3 + hstep, voffB);
            PG8_WAIT_V(6); PG8_BAR; PG8_MMA(1, 1, At, B1); PG8_BAR;
            }
        }
        if constexpr (ALIGN_EPI) { if (wr == 0) PG8_BAR; }
        if constexpr (!Epi::AFTER_DRAIN) { E(acc, cur, wr, wc, fr, fq); S.done(cur); }
        if (!has_next) break;
#pragma unroll
        for (int a = 0; a < 2; ++a)
#pragma unroll
            for (int b = 0; b < 2; ++b)
#pragma unroll
                for (int m = 0; m < 4; ++m)
#pragma unroll
                    for (int n = 0; n < 2; ++n) acc[a][b][m][n] = (f32x4){0.f, 0.f, 0.f, 0.f};
        cur = nxt; cA = nA; cB = nB; ++ui;
        if constexpr (ALIGN_EPI) { if (wr == 1) PG8_BAR; }
    }
    PG8_WAIT_V(0);
    if constexpr (!ALIGN_EPI) { if (wr == 0) PG8_BAR; }
    PG8_BAR;
    if constexpr (Epi::AFTER_DRAIN) { E.fused(acc, cur, wr, wc, fr, fq, lds, wid, lane); S.done(cur); }
#undef PG8_SA
#undef PG8_SB
#undef PG8_STAGE
#undef PG8_LDA
#undef PG8_LDB
#undef PG8_MMA
#undef PG8_WAIT_V
#undef PG8_WAIT_L
#undef PG8_BAR
#undef PG8_SCHED
}
}
namespace pg8 {
__device__ __forceinline__ u32x4 pack8(f32x4 v0, f32x4 v1) { u32x4 w; w.x = cvt_pk_bf16(v0[0], v0[1]); w.y = cvt_pk_bf16(v0[2], v0[3]); w.z = cvt_pk_bf16(v1[0], v1[1]); w.w = cvt_pk_bf16(v1[2], v1[3]); return w; }
__device__ __forceinline__ float dot4(f32x4 a) { return (a[0] * a[0] + a[1] * a[1]) + (a[2] * a[2] + a[3] * a[3]); }
__device__ __forceinline__ float rs16(const float* p) { const f32x4 a = *(const f32x4*)p, b = *(const f32x4*)(p + 4), c = *(const f32x4*)(p + 8), d = *(const f32x4*)(p + 12);
    const float s = ((a[0] + a[1]) + (a[2] + a[3])) + ((b[0] + b[1]) + (b[2] + b[3])) + ((c[0] + c[1]) + (c[2] + c[3])) + ((d[0] + d[1]) + (d[2] + d[3])); return rsqrtf(s * (1.0f / DM) + RMS_EPS); }

__device__ __forceinline__ float frcp(float x) { return __builtin_amdgcn_rcpf(x); }
__device__ __forceinline__ float fsigmoid(float x) { return frcp(1.0f + __builtin_amdgcn_exp2f(-1.4426950408889634f * x)); }
__device__ __forceinline__ float gelu_fast(float x) { const float t = fmaf(x * x, 2.302208198f * 0.044715f, 2.302208198f); return x * frcp(1.0f + __builtin_amdgcn_exp2f(-(x * t))); }
template <bool EPS = true> __device__ __forceinline__ void rs8(const float* rsq, int row0, int fq, float (&rs)[2][4]) {
    f32x4 pv[2][4];
#pragma unroll
    for (int ai = 0; ai < 2; ++ai)
#pragma unroll
        for (int m = 0; m < 4; ++m) pv[ai][m] = *(const f32x4*)(rsq + (size_t)(row0 + ai * HALF + m * 16) * 16 + 4 * fq);
#pragma unroll
    for (int ai = 0; ai < 2; ++ai)
#pragma unroll
        for (int m = 0; m < 4; ++m) { float s = (pv[ai][m][0] + pv[ai][m][1]) + (pv[ai][m][2] + pv[ai][m][3]); s += __shfl_xor(s, 16); s += __shfl_xor(s, 32); rs[ai][m] = rsqrtf(s * (1.0f / DM) + (EPS ? RMS_EPS : 0.0f)); }
}
typedef unsigned u32x2 __attribute__((ext_vector_type(2)));
__device__ __forceinline__ unsigned q8x4(f32x4 y, float qs) {
    unsigned b[4];
#pragma unroll
    for (int j = 0; j < 4; ++j) b[j] = __float_as_uint(__builtin_amdgcn_fmed3f(y[j] * qs, -127.0f, 127.0f) + 12582912.0f);
    const unsigned lo = __builtin_amdgcn_perm(b[1], b[0], 0x0c0c0400u), hi = __builtin_amdgcn_perm(b[3], b[2], 0x0c0c0400u);
    return __builtin_amdgcn_perm(hi, lo, 0x05040100u);
}
__device__ __forceinline__ f32x4 i2f4(f32x4 a) { return __builtin_convertvector(__builtin_bit_cast(i32x4, a), f32x4); }
#define DPP_ROT(src, ctrl) __uint_as_float((unsigned)__builtin_amdgcn_mov_dpp((int)__float_as_uint(src), (ctrl), 0xF, 0xF, true))
#define DPP_Z(src, ctrl) __uint_as_float((unsigned)__builtin_amdgcn_update_dpp(0, (int)__float_as_uint(src), (ctrl), 0xF, 0xF, true))
#define DPP_MOV(old, src, ctrl) __uint_as_float((unsigned)__builtin_amdgcn_update_dpp((int)__float_as_uint(old), (int)__float_as_uint(src), (ctrl), 0xF, 0xF, false))

__device__ __forceinline__ int log_sec(int si) { return si == 0 ? log_of(0) : si == 1 ? log_of(1) : si == 2 ? log_of(2) : si == 3 ? log_of(3) : si == 4 ? log_of(4) : si == 5 ? log_of(5) : log_of(6); }
__device__ __forceinline__ int img_sec(int ls) { return ls == 0 ? img_of(0) : ls == 1 ? img_of(1) : ls == 2 ? img_of(2) : ls == 3 ? img_of(3) : ls == 4 ? img_of(4) : ls == 5 ? img_of(5) : img_of(6); }
struct EpiProj8 {
    static constexpr bool PERM = true, AFTER_DRAIN = false;
    bf16_t* O; const float* xsc; const float* wsc;
    __device__ __forceinline__ void operator()(const f32x4 (&acc)[2][2][4][2], const Unit& u, int wr, int wc, int fr, int fq) const {
        const int icolt = N_I8 + u.pn * BM, colt = log_sec(icolt >> 9) * 512 + (icolt & 511);
        const float sc = (colt >= C_RK && colt < C_RV) ? RKSCALE : 1.0f;
        const int row0 = u.pm * BM + wr * 64 + fr, sec = colt >> 9, b = u.pm >> 6;
        bf16_t* sbase = O + (size_t)sec * SEC;
        float xs[8];
#pragma unroll
        for (int g = 0; g < 8; ++g) xs[g] = xsc[row0 + (g >> 2) * HALF + (g & 3) * 16] * sc;
#pragma unroll
        for (int bj = 0; bj < 2; ++bj) { const int c = (colt & 511) + bj * HALF + wc * 32 + 8 * fq;
            bf16_t* hb = sec < 3 ? sbase + ((size_t)(b * 8 + (c >> 6)) * SEQ) * 64 + (c & 63) : sbase + ((size_t)(b * 4 + (c >> 7)) * SEQ) * 128 + (c & 127);
            const int pitch = sec < 3 ? 64 : 128;
            const f32x4 w0 = *(const f32x4*)(wsc + icolt + bj * HALF + wc * 32 + 8 * fq), w1 = *(const f32x4*)(wsc + icolt + bj * HALF + wc * 32 + 8 * fq + 4);
#pragma unroll
            for (int ai = 0; ai < 2; ++ai)
#pragma unroll
                for (int m = 0; m < 4; ++m) { const int t = (row0 + ai * HALF + m * 16) & (SEQ - 1); const float x_ = xs[ai * 4 + m];
                    *(u32x4*)(hb + (size_t)t * pitch) = pack8(i2f4(acc[ai][bj][m][0]) * x_ * w0, i2f4(acc[ai][bj][m][1]) * x_ * w1); } }
    }
};
struct EpiProj {
    static constexpr bool PERM = true, AFTER_DRAIN = false;
    bf16_t* O; float* kmsum; unsigned* kmx;
    __device__ __forceinline__ void operator()(const f32x4 (&acc)[2][2][4][2], const Unit& u, int wr, int wc, int fr, int fq) const {
        const int icolt = u.pn * BM, colt = log_sec(icolt >> 9) * 512 + (icolt & 511);
        const float sc = colt < C_MK ? QSCALE : ((colt >= C_RK && colt < C_RV) ? RKSCALE : 1.0f);
        const int row0 = u.pm * BM + wr * 64 + fr, sec = colt >> 9, b = u.pm >> 6;
        bf16_t* sbase = O + (size_t)sec * SEC;
#pragma unroll
        for (int bj = 0; bj < 2; ++bj) { const int c = (colt & 511) + bj * HALF + wc * 32 + 8 * fq;
            bf16_t* hb = sec < 3 ? sbase + ((size_t)(b * 8 + (c >> 6)) * SEQ) * 64 + (c & 63) : sbase + ((size_t)(b * 4 + (c >> 7)) * SEQ) * 128 + (c & 127);
            const int pitch = sec < 3 ? 64 : 128;
#pragma unroll
            for (int ai = 0; ai < 2; ++ai)
#pragma unroll
                for (int m = 0; m < 4; ++m) { const int t = (row0 + ai * HALF + m * 16) & (SEQ - 1);
                    *(u32x4*)(hb + (size_t)t * pitch) = pack8(acc[ai][bj][m][0] * sc, acc[ai][bj][m][1] * sc); } }
        if (colt >= C_MK && colt < C_MV) {
            const int bh0 = (u.pm >> 6) * 8, blk = u.pm & 63;
#pragma unroll
            for (int bj = 0; bj < 2; ++bj)
#pragma unroll
                for (int n = 0; n < 2; ++n)
#pragma unroll
                    for (int j = 0; j < 4; ++j) { float s = 0.f;
#pragma unroll
                        for (int ai = 0; ai < 2; ++ai)
#pragma unroll
                            for (int m = 0; m < 4; ++m) s += acc[ai][bj][m][n][j];
                        s += __shfl_xor(s, 1); s += __shfl_xor(s, 2); s += __shfl_xor(s, 4); s += __shfl_xor(s, 8);
                        if (fr == 0) { const int c = colt - C_MK + bj * HALF + wc * 32 + 8 * fq + 4 * n + j; atomicAdd(kmsum + ((size_t)(bh0 + (c >> 6)) * 64 + blk) * 64 + (c & 63), s); } }
#pragma unroll
            for (int bj = 0; bj < 2; ++bj) { float mxk = 0.f;
#pragma unroll
                for (int ai = 0; ai < 2; ++ai)
#pragma unroll
                    for (int m = 0; m < 4; ++m) { float q2 = dot4(acc[ai][bj][m][0]) + dot4(acc[ai][bj][m][1]); q2 += __shfl_xor(q2, 16); q2 += __shfl_xor(q2, 32); mxk = fmaxf(mxk, q2); }
                mxk = fmaxf(mxk, __shfl_xor(mxk, 1)); mxk = fmaxf(mxk, __shfl_xor(mxk, 2)); mxk = fmaxf(mxk, __shfl_xor(mxk, 4)); mxk = fmaxf(mxk, __shfl_xor(mxk, 8));
                if (fr == 0 && fq == 0) { const int hd = (colt - C_MK + bj * HALF + wc * 32) >> 6; atomicMax(kmx + ((size_t)(bh0 + hd) * 64 + blk) * 2 + (wc & 1), __float_as_uint(mxk)); } }
        }
    }
};
struct EpiStore {
    static constexpr bool PERM = true, AFTER_DRAIN = false;
    bf16_t* O;
    __device__ __forceinline__ void operator()(const f32x4 (&acc)[2][2][4][2], const Unit& u, int wr, int wc, int fr, int fq) const {
        const int row0 = u.pm * BM + wr * 64 + fr, col0 = u.pn * BM + wc * 32 + 8 * fq;
#pragma unroll
        for (int ai = 0; ai < 2; ++ai)
#pragma unroll
            for (int m = 0; m < 4; ++m) { bf16_t* rowp = O + (size_t)(row0 + ai * HALF + m * 16) * DM + col0;
#pragma unroll
                for (int bj = 0; bj < 2; ++bj) *(u32x4*)(rowp + bj * HALF) = pack8(acc[ai][bj][m][0], acc[ai][bj][m][1]); }
    }
};
template <bool BF, bool WR = true, bool Q8 = false> struct EpiRes {
    static constexpr bool PERM = true, AFTER_DRAIN = false;
    const float* base; bf16_t* xb; float* rsq; const float* rs0; signed char* x8;
    __device__ __forceinline__ void operator()(const f32x4 (&acc)[2][2][4][2], const Unit& u, int wr, int wc, int fr, int fq) const {
        const int row0 = u.pm * BM + wr * 64 + fr, col0 = u.pn * BM + wc * 32 + 8 * fq;
        if constexpr (BF) {
            u32x4 pv[8][2];
#define ERB_LOAD(g) do { _Pragma("unroll") for (int bj = 0; bj < 2; ++bj) pv[g][bj] = *(const u32x4*)(xb + (size_t)(row0 + ((g) >> 2) * HALF + ((g) & 3) * 16) * DM + col0 + bj * HALF); } while (0)
            float qsv[8];
            if constexpr (Q8) {
#pragma unroll
                for (int g = 0; g < 8; ++g) qsv[g] = rs0[row0 + (g >> 2) * HALF + (g & 3) * 16] * (127.0f / CQ2);
            }
            ERB_LOAD(0); ERB_LOAD(1); ERB_LOAD(2); ERB_LOAD(3);
#pragma unroll
            for (int g = 0; g < 8; ++g) { const int ai = g >> 2, m = g & 3, row = row0 + ai * HALF + m * 16; float ss = 0.f;
                if (g + 4 < 8) { ERB_LOAD(g + 4); }
                asm volatile("" ::: "memory");
#pragma unroll
                for (int bj = 0; bj < 2; ++bj) { const size_t off = (size_t)row * DM + col0 + bj * HALF; const u32x4 p = pv[g][bj];
                    const f32x4 b0 = {__uint_as_float(p.x << 16), __uint_as_float(p.x & 0xffff0000u), __uint_as_float(p.y << 16), __uint_as_float(p.y & 0xffff0000u)};
                    const f32x4 b1 = {__uint_as_float(p.z << 16), __uint_as_float(p.z & 0xffff0000u), __uint_as_float(p.w << 16), __uint_as_float(p.w & 0xffff0000u)};
                    const f32x4 y0 = b0 + acc[ai][bj][m][0], y1 = b1 + acc[ai][bj][m][1];
                    if (WR) *(u32x4*)(xb + off) = pack8(y0, y1); ss += dot4(y0) + dot4(y1);
                    if constexpr (Q8) { if (WR) *(u32x2*)(x8 + off) = (u32x2){q8x4(y0, qsv[g]), q8x4(y1, qsv[g])}; } }
                ss += __shfl_xor(ss, 16); ss += __shfl_xor(ss, 32);
                if constexpr (Q8) ss = (ss + RMS_EPS * (DM / 16)) * (qsv[g] * qsv[g]);
                if (fq == 0) rsq[(size_t)row * 16 + u.pn * 4 + wc] = ss; }
#undef ERB_LOAD
        } else {
            f32x4 bv[8][2][2];
#define ER_LOAD(g) do { _Pragma("unroll") for (int bj = 0; bj < 2; ++bj) { const float* p_ = base + (size_t)(row0 + ((g) >> 2) * HALF + ((g) & 3) * 16) * DM + col0 + bj * HALF; bv[g][bj][0] = *(const f32x4*)p_; bv[g][bj][1] = *(const f32x4*)(p_ + 4); } } while (0)
            ER_LOAD(0); ER_LOAD(1);
#pragma unroll
            for (int g = 0; g < 8; ++g) { const int ai = g >> 2, m = g & 3, row = row0 + ai * HALF + m * 16; float ss = 0.f;
                if (g + 2 < 8) { ER_LOAD(g + 2); }
                asm volatile("" ::: "memory");
#pragma unroll
                for (int bj = 0; bj < 2; ++bj) { const size_t off = (size_t)row * DM + col0 + bj * HALF;
                    const f32x4 y0 = bv[g][bj][0] + acc[ai][bj][m][0], y1 = bv[g][bj][1] + acc[ai][bj][m][1];
                    if (WR) *(u32x4*)(xb + off) = pack8(y0, y1); ss += dot4(y0) + dot4(y1); }
                ss += __shfl_xor(ss, 16); ss += __shfl_xor(ss, 32);
                if (fq == 0) rsq[(size_t)row * 16 + u.pn * 4 + wc] = ss; }
#undef ER_LOAD
        }
    }
};
struct EpiResXN {
    static constexpr bool PERM = true, AFTER_DRAIN = false;
    const bf16_t* xn; const float* rs0; const float* gcol; bf16_t* xb; float* rsq; signed char* x8;
    __device__ __forceinline__ void operator()(const f32x4 (&acc)[2][2][4][2], const Unit& u, int wr, int wc, int fr, int fq) const {
        const int row0 = u.pm * BM + wr * 64 + fr, col0 = u.pn * BM + wc * 32 + 8 * fq;
        f32x4 ig[2][2];
#pragma unroll
        for (int bj = 0; bj < 2; ++bj)
#pragma unroll
            for (int n = 0; n < 2; ++n) { const f32x4 g = *(const f32x4*)(gcol + col0 + bj * HALF + 4 * n); ig[bj][n] = (f32x4){frcp(g[0]), frcp(g[1]), frcp(g[2]), frcp(g[3])}; }
        float r0[8];
#pragma unroll
        for (int g = 0; g < 8; ++g) r0[g] = rs0[row0 + (g >> 2) * HALF + (g & 3) * 16];
        u32x4 pv[8][2];
#define ERX_LOAD(g) do { _Pragma("unroll") for (int bj = 0; bj < 2; ++bj) pv[g][bj] = *(const u32x4*)(xn + (size_t)(row0 + ((g) >> 2) * HALF + ((g) & 3) * 16) * DM + col0 + bj * HALF); } while (0)
        ERX_LOAD(0); ERX_LOAD(1); ERX_LOAD(2); ERX_LOAD(3);
#pragma unroll
        for (int g = 0; g < 8; ++g) { const int ai = g >> 2, m = g & 3, row = row0 + ai * HALF + m * 16; float ss = 0.f;
            if (g + 4 < 8) { ERX_LOAD(g + 4); }
            asm volatile("" ::: "memory");
#pragma unroll
            for (int bj = 0; bj < 2; ++bj) { const size_t off = (size_t)row * DM + col0 + bj * HALF; const u32x4 p = pv[g][bj];
                const f32x4 b0 = {__uint_as_float(p.x << 16), __uint_as_float(p.x & 0xffff0000u), __uint_as_float(p.y << 16), __uint_as_float(p.y & 0xffff0000u)};
                const f32x4 b1 = {__uint_as_float(p.z << 16), __uint_as_float(p.z & 0xffff0000u), __uint_as_float(p.w << 16), __uint_as_float(p.w & 0xffff0000u)};
                const float irg = frcp(r0[g]), qs = r0[g] * (127.0f / CQ);
                const f32x4 y0 = b0 * ig[bj][0] * irg + acc[ai][bj][m][0], y1 = b1 * ig[bj][1] * irg + acc[ai][bj][m][1];
                *(u32x4*)(xb + off) = pack8(y0, y1); ss += dot4(y0) + dot4(y1);
                *(u32x2*)(x8 + off) = (u32x2){q8x4(y0, qs), q8x4(y1, qs)}; }
            ss += __shfl_xor(ss, 16); ss += __shfl_xor(ss, 32);
            if (fq == 0) { const float qs = r0[g] * (127.0f / CQ); rsq[(size_t)row * 16 + u.pn * 4 + wc] = (ss + RMS_EPS * (DM / 16)) * (qs * qs); } }
#undef ERX_LOAD
    }
};
struct EpiPleNorm {
    static constexpr bool PERM = true, AFTER_DRAIN = false;
    float* out; const bf16_t* xb; const bf16_t* pw; const float* rsq_in; float* rsq_out; unsigned* pcnt; const float* fnorm; unsigned long long* dts; const unsigned* wsc;
#define EPN_STAMP(i) do { if (dts && wr == 0 && wc == 0 && fr == 0 && fq == 0) __hip_atomic_store(dts + (i) + 4 * (u.pm >= 64 ? 1 : 0), (unsigned long long)__builtin_amdgcn_s_memrealtime(), __ATOMIC_RELAXED, __HIP_MEMORY_SCOPE_AGENT); } while (0)
    __device__ __forceinline__ void operator()(const f32x4 (&acc_)[2][2][4][2], const Unit& u, int wr, int wc, int fr, int fq) const {
        f32x4 (&acc)[2][2][4][2] = const_cast<f32x4 (&)[2][2][4][2]>(acc_);
        const int row0 = u.pm * BM + wr * 64 + fr, col0 = u.pn * BM + wc * 32 + 8 * fq;
        EPN_STAMP(30);
        float rsv[2][4]; rs8<false>(rsq_in, row0, fq, rsv);
        { const float sw = __uint_as_float(*wsc) * (1.0f / 127.0f);
#pragma unroll
          for (int ai = 0; ai < 2; ++ai)
#pragma unroll
              for (int m = 0; m < 4; ++m) rsv[ai][m] *= sw; }
        u32x4 xq[8][2], pq[8][2];
#define EP_LOAD(g) do { _Pragma("unroll") for (int bj = 0; bj < 2; ++bj) { const size_t o_ = (size_t)(row0 + ((g) >> 2) * HALF + ((g) & 3) * 16) * DM + col0 + bj * HALF; xq[g][bj] = *(const u32x4*)(xb + o_); pq[g][bj] = *(const u32x4*)(pw + o_); } } while (0)
        EP_LOAD(0); EP_LOAD(1);
#pragma unroll
        for (int g = 0; g < 8; ++g) { const int ai = g >> 2, m = g & 3, row = row0 + ai * HALF + m * 16; const float rs = rsv[ai][m]; float ss = 0.f;
            if (g + 2 < 8) { EP_LOAD(g + 2); }
            asm volatile("" ::: "memory");
#pragma unroll
            for (int bj = 0; bj < 2; ++bj) {
                const u32x4 pv = pq[g][bj];
                const f32x4 p0 = {__uint_as_float(pv.x << 16), __uint_as_float(pv.x & 0xffff0000u), __uint_as_float(pv.y << 16), __uint_as_float(pv.y & 0xffff0000u)};
                const f32x4 p1 = {__uint_as_float(pv.z << 16), __uint_as_float(pv.z & 0xffff0000u), __uint_as_float(pv.w << 16), __uint_as_float(pv.w & 0xffff0000u)};
                f32x4 g0 = i2f4(acc[ai][bj][m][0]) * rs, g1 = i2f4(acc[ai][bj][m][1]) * rs;
#pragma unroll
                for (int j = 0; j < 4; ++j) { g0[j] = fsigmoid(g0[j]); g1[j] = fsigmoid(g1[j]); }
                const u32x4 xv = xq[g][bj];
                const f32x4 x0 = {__uint_as_float(xv.x << 16), __uint_as_float(xv.x & 0xffff0000u), __uint_as_float(xv.y << 16), __uint_as_float(xv.y & 0xffff0000u)};
                const f32x4 x1 = {__uint_as_float(xv.z << 16), __uint_as_float(xv.z & 0xffff0000u), __uint_as_float(xv.w << 16), __uint_as_float(xv.w & 0xffff0000u)};
                const f32x4 y0 = x0 + p0 * g0, y1 = x1 + p1 * g1;
                acc[ai][bj][m][0] = y0; acc[ai][bj][m][1] = y1; ss += dot4(y0) + dot4(y1); }
            ss += __shfl_xor(ss, 16); ss += __shfl_xor(ss, 32);
            if (fq == 0) __hip_atomic_store((unsigned*)(rsq_out + (size_t)row * 16 + u.pn * 4 + wc), __float_as_uint(ss), __ATOMIC_RELAXED, __HIP_MEMORY_SCOPE_AGENT); }
#undef EP_LOAD
        asm volatile("s_waitcnt vmcnt(0)" ::: "memory");
        EPN_STAMP(31);
        unsigned* pc = pcnt + 16 * u.pm;
        if (fq == 0 && fr == 0) __hip_atomic_fetch_add(pc, 1u, __ATOMIC_RELAXED, __HIP_MEMORY_SCOPE_AGENT);
        for (unsigned spins = 0; spins < (1u << 22); ++spins) {
            if ((unsigned)__builtin_amdgcn_readfirstlane(__hip_atomic_load(pc, __ATOMIC_RELAXED, __HIP_MEMORY_SCOPE_AGENT)) >= 32u) break;
            __builtin_amdgcn_s_sleep(2);
        }
        EPN_STAMP(32);
        f32x4 fn[2][2];
#pragma unroll
        for (int bj = 0; bj < 2; ++bj) { fn[bj][0] = *(const f32x4*)(fnorm + col0 + bj * HALF); fn[bj][1] = *(const f32x4*)(fnorm + col0 + bj * HALF + 4); }
        unsigned long long pa[8], pb[8];
#pragma unroll
        for (int g = 0; g < 8; ++g) { const unsigned long long* pp = (const unsigned long long*)(rsq_out + (size_t)(row0 + (g >> 2) * HALF + (g & 3) * 16) * 16 + 4 * fq);
            pa[g] = __hip_atomic_load(pp, __ATOMIC_RELAXED, __HIP_MEMORY_SCOPE_AGENT); pb[g] = __hip_atomic_load(pp + 1, __ATOMIC_RELAXED, __HIP_MEMORY_SCOPE_AGENT); }
#pragma unroll
        for (int g = 0; g < 8; ++g) { const int ai = g >> 2, m = g & 3, row = row0 + ai * HALF + m * 16;
            float s = (__uint_as_float((unsigned)pa[g]) + __uint_as_float((unsigned)(pa[g] >> 32))) + (__uint_as_float((unsigned)pb[g]) + __uint_as_float((unsigned)(pb[g] >> 32)));
            s += __shfl_xor(s, 16); s += __shfl_xor(s, 32);
            const float rs3 = rsqrtf(s * (1.0f / DM) + RMS_EPS);
#pragma unroll
            for (int bj = 0; bj < 2; ++bj) { const size_t off = (size_t)row * DM + col0 + bj * HALF;
                *(f32x4*)(out + off) = acc[ai][bj][m][0] * rs3 * fn[bj][0]; *(f32x4*)(out + off + 4) = acc[ai][bj][m][1] * rs3 * fn[bj][1]; } }
        EPN_STAMP(33);
    }
};
#undef EPN_STAMP
struct EpiUG {
    static constexpr bool PERM = true, AFTER_DRAIN = false;
    bf16_t* act; const float* rsq; const float* cw; const float* cb; float* UL; float* UF; float* GF; const float* wsc;
    __device__ __forceinline__ void operator()(const f32x4 (&acc)[2][2][4][2], const Unit& u, int wr, int wc, int fr, int fq) const {
        const int cu = u.pn * HALF + wc * 32 + 8 * fq;
        const int row0 = u.pm * BM + wr * 64 + fr;
        float rsv[2][4]; rs8<false>(rsq, row0, fq, rsv);
        const float* wsc_ = wsc; asm volatile("" : "+s"(wsc_));
        const float* wscu = wsc_ + u.pn * BM + wc * 32 + 8 * fq;
        float sg[8];
#pragma unroll
        for (int q = 0; q < 2; ++q) { const f32x4 b = *(const f32x4*)(wscu + HALF + 4 * q);
#pragma unroll
            for (int j = 0; j < 4; ++j) sg[4 * q + j] = b[j]; }
        float w0[8], w1[8], w2[8], bb[8];
#pragma unroll
        for (int q = 0; q < 2; ++q) { const f32x4 a = *(const f32x4*)(cw + cu + 4 * q), b = *(const f32x4*)(cw + FF + cu + 4 * q), c = *(const f32x4*)(cw + 2 * FF + cu + 4 * q), d = *(const f32x4*)(cb + cu + 4 * q);
            const f32x4 s_ = *(const f32x4*)(wscu + 4 * q);
#pragma unroll
            for (int j = 0; j < 4; ++j) { w0[4 * q + j] = a[j] * s_[j]; w1[4 * q + j] = b[j] * s_[j]; w2[4 * q + j] = c[j] * s_[j]; bb[4 * q + j] = d[j]; } }
#pragma unroll
        for (int ai = 0; ai < 2; ++ai) {
            float up[8];
#pragma unroll
            for (int m = 0; m < 4; ++m) {
                const int row = row0 + ai * HALF + m * 16;
                const float rs = rsv[ai][m];
                float uu[8], gg[8], a8[8];
#pragma unroll
                for (int n = 0; n < 2; ++n) { const f32x4 au = i2f4(acc[ai][0][m][n]), ag = i2f4(acc[ai][1][m][n]);
#pragma unroll
                    for (int j = 0; j < 4; ++j) { uu[4 * n + j] = au[j] * rs; gg[4 * n + j] = ag[j] * rs * sg[4 * n + j]; } }
#pragma unroll
                for (int kp = 0; kp < 4; ++kp) {
                    const int k0 = 2 * kp, k1 = 2 * kp + 1;
                    float t1a = 0.f, t2a = 0.f, t1b = 0.f, t2b = 0.f;
                    if (m > 0) { t1a = DPP_ROT(up[k0], 0x121); t2a = DPP_ROT(up[k0], 0x122); t1b = DPP_ROT(up[k1], 0x121); t2b = DPP_ROT(up[k1], 0x122); }
                    const f32x2 u0 = {uu[k0], uu[k1]};
                    const f32x2 u1 = {DPP_MOV(t1a, uu[k0], 0x111), DPP_MOV(t1b, uu[k1], 0x111)}, u2 = {DPP_MOV(t2a, uu[k0], 0x112), DPP_MOV(t2b, uu[k1], 0x112)};
                    const f32x2 W0 = {w0[k0], w0[k1]}, W1 = {w1[k0], w1[k1]}, W2 = {w2[k0], w2[k1]}, B = {bb[k0], bb[k1]}, G2 = {gg[k0], gg[k1]};
                    const f32x2 y = __builtin_elementwise_fma(W0, u2, __builtin_elementwise_fma(W1, u1, __builtin_elementwise_fma(W2, u0, B)));
                    const f32x2 c1 = {2.302208198f * 0.044715f, 2.302208198f * 0.044715f}, c2 = {2.302208198f, 2.302208198f};
                    const f32x2 z = y * __builtin_elementwise_fma(y * y, c1, c2);
                    const f32x2 d = {1.0f + __builtin_amdgcn_exp2f(-z[0]), 1.0f + __builtin_amdgcn_exp2f(-z[1])};
                    const f32x2 r = {frcp(d[0]), frcp(d[1])};
                    const f32x2 o = (y * r) * G2;
                    a8[k0] = o[0]; a8[k1] = o[1];
                }
                const bool defer = (m == 0) && (fr < 2);
                if (!defer) { u32x4 w; w.x = cvt_pk_bf16(a8[0], a8[1]); w.y = cvt_pk_bf16(a8[2], a8[3]); w.z = cvt_pk_bf16(a8[4], a8[5]); w.w = cvt_pk_bf16(a8[6], a8[7]);
                    *(u32x4*)(act + (size_t)row * FF + cu) = w; }
                else { const size_t so = ((size_t)(row >> 6) * 2 + fr) * FF + cu;
                    *(f32x4*)(UF + so) = (f32x4){uu[0], uu[1], uu[2], uu[3]}; *(f32x4*)(UF + so + 4) = (f32x4){uu[4], uu[5], uu[6], uu[7]};
                    *(f32x4*)(GF + so) = (f32x4){gg[0], gg[1], gg[2], gg[3]}; *(f32x4*)(GF + so + 4) = (f32x4){gg[4], gg[5], gg[6], gg[7]}; }
                if (m == 3 && fr >= 14) { int f14 = fr - 14; asm volatile("" : "+v"(f14)); const size_t so = ((size_t)(row >> 6) * 2 + f14) * FF + cu;
                    *(f32x4*)(UL + so) = (f32x4){uu[0], uu[1], uu[2], uu[3]}; *(f32x4*)(UL + so + 4) = (f32x4){uu[4], uu[5], uu[6], uu[7]}; }
#pragma unroll
                for (int k = 0; k < 8; ++k) up[k] = uu[k];
            }
        }
    }
};
}
#define LAS __attribute__((address_space(3)))
namespace mx {
typedef short bf16x8 __attribute__((ext_vector_type(8)));
typedef short s16x4 __attribute__((ext_vector_type(4)));
typedef float f32x16 __attribute__((ext_vector_type(16)));
typedef unsigned u32x4 __attribute__((ext_vector_type(4)));
typedef float f32x4_t __attribute__((ext_vector_type(4)));
typedef LAS const char* lds_cptr;
typedef LAS char* lds_ptr;
__device__ __forceinline__ int crow(int r, int hi) { return (r & 3) + 8 * (r >> 2) + 4 * hi; }
__device__ __forceinline__ s16x4 vtr(lds_cptr p) { return __builtin_bit_cast(s16x4, __builtin_amdgcn_ds_read_tr16_b64_v4i16((LAS s16x4*)p)); }
__device__ __forceinline__ bf16x8 cat8(s16x4 lo, s16x4 hi) { return (bf16x8){lo[0], lo[1], lo[2], lo[3], hi[0], hi[1], hi[2], hi[3]}; }
typedef float f32x2_t __attribute__((ext_vector_type(2))); typedef __bf16 bf16x2_t __attribute__((ext_vector_type(2)));
__device__ __forceinline__ unsigned pk(float lo, float hi) { const f32x2_t v = {lo, hi}; return __builtin_bit_cast(unsigned, __builtin_convertvector(v, bf16x2_t)); }
typedef __bf16 bf16x2_d __attribute__((ext_vector_type(2)));
__device__ __forceinline__ float dot2bf(unsigned a, unsigned b, float c) { return __builtin_amdgcn_fdot2_f32_bf16(__builtin_bit_cast(bf16x2_d, a), __builtin_bit_cast(bf16x2_d, b), c, false); }
__device__ __forceinline__ float dot8bf(u32x4 a, u32x4 b, float c) { return dot2bf(a.w, b.w, dot2bf(a.z, b.z, dot2bf(a.y, b.y, dot2bf(a.x, b.x, c)))); }
__device__ __forceinline__ float other_half(float v) { return __shfl_xor(v, 32); }

constexpr int L_K = 0, L_V = 32768;
constexpr int L_WSF = 65536;
constexpr int L_OST = 65536 + 2048;
constexpr int L_ENT = L_OST + 32768;
constexpr int ENT_CAP = 4096;
constexpr int L_PREF = L_ENT + ENT_CAP * 4;
constexpr int L_MW = L_PREF + 512;
constexpr int L_END = L_MW + 4096;
static_assert(L_END <= 147456, "mixer LDS map");

__device__ __forceinline__ void moba_stage_kv(const bf16_t* __restrict__ proj, int b, int h, int blk, lds_ptr lds, int tid) {
#pragma unroll
    for (int i = 0; i < 4; ++i) { const int pc = tid + 512 * i, key = pc >> 3, ch = pc & 7;
        const bf16_t* src = proj + ((size_t)(b * 8 + h) * SEQ + blk * 256 + key) * 64 + ch * 8;
        const u32x4 kv = *(const u32x4*)(src + SEC), vv = *(const u32x4*)(src + 2 * SEC);
        *(LAS u32x4*)(lds + L_K + ch * 4096 + key * 16) = kv;
        *(LAS u32x4*)(lds + L_V + (key >> 6) * 8192 + (ch >> 2) * 4096 + ((key & 63) >> 3) * 512 + (key & 7) * 64 + (ch & 3) * 16) = vv; }
}

__device__ __forceinline__ void moba_stage_kv_load(const bf16_t* __restrict__ proj, int b, int h, int blk, int tid, u32x4 (&kr)[4], u32x4 (&vr)[4]) {
#pragma unroll
    for (int i = 0; i < 4; ++i) { const int pc = tid + 512 * i, key = pc >> 3, ch = pc & 7;
        const bf16_t* src = proj + ((size_t)(b * 8 + h) * SEQ + blk * 256 + key) * 64 + ch * 8;
        kr[i] = *(const u32x4*)(src + SEC); vr[i] = *(const u32x4*)(src + 2 * SEC); }
}
__device__ __forceinline__ void moba_stage_kv_store(lds_ptr lds, int tid, const u32x4 (&kr)[4], const u32x4 (&vr)[4]) {
#pragma unroll
    for (int i = 0; i < 4; ++i) { const int pc = tid + 512 * i, key = pc >> 3, ch = pc & 7;
        *(LAS u32x4*)(lds + L_K + ch * 4096 + key * 16) = kr[i];
        *(LAS u32x4*)(lds + L_V + (key >> 6) * 8192 + (ch >> 2) * 4096 + ((key & 63) >> 3) * 512 + (key & 7) * 64 + (ch & 3) * 16) = vr[i]; }
}

__device__ __forceinline__ void moba_batch(const bf16x8 (&qr)[4], int qpos, int kbase, float slope2, bool diag, int ntiles, lds_ptr lds, int wave, int lane, bf16_t* odst, float* ldst,
                                           const bf16_t* part_row = nullptr, const float* pl_row = nullptr, int nv = 0, bf16_t* mix_row = nullptr, bf16_t* mix_base = nullptr) {
    const int r32 = lane & 31, hi = lane >> 5;
    f32x16 o0, o1;
#pragma unroll
    for (int r = 0; r < 16; ++r) { o0[r] = 0.f; o1[r] = 0.f; }
    float m = -1e30f, l = 0.f;
    const lds_cptr kp = (lds_cptr)lds + L_K + hi * 4096 + r32 * 16;
    const lds_cptr vp = (lds_cptr)lds + L_V + ((lane >> 4) & 1) * 32 + (lane & 3) * 8 + (4 * hi + ((lane & 15) >> 2)) * 64;
    LAS float* wsf = (LAS float*)(lds + L_WSF) + wave * 64;
    const float s4h = slope2 * (float)(4 * hi);
#define MX_LOAD(KT) bf16x8 kf_[4], kg_[4], vf_[2][4]; do { _Pragma("unroll") for (int d0 = 0; d0 < 4; ++d0) { kf_[d0] = *(const LAS bf16x8*)(kp + (KT) * 1024 + d0 * 8192); kg_[d0] = *(const LAS bf16x8*)(kp + (KT) * 1024 + 512 + d0 * 8192); } \
        const lds_cptr vt_ = vp + (KT) * 8192; _Pragma("unroll") for (int db = 0; db < 2; ++db) _Pragma("unroll") for (int ks = 0; ks < 4; ++ks) vf_[db][ks] = cat8(vtr(vt_ + db * 4096 + ks * 1024), vtr(vt_ + db * 4096 + ks * 1024 + 512)); \
        __builtin_amdgcn_sched_barrier(0); } while (0)
#define MX_QK(P0, P1, C0, C1) do { _Pragma("unroll") for (int d0 = 0; d0 < 4; ++d0) { \
        P0 = __builtin_amdgcn_mfma_f32_32x32x16_bf16(kf_[d0], qr[d0], d0 == 0 ? C0 : P0, 0, 0, 0); P1 = __builtin_amdgcn_mfma_f32_32x32x16_bf16(kg_[d0], qr[d0], d0 == 0 ? C1 : P1, 0, 0, 0); } } while (0)
#define MX_PV(O, DB, KS, PW) O = __builtin_amdgcn_mfma_f32_32x32x16_bf16(__builtin_bit_cast(bf16x8, PW), vf_[DB][KS], O, 0, 0, 0)
#define MX_PVALL() do { \
        const u32x4 pw0 = {pk(p0[0], p0[1]), pk(p0[2], p0[3]), pk(p0[4], p0[5]), pk(p0[6], p0[7])}, pw1 = {pk(p0[8], p0[9]), pk(p0[10], p0[11]), pk(p0[12], p0[13]), pk(p0[14], p0[15])}; \
        const u32x4 pw2 = {pk(p1[0], p1[1]), pk(p1[2], p1[3]), pk(p1[4], p1[5]), pk(p1[6], p1[7])}, pw3 = {pk(p1[8], p1[9]), pk(p1[10], p1[11]), pk(p1[12], p1[13]), pk(p1[14], p1[15])}; \
        MX_PV(o0, 0, 0, pw0); MX_PV(o1, 1, 0, pw0); MX_PV(o0, 0, 1, pw1); MX_PV(o1, 1, 1, pw1); MX_PV(o0, 0, 2, pw2); MX_PV(o1, 1, 2, pw2); MX_PV(o0, 0, 3, pw3); MX_PV(o1, 1, 3, pw3); } while (0)
    {
        const int kt = ntiles - 1;
        f32x16 p0, p1;
        MX_LOAD(kt);
#pragma unroll
        for (int r = 0; r < 16; ++r) { p0[r] = fmaf(slope2, (float)((r & 3) + 8 * (r >> 2)), s4h); p1[r] = p0[r]; }
        MX_QK(p0, p1, p0, p1);
        const int dq = qpos - kbase - 64 * kt;
        const float t0 = -slope2 * (float)dq, t1 = t0 + 32.0f * slope2;
        if (diag) {
#pragma unroll
            for (int r = 0; r < 16; ++r) { const int c = crow(r, hi); if (c > dq) p0[r] = -1e30f; if (c + 32 > dq) p1[r] = -1e30f; }
        }
        float mx0 = p0[0], mx1 = p1[0];
#pragma unroll
        for (int r = 1; r < 16; ++r) { mx0 = fmaxf(mx0, p0[r]); mx1 = fmaxf(mx1, p1[r]); }
        float mx_ = fmaxf(mx0 + t0, mx1 + t1);
        m = fmaxf(mx_, other_half(mx_));
        const float e0 = m - t0, e1 = m - t1;
        float rs = 0.f;
#pragma unroll
        for (int r = 0; r < 16; ++r) { p0[r] = __builtin_amdgcn_exp2f(p0[r] - e0); p1[r] = __builtin_amdgcn_exp2f(p1[r] - e1); rs += p0[r] + p1[r]; }
        l = rs;
        MX_PVALL();
    }
    for (int kt = ntiles - 2; kt >= 0; --kt) {
        const int dq = qpos - kbase - 64 * kt;
        const float c0 = -slope2 * (float)dq - m + s4h, c1 = c0 + 32.0f * slope2;
        f32x16 p0, p1;
        MX_LOAD(kt);
#pragma unroll
        for (int r = 0; r < 16; ++r) { const float cr = (float)((r & 3) + 8 * (r >> 2)); p0[r] = fmaf(slope2, cr, c0); p1[r] = fmaf(slope2, cr, c1); }
        MX_QK(p0, p1, p0, p1);
        float mx_ = fmaxf(p0[0], p1[0]);
#pragma unroll
        for (int r = 1; r < 16; ++r) mx_ = fmaxf(mx_, fmaxf(p0[r], p1[r]));
        mx_ = fmaxf(mx_, other_half(mx_));
        if (__all(mx_ < -30.0f)) continue;
        if (__any(mx_ > 16.0f)) {
            const float dl = fmaxf(mx_, 0.f); m += dl;
#pragma unroll
            for (int r = 0; r < 16; ++r) { p0[r] -= dl; p1[r] -= dl; }
            const float f = __builtin_amdgcn_exp2f(-dl); l *= f;
            if (hi == 0) wsf[r32] = f;
#pragma unroll
            for (int r = 0; r < 16; ++r) { const float g = wsf[crow(r, hi)]; o0[r] *= g; o1[r] *= g; }
        }
        float rs = 0.f;
#pragma unroll
        for (int r = 0; r < 16; ++r) { p0[r] = __builtin_amdgcn_exp2f(p0[r]); p1[r] = __builtin_amdgcn_exp2f(p1[r]); rs += p0[r] + p1[r]; }
        l += rs;
        MX_PVALL();
    }
#undef MX_LOAD
#undef MX_QK
#undef MX_PV
#undef MX_PVALL
    l += other_half(l);
    if (hi == 0) wsf[32 + r32] = 1.0f / l;
    const float lse = m + __builtin_amdgcn_logf(l);
    LAS bf16_t* ost = (LAS bf16_t*)(lds + L_OST) + wave * 2048;
#pragma unroll
    for (int r = 0; r < 16; ++r) { const int orow = crow(r, hi); const float f = wsf[32 + orow];
        ost[orow * 64 + r32] = (bf16_t)pk(o0[r] * f, 0.f); ost[orow * 64 + 32 + r32] = (bf16_t)pk(o1[r] * f, 0.f); }
    if (mix_row == nullptr) {
        const unsigned long long dp = (unsigned long long)odst; const unsigned dlo = (unsigned)dp, dhi = (unsigned)(dp >> 32);
#pragma unroll
        for (int i = 0; i < 4; ++i) { const int row = i * 8 + (lane >> 3), ch = lane & 7;
            const u32x4 v = *(const LAS u32x4*)(ost + row * 64 + ch * 8);
            const unsigned long long d = ((unsigned long long)(unsigned)__shfl((int)dhi, row) << 32) | (unsigned)__shfl((int)dlo, row);
            if (d) *(u32x4*)((bf16_t*)d + ch * 8) = v; }
        if (hi == 0 && ldst) *ldst = lse;
    } else {
        if (hi == 0) { const f32x4_t lv = *(const f32x4_t*)pl_row;
            const float a0 = nv > 0 ? lv[0] : -1e30f, a1 = nv > 1 ? lv[1] : -1e30f, a2 = nv > 2 ? lv[2] : -1e30f;
            const float mm = fmaxf(fmaxf(a0, a1), fmaxf(a2, lse));
            const float w0 = __builtin_amdgcn_exp2f(a0 - mm), w1 = __builtin_amdgcn_exp2f(a1 - mm), w2 = __builtin_amdgcn_exp2f(a2 - mm), w3 = __builtin_amdgcn_exp2f(lse - mm);
            const float iw = 1.0f / ((w0 + w1) + (w2 + w3));
            ((LAS f32x4_t*)(lds + L_MW) + wave * 32)[r32] = (f32x4_t){w0 * iw, w1 * iw, w2 * iw, w3 * iw}; }
        const unsigned long long pp = (unsigned long long)part_row, mp = (unsigned long long)mix_row;
        const unsigned plo = (unsigned)pp, phi = (unsigned)(pp >> 32), mlo = (unsigned)mp, mhi = (unsigned)(mp >> 32);
#pragma unroll
        for (int i = 0; i < 4; ++i) { const int row = i * 8 + (lane >> 3), ch = lane & 7;
            const u32x4 v = *(const LAS u32x4*)(ost + row * 64 + ch * 8);
            const f32x4_t w = ((const LAS f32x4_t*)(lds + L_MW) + wave * 32)[row];
            const bf16_t* pr = (const bf16_t*)(((unsigned long long)(unsigned)__shfl((int)phi, row) << 32) | (unsigned)__shfl((int)plo, row));
            bf16_t* mr = (bf16_t*)(((unsigned long long)(unsigned)__shfl((int)mhi, row) << 32) | (unsigned)__shfl((int)mlo, row));
            const unsigned vw[4] = {v.x, v.y, v.z, v.w}; float acc[8];
#pragma unroll
            for (int q = 0; q < 4; ++q) { acc[2 * q] = w[3] * __uint_as_float(vw[q] << 16); acc[2 * q + 1] = w[3] * __uint_as_float(vw[q] & 0xffff0000u); }
#pragma unroll
            for (int s = 0; s < 3; ++s) if (w[s] != 0.f) { const u32x4 pv = *(const u32x4*)(pr + s * 64 + ch * 8); const unsigned pw_[4] = {pv.x, pv.y, pv.z, pv.w};
#pragma unroll
                for (int q = 0; q < 4; ++q) { acc[2 * q] += w[s] * __uint_as_float(pw_[q] << 16); acc[2 * q + 1] += w[s] * __uint_as_float(pw_[q] & 0xffff0000u); } }
            *(u32x4*)(mr + ch * 8) = (u32x4){pk(acc[0], acc[1]), pk(acc[2], acc[3]), pk(acc[4], acc[5]), pk(acc[6], acc[7])}; }
    }
}

__device__ __forceinline__ void moba_diag_unit(const bf16_t* __restrict__ proj, int bh, int i, const bf16_t* part_o, const float* part_l, const u32* __restrict__ sel, bf16_t* mix, lds_ptr lds, int tid) {
    const int b = bh >> 3, h = bh & 7, lane = tid & 63, wave = __builtin_amdgcn_readfirstlane(tid >> 6);
    const int ql = wave * 32 + (lane & 31), t = i * 256 + ql; const size_t row = (size_t)b * SEQ + t;
    bf16x8 qr[4];
    { const bf16_t* qp = proj + ((size_t)bh * SEQ + t) * 64 + (lane >> 5) * 8;
#pragma unroll
      for (int d0 = 0; d0 < 4; ++d0) qr[d0] = *(const bf16x8*)(qp + d0 * 16); }
    moba_stage_kv(proj, b, h, i, lds, tid);
    __syncthreads();
    const float slope2 = __builtin_amdgcn_exp2f(-(float)(h + 1)) * LOG2E;
    const int nv = (int)(sel[row * 8 + h] >> 24);
    moba_batch(qr, t, i * 256, slope2, true, (wave >> 1) + 1, lds, wave, lane, nullptr, nullptr,
               part_o + ((row * 8 + h) * 4) * 64, part_l + (row * 8 + h) * 4, nv, mix + row * DM + h * 64, mix);
    __syncthreads();
}
__device__ __forceinline__ void moba_sel_task(const bf16_t* __restrict__ proj, const unsigned short* __restrict__ seg, const int* __restrict__ cnt, int bh, int n,
                                              bf16_t* part_o, float* part_l, lds_ptr lds, int tid, int part = 0, int nparts = 1) {
    const int b = bh >> 3, h = bh & 7, lane = tid & 63, wave = __builtin_amdgcn_readfirstlane(tid >> 6);
    LAS int* pref = (LAS int*)(lds + L_PREF); LAS unsigned* ent = (LAS unsigned*)(lds + L_ENT);
    u32x4 kr_[4], vr_[4]; moba_stage_kv_load(proj, b, h, n, tid, kr_, vr_);
    if (wave == 0) {
        const int c = (lane > n) ? cnt[((size_t)bh * 64 + n) * 64 + lane] : 0; int s = c;
#pragma unroll
        for (int o = 1; o < 64; o <<= 1) { const int v = __shfl_up(s, o); if (lane >= o) s += v; }
        pref[lane + 1] = s; if (lane == 0) pref[0] = 0;
    }
    __syncthreads();
    const int Tall = pref[64];
    const int lo = nparts == 1 ? 0 : ((Tall * part / nparts) & ~31), T = (nparts == 1 || part == nparts - 1) ? Tall : ((Tall * (part + 1) / nparts) & ~31);
    if (T <= lo) { __syncthreads(); return; }
    moba_stage_kv_store(lds, tid, kr_, vr_);
    const float slope2 = __builtin_amdgcn_exp2f(-(float)(h + 1)) * LOG2E;
    for (int c0 = lo; c0 < T; c0 += ENT_CAP) {
        const int cn = (T - c0) < ENT_CAP ? (T - c0) : ENT_CAP;
        const unsigned short* segn = seg + ((size_t)bh * 64 + n) * 64 * 256;
#pragma unroll 2
        for (int g = tid; g < cn; g += 512) { const int G_ = c0 + g; int lo = 0;
#pragma unroll
            for (int st = 32; st >= 1; st >>= 1) { if (pref[lo + st] <= G_) lo += st; }
            ent[g] = ((unsigned)lo << 10) | (unsigned)segn[lo * 256 + (G_ - pref[lo])]; }
        __syncthreads();
        for (int wb = wave; wb * 32 < cn; wb += 8) {
            const int idx = wb * 32 + (lane & 31); const bool valid = idx < cn;
            const unsigned ec = ent[valid ? idx : wb * 32];
            const int t = (ec >> 10) * 256 + ((ec >> 2) & 255), slot = ec & 3; const size_t row = (size_t)b * SEQ + t;
            bf16x8 qr[4];
            { const bf16_t* qp = proj + ((size_t)bh * SEQ + t) * 64 + (lane >> 5) * 8;
#pragma unroll
              for (int d0 = 0; d0 < 4; ++d0) qr[d0] = *(const bf16x8*)(qp + d0 * 16); }
            moba_batch(qr, t, n * 256, slope2, false, 4, lds, wave, lane,
                       valid ? part_o + ((row * 8 + h) * 4 + slot) * 64 : (bf16_t*)nullptr, valid ? part_l + (row * 8 + h) * 4 + slot : (float*)nullptr);
        }
        __syncthreads();
    }
}
constexpr int G_KMH = 0, G_KML = 8192, G_CNT = 16384;
#define MX_INS(v, n) do { const bool g0_ = (v) > v0, g1_ = (v) > v1, g2_ = (v) > v2; \
    v2 = g1_ ? v1 : (g2_ ? (v) : v2); i2 = g1_ ? i1 : (g2_ ? (n) : i2); v1 = g0_ ? v0 : (g1_ ? (v) : v1); i1 = g0_ ? i0 : (g1_ ? (n) : i1); v0 = g0_ ? (v) : v0; i0 = g0_ ? (n) : i0; } while (0)
__device__ __forceinline__ void gate_task_mfma(int bh, int i, const bf16_t* __restrict__ proj, const float* __restrict__ kmsum, u32* __restrict__ sel,
                                               unsigned short* __restrict__ seg, int* __restrict__ cnt, const unsigned* __restrict__ kmx, float* __restrict__ part_l, lds_ptr lds, int tid, int nsrc = 1) {
    const int b = bh >> 3, h = bh & 7, lane = tid & 63, wave = __builtin_amdgcn_readfirstlane(tid >> 6), r32 = lane & 31, hi = lane >> 5;
    { const int n = tid >> 3, ch = tid & 7; const float* src = kmsum + (size_t)bh * 4096 + n * 64 + ch * 8;
      const f32x4_t a = *(const f32x4_t*)src * (1.0f / 256.0f), c = *(const f32x4_t*)(src + 4) * (1.0f / 256.0f);
      float v[8] = {a[0], a[1], a[2], a[3], c[0], c[1], c[2], c[3]}; float hf[8], lf[8];
#pragma unroll
      for (int k = 0; k < 8; ++k) { hf[k] = bf2f(f2bf(v[k])); lf[k] = v[k] - hf[k]; }
      const u32x4 H = {pk(hf[0], hf[1]), pk(hf[2], hf[3]), pk(hf[4], hf[5]), pk(hf[6], hf[7])}, Lw = {pk(lf[0], lf[1]), pk(lf[2], lf[3]), pk(lf[4], lf[5]), pk(lf[6], lf[7])};
      *(LAS u32x4*)(lds + G_KMH + ch * 1024 + n * 16) = H; *(LAS u32x4*)(lds + G_KML + ch * 1024 + n * 16) = Lw; }
    LAS int* cntL = (LAS int*)(lds + G_CNT);
#pragma unroll 1
    for (int rep_ = 0; rep_ < nsrc; ++rep_, ++i) {
    if (tid < 64) cntL[tid] = 0;
    __syncthreads();
    const int ql = wave * 32 + r32, t = i * 256 + ql; const size_t row = (size_t)b * SEQ + t;
    const bf16_t* qp = proj + ((size_t)bh * SEQ + t) * 64 + hi * 8;
    f32x16 p0, p1;
#pragma unroll
    for (int r = 0; r < 16; ++r) { p0[r] = 0.f; p1[r] = 0.f; }
    const bf16_t* ksp = proj + SEC + ((size_t)bh * SEQ + t) * 64 + hi * 8;
    float qq = 0.f, qk = 0.f;
#pragma unroll
    for (int ks = 0; ks < 4; ++ks) {
        const bf16x8 q = *(const bf16x8*)(qp + ks * 16);
        { const u32x4 qu = __builtin_bit_cast(u32x4, q), ku = *(const u32x4*)(ksp + ks * 16); qq = dot8bf(qu, qu, qq); qk = dot8bf(qu, ku, qk); }
        const lds_cptr kb = (lds_cptr)lds + (2 * ks + hi) * 1024 + r32 * 16;
        p0 = __builtin_amdgcn_mfma_f32_32x32x16_bf16(*(const LAS bf16x8*)(kb + G_KMH), q, p0, 0, 0, 0);
        p0 = __builtin_amdgcn_mfma_f32_32x32x16_bf16(*(const LAS bf16x8*)(kb + G_KML), q, p0, 0, 0, 0);
        p1 = __builtin_amdgcn_mfma_f32_32x32x16_bf16(*(const LAS bf16x8*)(kb + G_KMH + 512), q, p1, 0, 0, 0);
        p1 = __builtin_amdgcn_mfma_f32_32x32x16_bf16(*(const LAS bf16x8*)(kb + G_KML + 512), q, p1, 0, 0, 0);
    }
    float v0 = -INFINITY, v1 = -INFINITY, v2 = -INFINITY; int i0 = 0, i1 = 0, i2 = 0;
#pragma unroll
    for (int r = 0; r < 16; ++r) { const int n = crow(r, hi); const float v = n < i ? p0[r] : -INFINITY; MX_INS(v, n); }
#pragma unroll
    for (int r = 0; r < 16; ++r) { const int n = 32 + crow(r, hi); const float v = n < i ? p1[r] : -INFINITY; MX_INS(v, n); }
    { const float a0 = __shfl_xor(v0, 32), a1 = __shfl_xor(v1, 32), a2 = __shfl_xor(v2, 32); const int j0 = __shfl_xor(i0, 32), j1 = __shfl_xor(i1, 32), j2 = __shfl_xor(i2, 32);
      MX_INS(a0, j0); MX_INS(a1, j1); MX_INS(a2, j2); }
    qq += other_half(qq); qk += other_half(qk);
    if (hi == 0) {
        const int nv = i < 3 ? i : 3;
        sel[row * 8 + h] = (u32)i0 | ((u32)i1 << 8) | ((u32)i2 << 16) | ((u32)nv << 24);
        const float qn = sqrtf(qq) * 1.01f, slope2 = __builtin_amdgcn_exp2f(-(float)(h + 1)) * LOG2E;
#pragma unroll
        for (int s = 0; s < 3; ++s) if (s < nv) { const int n = s == 0 ? i0 : (s == 1 ? i1 : i2);
            const float kmax = sqrtf(__uint_as_float(kmx[((size_t)bh * 64 + n) * 2]) + __uint_as_float(kmx[((size_t)bh * 64 + n) * 2 + 1]));
            const float U = qn * kmax - slope2 * (float)(t - (n * 256 + 255));
            if (U + 8.0f - qk < -30.0f) part_l[(row * 8 + h) * 4 + s] = -1e30f;
            else { const int pos = atomicAdd((int*)&cntL[n], 1);
                seg[(((size_t)bh * 64 + n) * 64 + i) * 256 + pos] = (unsigned short)((ql << 2) | s); } }
    }
    __syncthreads();
    if (tid < i) cnt[((size_t)bh * 64 + tid) * 64 + i] = cntL[tid];
    __syncthreads();
    }
}
#undef MX_INS

__device__ __forceinline__ void moba_combine(const bf16_t* __restrict__ part_o, const float* __restrict__ part_l, const u32* __restrict__ sel, bf16_t* __restrict__ mix, size_t gt, size_t GT) {
    for (size_t i = gt; i < (size_t)MT * 64; i += GT) {
        const int ch = (int)(i & 7), h = (int)((i >> 3) & 7); const size_t row = i >> 6;
        const int nv = sel[row * 8 + h] >> 24;
        const f32x4_t lv = *(const f32x4_t*)(part_l + (row * 8 + h) * 4);
        float w[4]; w[0] = nv > 0 ? lv[0] : -1e30f; w[1] = nv > 1 ? lv[1] : -1e30f; w[2] = nv > 2 ? lv[2] : -1e30f; w[3] = lv[3];
        const float mm = fmaxf(fmaxf(w[0], w[1]), fmaxf(w[2], w[3]));
        float acc[8] = {0.f, 0.f, 0.f, 0.f, 0.f, 0.f, 0.f, 0.f}; float ws = 0.f;
#pragma unroll
        for (int s = 0; s < 4; ++s) { const bool ok = s == 3 || s < nv; const float ww = ok ? __builtin_amdgcn_exp2f(w[s] - mm) : 0.f; ws += ww;
            if (ok) { const u32x4 v = *(const u32x4*)(part_o + ((row * 8 + h) * 4 + s) * 64 + ch * 8);
                acc[0] += ww * __uint_as_float(v.x << 16); acc[1] += ww * __uint_as_float(v.x & 0xffff0000u); acc[2] += ww * __uint_as_float(v.y << 16); acc[3] += ww * __uint_as_float(v.y & 0xffff0000u);
                acc[4] += ww * __uint_as_float(v.z << 16); acc[5] += ww * __uint_as_float(v.z & 0xffff0000u); acc[6] += ww * __uint_as_float(v.w << 16); acc[7] += ww * __uint_as_float(v.w & 0xffff0000u); } }
        const float iw = 1.0f / ws;
        u32x4 o; o.x = pk(acc[0] * iw, acc[1] * iw); o.y = pk(acc[2] * iw, acc[3] * iw); o.z = pk(acc[4] * iw, acc[5] * iw); o.w = pk(acc[6] * iw, acc[7] * iw);
        *(u32x4*)(mix + row * DM + h * 64 + ch * 8) = o;
    }
}

constexpr int R_IMG = 65536;
__device__ __forceinline__ int rimg_off(int t, int c) { return (c >> 5) * 16384 + (t >> 3) * 512 + (t & 7) * 64 + (c & 31) * 2; }
__device__ __forceinline__ void ret_stage(const bf16_t* __restrict__ plane, int t0, lds_ptr img, int tid, bool kdecay, float log2g) {
#pragma unroll
    for (int i = 0; i < 8; ++i) { const int pc = tid + 512 * i, t = pc >> 4, ch = pc & 15;
        u32x4 v = *(const u32x4*)(plane + (size_t)(t0 + t) * 128 + ch * 8);
        if (kdecay) { const float f = __builtin_amdgcn_exp2f((float)(255 - t) * log2g);
            v.x = pk(__uint_as_float(v.x << 16) * f, __uint_as_float(v.x & 0xffff0000u) * f); v.y = pk(__uint_as_float(v.y << 16) * f, __uint_as_float(v.y & 0xffff0000u) * f);
            v.z = pk(__uint_as_float(v.z << 16) * f, __uint_as_float(v.z & 0xffff0000u) * f); v.w = pk(__uint_as_float(v.w << 16) * f, __uint_as_float(v.w & 0xffff0000u) * f); }
        *(LAS u32x4*)(img + rimg_off(t, ch * 8)) = v; }
}
__device__ __forceinline__ void ret_kv_task(const bf16_t* __restrict__ proj, int bh, int c, float* __restrict__ kvt, lds_ptr lds, int tid) {
    const int b = bh >> 2, h = bh & 3, lane = tid & 63, wave = __builtin_amdgcn_readfirstlane(tid >> 6), r32 = lane & 31, hi = lane >> 5;
    const float log2g = __builtin_amdgcn_logf(1.0f - __builtin_amdgcn_exp2f(-5.0f - (float)h));
    ret_stage(proj + 5 * SEC + (size_t)bh * SEQ * 128, c * 256, lds, tid, false, 0.f);
    ret_stage(proj + 4 * SEC + (size_t)bh * SEQ * 128, c * 256, lds + R_IMG, tid, true, log2g);
    __syncthreads();
    const int et = wave >> 1, dt0 = (wave & 1) * 2;
    const int lbase = hi * 512 + ((lane & 15) >> 2) * 64 + ((lane >> 4) & 1) * 32 + (lane & 3) * 8;
    const lds_cptr va = (lds_cptr)lds + et * 16384 + lbase, kb0 = (lds_cptr)lds + R_IMG + dt0 * 16384 + lbase, kb1 = kb0 + 16384;
    f32x16 a0, a1;
#pragma unroll
    for (int r = 0; r < 16; ++r) { a0[r] = 0.f; a1[r] = 0.f; }
#pragma unroll 4
    for (int ks = 0; ks < 16; ++ks) {
        const bf16x8 vf = cat8(vtr(va + ks * 1024), vtr(va + ks * 1024 + 256));
        const bf16x8 k0 = cat8(vtr(kb0 + ks * 1024), vtr(kb0 + ks * 1024 + 256)), k1 = cat8(vtr(kb1 + ks * 1024), vtr(kb1 + ks * 1024 + 256));
        a0 = __builtin_amdgcn_mfma_f32_32x32x16_bf16(vf, k0, a0, 0, 0, 0);
        a1 = __builtin_amdgcn_mfma_f32_32x32x16_bf16(vf, k1, a1, 0, 0, 0);
    }
    float* dst = kvt + ((size_t)(bh * 64 + c) * 128) * 128;
#pragma unroll
    for (int r = 0; r < 16; ++r) { const int e = et * 32 + crow(r, hi);
        dst[(size_t)e * 128 + dt0 * 32 + r32] = a0[r]; dst[(size_t)e * 128 + dt0 * 32 + 32 + r32] = a1[r]; }
    __syncthreads();
}
__device__ __forceinline__ void ret_scan(const float* __restrict__ kvt, bf16_t* __restrict__ stt, size_t gt, size_t GT) {
    for (size_t i = gt; i < (size_t)8 * 16384; i += GT) {
        const int bh = (int)(i >> 14), ed = (int)(i & 16383), h = bh & 3;
        const float g256 = __builtin_amdgcn_exp2f(256.0f * __builtin_amdgcn_logf(1.0f - __builtin_amdgcn_exp2f(-5.0f - (float)h)));
        float s = 0.f;
#pragma unroll 8
        for (int c = 0; c < 64; ++c) { const size_t o = ((size_t)(bh * 64 + c) << 14) + ed; stt[o] = f2bf(s); s = s * g256 + kvt[o]; }
    }
}
constexpr int RO_A = 0, RO_V = 65536, RO_ST = 131072;
#define RO_STAMP(i) do { if (dts && tid == 0) __hip_atomic_store(dts + (i), (unsigned long long)__builtin_amdgcn_s_memrealtime(), __ATOMIC_RELAXED, __HIP_MEMORY_SCOPE_AGENT); } while (0)
__device__ __forceinline__ void ret_out_task(const bf16_t* __restrict__ proj, const bf16_t* __restrict__ stt, const float* __restrict__ gain, bf16_t* __restrict__ mix, int bh, int c, lds_ptr lds, int tid, unsigned long long* dts = nullptr) {
    RO_STAMP(21);
    const int b = bh >> 2, h = bh & 3, lane = tid & 63, wave = __builtin_amdgcn_readfirstlane(tid >> 6), r32 = lane & 31, hi = lane >> 5;
    const float log2g = __builtin_amdgcn_logf(1.0f - __builtin_amdgcn_exp2f(-5.0f - (float)h));
    const size_t row0 = (size_t)b * SEQ + c * 256;
    u32x4 sreg[4], vreg[8], kreg[8];
    { const bf16_t* sp = stt + ((size_t)(bh * 64 + c) << 14);
#pragma unroll
      for (int i = 0; i < 4; ++i) sreg[i] = *(const u32x4*)(sp + (size_t)(tid + 512 * i) * 8); }
    const size_t hrow0 = (size_t)bh * SEQ + c * 256;
#pragma unroll
    for (int i = 0; i < 8; ++i) { const int pc = tid + 512 * i, t = pc >> 4, ch = pc & 15; const bf16_t* src = proj + (hrow0 + t) * 128 + ch * 8;
        vreg[i] = *(const u32x4*)(src + 5 * SEC); kreg[i] = *(const u32x4*)(src + 4 * SEC); }
    bf16x8 qf[8];
    { const bf16_t* qp = proj + 3 * SEC + (hrow0 + wave * 32 + r32) * 128 + hi * 8;
#pragma unroll
      for (int ks = 0; ks < 8; ++ks) qf[ks] = *(const bf16x8*)(qp + ks * 16); }
#pragma unroll
    for (int i = 0; i < 4; ++i) { const int pc = tid + 512 * i, e = pc >> 4, ch = pc & 15; *(LAS u32x4*)(lds + RO_A + ch * 2048 + e * 16) = sreg[i]; }
#pragma unroll
    for (int i = 0; i < 8; ++i) { const int pc = tid + 512 * i, t = pc >> 4, ch = pc & 15; *(LAS u32x4*)(lds + RO_V + rimg_off(t, ch * 8)) = vreg[i]; }
    __syncthreads();
    RO_STAMP(22);
    f32x16 o[4];
#pragma unroll
    for (int et = 0; et < 4; ++et)
#pragma unroll
        for (int r = 0; r < 16; ++r) o[et][r] = 0.f;
    { const lds_cptr sb = (lds_cptr)lds + RO_A + hi * 2048 + r32 * 16;
#pragma unroll
      for (int et = 0; et < 4; ++et)
#pragma unroll
          for (int ks = 0; ks < 8; ++ks) o[et] = __builtin_amdgcn_mfma_f32_32x32x16_bf16(qf[ks], *(const LAS bf16x8*)(sb + ks * 4096 + et * 512), o[et], 0, 0, 0); }
#pragma unroll
    for (int r = 0; r < 16; ++r) { const float f = __builtin_amdgcn_exp2f((float)(wave * 32 + crow(r, hi) + 1) * log2g);
#pragma unroll
        for (int et = 0; et < 4; ++et) o[et][r] *= f; }
    RO_STAMP(23);
    __syncthreads();
#pragma unroll
    for (int i = 0; i < 8; ++i) { const int pc = tid + 512 * i, t = pc >> 4, ch = pc & 15; *(LAS u32x4*)(lds + RO_A + ch * 4096 + t * 16) = kreg[i]; }
    __syncthreads();
    u32x4 rgv[8];
#pragma unroll
    for (int g = 0; g < 4; ++g)
#pragma unroll
        for (int k = 0; k < 2; ++k) { const int pidx = lane + 64 * k; rgv[2 * g + k] = *(const u32x4*)(proj + 6 * SEC + (hrow0 + wave * 32 + 8 * g + (pidx >> 4)) * 128 + (pidx & 15) * 8); }
    const lds_cptr vp = (lds_cptr)lds + RO_V + ((lane >> 4) & 1) * 32 + (lane & 3) * 8 + (4 * hi + ((lane & 15) >> 2)) * 64;
    const lds_cptr kpb = (lds_cptr)lds + RO_A + hi * 4096 + r32 * 16;
    for (int kvt = 0; kvt <= wave; ++kvt) {
        f32x16 p;
#pragma unroll
        for (int r = 0; r < 16; ++r) p[r] = 0.f;
#pragma unroll
        for (int ks = 0; ks < 8; ++ks) p = __builtin_amdgcn_mfma_f32_32x32x16_bf16(*(const LAS bf16x8*)(kpb + ks * 8192 + kvt * 512), qf[ks], p, 0, 0, 0);
        const int dbase = 32 * (wave - kvt) + r32 - 4 * hi;
#pragma unroll
        for (int r = 0; r < 16; ++r) { const int dist = dbase - ((r & 3) + 8 * (r >> 2)); p[r] = dist >= 0 ? p[r] * __builtin_amdgcn_exp2f((float)dist * log2g) : 0.f; }
        const u32x4 pw0 = {pk(p[0], p[1]), pk(p[2], p[3]), pk(p[4], p[5]), pk(p[6], p[7])}, pw1 = {pk(p[8], p[9]), pk(p[10], p[11]), pk(p[12], p[13]), pk(p[14], p[15])};
        const lds_cptr vt = vp + kvt * 2048;
#pragma unroll
        for (int et = 0; et < 4; ++et) {
            o[et] = __builtin_amdgcn_mfma_f32_32x32x16_bf16(__builtin_bit_cast(bf16x8, pw0), cat8(vtr(vt + et * 16384), vtr(vt + et * 16384 + 512)), o[et], 0, 0, 0);
            o[et] = __builtin_amdgcn_mfma_f32_32x32x16_bf16(__builtin_bit_cast(bf16x8, pw1), cat8(vtr(vt + et * 16384 + 1024), vtr(vt + et * 16384 + 1536)), o[et], 0, 0, 0);
        }
    }
    RO_STAMP(24);
    float mu[16], rstd[16];
#pragma unroll
    for (int r = 0; r < 16; ++r) {
        float s = (o[0][r] + o[1][r]) + (o[2][r] + o[3][r]);
        s += __shfl_xor(s, 1); s += __shfl_xor(s, 2); s += __shfl_xor(s, 4); s += __shfl_xor(s, 8); s += __shfl_xor(s, 16);
        mu[r] = s * (1.0f / 128.0f);
        const float d0 = o[0][r] - mu[r], d1 = o[1][r] - mu[r], d2 = o[2][r] - mu[r], d3 = o[3][r] - mu[r];
        float q = (d0 * d0 + d1 * d1) + (d2 * d2 + d3 * d3);
        q += __shfl_xor(q, 1); q += __shfl_xor(q, 2); q += __shfl_xor(q, 4); q += __shfl_xor(q, 8); q += __shfl_xor(q, 16);
        rstd[r] = rsqrtf(q * (1.0f / 128.0f) + GN_EPS);
    }
    float gn[4];
#pragma unroll
    for (int et = 0; et < 4; ++et) gn[et] = gain[h * 128 + et * 32 + r32];
    LAS bf16_t* st = (LAS bf16_t*)(lds + RO_ST) + wave * 1024;
#pragma unroll
    for (int g = 0; g < 4; ++g) {
#pragma unroll
        for (int rr = 0; rr < 4; ++rr) { const int r = 4 * g + rr;
#pragma unroll
            for (int et = 0; et < 4; ++et) st[(rr + 4 * hi) * 128 + et * 32 + r32] = f2bf((o[et][r] - mu[r]) * rstd[r] * gn[et]); }
#pragma unroll
        for (int k = 0; k < 2; ++k) { const int pidx = lane + 64 * k, r8 = pidx >> 4, ch = pidx & 15; const size_t row = row0 + wave * 32 + 8 * g + r8;
            const u32x4 nv = *(const LAS u32x4*)(st + r8 * 128 + ch * 8); const u32x4 gv = rgv[2 * g + k];
            const unsigned nw[4] = {nv.x, nv.y, nv.z, nv.w}, gw_[4] = {gv.x, gv.y, gv.z, gv.w}; unsigned ow[4];
#pragma unroll
            for (int q = 0; q < 4; ++q) { const float g0 = __uint_as_float(gw_[q] << 16), g1 = __uint_as_float(gw_[q] & 0xffff0000u);
                ow[q] = pk(__uint_as_float(nw[q] << 16) * (g0 * __builtin_amdgcn_rcpf(1.0f + __builtin_amdgcn_exp2f(-LOG2E * g0))), __uint_as_float(nw[q] & 0xffff0000u) * (g1 * __builtin_amdgcn_rcpf(1.0f + __builtin_amdgcn_exp2f(-LOG2E * g1)))); }
            *(u32x4*)(mix + row * DM + 512 + h * 128 + ch * 8) = (u32x4){ow[0], ow[1], ow[2], ow[3]}; }
    }
    RO_STAMP(25);
    __syncthreads();
    RO_STAMP(26);
}
#undef RO_STAMP
}
#ifndef DIAG_TASKQ
#define DIAG_TASKQ 0
#endif
#ifndef DIAG_K
#define DIAG_K -1
#endif
#ifndef DIAG_BLOCK
#define DIAG_BLOCK 100
#endif
#ifndef DIAG_SCALE
#define DIAG_SCALE 1.0f
#endif
#ifndef DIAG_A
#define DIAG_A 45
#endif
#ifndef DIAG_B
#define DIAG_B 6
#endif
#ifndef P4_DIAG_FIRST
#define P4_DIAG_FIRST(v) (true)
#endif
#ifndef REP_MASK
#define REP_MASK 0
#endif
#ifndef REP_SUB
#define REP_SUB 7
#endif
#include <hip/hip_cooperative_groups.h>
namespace cg = cooperative_groups;
constexpr int NWAVES = 8, NTHREADS = 512;
constexpr int LDS_BYTES = 147456 + 256;
constexpr int NPH = 10;
constexpr size_t WS_STASH = 180 * MiB;
constexpr size_t STASH_ELEMS = (size_t)512 * 2 * FF;

struct Args { const float* in[16]; float* out; unsigned char* ws; int ph_lo, ph_hi, flags, pad; };

__device__ __forceinline__ void p0_transpose_item(const float* __restrict__ W, int K, int N, const float* __restrict__ gk, bf16_t* __restrict__ WT, int k0, int n0, int orow0, LAS float* scr, int lane) {
    { float4 v[8];
#pragma unroll
      for (int i = 0; i < 8; ++i) v[i] = *(const float4*)(W + (size_t)(k0 + 8 * i + (lane >> 3)) * N + n0 + (lane & 7) * 4);
#pragma unroll
      for (int i = 0; i < 8; ++i) { const int kk = 8 * i + (lane >> 3); const float g = gk ? gk[k0 + kk] : 1.0f; LAS float* d = scr + kk * 33 + (lane & 7) * 4;
          d[0] = v[i].x * g; d[1] = v[i].y * g; d[2] = v[i].z * g; d[3] = v[i].w * g; } }
    asm volatile("s_waitcnt lgkmcnt(0)" ::: "memory");
    const int c = lane & 7;
#pragma unroll
    for (int j = 0; j < 4; ++j) { const int n = (lane >> 3) + 8 * j; const LAS float* s = scr + (8 * c) * 33 + n;
        uint4 o; o.x = (u32)f2bf(s[0 * 33]) | ((u32)f2bf(s[1 * 33]) << 16); o.y = (u32)f2bf(s[2 * 33]) | ((u32)f2bf(s[3 * 33]) << 16);
        o.z = (u32)f2bf(s[4 * 33]) | ((u32)f2bf(s[5 * 33]) << 16); o.w = (u32)f2bf(s[6 * 33]) | ((u32)f2bf(s[7 * 33]) << 16);
        *(uint4*)(WT + (size_t)(orow0 + n) * K + k0 + 8 * c) = o; }
    asm volatile("s_waitcnt lgkmcnt(0)" ::: "memory");
}

#define XB_TMO      128
#define XB_XCNT(j)  (256  + 64 * (j))
#define XB_XSUB(j)  (1280 + 64 * (j))
#define XB_XGEN(j)  (2304 + 64 * (j))
#define XB_TOP      3328
#define XB_TOPGEN   3392
#define XCD_BAR_WORDS 3456
#define XB_SPIN_CAP (1u << 18)

__device__ __forceinline__ unsigned xb_ld(unsigned* p)              { return __hip_atomic_load(p, __ATOMIC_RELAXED, __HIP_MEMORY_SCOPE_AGENT); }
__device__ __forceinline__ unsigned xb_add(unsigned* p, unsigned v) { return __hip_atomic_fetch_add(p, v, __ATOMIC_RELAXED, __HIP_MEMORY_SCOPE_AGENT); }
__device__ __forceinline__ unsigned xb_xcc_id() { return (unsigned)__builtin_amdgcn_s_getreg((3 << 11) | 20) & 0xFu; }
#define XB_SPIN(cond, bar) do { unsigned _sp = 0; while (cond) { __builtin_amdgcn_s_sleep(1); \
    if ((++_sp & 255u) == 0u) { if (xb_ld(&(bar)[XB_TMO])) break; if (_sp > XB_SPIN_CAP) { atomicAdd(&(bar)[XB_TMO], 1u); break; } } } } while (0)

struct XcdBarrier {
    unsigned* bar; unsigned x;
    volatile LAS unsigned* st;
};

__device__ __forceinline__ XcdBarrier xcd_barrier_post(unsigned* bar, volatile LAS unsigned* st) {
    XcdBarrier b; b.bar = bar; b.x = xb_xcc_id(); b.st = st;
    if (threadIdx.x == 0) (void)xb_add(&bar[XB_XCNT(b.x)], 1u);
    return b;
}
__device__ __forceinline__ void xcd_barrier_complete(unsigned* bar, unsigned x, unsigned& nloc, unsigned& nx) {
    const unsigned G = gridDim.x * gridDim.y * gridDim.z;
    unsigned sum, cnt, mine, sp = 0u;
    for (;;) {
        sum = 0u; cnt = 0u; mine = 0u;
#pragma unroll
        for (unsigned j = 0; j < 16; ++j) { const unsigned c = xb_ld(&bar[XB_XCNT(j)]); sum += c; cnt += (c > 0u) ? 1u : 0u; mine = (j == x) ? c : mine; }
        if (sum == G) break;
        __builtin_amdgcn_s_sleep(1);
        if ((++sp & 255u) == 0u) { if (xb_ld(&bar[XB_TMO])) break; if (sp > XB_SPIN_CAP) { atomicAdd(&bar[XB_TMO], 1u); break; } }
    }
    nloc = mine > 0u ? mine : 1u; nx = cnt > 0u ? cnt : 1u;
}

__device__ __forceinline__ void xcd_barrier(const XcdBarrier& b, const int tid_) {
    asm volatile("s_waitcnt vmcnt(0)" ::: "memory");
    __syncthreads();
    if (tid_ == 0) {
        unsigned* bar = b.bar;
        __builtin_amdgcn_s_waitcnt(0);
        unsigned nloc = b.st[0], nx = b.st[1];
        if (nloc == 0u) { xcd_barrier_complete(bar, b.x, nloc, nx); b.st[0] = nloc; b.st[1] = nx; }
        const unsigned old = xb_add(&bar[XB_XSUB(b.x)], 1u);
        const unsigned gen = old / nloc;
        if (old + 1u == (gen + 1u) * nloc) {
            __builtin_amdgcn_fence(__ATOMIC_RELEASE, "agent");
            asm volatile("s_waitcnt vmcnt(0)" ::: "memory");
            const unsigned og = xb_add(&bar[XB_TOP], 1u);
            const unsigned tg = og / nx;
            if (og + 1u == (tg + 1u) * nx) xb_add(&bar[XB_TOPGEN], 1u);
            else XB_SPIN(xb_ld(&bar[XB_TOPGEN]) == tg, bar);
            __builtin_amdgcn_fence(__ATOMIC_ACQUIRE, "agent");
            xb_add(&bar[XB_XGEN(b.x)], 1u);
            asm volatile("s_waitcnt vmcnt(0)" ::: "memory");
        } else {
            XB_SPIN(xb_ld(&bar[XB_XGEN(b.x)]) == gen, bar);
            __builtin_amdgcn_fence(__ATOMIC_ACQUIRE, "agent");
            asm volatile("s_waitcnt vmcnt(0)" ::: "memory");
        }
    }
    __syncthreads();
}

constexpr int CW_BAR = 4096;
constexpr int LDS_BARST = 147456;
constexpr size_t CTL_ZERO_BYTES = 65536;
constexpr int CW_WPGMAX = 100;
constexpr int CW_PANEL = 8192;

#if (REP_MASK >> 2) & 1
#define SUBON2(bit) (rep == 0 || ((REP_SUB >> (bit)) & 1))
#else
#define SUBON2(bit) true
#endif
#if (REP_MASK >> 3) & 1
#define SUBON3(bit) (rep == 0 || ((REP_SUB >> (bit)) & 1))
#else
#define SUBON3(bit) true
#endif
#if (REP_MASK >> 4) & 1
#define SUBON4(bit) (rep == 0 || ((REP_SUB >> (bit)) & 1))
#else
#define SUBON4(bit) true
#endif
__global__ void __launch_bounds__(NTHREADS, 2) mega(Args a) {
    extern __shared__ __attribute__((aligned(16))) unsigned char lds[];
    cg::grid_group grid = cg::this_grid();
    const int wave = __builtin_amdgcn_readfirstlane(threadIdx.x >> 6);
#define MKLANE() ({ int l_; asm volatile("v_mbcnt_lo_u32_b32 %0, -1, 0\n\tv_mbcnt_hi_u32_b32 %0, -1, %0" : "=v"(l_)); l_; })
#define MKTID() (wave * 64 + MKLANE())
#define tid MKTID()
#define lane MKLANE()
    const int G = gridDim.x, bx = blockIdx.x;
    const int vcu = (G % 8 == 0) ? (bx % 8) * (G / 8) + bx / 8 : bx;
    const int gw = vcu * NWAVES + wave, NGW = G * NWAVES;
    unsigned char* ws = a.ws;
    const float* x = a.in[0]; const float* p = a.in[1]; const float* attn_norm = a.in[2]; const float* w_in = a.in[3]; const float* ret_norm = a.in[4]; const float* w_out = a.in[5];
    const float* ffn_norm = a.in[6]; const float* w_up = a.in[7]; const float* w_gate = a.in[8]; const float* conv_w = a.in[9]; const float* conv_b = a.in[10]; const float* w_down = a.in[11];
    const float* ple_norm = a.in[12]; const float* w_ple = a.in[13]; const float* w_ple_gate = a.in[14]; const float* final_norm = a.in[15];
    float* out = a.out;
    bf16_t* Win_t = (bf16_t*)(ws + WS_WIN); bf16_t* Wout_t = (bf16_t*)(ws + WS_WOUT); bf16_t* Wug_t = (bf16_t*)(ws + WS_WUG); bf16_t* Wdown_t = (bf16_t*)(ws + WS_WDOWN);
    bf16_t* Wpg_t = (bf16_t*)(ws + WS_WPG); bf16_t* Wple_t = (bf16_t*)(ws + WS_WPLE);
    bf16_t* XN = (bf16_t*)(ws + WS_R1); bf16_t* MIX = (bf16_t*)(ws + WS_SEG); bf16_t* PW = (bf16_t*)(ws + WS_R1);
    float* RS0 = (float*)(ws + WS_CNT + 768 * 1024);
    unsigned* KMX = (unsigned*)(ws + WS_CNT + 896 * 1024);
    bf16_t* XB = (bf16_t*)(ws + WS_R2);
    signed char* XN8 = (signed char*)(ws + WS_XN8); signed char* Win8 = (signed char*)(ws + WS_WIN8); float* WSCIN = (float*)(ws + WS_WSC) + 8192; float* XSC = (float*)(ws + WS_WSC + 65536);
    signed char* X8 = (signed char*)(ws + WS_X8); signed char* Wug8 = (signed char*)(ws + WS_WUG8); signed char* Wpg8 = (signed char*)(ws + WS_WPG8); float* WSC = (float*)(ws + WS_WSC);
    bf16_t* PROJ = (bf16_t*)(ws + WS_PROJ); bf16_t* ACT = (bf16_t*)(ws + WS_PROJ);
    bf16_t* PB = (bf16_t*)(ws + WS_PB); float* RSQ = (float*)(ws + WS_RSQ);
    float* KM = (float*)(ws + WS_KMEAN);
    float* UL = (float*)(ws + WS_STASH); float* UF = UL + STASH_ELEMS; float* GF = UF + STASH_ELEMS;
    float* KVT = (float*)(ws + WS_KVT); bf16_t* STT = (bf16_t*)(ws + WS_STT); float* PART_L = (float*)(ws + WS_PARTL); bf16_t* PART_O = (bf16_t*)out;
    u32* SEL = (u32*)(ws + WS_SEL); unsigned short* SEG = (unsigned short*)(ws + WS_SEG); int* CNT = (int*)(ws + WS_CNT);

    const int lo = a.ph_lo, hi = a.ph_hi;
#if DIAG_K >= 0
    unsigned long long* dts = (unsigned long long*)(ws + WS_CTL + 49152);
#define DIAG_STAMP(i) do { if (bx == DIAG_BLOCK && wave == 0 && MKLANE() == 0) { __hip_atomic_store(dts + (i), (unsigned long long)__builtin_amdgcn_s_memrealtime(), __ATOMIC_RELAXED, __HIP_MEMORY_SCOPE_AGENT); \
    __hip_atomic_store(dts + 64 + (i), (unsigned long long)__builtin_amdgcn_s_memtime(), __ATOMIC_RELAXED, __HIP_MEMORY_SCOPE_AGENT); } } while (0)
    DIAG_STAMP(0);
#define DIAG_STAMP_MAX(i) do { if (wave == 0 && MKLANE() == 0) atomicMax(dts + (i), (unsigned long long)__builtin_amdgcn_s_memrealtime()); } while (0)
#define DIAG_DTS(it) ((bx == DIAG_BLOCK && (it) == bx) ? dts : (unsigned long long*)nullptr)
#else
#define DIAG_STAMP(i) do { } while (0)
#define DIAG_STAMP_MAX(i) do { } while (0)
#define DIAG_DTS(it) ((unsigned long long*)nullptr)
#endif
#define IN(k) (lo <= (k) && (k) < hi)
    if (a.ph_lo < 0) grid.sync();
#define SEAM(k) do { if (IN(k) && IN((k) + 1)) { DIAG_STAMP(40 + (k)); DIAG_STAMP_MAX(50 + (k)); xcd_barrier(xbar, MKTID()); DIAG_STAMP(1 + (k)); } } while (0)
    { volatile LAS unsigned* st = (volatile LAS unsigned*)((LAS unsigned char*)lds + LDS_BARST); if (tid < 2) st[tid] = 0u; }
    __syncthreads();
    XcdBarrier xbar = xcd_barrier_post((unsigned*)(ws + WS_CTL) + CW_BAR, (volatile LAS unsigned*)((LAS unsigned char*)lds + LDS_BARST));

#if (REP_MASK >> 0) & 1
    for (int rep = 0; rep < 2; ++rep)
#endif
    if (IN(0)) {
        LAS float* scr = (LAS float*)(lds) + wave * (64 * 33);
        constexpr int I_IN = 16 * (NPROJ / 32), I_OUT = 16 * (DM / 32), I_UP = 16 * (FF / 32), I_DOWN = (FF / 64) * (DM / 32), I_PG = 16 * (DM / 32), I_PLE = (PLED / 64) * (DM / 32);
        for (int it = gw; it < I_IN + 2 * I_UP + I_PG; it += NGW) {
            int r = it;
            if (r < I_IN) { const int nb = r % (NPROJ / 32), kb = r / (NPROJ / 32); p0_transpose_item(w_in, DM, NPROJ, nullptr, Win_t, kb * 64, nb * 32, pg8::img_sec((nb * 32) >> 9) * 512 + ((nb * 32) & 511), scr, lane); continue; } r -= I_IN;
            if (r < I_UP) { const int nb = r % (FF / 32), kb = r / (FF / 32), n0 = nb * 32; p0_transpose_item(w_up, DM, FF, ffn_norm, Wug_t, kb * 64, n0, (n0 >> 7) * 256 + (n0 & 127), scr, lane); continue; } r -= I_UP;
            if (r < I_UP) { const int nb = r % (FF / 32), kb = r / (FF / 32), n0 = nb * 32; p0_transpose_item(w_gate, DM, FF, ffn_norm, Wug_t, kb * 64, n0, (n0 >> 7) * 256 + 128 + (n0 & 127), scr, lane); continue; } r -= I_UP;
            { const int nb = r % (DM / 32), kb = r / (DM / 32); p0_transpose_item(w_ple_gate, DM, DM, ple_norm, Wpg_t, kb * 64, nb * 32, nb * 32, scr, lane); }
        }
        xcd_barrier(xbar, MKTID());
        for (int r0_ = gw; r0_ < (NPROJ - N_I8) + 2 * FF + DM; r0_ += NGW) {
            int r = r0_; const bf16_t* src; signed char* dst; float* scp; bool amax_only = false;
            if (r < NPROJ - N_I8) { src = Win_t + (size_t)(N_I8 + r) * DM; dst = Win8 + (size_t)(N_I8 + r) * DM; scp = WSCIN + N_I8 + r; }
            else { r -= NPROJ - N_I8;
                if (r < 2 * FF) { src = Wug_t + (size_t)r * DM; dst = Wug8 + (size_t)r * DM; scp = WSC + r; }
                else { src = Wpg_t + (size_t)(r - 2 * FF) * DM; dst = nullptr; scp = nullptr; amax_only = true; } }
            const int l_ = lane;
            const pg8::u32x4 v0 = *(const pg8::u32x4*)(src + l_ * 16), v1 = *(const pg8::u32x4*)(src + l_ * 16 + 8);
            const pg8::f32x4 f0 = {__uint_as_float(v0.x << 16), __uint_as_float(v0.x & 0xffff0000u), __uint_as_float(v0.y << 16), __uint_as_float(v0.y & 0xffff0000u)};
            const pg8::f32x4 f1 = {__uint_as_float(v0.z << 16), __uint_as_float(v0.z & 0xffff0000u), __uint_as_float(v0.w << 16), __uint_as_float(v0.w & 0xffff0000u)};
            const pg8::f32x4 f2 = {__uint_as_float(v1.x << 16), __uint_as_float(v1.x & 0xffff0000u), __uint_as_float(v1.y << 16), __uint_as_float(v1.y & 0xffff0000u)};
            const pg8::f32x4 f3 = {__uint_as_float(v1.z << 16), __uint_as_float(v1.z & 0xffff0000u), __uint_as_float(v1.w << 16), __uint_as_float(v1.w & 0xffff0000u)};
            float am = 0.f;
#pragma unroll
            for (int j = 0; j < 4; ++j) am = fmaxf(fmaxf(am, fmaxf(fabsf(f0[j]), fabsf(f1[j]))), fmaxf(fabsf(f2[j]), fabsf(f3[j])));
#pragma unroll
            for (int o = 1; o < 64; o <<= 1) am = fmaxf(am, __shfl_xor(am, o));
            if (amax_only) { if (l_ == 0) atomicMax((unsigned*)(ws + WS_CTL) + CW_WPGMAX, __float_as_uint(am)); continue; }
            const float qs = am > 0.f ? 127.0f / am : 0.f;
            *(pg8::u32x4*)(dst + l_ * 16) = (pg8::u32x4){pg8::q8x4(f0, qs), pg8::q8x4(f1, qs), pg8::q8x4(f2, qs), pg8::q8x4(f3, qs)};
            if (l_ == 0) *scp = am * (1.0f / 127.0f);
        }
        for (int it = gw; it < I_OUT + I_DOWN + I_PLE; it += NGW) {
            int r = it;
            if (r < I_OUT) { const int nb = r % (DM / 32), kb = r / (DM / 32); p0_transpose_item(w_out, DM, DM, nullptr, Wout_t, kb * 64, nb * 32, nb * 32, scr, lane); continue; } r -= I_OUT;
            if (r < I_DOWN) { const int nb = r % (DM / 32), kb = r / (DM / 32); p0_transpose_item(w_down, FF, DM, nullptr, Wdown_t, kb * 64, nb * 32, nb * 32, scr, lane); continue; } r -= I_DOWN;
            { const int nb = r % (DM / 32), kb = r / (DM / 32); p0_transpose_item(w_ple, PLED, DM, nullptr, Wple_t, kb * 64, nb * 32, nb * 32, scr, lane); }
        }
        DIAG_STAMP(12);
        for (int m = gw; m < MT; m += 2 * NGW) {
            const int m2 = m + NGW;
            const float4* xr = (const float4*)(x + (size_t)m * DM); const float4* xr2 = (const float4*)(x + (size_t)m2 * DM); float4 v[4], w[4]; float s = 0.f, s2 = 0.f;
#pragma unroll
            for (int j = 0; j < 4; ++j) { v[j] = xr[lane + 64 * j]; w[j] = xr2[lane + 64 * j]; }
#pragma unroll
            for (int j = 0; j < 4; ++j) { s += v[j].x * v[j].x + v[j].y * v[j].y + v[j].z * v[j].z + v[j].w * v[j].w; s2 += w[j].x * w[j].x + w[j].y * w[j].y + w[j].z * w[j].z + w[j].w * w[j].w; }
            const float rs = rsqrtf(wave_sum(s) * (1.0f / DM) + RMS_EPS), rs2 = rsqrtf(wave_sum(s2) * (1.0f / DM) + RMS_EPS);
            if (lane == 0) { RS0[m] = rs; RS0[m2] = rs2; }
            float am = 0.f, am2 = 0.f;
#pragma unroll
            for (int j = 0; j < 4; ++j) { const float4 gg = ((const float4*)attn_norm)[lane + 64 * j];
                v[j].x *= rs * gg.x; v[j].y *= rs * gg.y; v[j].z *= rs * gg.z; v[j].w *= rs * gg.w; w[j].x *= rs2 * gg.x; w[j].y *= rs2 * gg.y; w[j].z *= rs2 * gg.z; w[j].w *= rs2 * gg.w;
                am = fmaxf(fmaxf(am, fmaxf(fabsf(v[j].x), fabsf(v[j].y))), fmaxf(fabsf(v[j].z), fabsf(v[j].w))); am2 = fmaxf(fmaxf(am2, fmaxf(fabsf(w[j].x), fabsf(w[j].y))), fmaxf(fabsf(w[j].z), fabsf(w[j].w)));
                ushort4 o; o.x = f2bf(v[j].x); o.y = f2bf(v[j].y); o.z = f2bf(v[j].z); o.w = f2bf(v[j].w);
                ((ushort4*)(XN + (size_t)m * DM))[lane + 64 * j] = o;
                ushort4 o2; o2.x = f2bf(w[j].x); o2.y = f2bf(w[j].y); o2.z = f2bf(w[j].z); o2.w = f2bf(w[j].w);
                ((ushort4*)(XN + (size_t)m2 * DM))[lane + 64 * j] = o2; }
#pragma unroll
            for (int o = 1; o < 64; o <<= 1) { am = fmaxf(am, __shfl_xor(am, o)); am2 = fmaxf(am2, __shfl_xor(am2, o)); }
            const float qa = am > 0.f ? 127.0f / am : 0.f, qa2 = am2 > 0.f ? 127.0f / am2 : 0.f;
            if (lane == 0) { XSC[m] = am * (1.0f / 127.0f); XSC[m2] = am2 * (1.0f / 127.0f); }
#pragma unroll
            for (int j = 0; j < 4; ++j) { ((unsigned*)(XN8 + (size_t)m * DM))[lane + 64 * j] = pg8::q8x4((pg8::f32x4){v[j].x, v[j].y, v[j].z, v[j].w}, qa);
                ((unsigned*)(XN8 + (size_t)m2 * DM))[lane + 64 * j] = pg8::q8x4((pg8::f32x4){w[j].x, w[j].y, w[j].z, w[j].w}, qa2); }
        }
        DIAG_STAMP(13);
        { const size_t n4 = (size_t)MT * PLED / 4; const size_t gt = (size_t)vcu * NTHREADS + tid, GT = (size_t)G * NTHREADS;
          for (size_t i = gt; i < n4; i += GT) { const float4 v = ((const float4*)p)[i]; ushort4 o; o.x = f2bf(v.x); o.y = f2bf(v.y); o.z = f2bf(v.z); o.w = f2bf(v.w); ((ushort4*)PB)[i] = o; }
          for (size_t i = gt; i < 16 * 64 * 64; i += GT) KM[i] = 0.f;
          if (gt < 16 * 64 * 2) KMX[gt] = 0u;
          if (gt < 64) ((int*)(ws + WS_CTL))[gt] = 0;
          for (size_t i = gt; i < 16 * 64 * 64; i += GT) CNT[i] = 0; }
    }
    SEAM(0);
#if (REP_MASK >> 1) & 1
    if (IN(1)) {
        pg8::Gemm g{XN, Win_t, MT, NPROJ, DM}; pg8::StaticOrder S; S.init(MT, NPROJ, G, bx);
        pg8::EpiProj E{PROJ, KM, KMX};
        pg8::gemm_phase<pg8::EpiProj, pg8::StaticOrder, true, true>((PG8_LAS unsigned char*)lds, g, S, E, MKTID());
    }
    asm volatile("" ::: "memory");
#endif
    if (IN(1)) {
        { pg8::Gemm g{XN, Win_t, MT, N_I8, DM}; pg8::StaticOrder S; S.init(MT, N_I8, G, bx);
          pg8::EpiProj E{PROJ, KM, KMX};
          pg8::gemm_phase<pg8::EpiProj, pg8::StaticOrder, true, true>((PG8_LAS unsigned char*)lds, g, S, E, MKTID()); }
        { int kk = DM / 2; const bf16_t* a_ = (const bf16_t*)XN8; const bf16_t* b_ = (const bf16_t*)(Win8 + (size_t)N_I8 * DM); asm volatile("" : "+s"(kk), "+s"(a_), "+s"(b_) :: "memory");
          pg8::Gemm g{a_, b_, MT, NPROJ - N_I8, kk}; pg8::StaticOrder S; S.init(MT, NPROJ - N_I8, G, bx);
          pg8::EpiProj8 E{PROJ, XSC, WSCIN};
          pg8::gemm_phase<pg8::EpiProj8, pg8::StaticOrder, true, true, true>((PG8_LAS unsigned char*)lds, g, S, E, MKTID()); }
    }
    SEAM(1);
#if (REP_MASK >> 2) & 1
    { const int rep = 1; (void)rep;
    if (IN(2)) {
        mx::lds_ptr L = (mx::lds_ptr)lds;
        if (!(a.flags & 1) && SUBON2(0)) for (int it = bx; it < 512; it += G) mx::ret_kv_task(PROJ, it >> 6, it & 63, KVT, L, tid);
        if (!(a.flags & 2)) {
            if (SUBON2(1)) for (int it = bx; it < 16 * 63; it += G) mx::gate_task_mfma(it / 63, 1 + it % 63, PROJ, KM, SEL, SEG, CNT, KMX, PART_L, L, tid);
            { const int gtid = vcu * NTHREADS + tid; if (gtid < BATCH * 256 * 8) { const int h = gtid & 7, t = (gtid >> 3) & 255, b = gtid >> 11; SEL[((size_t)b * SEQ + t) * 8 + h] = 0u; } }
        }
    }
    }
    asm volatile("" ::: "memory");
#endif
    { const int rep = 0; (void)rep;
    if (IN(2)) {
        mx::lds_ptr L = (mx::lds_ptr)lds;
        if (!(a.flags & 1) && SUBON2(0)) for (int it = bx; it < 512; it += G) mx::ret_kv_task(PROJ, it >> 6, it & 63, KVT, L, tid);
        DIAG_STAMP(14);
        if (!(a.flags & 2)) {
            if (SUBON2(1)) for (int it = bx; it < 16 * 32; it += G) { const int i0_ = 1 + 2 * (it & 31); mx::gate_task_mfma(it >> 5, i0_, PROJ, KM, SEL, SEG, CNT, KMX, PART_L, L, tid, i0_ < 63 ? 2 : 1); }
        DIAG_STAMP(15);
            { const int gtid = vcu * NTHREADS + tid; if (gtid < BATCH * 256 * 8) { const int h = gtid & 7, t = (gtid >> 3) & 255, b = gtid >> 11; SEL[((size_t)b * SEQ + t) * 8 + h] = 0u; } }
        }
    }
    }
    SEAM(2);
#if (REP_MASK >> 3) & 1
#define QREP rep
#else
#define QREP 0
#endif
#if (REP_MASK >> 3) & 1
    for (int rep = 0; rep < 2; ++rep)
#endif
    if (IN(3)) {
        mx::lds_ptr L = (mx::lds_ptr)lds;
        {
            const float am = __uint_as_float(__hip_atomic_load((unsigned*)(ws + WS_CTL) + CW_WPGMAX, __ATOMIC_RELAXED, __HIP_MEMORY_SCOPE_AGENT)), qs = am > 0.f ? 127.0f / am : 0.f;
            for (int r = gw; r < DM; r += NGW) { const int l_ = lane; const bf16_t* src = Wpg_t + (size_t)r * DM;
                const pg8::u32x4 v0 = *(const pg8::u32x4*)(src + l_ * 16), v1 = *(const pg8::u32x4*)(src + l_ * 16 + 8);
                const pg8::f32x4 f0 = {__uint_as_float(v0.x << 16), __uint_as_float(v0.x & 0xffff0000u), __uint_as_float(v0.y << 16), __uint_as_float(v0.y & 0xffff0000u)};
                const pg8::f32x4 f1 = {__uint_as_float(v0.z << 16), __uint_as_float(v0.z & 0xffff0000u), __uint_as_float(v0.w << 16), __uint_as_float(v0.w & 0xffff0000u)};
                const pg8::f32x4 f2 = {__uint_as_float(v1.x << 16), __uint_as_float(v1.x & 0xffff0000u), __uint_as_float(v1.y << 16), __uint_as_float(v1.y & 0xffff0000u)};
                const pg8::f32x4 f3 = {__uint_as_float(v1.z << 16), __uint_as_float(v1.z & 0xffff0000u), __uint_as_float(v1.w << 16), __uint_as_float(v1.w & 0xffff0000u)};
                *(pg8::u32x4*)(Wpg8 + (size_t)r * DM + l_ * 16) = (pg8::u32x4){pg8::q8x4(f0, qs), pg8::q8x4(f1, qs), pg8::q8x4(f2, qs), pg8::q8x4(f3, qs)}; } }
        const int nbig = G > 128 ? 96 : 0; const bool big = vcu < nbig;
        const int nscan = G > 128 ? G / 2 : G - nbig;
        if (!(a.flags & 1) && SUBON3(0) && vcu >= G - nscan) mx::ret_scan(KVT, STT, (size_t)(vcu - (G - nscan)) * NTHREADS + tid, (size_t)nscan * NTHREADS);
        DIAG_STAMP(18); DIAG_STAMP_MAX(61);
        if (!(a.flags & 2) && SUBON3(1)) {
            LAS int* qslot = (LAS int*)(L + mx::L_PREF + 384);
            for (bool first = big;; first = false) {
                if (!first && tid == 0) *qslot = nbig + atomicAdd((int*)(ws + WS_CTL) + QREP, 1);
                __syncthreads();
                const int q = first ? vcu : *qslot;
                __syncthreads();
                if (q >= 16 * 63 + 32) break;
#ifdef DIAG_TASK
                const unsigned long long tt0 = __builtin_amdgcn_s_memrealtime();
#endif
                { int tbh_ = q & 15, tn_, tp_ = 0, tnp_ = 1;
                  if (q < 64) { tn_ = (q >> 4) & 1; tp_ = q >> 5; tnp_ = 2; } else if (q < 96) tn_ = 2 + ((q - 64) >> 4); else tn_ = (q - 32) >> 4;
                  mx::moba_sel_task(PROJ, SEG, CNT, tbh_, tn_, PART_O, PART_L, L, tid, tp_, tnp_); }
#ifdef DIAG_TASK
                { const unsigned long long tt1 = __builtin_amdgcn_s_memrealtime();
#if DIAG_TASK <= 2
                  if (wave == 0 && MKLANE() == 0) atomicMax(dts + 63, ((tt1 - tt0) << 16) | (unsigned long long)q);
#else
                  if (wave == 0 && MKLANE() == 0) atomicMax(dts + 63, (tt1 << 16) | (unsigned long long)q);
                  if (wave == 0 && MKLANE() == 0 && q == DIAG_TASKQ) __hip_atomic_store(dts + 59, tt1 - tt0, __ATOMIC_RELAXED, __HIP_MEMORY_SCOPE_AGENT);
#endif
                }
#endif
            }
        }
        DIAG_STAMP(19); DIAG_STAMP_MAX(62);
    }
    SEAM(3);
#if (REP_MASK >> 4) & 1
    { const int rep = 1; (void)rep;
    if (IN(4)) {
        mx::lds_ptr L = (mx::lds_ptr)lds;
        if (!(a.flags & 1) && SUBON4(0)) for (int it = bx; it < 512; it += G) mx::ret_out_task(PROJ, STT, ret_norm, MIX, it >> 6, it & 63, L, tid);
        if (!(a.flags & 2) && SUBON4(1)) for (int it = bx; it < 16 * 64; it += G) mx::moba_diag_unit(PROJ, it >> 6, it & 63, PART_O, PART_L, SEL, MIX, L, tid);
    }
    }
    asm volatile("" ::: "memory");
#endif
    { const int rep = 0; (void)rep;
    if (IN(4)) {
        mx::lds_ptr L = (mx::lds_ptr)lds;
        if (P4_DIAG_FIRST(vcu)) for (int it = bx; it < 16 * 64; it += G) mx::moba_diag_unit(PROJ, it >> 6, it & 63, PART_O, PART_L, SEL, MIX, L, tid);
        for (int it = bx; it < 512; it += G) mx::ret_out_task(PROJ, STT, ret_norm, MIX, it >> 6, it & 63, L, tid, DIAG_DTS(it));
        DIAG_STAMP(16);
        if (!P4_DIAG_FIRST(vcu)) for (int it = bx; it < 16 * 64; it += G) mx::moba_diag_unit(PROJ, it >> 6, it & 63, PART_O, PART_L, SEL, MIX, L, tid);
        DIAG_STAMP(17);
    }
    }
    SEAM(4);
#if (REP_MASK >> 5) & 1
    if (IN(5)) {
        pg8::Gemm g{MIX, Wout_t, MT, DM, DM}; pg8::StaticOrder S; S.init(MT, DM, G, bx);
        pg8::EpiRes<false> E{x, XB, RSQ, nullptr, nullptr};
        pg8::gemm_phase<pg8::EpiRes<false>, pg8::StaticOrder, true, true>((PG8_LAS unsigned char*)lds, g, S, E, MKTID());
    }
    asm volatile("" ::: "memory");
#endif
    if (IN(5)) {
        pg8::Gemm g{MIX, Wout_t, MT, DM, DM}; pg8::StaticOrder S; S.init(MT, DM, G, bx);
        pg8::EpiResXN E{XN, RS0, attn_norm, XB, RSQ, X8};
        pg8::gemm_phase<pg8::EpiResXN, pg8::StaticOrder, true, true>((PG8_LAS unsigned char*)lds, g, S, E, MKTID());
    }
    SEAM(5);
#if (REP_MASK >> 6) & 1
    if (IN(6)) {
        pg8::Gemm g{(const bf16_t*)X8, (const bf16_t*)Wug8, MT, 2 * FF, DM / 2}; pg8::StaticOrder S; S.init(MT, 2 * FF, G, bx);
        pg8::EpiUG E{ACT, RSQ, conv_w, conv_b, UL, UF, GF, WSC};
        pg8::gemm_phase<pg8::EpiUG, pg8::StaticOrder, true, true, true>((PG8_LAS unsigned char*)lds, g, S, E, MKTID());
    }
    asm volatile("" ::: "memory");
#endif
    if (IN(6)) {
        pg8::Gemm g{(const bf16_t*)X8, (const bf16_t*)Wug8, MT, 2 * FF, DM / 2}; pg8::StaticOrder S; S.init(MT, 2 * FF, G, bx);
        pg8::EpiUG E{ACT, RSQ, conv_w, conv_b, UL, UF, GF, WSC};
        pg8::gemm_phase<pg8::EpiUG, pg8::StaticOrder, true, true, true>((PG8_LAS unsigned char*)lds, g, S, E, MKTID());
    }
    SEAM(6);
#if (REP_MASK >> 7) & 1
    for (int rep = 0; rep < 2; ++rep)
#endif
    if (IN(7)) {
        const size_t gt = (size_t)vcu * NTHREADS + tid, GT = (size_t)G * NTHREADS;
        for (size_t i = gt; i < (size_t)512 * 2 * (FF / 4); i += GT) {
            const int c = (int)(i % (FF / 4)) * 4, r = (int)((i / (FF / 4)) & 1), g64 = (int)(i / (FF / 4) / 2);
            const bool first = (g64 & 255) == 0; const size_t pg = first ? 0 : (size_t)(g64 - 1);
            const pg8::f32x4 q0 = *(const pg8::f32x4*)(UL + (pg * 2 + 0) * FF + c), q1 = *(const pg8::f32x4*)(UL + (pg * 2 + 1) * FF + c);
            const pg8::f32x4 f0 = *(const pg8::f32x4*)(UF + ((size_t)g64 * 2 + 0) * FF + c), f1 = *(const pg8::f32x4*)(UF + ((size_t)g64 * 2 + 1) * FF + c);
            const pg8::f32x4 gg = *(const pg8::f32x4*)(GF + ((size_t)g64 * 2 + r) * FF + c);
            const pg8::f32x4 w0 = *(const pg8::f32x4*)(conv_w + c), w1 = *(const pg8::f32x4*)(conv_w + FF + c), w2 = *(const pg8::f32x4*)(conv_w + 2 * FF + c), cb = *(const pg8::f32x4*)(conv_b + c);
            const float z = first ? 0.f : 1.f;
            const pg8::f32x4 p0 = q0 * z, p1 = q1 * z;
            const pg8::f32x4 u2 = r == 0 ? p0 : p1, u1 = r == 0 ? p1 : f0, u0 = r == 0 ? f0 : f1;
            const pg8::f32x4 su = *(const pg8::f32x4*)(WSC + (c >> 7) * 256 + (c & 127));
            const pg8::f32x4 y = cb + su * (w0 * u2 + w1 * u1 + w2 * u0);
            ushort4 o; o.x = f2bf(gelu_tanh(y[0]) * gg[0]); o.y = f2bf(gelu_tanh(y[1]) * gg[1]); o.z = f2bf(gelu_tanh(y[2]) * gg[2]); o.w = f2bf(gelu_tanh(y[3]) * gg[3]);
            *(ushort4*)(ACT + ((size_t)g64 * 64 + r) * FF + c) = o;
        }
        { int kk = PLED; asm volatile("" : "+s"(kk)); pg8::Gemm g{PB, Wple_t, MT, DM, kk}; pg8::StaticOrder S; S.init(MT, DM, G, bx); pg8::EpiStore E{PW};
          pg8::gemm_phase<pg8::EpiStore, pg8::StaticOrder, true, true>((PG8_LAS unsigned char*)lds, g, S, E, MKTID()); }
    }
    SEAM(7);
#if (REP_MASK >> 8) & 1
    if (IN(8)) {
        pg8::Gemm g{ACT, Wdown_t, MT, DM, FF}; pg8::StaticOrder S; S.init(MT, DM, G, bx);
        pg8::EpiRes<true, false> E{nullptr, XB, RSQ + (size_t)MT * 16, nullptr, nullptr};
        pg8::gemm_phase<pg8::EpiRes<true, false>, pg8::StaticOrder, true, true>((PG8_LAS unsigned char*)lds, g, S, E, MKTID());
    }
    asm volatile("" ::: "memory");
#endif
    if (IN(8)) {
        pg8::Gemm g{ACT, Wdown_t, MT, DM, FF}; pg8::StaticOrder S; S.init(MT, DM, G, bx);
        pg8::EpiRes<true, true, true> E{nullptr, XB, RSQ + (size_t)MT * 16, RS0, X8};
        pg8::gemm_phase<pg8::EpiRes<true, true, true>, pg8::StaticOrder, true, true>((PG8_LAS unsigned char*)lds, g, S, E, MKTID());
    }
    SEAM(8);
#if (REP_MASK >> 9) & 1
    if (IN(9)) {
        if (REP_SUB & 1) { int kk = PLED; asm volatile("" : "+s"(kk)); pg8::Gemm g{PB, Wple_t, MT, DM, kk}; pg8::StaticOrder S; S.init(MT, DM, G, bx); pg8::EpiStore E{PW};
          pg8::gemm_phase<pg8::EpiStore, pg8::StaticOrder, true, true>((PG8_LAS unsigned char*)lds, g, S, E, MKTID()); }
        if (REP_SUB & 2) { int kk = DM; const bf16_t* a_ = XB; const bf16_t* b_ = Wpg_t; asm volatile("" : "+s"(kk), "+s"(a_), "+s"(b_) :: "memory"); pg8::Gemm g{a_, b_, MT, DM, kk}; pg8::StaticOrder S; S.init(MT, DM, G, bx); pg8::EpiPleNorm E{out, XB, PW, RSQ + (size_t)MT * 16, RSQ + (size_t)2 * MT * 16, (unsigned*)(ws + WS_CTL) + CW_PANEL, final_norm, DIAG_DTS(bx)};
          pg8::gemm_phase<pg8::EpiPleNorm, pg8::StaticOrder, true, true>((PG8_LAS unsigned char*)lds, g, S, E, MKTID()); }
    }
    asm volatile("" ::: "memory");
#endif
    if (IN(9)) {
        DIAG_STAMP(20);
        { int kk = DM / 2; const bf16_t* a_ = (const bf16_t*)X8; const bf16_t* b_ = (const bf16_t*)Wpg8; asm volatile("" : "+s"(kk), "+s"(a_), "+s"(b_) :: "memory"); pg8::Gemm g{a_, b_, MT, DM, kk}; pg8::StaticOrder S; S.init(MT, DM, G, bx); pg8::EpiPleNorm E{out, XB, PW, RSQ + (size_t)MT * 16, RSQ + (size_t)2 * MT * 16, (unsigned*)(ws + WS_CTL) + CW_PANEL, final_norm, DIAG_DTS(bx), (const unsigned*)(ws + WS_CTL) + CW_WPGMAX};
          pg8::gemm_phase<pg8::EpiPleNorm, pg8::StaticOrder, true, true, true>((PG8_LAS unsigned char*)lds, g, S, E, MKTID()); }
    }
    SEAM(9);
    if (IN(10)) {
        const float* rsq = RSQ + (size_t)2 * MT * 16;
        for (int m = gw; m < MT; m += NGW) {
            const float rs = pg8::rs16(rsq + (size_t)m * 16); float4* xr = (float4*)(out + (size_t)m * DM);
#pragma unroll
            for (int j = 0; j < 4; ++j) { float4 v = xr[lane + 64 * j]; const float4 gg = ((const float4*)final_norm)[lane + 64 * j];
                v.x *= rs * gg.x; v.y *= rs * gg.y; v.z *= rs * gg.z; v.w *= rs * gg.w; xr[lane + 64 * j] = v; }
        }
    }
#if DIAG_K >= 0
    xcd_barrier(xbar, MKTID()); DIAG_STAMP(11);
    xcd_barrier(xbar, MKTID());
    { const unsigned long long t0 = __hip_atomic_load(dts + 0, __ATOMIC_RELAXED, __HIP_MEMORY_SCOPE_AGENT), t1 = __hip_atomic_load(dts + 11, __ATOMIC_RELAXED, __HIP_MEMORY_SCOPE_AGENT);
      const unsigned long long ta = __hip_atomic_load(dts + (DIAG_K == 99 ? DIAG_A : DIAG_K), __ATOMIC_RELAXED, __HIP_MEMORY_SCOPE_AGENT), tb = DIAG_K == 99 ? __hip_atomic_load(dts + DIAG_B, __ATOMIC_RELAXED, __HIP_MEMORY_SCOPE_AGENT) : (DIAG_K == 9 ? t1 : __hip_atomic_load(dts + DIAG_K + 1, __ATOMIC_RELAXED, __HIP_MEMORY_SCOPE_AGENT));
      float eps = (float)(tb - ta) / (float)(t1 - t0);
#ifdef DIAG_TASK
      { const unsigned long long v_ = __hip_atomic_load(dts + 63, __ATOMIC_RELAXED, __HIP_MEMORY_SCOPE_AGENT);
        if (DIAG_TASK == 1 || DIAG_TASK == 3) eps = (float)(v_ & 0xffffull) / 1008.0f;
        else if (DIAG_TASK == 2) eps = (float)(v_ >> 16) / (float)(t1 - t0);
        else eps = (float)__hip_atomic_load(dts + 59, __ATOMIC_RELAXED, __HIP_MEMORY_SCOPE_AGENT) / (float)(t1 - t0); }
#endif
#ifdef DIAG_CLOCK
      { const unsigned long long ca = __hip_atomic_load(dts + 64 + DIAG_A, __ATOMIC_RELAXED, __HIP_MEMORY_SCOPE_AGENT), cb = __hip_atomic_load(dts + 64 + DIAG_B, __ATOMIC_RELAXED, __HIP_MEMORY_SCOPE_AGENT);
        eps = 0.01f * (float)(cb - ca) / (float)(tb - ta); }
#endif
      const float sc = 1.0f + DIAG_SCALE * eps;
      float4* o4 = (float4*)out; const size_t gt = (size_t)vcu * NTHREADS + tid, GT = (size_t)G * NTHREADS;
      for (size_t i = gt; i < (size_t)MT * DM / 4; i += GT) { float4 v = o4[i]; v.x *= sc; v.y *= sc; v.z *= sc; v.w *= sc; o4[i] = v; } }
#endif
#undef IN
#undef SEAM
#undef tid
#undef lane
}

#ifndef BUILD_MODE
#define BUILD_MODE 0
#endif
static int g_grid = 0;
static void launch_mega(Args a, int lo, int hi, hipStream_t stream) {
    a.ph_lo = lo; a.ph_hi = hi; void* args[] = {&a};
    hipError_t e = hipLaunchCooperativeKernel((const void*)mega, dim3(g_grid), dim3(NTHREADS), args, LDS_BYTES, stream);
    if (e != hipSuccess) fprintf(stderr, "cooperative launch [%d,%d) failed: %s (grid %d)\n", lo, hi, hipGetErrorString(e), g_grid);
}
extern "C" void kernel_launch(void* const* d_in, const int* in_sizes, int n_in, void* d_out, int out_size, void* d_ws, size_t ws_size, hipStream_t stream) {
    if (n_in != 16 || out_size != MT * DM || ws_size < WS_END) { fprintf(stderr, "kernel_launch: unexpected shapes (n_in %d out %d ws %zu)\n", n_in, out_size, ws_size); return; }
    if (g_grid == 0) {
        int dev = 0, cus = 0, per_cu = 0;
        hipGetDevice(&dev); hipDeviceGetAttribute(&cus, hipDeviceAttributeMultiprocessorCount, dev);
        hipFuncSetAttribute((const void*)mega, hipFuncAttributeMaxDynamicSharedMemorySize, LDS_BYTES);
        hipOccupancyMaxActiveBlocksPerMultiprocessor(&per_cu, (const void*)mega, NTHREADS, LDS_BYTES);
        if (per_cu < 1) { fprintf(stderr, "occupancy query says %d blocks/CU\n", per_cu); per_cu = 1; }
        g_grid = cus * 1;
        (void)hipGetLastError();
    }
    unsigned char* ws = (unsigned char*)d_ws;
    hipMemsetAsync(ws + WS_CTL, 0, CTL_ZERO_BYTES, stream);
    Args a{}; for (int i = 0; i < 16; ++i) a.in[i] = (const float*)d_in[i]; a.out = (float*)d_out; a.ws = ws;

    a.flags = 0; launch_mega(a, 0, NPH, stream);
}
```
